# Optimizing an MI355X kernel written in HIP

```python
import jax, jax.numpy as jnp
from jax import lax
import numpy as np

D_MODEL = 1024
BATCH = 4
SEQ = 4096
DEPTH = 2

HEAD_DIM = 64
ROT_DIM = HEAD_DIM // 4
ROPE_THETA = 500000.0
A_HEADS = (D_MODEL // 2) // (2 * HEAD_DIM)
B_HEADS = (D_MODEL // 2) // HEAD_DIM
KV_LORA = D_MODEL // 4
IDX_HEADS = 4
IDX_DIM = 64
TOPK_MAX = 256
QBLOCK = 128
C_WIDTH = D_MODEL // 2
CONV_W = 3
POOL_WINDOWS = (2, 4, 8, 16)
POOL_WIDTH = D_MODEL // 2
POOL_GROUP = POOL_WIDTH // len(POOL_WINDOWS)
MEM_LEN = 256
X_HEADS = 4
X_HEAD_DIM = D_MODEL // 8
D_FF = 4 * D_MODEL
EPS = 1e-6
N_EVEN = (DEPTH + 1) // 2
N_ODD = DEPTH // 2
EVEN_SPLITS = (A_HEADS * 2 * HEAD_DIM, A_HEADS * 2 * HEAD_DIM, A_HEADS * 2 * HEAD_DIM,
               B_HEADS * HEAD_DIM, KV_LORA, IDX_HEADS * IDX_DIM, IDX_DIM, IDX_HEADS)
EVEN_IN = sum(EVEN_SPLITS)
ODD_SPLITS = (C_WIDTH, C_WIDTH, C_WIDTH, POOL_WIDTH)
ODD_IN = sum(ODD_SPLITS)

kernel_name = 'hybrid_diff_dsa_conv_pool_trunk'


def rmsnorm(x, g):
    xf = x.astype(jnp.float32)
    y = xf * lax.rsqrt(jnp.mean(xf * xf, axis=-1, keepdims=True) + EPS)
    return (y * g.astype(jnp.float32)).astype(x.dtype)


def _split(a, sizes):
    return jnp.split(a, np.cumsum(sizes)[:-1].tolist(), axis=-1)


def rope_tables(positions):
    inv = ROPE_THETA ** (-jnp.arange(0, ROT_DIM, 2, dtype=jnp.float32) / ROT_DIM)
    ang = positions.astype(jnp.float32)[..., None] * inv
    return jnp.cos(ang)[:, :, None, :], jnp.sin(ang)[:, :, None, :]


def rope(x, cos, sin):
    half = ROT_DIM // 2
    xr, xp = x[..., :ROT_DIM], x[..., ROT_DIM:]
    x1, x2 = xr[..., :half], xr[..., half:]
    rot = jnp.concatenate([x1 * cos - x2 * sin, x2 * cos + x1 * sin], axis=-1)
    return jnp.concatenate([rot.astype(x.dtype), xp], axis=-1)


def even_mixer(h, cos, sin, w_in, gq_a, gk_a, lam, lam_init, g_sub_a,
               g_kv_b, w_kv_up_b, gq_b, gk_b, g_kidx, w_out, k_sel):
    B, S, _ = h.shape
    nb = S // QBLOCK

    def to_blocks(a):
        return jnp.moveaxis(a.reshape((B, nb, QBLOCK) + a.shape[2:]), 1, 0)

    def from_blocks(o):
        return jnp.moveaxis(o, 0, 1).reshape((B, S) + o.shape[3:])

    qa, ka, va, qb, ckv, qi, ki, wi = _split(h @ w_in, EVEN_SPLITS)

    qa = rope(rmsnorm(qa.reshape(B, S, 2 * A_HEADS, HEAD_DIM), gq_a), cos, sin)
    qa = qa.reshape(B, S, A_HEADS, 2, HEAD_DIM)
    ka = rope(rmsnorm(ka.reshape(B, S, 2 * A_HEADS, HEAD_DIM), gk_a), cos, sin)
    ka = ka.reshape(B, S, A_HEADS, 2, HEAD_DIM)
    va = va.reshape(B, S, A_HEADS, 2 * HEAD_DIM)

    kb, vb = jnp.split(rmsnorm(ckv, g_kv_b) @ w_kv_up_b, 2, axis=-1)
    qb = rope(rmsnorm(qb.reshape(B, S, B_HEADS, HEAD_DIM), gq_b), cos, sin)
    kb = rope(rmsnorm(kb.reshape(B, S, B_HEADS, HEAD_DIM), gk_b), cos, sin)
    vb = vb.reshape(B, S, B_HEADS, HEAD_DIM)
    qi = rope(qi.reshape(B, S, IDX_HEADS, IDX_DIM), cos, sin)
    ki = rope(rmsnorm(ki, g_kidx)[:, :, None, :], cos, sin)[:, :, 0, :]
    wi = wi.astype(jnp.float32) * (IDX_HEADS ** -0.5 * IDX_DIM ** -0.5)

    kpos = jnp.arange(S)
    scale = HEAD_DIM ** -0.5

    def a_block(args):
        q, t0 = args
        qpos = t0 + jnp.arange(QBLOCK)
        causal = kpos[None, :] <= qpos[:, None]
        logits = jnp.einsum('bqhcd,bkhcd->bhcqk', q, ka).astype(jnp.float32) * scale
        p = jax.nn.softmax(jnp.where(causal, logits, -jnp.inf), axis=-1)
        attn = p[:, :, 0] - lam * p[:, :, 1]
        return jnp.einsum('bhqk,bkhe->bqhe', attn.astype(va.dtype), va)

    def b_block(args):
        q, qidx, widx, t0 = args
        qpos = t0 + jnp.arange(QBLOCK)
        causal = kpos[None, :] <= qpos[:, None]
        isc = jax.nn.relu(jnp.einsum('bqhd,bkd->bqhk', qidx, ki).astype(jnp.float32))
        isc = jnp.einsum('bqhk,bqh->bqk', isc, widx)
        isc = jnp.where(causal[None], isc, -jnp.inf)
        _, idx = lax.top_k(isc, k_sel)
        k_g = jax.vmap(lambda a, i: a[i])(kb, idx)
        v_g = jax.vmap(lambda a, i: a[i])(vb, idx)
        logits = jnp.einsum('bqhd,bqkhd->bhqk', q, k_g).astype(jnp.float32) * scale
        valid = (idx <= qpos[None, :, None])[:, None]
        p = jax.nn.softmax(jnp.where(valid, logits, -jnp.inf), axis=-1)
        return jnp.einsum('bhqk,bqkhd->bqhd', p.astype(vb.dtype), v_g)

    starts = jnp.arange(nb, dtype=jnp.int32) * QBLOCK
    out_a = from_blocks(lax.map(a_block, (to_blocks(qa), starts)))
    out_a = rmsnorm(out_a, g_sub_a) * (1.0 - lam_init)
    out_b = from_blocks(lax.map(b_block, (to_blocks(qb), to_blocks(qi), to_blocks(wi), starts)))
    y = jnp.concatenate([out_a.reshape(B, S, -1), out_b.reshape(B, S, -1)], axis=-1)
    return y @ w_out


def pool_mixer(z, w_pool, pool_scale):
    B, S, _ = z.shape
    zf = z.astype(jnp.float32).reshape(B, S, len(POOL_WINDOWS), POOL_GROUP)
    csp = jnp.pad(jnp.cumsum(zf, axis=1), ((0, 0), (1, 0), (0, 0), (0, 0)))
    t = jnp.arange(S)
    outs = []
    for g, w in enumerate(POOL_WINDOWS):
        lo = jnp.maximum(t + 1 - w, 0)
        win_sum = csp[:, 1:, g] - csp[:, lo, g]
        cnt = jnp.minimum(t + 1, w).astype(jnp.float32)
        outs.append(win_sum / cnt[None, :, None] - zf[:, :, g])
    pooled = jnp.stack(outs, axis=2).astype(z.dtype)
    y = jnp.einsum('bsgc,gcd->bsgd', pooled, w_pool).reshape(B, S, POOL_WIDTH)
    return y * pool_scale


def odd_mixer(h, w_in, conv_w, w_pool, pool_scale, w_out):
    gb, gc, hc, zd = _split(h @ w_in, ODD_SPLITS)
    u = gc * hc
    conv = lax.conv_general_dilated(
        u, conv_w[:, None, :].astype(u.dtype), window_strides=(1,),
        padding=[(CONV_W - 1, 0)], dimension_numbers=('NWC', 'WIO', 'NWC'),
        feature_group_count=C_WIDTH)
    yc = gb * conv
    yd = pool_mixer(zd, w_pool, pool_scale)
    return jnp.concatenate([yc, yd], axis=-1) @ w_out


def cross_attn(h, m, wq, wkv, gq, gk, wo):
    B, S, _ = h.shape
    q = rmsnorm((h @ wq).reshape(B, S, X_HEADS, X_HEAD_DIM), gq)
    k, v = jnp.split(m @ wkv, 2, axis=-1)
    k = rmsnorm(k.reshape(B, -1, X_HEADS, X_HEAD_DIM), gk)
    v = v.reshape(B, -1, X_HEADS, X_HEAD_DIM)
    logits = jnp.einsum('bqhd,bkhd->bhqk', q, k).astype(jnp.float32) * X_HEAD_DIM ** -0.5
    p = jax.nn.softmax(logits, axis=-1)
    o = jnp.einsum('bhqk,bkhd->bqhd', p.astype(v.dtype), v).reshape(B, S, -1)
    return o @ wo


def mlp(h, w_up, w_down):
    return jnp.square(jax.nn.relu(h @ w_up)) @ w_down


def setup_inputs(seed: int = 0) -> dict:
    key = jax.random.key(seed)
    ks = iter(jax.random.split(key, 48))

    def nrm(shape, scale):
        return scale * jax.random.normal(next(ks), shape, jnp.float32)

    def gain(shape):
        return 1.0 + 0.05 * jax.random.normal(next(ks), shape, jnp.float32)

    d = D_MODEL
    return {
        'x': nrm((BATCH, SEQ, d), 1.0),
        'mem': nrm((BATCH, MEM_LEN, d), 1.0),
        'positions': jnp.tile(jnp.arange(SEQ, dtype=jnp.int32)[None, :], (BATCH, 1)),
        'g_mix': gain((DEPTH, d)),
        'g_xattn': gain((DEPTH, d)),
        'g_mem': gain((DEPTH, d)),
        'g_mlp': gain((DEPTH, d)),
        'wq_x': nrm((DEPTH, d, X_HEADS * X_HEAD_DIM), d ** -0.5),
        'wkv_x': nrm((DEPTH, d, 2 * X_HEADS * X_HEAD_DIM), d ** -0.5),
        'gq_x': gain((DEPTH, X_HEAD_DIM)),
        'gk_x': gain((DEPTH, X_HEAD_DIM)),
        'wo_x': nrm((DEPTH, X_HEADS * X_HEAD_DIM, d), (X_HEADS * X_HEAD_DIM) ** -0.5),
        'w_up': nrm((DEPTH, d, D_FF), d ** -0.5),
        'w_down': nrm((DEPTH, D_FF, d), D_FF ** -0.5),
        'w_in_e': nrm((N_EVEN, d, EVEN_IN), d ** -0.5),
        'gq_a': gain((N_EVEN, HEAD_DIM)),
        'gk_a': gain((N_EVEN, HEAD_DIM)),
        'lam_q1': nrm((N_EVEN, HEAD_DIM), 0.1),
        'lam_k1': nrm((N_EVEN, HEAD_DIM), 0.1),
        'lam_q2': nrm((N_EVEN, HEAD_DIM), 0.1),
        'lam_k2': nrm((N_EVEN, HEAD_DIM), 0.1),
        'g_sub_a': gain((N_EVEN, 2 * HEAD_DIM)),
        'g_kv_b': gain((N_EVEN, KV_LORA)),
        'w_kv_up_b': nrm((N_EVEN, KV_LORA, 2 * B_HEADS * HEAD_DIM), KV_LORA ** -0.5),
        'gq_b': gain((N_EVEN, HEAD_DIM)),
        'gk_b': gain((N_EVEN, HEAD_DIM)),
        'g_kidx': gain((N_EVEN, IDX_DIM)),
        'w_out_e': nrm((N_EVEN, d, d), d ** -0.5),
        'w_in_o': nrm((N_ODD, d, ODD_IN), d ** -0.5),
        'conv_w': nrm((N_ODD, CONV_W, C_WIDTH), CONV_W ** -0.5),
        'w_pool': nrm((N_ODD, len(POOL_WINDOWS), POOL_GROUP, POOL_GROUP), POOL_GROUP ** -0.5),
        'pool_scale': gain((N_ODD, POOL_WIDTH)),
        'w_out_o': nrm((N_ODD, d, d), d ** -0.5),
    }


def reference(x, mem, positions, g_mix, g_xattn, g_mem, g_mlp, wq_x, wkv_x, gq_x, gk_x,
              wo_x, w_up, w_down, w_in_e, gq_a, gk_a, lam_q1, lam_k1, lam_q2, lam_k2,
              g_sub_a, g_kv_b, w_kv_up_b, gq_b, gk_b, g_kidx, w_out_e, w_in_o, conv_w,
              w_pool, pool_scale, w_out_o):
    S = x.shape[1]
    k_sel = min(TOPK_MAX, S // 4)
    cos, sin = rope_tables(positions)
    for i in range(DEPTH):
        j = i // 2
        h = rmsnorm(x, g_mix[i])
        if i % 2 == 0:
            lam_init = 0.8 - 0.6 * float(np.exp(-0.3 * i))
            f32 = jnp.float32
            lam = (jnp.exp(jnp.sum(lam_q1[j].astype(f32) * lam_k1[j].astype(f32)))
                   - jnp.exp(jnp.sum(lam_q2[j].astype(f32) * lam_k2[j].astype(f32)))
                   + lam_init)
            mix = even_mixer(h, cos, sin, w_in_e[j], gq_a[j], gk_a[j], lam, lam_init,
                             g_sub_a[j], g_kv_b[j], w_kv_up_b[j], gq_b[j], gk_b[j],
                             g_kidx[j], w_out_e[j], k_sel)
        else:
            mix = odd_mixer(h, w_in_o[j], conv_w[j], w_pool[j], pool_scale[j], w_out_o[j])
        x = x + mix
        x = x + cross_attn(rmsnorm(x, g_xattn[i]), rmsnorm(mem, g_mem[i]),
                           wq_x[i], wkv_x[i], gq_x[i], gk_x[i], wo_x[i])
        x = x + mlp(rmsnorm(x, g_mlp[i]), w_up[i], w_down[i])
    return x
```

```cpp
#include <hip/hip_runtime.h>
#include <hip/hip_cooperative_groups.h>
#include <cstdio>
#include <cstdint>
namespace cg = cooperative_groups;

#define DEVI __device__ __forceinline__
#define LAS __attribute__((address_space(3)))
typedef unsigned short bf16_t;
typedef short bf16x8 __attribute__((ext_vector_type(8)));
typedef short s16x4 __attribute__((ext_vector_type(4)));
typedef float f32x2 __attribute__((ext_vector_type(2)));
typedef float f32x4 __attribute__((ext_vector_type(4)));
typedef float f32x16 __attribute__((ext_vector_type(16)));
typedef unsigned u32x2 __attribute__((ext_vector_type(2)));
typedef unsigned u32x4 __attribute__((ext_vector_type(4)));
typedef unsigned long long u64;

constexpr int NB = 4, S = 4096, T = NB * S, D = 1024, DFF = 4096, MEML = 256, MEMT = NB * MEML;
constexpr int LDP = 2816;
constexpr int C_QA = 0, C_KA = 512, C_VA = 1024, C_QB = 1536, C_CKV = 2048, C_QI = 2304, C_KI = 2560, C_WI = 2624, EVEN_IN = 2628;
constexpr float EPS = 1e-6f;
constexpr float LOG2E = 1.4426950408889634f;
constexpr int NTHR = 512, NWAVE = 8;
constexpr int LDS_BYTES = 147456;

constexpr size_t MiB = 1u << 20;
constexpr size_t WS_SSQ = 0;
constexpr size_t WS_SSQCKV = WS_SSQ + 6ull * T * 4;
constexpr size_t WS_SSQMEM = WS_SSQCKV + (size_t)T * 4;
constexpr size_t WS_WI = 512 * 1024;
constexpr size_t WS_W = 2 * MiB;
constexpr size_t W_INE = WS_W;
constexpr size_t W_KVUP = W_INE + (size_t)LDP * 1024 * 2;
constexpr size_t W_OUTE = W_KVUP + 1024ull * 256 * 2;
constexpr size_t W_QX = W_OUTE + 1024ull * 1024 * 2;
constexpr size_t W_KVX = W_QX + 2 * 512ull * 1024 * 2;
constexpr size_t W_OX = W_KVX + 2 * 1024ull * 1024 * 2;
constexpr size_t W_UP = W_OX + 2 * 1024ull * 512 * 2;
constexpr size_t W_DOWN = W_UP + 2 * 4096ull * 1024 * 2;
constexpr size_t W_INO = W_DOWN + 2 * 4096ull * 1024 * 2;
constexpr size_t W_POOL = W_INO + 2048ull * 1024 * 2;
constexpr size_t W_OUTO = W_POOL + 512ull * 512 * 2;
constexpr size_t W_END = W_OUTO + 1024ull * 1024 * 2;
static_assert(W_END <= 57 * MiB, "weights region");
constexpr size_t WS_XB = 57 * MiB;
constexpr size_t WS_PROJ = 89 * MiB;
constexpr size_t WS_KBVB = 177 * MiB;
constexpr size_t WS_MASK = 209 * MiB;
constexpr size_t WS_Y = 217 * MiB;
constexpr size_t WS_CS = 249 * MiB;
constexpr size_t WS_MB = 250 * MiB;
constexpr size_t WS_KVX = 252 * MiB;
constexpr size_t WS_END = 256 * MiB;
constexpr size_t WS_QX = WS_PROJ;
constexpr size_t WS_YX = WS_PROJ + 16 * MiB;
constexpr size_t WS_H = WS_PROJ;
constexpr size_t WS_PROJ1 = WS_PROJ;
constexpr size_t WS_POOLED = WS_PROJ + 64 * MiB;

struct Params { const float* in[33]; float* out; unsigned char* ws; };

DEVI float bf2f(bf16_t v) { return __uint_as_float(((unsigned)v) << 16); }
DEVI unsigned f2bf(float f) { unsigned u = __float_as_uint(f); return (u + 0x7fffu + ((u >> 16) & 1u)) >> 16; }
DEVI unsigned pk2(float lo, float hi) { return f2bf(lo) | (f2bf(hi) << 16); }
DEVI float wave_sum(float v) {
#pragma unroll
    for (int o = 1; o < 64; o <<= 1) v += __shfl_xor(v, o);
    return v;
}
DEVI float lo16(unsigned w) { return __uint_as_float(w << 16); }
DEVI float hi16(unsigned w) { return __uint_as_float(w & 0xffff0000u); }
#define LDS_WAIT() asm volatile("s_waitcnt lgkmcnt(0)" ::: "memory")

struct TrD { const float* src; bf16_t* dst; const float* sk; const float* sn; int K, N, ldd; };
constexpr int NTR = 19;
DEVI TrD get_tr(const Params& P, int i) {
    unsigned char* ws = P.ws; TrD d; d.sk = nullptr; d.sn = nullptr;
    switch (i) {
    case 0: d.src = P.in[14]; d.dst = (bf16_t*)(ws + W_INE); d.K = 1024; d.N = EVEN_IN; d.ldd = 1024; d.sk = P.in[3]; break;
    case 1: d.src = P.in[23]; d.dst = (bf16_t*)(ws + W_KVUP); d.K = 256; d.N = 1024; d.ldd = 256; d.sk = P.in[22]; break;
    case 2: d.src = P.in[27]; d.dst = (bf16_t*)(ws + W_OUTE); d.K = 1024; d.N = 1024; d.ldd = 1024; break;
    case 3: case 4: { int l = i - 3; d.src = P.in[7] + (size_t)l * 1024 * 512; d.dst = (bf16_t*)(ws + W_QX) + (size_t)l * 512 * 1024; d.K = 1024; d.N = 512; d.ldd = 1024; d.sk = P.in[4] + l * 1024; } break;
    case 5: case 6: { int l = i - 5; d.src = P.in[8] + (size_t)l * 1024 * 1024; d.dst = (bf16_t*)(ws + W_KVX) + (size_t)l * 1024 * 1024; d.K = 1024; d.N = 1024; d.ldd = 1024; d.sk = P.in[5] + l * 1024; } break;
    case 7: case 8: { int l = i - 7; d.src = P.in[11] + (size_t)l * 512 * 1024; d.dst = (bf16_t*)(ws + W_OX) + (size_t)l * 1024 * 512; d.K = 512; d.N = 1024; d.ldd = 512; } break;
    case 9: case 10: { int l = i - 9; d.src = P.in[12] + (size_t)l * 1024 * 4096; d.dst = (bf16_t*)(ws + W_UP) + (size_t)l * 4096 * 1024; d.K = 1024; d.N = 4096; d.ldd = 1024; d.sk = P.in[6] + l * 1024; } break;
    case 11: case 12: { int l = i - 11; d.src = P.in[13] + (size_t)l * 4096 * 1024; d.dst = (bf16_t*)(ws + W_DOWN) + (size_t)l * 1024 * 4096; d.K = 4096; d.N = 1024; d.ldd = 4096; } break;
    case 13: d.src = P.in[28]; d.dst = (bf16_t*)(ws + W_INO); d.K = 1024; d.N = 2048; d.ldd = 1024; d.sk = P.in[3] + 1024; break;
    case 14: case 15: case 16: case 17: { int g = i - 14; d.src = P.in[30] + (size_t)g * 128 * 128; d.dst = (bf16_t*)(ws + W_POOL) + (size_t)(g * 128) * 512 + g * 128; d.K = 128; d.N = 128; d.ldd = 512; d.sn = P.in[31] + g * 128; } break;
    default: d.src = P.in[32]; d.dst = (bf16_t*)(ws + W_OUTO); d.K = 1024; d.N = 1024; d.ldd = 1024; break;
    }
    return d;
}
DEVI int tr_items(const TrD& d) { return (d.K / 64) * ((d.N + 31) / 32); }
DEVI void tr_item(const TrD& d, LAS float* scr, int item, int lane) {
    const int nblk = (d.N + 31) / 32, kb = item / nblk, nb = item % nblk, k0 = 64 * kb, n0 = 32 * nb;
#pragma unroll 8
    for (int i = 0; i < 32; ++i) {
        const int kk = 2 * i + (lane >> 5), n = n0 + (lane & 31);
        float v = (n < d.N) ? d.src[(size_t)(k0 + kk) * d.N + n] : 0.f;
        if (d.sk) v *= d.sk[k0 + kk];
        scr[kk * 33 + (lane & 31)] = v;
    }
    LDS_WAIT(); asm volatile("" ::: "memory");
    const int c = lane & 7;
#pragma unroll
    for (int j = 0; j < 4; ++j) {
        const int n = (lane >> 3) + 8 * j;
        if (n0 + n < d.N) {
            const LAS float* s = scr + (8 * c) * 33 + n;
            const float sc = d.sn ? d.sn[n0 + n] : 1.f;
            u32x4 o; o.x = pk2(s[0 * 33] * sc, s[1 * 33] * sc); o.y = pk2(s[2 * 33] * sc, s[3 * 33] * sc); o.z = pk2(s[4 * 33] * sc, s[5 * 33] * sc); o.w = pk2(s[6 * 33] * sc, s[7 * 33] * sc);
            *(u32x4*)(d.dst + (size_t)(n0 + n) * d.ldd + k0 + 8 * c) = o;
        }
    }
    LDS_WAIT(); asm volatile("" ::: "memory");
}
DEVI void row_to_bf16_ssq(const float* xrow, bf16_t* orow, float* ssq_out, int lane) {
    const f32x4* xr = (const f32x4*)xrow + lane;
    f32x4 v[4]; float s = 0.f;
#pragma unroll
    for (int j = 0; j < 4; ++j) { v[j] = xr[64 * j]; s += (v[j].x * v[j].x + v[j].y * v[j].y) + (v[j].z * v[j].z + v[j].w * v[j].w); }
    s = wave_sum(s);
    if (lane == 0) *ssq_out = s;
    u32x2* o8 = (u32x2*)orow + lane;
#pragma unroll
    for (int j = 0; j < 4; ++j) { u32x2 w; w.x = pk2(v[j].x, v[j].y); w.y = pk2(v[j].z, v[j].w); o8[64 * j] = w; }
}
DEVI void phase_prologue(const Params& P, LAS unsigned char* lds) {
    const int tid = threadIdx.x, lane = tid & 63, wave = tid >> 6;
    const int gw = blockIdx.x * NWAVE + wave, NGW = gridDim.x * NWAVE;
    const int gt = blockIdx.x * NTHR + tid, NGT = gridDim.x * NTHR;
    unsigned char* ws = P.ws;
    LAS float* scr = (LAS float*)(lds + wave * 16384);
    int base = 0;
    for (int i = 0; i < NTR; ++i) {
        const TrD d = get_tr(P, i); const int n = tr_items(d);
        int first = gw - (base % NGW); if (first < 0) first += NGW;
        for (int it = first; it < n; it += NGW) tr_item(d, scr, it, lane);
        base += n;
    }
    { bf16_t* w = (bf16_t*)(ws + W_INE) + (size_t)EVEN_IN * 1024; const int n = (LDP - EVEN_IN) * 1024 / 8;
      for (int i = gt; i < n; i += NGT) ((u32x4*)w)[i] = (u32x4){0u, 0u, 0u, 0u}; }
    { bf16_t* w = (bf16_t*)(ws + W_POOL); for (int i = gt; i < 512 * 512 / 8; i += NGT) { const int n = i / 64, k = (i % 64) * 8; if ((n >> 7) != (k >> 7)) ((u32x4*)w)[i] = (u32x4){0u, 0u, 0u, 0u}; } }
    { float* q = (float*)(ws + WS_SSQ) + T; for (int i = gt; i < 5 * T; i += NGT) q[i] = 0.f; }
    for (int m = gw; m < T; m += NGW) row_to_bf16_ssq(P.in[0] + (size_t)m * D, (bf16_t*)(ws + WS_XB) + (size_t)m * D, (float*)(ws + WS_SSQ) + m, lane);
    for (int m = gw; m < MEMT; m += NGW) row_to_bf16_ssq(P.in[1] + (size_t)m * D, (bf16_t*)(ws + WS_MB) + (size_t)m * D, (float*)(ws + WS_SSQMEM) + m, lane);
    { const int* pos = (const int*)P.in[2]; float* cs = (float*)(ws + WS_CS);
      for (int i = gt; i < T * 8; i += NGT) { const int m = i >> 3, f = i & 7;
        const double inv = exp(-log(500000.0) * (double)f / 8.0), ang = (double)pos[m] * inv;
        cs[m * 16 + f] = (float)cos(ang); cs[m * 16 + 8 + f] = (float)sin(ang); } }
}

struct EpiStore {
    bf16_t* O; int ldo; const float* ssq; float inv_n; int act;
    DEVI void operator()(const f32x4 (&acc)[4][4], int row0, int col0, int lane) const {
#pragma unroll
        for (int m = 0; m < 4; ++m)
#pragma unroll
            for (int i = 0; i < 4; ++i) {
                const int row = row0 + 16 * m + (lane >> 4) * 4 + i;
                const float rs = ssq ? rsqrtf(ssq[row] * inv_n + EPS) : 1.f;
#pragma unroll
                for (int n = 0; n < 4; ++n) {
                    float v = acc[m][n][i] * rs;
                    if (act == 1) { v = fmaxf(v, 0.f); v = v * v; }
                    O[(size_t)row * ldo + col0 + 16 * n + (lane & 15)] = (bf16_t)f2bf(v);
                }
            }
    }
};
struct EpiRes {
    const float* base; float* out; bf16_t* xb; float* ssq_next;
    DEVI void operator()(const f32x4 (&acc)[4][4], int row0, int col0, int lane) const {
#pragma unroll
        for (int m = 0; m < 4; ++m)
#pragma unroll
            for (int i = 0; i < 4; ++i) {
                const int row = row0 + 16 * m + (lane >> 4) * 4 + i; float s = 0.f;
#pragma unroll
                for (int n = 0; n < 4; ++n) {
                    const size_t idx = (size_t)row * D + col0 + 16 * n + (lane & 15);
                    const float v = base[idx] + acc[m][n][i];
                    out[idx] = v; s += v * v;
                    if (xb) xb[idx] = (bf16_t)f2bf(v);
                }
                if (ssq_next) {
                    s += __shfl_xor(s, 1); s += __shfl_xor(s, 2); s += __shfl_xor(s, 4); s += __shfl_xor(s, 8);
                    if ((lane & 15) == 0) atomicAdd(ssq_next + row, s);
                }
            }
    }
};
template <class Epi>
DEVI void gemm_simple(const bf16_t* A, int lda, const bf16_t* Bt, int ldb, int M, int N, int K, const Epi& epi) {
    const int tid = threadIdx.x, lane = tid & 63, wave = tid >> 6;
    const int gw = blockIdx.x * NWAVE + wave, NGW = gridDim.x * NWAVE;
    const int nN = N / 64, ntiles = (M / 64) * nN;
    for (int tile = gw; tile < ntiles; tile += NGW) {
        const int row0 = (tile / nN) * 64, col0 = (tile % nN) * 64;
        f32x4 acc[4][4];
#pragma unroll
        for (int m = 0; m < 4; ++m)
#pragma unroll
            for (int n = 0; n < 4; ++n) acc[m][n] = (f32x4){0.f, 0.f, 0.f, 0.f};
        const bf16_t* ap = A + (size_t)(row0 + (lane & 15)) * lda + 8 * (lane >> 4);
        const bf16_t* bp = Bt + (size_t)(col0 + (lane & 15)) * ldb + 8 * (lane >> 4);
        for (int k0 = 0; k0 < K; k0 += 32) {
            bf16x8 a[4], b[4];
#pragma unroll
            for (int m = 0; m < 4; ++m) a[m] = *(const bf16x8*)(ap + (size_t)(16 * m) * lda + k0);
#pragma unroll
            for (int n = 0; n < 4; ++n) b[n] = *(const bf16x8*)(bp + (size_t)(16 * n) * ldb + k0);
#pragma unroll
            for (int m = 0; m < 4; ++m)
#pragma unroll
                for (int n = 0; n < 4; ++n) acc[m][n] = __builtin_amdgcn_mfma_f32_16x16x32_bf16(a[m], b[n], acc[m][n], 0, 0, 0);
        }
        epi(acc, row0, col0, lane);
    }
}

DEVI void head64(bf16_t* p, const float* g, bool do_norm, bool do_rope, float scale, float cosv, float sinv, int lane) {
    float v = bf2f(p[lane]);
    if (do_norm) { const float ss = wave_sum(v * v); v = v * rsqrtf(ss * (1.f / 64.f) + EPS) * g[lane]; }
    if (do_rope) { const float o = __shfl_xor(v, 8); if (lane < 8) v = v * cosv - o * sinv; else if (lane < 16) v = v * cosv + o * sinv; }
    p[lane] = (bf16_t)f2bf(v * scale);
}
DEVI void phase_post0(const Params& P) {
    const int tid = threadIdx.x, lane = tid & 63, wave = tid >> 6;
    const int gw = blockIdx.x * NWAVE + wave, NGW = gridDim.x * NWAVE;
    unsigned char* ws = P.ws;
    const float qscale = 0.125f * LOG2E;
    for (int m = gw; m < T; m += NGW) {
        bf16_t* row = (bf16_t*)(ws + WS_PROJ) + (size_t)m * LDP;
        const float* cs = (const float*)(ws + WS_CS) + (size_t)m * 16;
        const float cosv = cs[lane & 7], sinv = cs[8 + (lane & 7)];
        for (int h = 0; h < 8; ++h) head64(row + C_QA + 64 * h, P.in[15], true, true, qscale, cosv, sinv, lane);
        for (int h = 0; h < 8; ++h) head64(row + C_KA + 64 * h, P.in[16], true, true, 1.f, cosv, sinv, lane);
        for (int h = 0; h < 8; ++h) head64(row + C_QB + 64 * h, P.in[24], true, true, qscale, cosv, sinv, lane);
        for (int h = 0; h < 4; ++h) head64(row + C_QI + 64 * h, nullptr, false, true, 1.f, cosv, sinv, lane);
        head64(row + C_KI, P.in[26], true, true, 1.f, cosv, sinv, lane);
        { float s = 0.f;
#pragma unroll
          for (int j = 0; j < 4; ++j) { const float v = bf2f(row[C_CKV + 64 * j + lane]); s += v * v; }
          s = wave_sum(s); if (lane == 0) ((float*)(ws + WS_SSQCKV))[m] = s; }
        if (lane < 4) ((float*)(ws + WS_WI))[(size_t)m * 4 + lane] = bf2f(row[C_WI + lane]) * (1.f / 16.f);
    }
    for (int it = gw; it < 2 * MEMT; it += NGW) {
        const int l = it / MEMT, m = it % MEMT;
        bf16_t* row = (bf16_t*)(ws + WS_KVX) + (size_t)l * MEMT * 1024 + (size_t)m * 1024;
        const float* g = P.in[10] + l * 128;
        for (int h = 0; h < 4; ++h) {
            float v0 = bf2f(row[128 * h + lane]), v1 = bf2f(row[128 * h + 64 + lane]);
            const float ss = wave_sum(v0 * v0 + v1 * v1), rs = rsqrtf(ss * (1.f / 128.f) + EPS);
            row[128 * h + lane] = (bf16_t)f2bf(v0 * rs * g[lane]); row[128 * h + 64 + lane] = (bf16_t)f2bf(v1 * rs * g[64 + lane]);
        }
    }
}
DEVI void phase_postkb(const Params& P) {
    const int tid = threadIdx.x, lane = tid & 63, wave = tid >> 6;
    const int gw = blockIdx.x * NWAVE + wave, NGW = gridDim.x * NWAVE;
    unsigned char* ws = P.ws;
    for (int m = gw; m < T; m += NGW) {
        bf16_t* row = (bf16_t*)(ws + WS_KBVB) + (size_t)m * 1024;
        const float* cs = (const float*)(ws + WS_CS) + (size_t)m * 16;
        const float cosv = cs[lane & 7], sinv = cs[8 + (lane & 7)];
        for (int h = 0; h < 8; ++h) head64(row + 64 * h, P.in[25], true, true, 1.f, cosv, sinv, lane);
    }
}

DEVI unsigned cvtpk(float lo, float hi) { typedef __bf16 bf2 __attribute__((ext_vector_type(2))); f32x2 v = {lo, hi}; bf2 b = __builtin_convertvector(v, bf2); return __builtin_bit_cast(unsigned, b); }
DEVI int crow(int r, int hi) { return (r & 3) + 8 * (r >> 2) + 4 * hi; }
typedef short v4i16_t __attribute__((ext_vector_type(4)));
DEVI s16x4 vtr(LAS const unsigned char* p) { return __builtin_bit_cast(s16x4, __builtin_amdgcn_ds_read_tr16_b64_v4i16((LAS v4i16_t*)p)); }

template <int DQK, int DV, int MODE>
DEVI void attn_core(f32x16 (&o)[DV / 32], float& m_run, float& l_run, const bf16x8 (&qf)[DQK / 16],
                    const bf16_t* Kg, int ldk, const bf16_t* Vg, int ldv, int ntiles, int qpos, int qpos_wmin,
                    const u64* mrow, LAS unsigned char* lds, int tid) {
    constexpr int KROWB = DQK * 2, KCPR = DQK / 8, VP = (DV == 128) ? 320 : 192, VCPR = DV / 8;
    constexpr int KBUF = 64 * KROWB, VBUF = 64 * VP, KCH = 64 * KCPR / NTHR, VCH = 64 * VCPR / NTHR;
    LAS unsigned char* Kl = lds; LAS unsigned char* Vl = lds + 2 * KBUF;
    const int lane = tid & 63, r32 = lane & 31, hi = lane >> 5;
    u32x4 kreg[KCH], vreg[VCH];
#define A_GLOAD(t) do { _Pragma("unroll") for (int i_ = 0; i_ < KCH; ++i_) { const int c_ = tid + NTHR * i_, row_ = c_ / KCPR, ch_ = c_ % KCPR; kreg[i_] = *(const u32x4*)(Kg + (size_t)(64 * (t) + row_) * ldk + ch_ * 8); } \
        _Pragma("unroll") for (int i_ = 0; i_ < VCH; ++i_) { const int c_ = tid + NTHR * i_, row_ = c_ / VCPR, ch_ = c_ % VCPR; vreg[i_] = *(const u32x4*)(Vg + (size_t)(64 * (t) + row_) * ldv + ch_ * 8); } } while (0)
#define A_LSTORE(buf) do { _Pragma("unroll") for (int i_ = 0; i_ < KCH; ++i_) { const int c_ = tid + NTHR * i_, row_ = c_ / KCPR, ch_ = c_ % KCPR; *(LAS u32x4*)(Kl + (buf) * KBUF + row_ * KROWB + ((ch_ ^ (row_ & (KCPR - 1))) << 4)) = kreg[i_]; } \
        _Pragma("unroll") for (int i_ = 0; i_ < VCH; ++i_) { const int c_ = tid + NTHR * i_, row_ = c_ / VCPR, ch_ = c_ % VCPR; *(LAS u32x4*)(Vl + (buf) * VBUF + row_ * VP + ch_ * 16) = vreg[i_]; } } while (0)
    A_GLOAD(0); A_LSTORE(0); __syncthreads();
    const int vb = (4 * hi + ((lane & 15) >> 2)) * VP + (16 * ((lane >> 4) & 1) + 4 * (lane & 3)) * 2;
    for (int t = 0; t < ntiles; ++t) {
        const int buf = t & 1;
        if (t + 1 < ntiles) A_GLOAD(t + 1);
        f32x16 p0, p1;
#pragma unroll
        for (int r = 0; r < 16; ++r) { p0[r] = 0.f; p1[r] = 0.f; }
#pragma unroll
        for (int d0 = 0; d0 < DQK / 16; ++d0) {
            const int ch = 2 * d0 + hi, row0 = r32, row1 = 32 + r32;
            const bf16x8 a0 = *(LAS const bf16x8*)(Kl + buf * KBUF + row0 * KROWB + ((ch ^ (row0 & (KCPR - 1))) << 4));
            const bf16x8 a1 = *(LAS const bf16x8*)(Kl + buf * KBUF + row1 * KROWB + ((ch ^ (row1 & (KCPR - 1))) << 4));
            p0 = __builtin_amdgcn_mfma_f32_32x32x16_bf16(a0, qf[d0], p0, 0, 0, 0);
            p1 = __builtin_amdgcn_mfma_f32_32x32x16_bf16(a1, qf[d0], p1, 0, 0, 0);
        }
        if (MODE == 1) {
            if (64 * t + 63 > qpos_wmin) {
#pragma unroll
                for (int r = 0; r < 16; ++r) { const int kv = 64 * t + crow(r, hi); if (kv > qpos) p0[r] = -INFINITY; if (kv + 32 > qpos) p1[r] = -INFINITY; }
            }
        } else if (MODE == 2) {
            const u64 w = mrow[t] >> (4 * hi); const unsigned wl = (unsigned)w, wh = (unsigned)(w >> 32);
#pragma unroll
            for (int r = 0; r < 16; ++r) { const int bit = (r & 3) + 8 * (r >> 2); if (!((wl >> bit) & 1u)) p0[r] = -INFINITY; if (!((wh >> bit) & 1u)) p1[r] = -INFINITY; }
        }
        float mx = fmaxf(p0[0], p1[0]);
#pragma unroll
        for (int r = 1; r < 16; ++r) mx = fmaxf(mx, fmaxf(p0[r], p1[r]));
        mx = fmaxf(mx, __shfl_xor(mx, 32));
        const float m_new = fmaxf(m_run, mx), alpha = __builtin_amdgcn_exp2f(m_run - m_new);
        m_run = m_new;
        float rs = 0.f;
#pragma unroll
        for (int r = 0; r < 16; ++r) { p0[r] = __builtin_amdgcn_exp2f(p0[r] - m_new); p1[r] = __builtin_amdgcn_exp2f(p1[r] - m_new); rs += p0[r] + p1[r]; }
        l_run = l_run * alpha + rs;
        if (__any(alpha != 1.f)) {
#pragma unroll
            for (int d0 = 0; d0 < DV / 32; ++d0)
#pragma unroll
                for (int r = 0; r < 16; ++r) o[d0][r] *= alpha;
        }
        bf16x8 pb[4];
#pragma unroll
        for (int ks = 0; ks < 4; ++ks) {
            u32x4 w;
            if (ks < 2) { w.x = cvtpk(p0[8 * ks + 0], p0[8 * ks + 1]); w.y = cvtpk(p0[8 * ks + 2], p0[8 * ks + 3]); w.z = cvtpk(p0[8 * ks + 4], p0[8 * ks + 5]); w.w = cvtpk(p0[8 * ks + 6], p0[8 * ks + 7]); }
            else { const int k2 = ks - 2; w.x = cvtpk(p1[8 * k2 + 0], p1[8 * k2 + 1]); w.y = cvtpk(p1[8 * k2 + 2], p1[8 * k2 + 3]); w.z = cvtpk(p1[8 * k2 + 4], p1[8 * k2 + 5]); w.w = cvtpk(p1[8 * k2 + 6], p1[8 * k2 + 7]); }
            pb[ks] = __builtin_bit_cast(bf16x8, w);
        }
#pragma unroll
        for (int d0 = 0; d0 < DV / 32; ++d0)
#pragma unroll
            for (int ks = 0; ks < 4; ++ks) {
                const s16x4 lo = vtr(Vl + buf * VBUF + vb + (16 * ks) * VP + d0 * 64);
                const s16x4 hh = vtr(Vl + buf * VBUF + vb + (16 * ks + 8) * VP + d0 * 64);
                const bf16x8 a = (bf16x8){lo[0], lo[1], lo[2], lo[3], hh[0], hh[1], hh[2], hh[3]};
                o[d0] = __builtin_amdgcn_mfma_f32_32x32x16_bf16(a, pb[ks], o[d0], 0, 0, 0);
            }
        if (t + 1 < ntiles) A_LSTORE((t + 1) & 1);
        __syncthreads();
    }
#undef A_GLOAD
#undef A_LSTORE
}
template <int DV>
DEVI void store_oT(const f32x16 (&o)[DV / 32], float inv, bf16_t* dst, int hi) {
#pragma unroll
    for (int d0 = 0; d0 < DV / 32; ++d0)
#pragma unroll
        for (int g4 = 0; g4 < 4; ++g4) {
            u32x2 w; w.x = cvtpk(o[d0][4 * g4 + 0] * inv, o[d0][4 * g4 + 1] * inv); w.y = cvtpk(o[d0][4 * g4 + 2] * inv, o[d0][4 * g4 + 3] * inv);
            *(u32x2*)(dst + 32 * d0 + 8 * g4 + 4 * hi) = w;
        }
}

DEVI void attnA_unit(const Params& P, int b, int h, int c, int qb, LAS unsigned char* lds) {
    const int tid = threadIdx.x, lane = tid & 63, wave = tid >> 6, r32 = lane & 31, hi = lane >> 5;
    unsigned char* ws = P.ws;
    const bf16_t* proj = (const bf16_t*)(ws + WS_PROJ);
    const int q = qb * 256 + 32 * wave + r32; const size_t row = (size_t)b * S + q;
    bf16x8 qf[4];
#pragma unroll
    for (int d0 = 0; d0 < 4; ++d0) qf[d0] = *(const bf16x8*)(proj + row * LDP + C_QA + (2 * h + c) * 64 + 16 * d0 + 8 * hi);
    f32x16 o[4];
#pragma unroll
    for (int d0 = 0; d0 < 4; ++d0)
#pragma unroll
        for (int r = 0; r < 16; ++r) o[d0][r] = 0.f;
    float m_run = -1e30f, l_run = 0.f;
    attn_core<64, 128, 1>(o, m_run, l_run, qf, proj + (size_t)b * S * LDP + C_KA + (2 * h + c) * 64, LDP, proj + (size_t)b * S * LDP + C_VA + h * 128, LDP,
                          4 * (qb + 1), q, qb * 256 + 32 * wave, nullptr, lds, tid);
    const float lt = l_run + __shfl_xor(l_run, 32);
    bf16_t* oa = (bf16_t*)(ws + WS_XB) + (size_t)c * T * 512 + row * 512 + h * 128;
    store_oT<128>(o, 1.f / lt, oa, hi);
}
DEVI void attnB_unit(const Params& P, int b, int hd, int qb, LAS unsigned char* lds) {
    const int tid = threadIdx.x, lane = tid & 63, wave = tid >> 6, r32 = lane & 31, hi = lane >> 5;
    unsigned char* ws = P.ws;
    const bf16_t* proj = (const bf16_t*)(ws + WS_PROJ); const bf16_t* kbvb = (const bf16_t*)(ws + WS_KBVB);
    const int q = qb * 256 + 32 * wave + r32; const size_t row = (size_t)b * S + q;
    bf16x8 qf[4];
#pragma unroll
    for (int d0 = 0; d0 < 4; ++d0) qf[d0] = *(const bf16x8*)(proj + row * LDP + C_QB + hd * 64 + 16 * d0 + 8 * hi);
    f32x16 o[2];
#pragma unroll
    for (int d0 = 0; d0 < 2; ++d0)
#pragma unroll
        for (int r = 0; r < 16; ++r) o[d0][r] = 0.f;
    float m_run = -1e30f, l_run = 0.f;
    attn_core<64, 64, 2>(o, m_run, l_run, qf, kbvb + (size_t)b * S * 1024 + hd * 64, 1024, kbvb + (size_t)b * S * 1024 + 512 + hd * 64, 1024,
                         4 * (qb + 1), q, qb * 256 + 32 * wave, (const u64*)(ws + WS_MASK) + row * 64, lds, tid);
    const float lt = l_run + __shfl_xor(l_run, 32);
    store_oT<64>(o, 1.f / lt, (bf16_t*)(ws + WS_Y) + row * 1024 + 512 + hd * 64, hi);
}
DEVI void xattn_unit(const Params& P, int l, int b, int hd, int qb, LAS unsigned char* lds) {
    const int tid = threadIdx.x, lane = tid & 63, wave = tid >> 6, r32 = lane & 31, hi = lane >> 5;
    unsigned char* ws = P.ws;
    const bf16_t* qx = (const bf16_t*)(ws + WS_QX); const bf16_t* kvx = (const bf16_t*)(ws + WS_KVX) + (size_t)l * MEMT * 1024;
    const int q = qb * 256 + 32 * wave + r32; const size_t row = (size_t)b * S + q;
    const float* gq = P.in[9] + l * 128;
    u32x4 raw[8]; float ss = 0.f;
#pragma unroll
    for (int d0 = 0; d0 < 8; ++d0) { raw[d0] = *(const u32x4*)(qx + row * 512 + hd * 128 + 16 * d0 + 8 * hi);
#pragma unroll
        for (int j = 0; j < 4; ++j) { const float a = lo16(raw[d0][j]), bq = hi16(raw[d0][j]); ss += a * a + bq * bq; } }
    ss += __shfl_xor(ss, 32);
    const float rs = rsqrtf(ss * (1.f / 128.f) + EPS) * (0.08838834764831845f * LOG2E);
    bf16x8 qf[8];
#pragma unroll
    for (int d0 = 0; d0 < 8; ++d0) { u32x4 w;
#pragma unroll
        for (int j = 0; j < 4; ++j) { const int dim = 16 * d0 + 8 * hi + 2 * j; w[j] = cvtpk(lo16(raw[d0][j]) * rs * gq[dim], hi16(raw[d0][j]) * rs * gq[dim + 1]); }
        qf[d0] = __builtin_bit_cast(bf16x8, w); }
    f32x16 o[4];
#pragma unroll
    for (int d0 = 0; d0 < 4; ++d0)
#pragma unroll
        for (int r = 0; r < 16; ++r) o[d0][r] = 0.f;
    float m_run = -1e30f, l_run = 0.f;
    attn_core<128, 128, 0>(o, m_run, l_run, qf, kvx + (size_t)b * MEML * 1024 + hd * 128, 1024, kvx + (size_t)b * MEML * 1024 + 512 + hd * 128, 1024,
                           MEML / 64, q, 0, nullptr, lds, tid);
    const float lt = l_run + __shfl_xor(l_run, 32);
    store_oT<128>(o, 1.f / lt, (bf16_t*)(ws + WS_YX) + row * 512 + hd * 128, hi);
}

DEVI void indexer_unit(const Params& P, int b, int t0, LAS unsigned char* lds) {
    const int tid = threadIdx.x, lane = tid & 63, wave = tid >> 6, r32 = lane & 31, hi = lane >> 5;
    unsigned char* ws = P.ws;
    const bf16_t* proj = (const bf16_t*)(ws + WS_PROJ); const float* WI = (const float*)(ws + WS_WI);
    LAS float* Ssc = (LAS float*)lds;
    if (t0 + 7 >= 255) {
        bf16x8 af[4];
        { const int qq = r32 >> 2, hh = r32 & 3; const size_t row = (size_t)b * S + t0 + qq;
#pragma unroll
          for (int d0 = 0; d0 < 4; ++d0) af[d0] = *(const bf16x8*)(proj + row * LDP + C_QI + hh * 64 + 16 * d0 + 8 * hi); }
        float wv[16];
#pragma unroll
        for (int r = 0; r < 16; ++r) wv[r] = WI[((size_t)b * S + t0 + 2 * (r >> 2) + hi) * 4 + (r & 3)];
        const int nkt = (t0 + 8 + 31) / 32;
        for (int kt = wave; kt < nkt; kt += NWAVE) {
            const int key = kt * 32 + r32; const size_t krow = (size_t)b * S + key;
            f32x16 c;
#pragma unroll
            for (int r = 0; r < 16; ++r) c[r] = 0.f;
#pragma unroll
            for (int d0 = 0; d0 < 4; ++d0) { const bf16x8 bk = *(const bf16x8*)(proj + krow * LDP + C_KI + 16 * d0 + 8 * hi); c = __builtin_amdgcn_mfma_f32_32x32x16_bf16(af[d0], bk, c, 0, 0, 0); }
#pragma unroll
            for (int g4 = 0; g4 < 4; ++g4) {
                float s = 0.f;
#pragma unroll
                for (int hh = 0; hh < 4; ++hh) s += fmaxf(c[4 * g4 + hh], 0.f) * wv[4 * g4 + hh];
                Ssc[(2 * g4 + hi) * 4096 + key] = s;
            }
        }
    }
    __syncthreads();
    {
        const int t = t0 + wave; u64 myw = 0ull;
        if (t >= 255) {
            unsigned u[64];
#pragma unroll
            for (int j = 0; j < 64; ++j) {
                const int s = 64 * j + lane; unsigned key = 0u;
                if (64 * j <= t) { const unsigned bits = __float_as_uint(Ssc[wave * 4096 + s]);
                    key = (bits == 0x80000000u) ? 0x80000000u : ((bits & 0x80000000u) ? ~bits : (bits | 0x80000000u));
                    if (s > t) key = 0u; }
                u[j] = key;
            }
            unsigned prefix = 0u;
            for (int bit = 31; bit >= 0; --bit) {
                const unsigned cand = prefix | (1u << bit); int cnt = 0;
#pragma unroll
                for (int j = 0; j < 64; ++j) cnt += (u[j] >= cand) ? 1 : 0;
                cnt = (int)wave_sum((float)cnt);
                if (cnt >= 256) prefix = cand;
            }
            int cgt = 0;
#pragma unroll
            for (int j = 0; j < 64; ++j) cgt += (u[j] > prefix) ? 1 : 0;
            cgt = (int)wave_sum((float)cgt);
            const int need = 256 - cgt; int running = 0;
#pragma unroll
            for (int j = 0; j < 64; ++j) {
                const bool tie = (u[j] == prefix);
                const u64 bt = __ballot(tie);
                const int rank = __builtin_amdgcn_mbcnt_hi((unsigned)(bt >> 32), __builtin_amdgcn_mbcnt_lo((unsigned)bt, 0u));
                const bool sel = (u[j] > prefix) || (tie && (running + rank < need));
                const u64 wj = __ballot(sel);
                running += __builtin_popcountll(bt);
                if (lane == j) myw = wj;
            }
        } else {
            const int lo = 64 * lane;
            if (lo + 63 <= t) myw = ~0ull; else if (lo > t) myw = 0ull; else myw = (~0ull) >> (63 - (t - lo));
        }
        ((u64*)(ws + WS_MASK))[((size_t)b * S + t) * 64 + lane] = myw;
    }
    __syncthreads();
}

DEVI void combineA_rows(const Params& P) {
    const int tid = threadIdx.x, lane = tid & 63, wave = tid >> 6;
    const int gw = blockIdx.x * NWAVE + wave, NGW = gridDim.x * NWAVE;
    unsigned char* ws = P.ws;
    const float d1 = wave_sum(P.in[17][lane] * P.in[18][lane]), d2 = wave_sum(P.in[19][lane] * P.in[20][lane]);
    const float lam_init = 0.2f, lam = expf(d1) - expf(d2) + lam_init;
    const bf16_t* o0 = (const bf16_t*)(ws + WS_XB); const bf16_t* o1 = o0 + (size_t)T * 512;
    const float* gs = P.in[21] + 8 * (lane & 15);
    for (int m = gw; m < T; m += NGW) {
        const u32x4 a = *(const u32x4*)(o0 + (size_t)m * 512 + 8 * lane), bq = *(const u32x4*)(o1 + (size_t)m * 512 + 8 * lane);
        float v[8]; float ss = 0.f;
#pragma unroll
        for (int j = 0; j < 4; ++j) { v[2 * j] = lo16(a[j]) - lam * lo16(bq[j]); v[2 * j + 1] = hi16(a[j]) - lam * hi16(bq[j]); ss += v[2 * j] * v[2 * j] + v[2 * j + 1] * v[2 * j + 1]; }
        ss += __shfl_xor(ss, 1); ss += __shfl_xor(ss, 2); ss += __shfl_xor(ss, 4); ss += __shfl_xor(ss, 8);
        const float rs = rsqrtf(ss * (1.f / 128.f) + EPS) * (1.f - lam_init);
        u32x4 w;
#pragma unroll
        for (int j = 0; j < 4; ++j) w[j] = cvtpk(v[2 * j] * rs * gs[2 * j], v[2 * j + 1] * rs * gs[2 * j + 1]);
        *(u32x4*)((bf16_t*)(ws + WS_Y) + (size_t)m * 1024 + 8 * lane) = w;
    }
}

DEVI void phase_mix1(const Params& P) {
    const int gt = blockIdx.x * NTHR + threadIdx.x, NGT = gridDim.x * NTHR;
    unsigned char* ws = P.ws;
    const bf16_t* pr = (const bf16_t*)(ws + WS_PROJ1);
    const float* cw = P.in[29];
    for (int it = gt; it < T * 128; it += NGT) {
        const int m = it >> 7, ci = it & 127, t = m & (S - 1);
        if (ci < 64) {
            const int c0 = 8 * ci; float conv[8];
#pragma unroll
            for (int j = 0; j < 8; ++j) conv[j] = 0.f;
#pragma unroll
            for (int dt = 0; dt < 3; ++dt) {
                if (t - dt >= 0) {
                    const u32x4 gc = *(const u32x4*)(pr + (size_t)(m - dt) * 2048 + 512 + c0), hc = *(const u32x4*)(pr + (size_t)(m - dt) * 2048 + 1024 + c0);
#pragma unroll
                    for (int j = 0; j < 4; ++j) { conv[2 * j] += cw[(2 - dt) * 512 + c0 + 2 * j] * (lo16(gc[j]) * lo16(hc[j])); conv[2 * j + 1] += cw[(2 - dt) * 512 + c0 + 2 * j + 1] * (hi16(gc[j]) * hi16(hc[j])); }
                }
            }
            const u32x4 gb = *(const u32x4*)(pr + (size_t)m * 2048 + c0); u32x4 w;
#pragma unroll
            for (int j = 0; j < 4; ++j) w[j] = cvtpk(lo16(gb[j]) * conv[2 * j], hi16(gb[j]) * conv[2 * j + 1]);
            *(u32x4*)((bf16_t*)(ws + WS_Y) + (size_t)m * 1024 + c0) = w;
        } else {
            const int c0 = 8 * (ci - 64), g = c0 >> 7, wdw = 2 << g; float sum[8];
#pragma unroll
            for (int j = 0; j < 8; ++j) sum[j] = 0.f;
            const int n = (t + 1 < wdw) ? (t + 1) : wdw;
            u32x4 z0 = (u32x4){0u, 0u, 0u, 0u};
            for (int dt = 0; dt < n; ++dt) {
                const u32x4 z = *(const u32x4*)(pr + (size_t)(m - dt) * 2048 + 1536 + c0); if (dt == 0) z0 = z;
#pragma unroll
                for (int j = 0; j < 4; ++j) { sum[2 * j] += lo16(z[j]); sum[2 * j + 1] += hi16(z[j]); }
            }
            const float inv = 1.f / (float)n; u32x4 w;
#pragma unroll
            for (int j = 0; j < 4; ++j) w[j] = cvtpk(sum[2 * j] * inv - lo16(z0[j]), sum[2 * j + 1] * inv - hi16(z0[j]));
            *(u32x4*)((bf16_t*)(ws + WS_POOLED) + (size_t)m * 512 + c0) = w;
        }
    }
}

constexpr int NPHASE = 22;
__global__ void __launch_bounds__(NTHR, 2) mega(Params P, int ph_lo, int ph_hi) {
    extern __shared__ __attribute__((aligned(16))) unsigned char lds_raw[];
    LAS unsigned char* lds = (LAS unsigned char*)lds_raw;
    cg::grid_group grid = cg::this_grid();
    unsigned char* ws = P.ws;
    const int G = gridDim.x, bx = blockIdx.x;
    float* ssq = (float*)(ws + WS_SSQ);
    bf16_t* XB = (bf16_t*)(ws + WS_XB);
    bf16_t* Y = (bf16_t*)(ws + WS_Y);
#define PH_BEGIN(k) if (ph_lo <= (k) && (k) < ph_hi) {
#define PH_END(k) if ((k) + 1 < ph_hi) grid.sync(); }
    PH_BEGIN(0) phase_prologue(P, lds); PH_END(0)
    PH_BEGIN(1)
        gemm_simple((const bf16_t*)(ws + WS_XB), 1024, (const bf16_t*)(ws + W_INE), 1024, T, LDP, 1024, EpiStore{(bf16_t*)(ws + WS_PROJ), LDP, ssq, 1.f / 1024.f, 0});
        for (int l = 0; l < 2; ++l)
            gemm_simple((const bf16_t*)(ws + WS_MB), 1024, (const bf16_t*)(ws + W_KVX) + (size_t)l * 1024 * 1024, 1024, MEMT, 1024, 1024,
                        EpiStore{(bf16_t*)(ws + WS_KVX) + (size_t)l * MEMT * 1024, 1024, (const float*)(ws + WS_SSQMEM), 1.f / 1024.f, 0});
    PH_END(1)
    PH_BEGIN(2) phase_post0(P); PH_END(2)
    PH_BEGIN(3) gemm_simple((const bf16_t*)(ws + WS_PROJ) + C_CKV, LDP, (const bf16_t*)(ws + W_KVUP), 256, T, 1024, 256, EpiStore{(bf16_t*)(ws + WS_KBVB), 1024, (const float*)(ws + WS_SSQCKV), 1.f / 256.f, 0}); PH_END(3)
    PH_BEGIN(4) phase_postkb(P); PH_END(4)
    PH_BEGIN(5)
        for (int u = bx; u < 256; u += G) { const int bhc = u >> 3, s = u & 7, b = bhc >> 3, h = (bhc >> 1) & 3, c = bhc & 1;
            attnA_unit(P, b, h, c, s, lds); attnA_unit(P, b, h, c, 15 - s, lds); }
        for (int u = bx; u < 2048; u += G) { const int k = u / 256, c = u % 256, b = k >> 1; const int blk = (k & 1) ? (511 - c) : c;
            indexer_unit(P, b, blk * 8, lds); }
    PH_END(5)
    PH_BEGIN(6)
        for (int u = bx; u < 256; u += G) { const int bh = u >> 3, s = u & 7, b = bh >> 3, hd = bh & 7;
            attnB_unit(P, b, hd, s, lds); attnB_unit(P, b, hd, 15 - s, lds); }
        combineA_rows(P);
    PH_END(6)
    PH_BEGIN(7) gemm_simple(Y, 1024, (const bf16_t*)(ws + W_OUTE), 1024, T, 1024, 1024, EpiRes{P.in[0], P.out, XB, ssq + 1 * T}); PH_END(7)
#define XATTN_MLP(l, p0)                                                                                                                                                      \
    PH_BEGIN(p0) gemm_simple(XB, 1024, (const bf16_t*)(ws + W_QX) + (size_t)(l) * 512 * 1024, 1024, T, 512, 1024, EpiStore{(bf16_t*)(ws + WS_QX), 512, ssq + ((l) ? 4 : 1) * T, 1.f / 1024.f, 0}); PH_END(p0) \
    PH_BEGIN(p0 + 1) for (int u = bx; u < 256; u += G) { const int b = u >> 6, hd = (u >> 4) & 3, qb = u & 15; xattn_unit(P, (l), b, hd, qb, lds); } PH_END(p0 + 1)                                 \
    PH_BEGIN(p0 + 2) gemm_simple((const bf16_t*)(ws + WS_YX), 512, (const bf16_t*)(ws + W_OX) + (size_t)(l) * 1024 * 512, 512, T, 1024, 512, EpiRes{P.out, P.out, XB, ssq + ((l) ? 5 : 2) * T}); PH_END(p0 + 2) \
    PH_BEGIN(p0 + 3) gemm_simple(XB, 1024, (const bf16_t*)(ws + W_UP) + (size_t)(l) * 4096 * 1024, 1024, T, DFF, 1024, EpiStore{(bf16_t*)(ws + WS_H), DFF, ssq + ((l) ? 5 : 2) * T, 1.f / 1024.f, 1}); PH_END(p0 + 3)
    XATTN_MLP(0, 8)
    PH_BEGIN(12) gemm_simple((const bf16_t*)(ws + WS_H), DFF, (const bf16_t*)(ws + W_DOWN), DFF, T, 1024, DFF, EpiRes{P.out, P.out, XB, ssq + 3 * T}); PH_END(12)
    PH_BEGIN(13) gemm_simple(XB, 1024, (const bf16_t*)(ws + W_INO), 1024, T, 2048, 1024, EpiStore{(bf16_t*)(ws + WS_PROJ1), 2048, ssq + 3 * T, 1.f / 1024.f, 0}); PH_END(13)
    PH_BEGIN(14) phase_mix1(P); PH_END(14)
    PH_BEGIN(15) gemm_simple((const bf16_t*)(ws + WS_POOLED), 512, (const bf16_t*)(ws + W_POOL), 512, T, 512, 512, EpiStore{Y + 512, 1024, nullptr, 0.f, 0}); PH_END(15)
    PH_BEGIN(16) gemm_simple(Y, 1024, (const bf16_t*)(ws + W_OUTO), 1024, T, 1024, 1024, EpiRes{P.out, P.out, XB, ssq + 4 * T}); PH_END(16)
    XATTN_MLP(1, 17)
    PH_BEGIN(21) gemm_simple((const bf16_t*)(ws + WS_H), DFF, (const bf16_t*)(ws + W_DOWN) + (size_t)1024 * 4096, DFF, T, 1024, DFF, EpiRes{P.out, P.out, nullptr, nullptr}); PH_END(21)
}

#ifndef MK_MULTI
#define MK_MULTI 0
#endif
extern "C" void kernel_launch(void* const* d_in, const int* in_sizes, int n_in, void* d_out, int out_size, void* d_ws, size_t ws_size, hipStream_t stream) {
    static int grid = 0;
    if (grid == 0) {
        if (n_in != 33 || out_size != T * D || ws_size < WS_END) { fprintf(stderr, "kernel_launch: unexpected shapes (n_in %d out %d ws %zu)\n", n_in, out_size, ws_size); grid = -1; return; }
        int dev = 0, cus = 0, per_cu = 0;
        hipGetDevice(&dev); hipDeviceGetAttribute(&cus, hipDeviceAttributeMultiprocessorCount, dev);
        hipFuncSetAttribute((const void*)mega, hipFuncAttributeMaxDynamicSharedMemorySize, LDS_BYTES);
        hipOccupancyMaxActiveBlocksPerMultiprocessor(&per_cu, (const void*)mega, NTHR, LDS_BYTES);
        if (per_cu < 1) { fprintf(stderr, "kernel_launch: occupancy query says %d blocks/CU\n", per_cu); per_cu = 1; }
        (void)hipGetLastError();
        grid = cus * 1;
    }
    if (grid < 0) return;
    Params p{};
    for (int i = 0; i < 33; ++i) p.in[i] = (const float*)d_in[i];
    p.out = (float*)d_out; p.ws = (unsigned char*)d_ws;
#if MK_MULTI
    for (int ph = 0; ph < NPHASE; ++ph) hipLaunchKernelGGL(mega, dim3(grid), dim3(NTHR), LDS_BYTES, stream, p, ph, ph + 1);
#else
    int lo = 0, hi = NPHASE;
    void* args[] = {&p, &lo, &hi};
    hipError_t e = hipLaunchCooperativeKernel((const void*)mega, dim3(grid), dim3(NTHR), args, LDS_BYTES, stream);
    if (e != hipSuccess) fprintf(stderr, "cooperative launch failed: %s (grid %d)\n", hipGetErrorString(e), grid);
#endif
}
```

```cpp
#include <hip/hip_runtime.h>
#include <hip/hip_cooperative_groups.h>
#include <cstdio>
#include <cstdint>
namespace cg = cooperative_groups;

#define DEVI __device__ __forceinline__
#define LAS __attribute__((address_space(3)))
typedef unsigned short bf16_t;
typedef short bf16x8 __attribute__((ext_vector_type(8)));
typedef short s16x4 __attribute__((ext_vector_type(4)));
typedef float f32x2 __attribute__((ext_vector_type(2)));
typedef float f32x4 __attribute__((ext_vector_type(4)));
typedef float f32x16 __attribute__((ext_vector_type(16)));
typedef unsigned u32x2 __attribute__((ext_vector_type(2)));
typedef unsigned u32x4 __attribute__((ext_vector_type(4)));
typedef unsigned long long u64;

constexpr int NB = 4, S = 4096, T = NB * S, D = 1024, DFF = 4096, MEML = 256, MEMT = NB * MEML;
constexpr int LDP = 2816;
constexpr int C_QA = 0, C_KA = 512, C_VA = 1024, C_QB = 1536, C_CKV = 2048, C_QI = 2304, C_KI = 2560, C_WI = 2624, EVEN_IN = 2628;
constexpr float EPS = 1e-6f;
constexpr float LOG2E = 1.4426950408889634f;
constexpr int NTHR = 512, NWAVE = 8;
constexpr int LDS_BYTES = 147456;

constexpr size_t MiB = 1u << 20;
constexpr size_t WS_SSQ = 0;
constexpr size_t WS_SSQCKV = WS_SSQ + 6ull * T * 4;
constexpr size_t WS_SSQMEM = WS_SSQCKV + (size_t)T * 4;
constexpr size_t WS_WI = 512 * 1024;
constexpr size_t WS_W = 2 * MiB;
constexpr size_t W_INE = WS_W;
constexpr size_t W_KVUP = W_INE + (size_t)LDP * 1024 * 2;
constexpr size_t W_OUTE = W_KVUP + 1024ull * 256 * 2;
constexpr size_t W_QX = W_OUTE + 1024ull * 1024 * 2;
constexpr size_t W_KVX = W_QX + 2 * 512ull * 1024 * 2;
constexpr size_t W_OX = W_KVX + 2 * 1024ull * 1024 * 2;
constexpr size_t W_UP = W_OX + 2 * 1024ull * 512 * 2;
constexpr size_t W_DOWN = W_UP + 2 * 4096ull * 1024 * 2;
constexpr size_t W_INO = W_DOWN + 2 * 4096ull * 1024 * 2;
constexpr size_t W_POOL = W_INO + 2048ull * 1024 * 2;
constexpr size_t W_OUTO = W_POOL + 512ull * 512 * 2;
constexpr size_t W_END = W_OUTO + 1024ull * 1024 * 2;
static_assert(W_END <= 57 * MiB, "weights region");
constexpr size_t WS_XB = 57 * MiB;
constexpr size_t WS_PROJ = 89 * MiB;
constexpr size_t WS_KBVB = 177 * MiB;
constexpr size_t WS_MASK = 209 * MiB;
constexpr size_t WS_Y = 217 * MiB;
constexpr size_t WS_CS = 249 * MiB;
constexpr size_t WS_MB = 250 * MiB;
constexpr size_t WS_KVX = 252 * MiB;
constexpr size_t WS_END = 256 * MiB;
constexpr size_t WS_QX = WS_PROJ;
constexpr size_t WS_YX = WS_PROJ + 16 * MiB;
constexpr size_t WS_H = WS_PROJ;
constexpr size_t WS_PROJ1 = WS_PROJ;
constexpr size_t WS_POOLED = WS_PROJ + 64 * MiB;

struct Params { const float* in[33]; float* out; unsigned char* ws; };

DEVI float bf2f(bf16_t v) { return __uint_as_float(((unsigned)v) << 16); }
DEVI unsigned f2bf(float f) { unsigned u = __float_as_uint(f); return (u + 0x7fffu + ((u >> 16) & 1u)) >> 16; }
DEVI unsigned pk2(float lo, float hi) { return f2bf(lo) | (f2bf(hi) << 16); }
DEVI float wave_sum(float v) {
#pragma unroll
    for (int o = 1; o < 64; o <<= 1) v += __shfl_xor(v, o);
    return v;
}
DEVI float lo16(unsigned w) { return __uint_as_float(w << 16); }
DEVI float hi16(unsigned w) { return __uint_as_float(w & 0xffff0000u); }
#define LDS_WAIT() asm volatile("s_waitcnt lgkmcnt(0)" ::: "memory")

struct TrD { const float* src; bf16_t* dst; const float* sk; const float* sn; int K, N, ldd; };
constexpr int NTR = 19;
DEVI TrD get_tr(const Params& P, int i) {
    unsigned char* ws = P.ws; TrD d; d.sk = nullptr; d.sn = nullptr;
    switch (i) {
    case 0: d.src = P.in[14]; d.dst = (bf16_t*)(ws + W_INE); d.K = 1024; d.N = EVEN_IN; d.ldd = 1024; d.sk = P.in[3]; break;
    case 1: d.src = P.in[23]; d.dst = (bf16_t*)(ws + W_KVUP); d.K = 256; d.N = 1024; d.ldd = 256; d.sk = P.in[22]; break;
    case 2: d.src = P.in[27]; d.dst = (bf16_t*)(ws + W_OUTE); d.K = 1024; d.N = 1024; d.ldd = 1024; break;
    case 3: case 4: { int l = i - 3; d.src = P.in[7] + (size_t)l * 1024 * 512; d.dst = (bf16_t*)(ws + W_QX) + (size_t)l * 512 * 1024; d.K = 1024; d.N = 512; d.ldd = 1024; d.sk = P.in[4] + l * 1024; } break;
    case 5: case 6: { int l = i - 5; d.src = P.in[8] + (size_t)l * 1024 * 1024; d.dst = (bf16_t*)(ws + W_KVX) + (size_t)l * 1024 * 1024; d.K = 1024; d.N = 1024; d.ldd = 1024; d.sk = P.in[5] + l * 1024; } break;
    case 7: case 8: { int l = i - 7; d.src = P.in[11] + (size_t)l * 512 * 1024; d.dst = (bf16_t*)(ws + W_OX) + (size_t)l * 1024 * 512; d.K = 512; d.N = 1024; d.ldd = 512; } break;
    case 9: case 10: { int l = i - 9; d.src = P.in[12] + (size_t)l * 1024 * 4096; d.dst = (bf16_t*)(ws + W_UP) + (size_t)l * 4096 * 1024; d.K = 1024; d.N = 4096; d.ldd = 1024; d.sk = P.in[6] + l * 1024; } break;
    case 11: case 12: { int l = i - 11; d.src = P.in[13] + (size_t)l * 4096 * 1024; d.dst = (bf16_t*)(ws + W_DOWN) + (size_t)l * 1024 * 4096; d.K = 4096; d.N = 1024; d.ldd = 4096; } break;
    case 13: d.src = P.in[28]; d.dst = (bf16_t*)(ws + W_INO); d.K = 1024; d.N = 2048; d.ldd = 1024; d.sk = P.in[3] + 1024; break;
    case 14: case 15: case 16: case 17: { int g = i - 14; d.src = P.in[30] + (size_t)g * 128 * 128; d.dst = (bf16_t*)(ws + W_POOL) + (size_t)(g * 128) * 512 + g * 128; d.K = 128; d.N = 128; d.ldd = 512; d.sn = P.in[31] + g * 128; } break;
    default: d.src = P.in[32]; d.dst = (bf16_t*)(ws + W_OUTO); d.K = 1024; d.N = 1024; d.ldd = 1024; break;
    }
    return d;
}
DEVI int tr_items(const TrD& d) { return (d.K / 64) * ((d.N + 31) / 32); }
DEVI void tr_item(const TrD& d, LAS float* scr, int item, int lane) {
    const int nblk = (d.N + 31) / 32, kb = item / nblk, nb = item % nblk, k0 = 64 * kb, n0 = 32 * nb;
#pragma unroll 8
    for (int i = 0; i < 32; ++i) {
        const int kk = 2 * i + (lane >> 5), n = n0 + (lane & 31);
        float v = (n < d.N) ? d.src[(size_t)(k0 + kk) * d.N + n] : 0.f;
        if (d.sk) v *= d.sk[k0 + kk];
        scr[kk * 33 + (lane & 31)] = v;
    }
    LDS_WAIT(); asm volatile("" ::: "memory");
    const int c = lane & 7;
#pragma unroll
    for (int j = 0; j < 4; ++j) {
        const int n = (lane >> 3) + 8 * j;
        if (n0 + n < d.N) {
            const LAS float* s = scr + (8 * c) * 33 + n;
            const float sc = d.sn ? d.sn[n0 + n] : 1.f;
            u32x4 o; o.x = pk2(s[0 * 33] * sc, s[1 * 33] * sc); o.y = pk2(s[2 * 33] * sc, s[3 * 33] * sc); o.z = pk2(s[4 * 33] * sc, s[5 * 33] * sc); o.w = pk2(s[6 * 33] * sc, s[7 * 33] * sc);
            *(u32x4*)(d.dst + (size_t)(n0 + n) * d.ldd + k0 + 8 * c) = o;
        }
    }
    LDS_WAIT(); asm volatile("" ::: "memory");
}
DEVI void row_to_bf16_ssq(const float* xrow, bf16_t* orow, float* ssq_out, int lane) {
    const f32x4* xr = (const f32x4*)xrow + lane;
    f32x4 v[4]; float s = 0.f;
#pragma unroll
    for (int j = 0; j < 4; ++j) { v[j] = xr[64 * j]; s += (v[j].x * v[j].x + v[j].y * v[j].y) + (v[j].z * v[j].z + v[j].w * v[j].w); }
    s = wave_sum(s);
    if (lane == 0) *ssq_out = s;
    u32x2* o8 = (u32x2*)orow + lane;
#pragma unroll
    for (int j = 0; j < 4; ++j) { u32x2 w; w.x = pk2(v[j].x, v[j].y); w.y = pk2(v[j].z, v[j].w); o8[64 * j] = w; }
}
DEVI void phase_prologue(const Params& P, LAS unsigned char* lds) {
    const int tid = threadIdx.x, lane = tid & 63, wave = tid >> 6;
    const int gw = blockIdx.x * NWAVE + wave, NGW = gridDim.x * NWAVE;
    const int gt = blockIdx.x * NTHR + tid, NGT = gridDim.x * NTHR;
    unsigned char* ws = P.ws;
    LAS float* scr = (LAS float*)(lds + wave * 16384);
    int base = 0;
    for (int i = 0; i < NTR; ++i) {
        const TrD d = get_tr(P, i); const int n = tr_items(d);
        int first = gw - (base % NGW); if (first < 0) first += NGW;
        for (int it = first; it < n; it += NGW) tr_item(d, scr, it, lane);
        base += n;
    }
    { bf16_t* w = (bf16_t*)(ws + W_INE) + (size_t)EVEN_IN * 1024; const int n = (LDP - EVEN_IN) * 1024 / 8;
      for (int i = gt; i < n; i += NGT) ((u32x4*)w)[i] = (u32x4){0u, 0u, 0u, 0u}; }
    { bf16_t* w = (bf16_t*)(ws + W_POOL); for (int i = gt; i < 512 * 512 / 8; i += NGT) { const int n = i / 64, k = (i % 64) * 8; if ((n >> 7) != (k >> 7)) ((u32x4*)w)[i] = (u32x4){0u, 0u, 0u, 0u}; } }
    { float* q = (float*)(ws + WS_SSQ) + T; for (int i = gt; i < 5 * T; i += NGT) q[i] = 0.f; }
    for (int m = gw; m < T; m += NGW) row_to_bf16_ssq(P.in[0] + (size_t)m * D, (bf16_t*)(ws + WS_XB) + (size_t)m * D, (float*)(ws + WS_SSQ) + m, lane);
    for (int m = gw; m < MEMT; m += NGW) row_to_bf16_ssq(P.in[1] + (size_t)m * D, (bf16_t*)(ws + WS_MB) + (size_t)m * D, (float*)(ws + WS_SSQMEM) + m, lane);
    { const int* pos = (const int*)P.in[2]; float* cs = (float*)(ws + WS_CS);
      for (int i = gt; i < T * 8; i += NGT) { const int m = i >> 3, f = i & 7;
        const double inv = exp(-log(500000.0) * (double)f / 8.0), ang = (double)pos[m] * inv;
        cs[m * 16 + f] = (float)cos(ang); cs[m * 16 + 8 + f] = (float)sin(ang); } }
}

struct EpiStore {
    bf16_t* O; int ldo; const float* ssq; float inv_n; int act;
    DEVI void operator()(const f32x4 (&acc)[4][4], int row0, int col0, int lane) const {
#pragma unroll
        for (int m = 0; m < 4; ++m)
#pragma unroll
            for (int i = 0; i < 4; ++i) {
                const int row = row0 + 16 * m + (lane >> 4) * 4 + i;
                const float rs = ssq ? rsqrtf(ssq[row] * inv_n + EPS) : 1.f;
#pragma unroll
                for (int n = 0; n < 4; ++n) {
                    float v = acc[m][n][i] * rs;
                    if (act == 1) { v = fmaxf(v, 0.f); v = v * v; }
                    O[(size_t)row * ldo + col0 + 16 * n + (lane & 15)] = (bf16_t)f2bf(v);
                }
            }
    }
};
struct EpiRes {
    const float* base; float* out; bf16_t* xb; float* ssq_next;
    DEVI void operator()(const f32x4 (&acc)[4][4], int row0, int col0, int lane) const {
#pragma unroll
        for (int m = 0; m < 4; ++m)
#pragma unroll
            for (int i = 0; i < 4; ++i) {
                const int row = row0 + 16 * m + (lane >> 4) * 4 + i; float s = 0.f;
#pragma unroll
                for (int n = 0; n < 4; ++n) {
                    const size_t idx = (size_t)row * D + col0 + 16 * n + (lane & 15);
                    const float v = base[idx] + acc[m][n][i];
                    out[idx] = v; s += v * v;
                    if (xb) xb[idx] = (bf16_t)f2bf(v);
                }
                if (ssq_next) {
                    s += __shfl_xor(s, 1); s += __shfl_xor(s, 2); s += __shfl_xor(s, 4); s += __shfl_xor(s, 8);
                    if ((lane & 15) == 0) atomicAdd(ssq_next + row, s);
                }
            }
    }
};
template <class Epi>
DEVI void gemm_simple(const bf16_t* A, int lda, const bf16_t* Bt, int ldb, int M, int N, int K, const Epi& epi) {
    const int tid = threadIdx.x, lane = tid & 63, wave = tid >> 6;
    const int gw = blockIdx.x * NWAVE + wave, NGW = gridDim.x * NWAVE;
    const int nN = N / 64, ntiles = (M / 64) * nN;
    for (int tile = gw; tile < ntiles; tile += NGW) {
        const int row0 = (tile / nN) * 64, col0 = (tile % nN) * 64;
        f32x4 acc[4][4];
#pragma unroll
        for (int m = 0; m < 4; ++m)
#pragma unroll
            for (int n = 0; n < 4; ++n) acc[m][n] = (f32x4){0.f, 0.f, 0.f, 0.f};
        const bf16_t* ap = A + (size_t)(row0 + (lane & 15)) * lda + 8 * (lane >> 4);
        const bf16_t* bp = Bt + (size_t)(col0 + (lane & 15)) * ldb + 8 * (lane >> 4);
        for (int k0 = 0; k0 < K; k0 += 32) {
            bf16x8 a[4], b[4];
#pragma unroll
            for (int m = 0; m < 4; ++m) a[m] = *(const bf16x8*)(ap + (size_t)(16 * m) * lda + k0);
#pragma unroll
            for (int n = 0; n < 4; ++n) b[n] = *(const bf16x8*)(bp + (size_t)(16 * n) * ldb + k0);
#pragma unroll
            for (int m = 0; m < 4; ++m)
#pragma unroll
                for (int n = 0; n < 4; ++n) acc[m][n] = __builtin_amdgcn_mfma_f32_16x16x32_bf16(a[m], b[n], acc[m][n], 0, 0, 0);
        }
        epi(acc, row0, col0, lane);
    }
}

DEVI void head64(bf16_t* p, const float* g, bool do_norm, bool do_rope, float scale, float cosv, float sinv, int lane) {
    float v = bf2f(p[lane]);
    if (do_norm) { const float ss = wave_sum(v * v); v = v * rsqrtf(ss * (1.f / 64.f) + EPS) * g[lane]; }
    if (do_rope) { const float o = __shfl_xor(v, 8); if (lane < 8) v = v * cosv - o * sinv; else if (lane < 16) v = v * cosv + o * sinv; }
    p[lane] = (bf16_t)f2bf(v * scale);
}
DEVI void phase_post0(const Params& P) {
    const int tid = threadIdx.x, lane = tid & 63, wave = tid >> 6;
    const int gw = blockIdx.x * NWAVE + wave, NGW = gridDim.x * NWAVE;
    unsigned char* ws = P.ws;
    const float qscale = 0.125f * LOG2E;
    for (int m = gw; m < T; m += NGW) {
        bf16_t* row = (bf16_t*)(ws + WS_PROJ) + (size_t)m * LDP;
        const float* cs = (const float*)(ws + WS_CS) + (size_t)m * 16;
        const float cosv = cs[lane & 7], sinv = cs[8 + (lane & 7)];
        for (int h = 0; h < 8; ++h) head64(row + C_QA + 64 * h, P.in[15], true, true, qscale, cosv, sinv, lane);
        for (int h = 0; h < 8; ++h) head64(row + C_KA + 64 * h, P.in[16], true, true, 1.f, cosv, sinv, lane);
        for (int h = 0; h < 8; ++h) head64(row + C_QB + 64 * h, P.in[24], true, true, qscale, cosv, sinv, lane);
        for (int h = 0; h < 4; ++h) head64(row + C_QI + 64 * h, nullptr, false, true, 1.f, cosv, sinv, lane);
        head64(row + C_KI, P.in[26], true, true, 1.f, cosv, sinv, lane);
        { float s = 0.f;
#pragma unroll
          for (int j = 0; j < 4; ++j) { const float v = bf2f(row[C_CKV + 64 * j + lane]); s += v * v; }
          s = wave_sum(s); if (lane == 0) ((float*)(ws + WS_SSQCKV))[m] = s; }
        if (lane < 4) ((float*)(ws + WS_WI))[(size_t)m * 4 + lane] = bf2f(row[C_WI + lane]) * (1.f / 16.f);
    }
    for (int it = gw; it < 2 * MEMT; it += NGW) {
        const int l = it / MEMT, m = it % MEMT;
        bf16_t* row = (bf16_t*)(ws + WS_KVX) + (size_t)l * MEMT * 1024 + (size_t)m * 1024;
        const float* g = P.in[10] + l * 128;
        for (int h = 0; h < 4; ++h) {
            float v0 = bf2f(row[128 * h + lane]), v1 = bf2f(row[128 * h + 64 + lane]);
            const float ss = wave_sum(v0 * v0 + v1 * v1), rs = rsqrtf(ss * (1.f / 128.f) + EPS);
            row[128 * h + lane] = (bf16_t)f2bf(v0 * rs * g[lane]); row[128 * h + 64 + lane] = (bf16_t)f2bf(v1 * rs * g[64 + lane]);
        }
    }
}
DEVI void phase_postkb(const Params& P) {
    const int tid = threadIdx.x, lane = tid & 63, wave = tid >> 6;
    const int gw = blockIdx.x * NWAVE + wave, NGW = gridDim.x * NWAVE;
    unsigned char* ws = P.ws;
    for (int m = gw; m < T; m += NGW) {
        bf16_t* row = (bf16_t*)(ws + WS_KBVB) + (size_t)m * 1024;
        const float* cs = (const float*)(ws + WS_CS) + (size_t)m * 16;
        const float cosv = cs[lane & 7], sinv = cs[8 + (lane & 7)];
        for (int h = 0; h < 8; ++h) head64(row + 64 * h, P.in[25], true, true, 1.f, cosv, sinv, lane);
    }
}

DEVI unsigned cvtpk(float lo, float hi) { typedef __bf16 bf2 __attribute__((ext_vector_type(2))); f32x2 v = {lo, hi}; bf2 b = __builtin_convertvector(v, bf2); return __builtin_bit_cast(unsigned, b); }
DEVI int crow(int r, int hi) { return (r & 3) + 8 * (r >> 2) + 4 * hi; }
typedef short v4i16_t __attribute__((ext_vector_type(4)));
DEVI s16x4 vtr(LAS const unsigned char* p) { return __builtin_bit_cast(s16x4, __builtin_amdgcn_ds_read_tr16_b64_v4i16((LAS v4i16_t*)p)); }

template <int DQK, int DV, int MODE>
DEVI void attn_core(f32x16 (&o)[DV / 32], float& m_run, float& l_run, const bf16x8 (&qf)[DQK / 16],
                    const bf16_t* Kg, int ldk, const bf16_t* Vg, int ldv, int ntiles, int qpos, int qpos_wmin,
                    const u64* mrow, LAS unsigned char* lds, int tid) {
    constexpr int KROWB = DQK * 2, KCPR = DQK / 8, VP = (DV == 128) ? 320 : 192, VCPR = DV / 8;
    constexpr int KBUF = 64 * KROWB, VBUF = 64 * VP, KCH = 64 * KCPR / NTHR, VCH = 64 * VCPR / NTHR;
    LAS unsigned char* Kl = lds; LAS unsigned char* Vl = lds + 2 * KBUF;
    const int lane = tid & 63, r32 = lane & 31, hi = lane >> 5;
    u32x4 kreg[KCH], vreg[VCH];
#define A_GLOAD(t) do { _Pragma("unroll") for (int i_ = 0; i_ < KCH; ++i_) { const int c_ = tid + NTHR * i_, row_ = c_ / KCPR, ch_ = c_ % KCPR; kreg[i_] = *(const u32x4*)(Kg + (size_t)(64 * (t) + row_) * ldk + ch_ * 8); } \
        _Pragma("unroll") for (int i_ = 0; i_ < VCH; ++i_) { const int c_ = tid + NTHR * i_, row_ = c_ / VCPR, ch_ = c_ % VCPR; vreg[i_] = *(const u32x4*)(Vg + (size_t)(64 * (t) + row_) * ldv + ch_ * 8); } } while (0)
#define A_LSTORE(buf) do { _Pragma("unroll") for (int i_ = 0; i_ < KCH; ++i_) { const int c_ = tid + NTHR * i_, row_ = c_ / KCPR, ch_ = c_ % KCPR; *(LAS u32x4*)(Kl + (buf) * KBUF + row_ * KROWB + ((ch_ ^ (row_ & (KCPR - 1))) << 4)) = kreg[i_]; } \
        _Pragma("unroll") for (int i_ = 0; i_ < VCH; ++i_) { const int c_ = tid + NTHR * i_, row_ = c_ / VCPR, ch_ = c_ % VCPR; *(LAS u32x4*)(Vl + (buf) * VBUF + row_ * VP + ch_ * 16) = vreg[i_]; } } while (0)
    A_GLOAD(0); A_LSTORE(0); __syncthreads();
    const int vb = (4 * hi + ((lane & 15) >> 2)) * VP + (16 * ((lane >> 4) & 1) + 4 * (lane & 3)) * 2;
    for (int t = 0; t < ntiles; ++t) {
        const int buf = t & 1;
        if (t + 1 < ntiles) A_GLOAD(t + 1);
        f32x16 p0, p1;
#pragma unroll
        for (int r = 0; r < 16; ++r) { p0[r] = 0.f; p1[r] = 0.f; }
#pragma unroll
        for (int d0 = 0; d0 < DQK / 16; ++d0) {
            const int ch = 2 * d0 + hi, row0 = r32, row1 = 32 + r32;
            const bf16x8 a0 = *(LAS const bf16x8*)(Kl + buf * KBUF + row0 * KROWB + ((ch ^ (row0 & (KCPR - 1))) << 4));
            const bf16x8 a1 = *(LAS const bf16x8*)(Kl + buf * KBUF + row1 * KROWB + ((ch ^ (row1 & (KCPR - 1))) << 4));
            p0 = __builtin_amdgcn_mfma_f32_32x32x16_bf16(a0, qf[d0], p0, 0, 0, 0);
            p1 = __builtin_amdgcn_mfma_f32_32x32x16_bf16(a1, qf[d0], p1, 0, 0, 0);
        }
        if (MODE == 1) {
            if (64 * t + 63 > qpos_wmin) {
#pragma unroll
                for (int r = 0; r < 16; ++r) { const int kv = 64 * t + crow(r, hi); if (kv > qpos) p0[r] = -INFINITY; if (kv + 32 > qpos) p1[r] = -INFINITY; }
            }
        } else if (MODE == 2) {
            const u64 w = mrow[t] >> (4 * hi); const unsigned wl = (unsigned)w, wh = (unsigned)(w >> 32);
#pragma unroll
            for (int r = 0; r < 16; ++r) { const int bit = (r & 3) + 8 * (r >> 2); if (!((wl >> bit) & 1u)) p0[r] = -INFINITY; if (!((wh >> bit) & 1u)) p1[r] = -INFINITY; }
        }
        float mx = fmaxf(p0[0], p1[0]);
#pragma unroll
        for (int r = 1; r < 16; ++r) mx = fmaxf(mx, fmaxf(p0[r], p1[r]));
        mx = fmaxf(mx, __shfl_xor(mx, 32));
        const float m_new = fmaxf(m_run, mx), alpha = __builtin_amdgcn_exp2f(m_run - m_new);
        m_run = m_new;
        float rs = 0.f;
#pragma unroll
        for (int r = 0; r < 16; ++r) { p0[r] = __builtin_amdgcn_exp2f(p0[r] - m_new); p1[r] = __builtin_amdgcn_exp2f(p1[r] - m_new); rs += p0[r] + p1[r]; }
        l_run = l_run * alpha + rs;
        if (__any(alpha != 1.f)) {
#pragma unroll
            for (int d0 = 0; d0 < DV / 32; ++d0)
#pragma unroll
                for (int r = 0; r < 16; ++r) o[d0][r] *= alpha;
        }
        bf16x8 pb[4];
#pragma unroll
        for (int ks = 0; ks < 4; ++ks) {
            u32x4 w;
            if (ks < 2) { w.x = cvtpk(p0[8 * ks + 0], p0[8 * ks + 1]); w.y = cvtpk(p0[8 * ks + 2], p0[8 * ks + 3]); w.z = cvtpk(p0[8 * ks + 4], p0[8 * ks + 5]); w.w = cvtpk(p0[8 * ks + 6], p0[8 * ks + 7]); }
            else { const int k2 = ks - 2; w.x = cvtpk(p1[8 * k2 + 0], p1[8 * k2 + 1]); w.y = cvtpk(p1[8 * k2 + 2], p1[8 * k2 + 3]); w.z = cvtpk(p1[8 * k2 + 4], p1[8 * k2 + 5]); w.w = cvtpk(p1[8 * k2 + 6], p1[8 * k2 + 7]); }
            pb[ks] = __builtin_bit_cast(bf16x8, w);
        }
#pragma unroll
        for (int d0 = 0; d0 < DV / 32; ++d0)
#pragma unroll
            for (int ks = 0; ks < 4; ++ks) {
                const s16x4 lo = vtr(Vl + buf * VBUF + vb + (16 * ks) * VP + d0 * 64);
                const s16x4 hh = vtr(Vl + buf * VBUF + vb + (16 * ks + 8) * VP + d0 * 64);
                const bf16x8 a = (bf16x8){lo[0], lo[1], lo[2], lo[3], hh[0], hh[1], hh[2], hh[3]};
                o[d0] = __builtin_amdgcn_mfma_f32_32x32x16_bf16(a, pb[ks], o[d0], 0, 0, 0);
            }
        if (t + 1 < ntiles) A_LSTORE((t + 1) & 1);
        __syncthreads();
    }
#undef A_GLOAD
#undef A_LSTORE
}
template <int DV>
DEVI void store_oT(const f32x16 (&o)[DV / 32], float inv, bf16_t* dst, int hi) {
#pragma unroll
    for (int d0 = 0; d0 < DV / 32; ++d0)
#pragma unroll
        for (int g4 = 0; g4 < 4; ++g4) {
            u32x2 w; w.x = cvtpk(o[d0][4 * g4 + 0] * inv, o[d0][4 * g4 + 1] * inv); w.y = cvtpk(o[d0][4 * g4 + 2] * inv, o[d0][4 * g4 + 3] * inv);
            *(u32x2*)(dst + 32 * d0 + 8 * g4 + 4 * hi) = w;
        }
}

DEVI void attnA_unit(const Params& P, int b, int h, int c, int qb, LAS unsigned char* lds) {
    const int tid = threadIdx.x, lane = tid & 63, wave = tid >> 6, r32 = lane & 31, hi = lane >> 5;
    unsigned char* ws = P.ws;
    const bf16_t* proj = (const bf16_t*)(ws + WS_PROJ);
    const int q = qb * 256 + 32 * wave + r32; const size_t row = (size_t)b * S + q;
    bf16x8 qf[4];
#pragma unroll
    for (int d0 = 0; d0 < 4; ++d0) qf[d0] = *(const bf16x8*)(proj + row * LDP + C_QA + (2 * h + c) * 64 + 16 * d0 + 8 * hi);
    f32x16 o[4];
#pragma unroll
    for (int d0 = 0; d0 < 4; ++d0)
#pragma unroll
        for (int r = 0; r < 16; ++r) o[d0][r] = 0.f;
    float m_run = -1e30f, l_run = 0.f;
    attn_core<64, 128, 1>(o, m_run, l_run, qf, proj + (size_t)b * S * LDP + C_KA + (2 * h + c) * 64, LDP, proj + (size_t)b * S * LDP + C_VA + h * 128, LDP,
                          4 * (qb + 1), q, qb * 256 + 32 * wave, nullptr, lds, tid);
    const float lt = l_run + __shfl_xor(l_run, 32);
    bf16_t* oa = (bf16_t*)(ws + WS_XB) + (size_t)c * T * 512 + row * 512 + h * 128;
    store_oT<128>(o, 1.f / lt, oa, hi);
}
DEVI void attnB_unit(const Params& P, int b, int hd, int qb, LAS unsigned char* lds) {
    const int tid = threadIdx.x, lane = tid & 63, wave = tid >> 6, r32 = lane & 31, hi = lane >> 5;
    unsigned char* ws = P.ws;
    const bf16_t* proj = (const bf16_t*)(ws + WS_PROJ); const bf16_t* kbvb = (const bf16_t*)(ws + WS_KBVB);
    const int q = qb * 256 + 32 * wave + r32; const size_t row = (size_t)b * S + q;
    bf16x8 qf[4];
#pragma unroll
    for (int d0 = 0; d0 < 4; ++d0) qf[d0] = *(const bf16x8*)(proj + row * LDP + C_QB + hd * 64 + 16 * d0 + 8 * hi);
    f32x16 o[2];
#pragma unroll
    for (int d0 = 0; d0 < 2; ++d0)
#pragma unroll
        for (int r = 0; r < 16; ++r) o[d0][r] = 0.f;
    float m_run = -1e30f, l_run = 0.f;
    attn_core<64, 64, 2>(o, m_run, l_run, qf, kbvb + (size_t)b * S * 1024 + hd * 64, 1024, kbvb + (size_t)b * S * 1024 + 512 + hd * 64, 1024,
                         4 * (qb + 1), q, qb * 256 + 32 * wave, (const u64*)(ws + WS_MASK) + row * 64, lds, tid);
    const float lt = l_run + __shfl_xor(l_run, 32);
    store_oT<64>(o, 1.f / lt, (bf16_t*)(ws + WS_Y) + row * 1024 + 512 + hd * 64, hi);
}
DEVI void xattn_unit(const Params& P, int l, int b, int hd, int qb, LAS unsigned char* lds) {
    const int tid = threadIdx.x, lane = tid & 63, wave = tid >> 6, r32 = lane & 31, hi = lane >> 5;
    unsigned char* ws = P.ws;
    const bf16_t* qx = (const bf16_t*)(ws + WS_QX); const bf16_t* kvx = (const bf16_t*)(ws + WS_KVX) + (size_t)l * MEMT * 1024;
    const int q = qb * 256 + 32 * wave + r32; const size_t row = (size_t)b * S + q;
    const float* gq = P.in[9] + l * 128;
    u32x4 raw[8]; float ss = 0.f;
#pragma unroll
    for (int d0 = 0; d0 < 8; ++d0) { raw[d0] = *(const u32x4*)(qx + row * 512 + hd * 128 + 16 * d0 + 8 * hi);
#pragma unroll
        for (int j = 0; j < 4; ++j) { const float a = lo16(raw[d0][j]), bq = hi16(raw[d0][j]); ss += a * a + bq * bq; } }
    ss += __shfl_xor(ss, 32);
    const float rs = rsqrtf(ss * (1.f / 128.f) + EPS) * (0.08838834764831845f * LOG2E);
    bf16x8 qf[8];
#pragma unroll
    for (int d0 = 0; d0 < 8; ++d0) { u32x4 w;
#pragma unroll
        for (int j = 0; j < 4; ++j) { const int dim = 16 * d0 + 8 * hi + 2 * j; w[j] = cvtpk(lo16(raw[d0][j]) * rs * gq[dim], hi16(raw[d0][j]) * rs * gq[dim + 1]); }
        qf[d0] = __builtin_bit_cast(bf16x8, w); }
    f32x16 o[4];
#pragma unroll
    for (int d0 = 0; d0 < 4; ++d0)
#pragma unroll
        for (int r = 0; r < 16; ++r) o[d0][r] = 0.f;
    float m_run = -1e30f, l_run = 0.f;
    attn_core<128, 128, 0>(o, m_run, l_run, qf, kvx + (size_t)b * MEML * 1024 + hd * 128, 1024, kvx + (size_t)b * MEML * 1024 + 512 + hd * 128, 1024,
                           MEML / 64, q, 0, nullptr, lds, tid);
    const float lt = l_run + __shfl_xor(l_run, 32);
    store_oT<128>(o, 1.f / lt, (bf16_t*)(ws + WS_YX) + row * 512 + hd * 128, hi);
}

DEVI void indexer_unit(const Params& P, int b, int t0, LAS unsigned char* lds) {
    const int tid = threadIdx.x, lane = tid & 63, wave = tid >> 6, r32 = lane & 31, hi = lane >> 5;
    unsigned char* ws = P.ws;
    const bf16_t* proj = (const bf16_t*)(ws + WS_PROJ); const float* WI = (const float*)(ws + WS_WI);
    LAS float* Ssc = (LAS float*)lds;
    if (t0 + 7 >= 255) {
        bf16x8 af[4];
        { const int qq = r32 >> 2, hh = r32 & 3; const size_t row = (size_t)b * S + t0 + qq;
#pragma unroll
          for (int d0 = 0; d0 < 4; ++d0) af[d0] = *(const bf16x8*)(proj + row * LDP + C_QI + hh * 64 + 16 * d0 + 8 * hi); }
        float wv[16];
#pragma unroll
        for (int r = 0; r < 16; ++r) wv[r] = WI[((size_t)b * S + t0 + 2 * (r >> 2) + hi) * 4 + (r & 3)];
        const int nkt = (t0 + 8 + 31) / 32;
        for (int kt = wave; kt < nkt; kt += NWAVE) {
            const int key = kt * 32 + r32; const size_t krow = (size_t)b * S + key;
            f32x16 c;
#pragma unroll
            for (int r = 0; r < 16; ++r) c[r] = 0.f;
#pragma unroll
            for (int d0 = 0; d0 < 4; ++d0) { const bf16x8 bk = *(const bf16x8*)(proj + krow * LDP + C_KI + 16 * d0 + 8 * hi); c = __builtin_amdgcn_mfma_f32_32x32x16_bf16(af[d0], bk, c, 0, 0, 0); }
#pragma unroll
            for (int g4 = 0; g4 < 4; ++g4) {
                float s = 0.f;
#pragma unroll
                for (int hh = 0; hh < 4; ++hh) s += fmaxf(c[4 * g4 + hh], 0.f) * wv[4 * g4 + hh];
                Ssc[(2 * g4 + hi) * 4096 + key] = s;
            }
        }
    }
    __syncthreads();
    {
        const int t = t0 + wave; u64 myw = 0ull;
        if (t >= 255) {
            unsigned u[64];
#pragma unroll
            for (int j = 0; j < 64; ++j) {
                const int s = 64 * j + lane; unsigned key = 0u;
                if (64 * j <= t) { const unsigned bits = __float_as_uint(Ssc[wave * 4096 + s]);
                    key = (bits == 0x80000000u) ? 0x80000000u : ((bits & 0x80000000u) ? ~bits : (bits | 0x80000000u));
                    if (s > t) key = 0u; }
                u[j] = key;
            }
            unsigned prefix = 0u;
            for (int bit = 31; bit >= 0; --bit) {
                const unsigned cand = prefix | (1u << bit); int cnt = 0;
#pragma unroll
                for (int j = 0; j < 64; ++j) cnt += (u[j] >= cand) ? 1 : 0;
                cnt = (int)wave_sum((float)cnt);
                if (cnt >= 256) prefix = cand;
            }
            int cgt = 0;
#pragma unroll
            for (int j = 0; j < 64; ++j) cgt += (u[j] > prefix) ? 1 : 0;
            cgt = (int)wave_sum((float)cgt);
            const int need = 256 - cgt; int running = 0;
#pragma unroll
            for (int j = 0; j < 64; ++j) {
                const bool tie = (u[j] == prefix);
                const u64 bt = __ballot(tie);
                const int rank = __builtin_amdgcn_mbcnt_hi((unsigned)(bt >> 32), __builtin_amdgcn_mbcnt_lo((unsigned)bt, 0u));
                const bool sel = (u[j] > prefix) || (tie && (running + rank < need));
                const u64 wj = __ballot(sel);
                running += __builtin_popcountll(bt);
                if (lane == j) myw = wj;
            }
        } else {
            const int lo = 64 * lane;
            if (lo + 63 <= t) myw = ~0ull; else if (lo > t) myw = 0ull; else myw = (~0ull) >> (63 - (t - lo));
        }
        ((u64*)(ws + WS_MASK))[((size_t)b * S + t) * 64 + lane] = myw;
    }
    __syncthreads();
}

DEVI void combineA_rows(const Params& P) {
    const int tid = threadIdx.x, lane = tid & 63, wave = tid >> 6;
    const int gw = blockIdx.x * NWAVE + wave, NGW = gridDim.x * NWAVE;
    unsigned char* ws = P.ws;
    const float d1 = wave_sum(P.in[17][lane] * P.in[18][lane]), d2 = wave_sum(P.in[19][lane] * P.in[20][lane]);
    const float lam_init = 0.2f, lam = expf(d1) - expf(d2) + lam_init;
    const bf16_t* o0 = (const bf16_t*)(ws + WS_XB); const bf16_t* o1 = o0 + (size_t)T * 512;
    const float* gs = P.in[21] + 8 * (lane & 15);
    for (int m = gw; m < T; m += NGW) {
        const u32x4 a = *(const u32x4*)(o0 + (size_t)m * 512 + 8 * lane), bq = *(const u32x4*)(o1 + (size_t)m * 512 + 8 * lane);
        float v[8]; float ss = 0.f;
#pragma unroll
        for (int j = 0; j < 4; ++j) { v[2 * j] = lo16(a[j]) - lam * lo16(bq[j]); v[2 * j + 1] = hi16(a[j]) - lam * hi16(bq[j]); ss += v[2 * j] * v[2 * j] + v[2 * j + 1] * v[2 * j + 1]; }
        ss += __shfl_xor(ss, 1); ss += __shfl_xor(ss, 2); ss += __shfl_xor(ss, 4); ss += __shfl_xor(ss, 8);
        const float rs = rsqrtf(ss * (1.f / 128.f) + EPS) * (1.f - lam_init);
        u32x4 w;
#pragma unroll
        for (int j = 0; j < 4; ++j) w[j] = cvtpk(v[2 * j] * rs * gs[2 * j], v[2 * j + 1] * rs * gs[2 * j + 1]);
        *(u32x4*)((bf16_t*)(ws + WS_Y) + (size_t)m * 1024 + 8 * lane) = w;
    }
}

DEVI void phase_mix1(const Params& P) {
    const int gt = blockIdx.x * NTHR + threadIdx.x, NGT = gridDim.x * NTHR;
    unsigned char* ws = P.ws;
    const bf16_t* pr = (const bf16_t*)(ws + WS_PROJ1);
    const float* cw = P.in[29];
    for (int it = gt; it < T * 128; it += NGT) {
        const int m = it >> 7, ci = it & 127, t = m & (S - 1);
        if (ci < 64) {
            const int c0 = 8 * ci; float conv[8];
#pragma unroll
            for (int j = 0; j < 8; ++j) conv[j] = 0.f;
#pragma unroll
            for (int dt = 0; dt < 3; ++dt) {
                if (t - dt >= 0) {
                    const u32x4 gc = *(const u32x4*)(pr + (size_t)(m - dt) * 2048 + 512 + c0), hc = *(const u32x4*)(pr + (size_t)(m - dt) * 2048 + 1024 + c0);
#pragma unroll
                    for (int j = 0; j < 4; ++j) { conv[2 * j] += cw[(2 - dt) * 512 + c0 + 2 * j] * (lo16(gc[j]) * lo16(hc[j])); conv[2 * j + 1] += cw[(2 - dt) * 512 + c0 + 2 * j + 1] * (hi16(gc[j]) * hi16(hc[j])); }
                }
            }
            const u32x4 gb = *(const u32x4*)(pr + (size_t)m * 2048 + c0); u32x4 w;
#pragma unroll
            for (int j = 0; j < 4; ++j) w[j] = cvtpk(lo16(gb[j]) * conv[2 * j], hi16(gb[j]) * conv[2 * j + 1]);
            *(u32x4*)((bf16_t*)(ws + WS_Y) + (size_t)m * 1024 + c0) = w;
        } else {
            const int c0 = 8 * (ci - 64), g = c0 >> 7, wdw = 2 << g; float sum[8];
#pragma unroll
            for (int j = 0; j < 8; ++j) sum[j] = 0.f;
            const int n = (t + 1 < wdw) ? (t + 1) : wdw;
            u32x4 z0 = (u32x4){0u, 0u, 0u, 0u};
            for (int dt = 0; dt < n; ++dt) {
                const u32x4 z = *(const u32x4*)(pr + (size_t)(m - dt) * 2048 + 1536 + c0); if (dt == 0) z0 = z;
#pragma unroll
                for (int j = 0; j < 4; ++j) { sum[2 * j] += lo16(z[j]); sum[2 * j + 1] += hi16(z[j]); }
            }
            const float inv = 1.f / (float)n; u32x4 w;
#pragma unroll
            for (int j = 0; j < 4; ++j) w[j] = cvtpk(sum[2 * j] * inv - lo16(z0[j]), sum[2 * j + 1] * inv - hi16(z0[j]));
            *(u32x4*)((bf16_t*)(ws + WS_POOLED) + (size_t)m * 512 + c0) = w;
        }
    }
}

namespace pg8 {
#define PG8_LAS __attribute__((address_space(3)))
typedef unsigned short bf16_t;
typedef short bf16x8 __attribute__((ext_vector_type(8)));
typedef float f32x4 __attribute__((ext_vector_type(4)));
typedef unsigned u32x4 __attribute__((ext_vector_type(4)));
constexpr int BM = 256, BK = 64, HALF = 128, HTB = HALF * BK * 2  , STAGE_BYTES = 8 * HTB, NXCD = 8, WGM = 8;

__host__ __device__ __forceinline__ int lds_byte(int r, int c) { const int st = (r >> 4) * 2 + (c >> 5), rr = r & 15, cc = c & 31, ob = rr * 64 + cc * 2; return st * 1024 + (ob ^ (((ob >> 9) & 1) << 5)); }
__host__ __device__ __forceinline__ void stage_rc(int b, int& R, int& C) { const int st = b / 1024, sb = b % 1024, swz = sb ^ (((sb >> 9) & 1) << 5); R = (st >> 1) * 16 + swz / 64; C = (st & 1) * 32 + (swz % 64) / 2; }
__host__ __device__ __forceinline__ int perm32(int rho) { const int n = rho >> 4, i = rho & 15; return 8 * (i >> 2) + 4 * n + (i & 3); }

struct Unit { int pm, pn; };
struct Gemm { const bf16_t* A; int lda; const bf16_t* Bt; int M, N, K; };

struct StaticOrder {
    int nM, nN, nwg, G, c;
    __host__ __device__ void init(int M, int N, int G_, int c_) { nM = M / BM; nN = N / BM; nwg = nM * nN; G = G_; c = c_; }
    __host__ __device__ bool next(int i, Unit& u) const {
        const long L = (long)i * G + c; if (L >= nwg) return false;
        int wgid = (int)L; { const int q = nwg / NXCD, r = nwg % NXCD, xcd = wgid % NXCD, off = wgid / NXCD; wgid = (xcd < r ? xcd * (q + 1) : r * (q + 1) + (xcd - r) * q) + off; }
        const int nig = WGM * nN, gid = wgid / nig, fm = gid * WGM, gsz = (nM - fm) < WGM ? (nM - fm) : WGM;
        u.pm = fm + ((wgid % nig) % gsz); u.pn = (wgid % nig) / gsz; return true;
    }
    __device__ __forceinline__ void a_ready(const Unit&) const {}
    __device__ __forceinline__ void done(const Unit&) const {}
};
template <class Epi, class Sched, bool ALIGN_EPI = false, bool SP2 = false>
__device__ __forceinline__ void gemm_phase(PG8_LAS unsigned char* lds, const Gemm g, const Sched& S, const Epi& E) {
    const int tid = threadIdx.x, wid = __builtin_amdgcn_readfirstlane(tid >> 6), lane = tid & 63, wr = wid >> 2, wc = wid & 3, fr = lane & 15, fq = lane >> 4;
    const int K = g.K, nt = K / BK;
    unsigned voffA[2], voffB[2];
#pragma unroll
    for (int i = 0; i < 2; ++i) { int R, C; stage_rc(tid * 16 + i * 8192, R, C); const int Rb = Epi::PERM ? ((R & ~31) + perm32(R & 31)) : R;
        voffA[i] = (unsigned)(R * g.lda + C) * 2u; voffB[i] = (unsigned)(Rb * K + C) * 2u; }
    const size_t kstep = (size_t)(BK * 2);
    const size_t hstepA = (size_t)HALF * g.lda * 2, hstepB = (size_t)HALF * K * 2;
    const size_t tstepA = 2 * hstepA, tstepB = 2 * hstepB;
    const unsigned ldsw = (unsigned)wid * 1024u;
    const int aoff = lds_byte(wr * 64 + fr, fq * 8), boff = lds_byte(wc * 32 + fr, fq * 8);
#define PG8_SA(b, h) (((b) * 2 + (h)) * HTB)
#define PG8_SB(b, h) ((4 + (b) * 2 + (h)) * HTB)
#define PG8_STAGE(bufoff, gbase, voff) do { _Pragma("unroll") for (int _i = 0; _i < 2; ++_i) \
        __builtin_amdgcn_global_load_lds((const unsigned*)((const char*)(gbase) + (voff)[_i]), (PG8_LAS unsigned*)(lds + (bufoff) + ldsw + _i * 8192), 16, 0, 0); } while (0)
#define PG8_LDA(dst, b, h) do { _Pragma("unroll") for (int m = 0; m < 4; ++m) _Pragma("unroll") for (int k = 0; k < 2; ++k) dst[m][k] = *(const PG8_LAS bf16x8*)(lds + PG8_SA(b, h) + aoff + m * 2048 + k * 1024); } while (0)
#define PG8_LDB(dst, b, h) do { _Pragma("unroll") for (int n = 0; n < 2; ++n) _Pragma("unroll") for (int k = 0; k < 2; ++k) dst[n][k] = *(const PG8_LAS bf16x8*)(lds + PG8_SB(b, h) + boff + n * 2048 + k * 1024); } while (0)
#define PG8_MMA(ai, bj, At, Bt) do { __builtin_amdgcn_s_setprio(1); _Pragma("unroll") for (int m = 0; m < 4; ++m) _Pragma("unroll") for (int n = 0; n < 2; ++n) _Pragma("unroll") for (int k = 0; k < 2; ++k) \
        acc[ai][bj][m][n] = __builtin_amdgcn_mfma_f32_16x16x32_bf16(Bt[n][k], At[m][k], acc[ai][bj][m][n], 0, 0, 0); __builtin_amdgcn_s_setprio(0); } while (0)
#define PG8_WAIT_V(n) asm volatile("s_waitcnt vmcnt(" #n ")" ::: "memory")
#define PG8_WAIT_L(n) asm volatile("s_waitcnt lgkmcnt(" #n ")" ::: "memory")
#define PG8_BAR __builtin_amdgcn_s_barrier()
#define PG8_SCHED __builtin_amdgcn_sched_barrier(0)
    Unit cur, nxt; int ui = 0;
    if (!S.next(0, cur)) return;
    f32x4 acc[2][2][4][2];
#pragma unroll
    for (int a = 0; a < 2; ++a)
#pragma unroll
        for (int b = 0; b < 2; ++b)
#pragma unroll
            for (int m = 0; m < 4; ++m)
#pragma unroll
                for (int n = 0; n < 2; ++n) acc[a][b][m][n] = (f32x4){0.f, 0.f, 0.f, 0.f};
    bf16x8 At[4][2], B0[2][2], B1[2][2];
    const char* cA = (const char*)g.A + (size_t)cur.pm * tstepA; const char* cB = (const char*)g.Bt + (size_t)cur.pn * tstepB;
    S.a_ready(cur);
    if constexpr (SP2) {
        PG8_STAGE(PG8_SB(0, 0), cB, voffB); PG8_STAGE(PG8_SB(0, 1), cB + hstepB, voffB); PG8_STAGE(PG8_SA(0, 0), cA, voffA); PG8_STAGE(PG8_SA(0, 1), cA + hstepA, voffA);
        if (wr == 1) PG8_BAR;
        PG8_WAIT_V(2); PG8_BAR;
        PG8_STAGE(PG8_SB(1, 0), cB + kstep, voffB); PG8_STAGE(PG8_SA(1, 0), cA + kstep, voffA); PG8_STAGE(PG8_SB(1, 1), cB + hstepB + kstep, voffB);
        PG8_WAIT_V(6); PG8_BAR;
    } else {
        PG8_STAGE(PG8_SB(0, 0), cB, voffB); PG8_STAGE(PG8_SA(0, 0), cA, voffA); PG8_STAGE(PG8_SB(0, 1), cB + hstepB, voffB); PG8_STAGE(PG8_SA(0, 1), cA + hstepA, voffA);
        if (wr == 1) PG8_BAR;
        PG8_WAIT_V(4); PG8_BAR;
        PG8_STAGE(PG8_SB(1, 0), cB + kstep, voffB); PG8_STAGE(PG8_SA(1, 0), cA + kstep, voffA); PG8_STAGE(PG8_SB(1, 1), cB + hstepB + kstep, voffB);
        PG8_WAIT_V(6); PG8_BAR;
    }
    for (;;) {
        const bool has_next = S.next(ui + 1, nxt);
        const char* nA = has_next ? (const char*)g.A + (size_t)nxt.pm * tstepA : cA; const char* nB = has_next ? (const char*)g.Bt + (size_t)nxt.pn * tstepB : cB;
        for (int t = 0; t < nt; t += 2) {
            const bool last = (t == nt - 2);
            const char* a1 = cA + (size_t)(t + 1) * kstep;
            const char* a2 = last ? nA : cA + (size_t)(t + 2) * kstep; const char* b2 = last ? nB : cB + (size_t)(t + 2) * kstep;
            const char* a3 = a2 + kstep; const char* b3 = b2 + kstep;
            if (last && has_next) S.a_ready(nxt);
            if constexpr (SP2) {
            PG8_LDB(B0, 0, 0); PG8_LDB(B1, 0, 1); PG8_SCHED; PG8_LDA(At, 0, 0); PG8_STAGE(PG8_SA(1, 1), a1 + hstepA, voffA);
            PG8_WAIT_V(8); PG8_WAIT_L(0); PG8_BAR; PG8_MMA(0, 0, At, B0); PG8_MMA(0, 1, At, B1); PG8_BAR; PG8_SCHED;
            PG8_LDA(At, 0, 1); PG8_STAGE(PG8_SB(0, 0), b2, voffB); PG8_STAGE(PG8_SB(0, 1), b2 + hstepB, voffB); PG8_STAGE(PG8_SA(0, 0), a2, voffA);
            PG8_WAIT_V(8); PG8_WAIT_L(0); PG8_BAR; PG8_MMA(1, 0, At, B0); PG8_MMA(1, 1, At, B1); PG8_BAR; PG8_SCHED;
            PG8_LDB(B0, 1, 0); PG8_LDB(B1, 1, 1); PG8_SCHED; PG8_LDA(At, 1, 0); PG8_STAGE(PG8_SA(0, 1), a2 + hstepA, voffA);
            PG8_WAIT_V(8); PG8_WAIT_L(0); PG8_BAR; PG8_MMA(0, 0, At, B0); PG8_MMA(0, 1, At, B1); PG8_BAR; PG8_SCHED;
            PG8_LDA(At, 1, 1); PG8_STAGE(PG8_SB(1, 0), b3, voffB); PG8_STAGE(PG8_SB(1, 1), b3 + hstepB, voffB); PG8_STAGE(PG8_SA(1, 0), a3, voffA);
            PG8_WAIT_V(8); PG8_WAIT_L(0); PG8_BAR; PG8_MMA(1, 0, At, B0); PG8_MMA(1, 1, At, B1); PG8_BAR; PG8_SCHED;
            } else {
            PG8_LDB(B0, 0, 0); PG8_SCHED; PG8_LDA(At, 0, 0); PG8_STAGE(PG8_SA(1, 1), a1 + hstepA, voffA);
            PG8_WAIT_L(8); PG8_BAR; PG8_WAIT_L(0); PG8_MMA(0, 0, At, B0); PG8_BAR; PG8_SCHED;
            PG8_LDB(B1, 0, 1); PG8_STAGE(PG8_SB(0, 0), b2, voffB);
            PG8_BAR; PG8_WAIT_L(0); PG8_MMA(0, 1, At, B1); PG8_BAR;
            PG8_LDA(At, 0, 1); PG8_STAGE(PG8_SA(0, 0), a2, voffA);
            PG8_BAR; PG8_WAIT_L(0); PG8_MMA(1, 0, At, B0); PG8_BAR; PG8_SCHED;
            PG8_STAGE(PG8_SB(0, 1), b2 + hstepB, voffB);
            PG8_WAIT_V(6); PG8_BAR; PG8_MMA(1, 1, At, B1); PG8_BAR;
            PG8_LDB(B0, 1, 0); PG8_SCHED; PG8_LDA(At, 1, 0); PG8_STAGE(PG8_SA(0, 1), a2 + hstepA, voffA);
            PG8_WAIT_L(8); PG8_BAR; PG8_WAIT_L(0); PG8_MMA(0, 0, At, B0); PG8_BAR; PG8_SCHED;
            PG8_LDB(B1, 1, 1); PG8_STAGE(PG8_SB(1, 0), b3, voffB);
            PG8_BAR; PG8_WAIT_L(0); PG8_MMA(0, 1, At, B1); PG8_BAR;
            PG8_LDA(At, 1, 1); PG8_STAGE(PG8_SA(1, 0), a3, voffA);
            PG8_BAR; PG8_WAIT_L(0); PG8_MMA(1, 0, At, B0); PG8_BAR; PG8_SCHED;
            PG8_STAGE(PG8_SB(1, 1), b3 + hstepB, voffB);
            PG8_WAIT_V(6); PG8_BAR; PG8_MMA(1, 1, At, B1); PG8_BAR;
            }
        }
        if constexpr (ALIGN_EPI) { if (wr == 0) PG8_BAR; }
        if constexpr (!Epi::AFTER_DRAIN) { E(acc, cur, wr, wc, fr, fq); S.done(cur); }
        if (!has_next) break;
#pragma unroll
        for (int a = 0; a < 2; ++a)
#pragma unroll
            for (int b = 0; b < 2; ++b)
#pragma unroll
                for (int m = 0; m < 4; ++m)
#pragma unroll
                    for (int n = 0; n < 2; ++n) acc[a][b][m][n] = (f32x4){0.f, 0.f, 0.f, 0.f};
        cur = nxt; cA = nA; cB = nB; ++ui;
        if constexpr (ALIGN_EPI) { if (wr == 1) PG8_BAR; }
    }
    PG8_WAIT_V(0);
    if constexpr (!ALIGN_EPI) { if (wr == 0) PG8_BAR; }
    PG8_BAR;
    if constexpr (Epi::AFTER_DRAIN) { E.fused(acc, cur, wr, wc, fr, fq, lds, wid, lane); S.done(cur); }
#undef PG8_SA
#undef PG8_SB
#undef PG8_STAGE
#undef PG8_LDA
#undef PG8_LDB
#undef PG8_MMA
#undef PG8_WAIT_V
#undef PG8_WAIT_L
#undef PG8_BAR
#undef PG8_SCHED
}
}

namespace pg8 {
struct EpiScale {
    static constexpr bool PERM = true, AFTER_DRAIN = false;
    bf16_t* O; int ldo; const float* ssq; float inv_n; int act;
    __device__ __forceinline__ void operator()(const f32x4 (&acc)[2][2][4][2], const Unit& u, int wr, int wc, int fr, int fq) const {
        const int row0 = u.pm * BM + wr * 64 + fr, col0 = u.pn * BM + wc * 32 + 8 * fq;
#pragma unroll
        for (int ai = 0; ai < 2; ++ai)
#pragma unroll
            for (int m = 0; m < 4; ++m) {
                const int row = row0 + ai * HALF + m * 16;
                const float rs = ssq ? rsqrtf(ssq[row] * inv_n + 1e-6f) : 1.f;
                bf16_t* rowp = O + (size_t)row * ldo + col0;
#pragma unroll
                for (int bj = 0; bj < 2; ++bj) {
                    f32x4 v0 = acc[ai][bj][m][0] * rs, v1 = acc[ai][bj][m][1] * rs;
                    if (act == 1) {
#pragma unroll
                        for (int j = 0; j < 4; ++j) { const float a = fmaxf(v0[j], 0.f), b = fmaxf(v1[j], 0.f); v0[j] = a * a; v1[j] = b * b; }
                    }
                    u32x4 w; w.x = ::cvtpk(v0[0], v0[1]); w.y = ::cvtpk(v0[2], v0[3]); w.z = ::cvtpk(v1[0], v1[1]); w.w = ::cvtpk(v1[2], v1[3]);
                    *(u32x4*)(rowp + bj * HALF) = w;
                }
            }
    }
};
struct EpiResid {
    static constexpr bool PERM = false, AFTER_DRAIN = false;
    const float* base; float* out; bf16_t* xb; float* ssq_next;
    __device__ __forceinline__ void operator()(const f32x4 (&acc)[2][2][4][2], const Unit& u, int wr, int wc, int fr, int fq) const {
        const int col0 = u.pn * BM + wc * 32 + 4 * fq;
#pragma unroll
        for (int ai = 0; ai < 2; ++ai)
#pragma unroll
            for (int m = 0; m < 4; ++m) {
                const int row = u.pm * BM + ai * HALF + wr * 64 + m * 16 + fr; const size_t off = (size_t)row * 1024 + col0; float s = 0.f;
#pragma unroll
                for (int bj = 0; bj < 2; ++bj)
#pragma unroll
                    for (int n = 0; n < 2; ++n) {
                        const size_t idx = off + bj * HALF + n * 16;
                        const f32x4 x = *(const f32x4*)(base + idx) + acc[ai][bj][m][n];
                        *(f32x4*)(out + idx) = x; s += (x[0] * x[0] + x[1] * x[1]) + (x[2] * x[2] + x[3] * x[3]);
                        if (xb) { ::u32x2 w; w.x = ::cvtpk(x[0], x[1]); w.y = ::cvtpk(x[2], x[3]); *(::u32x2*)(xb + idx) = w; }
                    }
                if (ssq_next) { s += __shfl_xor(s, 16); s += __shfl_xor(s, 32); if (fq == 0) atomicAdd(ssq_next + row, s); }
            }
    }
};
}

#define XB_TMO      128
#define XB_XCNT(j)  (256  + 64 * (j))
#define XB_XSUB(j)  (1280 + 64 * (j))
#define XB_XGEN(j)  (2304 + 64 * (j))
#define XB_TOP      3328
#define XB_TOPGEN   3392
#define XCD_BAR_WORDS 3456
#define XB_SPIN_CAP (1u << 18)

__device__ __forceinline__ unsigned xb_ld(unsigned* p)              { return __hip_atomic_load(p, __ATOMIC_RELAXED, __HIP_MEMORY_SCOPE_AGENT); }
__device__ __forceinline__ unsigned xb_add(unsigned* p, unsigned v) { return __hip_atomic_fetch_add(p, v, __ATOMIC_RELAXED, __HIP_MEMORY_SCOPE_AGENT); }
__device__ __forceinline__ unsigned xb_xcc_id() { return (unsigned)__builtin_amdgcn_s_getreg((3 << 11) | 20) & 0xFu; }
#define XB_SPIN(cond, bar) do { unsigned _sp = 0; while (cond) { __builtin_amdgcn_s_sleep(1); \
    if ((++_sp & 255u) == 0u) { if (xb_ld(&(bar)[XB_TMO])) break; if (_sp > XB_SPIN_CAP) { atomicAdd(&(bar)[XB_TMO], 1u); break; } } } } while (0)

struct XcdBarrier {
    unsigned* bar; unsigned x;
    volatile LAS unsigned* st;
};

__device__ __forceinline__ XcdBarrier xcd_barrier_post(unsigned* bar, volatile LAS unsigned* st) {
    XcdBarrier b; b.bar = bar; b.x = xb_xcc_id(); b.st = st;
    if (threadIdx.x == 0) (void)xb_add(&bar[XB_XCNT(b.x)], 1u);
    return b;
}
__device__ __forceinline__ void xcd_barrier_complete(unsigned* bar, unsigned x, unsigned& nloc, unsigned& nx) {
    const unsigned G = gridDim.x * gridDim.y * gridDim.z;
    unsigned sum, cnt, mine, sp = 0u;
    for (;;) {
        sum = 0u; cnt = 0u; mine = 0u;
#pragma unroll
        for (unsigned j = 0; j < 16; ++j) { const unsigned c = xb_ld(&bar[XB_XCNT(j)]); sum += c; cnt += (c > 0u) ? 1u : 0u; mine = (j == x) ? c : mine; }
        if (sum == G) break;
        __builtin_amdgcn_s_sleep(1);
        if ((++sp & 255u) == 0u) { if (xb_ld(&bar[XB_TMO])) break; if (sp > XB_SPIN_CAP) { atomicAdd(&bar[XB_TMO], 1u); break; } }
    }
    nloc = mine > 0u ? mine : 1u; nx = cnt > 0u ? cnt : 1u;
}

__device__ __forceinline__ void xcd_barrier(const XcdBarrier& b) {
    asm volatile("s_waitcnt vmcnt(0)" ::: "memory");
    __syncthreads();
    if (threadIdx.x == 0) {
        unsigned* bar = b.bar;
        __builtin_amdgcn_s_waitcnt(0);
        unsigned nloc = b.st[0], nx = b.st[1];
        if (nloc == 0u) { xcd_barrier_complete(bar, b.x, nloc, nx); b.st[0] = nloc; b.st[1] = nx; }
        const unsigned old = xb_add(&bar[XB_XSUB(b.x)], 1u);
        const unsigned gen = old / nloc;
        if (old + 1u == (gen + 1u) * nloc) {
            __builtin_amdgcn_fence(__ATOMIC_RELEASE, "agent");
            asm volatile("s_waitcnt vmcnt(0)" ::: "memory");
            const unsigned og = xb_add(&bar[XB_TOP], 1u);
            const unsigned tg = og / nx;
            if (og + 1u == (tg + 1u) * nx) xb_add(&bar[XB_TOPGEN], 1u);
            else XB_SPIN(xb_ld(&bar[XB_TOPGEN]) == tg, bar);
            __builtin_amdgcn_fence(__ATOMIC_ACQUIRE, "agent");
            xb_add(&bar[XB_XGEN(b.x)], 1u);
            asm volatile("s_waitcnt vmcnt(0)" ::: "memory");
        } else {
            XB_SPIN(xb_ld(&bar[XB_XGEN(b.x)]) == gen, bar);
            __builtin_amdgcn_fence(__ATOMIC_ACQUIRE, "agent");
            asm volatile("s_waitcnt vmcnt(0)" ::: "memory");
        }
    }
    __syncthreads();
}
constexpr int NPHASE = 22;
constexpr size_t WS_BAR = 1 * MiB;
constexpr int MISC_OFF = 131072 + 320;
#ifndef MK_CGSYNC
#define MK_CGSYNC 0
#endif
template <class Epi, bool ALIGN>
DEVI void run_gemm(LAS unsigned char* lds, const bf16_t* A, int lda, const bf16_t* Bt, int M, int N, int K, const Epi& E) {
    pg8::Gemm g{A, lda, Bt, M, N, K}; pg8::StaticOrder So; So.init(M, N, (int)gridDim.x, (int)blockIdx.x);
    pg8::gemm_phase<Epi, pg8::StaticOrder, ALIGN, true>(lds, g, So, E);
}
__global__ void __launch_bounds__(NTHR, 2) mega(Params P, int ph_lo, int ph_hi) {
    extern __shared__ __attribute__((aligned(16))) unsigned char lds_raw[];
    LAS unsigned char* lds = (LAS unsigned char*)lds_raw;
    cg::grid_group grid = cg::this_grid();
    unsigned char* ws = P.ws;
    const int G = gridDim.x, bx = blockIdx.x;
    float* ssq = (float*)(ws + WS_SSQ);
    bf16_t* XB = (bf16_t*)(ws + WS_XB);
    bf16_t* Y = (bf16_t*)(ws + WS_Y);
    volatile LAS unsigned* MISC = (volatile LAS unsigned*)(lds + MISC_OFF);
    if (threadIdx.x < 32) MISC[threadIdx.x] = 0u;
    __syncthreads();
    XcdBarrier bar; bar.bar = (unsigned*)(ws + WS_BAR); bar.x = 0; bar.st = nullptr;
    if (ph_hi - ph_lo > 1) bar = xcd_barrier_post((unsigned*)(ws + WS_BAR), MISC + 8);
#define PH_BEGIN(k) if (ph_lo <= (k) && (k) < ph_hi) {
#define PH_END(k) if ((k) + 1 < ph_hi) { if (MK_CGSYNC || (k) == 0) grid.sync(); else xcd_barrier(bar); } }
    using pg8::EpiScale; using pg8::EpiResid;
    PH_BEGIN(0) phase_prologue(P, lds); PH_END(0)
    PH_BEGIN(1)
        run_gemm<EpiScale, true>(lds, (const bf16_t*)(ws + WS_XB), 1024, (const bf16_t*)(ws + W_INE), T, LDP, 1024, EpiScale{(bf16_t*)(ws + WS_PROJ), LDP, ssq, 1.f / 1024.f, 0});
        for (int l = 0; l < 2; ++l)
            gemm_simple((const bf16_t*)(ws + WS_MB), 1024, (const bf16_t*)(ws + W_KVX) + (size_t)l * 1024 * 1024, 1024, MEMT, 1024, 1024,
                        EpiStore{(bf16_t*)(ws + WS_KVX) + (size_t)l * MEMT * 1024, 1024, (const float*)(ws + WS_SSQMEM), 1.f / 1024.f, 0});
    PH_END(1)
    PH_BEGIN(2) phase_post0(P); PH_END(2)
    PH_BEGIN(3) run_gemm<EpiScale, false>(lds, (const bf16_t*)(ws + WS_PROJ) + C_CKV, LDP, (const bf16_t*)(ws + W_KVUP), T, 1024, 256, EpiScale{(bf16_t*)(ws + WS_KBVB), 1024, (const float*)(ws + WS_SSQCKV), 1.f / 256.f, 0}); PH_END(3)
    PH_BEGIN(4) phase_postkb(P); PH_END(4)
    PH_BEGIN(5)
        for (int u = bx; u < 256; u += G) { const int bhc = u >> 3, s = u & 7, b = bhc >> 3, h = (bhc >> 1) & 3, c = bhc & 1;
            attnA_unit(P, b, h, c, s, lds); attnA_unit(P, b, h, c, 15 - s, lds); }
        for (int u = bx; u < 2048; u += G) { const int k = u / 256, c = u % 256, b = k >> 1; const int blk = (k & 1) ? (511 - c) : c;
            indexer_unit(P, b, blk * 8, lds); }
    PH_END(5)
    PH_BEGIN(6)
        for (int u = bx; u < 256; u += G) { const int bh = u >> 3, s = u & 7, b = bh >> 3, hd = bh & 7;
            attnB_unit(P, b, hd, s, lds); attnB_unit(P, b, hd, 15 - s, lds); }
        combineA_rows(P);
    PH_END(6)
    PH_BEGIN(7) run_gemm<EpiResid, false>(lds, Y, 1024, (const bf16_t*)(ws + W_OUTE), T, 1024, 1024, EpiResid{P.in[0], P.out, XB, ssq + 1 * T}); PH_END(7)
#define XATTN_MLP(l, p0)                                                                                                                                                      \
    PH_BEGIN(p0) run_gemm<EpiScale, false>(lds, XB, 1024, (const bf16_t*)(ws + W_QX) + (size_t)(l) * 512 * 1024, T, 512, 1024, EpiScale{(bf16_t*)(ws + WS_QX), 512, ssq + ((l) ? 4 : 1) * T, 1.f / 1024.f, 0}); PH_END(p0) \
    PH_BEGIN(p0 + 1) for (int u = bx; u < 256; u += G) { const int b = u >> 6, hd = (u >> 4) & 3, qb = u & 15; xattn_unit(P, (l), b, hd, qb, lds); } PH_END(p0 + 1)                                 \
    PH_BEGIN(p0 + 2) run_gemm<EpiResid, false>(lds, (const bf16_t*)(ws + WS_YX), 512, (const bf16_t*)(ws + W_OX) + (size_t)(l) * 1024 * 512, T, 1024, 512, EpiResid{P.out, P.out, XB, ssq + ((l) ? 5 : 2) * T}); PH_END(p0 + 2) \
    PH_BEGIN(p0 + 3) run_gemm<EpiScale, true>(lds, XB, 1024, (const bf16_t*)(ws + W_UP) + (size_t)(l) * 4096 * 1024, T, DFF, 1024, EpiScale{(bf16_t*)(ws + WS_H), DFF, ssq + ((l) ? 5 : 2) * T, 1.f / 1024.f, 1}); PH_END(p0 + 3)
    XATTN_MLP(0, 8)
    PH_BEGIN(12) run_gemm<EpiResid, false>(lds, (const bf16_t*)(ws + WS_H), DFF, (const bf16_t*)(ws + W_DOWN), T, 1024, DFF, EpiResid{P.out, P.out, XB, ssq + 3 * T}); PH_END(12)
    PH_BEGIN(13) run_gemm<EpiScale, true>(lds, XB, 1024, (const bf16_t*)(ws + W_INO), T, 2048, 1024, EpiScale{(bf16_t*)(ws + WS_PROJ1), 2048, ssq + 3 * T, 1.f / 1024.f, 0}); PH_END(13)
    PH_BEGIN(14) phase_mix1(P); PH_END(14)
    PH_BEGIN(15) run_gemm<EpiScale, false>(lds, (const bf16_t*)(ws + WS_POOLED), 512, (const bf16_t*)(ws + W_POOL), T, 512, 512, EpiScale{Y + 512, 1024, nullptr, 0.f, 0}); PH_END(15)
    PH_BEGIN(16) run_gemm<EpiResid, false>(lds, Y, 1024, (const bf16_t*)(ws + W_OUTO), T, 1024, 1024, EpiResid{P.out, P.out, XB, ssq + 4 * T}); PH_END(16)
    XATTN_MLP(1, 17)
    PH_BEGIN(21) run_gemm<EpiResid, false>(lds, (const bf16_t*)(ws + WS_H), DFF, (const bf16_t*)(ws + W_DOWN) + (size_t)1024 * 4096, T, 1024, DFF, EpiResid{P.out, P.out, nullptr, nullptr}); PH_END(21)
}

#ifndef MK_MULTI
#define MK_MULTI 0
#endif
extern "C" void kernel_launch(void* const* d_in, const int* in_sizes, int n_in, void* d_out, int out_size, void* d_ws, size_t ws_size, hipStream_t stream) {
    static int grid = 0;
    if (grid == 0) {
        if (n_in != 33 || out_size != T * D || ws_size < WS_END) { fprintf(stderr, "kernel_launch: unexpected shapes (n_in %d out %d ws %zu)\n", n_in, out_size, ws_size); grid = -1; return; }
        int dev = 0, cus = 0, per_cu = 0;
        hipGetDevice(&dev); hipDeviceGetAttribute(&cus, hipDeviceAttributeMultiprocessorCount, dev);
        hipFuncSetAttribute((const void*)mega, hipFuncAttributeMaxDynamicSharedMemorySize, LDS_BYTES);
        hipOccupancyMaxActiveBlocksPerMultiprocessor(&per_cu, (const void*)mega, NTHR, LDS_BYTES);
        if (per_cu < 1) { fprintf(stderr, "kernel_launch: occupancy query says %d blocks/CU\n", per_cu); per_cu = 1; }
        (void)hipGetLastError();
        grid = cus * 1;
    }
    if (grid < 0) return;
    Params p{};
    for (int i = 0; i < 33; ++i) p.in[i] = (const float*)d_in[i];
    p.out = (float*)d_out; p.ws = (unsigned char*)d_ws;
    (void)hipMemsetAsync((char*)d_ws + WS_BAR, 0, XCD_BAR_WORDS * 4, stream);
#if MK_MULTI
    for (int ph = 0; ph < NPHASE; ++ph) hipLaunchKernelGGL(mega, dim3(grid), dim3(NTHR), LDS_BYTES, stream, p, ph, ph + 1);
#else
    int lo = 0, hi = NPHASE;
    void* args[] = {&p, &lo, &hi};
    hipError_t e = hipLaunchCooperativeKernel((const void*)mega, dim3(grid), dim3(NTHR), args, LDS_BYTES, stream);
    if (e != hipSuccess) fprintf(stderr, "cooperative launch failed: %s (grid %d)\n", hipGetErrorString(e), grid);
#endif
}
```

```cpp
#include <hip/hip_runtime.h>
#include <hip/hip_cooperative_groups.h>
#include <cstdio>
#include <cstdint>
namespace cg = cooperative_groups;

#define DEVI __device__ __forceinline__
#define LAS __attribute__((address_space(3)))
typedef unsigned short bf16_t;
typedef short bf16x8 __attribute__((ext_vector_type(8)));
typedef short s16x4 __attribute__((ext_vector_type(4)));
typedef float f32x2 __attribute__((ext_vector_type(2)));
typedef float f32x4 __attribute__((ext_vector_type(4)));
typedef float f32x16 __attribute__((ext_vector_type(16)));
typedef unsigned u32x2 __attribute__((ext_vector_type(2)));
typedef unsigned u32x4 __attribute__((ext_vector_type(4)));
typedef unsigned long long u64;

constexpr int NB = 4, S = 4096, T = NB * S, D = 1024, DFF = 4096, MEML = 256, MEMT = NB * MEML;
constexpr int LDP = 2816;
constexpr int C_QA = 0, C_KA = 512, C_VA = 1024, C_QB = 1536, C_CKV = 2048, C_QI = 2304, C_KI = 2560, C_WI = 2624, EVEN_IN = 2628;
constexpr float EPS = 1e-6f;
constexpr float LOG2E = 1.4426950408889634f;
constexpr int NTHR = 512, NWAVE = 8;
constexpr int LDS_BYTES = 147456;

constexpr size_t MiB = 1u << 20;
constexpr size_t WS_SSQ = 0;
constexpr size_t WS_SSQCKV = WS_SSQ + 6ull * T * 4;
constexpr size_t WS_SSQMEM = WS_SSQCKV + (size_t)T * 4;
constexpr size_t WS_WI = 512 * 1024;
constexpr size_t WS_W = 2 * MiB;
constexpr size_t W_INE = WS_W;
constexpr size_t W_KVUP = W_INE + (size_t)LDP * 1024 * 2;
constexpr size_t W_OUTE = W_KVUP + 1024ull * 256 * 2;
constexpr size_t W_QX = W_OUTE + 1024ull * 1024 * 2;
constexpr size_t W_KVX = W_QX + 2 * 512ull * 1024 * 2;
constexpr size_t W_OX = W_KVX + 2 * 1024ull * 1024 * 2;
constexpr size_t W_UP = W_OX + 2 * 1024ull * 512 * 2;
constexpr size_t W_DOWN = W_UP + 2 * 4096ull * 1024 * 2;
constexpr size_t W_INO = W_DOWN + 2 * 4096ull * 1024 * 2;
constexpr size_t W_POOL = W_INO + 2048ull * 1024 * 2;
constexpr size_t W_OUTO = W_POOL + 512ull * 512 * 2;
constexpr size_t W_END = W_OUTO + 1024ull * 1024 * 2;
static_assert(W_END <= 57 * MiB, "weights region");
constexpr size_t WS_XB = 57 * MiB;
constexpr size_t WS_PROJ = 89 * MiB;
constexpr size_t WS_KBVB = 177 * MiB;
constexpr size_t WS_MASK = 209 * MiB;
constexpr size_t WS_Y = 217 * MiB;
constexpr size_t WS_CS = 249 * MiB;
constexpr size_t WS_MB = 250 * MiB;
constexpr size_t WS_KVX = 252 * MiB;
constexpr size_t WS_END = 256 * MiB;
constexpr size_t WS_QX = WS_PROJ;
constexpr size_t WS_YX = WS_PROJ + 16 * MiB;
constexpr size_t WS_H = WS_PROJ;
constexpr size_t WS_PROJ1 = WS_PROJ;
constexpr size_t WS_POOLED = WS_PROJ + 64 * MiB;
constexpr size_t WS_KI = WS_Y;

struct Params { const float* in[33]; float* out; unsigned char* ws; };

DEVI float bf2f(bf16_t v) { return __uint_as_float(((unsigned)v) << 16); }
DEVI unsigned f2bf(float f) { unsigned u = __float_as_uint(f); return (u + 0x7fffu + ((u >> 16) & 1u)) >> 16; }
DEVI unsigned pk2(float lo, float hi) { return f2bf(lo) | (f2bf(hi) << 16); }
DEVI float wave_sum(float v) {
#pragma unroll
    for (int o = 1; o < 64; o <<= 1) v += __shfl_xor(v, o);
    return v;
}
DEVI float lo16(unsigned w) { return __uint_as_float(w << 16); }
DEVI float hi16(unsigned w) { return __uint_as_float(w & 0xffff0000u); }
#define LDS_WAIT() asm volatile("s_waitcnt lgkmcnt(0)" ::: "memory")

struct TrD { const float* src; bf16_t* dst; const float* sk; const float* sn; int K, N, ldd; };
constexpr int NTR = 19;
DEVI TrD get_tr(const Params& P, int i) {
    unsigned char* ws = P.ws; TrD d; d.sk = nullptr; d.sn = nullptr;
    switch (i) {
    case 0: d.src = P.in[14]; d.dst = (bf16_t*)(ws + W_INE); d.K = 1024; d.N = EVEN_IN; d.ldd = 1024; d.sk = P.in[3]; break;
    case 1: d.src = P.in[23]; d.dst = (bf16_t*)(ws + W_KVUP); d.K = 256; d.N = 1024; d.ldd = 256; d.sk = P.in[22]; break;
    case 2: d.src = P.in[27]; d.dst = (bf16_t*)(ws + W_OUTE); d.K = 1024; d.N = 1024; d.ldd = 1024; break;
    case 3: case 4: { int l = i - 3; d.src = P.in[7] + (size_t)l * 1024 * 512; d.dst = (bf16_t*)(ws + W_QX) + (size_t)l * 512 * 1024; d.K = 1024; d.N = 512; d.ldd = 1024; d.sk = P.in[4] + l * 1024; } break;
    case 5: case 6: { int l = i - 5; d.src = P.in[8] + (size_t)l * 1024 * 1024; d.dst = (bf16_t*)(ws + W_KVX) + (size_t)l * 1024 * 1024; d.K = 1024; d.N = 1024; d.ldd = 1024; d.sk = P.in[5] + l * 1024; } break;
    case 7: case 8: { int l = i - 7; d.src = P.in[11] + (size_t)l * 512 * 1024; d.dst = (bf16_t*)(ws + W_OX) + (size_t)l * 1024 * 512; d.K = 512; d.N = 1024; d.ldd = 512; } break;
    case 9: case 10: { int l = i - 9; d.src = P.in[12] + (size_t)l * 1024 * 4096; d.dst = (bf16_t*)(ws + W_UP) + (size_t)l * 4096 * 1024; d.K = 1024; d.N = 4096; d.ldd = 1024; d.sk = P.in[6] + l * 1024; } break;
    case 11: case 12: { int l = i - 11; d.src = P.in[13] + (size_t)l * 4096 * 1024; d.dst = (bf16_t*)(ws + W_DOWN) + (size_t)l * 1024 * 4096; d.K = 4096; d.N = 1024; d.ldd = 4096; } break;
    case 13: d.src = P.in[28]; d.dst = (bf16_t*)(ws + W_INO); d.K = 1024; d.N = 2048; d.ldd = 1024; d.sk = P.in[3] + 1024; break;
    case 14: case 15: case 16: case 17: { int g = i - 14; d.src = P.in[30] + (size_t)g * 128 * 128; d.dst = (bf16_t*)(ws + W_POOL) + (size_t)(g * 128) * 512 + g * 128; d.K = 128; d.N = 128; d.ldd = 512; d.sn = P.in[31] + g * 128; } break;
    default: d.src = P.in[32]; d.dst = (bf16_t*)(ws + W_OUTO); d.K = 1024; d.N = 1024; d.ldd = 1024; break;
    }
    return d;
}
DEVI int tr_items(const TrD& d) { return (d.K / 64) * ((d.N + 31) / 32); }
template <bool SK, bool SN>
DEVI void tr_item(const TrD& d, LAS float* scr, int item, int lane) {
    const int nblk = (d.N + 31) / 32, kb = item / nblk, nb = item % nblk, k0 = 64 * kb, n0 = 32 * nb;
    const int n = n0 + (lane & 31), nc = (n < d.N) ? n : (d.N - 1);
    const float* sp = d.src + (size_t)(k0 + (lane >> 5)) * d.N + nc;
    float v[32], sk[32];
#pragma unroll
    for (int i = 0; i < 32; ++i) { v[i] = sp[(size_t)(2 * i) * d.N]; if (SK) sk[i] = d.sk[k0 + 2 * i + (lane >> 5)]; }
#pragma unroll
    for (int i = 0; i < 32; ++i) { float x = v[i]; if (SK) x *= sk[i]; if (n >= d.N) x = 0.f; scr[(2 * i + (lane >> 5)) * 33 + (lane & 31)] = x; }
    LDS_WAIT(); asm volatile("" ::: "memory");
    const int c = lane & 7;
#pragma unroll
    for (int j = 0; j < 4; ++j) {
        const int nn = (lane >> 3) + 8 * j, ncl = (n0 + nn < d.N) ? (n0 + nn) : (d.N - 1);
        const LAS float* s = scr + (8 * c) * 33 + nn;
        float sc = 1.f; if (SN) sc = d.sn[ncl];
        u32x4 o; o.x = pk2(s[0 * 33] * sc, s[1 * 33] * sc); o.y = pk2(s[2 * 33] * sc, s[3 * 33] * sc); o.z = pk2(s[4 * 33] * sc, s[5 * 33] * sc); o.w = pk2(s[6 * 33] * sc, s[7 * 33] * sc);
        if (n0 + nn < d.N) *(u32x4*)(d.dst + (size_t)(n0 + nn) * d.ldd + k0 + 8 * c) = o;
    }
    LDS_WAIT(); asm volatile("" ::: "memory");
}
DEVI void row_to_bf16_ssq(const float* xrow, bf16_t* orow, float* ssq_out, int lane) {
    const f32x4* xr = (const f32x4*)xrow + lane;
    f32x4 v[4]; float s = 0.f;
#pragma unroll
    for (int j = 0; j < 4; ++j) { v[j] = xr[64 * j]; s += (v[j].x * v[j].x + v[j].y * v[j].y) + (v[j].z * v[j].z + v[j].w * v[j].w); }
    s = wave_sum(s);
    if (lane == 0) *ssq_out = s;
    u32x2* o8 = (u32x2*)orow + lane;
#pragma unroll
    for (int j = 0; j < 4; ++j) { u32x2 w; w.x = pk2(v[j].x, v[j].y); w.y = pk2(v[j].z, v[j].w); o8[64 * j] = w; }
}
#ifndef MK_SUB
#define MK_SUB 0
#endif
DEVI void phase_prologue(const Params& P, LAS unsigned char* lds, int dry = 0) {
    const int tid = threadIdx.x, lane = tid & 63, wave = tid >> 6;
    const int gw = blockIdx.x * NWAVE + wave, NGW = gridDim.x * NWAVE;
    const int gt = blockIdx.x * NTHR + tid, NGT = gridDim.x * NTHR;
    unsigned char* ws = P.ws;
    LAS float* scr = (LAS float*)(lds + wave * 16384);
    int base = 0;
    if (!(dry && MK_SUB != 1 && MK_SUB != 0))
    for (int i = 0; i < NTR; ++i) {
        const TrD d = get_tr(P, i); const int n = tr_items(d);
        int first = gw - (base % NGW); if (first < 0) first += NGW;
        if (d.sn) { for (int it = first; it < n; it += NGW) tr_item<false, true>(d, scr, it, lane); }
        else if (d.sk) { for (int it = first; it < n; it += NGW) tr_item<true, false>(d, scr, it, lane); }
        else { for (int it = first; it < n; it += NGW) tr_item<false, false>(d, scr, it, lane); }
        base += n;
    }
    { bf16_t* w = (bf16_t*)(ws + W_INE) + (size_t)EVEN_IN * 1024; const int n = (LDP - EVEN_IN) * 1024 / 8;
      for (int i = gt; i < n; i += NGT) ((u32x4*)w)[i] = (u32x4){0u, 0u, 0u, 0u}; }
    { bf16_t* w = (bf16_t*)(ws + W_POOL); for (int i = gt; i < 512 * 512 / 8; i += NGT) { const int n = i / 64, k = (i % 64) * 8; if ((n >> 7) != (k >> 7)) ((u32x4*)w)[i] = (u32x4){0u, 0u, 0u, 0u}; } }
    { float* q = (float*)(ws + WS_SSQ) + T; for (int i = gt; i < 5 * T; i += NGT) q[i] = 0.f; }
    if (!(dry && MK_SUB != 2 && MK_SUB != 0))
    for (int m = gw; m < T; m += NGW) row_to_bf16_ssq(P.in[0] + (size_t)m * D, (bf16_t*)(ws + WS_XB) + (size_t)m * D, (float*)(ws + WS_SSQ) + m, lane);
    for (int m = gw; m < MEMT; m += NGW) row_to_bf16_ssq(P.in[1] + (size_t)m * D, (bf16_t*)(ws + WS_MB) + (size_t)m * D, (float*)(ws + WS_SSQMEM) + m, lane);
    if (!(dry && MK_SUB != 3 && MK_SUB != 0))
    { const int* pos = (const int*)P.in[2]; float* cs = (float*)(ws + WS_CS);
      for (int i = gt; i < T * 8; i += NGT) { const int m = i >> 3, f = i & 7;
        const double inv = (f == 0) ? 1.0 : (f == 1) ? 0.19392274474868576 : (f == 2) ? 0.03760603093086393 : (f == 3) ? 0.007292664737217109 : (f == 4) ? 0.001414213562373095
                         : (f == 5) ? 0.0002742481756762073 : (f == 6) ? 5.318295896944988e-05 : 1.031338537721246e-05;
        const double ang = (double)pos[m] * inv, k = rint(ang * 0.15915494309189535), r = fma(-k, 6.283185307179586, ang) - k * 2.4492935982947064e-16;
        cs[m * 16 + f] = cosf((float)r); cs[m * 16 + 8 + f] = sinf((float)r); } }
}

struct EpiStore {
    bf16_t* O; int ldo; const float* ssq; float inv_n; int act;
    DEVI void operator()(const f32x4 (&acc)[4][4], int row0, int col0, int lane) const {
#pragma unroll
        for (int m = 0; m < 4; ++m)
#pragma unroll
            for (int i = 0; i < 4; ++i) {
                const int row = row0 + 16 * m + (lane >> 4) * 4 + i;
                const float rs = ssq ? rsqrtf(ssq[row] * inv_n + EPS) : 1.f;
#pragma unroll
                for (int n = 0; n < 4; ++n) {
                    float v = acc[m][n][i] * rs;
                    if (act == 1) { v = fmaxf(v, 0.f); v = v * v; }
                    O[(size_t)row * ldo + col0 + 16 * n + (lane & 15)] = (bf16_t)f2bf(v);
                }
            }
    }
};
struct EpiRes {
    const float* base; float* out; bf16_t* xb; float* ssq_next;
    DEVI void operator()(const f32x4 (&acc)[4][4], int row0, int col0, int lane) const {
#pragma unroll
        for (int m = 0; m < 4; ++m)
#pragma unroll
            for (int i = 0; i < 4; ++i) {
                const int row = row0 + 16 * m + (lane >> 4) * 4 + i; float s = 0.f;
#pragma unroll
                for (int n = 0; n < 4; ++n) {
                    const size_t idx = (size_t)row * D + col0 + 16 * n + (lane & 15);
                    const float v = base[idx] + acc[m][n][i];
                    out[idx] = v; s += v * v;
                    if (xb) xb[idx] = (bf16_t)f2bf(v);
                }
                if (ssq_next) {
                    s += __shfl_xor(s, 1); s += __shfl_xor(s, 2); s += __shfl_xor(s, 4); s += __shfl_xor(s, 8);
                    if ((lane & 15) == 0) atomicAdd(ssq_next + row, s);
                }
            }
    }
};
template <class Epi>
DEVI void gemm_simple(const bf16_t* A, int lda, const bf16_t* Bt, int ldb, int M, int N, int K, const Epi& epi) {
    const int tid = threadIdx.x, lane = tid & 63, wave = tid >> 6;
    const int gw = blockIdx.x * NWAVE + wave, NGW = gridDim.x * NWAVE;
    const int nN = N / 64, ntiles = (M / 64) * nN;
    for (int tile = gw; tile < ntiles; tile += NGW) {
        const int row0 = (tile / nN) * 64, col0 = (tile % nN) * 64;
        f32x4 acc[4][4];
#pragma unroll
        for (int m = 0; m < 4; ++m)
#pragma unroll
            for (int n = 0; n < 4; ++n) acc[m][n] = (f32x4){0.f, 0.f, 0.f, 0.f};
        const bf16_t* ap = A + (size_t)(row0 + (lane & 15)) * lda + 8 * (lane >> 4);
        const bf16_t* bp = Bt + (size_t)(col0 + (lane & 15)) * ldb + 8 * (lane >> 4);
        for (int k0 = 0; k0 < K; k0 += 32) {
            bf16x8 a[4], b[4];
#pragma unroll
            for (int m = 0; m < 4; ++m) a[m] = *(const bf16x8*)(ap + (size_t)(16 * m) * lda + k0);
#pragma unroll
            for (int n = 0; n < 4; ++n) b[n] = *(const bf16x8*)(bp + (size_t)(16 * n) * ldb + k0);
#pragma unroll
            for (int m = 0; m < 4; ++m)
#pragma unroll
                for (int n = 0; n < 4; ++n) acc[m][n] = __builtin_amdgcn_mfma_f32_16x16x32_bf16(a[m], b[n], acc[m][n], 0, 0, 0);
        }
        epi(acc, row0, col0, lane);
    }
}

DEVI void head64(bf16_t* p, const float* g, bool do_norm, bool do_rope, float scale, float cosv, float sinv, int lane) {
    float v = bf2f(p[lane]);
    if (do_norm) { const float ss = wave_sum(v * v); v = v * rsqrtf(ss * (1.f / 64.f) + EPS) * g[lane]; }
    if (do_rope) { const float o = __shfl_xor(v, 8); if (lane < 8) v = v * cosv - o * sinv; else if (lane < 16) v = v * cosv + o * sinv; }
    p[lane] = (bf16_t)f2bf(v * scale);
}
DEVI void phase_post0(const Params& P) {
    const int tid = threadIdx.x, lane = tid & 63, wave = tid >> 6;
    const int gw = blockIdx.x * NWAVE + wave, NGW = gridDim.x * NWAVE;
    unsigned char* ws = P.ws;
    const float qscale = 0.125f * LOG2E;
    for (int m = gw; m < T; m += NGW) {
        bf16_t* row = (bf16_t*)(ws + WS_PROJ) + (size_t)m * LDP;
        const float* cs = (const float*)(ws + WS_CS) + (size_t)m * 16;
        const float cosv = cs[lane & 7], sinv = cs[8 + (lane & 7)];
        for (int h = 0; h < 8; ++h) head64(row + C_QA + 64 * h, P.in[15], true, true, qscale, cosv, sinv, lane);
        for (int h = 0; h < 8; ++h) head64(row + C_KA + 64 * h, P.in[16], true, true, 1.f, cosv, sinv, lane);
        for (int h = 0; h < 8; ++h) head64(row + C_QB + 64 * h, P.in[24], true, true, qscale, cosv, sinv, lane);
        for (int h = 0; h < 4; ++h) head64(row + C_QI + 64 * h, nullptr, false, true, 1.f, cosv, sinv, lane);
        { float v = bf2f(row[C_KI + lane]);
          const float ss = wave_sum(v * v); v = v * rsqrtf(ss * (1.f / 64.f) + EPS) * P.in[26][lane];
          const float o = __shfl_xor(v, 8); if (lane < 8) v = v * cosv - o * sinv; else if (lane < 16) v = v * cosv + o * sinv;
          ((bf16_t*)(ws + WS_KI))[(size_t)(m >> 5) * 2048 + (lane >> 4) * 512 + ((((lane >> 3) & 1) * 32 + (m & 31)) * 8) + (lane & 7)] = (bf16_t)f2bf(v); }
        { float s = 0.f;
#pragma unroll
          for (int j = 0; j < 4; ++j) { const float v = bf2f(row[C_CKV + 64 * j + lane]); s += v * v; }
          s = wave_sum(s); if (lane == 0) ((float*)(ws + WS_SSQCKV))[m] = s; }
        if (lane < 4) ((float*)(ws + WS_WI))[(size_t)m * 4 + lane] = bf2f(row[C_WI + lane]) * (1.f / 16.f);
    }
    for (int it = gw; it < 2 * MEMT; it += NGW) {
        const int l = it / MEMT, m = it % MEMT;
        bf16_t* row = (bf16_t*)(ws + WS_KVX) + (size_t)m * 2048 + l * 1024;
        const float* g = P.in[10] + l * 128;
        for (int h = 0; h < 4; ++h) {
            float v0 = bf2f(row[128 * h + lane]), v1 = bf2f(row[128 * h + 64 + lane]);
            const float ss = wave_sum(v0 * v0 + v1 * v1), rs = rsqrtf(ss * (1.f / 128.f) + EPS);
            row[128 * h + lane] = (bf16_t)f2bf(v0 * rs * g[lane]); row[128 * h + 64 + lane] = (bf16_t)f2bf(v1 * rs * g[64 + lane]);
        }
    }
}
DEVI void phase_postkb(const Params& P) {
    const int tid = threadIdx.x, lane = tid & 63, wave = tid >> 6;
    const int gw = blockIdx.x * NWAVE + wave, NGW = gridDim.x * NWAVE;
    unsigned char* ws = P.ws;
    for (int m = gw; m < T; m += NGW) {
        bf16_t* row = (bf16_t*)(ws + WS_KBVB) + (size_t)m * 1024;
        const float* cs = (const float*)(ws + WS_CS) + (size_t)m * 16;
        const float cosv = cs[lane & 7], sinv = cs[8 + (lane & 7)];
        for (int h = 0; h < 8; ++h) head64(row + 64 * h, P.in[25], true, true, 1.f, cosv, sinv, lane);
    }
}

DEVI unsigned cvtpk(float lo, float hi) { typedef __bf16 bf2 __attribute__((ext_vector_type(2))); f32x2 v = {lo, hi}; bf2 b = __builtin_convertvector(v, bf2); return __builtin_bit_cast(unsigned, b); }
DEVI int crow(int r, int hi) { return (r & 3) + 8 * (r >> 2) + 4 * hi; }
typedef short v4i16_t __attribute__((ext_vector_type(4)));
DEVI s16x4 vtr(LAS const unsigned char* p) { return __builtin_bit_cast(s16x4, __builtin_amdgcn_ds_read_tr16_b64_v4i16((LAS v4i16_t*)p)); }

template <int DQK, int DV, int MODE>
DEVI void attn_core(f32x16 (&o)[DV / 32], float& m_run, float& l_run, const bf16x8 (&qf)[DQK / 16],
                    const bf16_t* Kg, int ldk, const bf16_t* Vg, int ldv, int ntiles, int qpos, int qpos_wmin,
                    const u64* mrow, LAS unsigned char* lds, int tid) {
    constexpr int KROWB = DQK * 2, KCPR = DQK / 8, VP = (DV == 128) ? 320 : 192, VCPR = DV / 8;
    constexpr int KBUF = 64 * KROWB, VBUF = 64 * VP, KCH = 64 * KCPR / NTHR, VCH = 64 * VCPR / NTHR;
    LAS unsigned char* Kl = lds; LAS unsigned char* Vl = lds + 2 * KBUF;
    const int lane = tid & 63, r32 = lane & 31, hi = lane >> 5;
    u32x4 kreg[KCH], vreg[VCH];
#define A_GLOAD(t) do { _Pragma("unroll") for (int i_ = 0; i_ < KCH; ++i_) { const int c_ = tid + NTHR * i_, row_ = c_ / KCPR, ch_ = c_ % KCPR; kreg[i_] = *(const u32x4*)(Kg + (size_t)(64 * (t) + row_) * ldk + ch_ * 8); } \
        _Pragma("unroll") for (int i_ = 0; i_ < VCH; ++i_) { const int c_ = tid + NTHR * i_, row_ = c_ / VCPR, ch_ = c_ % VCPR; vreg[i_] = *(const u32x4*)(Vg + (size_t)(64 * (t) + row_) * ldv + ch_ * 8); } } while (0)
#define A_LSTORE(buf) do { _Pragma("unroll") for (int i_ = 0; i_ < KCH; ++i_) { const int c_ = tid + NTHR * i_, row_ = c_ / KCPR, ch_ = c_ % KCPR; *(LAS u32x4*)(Kl + (buf) * KBUF + row_ * KROWB + ((ch_ ^ (row_ & (KCPR - 1))) << 4)) = kreg[i_]; } \
        _Pragma("unroll") for (int i_ = 0; i_ < VCH; ++i_) { const int c_ = tid + NTHR * i_, row_ = c_ / VCPR, ch_ = c_ % VCPR; *(LAS u32x4*)(Vl + (buf) * VBUF + row_ * VP + ch_ * 16) = vreg[i_]; } } while (0)
    A_GLOAD(0); A_LSTORE(0); __syncthreads();
    const int vb = (4 * hi + ((lane & 15) >> 2)) * VP + (16 * ((lane >> 4) & 1) + 4 * (lane & 3)) * 2;
    for (int t = 0; t < ntiles; ++t) {
        const int buf = t & 1;
        if (t + 1 < ntiles) A_GLOAD(t + 1);
        f32x16 p0, p1;
#pragma unroll
        for (int r = 0; r < 16; ++r) { p0[r] = 0.f; p1[r] = 0.f; }
#pragma unroll
        for (int d0 = 0; d0 < DQK / 16; ++d0) {
            const int ch = 2 * d0 + hi, row0 = r32, row1 = 32 + r32;
            const bf16x8 a0 = *(LAS const bf16x8*)(Kl + buf * KBUF + row0 * KROWB + ((ch ^ (row0 & (KCPR - 1))) << 4));
            const bf16x8 a1 = *(LAS const bf16x8*)(Kl + buf * KBUF + row1 * KROWB + ((ch ^ (row1 & (KCPR - 1))) << 4));
            p0 = __builtin_amdgcn_mfma_f32_32x32x16_bf16(a0, qf[d0], p0, 0, 0, 0);
            p1 = __builtin_amdgcn_mfma_f32_32x32x16_bf16(a1, qf[d0], p1, 0, 0, 0);
        }
        if (MODE == 1) {
            if (64 * t + 63 > qpos_wmin) {
#pragma unroll
                for (int r = 0; r < 16; ++r) { const int kv = 64 * t + crow(r, hi); if (kv > qpos) p0[r] = -INFINITY; if (kv + 32 > qpos) p1[r] = -INFINITY; }
            }
        } else if (MODE == 2) {
            const u64 w = mrow[t] >> (4 * hi); const unsigned wl = (unsigned)w, wh = (unsigned)(w >> 32);
#pragma unroll
            for (int r = 0; r < 16; ++r) { const int bit = (r & 3) + 8 * (r >> 2); if (!((wl >> bit) & 1u)) p0[r] = -INFINITY; if (!((wh >> bit) & 1u)) p1[r] = -INFINITY; }
        }
        float mx = fmaxf(p0[0], p1[0]);
#pragma unroll
        for (int r = 1; r < 16; ++r) mx = fmaxf(mx, fmaxf(p0[r], p1[r]));
        mx = fmaxf(mx, __shfl_xor(mx, 32));
        const float m_new = fmaxf(m_run, mx), alpha = __builtin_amdgcn_exp2f(m_run - m_new);
        m_run = m_new;
        float rs = 0.f;
#pragma unroll
        for (int r = 0; r < 16; ++r) { p0[r] = __builtin_amdgcn_exp2f(p0[r] - m_new); p1[r] = __builtin_amdgcn_exp2f(p1[r] - m_new); rs += p0[r] + p1[r]; }
        l_run = l_run * alpha + rs;
        if (__any(alpha != 1.f)) {
#pragma unroll
            for (int d0 = 0; d0 < DV / 32; ++d0)
#pragma unroll
                for (int r = 0; r < 16; ++r) o[d0][r] *= alpha;
        }
        bf16x8 pb[4];
#pragma unroll
        for (int ks = 0; ks < 4; ++ks) {
            u32x4 w;
            if (ks < 2) { w.x = cvtpk(p0[8 * ks + 0], p0[8 * ks + 1]); w.y = cvtpk(p0[8 * ks + 2], p0[8 * ks + 3]); w.z = cvtpk(p0[8 * ks + 4], p0[8 * ks + 5]); w.w = cvtpk(p0[8 * ks + 6], p0[8 * ks + 7]); }
            else { const int k2 = ks - 2; w.x = cvtpk(p1[8 * k2 + 0], p1[8 * k2 + 1]); w.y = cvtpk(p1[8 * k2 + 2], p1[8 * k2 + 3]); w.z = cvtpk(p1[8 * k2 + 4], p1[8 * k2 + 5]); w.w = cvtpk(p1[8 * k2 + 6], p1[8 * k2 + 7]); }
            pb[ks] = __builtin_bit_cast(bf16x8, w);
        }
#pragma unroll
        for (int d0 = 0; d0 < DV / 32; ++d0)
#pragma unroll
            for (int ks = 0; ks < 4; ++ks) {
                const s16x4 lo = vtr(Vl + buf * VBUF + vb + (16 * ks) * VP + d0 * 64);
                const s16x4 hh = vtr(Vl + buf * VBUF + vb + (16 * ks + 8) * VP + d0 * 64);
                const bf16x8 a = (bf16x8){lo[0], lo[1], lo[2], lo[3], hh[0], hh[1], hh[2], hh[3]};
                o[d0] = __builtin_amdgcn_mfma_f32_32x32x16_bf16(a, pb[ks], o[d0], 0, 0, 0);
            }
        if (t + 1 < ntiles) A_LSTORE((t + 1) & 1);
        __syncthreads();
    }
#undef A_GLOAD
#undef A_LSTORE
}
template <int DV>
DEVI void store_oT(const f32x16 (&o)[DV / 32], float inv, bf16_t* dst, int hi) {
#pragma unroll
    for (int d0 = 0; d0 < DV / 32; ++d0)
#pragma unroll
        for (int g4 = 0; g4 < 4; ++g4) {
            u32x2 w; w.x = cvtpk(o[d0][4 * g4 + 0] * inv, o[d0][4 * g4 + 1] * inv); w.y = cvtpk(o[d0][4 * g4 + 2] * inv, o[d0][4 * g4 + 3] * inv);
            *(u32x2*)(dst + 32 * d0 + 8 * g4 + 4 * hi) = w;
        }
}

DEVI void attnA_unit(const Params& P, int b, int h, int c, int qb, LAS unsigned char* lds) {
    const int tid = threadIdx.x, lane = tid & 63, wave = tid >> 6, r32 = lane & 31, hi = lane >> 5;
    unsigned char* ws = P.ws;
    const bf16_t* proj = (const bf16_t*)(ws + WS_PROJ);
    const int q = qb * 256 + 32 * wave + r32; const size_t row = (size_t)b * S + q;
    bf16x8 qf[4];
#pragma unroll
    for (int d0 = 0; d0 < 4; ++d0) qf[d0] = *(const bf16x8*)(proj + row * LDP + C_QA + (2 * h + c) * 64 + 16 * d0 + 8 * hi);
    f32x16 o[4];
#pragma unroll
    for (int d0 = 0; d0 < 4; ++d0)
#pragma unroll
        for (int r = 0; r < 16; ++r) o[d0][r] = 0.f;
    float m_run = -1e30f, l_run = 0.f;
    attn_core<64, 128, 1>(o, m_run, l_run, qf, proj + (size_t)b * S * LDP + C_KA + (2 * h + c) * 64, LDP, proj + (size_t)b * S * LDP + C_VA + h * 128, LDP,
                          4 * (qb + 1), q, qb * 256 + 32 * wave, nullptr, lds, tid);
    const float lt = l_run + __shfl_xor(l_run, 32);
    bf16_t* oa = (bf16_t*)(ws + WS_XB) + (size_t)c * T * 512 + row * 512 + h * 128;
    store_oT<128>(o, 1.f / lt, oa, hi);
}
DEVI void attnB_unit(const Params& P, int b, int hd, int qb, LAS unsigned char* lds) {
    const int tid = threadIdx.x, lane = tid & 63, wave = tid >> 6, r32 = lane & 31, hi = lane >> 5;
    unsigned char* ws = P.ws;
    const bf16_t* proj = (const bf16_t*)(ws + WS_PROJ); const bf16_t* kbvb = (const bf16_t*)(ws + WS_KBVB);
    const int q = qb * 256 + 32 * wave + r32; const size_t row = (size_t)b * S + q;
    bf16x8 qf[4];
#pragma unroll
    for (int d0 = 0; d0 < 4; ++d0) qf[d0] = *(const bf16x8*)(proj + row * LDP + C_QB + hd * 64 + 16 * d0 + 8 * hi);
    f32x16 o[2];
#pragma unroll
    for (int d0 = 0; d0 < 2; ++d0)
#pragma unroll
        for (int r = 0; r < 16; ++r) o[d0][r] = 0.f;
    float m_run = -1e30f, l_run = 0.f;
    attn_core<64, 64, 2>(o, m_run, l_run, qf, kbvb + (size_t)b * S * 1024 + hd * 64, 1024, kbvb + (size_t)b * S * 1024 + 512 + hd * 64, 1024,
                         4 * (qb + 1), q, qb * 256 + 32 * wave, (const u64*)(ws + WS_MASK) + row * 64, lds, tid);
    const float lt = l_run + __shfl_xor(l_run, 32);
    store_oT<64>(o, 1.f / lt, (bf16_t*)(ws + WS_Y) + row * 1024 + 512 + hd * 64, hi);
}
DEVI void xattn_unit(const Params& P, int l, int b, int hd, int qb, LAS unsigned char* lds) {
    const int tid = threadIdx.x, lane = tid & 63, wave = tid >> 6, r32 = lane & 31, hi = lane >> 5;
    unsigned char* ws = P.ws;
    const bf16_t* qx = (const bf16_t*)(ws + WS_QX); const bf16_t* kvx = (const bf16_t*)(ws + WS_KVX) + l * 1024;
    const int q = qb * 256 + 32 * wave + r32; const size_t row = (size_t)b * S + q;
    const float* gq = P.in[9] + l * 128;
    u32x4 raw[8]; float ss = 0.f;
#pragma unroll
    for (int d0 = 0; d0 < 8; ++d0) { raw[d0] = *(const u32x4*)(qx + row * 512 + hd * 128 + 16 * d0 + 8 * hi);
#pragma unroll
        for (int j = 0; j < 4; ++j) { const float a = lo16(raw[d0][j]), bq = hi16(raw[d0][j]); ss += a * a + bq * bq; } }
    ss += __shfl_xor(ss, 32);
    const float rs = rsqrtf(ss * (1.f / 128.f) + EPS) * (0.08838834764831845f * LOG2E);
    bf16x8 qf[8];
#pragma unroll
    for (int d0 = 0; d0 < 8; ++d0) { u32x4 w;
#pragma unroll
        for (int j = 0; j < 4; ++j) { const int dim = 16 * d0 + 8 * hi + 2 * j; w[j] = cvtpk(lo16(raw[d0][j]) * rs * gq[dim], hi16(raw[d0][j]) * rs * gq[dim + 1]); }
        qf[d0] = __builtin_bit_cast(bf16x8, w); }
    f32x16 o[4];
#pragma unroll
    for (int d0 = 0; d0 < 4; ++d0)
#pragma unroll
        for (int r = 0; r < 16; ++r) o[d0][r] = 0.f;
    float m_run = -1e30f, l_run = 0.f;
    attn_core<128, 128, 0>(o, m_run, l_run, qf, kvx + (size_t)b * MEML * 2048 + hd * 128, 2048, kvx + (size_t)b * MEML * 2048 + 512 + hd * 128, 2048,
                           MEML / 64, q, 0, nullptr, lds, tid);
    const float lt = l_run + __shfl_xor(l_run, 32);
    store_oT<128>(o, 1.f / lt, (bf16_t*)(ws + WS_YX) + row * 512 + hd * 128, hi);
}

DEVI void indexer_unit(const Params& P, int b, int t0, LAS unsigned char* lds) {
    const int tid = threadIdx.x, lane = tid & 63, wave = __builtin_amdgcn_readfirstlane(tid >> 6), r32 = lane & 31, hi = lane >> 5;
    unsigned char* ws = P.ws;
    const bf16_t* proj = (const bf16_t*)(ws + WS_PROJ); const float* WI = (const float*)(ws + WS_WI);
    LAS float* Ssc = (LAS float*)lds;
    if (t0 + 7 >= 255) {
        bf16x8 af[4];
        { const int qq = r32 >> 2, hh = r32 & 3; const size_t row = (size_t)b * S + t0 + qq;
#pragma unroll
          for (int d0 = 0; d0 < 4; ++d0) af[d0] = *(const bf16x8*)(proj + row * LDP + C_QI + hh * 64 + 16 * d0 + 8 * hi); }
        float wv[16];
#pragma unroll
        for (int r = 0; r < 16; ++r) wv[r] = WI[((size_t)b * S + t0 + 2 * (r >> 2) + hi) * 4 + (r & 3)];
        const int nkt = (t0 + 8 + 31) / 32;
        const bf16_t* kbase = (const bf16_t*)(ws + WS_KI) + (size_t)(b * (S / 32)) * 2048 + lane * 8;
        bf16x8 bk[4], bn[4], bm[4];
        { const int k1 = (wave < nkt) ? wave : 0, k2 = (wave + NWAVE < nkt) ? wave + NWAVE : k1;
#pragma unroll
          for (int d0 = 0; d0 < 4; ++d0) { bk[d0] = *(const bf16x8*)(kbase + (size_t)k1 * 2048 + d0 * 512); bn[d0] = *(const bf16x8*)(kbase + (size_t)k2 * 2048 + d0 * 512); } }
        for (int kt = wave; kt < nkt; kt += NWAVE) {
            const int ktn = (kt + 2 * NWAVE < nkt) ? kt + 2 * NWAVE : kt;
#pragma unroll
            for (int d0 = 0; d0 < 4; ++d0) bm[d0] = *(const bf16x8*)(kbase + (size_t)ktn * 2048 + d0 * 512);
            f32x16 c;
#pragma unroll
            for (int r = 0; r < 16; ++r) c[r] = 0.f;
#pragma unroll
            for (int d0 = 0; d0 < 4; ++d0) c = __builtin_amdgcn_mfma_f32_32x32x16_bf16(af[d0], bk[d0], c, 0, 0, 0);
            const int key = kt * 32 + r32;
#pragma unroll
            for (int g4 = 0; g4 < 4; ++g4) {
                float s = 0.f;
#pragma unroll
                for (int hh = 0; hh < 4; ++hh) s += fmaxf(c[4 * g4 + hh], 0.f) * wv[4 * g4 + hh];
                Ssc[(2 * g4 + hi) * 4096 + key] = s;
            }
#pragma unroll
            for (int d0 = 0; d0 < 4; ++d0) { bk[d0] = bn[d0]; bn[d0] = bm[d0]; }
        }
    }
    __syncthreads();
    {
        const int t = t0 + wave; u64 myw = 0ull;
        if (t >= 255) {
            unsigned u[64];
#pragma unroll
            for (int j = 0; j < 64; ++j) {
                const int s = 64 * j + lane; unsigned key = 0u;
                if (64 * j <= t) { const unsigned bits = __float_as_uint(Ssc[wave * 4096 + s]);
                    key = (bits == 0x80000000u) ? 0x80000000u : ((bits & 0x80000000u) ? ~bits : (bits | 0x80000000u));
                    if (s > t) key = 0u; }
                u[j] = key;
            }
            const int nq = __builtin_amdgcn_readfirstlane(t >> 10);
            unsigned gm0 = 0u, gm1 = 0u, gm2 = 0u, gm3 = 0u;
#pragma unroll
            for (int j = 0; j < 64; j += 4) { gm0 = max(gm0, u[j]); gm1 = max(gm1, u[j + 1]); gm2 = max(gm2, u[j + 2]); gm3 = max(gm3, u[j + 3]); }
            unsigned Mx = max(max(gm0, gm1), max(gm2, gm3)), Lx = min(min(gm0, gm1), min(gm2, gm3));
#pragma unroll
            for (int o = 1; o < 64; o <<= 1) { Mx = max(Mx, (unsigned)__shfl_xor((int)Mx, o)); Lx = min(Lx, (unsigned)__shfl_xor((int)Lx, o)); }
            Mx = __builtin_amdgcn_readfirstlane(Mx); Lx = __builtin_amdgcn_readfirstlane(Lx);
            unsigned prefix = 0u; bool exact = false;
#define IDX_CNT16(q) do { _Pragma("unroll") for (int jj = 0; jj < 16; ++jj) cnt += __builtin_popcountll(__ballot(u[16 * (q) + jj] >= cand)); } while (0)
            for (int bit = 31; bit >= 0; --bit) {
                const unsigned cand = prefix | (1u << bit); int cnt = 0;
                if (cand > Mx) continue;
                if (cand <= Lx) { prefix = cand; continue; }
                IDX_CNT16(0);
                if (nq >= 1) IDX_CNT16(1);
                if (nq >= 2) IDX_CNT16(2);
                if (nq >= 3) IDX_CNT16(3);
                if (cnt >= 256) prefix = cand;
                if (cnt == 256) { exact = true; break; }
            }
#undef IDX_CNT16
            LAS u64* wl = (LAS u64*)(lds + 132096 + wave * 512);
            if (exact) {
#pragma unroll
                for (int j = 0; j < 64; ++j) { const u64 wj = __ballot(u[j] >= prefix); wl[j] = wj; }
            } else {
                int cgt = 0;
#pragma unroll
                for (int j = 0; j < 64; ++j) cgt += __builtin_popcountll(__ballot(u[j] > prefix));
                const int need = 256 - cgt; int running = 0;
                asm volatile("" : "+v"(prefix));
#pragma unroll
                for (int j = 0; j < 64; ++j) {
                    const bool tie = (u[j] == prefix);
                    const u64 bt = __ballot(tie);
                    const int rank = __builtin_amdgcn_mbcnt_hi((unsigned)(bt >> 32), __builtin_amdgcn_mbcnt_lo((unsigned)bt, 0u));
                    const bool sel = (u[j] > prefix) || (tie && (running + rank < need));
                    const u64 wj = __ballot(sel);
                    running += __builtin_popcountll(bt);
                    wl[j] = wj;
                }
            }
            LDS_WAIT(); asm volatile("" ::: "memory");
            myw = wl[lane];
        } else {
            const int lo = 64 * lane;
            if (lo + 63 <= t) myw = ~0ull; else if (lo > t) myw = 0ull; else myw = (~0ull) >> (63 - (t - lo));
        }
        ((u64*)(ws + WS_MASK))[((size_t)b * S + t) * 64 + lane] = myw;
    }
    __syncthreads();
}

DEVI void combineA_rows(const Params& P) {
    const int tid = threadIdx.x, lane = tid & 63, wave = tid >> 6;
    const int gw = blockIdx.x * NWAVE + wave, NGW = gridDim.x * NWAVE;
    unsigned char* ws = P.ws;
    const float d1 = wave_sum(P.in[17][lane] * P.in[18][lane]), d2 = wave_sum(P.in[19][lane] * P.in[20][lane]);
    const float lam_init = 0.2f, lam = expf(d1) - expf(d2) + lam_init;
    const bf16_t* o0 = (const bf16_t*)(ws + WS_XB); const bf16_t* o1 = o0 + (size_t)T * 512;
    const float* gs = P.in[21] + 8 * (lane & 15);
    for (int m = gw; m < T; m += NGW) {
        const u32x4 a = *(const u32x4*)(o0 + (size_t)m * 512 + 8 * lane), bq = *(const u32x4*)(o1 + (size_t)m * 512 + 8 * lane);
        float v[8]; float ss = 0.f;
#pragma unroll
        for (int j = 0; j < 4; ++j) { v[2 * j] = lo16(a[j]) - lam * lo16(bq[j]); v[2 * j + 1] = hi16(a[j]) - lam * hi16(bq[j]); ss += v[2 * j] * v[2 * j] + v[2 * j + 1] * v[2 * j + 1]; }
        ss += __shfl_xor(ss, 1); ss += __shfl_xor(ss, 2); ss += __shfl_xor(ss, 4); ss += __shfl_xor(ss, 8);
        const float rs = rsqrtf(ss * (1.f / 128.f) + EPS) * (1.f - lam_init);
        u32x4 w;
#pragma unroll
        for (int j = 0; j < 4; ++j) w[j] = cvtpk(v[2 * j] * rs * gs[2 * j], v[2 * j + 1] * rs * gs[2 * j + 1]);
        *(u32x4*)((bf16_t*)(ws + WS_Y) + (size_t)m * 1024 + 8 * lane) = w;
    }
}

DEVI void phase_mix1(const Params& P) {
    const int gt = blockIdx.x * NTHR + threadIdx.x, NGT = gridDim.x * NTHR;
    unsigned char* ws = P.ws;
    const bf16_t* pr = (const bf16_t*)(ws + WS_PROJ1);
    const float* cw = P.in[29];
    for (int it = gt; it < T * 128; it += NGT) {
        const int m = it >> 7, ci = it & 127, t = m & (S - 1);
        if (ci < 64) {
            const int c0 = 8 * ci; float conv[8];
#pragma unroll
            for (int j = 0; j < 8; ++j) conv[j] = 0.f;
#pragma unroll
            for (int dt = 0; dt < 3; ++dt) {
                if (t - dt >= 0) {
                    const u32x4 gc = *(const u32x4*)(pr + (size_t)(m - dt) * 2048 + 512 + c0), hc = *(const u32x4*)(pr + (size_t)(m - dt) * 2048 + 1024 + c0);
#pragma unroll
                    for (int j = 0; j < 4; ++j) { conv[2 * j] += cw[(2 - dt) * 512 + c0 + 2 * j] * (lo16(gc[j]) * lo16(hc[j])); conv[2 * j + 1] += cw[(2 - dt) * 512 + c0 + 2 * j + 1] * (hi16(gc[j]) * hi16(hc[j])); }
                }
            }
            const u32x4 gb = *(const u32x4*)(pr + (size_t)m * 2048 + c0); u32x4 w;
#pragma unroll
            for (int j = 0; j < 4; ++j) w[j] = cvtpk(lo16(gb[j]) * conv[2 * j], hi16(gb[j]) * conv[2 * j + 1]);
            *(u32x4*)((bf16_t*)(ws + WS_Y) + (size_t)m * 1024 + c0) = w;
        } else {
            const int c0 = 8 * (ci - 64), g = c0 >> 7, wdw = 2 << g; float sum[8];
#pragma unroll
            for (int j = 0; j < 8; ++j) sum[j] = 0.f;
            const int n = (t + 1 < wdw) ? (t + 1) : wdw;
            u32x4 z0 = (u32x4){0u, 0u, 0u, 0u};
            for (int dt = 0; dt < n; ++dt) {
                const u32x4 z = *(const u32x4*)(pr + (size_t)(m - dt) * 2048 + 1536 + c0); if (dt == 0) z0 = z;
#pragma unroll
                for (int j = 0; j < 4; ++j) { sum[2 * j] += lo16(z[j]); sum[2 * j + 1] += hi16(z[j]); }
            }
            const float inv = 1.f / (float)n; u32x4 w;
#pragma unroll
            for (int j = 0; j < 4; ++j) w[j] = cvtpk(sum[2 * j] * inv - lo16(z0[j]), sum[2 * j + 1] * inv - hi16(z0[j]));
            *(u32x4*)((bf16_t*)(ws + WS_POOLED) + (size_t)m * 512 + c0) = w;
        }
    }
}

namespace pg8 {
#define PG8_LAS __attribute__((address_space(3)))
typedef unsigned short bf16_t;
typedef short bf16x8 __attribute__((ext_vector_type(8)));
typedef float f32x4 __attribute__((ext_vector_type(4)));
typedef unsigned u32x4 __attribute__((ext_vector_type(4)));
constexpr int BM = 256, BK = 64, HALF = 128, HTB = HALF * BK * 2  , STAGE_BYTES = 8 * HTB, NXCD = 8, WGM = 8;

__host__ __device__ __forceinline__ int lds_byte(int r, int c) { const int st = (r >> 4) * 2 + (c >> 5), rr = r & 15, cc = c & 31, ob = rr * 64 + cc * 2; return st * 1024 + (ob ^ (((ob >> 9) & 1) << 5)); }
__host__ __device__ __forceinline__ void stage_rc(int b, int& R, int& C) { const int st = b / 1024, sb = b % 1024, swz = sb ^ (((sb >> 9) & 1) << 5); R = (st >> 1) * 16 + swz / 64; C = (st & 1) * 32 + (swz % 64) / 2; }
__host__ __device__ __forceinline__ int perm32(int rho) { const int n = rho >> 4, i = rho & 15; return 8 * (i >> 2) + 4 * n + (i & 3); }

struct Unit { int pm, pn; };
struct Gemm { const bf16_t* A; int lda; const bf16_t* Bt; int M, N, K; };

struct StaticOrder {
    int nM, nN, nwg, G, c;
    __host__ __device__ void init(int M, int N, int G_, int c_) { nM = M / BM; nN = N / BM; nwg = nM * nN; G = G_; c = c_; }
    __host__ __device__ bool next(int i, Unit& u) const {
        const long L = (long)i * G + c; if (L >= nwg) return false;
        int wgid = (int)L; { const int q = nwg / NXCD, r = nwg % NXCD, xcd = wgid % NXCD, off = wgid / NXCD; wgid = (xcd < r ? xcd * (q + 1) : r * (q + 1) + (xcd - r) * q) + off; }
        const int nig = WGM * nN, gid = wgid / nig, fm = gid * WGM, gsz = (nM - fm) < WGM ? (nM - fm) : WGM;
        u.pm = fm + ((wgid % nig) % gsz); u.pn = (wgid % nig) / gsz; return true;
    }
    __device__ __forceinline__ void a_ready(const Unit&) const {}
    __device__ __forceinline__ void done(const Unit&) const {}
};
template <class Epi, class Sched, bool ALIGN_EPI = false, bool SP2 = false>
__device__ __forceinline__ void gemm_phase(PG8_LAS unsigned char* lds, const Gemm g, const Sched& S, const Epi& E) {
    const int tid = threadIdx.x, wid = __builtin_amdgcn_readfirstlane(tid >> 6), lane = tid & 63, wr = wid >> 2, wc = wid & 3, fr = lane & 15, fq = lane >> 4;
    const int K = g.K, nt = K / BK;
    unsigned voffA[2], voffB[2];
#pragma unroll
    for (int i = 0; i < 2; ++i) { int R, C; stage_rc(tid * 16 + i * 8192, R, C); const int Rb = Epi::PERM ? ((R & ~31) + perm32(R & 31)) : R;
        voffA[i] = (unsigned)(R * g.lda + C) * 2u; voffB[i] = (unsigned)(Rb * K + C) * 2u; }
    const size_t kstep = (size_t)(BK * 2);
    const size_t hstepA = (size_t)HALF * g.lda * 2, hstepB = (size_t)HALF * K * 2;
    const size_t tstepA = 2 * hstepA, tstepB = 2 * hstepB;
    const unsigned ldsw = (unsigned)wid * 1024u;
    const int aoff = lds_byte(wr * 64 + fr, fq * 8), boff = lds_byte(wc * 32 + fr, fq * 8);
#define PG8_SA(b, h) (((b) * 2 + (h)) * HTB)
#define PG8_SB(b, h) ((4 + (b) * 2 + (h)) * HTB)
#define PG8_STAGE(bufoff, gbase, voff) do { _Pragma("unroll") for (int _i = 0; _i < 2; ++_i) \
        __builtin_amdgcn_global_load_lds((const unsigned*)((const char*)(gbase) + (voff)[_i]), (PG8_LAS unsigned*)(lds + (bufoff) + ldsw + _i * 8192), 16, 0, 0); } while (0)
#define PG8_LDA(dst, b, h) do { _Pragma("unroll") for (int m = 0; m < 4; ++m) _Pragma("unroll") for (int k = 0; k < 2; ++k) dst[m][k] = *(const PG8_LAS bf16x8*)(lds + PG8_SA(b, h) + aoff + m * 2048 + k * 1024); } while (0)
#define PG8_LDB(dst, b, h) do { _Pragma("unroll") for (int n = 0; n < 2; ++n) _Pragma("unroll") for (int k = 0; k < 2; ++k) dst[n][k] = *(const PG8_LAS bf16x8*)(lds + PG8_SB(b, h) + boff + n * 2048 + k * 1024); } while (0)
#define PG8_MMA(ai, bj, At, Bt) do { __builtin_amdgcn_s_setprio(1); _Pragma("unroll") for (int m = 0; m < 4; ++m) _Pragma("unroll") for (int n = 0; n < 2; ++n) _Pragma("unroll") for (int k = 0; k < 2; ++k) \
        acc[ai][bj][m][n] = __builtin_amdgcn_mfma_f32_16x16x32_bf16(Bt[n][k], At[m][k], acc[ai][bj][m][n], 0, 0, 0); __builtin_amdgcn_s_setprio(0); } while (0)
#define PG8_WAIT_V(n) asm volatile("s_waitcnt vmcnt(" #n ")" ::: "memory")
#define PG8_WAIT_L(n) asm volatile("s_waitcnt lgkmcnt(" #n ")" ::: "memory")
#define PG8_BAR __builtin_amdgcn_s_barrier()
#define PG8_SCHED __builtin_amdgcn_sched_barrier(0)
    Unit cur, nxt; int ui = 0;
    if (!S.next(0, cur)) return;
    f32x4 acc[2][2][4][2];
#pragma unroll
    for (int a = 0; a < 2; ++a)
#pragma unroll
        for (int b = 0; b < 2; ++b)
#pragma unroll
            for (int m = 0; m < 4; ++m)
#pragma unroll
                for (int n = 0; n < 2; ++n) acc[a][b][m][n] = (f32x4){0.f, 0.f, 0.f, 0.f};
    bf16x8 At[4][2], B0[2][2], B1[2][2];
    const char* cA = (const char*)g.A + (size_t)cur.pm * tstepA; const char* cB = (const char*)g.Bt + (size_t)cur.pn * tstepB;
    S.a_ready(cur);
    if constexpr (SP2) {
        PG8_STAGE(PG8_SB(0, 0), cB, voffB); PG8_STAGE(PG8_SB(0, 1), cB + hstepB, voffB); PG8_STAGE(PG8_SA(0, 0), cA, voffA); PG8_STAGE(PG8_SA(0, 1), cA + hstepA, voffA);
        if (wr == 1) PG8_BAR;
        PG8_WAIT_V(2); PG8_BAR;
        PG8_STAGE(PG8_SB(1, 0), cB + kstep, voffB); PG8_STAGE(PG8_SA(1, 0), cA + kstep, voffA); PG8_STAGE(PG8_SB(1, 1), cB + hstepB + kstep, voffB);
        PG8_WAIT_V(6); PG8_BAR;
    } else {
        PG8_STAGE(PG8_SB(0, 0), cB, voffB); PG8_STAGE(PG8_SA(0, 0), cA, voffA); PG8_STAGE(PG8_SB(0, 1), cB + hstepB, voffB); PG8_STAGE(PG8_SA(0, 1), cA + hstepA, voffA);
        if (wr == 1) PG8_BAR;
        PG8_WAIT_V(4); PG8_BAR;
        PG8_STAGE(PG8_SB(1, 0), cB + kstep, voffB); PG8_STAGE(PG8_SA(1, 0), cA + kstep, voffA); PG8_STAGE(PG8_SB(1, 1), cB + hstepB + kstep, voffB);
        PG8_WAIT_V(6); PG8_BAR;
    }
    for (;;) {
        const bool has_next = S.next(ui + 1, nxt);
        const char* nA = has_next ? (const char*)g.A + (size_t)nxt.pm * tstepA : cA; const char* nB = has_next ? (const char*)g.Bt + (size_t)nxt.pn * tstepB : cB;
        for (int t = 0; t < nt; t += 2) {
            const bool last = (t == nt - 2);
            const char* a1 = cA + (size_t)(t + 1) * kstep;
            const char* a2 = last ? nA : cA + (size_t)(t + 2) * kstep; const char* b2 = last ? nB : cB + (size_t)(t + 2) * kstep;
            const char* a3 = a2 + kstep; const char* b3 = b2 + kstep;
            if (last && has_next) S.a_ready(nxt);
            if constexpr (SP2) {
            PG8_LDB(B0, 0, 0); PG8_LDB(B1, 0, 1); PG8_SCHED; PG8_LDA(At, 0, 0); PG8_STAGE(PG8_SA(1, 1), a1 + hstepA, voffA);
            PG8_WAIT_V(8); PG8_WAIT_L(0); PG8_BAR; PG8_MMA(0, 0, At, B0); PG8_MMA(0, 1, At, B1); PG8_BAR; PG8_SCHED;
            PG8_LDA(At, 0, 1); PG8_STAGE(PG8_SB(0, 0), b2, voffB); PG8_STAGE(PG8_SB(0, 1), b2 + hstepB, voffB); PG8_STAGE(PG8_SA(0, 0), a2, voffA);
            PG8_WAIT_V(8); PG8_WAIT_L(0); PG8_BAR; PG8_MMA(1, 0, At, B0); PG8_MMA(1, 1, At, B1); PG8_BAR; PG8_SCHED;
            PG8_LDB(B0, 1, 0); PG8_LDB(B1, 1, 1); PG8_SCHED; PG8_LDA(At, 1, 0); PG8_STAGE(PG8_SA(0, 1), a2 + hstepA, voffA);
            PG8_WAIT_V(8); PG8_WAIT_L(0); PG8_BAR; PG8_MMA(0, 0, At, B0); PG8_MMA(0, 1, At, B1); PG8_BAR; PG8_SCHED;
            PG8_LDA(At, 1, 1); PG8_STAGE(PG8_SB(1, 0), b3, voffB); PG8_STAGE(PG8_SB(1, 1), b3 + hstepB, voffB); PG8_STAGE(PG8_SA(1, 0), a3, voffA);
            PG8_WAIT_V(8); PG8_WAIT_L(0); PG8_BAR; PG8_MMA(1, 0, At, B0); PG8_MMA(1, 1, At, B1); PG8_BAR; PG8_SCHED;
            } else {
            PG8_LDB(B0, 0, 0); PG8_SCHED; PG8_LDA(At, 0, 0); PG8_STAGE(PG8_SA(1, 1), a1 + hstepA, voffA);
            PG8_WAIT_L(8); PG8_BAR; PG8_WAIT_L(0); PG8_MMA(0, 0, At, B0); PG8_BAR; PG8_SCHED;
            PG8_LDB(B1, 0, 1); PG8_STAGE(PG8_SB(0, 0), b2, voffB);
            PG8_BAR; PG8_WAIT_L(0); PG8_MMA(0, 1, At, B1); PG8_BAR;
            PG8_LDA(At, 0, 1); PG8_STAGE(PG8_SA(0, 0), a2, voffA);
            PG8_BAR; PG8_WAIT_L(0); PG8_MMA(1, 0, At, B0); PG8_BAR; PG8_SCHED;
            PG8_STAGE(PG8_SB(0, 1), b2 + hstepB, voffB);
            PG8_WAIT_V(6); PG8_BAR; PG8_MMA(1, 1, At, B1); PG8_BAR;
            PG8_LDB(B0, 1, 0); PG8_SCHED; PG8_LDA(At, 1, 0); PG8_STAGE(PG8_SA(0, 1), a2 + hstepA, voffA);
            PG8_WAIT_L(8); PG8_BAR; PG8_WAIT_L(0); PG8_MMA(0, 0, At, B0); PG8_BAR; PG8_SCHED;
            PG8_LDB(B1, 1, 1); PG8_STAGE(PG8_SB(1, 0), b3, voffB);
            PG8_BAR; PG8_WAIT_L(0); PG8_MMA(0, 1, At, B1); PG8_BAR;
            PG8_LDA(At, 1, 1); PG8_STAGE(PG8_SA(1, 0), a3, voffA);
            PG8_BAR; PG8_WAIT_L(0); PG8_MMA(1, 0, At, B0); PG8_BAR; PG8_SCHED;
            PG8_STAGE(PG8_SB(1, 1), b3 + hstepB, voffB);
            PG8_WAIT_V(6); PG8_BAR; PG8_MMA(1, 1, At, B1); PG8_BAR;
            }
        }
        if constexpr (ALIGN_EPI) { if (wr == 0) PG8_BAR; }
        if constexpr (!Epi::AFTER_DRAIN) { E(acc, cur, wr, wc, fr, fq); S.done(cur); }
        if (!has_next) break;
#pragma unroll
        for (int a = 0; a < 2; ++a)
#pragma unroll
            for (int b = 0; b < 2; ++b)
#pragma unroll
                for (int m = 0; m < 4; ++m)
#pragma unroll
                    for (int n = 0; n < 2; ++n) acc[a][b][m][n] = (f32x4){0.f, 0.f, 0.f, 0.f};
        cur = nxt; cA = nA; cB = nB; ++ui;
        if constexpr (ALIGN_EPI) { if (wr == 1) PG8_BAR; }
    }
    PG8_WAIT_V(0);
    if constexpr (!ALIGN_EPI) { if (wr == 0) PG8_BAR; }
    PG8_BAR;
    if constexpr (Epi::AFTER_DRAIN) { E.fused(acc, cur, wr, wc, fr, fq, lds, wid, lane); S.done(cur); }
#undef PG8_SA
#undef PG8_SB
#undef PG8_STAGE
#undef PG8_LDA
#undef PG8_LDB
#undef PG8_MMA
#undef PG8_WAIT_V
#undef PG8_WAIT_L
#undef PG8_BAR
#undef PG8_SCHED
}
}

namespace pg8 {
struct EpiScale {
    static constexpr bool PERM = true, AFTER_DRAIN = false;
    bf16_t* O; int ldo; const float* ssq; float inv_n; int act;
    __device__ __forceinline__ void operator()(const f32x4 (&acc)[2][2][4][2], const Unit& u, int wr, int wc, int fr, int fq) const {
        const int row0 = u.pm * BM + wr * 64 + fr, col0 = u.pn * BM + wc * 32 + 8 * fq;
#pragma unroll
        for (int ai = 0; ai < 2; ++ai)
#pragma unroll
            for (int m = 0; m < 4; ++m) {
                const int row = row0 + ai * HALF + m * 16;
                const float rs = ssq ? rsqrtf(ssq[row] * inv_n + 1e-6f) : 1.f;
                bf16_t* rowp = O + (size_t)row * ldo + col0;
#pragma unroll
                for (int bj = 0; bj < 2; ++bj) {
                    f32x4 v0 = acc[ai][bj][m][0] * rs, v1 = acc[ai][bj][m][1] * rs;
                    if (act == 1) {
#pragma unroll
                        for (int j = 0; j < 4; ++j) { const float a = fmaxf(v0[j], 0.f), b = fmaxf(v1[j], 0.f); v0[j] = a * a; v1[j] = b * b; }
                    }
                    u32x4 w; w.x = ::cvtpk(v0[0], v0[1]); w.y = ::cvtpk(v0[2], v0[3]); w.z = ::cvtpk(v1[0], v1[1]); w.w = ::cvtpk(v1[2], v1[3]);
                    *(u32x4*)(rowp + bj * HALF) = w;
                }
            }
    }
};
struct EpiResid {
    static constexpr bool PERM = true, AFTER_DRAIN = false;
    const float* base; float* out; bf16_t* xb; float* ssq_next; int dry;
    __device__ __forceinline__ void operator()(const f32x4 (&acc)[2][2][4][2], const Unit& u, int wr, int wc, int fr, int fq) const {
        const int col0 = u.pn * BM + wc * 32 + 8 * fq;
#pragma unroll
        for (int ai = 0; ai < 2; ++ai)
#pragma unroll
            for (int m = 0; m < 4; ++m) {
                const int row = u.pm * BM + ai * HALF + wr * 64 + m * 16 + fr; const size_t off = (size_t)row * 1024 + col0; float s = 0.f;
#pragma unroll
                for (int bj = 0; bj < 2; ++bj) {
                    const size_t idx = off + bj * HALF;
                    const f32x4 x0 = *(const f32x4*)(base + idx) + acc[ai][bj][m][0], x1 = *(const f32x4*)(base + idx + 4) + acc[ai][bj][m][1];
                    const size_t oidx = dry ? (idx & ((1u << 23) - 1)) : idx;
                    *(f32x4*)(out + oidx) = x0; *(f32x4*)(out + oidx + 4) = x1;
                    s += (x0[0] * x0[0] + x0[1] * x0[1]) + (x0[2] * x0[2] + x0[3] * x0[3]) + (x1[0] * x1[0] + x1[1] * x1[1]) + (x1[2] * x1[2] + x1[3] * x1[3]);
                    if (xb && !dry) { u32x4 w; w.x = ::cvtpk(x0[0], x0[1]); w.y = ::cvtpk(x0[2], x0[3]); w.z = ::cvtpk(x1[0], x1[1]); w.w = ::cvtpk(x1[2], x1[3]); *(u32x4*)(xb + idx) = w; }
                }
                if (ssq_next && !dry) { s += __shfl_xor(s, 16); s += __shfl_xor(s, 32); if (fq == 0) atomicAdd(ssq_next + row, s); }
            }
    }
};
}

#define XB_TMO      128
#define XB_XCNT(j)  (256  + 64 * (j))
#define XB_XSUB(j)  (1280 + 64 * (j))
#define XB_XGEN(j)  (2304 + 64 * (j))
#define XB_TOP      3328
#define XB_TOPGEN   3392
#define XCD_BAR_WORDS 3456
#define XB_SPIN_CAP (1u << 18)

__device__ __forceinline__ unsigned xb_ld(unsigned* p)              { return __hip_atomic_load(p, __ATOMIC_RELAXED, __HIP_MEMORY_SCOPE_AGENT); }
__device__ __forceinline__ unsigned xb_add(unsigned* p, unsigned v) { return __hip_atomic_fetch_add(p, v, __ATOMIC_RELAXED, __HIP_MEMORY_SCOPE_AGENT); }
__device__ __forceinline__ unsigned xb_xcc_id() { return (unsigned)__builtin_amdgcn_s_getreg((3 << 11) | 20) & 0xFu; }
#define XB_SPIN(cond, bar) do { unsigned _sp = 0; while (cond) { __builtin_amdgcn_s_sleep(1); \
    if ((++_sp & 255u) == 0u) { if (xb_ld(&(bar)[XB_TMO])) break; if (_sp > XB_SPIN_CAP) { atomicAdd(&(bar)[XB_TMO], 1u); break; } } } } while (0)

struct XcdBarrier {
    unsigned* bar; unsigned x;
    volatile LAS unsigned* st;
};

__device__ __forceinline__ XcdBarrier xcd_barrier_post(unsigned* bar, volatile LAS unsigned* st) {
    XcdBarrier b; b.bar = bar; b.x = xb_xcc_id(); b.st = st;
    if (threadIdx.x == 0) (void)xb_add(&bar[XB_XCNT(b.x)], 1u);
    return b;
}
__device__ __forceinline__ void xcd_barrier_complete(unsigned* bar, unsigned x, unsigned& nloc, unsigned& nx) {
    const unsigned G = gridDim.x * gridDim.y * gridDim.z;
    unsigned sum, cnt, mine, sp = 0u;
    for (;;) {
        sum = 0u; cnt = 0u; mine = 0u;
#pragma unroll
        for (unsigned j = 0; j < 16; ++j) { const unsigned c = xb_ld(&bar[XB_XCNT(j)]); sum += c; cnt += (c > 0u) ? 1u : 0u; mine = (j == x) ? c : mine; }
        if (sum == G) break;
        __builtin_amdgcn_s_sleep(1);
        if ((++sp & 255u) == 0u) { if (xb_ld(&bar[XB_TMO])) break; if (sp > XB_SPIN_CAP) { atomicAdd(&bar[XB_TMO], 1u); break; } }
    }
    nloc = mine > 0u ? mine : 1u; nx = cnt > 0u ? cnt : 1u;
}

__device__ __forceinline__ void xcd_barrier(const XcdBarrier& b) {
    asm volatile("s_waitcnt vmcnt(0)" ::: "memory");
    __syncthreads();
    if (threadIdx.x == 0) {
        unsigned* bar = b.bar;
        __builtin_amdgcn_s_waitcnt(0);
        unsigned nloc = b.st[0], nx = b.st[1];
        if (nloc == 0u) { xcd_barrier_complete(bar, b.x, nloc, nx); b.st[0] = nloc; b.st[1] = nx; }
        const unsigned old = xb_add(&bar[XB_XSUB(b.x)], 1u);
        const unsigned gen = old / nloc;
        if (old + 1u == (gen + 1u) * nloc) {
            __builtin_amdgcn_fence(__ATOMIC_RELEASE, "agent");
            asm volatile("s_waitcnt vmcnt(0)" ::: "memory");
            const unsigned og = xb_add(&bar[XB_TOP], 1u);
            const unsigned tg = og / nx;
            if (og + 1u == (tg + 1u) * nx) xb_add(&bar[XB_TOPGEN], 1u);
            else XB_SPIN(xb_ld(&bar[XB_TOPGEN]) == tg, bar);
            __builtin_amdgcn_fence(__ATOMIC_ACQUIRE, "agent");
            xb_add(&bar[XB_XGEN(b.x)], 1u);
            asm volatile("s_waitcnt vmcnt(0)" ::: "memory");
        } else {
            XB_SPIN(xb_ld(&bar[XB_XGEN(b.x)]) == gen, bar);
            __builtin_amdgcn_fence(__ATOMIC_ACQUIRE, "agent");
            asm volatile("s_waitcnt vmcnt(0)" ::: "memory");
        }
    }
    __syncthreads();
}
constexpr int NPHASE = 22;
constexpr size_t WS_BAR = 1 * MiB;
constexpr int MISC_OFF = 131072 + 320;
#ifndef MK_REP_N
#define MK_REP_N 0
#define MK_REP_LO 0
#define MK_REP_HI -1
#endif
#ifndef MK_XPH
#define MK_XPH -1
#define MK_XN 0
#endif
#ifndef MK_SUB
#define MK_SUB 0
#endif
#ifndef MK_CGSYNC
#define MK_CGSYNC 0
#endif
template <class Epi, bool ALIGN>
DEVI void run_gemm(LAS unsigned char* lds, const bf16_t* A, int lda, const bf16_t* Bt, int M, int N, int K, const Epi& E, int cu_off = 0) {
    const int Gd = (int)gridDim.x; int cu = (int)blockIdx.x - cu_off; if (cu < 0) cu += Gd;
    pg8::Gemm g{A, lda, Bt, M, N, K}; pg8::StaticOrder So; So.init(M, N, Gd, cu);
    pg8::gemm_phase<Epi, pg8::StaticOrder, ALIGN, true>(lds, g, So, E);
}
template <bool DRYK>
__global__ void __launch_bounds__(NTHR, 2) mega(Params P, int ph_lo, int ph_hi) {
    extern __shared__ __attribute__((aligned(16))) unsigned char lds_raw[];
    LAS unsigned char* lds = (LAS unsigned char*)lds_raw;
    cg::grid_group grid = cg::this_grid();
    unsigned char* ws = P.ws;
    const int G = gridDim.x, bx = blockIdx.x;
    float* ssq = (float*)(ws + WS_SSQ);
    bf16_t* XB = (bf16_t*)(ws + WS_XB);
    bf16_t* Y = (bf16_t*)(ws + WS_Y);
    volatile LAS unsigned* MISC = (volatile LAS unsigned*)(lds + MISC_OFF);
    if (threadIdx.x < 32) MISC[threadIdx.x] = 0u;
    __syncthreads();
    XcdBarrier bar; bar.bar = (unsigned*)(ws + WS_BAR); bar.x = 0; bar.st = nullptr;
    if (ph_hi - ph_lo > 1) bar = xcd_barrier_post((unsigned*)(ws + WS_BAR), MISC + 8);
#define PH_REPS(k) (((k) >= MK_REP_LO && (k) <= MK_REP_HI && (k) != 2 && (k) != 4) ? 1 + MK_REP_N : 1)
#define PH_BEGIN(k) if (ph_lo <= (k) && (k) < ph_hi) { for (int rep = 0; rep < PH_REPS(k); ++rep) { const int dry = (rep > 0) || DRYK; (void)dry; if (rep > 0) xcd_barrier(bar);
#define PH_END(k) } if ((k) + 1 < ph_hi) { if (MK_CGSYNC || (k) == 0) grid.sync(); else xcd_barrier(bar); } }
#define DRYOUT (dry ? (float*)(ws + WS_Y) : P.out)
    using pg8::EpiScale; using pg8::EpiResid;
    PH_BEGIN(0) phase_prologue(P, lds, dry); PH_END(0)
    PH_BEGIN(1)
        run_gemm<EpiScale, true>(lds, (const bf16_t*)(ws + WS_XB), 1024, (const bf16_t*)(ws + W_INE), T, LDP, 1024, EpiScale{(bf16_t*)(ws + WS_PROJ), LDP, ssq, 1.f / 1024.f, 0});
        run_gemm<EpiScale, false>(lds, (const bf16_t*)(ws + WS_MB), 1024, (const bf16_t*)(ws + W_KVX), MEMT, 2048, 1024, EpiScale{(bf16_t*)(ws + WS_KVX), 2048, (const float*)(ws + WS_SSQMEM), 1.f / 1024.f, 0}, ((T / 256) * (LDP / 256)) % G);
    PH_END(1)
    PH_BEGIN(2) phase_post0(P); PH_END(2)
    PH_BEGIN(3) run_gemm<EpiScale, false>(lds, (const bf16_t*)(ws + WS_PROJ) + C_CKV, LDP, (const bf16_t*)(ws + W_KVUP), T, 1024, 256, EpiScale{(bf16_t*)(ws + WS_KBVB), 1024, (const float*)(ws + WS_SSQCKV), 1.f / 256.f, 0}); PH_END(3)
    PH_BEGIN(4) phase_postkb(P); PH_END(4)
    PH_BEGIN(5)
        if (!(dry && MK_SUB == 2))
        for (int u = bx; u < 256; u += G) { const int bhc = u >> 3, s = u & 7, b = bhc >> 3, h = (bhc >> 1) & 3, c = bhc & 1;
            attnA_unit(P, b, h, c, s, lds); attnA_unit(P, b, h, c, 15 - s, lds); }
        if (!(dry && MK_SUB == 1))
        for (int u = bx; u < 2048; u += G) { const int k = u / 256, c = u % 256, b = k >> 1; const int blk = (k & 1) ? (511 - c) : c;
            indexer_unit(P, b, blk * 8, lds); }
    PH_END(5)
    PH_BEGIN(6)
        if (!(dry && MK_SUB == 2))
        for (int u = bx; u < 256; u += G) { const int bh = u >> 3, s = u & 7, b = bh >> 3, hd = bh & 7;
            attnB_unit(P, b, hd, s, lds); attnB_unit(P, b, hd, 15 - s, lds); }
        if (!(dry && MK_SUB == 1)) combineA_rows(P);
    PH_END(6)
    PH_BEGIN(7) run_gemm<EpiResid, false>(lds, Y, 1024, (const bf16_t*)(ws + W_OUTE), T, 1024, 1024, EpiResid{P.in[0], DRYOUT, XB, ssq + 1 * T, dry}); PH_END(7)
#define XATTN_MLP(l, p0)                                                                                                                                                      \
    PH_BEGIN(p0) run_gemm<EpiScale, false>(lds, XB, 1024, (const bf16_t*)(ws + W_QX) + (size_t)(l) * 512 * 1024, T, 512, 1024, EpiScale{(bf16_t*)(ws + WS_QX), 512, ssq + ((l) ? 4 : 1) * T, 1.f / 1024.f, 0}); PH_END(p0) \
    PH_BEGIN(p0 + 1) for (int u = bx; u < 256; u += G) { const int b = u >> 6, hd = (u >> 4) & 3, qb = u & 15; xattn_unit(P, (l), b, hd, qb, lds); } PH_END(p0 + 1)                                 \
    PH_BEGIN(p0 + 2) run_gemm<EpiResid, false>(lds, (const bf16_t*)(ws + WS_YX), 512, (const bf16_t*)(ws + W_OX) + (size_t)(l) * 1024 * 512, T, 1024, 512, EpiResid{P.out, DRYOUT, XB, ssq + ((l) ? 5 : 2) * T, dry}); PH_END(p0 + 2) \
    PH_BEGIN(p0 + 3) run_gemm<EpiScale, true>(lds, XB, 1024, (const bf16_t*)(ws + W_UP) + (size_t)(l) * 4096 * 1024, T, DFF, 1024, EpiScale{(bf16_t*)(ws + WS_H), DFF, ssq + ((l) ? 5 : 2) * T, 1.f / 1024.f, 1}); PH_END(p0 + 3)
    XATTN_MLP(0, 8)
    PH_BEGIN(12) run_gemm<EpiResid, false>(lds, (const bf16_t*)(ws + WS_H), DFF, (const bf16_t*)(ws + W_DOWN), T, 1024, DFF, EpiResid{P.out, DRYOUT, XB, ssq + 3 * T, dry}); PH_END(12)
    PH_BEGIN(13) run_gemm<EpiScale, true>(lds, XB, 1024, (const bf16_t*)(ws + W_INO), T, 2048, 1024, EpiScale{(bf16_t*)(ws + WS_PROJ1), 2048, ssq + 3 * T, 1.f / 1024.f, 0}); PH_END(13)
    PH_BEGIN(14) phase_mix1(P); PH_END(14)
    PH_BEGIN(15) run_gemm<EpiScale, false>(lds, (const bf16_t*)(ws + WS_POOLED), 512, (const bf16_t*)(ws + W_POOL), T, 512, 512, EpiScale{Y + 512, 1024, nullptr, 0.f, 0}); PH_END(15)
    PH_BEGIN(16) run_gemm<EpiResid, false>(lds, Y, 1024, (const bf16_t*)(ws + W_OUTO), T, 1024, 1024, EpiResid{P.out, DRYOUT, XB, ssq + 4 * T, dry}); PH_END(16)
    XATTN_MLP(1, 17)
    PH_BEGIN(21) run_gemm<EpiResid, false>(lds, (const bf16_t*)(ws + WS_H), DFF, (const bf16_t*)(ws + W_DOWN) + (size_t)1024 * 4096, T, 1024, DFF, EpiResid{P.out, DRYOUT, nullptr, nullptr, dry}); PH_END(21)
}

#ifndef MK_MULTI
#define MK_MULTI 0
#endif
extern "C" void kernel_launch(void* const* d_in, const int* in_sizes, int n_in, void* d_out, int out_size, void* d_ws, size_t ws_size, hipStream_t stream) {
    static int grid = 0;
    if (grid == 0) {
        if (n_in != 33 || out_size != T * D || ws_size < WS_END) { fprintf(stderr, "kernel_launch: unexpected shapes (n_in %d out %d ws %zu)\n", n_in, out_size, ws_size); grid = -1; return; }
        int dev = 0, cus = 0, per_cu = 0;
        hipGetDevice(&dev); hipDeviceGetAttribute(&cus, hipDeviceAttributeMultiprocessorCount, dev);
        hipFuncSetAttribute((const void*)mega<false>, hipFuncAttributeMaxDynamicSharedMemorySize, LDS_BYTES);
        hipOccupancyMaxActiveBlocksPerMultiprocessor(&per_cu, (const void*)mega<false>, NTHR, LDS_BYTES);
        if (per_cu < 1) { fprintf(stderr, "kernel_launch: occupancy query says %d blocks/CU\n", per_cu); per_cu = 1; }
        (void)hipGetLastError();
        grid = cus * 1;
    }
    if (grid < 0) return;
    Params p{};
    for (int i = 0; i < 33; ++i) p.in[i] = (const float*)d_in[i];
    p.out = (float*)d_out; p.ws = (unsigned char*)d_ws;
    (void)hipMemsetAsync((char*)d_ws + WS_BAR, 0, XCD_BAR_WORDS * 4, stream);
#if MK_MULTI
    for (int ph = 0; ph < NPHASE; ++ph) hipLaunchKernelGGL(mega<false>, dim3(grid), dim3(NTHR), LDS_BYTES, stream, p, ph, ph + 1);
#else
    int lo = 0, hi = NPHASE;
    void* args[] = {&p, &lo, &hi};
    hipError_t e = hipLaunchCooperativeKernel((const void*)mega<false>, dim3(grid), dim3(NTHR), args, LDS_BYTES, stream);
    if (e != hipSuccess) fprintf(stderr, "cooperative launch failed: %s (grid %d)\n", hipGetErrorString(e), grid);
#endif
#if MK_XPH >= 0
    { static bool once = false; if (!once) { (void)hipFuncSetAttribute((const void*)mega<true>, hipFuncAttributeMaxDynamicSharedMemorySize, LDS_BYTES); once = true; } }
    for (int i = 0; i < MK_XN; ++i) hipLaunchKernelGGL(mega<true>, dim3(grid), dim3(NTHR), LDS_BYTES, stream, p, MK_XPH, MK_XPH + 1);
#endif
}
```

```cpp
#include <hip/hip_runtime.h>
#include <hip/hip_cooperative_groups.h>
#include <cstdio>
#include <cstdint>
namespace cg = cooperative_groups;
#ifndef MK_SEL2
#define MK_SEL2 0
#define MK_SC2 0
#define MK_BIS2 0
#define MK_AX 0
#define MK_TPROBE 0
#endif

#define DEVI __device__ __forceinline__
#define LAS __attribute__((address_space(3)))
typedef unsigned short bf16_t;
typedef short bf16x8 __attribute__((ext_vector_type(8)));
typedef short s16x4 __attribute__((ext_vector_type(4)));
typedef float f32x2 __attribute__((ext_vector_type(2)));
typedef float f32x4 __attribute__((ext_vector_type(4)));
typedef float f32x16 __attribute__((ext_vector_type(16)));
typedef unsigned u32x2 __attribute__((ext_vector_type(2)));
typedef unsigned u32x4 __attribute__((ext_vector_type(4)));
typedef unsigned long long u64;

constexpr int NB = 4, S = 4096, T = NB * S, D = 1024, DFF = 4096, MEML = 256, MEMT = NB * MEML;
constexpr int LDP = 2816;
constexpr int C_QA = 0, C_KA = 512, C_VA = 1024, C_QB = 1536, C_CKV = 2048, C_QI = 2304, C_KI = 2560, C_WI = 2624, EVEN_IN = 2628;
constexpr float EPS = 1e-6f;
constexpr float LOG2E = 1.4426950408889634f;
constexpr int NTHR = 512, NWAVE = 8;
constexpr int LDS_BYTES = 147456;

constexpr size_t MiB = 1u << 20;
constexpr size_t WS_SSQ = 0;
constexpr size_t WS_SSQCKV = WS_SSQ + 6ull * T * 4;
constexpr size_t WS_SSQMEM = WS_SSQCKV + (size_t)T * 4;
constexpr size_t WS_WI = 512 * 1024;
constexpr size_t WS_BAR = 1 * MiB;
constexpr size_t WS_W = 2 * MiB;
constexpr size_t W_INE = WS_W;
constexpr size_t W_KVUP = W_INE + (size_t)LDP * 1024 * 2;
constexpr size_t W_OUTE = W_KVUP + 1024ull * 256 * 2;
constexpr size_t W_QX = W_OUTE + 1024ull * 1024 * 2;
constexpr size_t W_KVX = W_QX + 2 * 512ull * 1024 * 2;
constexpr size_t W_OX = W_KVX + 2 * 1024ull * 1024 * 2;
constexpr size_t W_UP = W_OX + 2 * 1024ull * 512 * 2;
constexpr size_t W_DOWN = W_UP + 2 * 4096ull * 1024 * 2;
constexpr size_t W_INO = W_DOWN + 2 * 4096ull * 1024 * 2;
constexpr size_t W_POOL = W_INO + 2048ull * 1024 * 2;
constexpr size_t W_OUTO = W_POOL + 512ull * 512 * 2;
constexpr size_t W_END = W_OUTO + 1024ull * 1024 * 2;
static_assert(W_END <= 57 * MiB, "weights region");
constexpr size_t WS_XB = 57 * MiB;
constexpr size_t WS_PROJ = 89 * MiB;
constexpr size_t WS_KBVB = 177 * MiB;
constexpr size_t WS_MASK = 209 * MiB;
constexpr size_t WS_Y = 217 * MiB;
constexpr size_t WS_CS = 249 * MiB;
constexpr size_t WS_MB = 250 * MiB;
constexpr size_t WS_KVX = 252 * MiB;
constexpr size_t WS_END = 256 * MiB;
constexpr size_t WS_QX = WS_PROJ;
constexpr size_t WS_YX = WS_PROJ + 16 * MiB;
constexpr size_t WS_H = WS_PROJ;
constexpr size_t WS_PROJ1 = WS_PROJ;
constexpr size_t WS_POOLED = WS_PROJ + 64 * MiB;
constexpr size_t WS_KI = WS_Y;

struct Params { const float* in[33]; float* out; unsigned char* ws; };

DEVI float bf2f(bf16_t v) { return __uint_as_float(((unsigned)v) << 16); }
DEVI unsigned f2bf(float f) { unsigned u = __float_as_uint(f); return (u + 0x7fffu + ((u >> 16) & 1u)) >> 16; }
DEVI unsigned pk2(float lo, float hi) { return f2bf(lo) | (f2bf(hi) << 16); }
DEVI float wave_sum(float v) {
#pragma unroll
    for (int o = 1; o < 64; o <<= 1) v += __shfl_xor(v, o);
    return v;
}
DEVI float lo16(unsigned w) { return __uint_as_float(w << 16); }
DEVI float hi16(unsigned w) { return __uint_as_float(w & 0xffff0000u); }
#define LDS_WAIT() asm volatile("s_waitcnt lgkmcnt(0)" ::: "memory")
DEVI unsigned cvtpk(float lo, float hi) { typedef __bf16 bf2 __attribute__((ext_vector_type(2))); f32x2 v = {lo, hi}; bf2 b = __builtin_convertvector(v, bf2); return __builtin_bit_cast(unsigned, b); }

DEVI int tid_opaque() { int w = __builtin_amdgcn_readfirstlane(threadIdx.x >> 6); asm volatile("" : "+s"(w)); const int l = __builtin_amdgcn_mbcnt_hi(~0u, __builtin_amdgcn_mbcnt_lo(~0u, 0u)); return w * 64 + l; }
struct TrD { const float* src; bf16_t* dst; const float* sk; const float* sn; int K, N, ldd; };
constexpr int NTR = 19;
DEVI TrD get_tr(const Params& P, int i) {
    unsigned char* ws = P.ws; TrD d; d.sk = nullptr; d.sn = nullptr;
    switch (i) {
    case 0: d.src = P.in[14]; d.dst = (bf16_t*)(ws + W_INE); d.K = 1024; d.N = EVEN_IN; d.ldd = 1024; d.sk = P.in[3]; break;
    case 1: d.src = P.in[23]; d.dst = (bf16_t*)(ws + W_KVUP); d.K = 256; d.N = 1024; d.ldd = 256; d.sk = P.in[22]; break;
    case 2: d.src = P.in[27]; d.dst = (bf16_t*)(ws + W_OUTE); d.K = 1024; d.N = 1024; d.ldd = 1024; break;
    case 3: case 4: { int l = i - 3; d.src = P.in[7] + (size_t)l * 1024 * 512; d.dst = (bf16_t*)(ws + W_QX) + (size_t)l * 512 * 1024; d.K = 1024; d.N = 512; d.ldd = 1024; d.sk = P.in[4] + l * 1024; } break;
    case 5: case 6: { int l = i - 5; d.src = P.in[8] + (size_t)l * 1024 * 1024; d.dst = (bf16_t*)(ws + W_KVX) + (size_t)l * 1024 * 1024; d.K = 1024; d.N = 1024; d.ldd = 1024; d.sk = P.in[5] + l * 1024; } break;
    case 7: case 8: { int l = i - 7; d.src = P.in[11] + (size_t)l * 512 * 1024; d.dst = (bf16_t*)(ws + W_OX) + (size_t)l * 1024 * 512; d.K = 512; d.N = 1024; d.ldd = 512; } break;
    case 9: case 10: { int l = i - 9; d.src = P.in[12] + (size_t)l * 1024 * 4096; d.dst = (bf16_t*)(ws + W_UP) + (size_t)l * 4096 * 1024; d.K = 1024; d.N = 4096; d.ldd = 1024; d.sk = P.in[6] + l * 1024; } break;
    case 11: case 12: { int l = i - 11; d.src = P.in[13] + (size_t)l * 4096 * 1024; d.dst = (bf16_t*)(ws + W_DOWN) + (size_t)l * 1024 * 4096; d.K = 4096; d.N = 1024; d.ldd = 4096; } break;
    case 13: d.src = P.in[28]; d.dst = (bf16_t*)(ws + W_INO); d.K = 1024; d.N = 2048; d.ldd = 1024; d.sk = P.in[3] + 1024; break;
    case 14: case 15: case 16: case 17: d.src = P.in[30]; d.dst = (bf16_t*)(ws + W_POOL); d.K = 0; d.N = 32; d.ldd = 512; break;
    default: d.src = P.in[32]; d.dst = (bf16_t*)(ws + W_OUTO); d.K = 512; d.N = 1024; d.ldd = 1024; break;
    }
    return d;
}
DEVI int tr_items(const TrD& d) { return (d.K / 64) * ((d.N + 31) / 32); }
template <bool SK, bool SN>
DEVI void tr_item(const TrD& d, LAS float* scr, int item, int lane) {
    const int nblk = (d.N + 31) / 32, kb = item / nblk, nb = item % nblk, k0 = 64 * kb, n0 = 32 * nb;
    const int n = n0 + (lane & 31), nc = (n < d.N) ? n : (d.N - 1);
    const float* sp = d.src + (size_t)(k0 + (lane >> 5)) * d.N + nc;
    float v[32], sk[32];
#pragma unroll
    for (int i = 0; i < 32; ++i) { v[i] = sp[(size_t)(2 * i) * d.N]; if (SK) sk[i] = d.sk[k0 + 2 * i + (lane >> 5)]; }
#pragma unroll
    for (int i = 0; i < 32; ++i) { float x = v[i]; if (SK) x *= sk[i]; if (n >= d.N) x = 0.f; scr[(2 * i + (lane >> 5)) * 33 + (lane & 31)] = x; }
    LDS_WAIT(); asm volatile("" ::: "memory");
    const int c = lane & 7;
#pragma unroll
    for (int j = 0; j < 4; ++j) {
        const int nn = (lane >> 3) + 8 * j, ncl = (n0 + nn < d.N) ? (n0 + nn) : (d.N - 1);
        const LAS float* s = scr + (8 * c) * 33 + nn;
        float sc = 1.f; if (SN) sc = d.sn[ncl];
        u32x4 o; o.x = pk2(s[0 * 33] * sc, s[1 * 33] * sc); o.y = pk2(s[2 * 33] * sc, s[3 * 33] * sc); o.z = pk2(s[4 * 33] * sc, s[5 * 33] * sc); o.w = pk2(s[6 * 33] * sc, s[7 * 33] * sc);
        if (n0 + nn < d.N) *(u32x4*)(d.dst + (size_t)(n0 + nn) * d.ldd + k0 + 8 * c) = o;
    }
    LDS_WAIT(); asm volatile("" ::: "memory");
}
DEVI void row_to_bf16_ssq(const float* xrow, bf16_t* orow, float* ssq_out, int lane) {
    const f32x4* xr = (const f32x4*)xrow + lane;
    f32x4 v[4]; float s = 0.f;
#pragma unroll
    for (int j = 0; j < 4; ++j) { v[j] = xr[64 * j]; s += (v[j].x * v[j].x + v[j].y * v[j].y) + (v[j].z * v[j].z + v[j].w * v[j].w); }
    s = wave_sum(s);
    if (lane == 0) *ssq_out = s;
    u32x2* o8 = (u32x2*)orow + lane;
#pragma unroll
    for (int j = 0; j < 4; ++j) { u32x2 w; w.x = pk2(v[j].x, v[j].y); w.y = pk2(v[j].z, v[j].w); o8[64 * j] = w; }
}
#ifndef MK_SUB
#define MK_SUB 0
#endif
DEVI void phase_prologue(const Params& P, LAS unsigned char* lds, int dry = 0) {
    const int tid = tid_opaque(), lane = tid & 63, wave = tid >> 6;
    const int gw = blockIdx.x * NWAVE + wave, NGW = gridDim.x * NWAVE;
    const int gt = blockIdx.x * NTHR + tid, NGT = gridDim.x * NTHR;
    unsigned char* ws = P.ws;
    LAS float* scr = (LAS float*)(lds + wave * 16384);
    int base = 0;
    if (!(dry && MK_SUB != 1 && MK_SUB != 0))
    for (int i = 0; i < NTR; ++i) {
        const TrD d = get_tr(P, i); const int n = tr_items(d);
        int first = gw - (base % NGW); if (first < 0) first += NGW;
        if (d.sn) { for (int it = first; it < n; it += NGW) tr_item<false, true>(d, scr, it, lane); }
        else if (d.sk) { for (int it = first; it < n; it += NGW) tr_item<true, false>(d, scr, it, lane); }
        else { for (int it = first; it < n; it += NGW) tr_item<false, false>(d, scr, it, lane); }
        base += n;
    }
    { bf16_t* w = (bf16_t*)(ws + W_INE) + (size_t)EVEN_IN * 1024; const int n = (LDP - EVEN_IN) * 1024 / 8;
      for (int i = gt; i < n; i += NGT) ((u32x4*)w)[i] = (u32x4){0u, 0u, 0u, 0u}; }
    for (int i = gt; i < 1024 * 64; i += NGT) {
        const int n = i & 1023, cp0 = (i >> 10) * 8, g = cp0 >> 7, c = cp0 & 127;
        const float* wo = P.in[32] + (size_t)(512 + g * 128) * 1024 + n; const float* wp = P.in[30] + (size_t)g * 16384 + (size_t)c * 128; const float* ps = P.in[31] + g * 128;
        float acc[8];
#pragma unroll
        for (int j = 0; j < 8; ++j) acc[j] = 0.f;
        for (int d0 = 0; d0 < 128; d0 += 8) {
            float wv[8];
#pragma unroll
            for (int dd = 0; dd < 8; ++dd) wv[dd] = wo[(size_t)(d0 + dd) * 1024] * ps[d0 + dd];
#pragma unroll
            for (int dd = 0; dd < 8; ++dd)
#pragma unroll
                for (int j = 0; j < 8; ++j) acc[j] += wp[j * 128 + d0 + dd] * wv[dd];
        }
        u32x4 w; w.x = pk2(acc[0], acc[1]); w.y = pk2(acc[2], acc[3]); w.z = pk2(acc[4], acc[5]); w.w = pk2(acc[6], acc[7]);
        *(u32x4*)((bf16_t*)(ws + W_OUTO) + (size_t)n * 1024 + 512 + cp0) = w;
    }
    { float* q = (float*)(ws + WS_SSQ) + T; for (int i = gt; i < 5 * T; i += NGT) q[i] = 0.f; }
    if (!(dry && MK_SUB != 2 && MK_SUB != 0))
    for (int m = gw; m < T; m += NGW) row_to_bf16_ssq(P.in[0] + (size_t)m * D, (bf16_t*)(ws + WS_XB) + (size_t)m * D, (float*)(ws + WS_SSQ) + m, lane);
    for (int m = gw; m < MEMT; m += NGW) row_to_bf16_ssq(P.in[1] + (size_t)m * D, (bf16_t*)(ws + WS_MB) + (size_t)m * D, (float*)(ws + WS_SSQMEM) + m, lane);
    if (!(dry && MK_SUB != 3 && MK_SUB != 0))
    { const int* pos = (const int*)P.in[2]; float* cs = (float*)(ws + WS_CS);
      for (int i = gt; i < T * 8; i += NGT) { const int m = i >> 3, f = i & 7;
        const double inv = (f == 0) ? 1.0 : (f == 1) ? 0.19392274474868576 : (f == 2) ? 0.03760603093086393 : (f == 3) ? 0.007292664737217109 : (f == 4) ? 0.001414213562373095
                         : (f == 5) ? 0.0002742481756762073 : (f == 6) ? 5.318295896944988e-05 : 1.031338537721246e-05;
        const double ang = (double)pos[m] * inv, k = rint(ang * 0.15915494309189535), r = fma(-k, 6.283185307179586, ang) - k * 2.4492935982947064e-16;
        cs[m * 16 + f] = cosf((float)r); cs[m * 16 + 8 + f] = sinf((float)r); } }
}

struct EpiStore {
    bf16_t* O; int ldo; const float* ssq; float inv_n; int act;
    DEVI void operator()(const f32x4 (&acc)[4][4], int row0, int col0, int lane) const {
#pragma unroll
        for (int m = 0; m < 4; ++m)
#pragma unroll
            for (int i = 0; i < 4; ++i) {
                const int row = row0 + 16 * m + (lane >> 4) * 4 + i;
                const float rs = ssq ? rsqrtf(ssq[row] * inv_n + EPS) : 1.f;
#pragma unroll
                for (int n = 0; n < 4; ++n) {
                    float v = acc[m][n][i] * rs;
                    if (act == 1) { v = fmaxf(v, 0.f); v = v * v; }
                    O[(size_t)row * ldo + col0 + 16 * n + (lane & 15)] = (bf16_t)f2bf(v);
                }
            }
    }
};
struct EpiRes {
    const float* base; float* out; bf16_t* xb; float* ssq_next;
    DEVI void operator()(const f32x4 (&acc)[4][4], int row0, int col0, int lane) const {
#pragma unroll
        for (int m = 0; m < 4; ++m)
#pragma unroll
            for (int i = 0; i < 4; ++i) {
                const int row = row0 + 16 * m + (lane >> 4) * 4 + i; float s = 0.f;
#pragma unroll
                for (int n = 0; n < 4; ++n) {
                    const size_t idx = (size_t)row * D + col0 + 16 * n + (lane & 15);
                    const float v = base[idx] + acc[m][n][i];
                    out[idx] = v; s += v * v;
                    if (xb) xb[idx] = (bf16_t)f2bf(v);
                }
                if (ssq_next) {
                    s += __shfl_xor(s, 1); s += __shfl_xor(s, 2); s += __shfl_xor(s, 4); s += __shfl_xor(s, 8);
                    if ((lane & 15) == 0) atomicAdd(ssq_next + row, s);
                }
            }
    }
};
template <class Epi>
DEVI void gemm_simple(const bf16_t* A, int lda, const bf16_t* Bt, int ldb, int M, int N, int K, const Epi& epi) {
    const int tid = tid_opaque(), lane = tid & 63, wave = tid >> 6;
    const int gw = blockIdx.x * NWAVE + wave, NGW = gridDim.x * NWAVE;
    const int nN = N / 64, ntiles = (M / 64) * nN;
    for (int tile = gw; tile < ntiles; tile += NGW) {
        const int row0 = (tile / nN) * 64, col0 = (tile % nN) * 64;
        f32x4 acc[4][4];
#pragma unroll
        for (int m = 0; m < 4; ++m)
#pragma unroll
            for (int n = 0; n < 4; ++n) acc[m][n] = (f32x4){0.f, 0.f, 0.f, 0.f};
        const bf16_t* ap = A + (size_t)(row0 + (lane & 15)) * lda + 8 * (lane >> 4);
        const bf16_t* bp = Bt + (size_t)(col0 + (lane & 15)) * ldb + 8 * (lane >> 4);
        for (int k0 = 0; k0 < K; k0 += 32) {
            bf16x8 a[4], b[4];
#pragma unroll
            for (int m = 0; m < 4; ++m) a[m] = *(const bf16x8*)(ap + (size_t)(16 * m) * lda + k0);
#pragma unroll
            for (int n = 0; n < 4; ++n) b[n] = *(const bf16x8*)(bp + (size_t)(16 * n) * ldb + k0);
#pragma unroll
            for (int m = 0; m < 4; ++m)
#pragma unroll
                for (int n = 0; n < 4; ++n) acc[m][n] = __builtin_amdgcn_mfma_f32_16x16x32_bf16(a[m], b[n], acc[m][n], 0, 0, 0);
        }
        epi(acc, row0, col0, lane);
    }
}

DEVI u32x4 heads8(u32x4 raw, const float (&gv)[8], bool do_norm, float scale, const float (&cs)[16], int lane) {
    float v[8];
#pragma unroll
    for (int j = 0; j < 4; ++j) { v[2 * j] = lo16(raw[j]); v[2 * j + 1] = hi16(raw[j]); }
    if (do_norm) {
        float ss = 0.f;
#pragma unroll
        for (int j = 0; j < 8; ++j) ss += v[j] * v[j];
        ss += __shfl_xor(ss, 1); ss += __shfl_xor(ss, 2); ss += __shfl_xor(ss, 4);
        const float rs = rsqrtf(ss * (1.f / 64.f) + EPS);
#pragma unroll
        for (int j = 0; j < 8; ++j) v[j] = v[j] * rs * gv[j];
    }
    const int sub = lane & 7;
#pragma unroll
    for (int j = 0; j < 8; ++j) { const float o = __shfl_xor(v[j], 1); if (sub == 0) v[j] = v[j] * cs[j] - o * cs[8 + j]; else if (sub == 1) v[j] = v[j] * cs[j] + o * cs[8 + j]; }
    u32x4 w;
#pragma unroll
    for (int j = 0; j < 4; ++j) w[j] = cvtpk(v[2 * j] * scale, v[2 * j + 1] * scale);
    return w;
}
DEVI void load8(float (&g)[8], const float* p) { const f32x4 a = *(const f32x4*)p, b = *(const f32x4*)(p + 4); g[0] = a[0]; g[1] = a[1]; g[2] = a[2]; g[3] = a[3]; g[4] = b[0]; g[5] = b[1]; g[6] = b[2]; g[7] = b[3]; }
struct Post0Row { u32x4 qa, ka, qb, x, ckv; u32x2 wi; f32x4 c0, c1, c2, c3; };
DEVI void post0_load(Post0Row& R, const bf16_t* row, const float* cs, int lane) {
    R.qa = *(const u32x4*)(row + C_QA + 8 * lane); R.ka = *(const u32x4*)(row + C_KA + 8 * lane); R.qb = *(const u32x4*)(row + C_QB + 8 * lane);
    R.x = *(const u32x4*)(row + C_QI + 8 * ((lane < 40) ? lane : 0));
    R.ckv = *(const u32x4*)(row + C_CKV + 8 * (lane & 31));
    R.wi = *(const u32x2*)(row + C_WI);
    R.c0 = *(const f32x4*)cs; R.c1 = *(const f32x4*)(cs + 4); R.c2 = *(const f32x4*)(cs + 8); R.c3 = *(const f32x4*)(cs + 12);
}
DEVI void phase_post0(const Params& P) {
    static_assert(C_KI == C_QI + 256, "k_idx follows q_idx");
    const int tid = tid_opaque(), lane = tid & 63, wave = tid >> 6;
    const int gw = blockIdx.x * NWAVE + wave, NGW = gridDim.x * NWAVE;
    unsigned char* ws = P.ws;
    const float qscale = 0.125f * LOG2E;
    float gqa[8], gka[8], gqb[8], gki[8];
    load8(gqa, P.in[15] + 8 * (lane & 7)); load8(gka, P.in[16] + 8 * (lane & 7)); load8(gqb, P.in[24] + 8 * (lane & 7)); load8(gki, P.in[26] + 8 * (lane & 7));
    for (int m0 = gw; m0 < T; m0 += 2 * NGW) {
        Post0Row R[2];
        const int m1 = (m0 + NGW < T) ? m0 + NGW : m0;
        post0_load(R[0], (const bf16_t*)(ws + WS_PROJ) + (size_t)m0 * LDP, (const float*)(ws + WS_CS) + (size_t)m0 * 16, lane);
        post0_load(R[1], (const bf16_t*)(ws + WS_PROJ) + (size_t)m1 * LDP, (const float*)(ws + WS_CS) + (size_t)m1 * 16, lane);
#pragma unroll
        for (int k = 0; k < 2; ++k) {
            const int m = k ? m1 : m0; if (k == 1 && m1 == m0) break;
            bf16_t* row = (bf16_t*)(ws + WS_PROJ) + (size_t)m * LDP;
            float cs[16];
#pragma unroll
            for (int j = 0; j < 4; ++j) { cs[j] = R[k].c0[j]; cs[4 + j] = R[k].c1[j]; cs[8 + j] = R[k].c2[j]; cs[12 + j] = R[k].c3[j]; }
            *(u32x4*)(row + C_QA + 8 * lane) = heads8(R[k].qa, gqa, true, qscale, cs, lane);
            *(u32x4*)(row + C_KA + 8 * lane) = heads8(R[k].ka, gka, true, 1.f, cs, lane);
            *(u32x4*)(row + C_QB + 8 * lane) = heads8(R[k].qb, gqb, true, qscale, cs, lane);
            {
              float v[8];
#pragma unroll
              for (int j = 0; j < 4; ++j) { v[2 * j] = lo16(R[k].x[j]); v[2 * j + 1] = hi16(R[k].x[j]); }
              float ss = 0.f;
#pragma unroll
              for (int j = 0; j < 8; ++j) ss += v[j] * v[j];
              ss += __shfl_xor(ss, 1); ss += __shfl_xor(ss, 2); ss += __shfl_xor(ss, 4);
              if (lane >= 32) { const float rs = rsqrtf(ss * (1.f / 64.f) + EPS);
#pragma unroll
                  for (int j = 0; j < 8; ++j) v[j] = v[j] * rs * gki[j]; }
              const int sub = lane & 7;
#pragma unroll
              for (int j = 0; j < 8; ++j) { const float o = __shfl_xor(v[j], 1); if (sub == 0) v[j] = v[j] * cs[j] - o * cs[8 + j]; else if (sub == 1) v[j] = v[j] * cs[j] + o * cs[8 + j]; }
              u32x4 w;
#pragma unroll
              for (int j = 0; j < 4; ++j) w[j] = cvtpk(v[2 * j], v[2 * j + 1]);
              if (lane < 32) *(u32x4*)(row + C_QI + 8 * lane) = w;
              else if (lane < 40) { const int c = lane - 32;
                  *(u32x4*)((bf16_t*)(ws + WS_KI) + (size_t)(m >> 5) * 2048 + (c >> 1) * 512 + (((c & 1) * 32 + (m & 31)) * 8)) = w; } }
            { float ss = 0.f;
#pragma unroll
              for (int j = 0; j < 4; ++j) { const float a = lo16(R[k].ckv[j]), b = hi16(R[k].ckv[j]); ss += a * a + b * b; }
              ss += __shfl_xor(ss, 1); ss += __shfl_xor(ss, 2); ss += __shfl_xor(ss, 4); ss += __shfl_xor(ss, 8); ss += __shfl_xor(ss, 16);
              if (lane == 0) { ((float*)(ws + WS_SSQCKV))[m] = ss;
                  *(f32x4*)((float*)(ws + WS_WI) + (size_t)m * 4) = (f32x4){lo16(R[k].wi.x) * (1.f / 16.f), hi16(R[k].wi.x) * (1.f / 16.f), lo16(R[k].wi.y) * (1.f / 16.f), hi16(R[k].wi.y) * (1.f / 16.f)}; } }
        }
    }
    for (int it = gw; it < 2 * MEMT; it += NGW) {
        const int l = it / MEMT, m = it % MEMT;
        bf16_t* row = (bf16_t*)(ws + WS_KVX) + (size_t)m * 2048 + l * 1024;
        float g[8]; load8(g, P.in[10] + l * 128 + 8 * (lane & 15));
        const u32x4 raw = *(const u32x4*)(row + 8 * lane);
        float v[8]; float ss = 0.f;
#pragma unroll
        for (int j = 0; j < 4; ++j) { v[2 * j] = lo16(raw[j]); v[2 * j + 1] = hi16(raw[j]); ss += v[2 * j] * v[2 * j] + v[2 * j + 1] * v[2 * j + 1]; }
        ss += __shfl_xor(ss, 1); ss += __shfl_xor(ss, 2); ss += __shfl_xor(ss, 4); ss += __shfl_xor(ss, 8);
        const float rs = rsqrtf(ss * (1.f / 128.f) + EPS);
        u32x4 w;
#pragma unroll
        for (int j = 0; j < 4; ++j) w[j] = cvtpk(v[2 * j] * rs * g[2 * j], v[2 * j + 1] * rs * g[2 * j + 1]);
        *(u32x4*)(row + 8 * lane) = w;
    }
}
DEVI void phase_postkb(const Params& P) {
    const int tid = tid_opaque(), lane = tid & 63, wave = tid >> 6;
    const int gw = blockIdx.x * NWAVE + wave, NGW = gridDim.x * NWAVE;
    unsigned char* ws = P.ws;
    float gkb[8]; load8(gkb, P.in[25] + 8 * (lane & 7));
    for (int m0 = gw; m0 < T; m0 += 4 * NGW) {
        u32x4 raw[4]; f32x4 c[4][4];
#pragma unroll
        for (int k = 0; k < 4; ++k) { const int m = (m0 + k * NGW < T) ? m0 + k * NGW : m0;
            raw[k] = *(const u32x4*)((const bf16_t*)(ws + WS_KBVB) + (size_t)m * 1024 + 8 * lane);
            const float* cs = (const float*)(ws + WS_CS) + (size_t)m * 16;
#pragma unroll
            for (int j = 0; j < 4; ++j) c[k][j] = *(const f32x4*)(cs + 4 * j); }
#pragma unroll
        for (int k = 0; k < 4; ++k) { const int m = m0 + k * NGW; if (m >= T) break;
            float cs[16];
#pragma unroll
            for (int j = 0; j < 16; ++j) cs[j] = c[k][j >> 2][j & 3];
            *(u32x4*)((bf16_t*)(ws + WS_KBVB) + (size_t)m * 1024 + 8 * lane) = heads8(raw[k], gkb, true, 1.f, cs, lane); }
    }
}

DEVI int crow(int r, int hi) { return (r & 3) + 8 * (r >> 2) + 4 * hi; }
typedef short v4i16_t __attribute__((ext_vector_type(4)));
DEVI s16x4 vtr(LAS const unsigned char* p) { return __builtin_bit_cast(s16x4, __builtin_amdgcn_ds_read_tr16_b64_v4i16((LAS v4i16_t*)p)); }

DEVI float max3f(float a, float b, float c) { float r; asm("v_max3_f32 %0, %1, %2, %3" : "=v"(r) : "v"(a), "v"(b), "v"(c)); return r; }
DEVI float max2f(float a, float b) { float r; asm("v_max_f32_e32 %0, %1, %2" : "=v"(r) : "v"(a), "v"(b)); return r; }
template <int DQK, int DV, int MODE>
DEVI void attn_core(f32x16 (&o)[DV / 32], float& l_out, const bf16x8 (&qf)[DQK / 16],
                    const bf16_t* Kg, int ldk, const bf16_t* Vg, int ldv, int ntiles, int qpos, int qpos_wmin,
                    const u64* mrow, LAS unsigned char* lds, int tid) {
    constexpr int KROWB = DQK * 2, KCPR = DQK / 8, VP = (DV == 128) ? 320 : 192, VCPR = DV / 8;
    constexpr int KBUF = 64 * KROWB, VBUF = 64 * VP, KCH = 64 * KCPR / NTHR, VCH = 64 * VCPR / NTHR;
    constexpr float THR = 8.f;
    LAS unsigned char* Kl = lds; LAS unsigned char* Vl = lds + 2 * KBUF;
    const int lane = tid & 63, r32 = lane & 31, hi = lane >> 5;
    u32x4 kreg[KCH], vreg[VCH];
#define A_GLOAD(t) do { _Pragma("unroll") for (int i_ = 0; i_ < KCH; ++i_) { const int c_ = tid + NTHR * i_, row_ = c_ / KCPR, ch_ = c_ % KCPR; kreg[i_] = *(const u32x4*)(Kg + (size_t)(64 * (t) + row_) * ldk + ch_ * 8); } \
        _Pragma("unroll") for (int i_ = 0; i_ < VCH; ++i_) { const int c_ = tid + NTHR * i_, row_ = c_ / VCPR, ch_ = c_ % VCPR; vreg[i_] = *(const u32x4*)(Vg + (size_t)(64 * (t) + row_) * ldv + ch_ * 8); } } while (0)
#define A_LSTORE(buf) do { _Pragma("unroll") for (int i_ = 0; i_ < KCH; ++i_) { const int c_ = tid + NTHR * i_, row_ = c_ / KCPR, ch_ = c_ % KCPR; *(LAS u32x4*)(Kl + (buf) * KBUF + row_ * KROWB + ((ch_ ^ (row_ & (KCPR - 1))) << 4)) = kreg[i_]; } \
        _Pragma("unroll") for (int i_ = 0; i_ < VCH; ++i_) { const int c_ = tid + NTHR * i_, row_ = c_ / VCPR, ch_ = c_ % VCPR; *(LAS u32x4*)(Vl + (buf) * VBUF + row_ * VP + ch_ * 16) = vreg[i_]; } } while (0)
    A_GLOAD(0); A_LSTORE(0); __syncthreads();
    const int vb = (4 * hi + ((lane & 15) >> 2)) * VP + (16 * ((lane >> 4) & 1) + 4 * (lane & 3)) * 2;
    const short one = (short)0x3F80;
    const bf16x8 ones = ((r32 & ~4) == 0) ? (bf16x8){one, one, one, one, one, one, one, one} : (bf16x8){0, 0, 0, 0, 0, 0, 0, 0};
    f32x16 negm, lacc;
#pragma unroll
    for (int r = 0; r < 16; ++r) { negm[r] = 0.f; lacc[r] = 0.f; }
    float mhat = 0.f;
    const unsigned ninf = 0xFF800000u;
#if MK_AX == 1
    f32x16 dmy_;
#pragma unroll
    for (int r = 0; r < 16; ++r) dmy_[r] = 0.f;
#endif
    for (int t = 0; t < ntiles; ++t) {
        const int buf = t & 1;
        if (t + 1 < ntiles) A_GLOAD(t + 1);
        f32x16 p0, p1;
#pragma unroll
        for (int d0 = 0; d0 < DQK / 16; ++d0) {
            const int ch = 2 * d0 + hi, row0 = r32, row1 = 32 + r32;
            const bf16x8 a0 = *(LAS const bf16x8*)(Kl + buf * KBUF + row0 * KROWB + ((ch ^ (row0 & (KCPR - 1))) << 4));
            const bf16x8 a1 = *(LAS const bf16x8*)(Kl + buf * KBUF + row1 * KROWB + ((ch ^ (row1 & (KCPR - 1))) << 4));
            if (d0 == 0) { p0 = __builtin_amdgcn_mfma_f32_32x32x16_bf16(a0, qf[0], negm, 0, 0, 0); p1 = __builtin_amdgcn_mfma_f32_32x32x16_bf16(a1, qf[0], negm, 0, 0, 0); }
            else { p0 = __builtin_amdgcn_mfma_f32_32x32x16_bf16(a0, qf[d0], p0, 0, 0, 0); p1 = __builtin_amdgcn_mfma_f32_32x32x16_bf16(a1, qf[d0], p1, 0, 0, 0); }
        }
        if (MODE == 1) {
            if (64 * t + 63 > qpos_wmin) {
#pragma unroll
                for (int r = 0; r < 16; ++r) { const int kv = 64 * t + crow(r, hi); if (kv > qpos) p0[r] = -INFINITY; if (kv + 32 > qpos) p1[r] = -INFINITY; }
            }
        } else if (MODE == 2) {
            const u64 w = mrow[t] >> (4 * hi); const unsigned wl = (unsigned)w, wh = (unsigned)(w >> 32);
#pragma unroll
            for (int r = 0; r < 16; ++r) { const int bit = (r & 3) + 8 * (r >> 2);
                const unsigned s0 = (unsigned)__builtin_amdgcn_sbfe(wl, bit, 1), s1 = (unsigned)__builtin_amdgcn_sbfe(wh, bit, 1);
                p0[r] = __uint_as_float((__float_as_uint(p0[r]) & s0) | (ninf & ~s0)); p1[r] = __uint_as_float((__float_as_uint(p1[r]) & s1) | (ninf & ~s1)); }
        }
        asm volatile("s_nop 15\n\ts_nop 7" : "+v"(p0), "+v"(p1));
        float rm;
        { float a = max3f(p0[0], p0[1], p1[0]), b = max3f(p0[2], p0[3], p1[1]); a = max3f(a, p1[2], p1[3]);
#pragma unroll
          for (int r = 4; r < 16; r += 4) { a = max3f(a, p0[r], p0[r + 1]); b = max3f(b, p0[r + 2], p0[r + 3]); a = max3f(a, p1[r], p1[r + 1]); b = max3f(b, p1[r + 2], p1[r + 3]); }
          const float m = max2f(a, b);
          const auto rr = __builtin_amdgcn_permlane32_swap(__float_as_uint(m), __float_as_uint(m), false, false);
          rm = max2f(__uint_as_float(rr[0]), __uint_as_float(rr[1])); }
        if (t == 0 || __any(rm > THR)) {
            const float dl = (t == 0) ? ((rm > -INFINITY) ? rm : 0.f) : fmaxf(rm, 0.f);
            mhat += dl;
#pragma unroll
            for (int r = 0; r < 16; ++r) { p0[r] -= dl; p1[r] -= dl; negm[r] = -mhat; }
            const float f = __builtin_amdgcn_exp2f(-dl);
#pragma unroll
            for (int d0 = 0; d0 < DV / 32; ++d0)
#pragma unroll
                for (int r = 0; r < 16; ++r) o[d0][r] *= f;
#pragma unroll
            for (int r = 0; r < 16; ++r) lacc[r] *= f;
        }
#pragma unroll
        for (int r = 0; r < 16; ++r) { p0[r] = __builtin_amdgcn_exp2f(p0[r]); p1[r] = __builtin_amdgcn_exp2f(p1[r]); }
#if MK_AX == 2
        if (MODE == 1) {
#pragma unroll
            for (int r = 0; r < 16; ++r) { float e0 = __builtin_amdgcn_exp2f(p0[r] * 0.999f), e1 = __builtin_amdgcn_exp2f(p1[r] * 0.999f); asm volatile("" :: "v"(e0), "v"(e1)); } }
#endif
        bf16x8 pb[4];
#pragma unroll
        for (int ks = 0; ks < 4; ++ks) {
            u32x4 w;
            if (ks < 2) { w.x = cvtpk(p0[8 * ks + 0], p0[8 * ks + 1]); w.y = cvtpk(p0[8 * ks + 2], p0[8 * ks + 3]); w.z = cvtpk(p0[8 * ks + 4], p0[8 * ks + 5]); w.w = cvtpk(p0[8 * ks + 6], p0[8 * ks + 7]); }
            else { const int k2 = ks - 2; w.x = cvtpk(p1[8 * k2 + 0], p1[8 * k2 + 1]); w.y = cvtpk(p1[8 * k2 + 2], p1[8 * k2 + 3]); w.z = cvtpk(p1[8 * k2 + 4], p1[8 * k2 + 5]); w.w = cvtpk(p1[8 * k2 + 6], p1[8 * k2 + 7]); }
            pb[ks] = __builtin_bit_cast(bf16x8, w);
        }
#pragma unroll
        for (int ks = 0; ks < 4; ++ks) lacc = __builtin_amdgcn_mfma_f32_32x32x16_bf16(ones, pb[ks], lacc, 0, 0, 0);
#pragma unroll
        for (int d0 = 0; d0 < DV / 32; ++d0)
#pragma unroll
            for (int ks = 0; ks < 4; ++ks) {
                const s16x4 lo = vtr(Vl + buf * VBUF + vb + (16 * ks) * VP + d0 * 64);
                const s16x4 hh = vtr(Vl + buf * VBUF + vb + (16 * ks + 8) * VP + d0 * 64);
                const bf16x8 a = (bf16x8){lo[0], lo[1], lo[2], lo[3], hh[0], hh[1], hh[2], hh[3]};
                o[d0] = __builtin_amdgcn_mfma_f32_32x32x16_bf16(a, pb[ks], o[d0], 0, 0, 0);
#if MK_AX == 1
                if (MODE == 1) dmy_ = __builtin_amdgcn_mfma_f32_32x32x16_bf16(a, pb[ks], dmy_, 0, 0, 0);
#endif
            }
        if (t + 1 < ntiles) A_LSTORE((t + 1) & 1);
        __syncthreads();
    }
#if MK_AX == 1
    asm volatile("" :: "v"(dmy_));
#endif
    l_out = lacc[0];
#undef A_GLOAD
#undef A_LSTORE
}
template <int DV>
DEVI void store_oT(const f32x16 (&o)[DV / 32], float inv, bf16_t* dst, int hi) {
#pragma unroll
    for (int d0 = 0; d0 < DV / 32; ++d0)
#pragma unroll
        for (int g4 = 0; g4 < 4; ++g4) {
            u32x2 w; w.x = cvtpk(o[d0][4 * g4 + 0] * inv, o[d0][4 * g4 + 1] * inv); w.y = cvtpk(o[d0][4 * g4 + 2] * inv, o[d0][4 * g4 + 3] * inv);
            *(u32x2*)(dst + 32 * d0 + 8 * g4 + 4 * hi) = w;
        }
}

DEVI void attnA_unit(const Params& P, int b, int h, int c, int qb, LAS unsigned char* lds) {
    const int tid = tid_opaque(), lane = tid & 63, wave = tid >> 6, r32 = lane & 31, hi = lane >> 5;
    unsigned char* ws = P.ws;
    const bf16_t* proj = (const bf16_t*)(ws + WS_PROJ);
    const int q = qb * 256 + 32 * wave + r32; const size_t row = (size_t)b * S + q;
    bf16x8 qf[4];
#pragma unroll
    for (int d0 = 0; d0 < 4; ++d0) qf[d0] = *(const bf16x8*)(proj + row * LDP + C_QA + (2 * h + c) * 64 + 16 * d0 + 8 * hi);
    f32x16 o[4];
#pragma unroll
    for (int d0 = 0; d0 < 4; ++d0)
#pragma unroll
        for (int r = 0; r < 16; ++r) o[d0][r] = 0.f;
    float l_run = 0.f;
    attn_core<64, 128, 1>(o, l_run, qf, proj + (size_t)b * S * LDP + C_KA + (2 * h + c) * 64, LDP, proj + (size_t)b * S * LDP + C_VA + h * 128, LDP,
                          4 * (qb + 1), q, qb * 256 + 32 * wave, nullptr, lds, tid);
    const float lt = l_run;
    bf16_t* oa = (bf16_t*)(ws + WS_XB) + (size_t)c * T * 512 + row * 512 + h * 128;
    store_oT<128>(o, 1.f / lt, oa, hi);
}
DEVI void attnB_unit(const Params& P, int b, int hd, int qb, LAS unsigned char* lds) {
    const int tid = tid_opaque(), lane = tid & 63, wave = tid >> 6, r32 = lane & 31, hi = lane >> 5;
    unsigned char* ws = P.ws;
    const bf16_t* proj = (const bf16_t*)(ws + WS_PROJ); const bf16_t* kbvb = (const bf16_t*)(ws + WS_KBVB);
    const int q = qb * 256 + 32 * wave + r32; const size_t row = (size_t)b * S + q;
    bf16x8 qf[4];
#pragma unroll
    for (int d0 = 0; d0 < 4; ++d0) qf[d0] = *(const bf16x8*)(proj + row * LDP + C_QB + hd * 64 + 16 * d0 + 8 * hi);
    f32x16 o[2];
#pragma unroll
    for (int d0 = 0; d0 < 2; ++d0)
#pragma unroll
        for (int r = 0; r < 16; ++r) o[d0][r] = 0.f;
    float l_run = 0.f;
    attn_core<64, 64, 2>(o, l_run, qf, kbvb + (size_t)b * S * 1024 + hd * 64, 1024, kbvb + (size_t)b * S * 1024 + 512 + hd * 64, 1024,
                         4 * (qb + 1), q, qb * 256 + 32 * wave, (const u64*)(ws + WS_MASK) + row * 64, lds, tid);
    const float lt = l_run;
    store_oT<64>(o, 1.f / lt, (bf16_t*)(ws + WS_Y) + row * 1024 + 512 + hd * 64, hi);
}
DEVI void xattn_unit(const Params& P, int l, int b, int hd, int qb, LAS unsigned char* lds) {
    const int tid = tid_opaque(), lane = tid & 63, wave = tid >> 6, r32 = lane & 31, hi = lane >> 5;
    unsigned char* ws = P.ws;
    const bf16_t* qx = (const bf16_t*)(ws + WS_QX); const bf16_t* kvx = (const bf16_t*)(ws + WS_KVX) + l * 1024;
    const int q = qb * 256 + 32 * wave + r32; const size_t row = (size_t)b * S + q;
    const float* gq = P.in[9] + l * 128;
    u32x4 raw[8]; float ss = 0.f;
#pragma unroll
    for (int d0 = 0; d0 < 8; ++d0) { raw[d0] = *(const u32x4*)(qx + row * 512 + hd * 128 + 16 * d0 + 8 * hi);
#pragma unroll
        for (int j = 0; j < 4; ++j) { const float a = lo16(raw[d0][j]), bq = hi16(raw[d0][j]); ss += a * a + bq * bq; } }
    ss += __shfl_xor(ss, 32);
    const float rs = rsqrtf(ss * (1.f / 128.f) + EPS) * (0.08838834764831845f * LOG2E);
    bf16x8 qf[8];
#pragma unroll
    for (int d0 = 0; d0 < 8; ++d0) { u32x4 w;
#pragma unroll
        for (int j = 0; j < 4; ++j) { const int dim = 16 * d0 + 8 * hi + 2 * j; w[j] = cvtpk(lo16(raw[d0][j]) * rs * gq[dim], hi16(raw[d0][j]) * rs * gq[dim + 1]); }
        qf[d0] = __builtin_bit_cast(bf16x8, w); }
    f32x16 o[4];
#pragma unroll
    for (int d0 = 0; d0 < 4; ++d0)
#pragma unroll
        for (int r = 0; r < 16; ++r) o[d0][r] = 0.f;
    float l_run = 0.f;
    attn_core<128, 128, 0>(o, l_run, qf, kvx + (size_t)b * MEML * 2048 + hd * 128, 2048, kvx + (size_t)b * MEML * 2048 + 512 + hd * 128, 2048,
                           MEML / 64, q, 0, nullptr, lds, tid);
    const float lt = l_run;
    store_oT<128>(o, 1.f / lt, (bf16_t*)(ws + WS_YX) + row * 512 + hd * 128, hi);
}

DEVI int wave_sum_dpp(int v) {
    v += __builtin_amdgcn_update_dpp(0, v, 0xB1, 0xF, 0xF, false);
    v += __builtin_amdgcn_update_dpp(0, v, 0x4E, 0xF, 0xF, false);
    v += __builtin_amdgcn_update_dpp(0, v, 0x141, 0xF, 0xF, false);
    v += __builtin_amdgcn_update_dpp(0, v, 0x140, 0xF, 0xF, false);
    return (__builtin_amdgcn_readlane(v, 0) + __builtin_amdgcn_readlane(v, 16)) + (__builtin_amdgcn_readlane(v, 32) + __builtin_amdgcn_readlane(v, 48));
}
constexpr int IDX_SROW = 4096 + 64;
DEVI void indexer_unit(const Params& P, int b, int t0, LAS unsigned char* lds) {
    const int tid = tid_opaque(), lane = tid & 63, wave = __builtin_amdgcn_readfirstlane(tid >> 6), r32 = lane & 31, hi = lane >> 5;
    unsigned char* ws = P.ws;
    const bf16_t* proj = (const bf16_t*)(ws + WS_PROJ); const float* WI = (const float*)(ws + WS_WI);
    LAS float* Ssc = (LAS float*)lds;
    for (int rs_ = 0; rs_ < 1 + MK_SC2; ++rs_)
    if (t0 + 7 >= 255) {
        bf16x8 af[4];
        { const int qq = r32 >> 2, hh = r32 & 3; const size_t row = (size_t)b * S + t0 + qq;
#pragma unroll
          for (int d0 = 0; d0 < 4; ++d0) af[d0] = *(const bf16x8*)(proj + row * LDP + C_QI + hh * 64 + 16 * d0 + 8 * hi); }
        float wv[16];
#pragma unroll
        for (int r = 0; r < 16; ++r) wv[r] = WI[((size_t)b * S + t0 + 2 * (r >> 2) + hi) * 4 + (r & 3)];
        const int nkt = (t0 + 8 + 31) / 32;
        const bf16_t* kbase = (const bf16_t*)(ws + WS_KI) + (size_t)(b * (S / 32)) * 2048 + lane * 8;
        bf16x8 kb0[4], kb1[4], kb2[4], kb3[4];
#define IDX_LOAD(B, kt_) do { const int k_ = ((kt_) < nkt) ? (kt_) : (nkt - 1); _Pragma("unroll") for (int d0 = 0; d0 < 4; ++d0) B[d0] = *(const bf16x8*)(kbase + (size_t)k_ * 2048 + d0 * 512); } while (0)
#define IDX_COMP(B, kt_) do { f32x16 c; _Pragma("unroll") for (int r = 0; r < 16; ++r) c[r] = 0.f; \
            _Pragma("unroll") for (int d0 = 0; d0 < 4; ++d0) c = __builtin_amdgcn_mfma_f32_32x32x16_bf16(af[d0], B[d0], c, 0, 0, 0); \
            const int key = (kt_) * 32 + r32; \
            _Pragma("unroll") for (int g4 = 0; g4 < 4; ++g4) { float s = 0.f; \
                _Pragma("unroll") for (int hh = 0; hh < 4; ++hh) s += fmaxf(c[4 * g4 + hh], 0.f) * wv[4 * g4 + hh]; \
                Ssc[(2 * g4 + hi) * IDX_SROW + key + (key >> 6)] = s; } } while (0)
#define IDX_FENCE() asm volatile("" ::: "memory")
        IDX_LOAD(kb0, wave); IDX_LOAD(kb1, wave + NWAVE); IDX_LOAD(kb2, wave + 2 * NWAVE); IDX_FENCE();
        for (int kt = wave; kt < nkt; kt += 4 * NWAVE) {
            IDX_LOAD(kb3, kt + 3 * NWAVE); IDX_FENCE(); IDX_COMP(kb0, kt); IDX_FENCE();
            if (kt + NWAVE >= nkt) break;
            IDX_LOAD(kb0, kt + 4 * NWAVE); IDX_FENCE(); IDX_COMP(kb1, kt + NWAVE); IDX_FENCE();
            if (kt + 2 * NWAVE >= nkt) break;
            IDX_LOAD(kb1, kt + 5 * NWAVE); IDX_FENCE(); IDX_COMP(kb2, kt + 2 * NWAVE); IDX_FENCE();
            if (kt + 3 * NWAVE >= nkt) break;
            IDX_LOAD(kb2, kt + 6 * NWAVE); IDX_FENCE(); IDX_COMP(kb3, kt + 3 * NWAVE); IDX_FENCE();
        }
#undef IDX_FENCE
#undef IDX_LOAD
#undef IDX_COMP
    }
    __syncthreads();
    for (int rr_ = 0; rr_ < 1 + MK_SEL2; ++rr_) {
        const int t = t0 + wave; u64 myw = 0ull;
#if MK_TPROBE
        unsigned long long ts0_ = __builtin_amdgcn_s_memtime(), ts1_ = ts0_, ts2_ = ts0_;
#endif
        if (t >= 255) {
            unsigned u[64];
            { const LAS float* srow = Ssc + wave * IDX_SROW + 65 * lane;
#pragma unroll
              for (int j = 0; j < 64; ++j) { const unsigned bits = __float_as_uint(srow[j]);
                  unsigned key = (bits == 0x80000000u) ? 0x80000000u : ((bits & 0x80000000u) ? ~bits : (bits | 0x80000000u));
                  u[j] = (64 * lane + j > t) ? 0u : key; } }
            unsigned a32[32], a16[16], a8[8], a4[4];
#pragma unroll
            for (int i = 0; i < 32; ++i) a32[i] = max(u[2 * i], u[2 * i + 1]);
#pragma unroll
            for (int i = 0; i < 16; ++i) a16[i] = max(a32[2 * i], a32[2 * i + 1]);
#pragma unroll
            for (int i = 0; i < 8; ++i) a8[i] = max(a16[2 * i], a16[2 * i + 1]);
#pragma unroll
            for (int i = 0; i < 4; ++i) a4[i] = max(a8[2 * i], a8[2 * i + 1]);
            unsigned Mx = max(max(a4[0], a4[1]), max(a4[2], a4[3])), Lx = 0xffffffffu;
            { const int nfull = __builtin_amdgcn_readfirstlane((t + 1) >> 6); int nl;
              if (nfull >= 64) { nl = 64; Lx = min(min(a4[0], a4[1]), min(a4[2], a4[3])); }
              else if (nfull >= 32) { nl = 32;
#pragma unroll
                  for (int i = 0; i < 8; ++i) Lx = min(Lx, a8[i]); }
              else if (nfull >= 16) { nl = 16;
#pragma unroll
                  for (int i = 0; i < 16; ++i) Lx = min(Lx, a16[i]); }
              else if (nfull >= 8) { nl = 8;
#pragma unroll
                  for (int i = 0; i < 32; ++i) Lx = min(Lx, a32[i]); }
              else { nl = 4;
#pragma unroll
                  for (int j = 0; j < 64; ++j) Lx = min(Lx, u[j]); }
              if (lane >= nl) Lx = 0xffffffffu;
#pragma unroll
              for (int o = 1; o < 64; o <<= 1) { Mx = max(Mx, (unsigned)__shfl_xor((int)Mx, o)); Lx = min(Lx, (unsigned)__shfl_xor((int)Lx, o)); } }
            Mx = __builtin_amdgcn_readfirstlane(Mx); Lx = __builtin_amdgcn_readfirstlane(Lx);
#if MK_TPROBE
            asm volatile("s_waitcnt vmcnt(0) lgkmcnt(0)" ::: "memory"); ts1_ = __builtin_amdgcn_s_memtime();
#endif
#pragma unroll
            for (int j = 0; j < 64; ++j) u[j] = (u[j] >= Lx) ? (u[j] - Lx + 1u) : 0u;
            unsigned prefix = 0u; bool exact = false;
            for (int rb_ = 0; rb_ < 1 + MK_BIS2; ++rb_) { prefix = 0u; exact = false;
            for (int bit = 31 - __builtin_clz(Mx - Lx + 1u); bit >= 0; --bit) {
                const unsigned cand = prefix | (1u << bit); int c0 = 0, c1 = 0, c2 = 0, c3 = 0;
#define IDX_CNT8(j0) do { unsigned t0_, t1_, t2_, t3_, t4_, t5_, t6_, t7_; asm volatile( \
                    "v_sub_u32_e64 %0, %10, %18 clamp\n\tv_sub_u32_e64 %1, %11, %18 clamp\n\tv_sub_u32_e64 %2, %12, %18 clamp\n\tv_sub_u32_e64 %3, %13, %18 clamp\n\t" \
                    "v_sub_u32_e64 %4, %14, %18 clamp\n\tv_sub_u32_e64 %5, %15, %18 clamp\n\tv_sub_u32_e64 %6, %16, %18 clamp\n\tv_sub_u32_e64 %7, %17, %18 clamp\n\t" \
                    "v_min_u32 %0, 1, %0\n\tv_min_u32 %1, 1, %1\n\tv_min_u32 %2, 1, %2\n\tv_min_u32 %3, 1, %3\n\tv_min_u32 %4, 1, %4\n\tv_min_u32 %5, 1, %5\n\tv_min_u32 %6, 1, %6\n\tv_min_u32 %7, 1, %7\n\t" \
                    "v_add3_u32 %8, %8, %0, %1\n\tv_add3_u32 %9, %9, %2, %3\n\tv_add3_u32 %8, %8, %4, %5\n\tv_add3_u32 %9, %9, %6, %7" \
                    : "=&v"(t0_), "=&v"(t1_), "=&v"(t2_), "=&v"(t3_), "=&v"(t4_), "=&v"(t5_), "=&v"(t6_), "=&v"(t7_), "+v"(c0), "+v"(c1) \
                    : "v"(u[(j0)]), "v"(u[(j0) + 1]), "v"(u[(j0) + 2]), "v"(u[(j0) + 3]), "v"(u[(j0) + 4]), "v"(u[(j0) + 5]), "v"(u[(j0) + 6]), "v"(u[(j0) + 7]), "v"(cm1)); } while (0)
                const unsigned cm1 = cand - 1u;
                IDX_CNT8(0); IDX_CNT8(8); IDX_CNT8(16); IDX_CNT8(24); IDX_CNT8(32); IDX_CNT8(40); IDX_CNT8(48); IDX_CNT8(56);
#undef IDX_CNT8
                c2 = 0; c3 = 0;
                const int cnt = wave_sum_dpp((c0 + c1) + (c2 + c3));
                if (cnt >= 256) prefix = cand;
                if (cnt == 256) { exact = true; break; }
            }
            }
#if MK_TPROBE
            asm volatile("s_waitcnt vmcnt(0) lgkmcnt(0)" ::: "memory"); ts2_ = __builtin_amdgcn_s_memtime();
#endif
            unsigned mlo = 0u, mhi = 0u;
            if (exact) {
#pragma unroll
                for (int j = 31; j >= 0; --j) { mlo = (mlo << 1) | ((u[j] >= prefix) ? 1u : 0u); mhi = (mhi << 1) | ((u[32 + j] >= prefix) ? 1u : 0u); }
            } else {
                int ngt = 0, nti = 0;
#pragma unroll
                for (int j = 0; j < 64; ++j) { ngt += (u[j] > prefix) ? 1 : 0; nti += (u[j] == prefix) ? 1 : 0; }
                const int need = 256 - (int)wave_sum((float)ngt);
                int incl = nti;
#pragma unroll
                for (int o = 1; o < 64; o <<= 1) { const int v = __shfl_up(incl, o); if (lane >= o) incl += v; }
                int running = incl - nti;
#pragma unroll
                for (int j = 0; j < 64; ++j) {
                    const bool tie = (u[j] == prefix);
                    const unsigned sel = ((u[j] > prefix) || (tie && running < need)) ? 1u : 0u;
                    running += tie ? 1 : 0;
                    if (j < 32) mlo |= sel << j; else mhi |= sel << (j - 32);
                }
            }
            myw = ((u64)mhi << 32) | mlo;
        } else {
            const int lo = 64 * lane;
            if (lo + 63 <= t) myw = ~0ull; else if (lo > t) myw = 0ull; else myw = (~0ull) >> (63 - (t - lo));
        }
        ((u64*)(ws + WS_MASK))[((size_t)b * S + t) * 64 + lane] = myw;
#if MK_TPROBE
        { asm volatile("s_waitcnt vmcnt(0) lgkmcnt(0)" ::: "memory"); const unsigned long long ts3_ = __builtin_amdgcn_s_memtime();
          if (blockIdx.x == 0 && wave == 0 && lane == 0 && t >= 255) { unsigned long long* TS = (unsigned long long*)(ws + WS_BAR + 65536);
              atomicAdd(TS + 0, ts1_ - ts0_); atomicAdd(TS + 1, ts2_ - ts1_); atomicAdd(TS + 2, ts3_ - ts2_); atomicAdd(TS + 3, ts3_ - ts0_); } }
#endif
    }
    __syncthreads();
}

DEVI void combineA_rows(const Params& P) {
    const int tid = tid_opaque(), lane = tid & 63, wave = tid >> 6;
    const int gw = blockIdx.x * NWAVE + wave, NGW = gridDim.x * NWAVE;
    unsigned char* ws = P.ws;
    const float d1 = wave_sum(P.in[17][lane] * P.in[18][lane]), d2 = wave_sum(P.in[19][lane] * P.in[20][lane]);
    const float lam_init = 0.2f, lam = expf(d1) - expf(d2) + lam_init;
    const bf16_t* o0 = (const bf16_t*)(ws + WS_XB); const bf16_t* o1 = o0 + (size_t)T * 512;
    const float* gs = P.in[21] + 8 * (lane & 15);
    for (int m = gw; m < T; m += NGW) {
        const u32x4 a = *(const u32x4*)(o0 + (size_t)m * 512 + 8 * lane), bq = *(const u32x4*)(o1 + (size_t)m * 512 + 8 * lane);
        float v[8]; float ss = 0.f;
#pragma unroll
        for (int j = 0; j < 4; ++j) { v[2 * j] = lo16(a[j]) - lam * lo16(bq[j]); v[2 * j + 1] = hi16(a[j]) - lam * hi16(bq[j]); ss += v[2 * j] * v[2 * j] + v[2 * j + 1] * v[2 * j + 1]; }
        ss += __shfl_xor(ss, 1); ss += __shfl_xor(ss, 2); ss += __shfl_xor(ss, 4); ss += __shfl_xor(ss, 8);
        const float rs = rsqrtf(ss * (1.f / 128.f) + EPS) * (1.f - lam_init);
        u32x4 w;
#pragma unroll
        for (int j = 0; j < 4; ++j) w[j] = cvtpk(v[2 * j] * rs * gs[2 * j], v[2 * j + 1] * rs * gs[2 * j + 1]);
        *(u32x4*)((bf16_t*)(ws + WS_Y) + (size_t)m * 1024 + 8 * lane) = w;
    }
}

template <int W>
DEVI void pool_item(const bf16_t* pr, bf16_t* y, int m, int c0) {
    const int t = m & (S - 1);
    u32x4 z[W];
#pragma unroll
    for (int dt = 0; dt < W; ++dt) z[dt] = *(const u32x4*)(pr + (size_t)(m - ((dt <= t) ? dt : t)) * 2048 + 1536 + c0);
    float sum[8];
#pragma unroll
    for (int j = 0; j < 8; ++j) sum[j] = 0.f;
#pragma unroll
    for (int dt = 0; dt < W; ++dt) { const float wgt = (dt <= t) ? 1.f : 0.f;
#pragma unroll
        for (int j = 0; j < 4; ++j) { sum[2 * j] += wgt * lo16(z[dt][j]); sum[2 * j + 1] += wgt * hi16(z[dt][j]); } }
    const float inv = 1.f / (float)((t + 1 < W) ? (t + 1) : W); u32x4 w;
#pragma unroll
    for (int j = 0; j < 4; ++j) w[j] = cvtpk(sum[2 * j] * inv - lo16(z[0][j]), sum[2 * j + 1] * inv - hi16(z[0][j]));
    *(u32x4*)(y + (size_t)m * 1024 + 512 + c0) = w;
}
DEVI void phase_mix1(const Params& P) {
    const int gt = blockIdx.x * NTHR + tid_opaque(), NGT = gridDim.x * NTHR;
    unsigned char* ws = P.ws;
    const bf16_t* pr = (const bf16_t*)(ws + WS_PROJ1);
    bf16_t* y = (bf16_t*)(ws + WS_Y);
    const float* cw = P.in[29];
    for (int it = gt; it < T * 64; it += NGT) {
        const int m = it >> 6, c0 = 8 * (it & 63), t = m & (S - 1);
        u32x4 gc[3], hc[3];
#pragma unroll
        for (int dt = 0; dt < 3; ++dt) { const size_t r = (size_t)(m - ((dt <= t) ? dt : t)) * 2048; gc[dt] = *(const u32x4*)(pr + r + 512 + c0); hc[dt] = *(const u32x4*)(pr + r + 1024 + c0); }
        const u32x4 gb = *(const u32x4*)(pr + (size_t)m * 2048 + c0);
        float wgt[3][8];
#pragma unroll
        for (int dt = 0; dt < 3; ++dt) { float tmp[8]; load8(tmp, cw + (2 - dt) * 512 + c0); const float on = (dt <= t) ? 1.f : 0.f;
#pragma unroll
            for (int j = 0; j < 8; ++j) wgt[dt][j] = tmp[j] * on; }
        u32x4 w;
#pragma unroll
        for (int j = 0; j < 4; ++j) { float a = 0.f, b = 0.f;
#pragma unroll
            for (int dt = 0; dt < 3; ++dt) { a += wgt[dt][2 * j] * (lo16(gc[dt][j]) * lo16(hc[dt][j])); b += wgt[dt][2 * j + 1] * (hi16(gc[dt][j]) * hi16(hc[dt][j])); }
            w[j] = cvtpk(lo16(gb[j]) * a, hi16(gb[j]) * b); }
        *(u32x4*)(y + (size_t)m * 1024 + c0) = w;
    }
    for (int it = gt; it < T * 16; it += NGT) { const int m = it >> 4, cj = 8 * (it & 15);
        pool_item<2>(pr, y, m, cj); pool_item<4>(pr, y, m, 128 + cj); asm volatile("" ::: "memory"); pool_item<8>(pr, y, m, 256 + cj); asm volatile("" ::: "memory"); pool_item<16>(pr, y, m, 384 + cj); asm volatile("" ::: "memory"); }
}

namespace pg8 {
#define PG8_LAS __attribute__((address_space(3)))
typedef unsigned short bf16_t;
typedef short bf16x8 __attribute__((ext_vector_type(8)));
typedef float f32x4 __attribute__((ext_vector_type(4)));
typedef unsigned u32x4 __attribute__((ext_vector_type(4)));
constexpr int BM = 256, BK = 64, HALF = 128, HTB = HALF * BK * 2  , STAGE_BYTES = 8 * HTB, NXCD = 8, WGM = 8;

__host__ __device__ __forceinline__ int lds_byte(int r, int c) { const int st = (r >> 4) * 2 + (c >> 5), rr = r & 15, cc = c & 31, ob = rr * 64 + cc * 2; return st * 1024 + (ob ^ (((ob >> 9) & 1) << 5)); }
__host__ __device__ __forceinline__ void stage_rc(int b, int& R, int& C) { const int st = b / 1024, sb = b % 1024, swz = sb ^ (((sb >> 9) & 1) << 5); R = (st >> 1) * 16 + swz / 64; C = (st & 1) * 32 + (swz % 64) / 2; }
__host__ __device__ __forceinline__ int perm32(int rho) { const int n = rho >> 4, i = rho & 15; return 8 * (i >> 2) + 4 * n + (i & 3); }

struct Unit { int pm, pn; };
struct Gemm { const bf16_t* A; int lda; const bf16_t* Bt; int M, N, K; };

struct StaticOrder {
    int nM, nN, nwg, G, c;
    __host__ __device__ void init(int M, int N, int G_, int c_) { nM = M / BM; nN = N / BM; nwg = nM * nN; G = G_; c = c_; }
    __host__ __device__ bool next(int i, Unit& u) const {
        const long L = (long)i * G + c; if (L >= nwg) return false;
        int wgid = (int)L; { const int q = nwg / NXCD, r = nwg % NXCD, xcd = wgid % NXCD, off = wgid / NXCD; wgid = (xcd < r ? xcd * (q + 1) : r * (q + 1) + (xcd - r) * q) + off; }
        const int nig = WGM * nN, gid = wgid / nig, fm = gid * WGM, gsz = (nM - fm) < WGM ? (nM - fm) : WGM;
        u.pm = fm + ((wgid % nig) % gsz); u.pn = (wgid % nig) / gsz; return true;
    }
    __device__ __forceinline__ void a_ready(const Unit&) const {}
    __device__ __forceinline__ void done(const Unit&) const {}
};
template <class Epi, class Sched, bool ALIGN_EPI = false, bool SP2 = false>
__device__ __forceinline__ void gemm_phase(PG8_LAS unsigned char* lds, const Gemm g, const Sched& S, const Epi& E) {
    const int tid = tid_opaque(), wid = __builtin_amdgcn_readfirstlane(tid >> 6), lane = tid & 63, wr = wid >> 2, wc = wid & 3, fr = lane & 15, fq = lane >> 4;
    const int K = g.K, nt = K / BK;
    unsigned voffA[2], voffB[2];
#pragma unroll
    for (int i = 0; i < 2; ++i) { int R, C; stage_rc(tid * 16 + i * 8192, R, C); const int Rb = Epi::PERM ? ((R & ~31) + perm32(R & 31)) : R;
        voffA[i] = (unsigned)(R * g.lda + C) * 2u; voffB[i] = (unsigned)(Rb * K + C) * 2u; }
    const size_t kstep = (size_t)(BK * 2);
    const size_t hstepA = (size_t)HALF * g.lda * 2, hstepB = (size_t)HALF * K * 2;
    const size_t tstepA = 2 * hstepA, tstepB = 2 * hstepB;
    const unsigned ldsw = (unsigned)wid * 1024u;
    const int aoff = lds_byte(wr * 64 + fr, fq * 8), boff = lds_byte(wc * 32 + fr, fq * 8);
#define PG8_SA(b, h) (((b) * 2 + (h)) * HTB)
#define PG8_SB(b, h) ((4 + (b) * 2 + (h)) * HTB)
#define PG8_STAGE(bufoff, gbase, voff) do { _Pragma("unroll") for (int _i = 0; _i < 2; ++_i) \
        __builtin_amdgcn_global_load_lds((const unsigned*)((const char*)(gbase) + (voff)[_i]), (PG8_LAS unsigned*)(lds + (bufoff) + ldsw + _i * 8192), 16, 0, 0); } while (0)
#define PG8_LDA(dst, b, h) do { _Pragma("unroll") for (int m = 0; m < 4; ++m) _Pragma("unroll") for (int k = 0; k < 2; ++k) dst[m][k] = *(const PG8_LAS bf16x8*)(lds + PG8_SA(b, h) + aoff + m * 2048 + k * 1024); } while (0)
#define PG8_LDB(dst, b, h) do { _Pragma("unroll") for (int n = 0; n < 2; ++n) _Pragma("unroll") for (int k = 0; k < 2; ++k) dst[n][k] = *(const PG8_LAS bf16x8*)(lds + PG8_SB(b, h) + boff + n * 2048 + k * 1024); } while (0)
#define PG8_MMA(ai, bj, At, Bt) do { __builtin_amdgcn_s_setprio(1); _Pragma("unroll") for (int m = 0; m < 4; ++m) _Pragma("unroll") for (int n = 0; n < 2; ++n) _Pragma("unroll") for (int k = 0; k < 2; ++k) \
        acc[ai][bj][m][n] = __builtin_amdgcn_mfma_f32_16x16x32_bf16(Bt[n][k], At[m][k], acc[ai][bj][m][n], 0, 0, 0); __builtin_amdgcn_s_setprio(0); } while (0)
#define PG8_WAIT_V(n) asm volatile("s_waitcnt vmcnt(" #n ")" ::: "memory")
#define PG8_WAIT_L(n) asm volatile("s_waitcnt lgkmcnt(" #n ")" ::: "memory")
#define PG8_BAR __builtin_amdgcn_s_barrier()
#define PG8_SCHED __builtin_amdgcn_sched_barrier(0)
    Unit cur, nxt; int ui = 0;
    if (!S.next(0, cur)) return;
    f32x4 acc[2][2][4][2];
#pragma unroll
    for (int a = 0; a < 2; ++a)
#pragma unroll
        for (int b = 0; b < 2; ++b)
#pragma unroll
            for (int m = 0; m < 4; ++m)
#pragma unroll
                for (int n = 0; n < 2; ++n) acc[a][b][m][n] = (f32x4){0.f, 0.f, 0.f, 0.f};
    bf16x8 At[4][2], B0[2][2], B1[2][2];
    const char* cA = (const char*)g.A + (size_t)cur.pm * tstepA; const char* cB = (const char*)g.Bt + (size_t)cur.pn * tstepB;
    S.a_ready(cur);
    if constexpr (SP2) {
        PG8_STAGE(PG8_SB(0, 0), cB, voffB); PG8_STAGE(PG8_SB(0, 1), cB + hstepB, voffB); PG8_STAGE(PG8_SA(0, 0), cA, voffA); PG8_STAGE(PG8_SA(0, 1), cA + hstepA, voffA);
        if (wr == 1) PG8_BAR;
        PG8_WAIT_V(2); PG8_BAR;
        PG8_STAGE(PG8_SB(1, 0), cB + kstep, voffB); PG8_STAGE(PG8_SA(1, 0), cA + kstep, voffA); PG8_STAGE(PG8_SB(1, 1), cB + hstepB + kstep, voffB);
        PG8_WAIT_V(6); PG8_BAR;
    } else {
        PG8_STAGE(PG8_SB(0, 0), cB, voffB); PG8_STAGE(PG8_SA(0, 0), cA, voffA); PG8_STAGE(PG8_SB(0, 1), cB + hstepB, voffB); PG8_STAGE(PG8_SA(0, 1), cA + hstepA, voffA);
        if (wr == 1) PG8_BAR;
        PG8_WAIT_V(4); PG8_BAR;
        PG8_STAGE(PG8_SB(1, 0), cB + kstep, voffB); PG8_STAGE(PG8_SA(1, 0), cA + kstep, voffA); PG8_STAGE(PG8_SB(1, 1), cB + hstepB + kstep, voffB);
        PG8_WAIT_V(6); PG8_BAR;
    }
    for (;;) {
        const bool has_next = S.next(ui + 1, nxt);
        const char* nA = has_next ? (const char*)g.A + (size_t)nxt.pm * tstepA : cA; const char* nB = has_next ? (const char*)g.Bt + (size_t)nxt.pn * tstepB : cB;
        for (int t = 0; t < nt; t += 2) {
            const bool last = (t == nt - 2);
            const char* a1 = cA + (size_t)(t + 1) * kstep;
            const char* a2 = last ? nA : cA + (size_t)(t + 2) * kstep; const char* b2 = last ? nB : cB + (size_t)(t + 2) * kstep;
            const char* a3 = a2 + kstep; const char* b3 = b2 + kstep;
            if (last && has_next) S.a_ready(nxt);
            if constexpr (SP2) {
            PG8_LDB(B0, 0, 0); PG8_LDB(B1, 0, 1); PG8_SCHED; PG8_LDA(At, 0, 0); PG8_STAGE(PG8_SA(1, 1), a1 + hstepA, voffA);
            PG8_WAIT_V(8); PG8_WAIT_L(0); PG8_BAR; PG8_MMA(0, 0, At, B0); PG8_MMA(0, 1, At, B1); PG8_BAR; PG8_SCHED;
            PG8_LDA(At, 0, 1); PG8_STAGE(PG8_SB(0, 0), b2, voffB); PG8_STAGE(PG8_SB(0, 1), b2 + hstepB, voffB); PG8_STAGE(PG8_SA(0, 0), a2, voffA);
            PG8_WAIT_V(8); PG8_WAIT_L(0); PG8_BAR; PG8_MMA(1, 0, At, B0); PG8_MMA(1, 1, At, B1); PG8_BAR; PG8_SCHED;
            PG8_LDB(B0, 1, 0); PG8_LDB(B1, 1, 1); PG8_SCHED; PG8_LDA(At, 1, 0); PG8_STAGE(PG8_SA(0, 1), a2 + hstepA, voffA);
            PG8_WAIT_V(8); PG8_WAIT_L(0); PG8_BAR; PG8_MMA(0, 0, At, B0); PG8_MMA(0, 1, At, B1); PG8_BAR; PG8_SCHED;
            PG8_LDA(At, 1, 1); PG8_STAGE(PG8_SB(1, 0), b3, voffB); PG8_STAGE(PG8_SB(1, 1), b3 + hstepB, voffB); PG8_STAGE(PG8_SA(1, 0), a3, voffA);
            PG8_WAIT_V(8); PG8_WAIT_L(0); PG8_BAR; PG8_MMA(1, 0, At, B0); PG8_MMA(1, 1, At, B1); PG8_BAR; PG8_SCHED;
            } else {
            PG8_LDB(B0, 0, 0); PG8_SCHED; PG8_LDA(At, 0, 0); PG8_STAGE(PG8_SA(1, 1), a1 + hstepA, voffA);
            PG8_WAIT_L(8); PG8_BAR; PG8_WAIT_L(0); PG8_MMA(0, 0, At, B0); PG8_BAR; PG8_SCHED;
            PG8_LDB(B1, 0, 1); PG8_STAGE(PG8_SB(0, 0), b2, voffB);
            PG8_BAR; PG8_WAIT_L(0); PG8_MMA(0, 1, At, B1); PG8_BAR;
            PG8_LDA(At, 0, 1); PG8_STAGE(PG8_SA(0, 0), a2, voffA);
            PG8_BAR; PG8_WAIT_L(0); PG8_MMA(1, 0, At, B0); PG8_BAR; PG8_SCHED;
            PG8_STAGE(PG8_SB(0, 1), b2 + hstepB, voffB);
            PG8_WAIT_V(6); PG8_BAR; PG8_MMA(1, 1, At, B1); PG8_BAR;
            PG8_LDB(B0, 1, 0); PG8_SCHED; PG8_LDA(At, 1, 0); PG8_STAGE(PG8_SA(0, 1), a2 + hstepA, voffA);
            PG8_WAIT_L(8); PG8_BAR; PG8_WAIT_L(0); PG8_MMA(0, 0, At, B0); PG8_BAR; PG8_SCHED;
            PG8_LDB(B1, 1, 1); PG8_STAGE(PG8_SB(1, 0), b3, voffB);
            PG8_BAR; PG8_WAIT_L(0); PG8_MMA(0, 1, At, B1); PG8_BAR;
            PG8_LDA(At, 1, 1); PG8_STAGE(PG8_SA(1, 0), a3, voffA);
            PG8_BAR; PG8_WAIT_L(0); PG8_MMA(1, 0, At, B0); PG8_BAR; PG8_SCHED;
            PG8_STAGE(PG8_SB(1, 1), b3 + hstepB, voffB);
            PG8_WAIT_V(6); PG8_BAR; PG8_MMA(1, 1, At, B1); PG8_BAR;
            }
        }
        if constexpr (ALIGN_EPI) { if (wr == 0) PG8_BAR; }
        if constexpr (!Epi::AFTER_DRAIN) { E(acc, cur, wr, wc, fr, fq); S.done(cur); }
        if (!has_next) break;
#pragma unroll
        for (int a = 0; a < 2; ++a)
#pragma unroll
            for (int b = 0; b < 2; ++b)
#pragma unroll
                for (int m = 0; m < 4; ++m)
#pragma unroll
                    for (int n = 0; n < 2; ++n) acc[a][b][m][n] = (f32x4){0.f, 0.f, 0.f, 0.f};
        cur = nxt; cA = nA; cB = nB; ++ui;
        if constexpr (ALIGN_EPI) { if (wr == 1) PG8_BAR; }
    }
    PG8_WAIT_V(0);
    if constexpr (!ALIGN_EPI) { if (wr == 0) PG8_BAR; }
    PG8_BAR;
    if constexpr (Epi::AFTER_DRAIN) { E.fused(acc, cur, wr, wc, fr, fq, lds, wid, lane); S.done(cur); }
#undef PG8_SA
#undef PG8_SB
#undef PG8_STAGE
#undef PG8_LDA
#undef PG8_LDB
#undef PG8_MMA
#undef PG8_WAIT_V
#undef PG8_WAIT_L
#undef PG8_BAR
#undef PG8_SCHED
}
}

namespace pg8 {
struct EpiScale {
    static constexpr bool PERM = true, AFTER_DRAIN = false;
    bf16_t* O; int ldo; const float* ssq; float inv_n; int act;
    __device__ __forceinline__ void operator()(const f32x4 (&acc)[2][2][4][2], const Unit& u, int wr, int wc, int fr, int fq) const {
        const int row0 = u.pm * BM + wr * 64 + fr, col0 = u.pn * BM + wc * 32 + 8 * fq;
#pragma unroll
        for (int ai = 0; ai < 2; ++ai)
#pragma unroll
            for (int m = 0; m < 4; ++m) {
                const int row = row0 + ai * HALF + m * 16;
                const float rs = ssq ? rsqrtf(ssq[row] * inv_n + 1e-6f) : 1.f;
                bf16_t* rowp = O + (size_t)row * ldo + col0;
#pragma unroll
                for (int bj = 0; bj < 2; ++bj) {
                    f32x4 v0 = acc[ai][bj][m][0] * rs, v1 = acc[ai][bj][m][1] * rs;
                    if (act == 1) {
#pragma unroll
                        for (int j = 0; j < 4; ++j) { const float a = fmaxf(v0[j], 0.f), b = fmaxf(v1[j], 0.f); v0[j] = a * a; v1[j] = b * b; }
                    }
                    u32x4 w; w.x = ::cvtpk(v0[0], v0[1]); w.y = ::cvtpk(v0[2], v0[3]); w.z = ::cvtpk(v1[0], v1[1]); w.w = ::cvtpk(v1[2], v1[3]);
                    *(u32x4*)(rowp + bj * HALF) = w;
                }
            }
    }
};
struct EpiResid {
    static constexpr bool PERM = true, AFTER_DRAIN = false;
    const float* basef; float* outf; bf16_t* xb; float* ssq_next; int dry;
    __device__ __forceinline__ void operator()(const f32x4 (&acc)[2][2][4][2], const Unit& u, int wr, int wc, int fr, int fq) const {
        const int col0 = u.pn * BM + wc * 32 + 8 * fq;
#pragma unroll
        for (int ai = 0; ai < 2; ++ai)
#pragma unroll
            for (int m = 0; m < 4; ++m) {
                const int row = u.pm * BM + ai * HALF + wr * 64 + m * 16 + fr; const size_t off = (size_t)row * 1024 + col0; float s = 0.f;
#pragma unroll
                for (int bj = 0; bj < 2; ++bj) {
                    const size_t idx = off + bj * HALF;
                    f32x4 x0, x1;
                    if (basef) { x0 = *(const f32x4*)(basef + idx); x1 = *(const f32x4*)(basef + idx + 4); }
                    else { const u32x4 b = *(const u32x4*)(xb + idx); x0 = (f32x4){::lo16(b.x), ::hi16(b.x), ::lo16(b.y), ::hi16(b.y)}; x1 = (f32x4){::lo16(b.z), ::hi16(b.z), ::lo16(b.w), ::hi16(b.w)}; }
                    x0 += acc[ai][bj][m][0]; x1 += acc[ai][bj][m][1];
                    s += (x0[0] * x0[0] + x0[1] * x0[1]) + (x0[2] * x0[2] + x0[3] * x0[3]) + (x1[0] * x1[0] + x1[1] * x1[1]) + (x1[2] * x1[2] + x1[3] * x1[3]);
                    if (outf && !dry) { *(f32x4*)(outf + idx) = x0; *(f32x4*)(outf + idx + 4) = x1; }
                    if (xb && !outf && !dry) { u32x4 w; w.x = ::cvtpk(x0[0], x0[1]); w.y = ::cvtpk(x0[2], x0[3]); w.z = ::cvtpk(x1[0], x1[1]); w.w = ::cvtpk(x1[2], x1[3]); *(u32x4*)(xb + idx) = w; }
                    if (dry) asm volatile("" :: "v"(x0), "v"(x1));
                }
                if (ssq_next && !dry) { s += __shfl_xor(s, 16); s += __shfl_xor(s, 32); if (fq == 0) atomicAdd(ssq_next + row, s); }
            }
    }
};
}

#define XB_TMO      128
#define XB_XCNT(j)  (256  + 64 * (j))
#define XB_XSUB(j)  (1280 + 64 * (j))
#define XB_XGEN(j)  (2304 + 64 * (j))
#define XB_TOP      3328
#define XB_TOPGEN   3392
#define XCD_BAR_WORDS 3456
#define XB_SPIN_CAP (1u << 18)

__device__ __forceinline__ unsigned xb_ld(unsigned* p)              { return __hip_atomic_load(p, __ATOMIC_RELAXED, __HIP_MEMORY_SCOPE_AGENT); }
__device__ __forceinline__ unsigned xb_add(unsigned* p, unsigned v) { return __hip_atomic_fetch_add(p, v, __ATOMIC_RELAXED, __HIP_MEMORY_SCOPE_AGENT); }
__device__ __forceinline__ unsigned xb_xcc_id() { return (unsigned)__builtin_amdgcn_s_getreg((3 << 11) | 20) & 0xFu; }
#define XB_SPIN(cond, bar) do { unsigned _sp = 0; while (cond) { __builtin_amdgcn_s_sleep(1); \
    if ((++_sp & 255u) == 0u) { if (xb_ld(&(bar)[XB_TMO])) break; if (_sp > XB_SPIN_CAP) { atomicAdd(&(bar)[XB_TMO], 1u); break; } } } } while (0)

struct XcdBarrier {
    unsigned* bar; unsigned x;
    volatile LAS unsigned* st;
};

__device__ __forceinline__ XcdBarrier xcd_barrier_post(unsigned* bar, volatile LAS unsigned* st) {
    XcdBarrier b; b.bar = bar; b.x = xb_xcc_id(); b.st = st;
    if (threadIdx.x == 0) (void)xb_add(&bar[XB_XCNT(b.x)], 1u);
    return b;
}
__device__ __forceinline__ void xcd_barrier_complete(unsigned* bar, unsigned x, unsigned& nloc, unsigned& nx) {
    const unsigned G = gridDim.x * gridDim.y * gridDim.z;
    unsigned sum, cnt, mine, sp = 0u;
    for (;;) {
        sum = 0u; cnt = 0u; mine = 0u;
#pragma unroll
        for (unsigned j = 0; j < 16; ++j) { const unsigned c = xb_ld(&bar[XB_XCNT(j)]); sum += c; cnt += (c > 0u) ? 1u : 0u; mine = (j == x) ? c : mine; }
        if (sum == G) break;
        __builtin_amdgcn_s_sleep(1);
        if ((++sp & 255u) == 0u) { if (xb_ld(&bar[XB_TMO])) break; if (sp > XB_SPIN_CAP) { atomicAdd(&bar[XB_TMO], 1u); break; } }
    }
    nloc = mine > 0u ? mine : 1u; nx = cnt > 0u ? cnt : 1u;
}

__device__ __forceinline__ void xcd_barrier(const XcdBarrier& b) {
    asm volatile("s_waitcnt vmcnt(0)" ::: "memory");
    __syncthreads();
    if (threadIdx.x == 0) {
        unsigned* bar = b.bar;
        __builtin_amdgcn_s_waitcnt(0);
        unsigned nloc = b.st[0], nx = b.st[1];
        if (nloc == 0u) { xcd_barrier_complete(bar, b.x, nloc, nx); b.st[0] = nloc; b.st[1] = nx; }
        const unsigned old = xb_add(&bar[XB_XSUB(b.x)], 1u);
        const unsigned gen = old / nloc;
        if (old + 1u == (gen + 1u) * nloc) {
            __builtin_amdgcn_fence(__ATOMIC_RELEASE, "agent");
            asm volatile("s_waitcnt vmcnt(0)" ::: "memory");
            const unsigned og = xb_add(&bar[XB_TOP], 1u);
            const unsigned tg = og / nx;
            if (og + 1u == (tg + 1u) * nx) xb_add(&bar[XB_TOPGEN], 1u);
            else XB_SPIN(xb_ld(&bar[XB_TOPGEN]) == tg, bar);
            __builtin_amdgcn_fence(__ATOMIC_ACQUIRE, "agent");
            xb_add(&bar[XB_XGEN(b.x)], 1u);
            asm volatile("s_waitcnt vmcnt(0)" ::: "memory");
        } else {
            XB_SPIN(xb_ld(&bar[XB_XGEN(b.x)]) == gen, bar);
            __builtin_amdgcn_fence(__ATOMIC_ACQUIRE, "agent");
            asm volatile("s_waitcnt vmcnt(0)" ::: "memory");
        }
    }
    __syncthreads();
}
constexpr int NPHASE = 22;
constexpr int MISC_OFF = LDS_BYTES - 256;
#ifndef MK_REP_N
#define MK_REP_N 0
#define MK_REP_LO 0
#define MK_REP_HI -1
#endif
#ifndef MK_XPH
#define MK_XPH -1
#define MK_XN 0
#endif
#ifndef MK_SUB
#define MK_SUB 0
#endif
#ifndef MK_IDX2
#define MK_IDX2 0
#endif
#ifndef MK_CGSYNC
#define MK_CGSYNC 0
#endif
template <class Epi, bool ALIGN>
DEVI void run_gemm(LAS unsigned char* lds, const bf16_t* A, int lda, const bf16_t* Bt, int M, int N, int K, const Epi& E, int cu_off = 0) {
    const int Gd = (int)gridDim.x; int cu = (int)blockIdx.x - cu_off; if (cu < 0) cu += Gd;
    pg8::Gemm g{A, lda, Bt, M, N, K}; pg8::StaticOrder So; So.init(M, N, Gd, cu);
    pg8::gemm_phase<Epi, pg8::StaticOrder, ALIGN, true>(lds, g, So, E);
}
template <bool DRYK>
__global__ void __launch_bounds__(NTHR, 2) mega(Params P, int ph_lo, int ph_hi) {
    extern __shared__ __attribute__((aligned(16))) unsigned char lds_raw[];
    LAS unsigned char* lds = (LAS unsigned char*)lds_raw;
    cg::grid_group grid = cg::this_grid();
    { volatile LAS unsigned* MISC0 = (volatile LAS unsigned*)(lds + MISC_OFF);
      if (threadIdx.x < 32) MISC0[threadIdx.x] = 0u;
      __syncthreads();
      if (ph_hi - ph_lo > 1) (void)xcd_barrier_post((unsigned*)(P.ws + WS_BAR), MISC0 + 8); }
#define PH_LOCALS unsigned char* ws = P.ws; asm volatile("" : "+s"(ws)); float* ssq = (float*)(ws + WS_SSQ); bf16_t* XB = (bf16_t*)(ws + WS_XB); bf16_t* Y = (bf16_t*)(ws + WS_Y); const int G = gridDim.x, bx = blockIdx.x; (void)ssq; (void)XB; (void)Y; (void)G; (void)bx;
#define SEAM_XCD() do { XcdBarrier b_; b_.bar = (unsigned*)(P.ws + WS_BAR); b_.x = xb_xcc_id(); b_.st = (volatile LAS unsigned*)(lds + MISC_OFF) + 8; xcd_barrier(b_); } while (0)
#define PH_REPS(k) (((k) >= MK_REP_LO && (k) <= MK_REP_HI && (k) != 2 && (k) != 4) ? 1 + MK_REP_N : 1)
#define PH_BEGIN(k) if (ph_lo <= (k) && (k) < ph_hi) { PH_LOCALS for (int rep = 0; rep < PH_REPS(k); ++rep) { const int dry = (rep > 0) || DRYK; (void)dry; if (rep > 0) SEAM_XCD();
#define PH_END(k) } if ((k) + 1 < ph_hi) { if (MK_CGSYNC || (k) == 0) grid.sync(); else SEAM_XCD(); } }
#define DRYOUT (dry ? (float*)(ws + WS_Y) : P.out)
    using pg8::EpiScale; using pg8::EpiResid;
    PH_BEGIN(0) phase_prologue(P, lds, dry); PH_END(0)
    PH_BEGIN(1)
        run_gemm<EpiScale, true>(lds, (const bf16_t*)(ws + WS_XB), 1024, (const bf16_t*)(ws + W_INE), T, LDP, 1024, EpiScale{(bf16_t*)(ws + WS_PROJ), LDP, ssq, 1.f / 1024.f, 0});
        run_gemm<EpiScale, false>(lds, (const bf16_t*)(ws + WS_MB), 1024, (const bf16_t*)(ws + W_KVX), MEMT, 2048, 1024, EpiScale{(bf16_t*)(ws + WS_KVX), 2048, (const float*)(ws + WS_SSQMEM), 1.f / 1024.f, 0}, ((T / 256) * (LDP / 256)) % G);
    PH_END(1)
    PH_BEGIN(2) phase_post0(P); PH_END(2)
    PH_BEGIN(3) run_gemm<EpiScale, false>(lds, (const bf16_t*)(ws + WS_PROJ) + C_CKV, LDP, (const bf16_t*)(ws + W_KVUP), T, 1024, 256, EpiScale{(bf16_t*)(ws + WS_KBVB), 1024, (const float*)(ws + WS_SSQCKV), 1.f / 256.f, 0}); PH_END(3)
    PH_BEGIN(4) phase_postkb(P); PH_END(4)
    PH_BEGIN(5)
        if (!(dry && MK_SUB == 2))
        for (int u = bx; u < 256; u += G) { const int bhc = u >> 3, s = u & 7, b = bhc >> 3, h = (bhc >> 1) & 3, c = bhc & 1;
            attnA_unit(P, b, h, c, s, lds); attnA_unit(P, b, h, c, 15 - s, lds); }
        if (!(dry && MK_SUB == 1))
        for (int u = bx; u < 2048; u += G) { const int k = u / 256, c = u % 256, b = k >> 1; const int blk = (k & 1) ? (511 - c) : c;
            indexer_unit(P, b, blk * 8, lds); }
#if MK_IDX2
        for (int u = bx; u < 2048; u += G) { const int k = u / 256, c = u % 256, b = k >> 1; const int blk = (k & 1) ? (511 - c) : c;
            indexer_unit(P, b, blk * 8, lds); }
#endif
    PH_END(5)
    PH_BEGIN(6)
        if (!(dry && MK_SUB == 2))
        for (int u = bx; u < 256; u += G) { const int bh = u >> 3, s = u & 7, b = bh >> 3, hd = bh & 7;
            attnB_unit(P, b, hd, s, lds); attnB_unit(P, b, hd, 15 - s, lds); }
        if (!(dry && MK_SUB == 1)) combineA_rows(P);
    PH_END(6)
    PH_BEGIN(7) run_gemm<EpiResid, false>(lds, Y, 1024, (const bf16_t*)(ws + W_OUTE), T, 1024, 1024, EpiResid{P.in[0], nullptr, XB, ssq + 1 * T, dry}); PH_END(7)
#define XATTN_MLP(l, p0)                                                                                                                                                      \
    PH_BEGIN(p0) run_gemm<EpiScale, false>(lds, XB, 1024, (const bf16_t*)(ws + W_QX) + (size_t)(l) * 512 * 1024, T, 512, 1024, EpiScale{(bf16_t*)(ws + WS_QX), 512, ssq + ((l) ? 4 : 1) * T, 1.f / 1024.f, 0}); PH_END(p0) \
    PH_BEGIN(p0 + 1) for (int u = bx; u < 256; u += G) { const int b = u >> 6, hd = (u >> 4) & 3, qb = u & 15; xattn_unit(P, (l), b, hd, qb, lds); } PH_END(p0 + 1)                                 \
    PH_BEGIN(p0 + 2) run_gemm<EpiResid, false>(lds, (const bf16_t*)(ws + WS_YX), 512, (const bf16_t*)(ws + W_OX) + (size_t)(l) * 1024 * 512, T, 1024, 512, EpiResid{nullptr, nullptr, XB, ssq + ((l) ? 5 : 2) * T, dry}); PH_END(p0 + 2) \
    PH_BEGIN(p0 + 3) run_gemm<EpiScale, true>(lds, XB, 1024, (const bf16_t*)(ws + W_UP) + (size_t)(l) * 4096 * 1024, T, DFF, 1024, EpiScale{(bf16_t*)(ws + WS_H), DFF, ssq + ((l) ? 5 : 2) * T, 1.f / 1024.f, 1}); PH_END(p0 + 3)
    XATTN_MLP(0, 8)
    PH_BEGIN(12) run_gemm<EpiResid, false>(lds, (const bf16_t*)(ws + WS_H), DFF, (const bf16_t*)(ws + W_DOWN), T, 1024, DFF, EpiResid{nullptr, nullptr, XB, ssq + 3 * T, dry}); PH_END(12)
    PH_BEGIN(13) run_gemm<EpiScale, true>(lds, XB, 1024, (const bf16_t*)(ws + W_INO), T, 2048, 1024, EpiScale{(bf16_t*)(ws + WS_PROJ1), 2048, ssq + 3 * T, 1.f / 1024.f, 0}); PH_END(13)
    PH_BEGIN(14) phase_mix1(P); PH_END(15)
    PH_BEGIN(16) run_gemm<EpiResid, false>(lds, Y, 1024, (const bf16_t*)(ws + W_OUTO), T, 1024, 1024, EpiResid{nullptr, nullptr, XB, ssq + 4 * T, dry}); PH_END(16)
    XATTN_MLP(1, 17)
    PH_BEGIN(21) run_gemm<EpiResid, false>(lds, (const bf16_t*)(ws + WS_H), DFF, (const bf16_t*)(ws + W_DOWN) + (size_t)1024 * 4096, T, 1024, DFF, EpiResid{nullptr, P.out, XB, nullptr, dry}); PH_END(21)
#if MK_TPROBE
    if (ph_hi == NPHASE) { SEAM_XCD(); unsigned char* ws = P.ws;
        const unsigned long long* TS = (const unsigned long long*)(ws + WS_BAR + 65536);
        float delta = (MK_TPROBE == 14) ? (float)TS[12] / 625000.f : (MK_TPROBE >= 10) ? (float)TS[8 + MK_TPROBE - 10] / (float)TS[12] : (MK_TPROBE == 4) ? (float)TS[3] * 1e-6f : (float)TS[MK_TPROBE - 1] / (float)TS[3];
        delta = floorf(delta * 25.f + 0.5f) * 0.04f;
        for (int i = blockIdx.x * NTHR + threadIdx.x; i < T * D; i += gridDim.x * NTHR) P.out[i] *= (1.f + delta); }
#endif
}

#ifndef MK_MULTI
#define MK_MULTI 0
#endif
extern "C" void kernel_launch(void* const* d_in, const int* in_sizes, int n_in, void* d_out, int out_size, void* d_ws, size_t ws_size, hipStream_t stream) {
    static int grid = 0;
    if (grid == 0) {
        if (n_in != 33 || out_size != T * D || ws_size < WS_END) { fprintf(stderr, "kernel_launch: unexpected shapes (n_in %d out %d ws %zu)\n", n_in, out_size, ws_size); grid = -1; return; }
        int dev = 0, cus = 0, per_cu = 0;
        hipGetDevice(&dev); hipDeviceGetAttribute(&cus, hipDeviceAttributeMultiprocessorCount, dev);
        hipFuncSetAttribute((const void*)mega<false>, hipFuncAttributeMaxDynamicSharedMemorySize, LDS_BYTES);
        hipOccupancyMaxActiveBlocksPerMultiprocessor(&per_cu, (const void*)mega<false>, NTHR, LDS_BYTES);
        if (per_cu < 1) { fprintf(stderr, "kernel_launch: occupancy query says %d blocks/CU\n", per_cu); per_cu = 1; }
        (void)hipGetLastError();
        grid = cus * 1;
    }
    if (grid < 0) return;
    Params p{};
    for (int i = 0; i < 33; ++i) p.in[i] = (const float*)d_in[i];
    p.out = (float*)d_out; p.ws = (unsigned char*)d_ws;
    (void)hipMemsetAsync((char*)d_ws + WS_BAR, 0, MK_TPROBE ? 131072 : XCD_BAR_WORDS * 4, stream);
#if MK_MULTI
    for (int ph = 0; ph < NPHASE; ++ph) hipLaunchKernelGGL(mega<false>, dim3(grid), dim3(NTHR), LDS_BYTES, stream, p, ph, ph + 1);
#else
    int lo = 0, hi = NPHASE;
    void* args[] = {&p, &lo, &hi};
    hipError_t e = hipLaunchCooperativeKernel((const void*)mega<false>, dim3(grid), dim3(NTHR), args, LDS_BYTES, stream);
    if (e != hipSuccess) fprintf(stderr, "cooperative launch failed: %s (grid %d)\n", hipGetErrorString(e), grid);
#endif
#if MK_XPH >= 0
    { static bool once = false; if (!once) { (void)hipFuncSetAttribute((const void*)mega<true>, hipFuncAttributeMaxDynamicSharedMemorySize, LDS_BYTES); once = true; } }
    for (int i = 0; i < MK_XN; ++i) hipLaunchKernelGGL(mega<true>, dim3(grid), dim3(NTHR), LDS_BYTES, stream, p, MK_XPH, MK_XPH + 1);
#endif
}
```

```cpp
#include <hip/hip_runtime.h>
#include <hip/hip_cooperative_groups.h>
#include <cstdio>
#include <cstdint>
namespace cg = cooperative_groups;
#ifndef MK_SEL2
#define MK_SEL2 0
#define MK_SC2 0
#define MK_BIS2 0
#define MK_FUSE 7
#define MK_AX 0
#define MK_TPROBE 0
#endif

#define DEVI __device__ __forceinline__
#define LAS __attribute__((address_space(3)))
typedef unsigned short bf16_t;
typedef short bf16x8 __attribute__((ext_vector_type(8)));
typedef short s16x4 __attribute__((ext_vector_type(4)));
typedef float f32x2 __attribute__((ext_vector_type(2)));
typedef float f32x4 __attribute__((ext_vector_type(4)));
typedef float f32x16 __attribute__((ext_vector_type(16)));
typedef unsigned u32x2 __attribute__((ext_vector_type(2)));
typedef unsigned u32x4 __attribute__((ext_vector_type(4)));
typedef unsigned long long u64;

constexpr int NB = 4, S = 4096, T = NB * S, D = 1024, DFF = 4096, MEML = 256, MEMT = NB * MEML;
constexpr int LDP = 2816;
constexpr int C_QA = 0, C_KA = 512, C_VA = 1024, C_QB = 1536, C_CKV = 2048, C_QI = 2304, C_KI = 2560, C_WI = 2624, EVEN_IN = 2628;
constexpr float EPS = 1e-6f;
constexpr float LOG2E = 1.4426950408889634f;
constexpr int NTHR = 512, NWAVE = 8;
constexpr int LDS_BYTES = 163840;

constexpr size_t MiB = 1u << 20;
constexpr size_t WS_SSQ = 0;
constexpr size_t WS_SSQCKV = WS_SSQ + 6ull * T * 4;
constexpr size_t WS_SSQMEM = WS_SSQCKV + (size_t)T * 4;
constexpr size_t WS_WI = 512 * 1024;
constexpr size_t WS_BAR = 1 * MiB;
constexpr size_t WS_W = 2 * MiB;
constexpr size_t W_INE = WS_W;
constexpr size_t W_KVUP = W_INE + (size_t)LDP * 1024 * 2;
constexpr size_t W_OUTE = W_KVUP + 1024ull * 256 * 2;
constexpr size_t W_QX = W_OUTE + 1024ull * 1024 * 2;
constexpr size_t W_KVX = W_QX + 2 * 512ull * 1024 * 2;
constexpr size_t W_OX = W_KVX + 2 * 1024ull * 1024 * 2;
constexpr size_t W_UP = W_OX + 2 * 1024ull * 512 * 2;
constexpr size_t W_DOWN = W_UP + 2 * 4096ull * 1024 * 2;
constexpr size_t W_INO = W_DOWN + 2 * 4096ull * 1024 * 2;
constexpr size_t W_POOL = W_INO + 2048ull * 1024 * 2;
constexpr size_t W_OUTO = W_POOL + 512ull * 512 * 2;
constexpr size_t W_END = W_OUTO + 1024ull * 1024 * 2;
static_assert(W_END <= 57 * MiB, "weights region");
constexpr size_t WS_XB = 57 * MiB;
constexpr size_t WS_PROJ = 89 * MiB;
constexpr size_t WS_KBVB = 177 * MiB;
constexpr size_t WS_MASK = 209 * MiB;
constexpr size_t WS_Y = 217 * MiB;
constexpr size_t WS_CS = 249 * MiB;
constexpr size_t WS_MB = 250 * MiB;
constexpr size_t WS_KVX = 252 * MiB;
constexpr size_t WS_END = 256 * MiB;
constexpr size_t WS_QX = WS_PROJ;
constexpr size_t WS_YX = WS_PROJ + 16 * MiB;
constexpr size_t WS_H = WS_PROJ;
constexpr size_t WS_PROJ1 = WS_PROJ;
constexpr size_t WS_POOLED = WS_PROJ + 64 * MiB;
constexpr size_t WS_KI = WS_Y;

struct Params { const float* in[33]; float* out; unsigned char* ws; };

DEVI float bf2f(bf16_t v) { return __uint_as_float(((unsigned)v) << 16); }
DEVI unsigned f2bf(float f) { unsigned u = __float_as_uint(f); return (u + 0x7fffu + ((u >> 16) & 1u)) >> 16; }
DEVI unsigned pk2(float lo, float hi) { return f2bf(lo) | (f2bf(hi) << 16); }
DEVI float wave_sum(float v) {
#pragma unroll
    for (int o = 1; o < 64; o <<= 1) v += __shfl_xor(v, o);
    return v;
}
DEVI float lo16(unsigned w) { return __uint_as_float(w << 16); }
DEVI float hi16(unsigned w) { return __uint_as_float(w & 0xffff0000u); }
#define LDS_WAIT() asm volatile("s_waitcnt lgkmcnt(0)" ::: "memory")
DEVI unsigned cvtpk(float lo, float hi) { typedef __bf16 bf2 __attribute__((ext_vector_type(2))); f32x2 v = {lo, hi}; bf2 b = __builtin_convertvector(v, bf2); return __builtin_bit_cast(unsigned, b); }

DEVI int tid_opaque() { int w = __builtin_amdgcn_readfirstlane(threadIdx.x >> 6); asm volatile("" : "+s"(w)); const int l = __builtin_amdgcn_mbcnt_hi(~0u, __builtin_amdgcn_mbcnt_lo(~0u, 0u)); return w * 64 + l; }
struct TrD { const float* src; bf16_t* dst; const float* sk; const float* sn; int K, N, ldd; };
constexpr int NTR = 19;
DEVI TrD get_tr(const Params& P, int i) {
    unsigned char* ws = P.ws; TrD d; d.sk = nullptr; d.sn = nullptr;
    switch (i) {
    case 0: d.src = P.in[14]; d.dst = (bf16_t*)(ws + W_INE); d.K = 1024; d.N = EVEN_IN; d.ldd = 1024; d.sk = P.in[3]; break;
    case 1: d.src = P.in[23]; d.dst = (bf16_t*)(ws + W_KVUP); d.K = 256; d.N = 1024; d.ldd = 256; d.sk = P.in[22]; break;
    case 2: d.src = P.in[27]; d.dst = (bf16_t*)(ws + W_OUTE); d.K = 1024; d.N = 1024; d.ldd = 1024; break;
    case 3: case 4: { int l = i - 3; d.src = P.in[7] + (size_t)l * 1024 * 512; d.dst = (bf16_t*)(ws + W_QX) + (size_t)l * 512 * 1024; d.K = 1024; d.N = 512; d.ldd = 1024; d.sk = P.in[4] + l * 1024; } break;
    case 5: case 6: { int l = i - 5; d.src = P.in[8] + (size_t)l * 1024 * 1024; d.dst = (bf16_t*)(ws + W_KVX) + (size_t)l * 1024 * 1024; d.K = 1024; d.N = 1024; d.ldd = 1024; d.sk = P.in[5] + l * 1024; } break;
    case 7: case 8: { int l = i - 7; d.src = P.in[11] + (size_t)l * 512 * 1024; d.dst = (bf16_t*)(ws + W_OX) + (size_t)l * 1024 * 512; d.K = 512; d.N = 1024; d.ldd = 512; } break;
    case 9: case 10: { int l = i - 9; d.src = P.in[12] + (size_t)l * 1024 * 4096; d.dst = (bf16_t*)(ws + W_UP) + (size_t)l * 4096 * 1024; d.K = 1024; d.N = 4096; d.ldd = 1024; d.sk = P.in[6] + l * 1024; } break;
    case 11: case 12: { int l = i - 11; d.src = P.in[13] + (size_t)l * 4096 * 1024; d.dst = (bf16_t*)(ws + W_DOWN) + (size_t)l * 1024 * 4096; d.K = 4096; d.N = 1024; d.ldd = 4096; } break;
    case 13: d.src = P.in[28]; d.dst = (bf16_t*)(ws + W_INO); d.K = 1024; d.N = 2048; d.ldd = 1024; d.sk = P.in[3] + 1024; break;
    case 14: case 15: case 16: case 17: d.src = P.in[30]; d.dst = (bf16_t*)(ws + W_POOL); d.K = 0; d.N = 32; d.ldd = 512; break;
    default: d.src = P.in[32]; d.dst = (bf16_t*)(ws + W_OUTO); d.K = 512; d.N = 1024; d.ldd = 1024; break;
    }
    return d;
}
DEVI int tr_items(const TrD& d) { return (d.K / 64) * ((d.N + 31) / 32); }
template <bool SK, bool SN>
DEVI void tr_item(const TrD& d, LAS float* scr, int item, int lane) {
    const int nblk = (d.N + 31) / 32, kb = item / nblk, nb = item % nblk, k0 = 64 * kb, n0 = 32 * nb;
    const int n = n0 + (lane & 31), nc = (n < d.N) ? n : (d.N - 1);
    const float* sp = d.src + (size_t)(k0 + (lane >> 5)) * d.N + nc;
    float v[32], sk[32];
#pragma unroll
    for (int i = 0; i < 32; ++i) { v[i] = sp[(size_t)(2 * i) * d.N]; if (SK) sk[i] = d.sk[k0 + 2 * i + (lane >> 5)]; }
#pragma unroll
    for (int i = 0; i < 32; ++i) { float x = v[i]; if (SK) x *= sk[i]; if (n >= d.N) x = 0.f; scr[(2 * i + (lane >> 5)) * 33 + (lane & 31)] = x; }
    LDS_WAIT(); asm volatile("" ::: "memory");
    const int c = lane & 7;
#pragma unroll
    for (int j = 0; j < 4; ++j) {
        const int nn = (lane >> 3) + 8 * j, ncl = (n0 + nn < d.N) ? (n0 + nn) : (d.N - 1);
        const LAS float* s = scr + (8 * c) * 33 + nn;
        float sc = 1.f; if (SN) sc = d.sn[ncl];
        u32x4 o; o.x = pk2(s[0 * 33] * sc, s[1 * 33] * sc); o.y = pk2(s[2 * 33] * sc, s[3 * 33] * sc); o.z = pk2(s[4 * 33] * sc, s[5 * 33] * sc); o.w = pk2(s[6 * 33] * sc, s[7 * 33] * sc);
        if (n0 + nn < d.N) *(u32x4*)(d.dst + (size_t)(n0 + nn) * d.ldd + k0 + 8 * c) = o;
    }
    LDS_WAIT(); asm volatile("" ::: "memory");
}
DEVI void row_to_bf16_ssq(const float* xrow, bf16_t* orow, float* ssq_out, int lane) {
    const f32x4* xr = (const f32x4*)xrow + lane;
    f32x4 v[4]; float s = 0.f;
#pragma unroll
    for (int j = 0; j < 4; ++j) { v[j] = xr[64 * j]; s += (v[j].x * v[j].x + v[j].y * v[j].y) + (v[j].z * v[j].z + v[j].w * v[j].w); }
    s = wave_sum(s);
    if (lane == 0) *ssq_out = s;
    u32x2* o8 = (u32x2*)orow + lane;
#pragma unroll
    for (int j = 0; j < 4; ++j) { u32x2 w; w.x = pk2(v[j].x, v[j].y); w.y = pk2(v[j].z, v[j].w); o8[64 * j] = w; }
}
#ifndef MK_SUB
#define MK_SUB 0
#endif
DEVI void convert_weights(const Params& P, LAS unsigned char* lds, int dlo, int dhi, bool fold, int gw, int NGW, int gt, int NGT) {
    const int tid = tid_opaque(), lane = tid & 63, wave = tid >> 6;
    unsigned char* ws = P.ws;
    LAS float* scr = (LAS float*)(lds + wave * 16384);
    int base = 0;
    for (int i = dlo; i < dhi; ++i) {
        const TrD d = get_tr(P, i); const int n = tr_items(d);
        int first = gw - (base % NGW); if (first < 0) first += NGW;
        if (d.sn) { for (int it = first; it < n; it += NGW) tr_item<false, true>(d, scr, it, lane); }
        else if (d.sk) { for (int it = first; it < n; it += NGW) tr_item<true, false>(d, scr, it, lane); }
        else { for (int it = first; it < n; it += NGW) tr_item<false, false>(d, scr, it, lane); }
        base += n;
    }
    if (!fold) return;
    for (int i = gt; i < 1024 * 64; i += NGT) {
        const int n = i & 1023, cp0 = (i >> 10) * 8, g = cp0 >> 7, c = cp0 & 127;
        const float* wo = P.in[32] + (size_t)(512 + g * 128) * 1024 + n; const float* wp = P.in[30] + (size_t)g * 16384 + (size_t)c * 128; const float* ps = P.in[31] + g * 128;
        float acc[8];
#pragma unroll
        for (int j = 0; j < 8; ++j) acc[j] = 0.f;
        for (int d0 = 0; d0 < 128; d0 += 8) {
            float wv[8];
#pragma unroll
            for (int dd = 0; dd < 8; ++dd) wv[dd] = wo[(size_t)(d0 + dd) * 1024] * ps[d0 + dd];
#pragma unroll
            for (int dd = 0; dd < 8; ++dd)
#pragma unroll
                for (int j = 0; j < 8; ++j) acc[j] += wp[j * 128 + d0 + dd] * wv[dd];
        }
        u32x4 w; w.x = pk2(acc[0], acc[1]); w.y = pk2(acc[2], acc[3]); w.z = pk2(acc[4], acc[5]); w.w = pk2(acc[6], acc[7]);
        *(u32x4*)((bf16_t*)(ws + W_OUTO) + (size_t)n * 1024 + 512 + cp0) = w;
    }
}
constexpr int NTR_EARLY = 7;
DEVI void phase_prologue(const Params& P, LAS unsigned char* lds, int dry = 0) {
    const int tid = tid_opaque(), lane = tid & 63, wave = tid >> 6;
#if MK_TPROBE == 20
    { float a0 = lane, a1 = lane + 1, a2 = lane + 2, a3 = lane + 3, a4 = lane + 4, a5 = lane + 5, a6 = lane + 6, a7 = lane + 7;
      unsigned long long t0_ = __builtin_amdgcn_s_memtime();
      for (int it = 0; it < 1000; ++it) {
#pragma unroll
          for (int k = 0; k < 8; ++k) { asm volatile("v_fma_f32 %0, %0, 1.0, %0\n\tv_fma_f32 %1, %1, 1.0, %1\n\tv_fma_f32 %2, %2, 1.0, %2\n\tv_fma_f32 %3, %3, 1.0, %3\n\tv_fma_f32 %4, %4, 1.0, %4\n\tv_fma_f32 %5, %5, 1.0, %5\n\tv_fma_f32 %6, %6, 1.0, %6\n\tv_fma_f32 %7, %7, 1.0, %7" : "+v"(a0), "+v"(a1), "+v"(a2), "+v"(a3), "+v"(a4), "+v"(a5), "+v"(a6), "+v"(a7)); }
      }
      unsigned long long t1_ = __builtin_amdgcn_s_memtime();
      asm volatile("" :: "v"(a0), "v"(a1), "v"(a2), "v"(a3), "v"(a4), "v"(a5), "v"(a6), "v"(a7));
      if (blockIdx.x == 0 && tid == 0) atomicAdd((unsigned long long*)(P.ws + WS_BAR + 65536) + 3, t1_ - t0_); }
#endif
    const int gw = blockIdx.x * NWAVE + wave, NGW = gridDim.x * NWAVE;
    const int gt = blockIdx.x * NTHR + tid, NGT = gridDim.x * NTHR;
    unsigned char* ws = P.ws;
    convert_weights(P, lds, 0, (gridDim.x == 256) ? NTR_EARLY : NTR, gridDim.x != 256, gw, NGW, gt, NGT);
    { bf16_t* w = (bf16_t*)(ws + W_INE) + (size_t)EVEN_IN * 1024; const int n = (LDP - EVEN_IN) * 1024 / 8;
      for (int i = gt; i < n; i += NGT) ((u32x4*)w)[i] = (u32x4){0u, 0u, 0u, 0u}; }
    { float* q = (float*)(ws + WS_SSQ) + T; for (int i = gt; i < 5 * T; i += NGT) q[i] = 0.f; }
    if (!(dry && MK_SUB != 2 && MK_SUB != 0))
    for (int m = gw; m < T; m += NGW) row_to_bf16_ssq(P.in[0] + (size_t)m * D, (bf16_t*)(ws + WS_XB) + (size_t)m * D, (float*)(ws + WS_SSQ) + m, lane);
    for (int m = gw; m < MEMT; m += NGW) row_to_bf16_ssq(P.in[1] + (size_t)m * D, (bf16_t*)(ws + WS_MB) + (size_t)m * D, (float*)(ws + WS_SSQMEM) + m, lane);
    if (!(dry && MK_SUB != 3 && MK_SUB != 0))
    { const int* pos = (const int*)P.in[2]; float* cs = (float*)(ws + WS_CS);
      for (int i = gt; i < T * 8; i += NGT) { const int m = i >> 3, f = i & 7;
        const double inv = (f == 0) ? 1.0 : (f == 1) ? 0.19392274474868576 : (f == 2) ? 0.03760603093086393 : (f == 3) ? 0.007292664737217109 : (f == 4) ? 0.001414213562373095
                         : (f == 5) ? 0.0002742481756762073 : (f == 6) ? 5.318295896944988e-05 : 1.031338537721246e-05;
        const double ang = (double)pos[m] * inv, k = rint(ang * 0.15915494309189535), r = fma(-k, 6.283185307179586, ang) - k * 2.4492935982947064e-16;
        cs[m * 16 + f] = cosf((float)r); cs[m * 16 + 8 + f] = sinf((float)r); } }
}

struct EpiStore {
    bf16_t* O; int ldo; const float* ssq; float inv_n; int act;
    DEVI void operator()(const f32x4 (&acc)[4][4], int row0, int col0, int lane) const {
#pragma unroll
        for (int m = 0; m < 4; ++m)
#pragma unroll
            for (int i = 0; i < 4; ++i) {
                const int row = row0 + 16 * m + (lane >> 4) * 4 + i;
                const float rs = ssq ? rsqrtf(ssq[row] * inv_n + EPS) : 1.f;
#pragma unroll
                for (int n = 0; n < 4; ++n) {
                    float v = acc[m][n][i] * rs;
                    if (act == 1) { v = fmaxf(v, 0.f); v = v * v; }
                    O[(size_t)row * ldo + col0 + 16 * n + (lane & 15)] = (bf16_t)f2bf(v);
                }
            }
    }
};
struct EpiRes {
    const float* base; float* out; bf16_t* xb; float* ssq_next;
    DEVI void operator()(const f32x4 (&acc)[4][4], int row0, int col0, int lane) const {
#pragma unroll
        for (int m = 0; m < 4; ++m)
#pragma unroll
            for (int i = 0; i < 4; ++i) {
                const int row = row0 + 16 * m + (lane >> 4) * 4 + i; float s = 0.f;
#pragma unroll
                for (int n = 0; n < 4; ++n) {
                    const size_t idx = (size_t)row * D + col0 + 16 * n + (lane & 15);
                    const float v = base[idx] + acc[m][n][i];
                    out[idx] = v; s += v * v;
                    if (xb) xb[idx] = (bf16_t)f2bf(v);
                }
                if (ssq_next) {
                    s += __shfl_xor(s, 1); s += __shfl_xor(s, 2); s += __shfl_xor(s, 4); s += __shfl_xor(s, 8);
                    if ((lane & 15) == 0) atomicAdd(ssq_next + row, s);
                }
            }
    }
};
template <class Epi>
DEVI void gemm_simple(const bf16_t* A, int lda, const bf16_t* Bt, int ldb, int M, int N, int K, const Epi& epi) {
    const int tid = tid_opaque(), lane = tid & 63, wave = tid >> 6;
    const int gw = blockIdx.x * NWAVE + wave, NGW = gridDim.x * NWAVE;
    const int nN = N / 64, ntiles = (M / 64) * nN;
    for (int tile = gw; tile < ntiles; tile += NGW) {
        const int row0 = (tile / nN) * 64, col0 = (tile % nN) * 64;
        f32x4 acc[4][4];
#pragma unroll
        for (int m = 0; m < 4; ++m)
#pragma unroll
            for (int n = 0; n < 4; ++n) acc[m][n] = (f32x4){0.f, 0.f, 0.f, 0.f};
        const bf16_t* ap = A + (size_t)(row0 + (lane & 15)) * lda + 8 * (lane >> 4);
        const bf16_t* bp = Bt + (size_t)(col0 + (lane & 15)) * ldb + 8 * (lane >> 4);
        for (int k0 = 0; k0 < K; k0 += 32) {
            bf16x8 a[4], b[4];
#pragma unroll
            for (int m = 0; m < 4; ++m) a[m] = *(const bf16x8*)(ap + (size_t)(16 * m) * lda + k0);
#pragma unroll
            for (int n = 0; n < 4; ++n) b[n] = *(const bf16x8*)(bp + (size_t)(16 * n) * ldb + k0);
#pragma unroll
            for (int m = 0; m < 4; ++m)
#pragma unroll
                for (int n = 0; n < 4; ++n) acc[m][n] = __builtin_amdgcn_mfma_f32_16x16x32_bf16(a[m], b[n], acc[m][n], 0, 0, 0);
        }
        epi(acc, row0, col0, lane);
    }
}

DEVI u32x4 heads8(u32x4 raw, const float (&gv)[8], bool do_norm, float scale, const float (&cs)[16], int lane) {
    float v[8];
#pragma unroll
    for (int j = 0; j < 4; ++j) { v[2 * j] = lo16(raw[j]); v[2 * j + 1] = hi16(raw[j]); }
    if (do_norm) {
        float ss = 0.f;
#pragma unroll
        for (int j = 0; j < 8; ++j) ss += v[j] * v[j];
        ss += __shfl_xor(ss, 1); ss += __shfl_xor(ss, 2); ss += __shfl_xor(ss, 4);
        const float rs = rsqrtf(ss * (1.f / 64.f) + EPS);
#pragma unroll
        for (int j = 0; j < 8; ++j) v[j] = v[j] * rs * gv[j];
    }
    const int sub = lane & 7;
#pragma unroll
    for (int j = 0; j < 8; ++j) { const float o = __shfl_xor(v[j], 1); if (sub == 0) v[j] = v[j] * cs[j] - o * cs[8 + j]; else if (sub == 1) v[j] = v[j] * cs[j] + o * cs[8 + j]; }
    u32x4 w;
#pragma unroll
    for (int j = 0; j < 4; ++j) w[j] = cvtpk(v[2 * j] * scale, v[2 * j + 1] * scale);
    return w;
}
DEVI void load8(float (&g)[8], const float* p) { const f32x4 a = *(const f32x4*)p, b = *(const f32x4*)(p + 4); g[0] = a[0]; g[1] = a[1]; g[2] = a[2]; g[3] = a[3]; g[4] = b[0]; g[5] = b[1]; g[6] = b[2]; g[7] = b[3]; }
struct Post0Row { u32x4 qa, ka, qb, x, ckv; u32x2 wi; f32x4 c0, c1, c2, c3; };
DEVI void post0_load(Post0Row& R, const bf16_t* row, const float* cs, int lane) {
    R.qa = *(const u32x4*)(row + C_QA + 8 * lane); R.ka = *(const u32x4*)(row + C_KA + 8 * lane); R.qb = *(const u32x4*)(row + C_QB + 8 * lane);
    R.x = *(const u32x4*)(row + C_QI + 8 * ((lane < 40) ? lane : 0));
    R.ckv = *(const u32x4*)(row + C_CKV + 8 * (lane & 31));
    R.wi = *(const u32x2*)(row + C_WI);
    R.c0 = *(const f32x4*)cs; R.c1 = *(const f32x4*)(cs + 4); R.c2 = *(const f32x4*)(cs + 8); R.c3 = *(const f32x4*)(cs + 12);
}
DEVI void phase_post0(const Params& P, int parts = 3) {
    static_assert(C_KI == C_QI + 256, "k_idx follows q_idx");
    const int tid = tid_opaque(), lane = tid & 63, wave = tid >> 6;
    const int gw = blockIdx.x * NWAVE + wave, NGW = gridDim.x * NWAVE;
    unsigned char* ws = P.ws;
    const float qscale = 0.125f * LOG2E;
    float gqa[8], gka[8], gqb[8], gki[8];
    load8(gqa, P.in[15] + 8 * (lane & 7)); load8(gka, P.in[16] + 8 * (lane & 7)); load8(gqb, P.in[24] + 8 * (lane & 7)); load8(gki, P.in[26] + 8 * (lane & 7));
    if (parts & 1)
    for (int m0 = gw; m0 < T; m0 += 2 * NGW) {
        Post0Row R[2];
        const int m1 = (m0 + NGW < T) ? m0 + NGW : m0;
        post0_load(R[0], (const bf16_t*)(ws + WS_PROJ) + (size_t)m0 * LDP, (const float*)(ws + WS_CS) + (size_t)m0 * 16, lane);
        post0_load(R[1], (const bf16_t*)(ws + WS_PROJ) + (size_t)m1 * LDP, (const float*)(ws + WS_CS) + (size_t)m1 * 16, lane);
#pragma unroll
        for (int k = 0; k < 2; ++k) {
            const int m = k ? m1 : m0; if (k == 1 && m1 == m0) break;
            bf16_t* row = (bf16_t*)(ws + WS_PROJ) + (size_t)m * LDP;
            float cs[16];
#pragma unroll
            for (int j = 0; j < 4; ++j) { cs[j] = R[k].c0[j]; cs[4 + j] = R[k].c1[j]; cs[8 + j] = R[k].c2[j]; cs[12 + j] = R[k].c3[j]; }
            *(u32x4*)(row + C_QA + 8 * lane) = heads8(R[k].qa, gqa, true, qscale, cs, lane);
            *(u32x4*)(row + C_KA + 8 * lane) = heads8(R[k].ka, gka, true, 1.f, cs, lane);
            *(u32x4*)(row + C_QB + 8 * lane) = heads8(R[k].qb, gqb, true, qscale, cs, lane);
            {
              float v[8];
#pragma unroll
              for (int j = 0; j < 4; ++j) { v[2 * j] = lo16(R[k].x[j]); v[2 * j + 1] = hi16(R[k].x[j]); }
              float ss = 0.f;
#pragma unroll
              for (int j = 0; j < 8; ++j) ss += v[j] * v[j];
              ss += __shfl_xor(ss, 1); ss += __shfl_xor(ss, 2); ss += __shfl_xor(ss, 4);
              if (lane >= 32) { const float rs = rsqrtf(ss * (1.f / 64.f) + EPS);
#pragma unroll
                  for (int j = 0; j < 8; ++j) v[j] = v[j] * rs * gki[j]; }
              const int sub = lane & 7;
#pragma unroll
              for (int j = 0; j < 8; ++j) { const float o = __shfl_xor(v[j], 1); if (sub == 0) v[j] = v[j] * cs[j] - o * cs[8 + j]; else if (sub == 1) v[j] = v[j] * cs[j] + o * cs[8 + j]; }
              u32x4 w;
#pragma unroll
              for (int j = 0; j < 4; ++j) w[j] = cvtpk(v[2 * j], v[2 * j + 1]);
              if (lane < 32) *(u32x4*)(row + C_QI + 8 * lane) = w;
              else if (lane < 40) { const int c = lane - 32;
                  *(u32x4*)((bf16_t*)(ws + WS_KI) + (size_t)(m >> 5) * 2048 + (c >> 1) * 512 + (((c & 1) * 32 + (m & 31)) * 8)) = w; } }
            { float ss = 0.f;
#pragma unroll
              for (int j = 0; j < 4; ++j) { const float a = lo16(R[k].ckv[j]), b = hi16(R[k].ckv[j]); ss += a * a + b * b; }
              ss += __shfl_xor(ss, 1); ss += __shfl_xor(ss, 2); ss += __shfl_xor(ss, 4); ss += __shfl_xor(ss, 8); ss += __shfl_xor(ss, 16);
              if (lane == 0) { ((float*)(ws + WS_SSQCKV))[m] = ss;
                  *(f32x4*)((float*)(ws + WS_WI) + (size_t)m * 4) = (f32x4){lo16(R[k].wi.x) * (1.f / 16.f), hi16(R[k].wi.x) * (1.f / 16.f), lo16(R[k].wi.y) * (1.f / 16.f), hi16(R[k].wi.y) * (1.f / 16.f)}; } }
        }
    }
    if (parts & 2)
    for (int it = gw; it < 2 * MEMT; it += NGW) {
        const int l = it / MEMT, m = it % MEMT;
        bf16_t* row = (bf16_t*)(ws + WS_KVX) + (size_t)m * 2048 + l * 1024;
        float g[8]; load8(g, P.in[10] + l * 128 + 8 * (lane & 15));
        const u32x4 raw = *(const u32x4*)(row + 8 * lane);
        float v[8]; float ss = 0.f;
#pragma unroll
        for (int j = 0; j < 4; ++j) { v[2 * j] = lo16(raw[j]); v[2 * j + 1] = hi16(raw[j]); ss += v[2 * j] * v[2 * j] + v[2 * j + 1] * v[2 * j + 1]; }
        ss += __shfl_xor(ss, 1); ss += __shfl_xor(ss, 2); ss += __shfl_xor(ss, 4); ss += __shfl_xor(ss, 8);
        const float rs = rsqrtf(ss * (1.f / 128.f) + EPS);
        u32x4 w;
#pragma unroll
        for (int j = 0; j < 4; ++j) w[j] = cvtpk(v[2 * j] * rs * g[2 * j], v[2 * j + 1] * rs * g[2 * j + 1]);
        *(u32x4*)(row + 8 * lane) = w;
    }
}
DEVI void phase_postkb(const Params& P) {
    const int tid = tid_opaque(), lane = tid & 63, wave = tid >> 6;
    const int gw = blockIdx.x * NWAVE + wave, NGW = gridDim.x * NWAVE;
    unsigned char* ws = P.ws;
    float gkb[8]; load8(gkb, P.in[25] + 8 * (lane & 7));
    for (int m0 = gw; m0 < T; m0 += 4 * NGW) {
        u32x4 raw[4]; f32x4 c[4][4];
#pragma unroll
        for (int k = 0; k < 4; ++k) { const int m = (m0 + k * NGW < T) ? m0 + k * NGW : m0;
            raw[k] = *(const u32x4*)((const bf16_t*)(ws + WS_KBVB) + (size_t)m * 1024 + 8 * lane);
            const float* cs = (const float*)(ws + WS_CS) + (size_t)m * 16;
#pragma unroll
            for (int j = 0; j < 4; ++j) c[k][j] = *(const f32x4*)(cs + 4 * j); }
#pragma unroll
        for (int k = 0; k < 4; ++k) { const int m = m0 + k * NGW; if (m >= T) break;
            float cs[16];
#pragma unroll
            for (int j = 0; j < 16; ++j) cs[j] = c[k][j >> 2][j & 3];
            *(u32x4*)((bf16_t*)(ws + WS_KBVB) + (size_t)m * 1024 + 8 * lane) = heads8(raw[k], gkb, true, 1.f, cs, lane); }
    }
}

DEVI int crow(int r, int hi) { return (r & 3) + 8 * (r >> 2) + 4 * hi; }
typedef short v4i16_t __attribute__((ext_vector_type(4)));
DEVI s16x4 vtr(LAS const unsigned char* p) { return __builtin_bit_cast(s16x4, __builtin_amdgcn_ds_read_tr16_b64_v4i16((LAS v4i16_t*)p)); }

DEVI float max3f(float a, float b, float c) { float r; asm("v_max3_f32 %0, %1, %2, %3" : "=v"(r) : "v"(a), "v"(b), "v"(c)); return r; }
DEVI float max2f(float a, float b) { float r; asm("v_max_f32_e32 %0, %1, %2" : "=v"(r) : "v"(a), "v"(b)); return r; }
template <int DQK, int DV, int MODE>
DEVI void attn_core(f32x16 (&o)[DV / 32], float& l_out, const bf16x8 (&qf)[DQK / 16],
                    const bf16_t* Kg, int ldk, const bf16_t* Vg, int ldv, int ntiles, int qpos, int qpos_wmin,
                    const u64* mrow, LAS unsigned char* lds, int tid) {
    constexpr int KROWB = DQK * 2, KCPR = DQK / 8, VP = (DV == 128) ? 320 : 192, VCPR = DV / 8;
    constexpr int KBUF = 64 * KROWB, VBUF = 64 * VP, KCH = 64 * KCPR / NTHR, VCH = 64 * VCPR / NTHR;
    constexpr float THR = 8.f;
    LAS unsigned char* Kl = lds; LAS unsigned char* Vl = lds + 2 * KBUF;
    const int lane = tid & 63, r32 = lane & 31, hi = lane >> 5;
    u32x4 kreg[KCH], vreg[VCH];
#define A_GLOAD(t) do { _Pragma("unroll") for (int i_ = 0; i_ < KCH; ++i_) { const int c_ = tid + NTHR * i_, row_ = c_ / KCPR, ch_ = c_ % KCPR; kreg[i_] = *(const u32x4*)(Kg + (size_t)(64 * (t) + row_) * ldk + ch_ * 8); } \
        _Pragma("unroll") for (int i_ = 0; i_ < VCH; ++i_) { const int c_ = tid + NTHR * i_, row_ = c_ / VCPR, ch_ = c_ % VCPR; vreg[i_] = *(const u32x4*)(Vg + (size_t)(64 * (t) + row_) * ldv + ch_ * 8); } } while (0)
#define A_LSTORE(buf) do { _Pragma("unroll") for (int i_ = 0; i_ < KCH; ++i_) { const int c_ = tid + NTHR * i_, row_ = c_ / KCPR, ch_ = c_ % KCPR; *(LAS u32x4*)(Kl + (buf) * KBUF + row_ * KROWB + ((ch_ ^ (row_ & (KCPR - 1))) << 4)) = kreg[i_]; } \
        _Pragma("unroll") for (int i_ = 0; i_ < VCH; ++i_) { const int c_ = tid + NTHR * i_, row_ = c_ / VCPR, ch_ = c_ % VCPR; *(LAS u32x4*)(Vl + (buf) * VBUF + row_ * VP + ch_ * 16) = vreg[i_]; } } while (0)
    A_GLOAD(0); A_LSTORE(0); __syncthreads();
    const int vb = (4 * hi + ((lane & 15) >> 2)) * VP + (16 * ((lane >> 4) & 1) + 4 * (lane & 3)) * 2;
    const short one = (short)0x3F80;
    const bf16x8 ones = ((r32 & ~4) == 0) ? (bf16x8){one, one, one, one, one, one, one, one} : (bf16x8){0, 0, 0, 0, 0, 0, 0, 0};
    f32x16 negm, lacc;
#pragma unroll
    for (int r = 0; r < 16; ++r) { negm[r] = 0.f; lacc[r] = 0.f; }
    float mhat = 0.f;
    const unsigned ninf = 0xFF800000u;
#if MK_AX == 1
    f32x16 dmy_;
#pragma unroll
    for (int r = 0; r < 16; ++r) dmy_[r] = 0.f;
#endif
    for (int t = 0; t < ntiles; ++t) {
        const int buf = t & 1;
        if (t + 1 < ntiles) A_GLOAD(t + 1);
        f32x16 p0, p1;
#pragma unroll
        for (int d0 = 0; d0 < DQK / 16; ++d0) {
            const int ch = 2 * d0 + hi, row0 = r32, row1 = 32 + r32;
            const bf16x8 a0 = *(LAS const bf16x8*)(Kl + buf * KBUF + row0 * KROWB + ((ch ^ (row0 & (KCPR - 1))) << 4));
            const bf16x8 a1 = *(LAS const bf16x8*)(Kl + buf * KBUF + row1 * KROWB + ((ch ^ (row1 & (KCPR - 1))) << 4));
            if (d0 == 0) { p0 = __builtin_amdgcn_mfma_f32_32x32x16_bf16(a0, qf[0], negm, 0, 0, 0); p1 = __builtin_amdgcn_mfma_f32_32x32x16_bf16(a1, qf[0], negm, 0, 0, 0); }
            else { p0 = __builtin_amdgcn_mfma_f32_32x32x16_bf16(a0, qf[d0], p0, 0, 0, 0); p1 = __builtin_amdgcn_mfma_f32_32x32x16_bf16(a1, qf[d0], p1, 0, 0, 0); }
        }
        if (MODE == 1) {
            if (64 * t + 63 > qpos_wmin) {
#pragma unroll
                for (int r = 0; r < 16; ++r) { const int kv = 64 * t + crow(r, hi); if (kv > qpos) p0[r] = -INFINITY; if (kv + 32 > qpos) p1[r] = -INFINITY; }
            }
        } else if (MODE == 2) {
            const u64 w = mrow[t] >> (4 * hi); const unsigned wl = (unsigned)w, wh = (unsigned)(w >> 32);
#pragma unroll
            for (int r = 0; r < 16; ++r) { const int bit = (r & 3) + 8 * (r >> 2);
                const unsigned s0 = (unsigned)__builtin_amdgcn_sbfe(wl, bit, 1), s1 = (unsigned)__builtin_amdgcn_sbfe(wh, bit, 1);
                p0[r] = __uint_as_float((__float_as_uint(p0[r]) & s0) | (ninf & ~s0)); p1[r] = __uint_as_float((__float_as_uint(p1[r]) & s1) | (ninf & ~s1)); }
        }
        asm volatile("s_nop 15\n\ts_nop 7" : "+v"(p0), "+v"(p1));
        float rm;
        { float a = max3f(p0[0], p0[1], p1[0]), b = max3f(p0[2], p0[3], p1[1]); a = max3f(a, p1[2], p1[3]);
#pragma unroll
          for (int r = 4; r < 16; r += 4) { a = max3f(a, p0[r], p0[r + 1]); b = max3f(b, p0[r + 2], p0[r + 3]); a = max3f(a, p1[r], p1[r + 1]); b = max3f(b, p1[r + 2], p1[r + 3]); }
          const float m = max2f(a, b);
          const auto rr = __builtin_amdgcn_permlane32_swap(__float_as_uint(m), __float_as_uint(m), false, false);
          rm = max2f(__uint_as_float(rr[0]), __uint_as_float(rr[1])); }
        if (t == 0 || __any(rm > THR)) {
            const float dl = (t == 0) ? ((rm > -INFINITY) ? rm : 0.f) : fmaxf(rm, 0.f);
            mhat += dl;
#pragma unroll
            for (int r = 0; r < 16; ++r) { p0[r] -= dl; p1[r] -= dl; negm[r] = -mhat; }
            const float f = __builtin_amdgcn_exp2f(-dl);
#pragma unroll
            for (int d0 = 0; d0 < DV / 32; ++d0)
#pragma unroll
                for (int r = 0; r < 16; ++r) o[d0][r] *= f;
#pragma unroll
            for (int r = 0; r < 16; ++r) lacc[r] *= f;
        }
#pragma unroll
        for (int r = 0; r < 16; ++r) { p0[r] = __builtin_amdgcn_exp2f(p0[r]); p1[r] = __builtin_amdgcn_exp2f(p1[r]); }
#if MK_AX == 2
        if (MODE == 1) {
#pragma unroll
            for (int r = 0; r < 16; ++r) { float e0 = __builtin_amdgcn_exp2f(p0[r] * 0.999f), e1 = __builtin_amdgcn_exp2f(p1[r] * 0.999f); asm volatile("" :: "v"(e0), "v"(e1)); } }
#endif
        bf16x8 pb[4];
#pragma unroll
        for (int ks = 0; ks < 4; ++ks) {
            u32x4 w;
            if (ks < 2) { w.x = cvtpk(p0[8 * ks + 0], p0[8 * ks + 1]); w.y = cvtpk(p0[8 * ks + 2], p0[8 * ks + 3]); w.z = cvtpk(p0[8 * ks + 4], p0[8 * ks + 5]); w.w = cvtpk(p0[8 * ks + 6], p0[8 * ks + 7]); }
            else { const int k2 = ks - 2; w.x = cvtpk(p1[8 * k2 + 0], p1[8 * k2 + 1]); w.y = cvtpk(p1[8 * k2 + 2], p1[8 * k2 + 3]); w.z = cvtpk(p1[8 * k2 + 4], p1[8 * k2 + 5]); w.w = cvtpk(p1[8 * k2 + 6], p1[8 * k2 + 7]); }
            pb[ks] = __builtin_bit_cast(bf16x8, w);
        }
#pragma unroll
        for (int ks = 0; ks < 4; ++ks) lacc = __builtin_amdgcn_mfma_f32_32x32x16_bf16(ones, pb[ks], lacc, 0, 0, 0);
#pragma unroll
        for (int d0 = 0; d0 < DV / 32; ++d0)
#pragma unroll
            for (int ks = 0; ks < 4; ++ks) {
                const s16x4 lo = vtr(Vl + buf * VBUF + vb + (16 * ks) * VP + d0 * 64);
                const s16x4 hh = vtr(Vl + buf * VBUF + vb + (16 * ks + 8) * VP + d0 * 64);
                const bf16x8 a = (bf16x8){lo[0], lo[1], lo[2], lo[3], hh[0], hh[1], hh[2], hh[3]};
                o[d0] = __builtin_amdgcn_mfma_f32_32x32x16_bf16(a, pb[ks], o[d0], 0, 0, 0);
#if MK_AX == 1
                if (MODE == 1) dmy_ = __builtin_amdgcn_mfma_f32_32x32x16_bf16(a, pb[ks], dmy_, 0, 0, 0);
#endif
            }
        if (t + 1 < ntiles) A_LSTORE((t + 1) & 1);
        __syncthreads();
    }
#if MK_AX == 1
    asm volatile("" :: "v"(dmy_));
#endif
    l_out = lacc[0];
#undef A_GLOAD
#undef A_LSTORE
}
template <int DV>
DEVI void store_oT(const f32x16 (&o)[DV / 32], float inv, bf16_t* dst, int hi) {
#pragma unroll
    for (int d0 = 0; d0 < DV / 32; ++d0)
#pragma unroll
        for (int g4 = 0; g4 < 4; ++g4) {
            u32x2 w; w.x = cvtpk(o[d0][4 * g4 + 0] * inv, o[d0][4 * g4 + 1] * inv); w.y = cvtpk(o[d0][4 * g4 + 2] * inv, o[d0][4 * g4 + 3] * inv);
            *(u32x2*)(dst + 32 * d0 + 8 * g4 + 4 * hi) = w;
        }
}

DEVI void attnA_unit(const Params& P, int b, int h, int c, int qb, LAS unsigned char* lds) {
    const int tid = tid_opaque(), lane = tid & 63, wave = tid >> 6, r32 = lane & 31, hi = lane >> 5;
    unsigned char* ws = P.ws;
    const bf16_t* proj = (const bf16_t*)(ws + WS_PROJ);
    const int q = qb * 256 + 32 * wave + r32; const size_t row = (size_t)b * S + q;
    bf16x8 qf[4];
#pragma unroll
    for (int d0 = 0; d0 < 4; ++d0) qf[d0] = *(const bf16x8*)(proj + row * LDP + C_QA + (2 * h + c) * 64 + 16 * d0 + 8 * hi);
    f32x16 o[4];
#pragma unroll
    for (int d0 = 0; d0 < 4; ++d0)
#pragma unroll
        for (int r = 0; r < 16; ++r) o[d0][r] = 0.f;
    float l_run = 0.f;
    attn_core<64, 128, 1>(o, l_run, qf, proj + (size_t)b * S * LDP + C_KA + (2 * h + c) * 64, LDP, proj + (size_t)b * S * LDP + C_VA + h * 128, LDP,
                          4 * (qb + 1), q, qb * 256 + 32 * wave, nullptr, lds, tid);
    const float lt = l_run;
    bf16_t* oa = (bf16_t*)(ws + WS_XB) + (size_t)c * T * 512 + row * 512 + h * 128;
    store_oT<128>(o, 1.f / lt, oa, hi);
}
DEVI void attnB_unit(const Params& P, int b, int hd, int qb, LAS unsigned char* lds) {
    const int tid = tid_opaque(), lane = tid & 63, wave = tid >> 6, r32 = lane & 31, hi = lane >> 5;
    unsigned char* ws = P.ws;
    const bf16_t* proj = (const bf16_t*)(ws + WS_PROJ); const bf16_t* kbvb = (const bf16_t*)(ws + WS_KBVB);
    const int q = qb * 256 + 32 * wave + r32; const size_t row = (size_t)b * S + q;
    bf16x8 qf[4];
#pragma unroll
    for (int d0 = 0; d0 < 4; ++d0) qf[d0] = *(const bf16x8*)(proj + row * LDP + C_QB + hd * 64 + 16 * d0 + 8 * hi);
    f32x16 o[2];
#pragma unroll
    for (int d0 = 0; d0 < 2; ++d0)
#pragma unroll
        for (int r = 0; r < 16; ++r) o[d0][r] = 0.f;
    float l_run = 0.f;
    attn_core<64, 64, 2>(o, l_run, qf, kbvb + (size_t)b * S * 1024 + hd * 64, 1024, kbvb + (size_t)b * S * 1024 + 512 + hd * 64, 1024,
                         4 * (qb + 1), q, qb * 256 + 32 * wave, (const u64*)(ws + WS_MASK) + row * 64, lds, tid);
    const float lt = l_run;
    store_oT<64>(o, 1.f / lt, (bf16_t*)(ws + WS_Y) + row * 1024 + 512 + hd * 64, hi);
}
DEVI void xattn_unit(const Params& P, int l, int b, int hd, int qb, LAS unsigned char* lds) {
    const int tid = tid_opaque(), lane = tid & 63, wave = tid >> 6, r32 = lane & 31, hi = lane >> 5;
    unsigned char* ws = P.ws;
    const bf16_t* qx = (const bf16_t*)(ws + WS_QX); const bf16_t* kvx = (const bf16_t*)(ws + WS_KVX) + l * 1024;
    const int q = qb * 256 + 32 * wave + r32; const size_t row = (size_t)b * S + q;
    const float* gq = P.in[9] + l * 128;
    u32x4 raw[8]; float ss = 0.f;
#pragma unroll
    for (int d0 = 0; d0 < 8; ++d0) { raw[d0] = *(const u32x4*)(qx + row * 512 + hd * 128 + 16 * d0 + 8 * hi);
#pragma unroll
        for (int j = 0; j < 4; ++j) { const float a = lo16(raw[d0][j]), bq = hi16(raw[d0][j]); ss += a * a + bq * bq; } }
    ss += __shfl_xor(ss, 32);
    const float rs = rsqrtf(ss * (1.f / 128.f) + EPS) * (0.08838834764831845f * LOG2E);
    bf16x8 qf[8];
#pragma unroll
    for (int d0 = 0; d0 < 8; ++d0) { u32x4 w;
#pragma unroll
        for (int j = 0; j < 4; ++j) { const int dim = 16 * d0 + 8 * hi + 2 * j; w[j] = cvtpk(lo16(raw[d0][j]) * rs * gq[dim], hi16(raw[d0][j]) * rs * gq[dim + 1]); }
        qf[d0] = __builtin_bit_cast(bf16x8, w); }
    f32x16 o[4];
#pragma unroll
    for (int d0 = 0; d0 < 4; ++d0)
#pragma unroll
        for (int r = 0; r < 16; ++r) o[d0][r] = 0.f;
    float l_run = 0.f;
    attn_core<128, 128, 0>(o, l_run, qf, kvx + (size_t)b * MEML * 2048 + hd * 128, 2048, kvx + (size_t)b * MEML * 2048 + 512 + hd * 128, 2048,
                           MEML / 64, q, 0, nullptr, lds, tid);
    const float lt = l_run;
    store_oT<128>(o, 1.f / lt, (bf16_t*)(ws + WS_YX) + row * 512 + hd * 128, hi);
}

#define DPP_STEP4(OP, v) do { v = OP(v, __builtin_amdgcn_update_dpp(v, v, 0xB1, 0xF, 0xF, false)); v = OP(v, __builtin_amdgcn_update_dpp(v, v, 0x4E, 0xF, 0xF, false)); \
        v = OP(v, __builtin_amdgcn_update_dpp(v, v, 0x141, 0xF, 0xF, false)); v = OP(v, __builtin_amdgcn_update_dpp(v, v, 0x140, 0xF, 0xF, false)); } while (0)
DEVI unsigned umax2(unsigned a, unsigned b) { return a > b ? a : b; }
DEVI unsigned umin2(unsigned a, unsigned b) { return a < b ? a : b; }
DEVI unsigned wave_max_u32(unsigned v) { DPP_STEP4(umax2, v);
    const auto a = __builtin_amdgcn_permlane16_swap(v, v, false, false); v = umax2(a[0], a[1]);
    const auto b = __builtin_amdgcn_permlane32_swap(v, v, false, false); return umax2(b[0], b[1]); }
DEVI unsigned wave_min_u32(unsigned v) { DPP_STEP4(umin2, v);
    const auto a = __builtin_amdgcn_permlane16_swap(v, v, false, false); v = umin2(a[0], a[1]);
    const auto b = __builtin_amdgcn_permlane32_swap(v, v, false, false); return umin2(b[0], b[1]); }
DEVI float row16_sum(float s) {
    s += __builtin_bit_cast(float, __builtin_amdgcn_update_dpp(0, __builtin_bit_cast(int, s), 0xB1, 0xF, 0xF, false)); s += __builtin_bit_cast(float, __builtin_amdgcn_update_dpp(0, __builtin_bit_cast(int, s), 0x4E, 0xF, 0xF, false));
    s += __builtin_bit_cast(float, __builtin_amdgcn_update_dpp(0, __builtin_bit_cast(int, s), 0x141, 0xF, 0xF, false)); s += __builtin_bit_cast(float, __builtin_amdgcn_update_dpp(0, __builtin_bit_cast(int, s), 0x140, 0xF, 0xF, false));
    return s; }
DEVI int wave_sum_dpp(int v) {
    v += __builtin_amdgcn_update_dpp(0, v, 0xB1, 0xF, 0xF, false);
    v += __builtin_amdgcn_update_dpp(0, v, 0x4E, 0xF, 0xF, false);
    v += __builtin_amdgcn_update_dpp(0, v, 0x141, 0xF, 0xF, false);
    v += __builtin_amdgcn_update_dpp(0, v, 0x140, 0xF, 0xF, false);
    return (__builtin_amdgcn_readlane(v, 0) + __builtin_amdgcn_readlane(v, 16)) + (__builtin_amdgcn_readlane(v, 32) + __builtin_amdgcn_readlane(v, 48));
}
constexpr int IDX_SROW = 4096 + 64;
DEVI void indexer_unit(const Params& P, int b, int t0, LAS unsigned char* lds) {
    const int tid = tid_opaque(), lane = tid & 63, wave = __builtin_amdgcn_readfirstlane(tid >> 6), r32 = lane & 31, hi = lane >> 5;
    unsigned char* ws = P.ws;
    const bf16_t* proj = (const bf16_t*)(ws + WS_PROJ); const float* WI = (const float*)(ws + WS_WI);
    LAS float* Ssc = (LAS float*)lds;
    for (int rs_ = 0; rs_ < 1 + MK_SC2; ++rs_)
    if (t0 + 7 >= 255) {
        bf16x8 af[4];
        { const int qq = r32 >> 2, hh = r32 & 3; const size_t row = (size_t)b * S + t0 + qq;
#pragma unroll
          for (int d0 = 0; d0 < 4; ++d0) af[d0] = *(const bf16x8*)(proj + row * LDP + C_QI + hh * 64 + 16 * d0 + 8 * hi); }
        float wv[16];
#pragma unroll
        for (int r = 0; r < 16; ++r) wv[r] = WI[((size_t)b * S + t0 + 2 * (r >> 2) + hi) * 4 + (r & 3)];
        const int nkt = (t0 + 8 + 31) / 32;
        const bf16_t* kbase = (const bf16_t*)(ws + WS_KI) + (size_t)(b * (S / 32)) * 2048 + lane * 8;
        bf16x8 kb0[4], kb1[4], kb2[4], kb3[4];
#define IDX_LOAD(B, kt_) do { const int k_ = ((kt_) < nkt) ? (kt_) : (nkt - 1); _Pragma("unroll") for (int d0 = 0; d0 < 4; ++d0) B[d0] = *(const bf16x8*)(kbase + (size_t)k_ * 2048 + d0 * 512); } while (0)
#define IDX_COMP(B, kt_) do { f32x16 c; _Pragma("unroll") for (int r = 0; r < 16; ++r) c[r] = 0.f; \
            _Pragma("unroll") for (int d0 = 0; d0 < 4; ++d0) c = __builtin_amdgcn_mfma_f32_32x32x16_bf16(af[d0], B[d0], c, 0, 0, 0); \
            const int key = (kt_) * 32 + r32; \
            _Pragma("unroll") for (int g4 = 0; g4 < 4; ++g4) { float s = 0.f; \
                _Pragma("unroll") for (int hh = 0; hh < 4; ++hh) s += fmaxf(c[4 * g4 + hh], 0.f) * wv[4 * g4 + hh]; \
                Ssc[(2 * g4 + hi) * IDX_SROW + key + (key >> 6)] = s; } } while (0)
#define IDX_FENCE() asm volatile("" ::: "memory")
        IDX_LOAD(kb0, wave); IDX_LOAD(kb1, wave + NWAVE); IDX_LOAD(kb2, wave + 2 * NWAVE); IDX_FENCE();
        for (int kt = wave; kt < nkt; kt += 4 * NWAVE) {
            IDX_LOAD(kb3, kt + 3 * NWAVE); IDX_FENCE(); IDX_COMP(kb0, kt); IDX_FENCE();
            if (kt + NWAVE >= nkt) break;
            IDX_LOAD(kb0, kt + 4 * NWAVE); IDX_FENCE(); IDX_COMP(kb1, kt + NWAVE); IDX_FENCE();
            if (kt + 2 * NWAVE >= nkt) break;
            IDX_LOAD(kb1, kt + 5 * NWAVE); IDX_FENCE(); IDX_COMP(kb2, kt + 2 * NWAVE); IDX_FENCE();
            if (kt + 3 * NWAVE >= nkt) break;
            IDX_LOAD(kb2, kt + 6 * NWAVE); IDX_FENCE(); IDX_COMP(kb3, kt + 3 * NWAVE); IDX_FENCE();
        }
#undef IDX_FENCE
#undef IDX_LOAD
#undef IDX_COMP
    }
    __syncthreads();
    for (int rr_ = 0; rr_ < 1 + MK_SEL2; ++rr_) {
        const int t = t0 + wave; u64 myw = 0ull;
#if MK_TPROBE
        unsigned long long ts0_ = __builtin_amdgcn_s_memtime(), ts1_ = ts0_, ts2_ = ts0_;
#endif
        if (t >= 255) {
            unsigned u[64];
            { const LAS float* srow = Ssc + wave * IDX_SROW + 65 * lane;
              const int jmax = t - 64 * lane;
#pragma unroll
              for (int j = 0; j < 64; ++j) { const unsigned bits = __float_as_uint(srow[j]);
                  const unsigned key = bits ^ ((unsigned)((int)bits >> 31) | 0x80000000u);
                  u[j] = (j > jmax) ? 0u : key; } }
            unsigned a32[32], a16[16], a8[8], a4[4];
#pragma unroll
            for (int i = 0; i < 32; ++i) a32[i] = max(u[2 * i], u[2 * i + 1]);
#pragma unroll
            for (int i = 0; i < 16; ++i) a16[i] = max(a32[2 * i], a32[2 * i + 1]);
#pragma unroll
            for (int i = 0; i < 8; ++i) a8[i] = max(a16[2 * i], a16[2 * i + 1]);
#pragma unroll
            for (int i = 0; i < 4; ++i) a4[i] = max(a8[2 * i], a8[2 * i + 1]);
            unsigned Mx = max(max(a4[0], a4[1]), max(a4[2], a4[3])), Lx = 0xffffffffu;
            { const int nfull = __builtin_amdgcn_readfirstlane((t + 1) >> 6); int nl;
              if (nfull >= 64) { nl = 64; Lx = min(min(a4[0], a4[1]), min(a4[2], a4[3])); }
              else if (nfull >= 32) { nl = 32;
#pragma unroll
                  for (int i = 0; i < 8; ++i) Lx = min(Lx, a8[i]); }
              else if (nfull >= 16) { nl = 16;
#pragma unroll
                  for (int i = 0; i < 16; ++i) Lx = min(Lx, a16[i]); }
              else if (nfull >= 8) { nl = 8;
#pragma unroll
                  for (int i = 0; i < 32; ++i) Lx = min(Lx, a32[i]); }
              else { nl = 4;
#pragma unroll
                  for (int j = 0; j < 64; ++j) Lx = min(Lx, u[j]); }
              if (lane >= nl) Lx = 0xffffffffu;
              Mx = wave_max_u32(Mx); Lx = wave_min_u32(Lx); }
            Mx = __builtin_amdgcn_readfirstlane(Mx); Lx = __builtin_amdgcn_readfirstlane(Lx);
#if MK_TPROBE
            asm volatile("s_waitcnt vmcnt(0) lgkmcnt(0)" ::: "memory"); ts1_ = __builtin_amdgcn_s_memtime();
#endif
#pragma unroll
            for (int j = 0; j < 64; ++j) u[j] = (u[j] >= Lx) ? (u[j] - Lx + 1u) : 0u;
            unsigned prefix = 0u; bool exact = false;
            for (int rb_ = 0; rb_ < 1 + MK_BIS2; ++rb_) { prefix = 0u; exact = false;
            for (int bit = 31 - __builtin_clz(Mx - Lx + 1u); bit >= 0; --bit) {
                const unsigned cand = prefix | (1u << bit); int c0 = 0, c1 = 0, c2 = 0, c3 = 0;
#define IDX_CNT8(j0) asm volatile( \
                    "v_cmp_le_u32 vcc, %10, %2\n\tv_addc_co_u32 %0, vcc, 0, %0, vcc\n\tv_cmp_le_u32 vcc, %10, %3\n\tv_addc_co_u32 %1, vcc, 0, %1, vcc\n\t" \
                    "v_cmp_le_u32 vcc, %10, %4\n\tv_addc_co_u32 %0, vcc, 0, %0, vcc\n\tv_cmp_le_u32 vcc, %10, %5\n\tv_addc_co_u32 %1, vcc, 0, %1, vcc\n\t" \
                    "v_cmp_le_u32 vcc, %10, %6\n\tv_addc_co_u32 %0, vcc, 0, %0, vcc\n\tv_cmp_le_u32 vcc, %10, %7\n\tv_addc_co_u32 %1, vcc, 0, %1, vcc\n\t" \
                    "v_cmp_le_u32 vcc, %10, %8\n\tv_addc_co_u32 %0, vcc, 0, %0, vcc\n\tv_cmp_le_u32 vcc, %10, %9\n\tv_addc_co_u32 %1, vcc, 0, %1, vcc" \
                    : "+v"(c0), "+v"(c1) \
                    : "v"(u[(j0)]), "v"(u[(j0) + 1]), "v"(u[(j0) + 2]), "v"(u[(j0) + 3]), "v"(u[(j0) + 4]), "v"(u[(j0) + 5]), "v"(u[(j0) + 6]), "v"(u[(j0) + 7]), "v"(candv) : "vcc")
                const unsigned candv = cand;
                IDX_CNT8(0); IDX_CNT8(8); IDX_CNT8(16); IDX_CNT8(24); IDX_CNT8(32); IDX_CNT8(40); IDX_CNT8(48); IDX_CNT8(56);
#undef IDX_CNT8
                c2 = 0; c3 = 0;
                const int cnt = wave_sum_dpp((c0 + c1) + (c2 + c3));
                if (cnt >= 256) prefix = cand;
                if (cnt == 256) { exact = true; break; }
            }
            }
#if MK_TPROBE
            asm volatile("s_waitcnt vmcnt(0) lgkmcnt(0)" ::: "memory"); ts2_ = __builtin_amdgcn_s_memtime();
#endif
            unsigned mlo = 0u, mhi = 0u;
            if (exact) {
#pragma unroll
                for (int j = 31; j >= 0; --j) asm volatile("v_cmp_le_u32 vcc, %4, %2\n\tv_addc_co_u32 %0, vcc, %0, %0, vcc\n\tv_cmp_le_u32 vcc, %4, %3\n\tv_addc_co_u32 %1, vcc, %1, %1, vcc"
                                                           : "+v"(mlo), "+v"(mhi) : "v"(u[j]), "v"(u[32 + j]), "v"(prefix) : "vcc");
            } else {
                int ngt = 0, nti = 0;
#pragma unroll
                for (int j = 0; j < 64; ++j) { ngt += (u[j] > prefix) ? 1 : 0; nti += (u[j] == prefix) ? 1 : 0; }
                const int need = 256 - (int)wave_sum((float)ngt);
                int incl = nti;
#pragma unroll
                for (int o = 1; o < 64; o <<= 1) { const int v = __shfl_up(incl, o); if (lane >= o) incl += v; }
                int running = incl - nti;
#pragma unroll
                for (int j = 0; j < 64; ++j) {
                    const bool tie = (u[j] == prefix);
                    const unsigned sel = ((u[j] > prefix) || (tie && running < need)) ? 1u : 0u;
                    running += tie ? 1 : 0;
                    if (j < 32) mlo |= sel << j; else mhi |= sel << (j - 32);
                }
            }
            myw = ((u64)mhi << 32) | mlo;
        } else {
            const int lo = 64 * lane;
            if (lo + 63 <= t) myw = ~0ull; else if (lo > t) myw = 0ull; else myw = (~0ull) >> (63 - (t - lo));
        }
        ((u64*)(ws + WS_MASK))[((size_t)b * S + t) * 64 + lane] = myw;
#if MK_TPROBE
        { asm volatile("s_waitcnt vmcnt(0) lgkmcnt(0)" ::: "memory"); const unsigned long long ts3_ = __builtin_amdgcn_s_memtime();
          if (blockIdx.x == 0 && wave == 0 && lane == 0 && t >= 255) { unsigned long long* TS = (unsigned long long*)(ws + WS_BAR + 65536);
              atomicAdd(TS + 0, ts1_ - ts0_); atomicAdd(TS + 1, ts2_ - ts1_); atomicAdd(TS + 2, ts3_ - ts2_); atomicAdd(TS + 3, ts3_ - ts0_); } }
#endif
    }
    __syncthreads();
}

DEVI void combineA_rows(const Params& P) {
    const int tid = tid_opaque(), lane = tid & 63, wave = tid >> 6;
    const int gw = blockIdx.x * NWAVE + wave, NGW = gridDim.x * NWAVE;
    unsigned char* ws = P.ws;
    const float d1 = wave_sum(P.in[17][lane] * P.in[18][lane]), d2 = wave_sum(P.in[19][lane] * P.in[20][lane]);
    const float lam_init = 0.2f, lam = expf(d1) - expf(d2) + lam_init;
    const bf16_t* o0 = (const bf16_t*)(ws + WS_XB); const bf16_t* o1 = o0 + (size_t)T * 512;
    const float* gs = P.in[21] + 8 * (lane & 15);
    for (int m = gw; m < T; m += NGW) {
        const u32x4 a = *(const u32x4*)(o0 + (size_t)m * 512 + 8 * lane), bq = *(const u32x4*)(o1 + (size_t)m * 512 + 8 * lane);
        float v[8]; float ss = 0.f;
#pragma unroll
        for (int j = 0; j < 4; ++j) { v[2 * j] = lo16(a[j]) - lam * lo16(bq[j]); v[2 * j + 1] = hi16(a[j]) - lam * hi16(bq[j]); ss += v[2 * j] * v[2 * j] + v[2 * j + 1] * v[2 * j + 1]; }
        ss = row16_sum(ss);
        const float rs = rsqrtf(ss * (1.f / 128.f) + EPS) * (1.f - lam_init);
        u32x4 w;
#pragma unroll
        for (int j = 0; j < 4; ++j) w[j] = cvtpk(v[2 * j] * rs * gs[2 * j], v[2 * j + 1] * rs * gs[2 * j + 1]);
        *(u32x4*)((bf16_t*)(ws + WS_Y) + (size_t)m * 1024 + 8 * lane) = w;
    }
}

template <int W>
DEVI void pool_item(const bf16_t* pr, bf16_t* y, int m, int c0) {
    const int t = m & (S - 1);
    u32x4 z[W];
#pragma unroll
    for (int dt = 0; dt < W; ++dt) z[dt] = *(const u32x4*)(pr + (size_t)(m - ((dt <= t) ? dt : t)) * 2048 + 1536 + c0);
    float sum[8];
#pragma unroll
    for (int j = 0; j < 8; ++j) sum[j] = 0.f;
#pragma unroll
    for (int dt = 0; dt < W; ++dt) { const float wgt = (dt <= t) ? 1.f : 0.f;
#pragma unroll
        for (int j = 0; j < 4; ++j) { sum[2 * j] += wgt * lo16(z[dt][j]); sum[2 * j + 1] += wgt * hi16(z[dt][j]); } }
    const float inv = 1.f / (float)((t + 1 < W) ? (t + 1) : W); u32x4 w;
#pragma unroll
    for (int j = 0; j < 4; ++j) w[j] = cvtpk(sum[2 * j] * inv - lo16(z[0][j]), sum[2 * j + 1] * inv - hi16(z[0][j]));
    *(u32x4*)(y + (size_t)m * 1024 + 512 + c0) = w;
}
DEVI void phase_mix1(const Params& P) {
    const int gt = blockIdx.x * NTHR + tid_opaque(), NGT = gridDim.x * NTHR;
    unsigned char* ws = P.ws;
    const bf16_t* pr = (const bf16_t*)(ws + WS_PROJ1);
    bf16_t* y = (bf16_t*)(ws + WS_Y);
    const float* cw = P.in[29];
    for (int it = gt; it < T * 64; it += NGT) {
        const int m = it >> 6, c0 = 8 * (it & 63), t = m & (S - 1);
        u32x4 gc[3], hc[3];
#pragma unroll
        for (int dt = 0; dt < 3; ++dt) { const size_t r = (size_t)(m - ((dt <= t) ? dt : t)) * 2048; gc[dt] = *(const u32x4*)(pr + r + 512 + c0); hc[dt] = *(const u32x4*)(pr + r + 1024 + c0); }
        const u32x4 gb = *(const u32x4*)(pr + (size_t)m * 2048 + c0);
        float wgt[3][8];
#pragma unroll
        for (int dt = 0; dt < 3; ++dt) { float tmp[8]; load8(tmp, cw + (2 - dt) * 512 + c0); const float on = (dt <= t) ? 1.f : 0.f;
#pragma unroll
            for (int j = 0; j < 8; ++j) wgt[dt][j] = tmp[j] * on; }
        u32x4 w;
#pragma unroll
        for (int j = 0; j < 4; ++j) { float a = 0.f, b = 0.f;
#pragma unroll
            for (int dt = 0; dt < 3; ++dt) { a += wgt[dt][2 * j] * (lo16(gc[dt][j]) * lo16(hc[dt][j])); b += wgt[dt][2 * j + 1] * (hi16(gc[dt][j]) * hi16(hc[dt][j])); }
            w[j] = cvtpk(lo16(gb[j]) * a, hi16(gb[j]) * b); }
        *(u32x4*)(y + (size_t)m * 1024 + c0) = w;
    }
    for (int it = gt; it < T * 16; it += NGT) { const int m = it >> 4, cj = 8 * (it & 15);
        pool_item<2>(pr, y, m, cj); pool_item<4>(pr, y, m, 128 + cj); asm volatile("" ::: "memory"); pool_item<8>(pr, y, m, 256 + cj); asm volatile("" ::: "memory"); pool_item<16>(pr, y, m, 384 + cj); asm volatile("" ::: "memory"); }
}

DEVI float sum_rows4(float s) {
    const auto a = __builtin_amdgcn_permlane16_swap(__float_as_uint(s), __float_as_uint(s), false, false);
    const float s2 = __uint_as_float(a[0]) + __uint_as_float(a[1]);
    const auto b = __builtin_amdgcn_permlane32_swap(__float_as_uint(s2), __float_as_uint(s2), false, false);
    return __uint_as_float(b[0]) + __uint_as_float(b[1]);
}
namespace pg8 {
#define PG8_LAS __attribute__((address_space(3)))
typedef unsigned short bf16_t;
typedef short bf16x8 __attribute__((ext_vector_type(8)));
typedef float f32x4 __attribute__((ext_vector_type(4)));
typedef unsigned u32x4 __attribute__((ext_vector_type(4)));
constexpr int BM = 256, BK = 64, HALF = 128, HTB = HALF * BK * 2  , STAGE_BYTES = 8 * HTB, NXCD = 8, WGM = 8;

__host__ __device__ __forceinline__ int lds_byte(int r, int c) { const int st = (r >> 4) * 2 + (c >> 5), rr = r & 15, cc = c & 31, ob = rr * 64 + cc * 2; return st * 1024 + (ob ^ (((ob >> 9) & 1) << 5)); }
__host__ __device__ __forceinline__ void stage_rc(int b, int& R, int& C) { const int st = b / 1024, sb = b % 1024, swz = sb ^ (((sb >> 9) & 1) << 5); R = (st >> 1) * 16 + swz / 64; C = (st & 1) * 32 + (swz % 64) / 2; }
__host__ __device__ __forceinline__ int perm32(int rho) { const int n = rho >> 4, i = rho & 15; return 8 * (i >> 2) + 4 * n + (i & 3); }

struct Unit { int pm, pn; };
struct Gemm { const bf16_t* A; int lda; const bf16_t* Bt; int M, N, K; };

struct StaticOrder {
    int nM, nN, nwg, G, c;
    __host__ __device__ void init(int M, int N, int G_, int c_) { nM = M / BM; nN = N / BM; nwg = nM * nN; G = G_; c = c_; }
    __host__ __device__ bool next(int i, Unit& u) const {
        const long L = (long)i * G + c; if (L >= nwg) return false;
        int wgid = (int)L; { const int q = nwg / NXCD, r = nwg % NXCD, xcd = wgid % NXCD, off = wgid / NXCD; wgid = (xcd < r ? xcd * (q + 1) : r * (q + 1) + (xcd - r) * q) + off; }
        const int nig = WGM * nN, gid = wgid / nig, fm = gid * WGM, gsz = (nM - fm) < WGM ? (nM - fm) : WGM;
        u.pm = fm + ((wgid % nig) % gsz); u.pn = (wgid % nig) / gsz; return true;
    }
    __device__ __forceinline__ void a_ready(const Unit&) const {}
    __device__ __forceinline__ void done(const Unit&) const {}
};
template <class Epi, class Sched, bool ALIGN_EPI = false, bool SP2 = false>
__device__ __forceinline__ void gemm_phase(PG8_LAS unsigned char* lds, const Gemm g, const Sched& S, const Epi& E) {
    const int tid = tid_opaque(), wid = __builtin_amdgcn_readfirstlane(tid >> 6), lane = tid & 63, wr = wid >> 2, wc = wid & 3, fr = lane & 15, fq = lane >> 4;
    const int K = g.K, nt = K / BK;
    unsigned voffA[2], voffB[2];
#pragma unroll
    for (int i = 0; i < 2; ++i) { int R, C; stage_rc(tid * 16 + i * 8192, R, C); const int Rb = Epi::PERM ? ((R & ~31) + perm32(R & 31)) : R;
        voffA[i] = (unsigned)(R * g.lda + C) * 2u; voffB[i] = (unsigned)(Rb * K + C) * 2u; }
    const size_t kstep = (size_t)(BK * 2);
    const size_t hstepA = (size_t)HALF * g.lda * 2, hstepB = (size_t)HALF * K * 2;
    const size_t tstepA = 2 * hstepA, tstepB = 2 * hstepB;
    const unsigned ldsw = (unsigned)wid * 1024u;
    const int aoff = lds_byte(wr * 64 + fr, fq * 8), boff = lds_byte(wc * 32 + fr, fq * 8);
#define PG8_SA(b, h) (((b) * 2 + (h)) * HTB)
#define PG8_SB(b, h) ((4 + (b) * 2 + (h)) * HTB)
#define PG8_STAGE(bufoff, gbase, voff) do { _Pragma("unroll") for (int _i = 0; _i < 2; ++_i) \
        __builtin_amdgcn_global_load_lds((const unsigned*)((const char*)(gbase) + (voff)[_i]), (PG8_LAS unsigned*)(lds + (bufoff) + ldsw + _i * 8192), 16, 0, 0); } while (0)
#define PG8_LDA(dst, b, h) do { _Pragma("unroll") for (int m = 0; m < 4; ++m) _Pragma("unroll") for (int k = 0; k < 2; ++k) dst[m][k] = *(const PG8_LAS bf16x8*)(lds + PG8_SA(b, h) + aoff + m * 2048 + k * 1024); } while (0)
#define PG8_LDB(dst, b, h) do { _Pragma("unroll") for (int n = 0; n < 2; ++n) _Pragma("unroll") for (int k = 0; k < 2; ++k) dst[n][k] = *(const PG8_LAS bf16x8*)(lds + PG8_SB(b, h) + boff + n * 2048 + k * 1024); } while (0)
#define PG8_MMA(ai, bj, At, Bt) do { __builtin_amdgcn_s_setprio(1); _Pragma("unroll") for (int m = 0; m < 4; ++m) _Pragma("unroll") for (int n = 0; n < 2; ++n) _Pragma("unroll") for (int k = 0; k < 2; ++k) \
        acc[ai][bj][m][n] = __builtin_amdgcn_mfma_f32_16x16x32_bf16(Bt[n][k], At[m][k], acc[ai][bj][m][n], 0, 0, 0); __builtin_amdgcn_s_setprio(0); } while (0)
#define PG8_WAIT_V(n) asm volatile("s_waitcnt vmcnt(" #n ")" ::: "memory")
#define PG8_WAIT_L(n) asm volatile("s_waitcnt lgkmcnt(" #n ")" ::: "memory")
#define PG8_BAR __builtin_amdgcn_s_barrier()
#define PG8_SCHED __builtin_amdgcn_sched_barrier(0)
    Unit cur, nxt; int ui = 0;
    if (!S.next(0, cur)) return;
    f32x4 acc[2][2][4][2];
#pragma unroll
    for (int a = 0; a < 2; ++a)
#pragma unroll
        for (int b = 0; b < 2; ++b)
#pragma unroll
            for (int m = 0; m < 4; ++m)
#pragma unroll
                for (int n = 0; n < 2; ++n) acc[a][b][m][n] = (f32x4){0.f, 0.f, 0.f, 0.f};
    bf16x8 At[4][2], B0[2][2], B1[2][2];
    const char* cA = (const char*)g.A + (size_t)cur.pm * tstepA; const char* cB = (const char*)g.Bt + (size_t)cur.pn * tstepB;
    S.a_ready(cur);
    if constexpr (SP2) {
        PG8_STAGE(PG8_SB(0, 0), cB, voffB); PG8_STAGE(PG8_SB(0, 1), cB + hstepB, voffB); PG8_STAGE(PG8_SA(0, 0), cA, voffA); PG8_STAGE(PG8_SA(0, 1), cA + hstepA, voffA);
        if (wr == 1) PG8_BAR;
        PG8_WAIT_V(2); PG8_BAR;
        PG8_STAGE(PG8_SB(1, 0), cB + kstep, voffB); PG8_STAGE(PG8_SA(1, 0), cA + kstep, voffA); PG8_STAGE(PG8_SB(1, 1), cB + hstepB + kstep, voffB);
        PG8_WAIT_V(6); PG8_BAR;
    } else {
        PG8_STAGE(PG8_SB(0, 0), cB, voffB); PG8_STAGE(PG8_SA(0, 0), cA, voffA); PG8_STAGE(PG8_SB(0, 1), cB + hstepB, voffB); PG8_STAGE(PG8_SA(0, 1), cA + hstepA, voffA);
        if (wr == 1) PG8_BAR;
        PG8_WAIT_V(4); PG8_BAR;
        PG8_STAGE(PG8_SB(1, 0), cB + kstep, voffB); PG8_STAGE(PG8_SA(1, 0), cA + kstep, voffA); PG8_STAGE(PG8_SB(1, 1), cB + hstepB + kstep, voffB);
        PG8_WAIT_V(6); PG8_BAR;
    }
    for (;;) {
        const bool has_next = S.next(ui + 1, nxt);
        const char* nA = has_next ? (const char*)g.A + (size_t)nxt.pm * tstepA : cA; const char* nB = has_next ? (const char*)g.Bt + (size_t)nxt.pn * tstepB : cB;
        for (int t = 0; t < nt; t += 2) {
            const bool last = (t == nt - 2);
            const char* a1 = cA + (size_t)(t + 1) * kstep;
            const char* a2 = last ? nA : cA + (size_t)(t + 2) * kstep; const char* b2 = last ? nB : cB + (size_t)(t + 2) * kstep;
            const char* a3 = a2 + kstep; const char* b3 = b2 + kstep;
            if (last && has_next) S.a_ready(nxt);
            if constexpr (SP2) {
            PG8_LDB(B0, 0, 0); PG8_LDB(B1, 0, 1); PG8_SCHED; PG8_LDA(At, 0, 0); PG8_STAGE(PG8_SA(1, 1), a1 + hstepA, voffA);
            PG8_WAIT_V(8); PG8_WAIT_L(0); PG8_BAR; PG8_MMA(0, 0, At, B0); PG8_MMA(0, 1, At, B1); PG8_BAR; PG8_SCHED;
            PG8_LDA(At, 0, 1); PG8_STAGE(PG8_SB(0, 0), b2, voffB); PG8_STAGE(PG8_SB(0, 1), b2 + hstepB, voffB); PG8_STAGE(PG8_SA(0, 0), a2, voffA);
            PG8_WAIT_V(8); PG8_WAIT_L(0); PG8_BAR; PG8_MMA(1, 0, At, B0); PG8_MMA(1, 1, At, B1); PG8_BAR; PG8_SCHED;
            PG8_LDB(B0, 1, 0); PG8_LDB(B1, 1, 1); PG8_SCHED; PG8_LDA(At, 1, 0); PG8_STAGE(PG8_SA(0, 1), a2 + hstepA, voffA);
            PG8_WAIT_V(8); PG8_WAIT_L(0); PG8_BAR; PG8_MMA(0, 0, At, B0); PG8_MMA(0, 1, At, B1); PG8_BAR; PG8_SCHED;
            PG8_LDA(At, 1, 1); PG8_STAGE(PG8_SB(1, 0), b3, voffB); PG8_STAGE(PG8_SB(1, 1), b3 + hstepB, voffB); PG8_STAGE(PG8_SA(1, 0), a3, voffA);
            PG8_WAIT_V(8); PG8_WAIT_L(0); PG8_BAR; PG8_MMA(1, 0, At, B0); PG8_MMA(1, 1, At, B1); PG8_BAR; PG8_SCHED;
            } else {
            PG8_LDB(B0, 0, 0); PG8_SCHED; PG8_LDA(At, 0, 0); PG8_STAGE(PG8_SA(1, 1), a1 + hstepA, voffA);
            PG8_WAIT_L(8); PG8_BAR; PG8_WAIT_L(0); PG8_MMA(0, 0, At, B0); PG8_BAR; PG8_SCHED;
            PG8_LDB(B1, 0, 1); PG8_STAGE(PG8_SB(0, 0), b2, voffB);
            PG8_BAR; PG8_WAIT_L(0); PG8_MMA(0, 1, At, B1); PG8_BAR;
            PG8_LDA(At, 0, 1); PG8_STAGE(PG8_SA(0, 0), a2, voffA);
            PG8_BAR; PG8_WAIT_L(0); PG8_MMA(1, 0, At, B0); PG8_BAR; PG8_SCHED;
            PG8_STAGE(PG8_SB(0, 1), b2 + hstepB, voffB);
            PG8_WAIT_V(6); PG8_BAR; PG8_MMA(1, 1, At, B1); PG8_BAR;
            PG8_LDB(B0, 1, 0); PG8_SCHED; PG8_LDA(At, 1, 0); PG8_STAGE(PG8_SA(0, 1), a2 + hstepA, voffA);
            PG8_WAIT_L(8); PG8_BAR; PG8_WAIT_L(0); PG8_MMA(0, 0, At, B0); PG8_BAR; PG8_SCHED;
            PG8_LDB(B1, 1, 1); PG8_STAGE(PG8_SB(1, 0), b3, voffB);
            PG8_BAR; PG8_WAIT_L(0); PG8_MMA(0, 1, At, B1); PG8_BAR;
            PG8_LDA(At, 1, 1); PG8_STAGE(PG8_SA(1, 0), a3, voffA);
            PG8_BAR; PG8_WAIT_L(0); PG8_MMA(1, 0, At, B0); PG8_BAR; PG8_SCHED;
            PG8_STAGE(PG8_SB(1, 1), b3 + hstepB, voffB);
            PG8_WAIT_V(6); PG8_BAR; PG8_MMA(1, 1, At, B1); PG8_BAR;
            }
        }
        if constexpr (ALIGN_EPI) { if (wr == 0) PG8_BAR; }
        if constexpr (!Epi::AFTER_DRAIN) { E(acc, cur, wr, wc, fr, fq); S.done(cur); }
        if (!has_next) break;
#pragma unroll
        for (int a = 0; a < 2; ++a)
#pragma unroll
            for (int b = 0; b < 2; ++b)
#pragma unroll
                for (int m = 0; m < 4; ++m)
#pragma unroll
                    for (int n = 0; n < 2; ++n) acc[a][b][m][n] = (f32x4){0.f, 0.f, 0.f, 0.f};
        cur = nxt; cA = nA; cB = nB; ++ui;
        if constexpr (ALIGN_EPI) { if (wr == 1) PG8_BAR; }
    }
    PG8_WAIT_V(0);
    if constexpr (!ALIGN_EPI) { if (wr == 0) PG8_BAR; }
    PG8_BAR;
    if constexpr (Epi::AFTER_DRAIN) { E.fused(acc, cur, wr, wc, fr, fq, lds, wid, lane); S.done(cur); }
#undef PG8_SA
#undef PG8_SB
#undef PG8_STAGE
#undef PG8_LDA
#undef PG8_LDB
#undef PG8_MMA
#undef PG8_WAIT_V
#undef PG8_WAIT_L
#undef PG8_BAR
#undef PG8_SCHED
}
}

namespace pg8 {
struct EpiScale {
    static constexpr bool PERM = true, AFTER_DRAIN = false;
    bf16_t* O; int ldo; const float* ssq; float inv_n; int act;
    __device__ __forceinline__ void operator()(const f32x4 (&acc)[2][2][4][2], const Unit& u, int wr, int wc, int fr, int fq) const {
        const int row0 = u.pm * BM + wr * 64 + fr, col0 = u.pn * BM + wc * 32 + 8 * fq;
#pragma unroll
        for (int ai = 0; ai < 2; ++ai)
#pragma unroll
            for (int m = 0; m < 4; ++m) {
                const int row = row0 + ai * HALF + m * 16;
                const float rs = ssq ? rsqrtf(ssq[row] * inv_n + 1e-6f) : 1.f;
                bf16_t* rowp = O + (size_t)row * ldo + col0;
#pragma unroll
                for (int bj = 0; bj < 2; ++bj) {
                    f32x4 v0 = acc[ai][bj][m][0] * rs, v1 = acc[ai][bj][m][1] * rs;
                    if (act == 1) {
#pragma unroll
                        for (int j = 0; j < 4; ++j) { const float a = fmaxf(v0[j], 0.f), b = fmaxf(v1[j], 0.f); v0[j] = a * a; v1[j] = b * b; }
                    }
                    u32x4 w; w.x = ::cvtpk(v0[0], v0[1]); w.y = ::cvtpk(v0[2], v0[3]); w.z = ::cvtpk(v1[0], v1[1]); w.w = ::cvtpk(v1[2], v1[3]);
                    *(u32x4*)(rowp + bj * HALF) = w;
                }
            }
    }
};
struct EpiHead {
    static constexpr bool PERM = true, AFTER_DRAIN = false;
    int kind; bf16_t* O; int ldo; const float* ssq; float inv_n; const float* cs;
    const float *g0, *g1, *g2, *g3; float* ssq_ckv; float* WI; bf16_t* KI; PG8_LAS float* X;
    __device__ __forceinline__ void operator()(f32x4 (&acc)[2][2][4][2], const Unit& u, int wr, int wc, int fr, int fq) const {
        asm volatile("" : "+v"(fr), "+v"(fq));
        asm volatile("" : "+s"(wr), "+s"(wc));
        const int wave = wr * 4 + wc, pn = u.pn;
        int gt = 0; bool rope = false; float scale = 1.f; const float* g = nullptr;
        if (kind == 0) {
            if (pn < 2) { gt = 1; rope = true; scale = 0.125f * 1.4426950408889634f; g = g0; }
            else if (pn < 4) { gt = 1; rope = true; g = g1; }
            else if (pn < 6) { gt = 0; }
            else if (pn < 8) { gt = 1; rope = true; scale = 0.125f * 1.4426950408889634f; g = g2; }
            else if (pn == 8) { gt = 3; }
            else if (pn == 9) { gt = 4; rope = true; }
            else { gt = 1; rope = true; g = g3; }
        } else if (kind == 1) { if (pn < 2) { gt = 1; rope = true; g = g0; } }
        else { if ((pn & 3) < 2) { gt = 2; g = g0 + (pn >> 2) * 128; } }
        const int row0 = u.pm * BM + wr * 64 + fr, col0 = pn * BM + wc * 32 + 8 * fq;
        PG8_LAS float* CSL = X + 2048;
        if (rope) {
            const int tid_ = (wave * 4 + fq) * 16 + fr; f32x4 t_[2];
#pragma unroll
            for (int i = 0; i < 2; ++i) { const int idx = tid_ + 512 * i; t_[i] = *(const f32x4*)(cs + (size_t)(u.pm * BM + (idx >> 2)) * 16 + 4 * (idx & 3)); }
#pragma unroll
            for (int i = 0; i < 2; ++i) { const int idx = tid_ + 512 * i; *(PG8_LAS f32x4*)(CSL + (idx >> 2) * 20 + 4 * (idx & 3)) = t_[i]; }
        }
        float rsv[8];
#pragma unroll
        for (int i = 0; i < 8; ++i) rsv[i] = ssq[row0 + (i >> 2) * HALF + (i & 3) * 16];
#pragma unroll
        for (int i = 0; i < 8; ++i) rsv[i] = rsqrtf(rsv[i] * inv_n + 1e-6f);
        float gv[8];
        { const int db = (gt == 2) ? (32 * wc + 8 * fq) : (32 * (wc & 1) + 8 * fq);
#pragma unroll
          for (int j = 0; j < 8; ++j) gv[j] = g ? g[db + j] : 1.f; }
#pragma unroll
        for (int ai = 0; ai < 2; ++ai)
#pragma unroll
            for (int m = 0; m < 4; ++m) {
                const float rs = rsv[ai * 4 + m];
#pragma unroll
                for (int bj = 0; bj < 2; ++bj) {
                    acc[ai][bj][m][0] *= rs; acc[ai][bj][m][1] *= rs;
                    const f32x4 a = acc[ai][bj][m][0], b = acc[ai][bj][m][1];
                    float s = (a[0] * a[0] + a[1] * a[1]) + (a[2] * a[2] + a[3] * a[3]) + (b[0] * b[0] + b[1] * b[1]) + (b[2] * b[2] + b[3] * b[3]);
                    s = ::sum_rows4(s);
                    if (fq == 0) X[(((wave * 2 + ai) * 4 + m) * 2 + bj) * 16 + fr] = s;
                }
            }
        asm volatile("s_waitcnt lgkmcnt(0)\n\ts_barrier" ::: "memory");
#pragma unroll
        for (int ai = 0; ai < 2; ++ai)
#pragma unroll
            for (int m = 0; m < 4; ++m) {
                const int row = row0 + ai * HALF + m * 16;
                float cs16[16];
                if (rope) { const PG8_LAS float* c = CSL + (ai * HALF + wr * 64 + m * 16 + fr) * 20;
#pragma unroll
                    for (int q = 0; q < 4; ++q) { const f32x4 t = *(const PG8_LAS f32x4*)(c + 4 * q); cs16[4 * q] = t[0]; cs16[4 * q + 1] = t[1]; cs16[4 * q + 2] = t[2]; cs16[4 * q + 3] = t[3]; }
#pragma unroll
                    for (int j = 0; j < 8; ++j) { const float cj = cs16[j], sj = cs16[8 + j];
                        cs16[j] = (fq == 0) ? cj : (fq == 1) ? sj : (fq == 2) ? 1.f : 0.f; cs16[8 + j] = (fq == 0) ? -sj : (fq == 1) ? cj : (fq == 2) ? 0.f : 1.f; } }
                float rowtot = 0.f;
#pragma unroll
                for (int bj = 0; bj < 2; ++bj) {
                    float v[8];
#pragma unroll
                    for (int j = 0; j < 4; ++j) { v[j] = acc[ai][bj][m][0][j]; v[4 + j] = acc[ai][bj][m][1][j]; }
#define XAT(w_) X[((((w_) * 2 + ai) * 4 + m) * 2 + bj) * 16 + fr]
                    if (gt == 1) {
                        const float tot = XAT(wave) + XAT(wave ^ 1), r2 = rsqrtf(tot * (1.f / 64.f) + 1e-6f);
#pragma unroll
                        for (int j = 0; j < 8; ++j) v[j] = v[j] * r2 * gv[j];
                    } else if (gt == 2) {
                        const int w0 = wave & 4; const float tot = (XAT(w0) + XAT(w0 + 1)) + (XAT(w0 + 2) + XAT(w0 + 3)), r2 = rsqrtf(tot * (1.f / 128.f) + 1e-6f);
#pragma unroll
                        for (int j = 0; j < 8; ++j) v[j] = v[j] * r2 * gv[j];
                    } else if (gt == 3) {
                        const int w0 = wave & 4; rowtot += (XAT(w0) + XAT(w0 + 1)) + (XAT(w0 + 2) + XAT(w0 + 3));
                    }
#undef XAT
                    if (rope && (wc & 1) == 0) {
#pragma unroll
                        for (int j = 0; j < 8; ++j) { const auto r = __builtin_amdgcn_permlane16_swap(__float_as_uint(v[j]), __float_as_uint(v[j]), false, false);
                            v[j] = __uint_as_float(r[0]) * cs16[j] + __uint_as_float(r[1]) * cs16[8 + j]; }
                    }
                    u32x4 w; w.x = ::cvtpk(v[0] * scale, v[1] * scale); w.y = ::cvtpk(v[2] * scale, v[3] * scale); w.z = ::cvtpk(v[4] * scale, v[5] * scale); w.w = ::cvtpk(v[6] * scale, v[7] * scale);
                    if (kind == 0 && pn == 10) {
                        if (bj == 0 && wc < 2) { const int c = 4 * wc + fq;
                            *(u32x4*)(KI + (size_t)(row >> 5) * 2048 + (c >> 1) * 512 + (((c & 1) * 32 + (row & 31)) * 8)) = w; }
                        if (bj == 0 && wc == 2 && fq == 0) *(f32x4*)(WI + (size_t)row * 4) = acc[ai][0][m][0] * (1.f / 16.f);
                    } else {
                        *(u32x4*)(O + (size_t)row * ldo + col0 + bj * HALF) = w;
                    }
                }
                if (gt == 3 && wc == 0 && fq == 0) ssq_ckv[row] = rowtot;
            }
    }
};
struct EpiResid {
    static constexpr bool PERM = true, AFTER_DRAIN = false;
    const float* basef; float* outf; bf16_t* xb; float* ssq_next; int dry;
    __device__ __forceinline__ void operator()(const f32x4 (&acc)[2][2][4][2], const Unit& u, int wr, int wc, int fr, int fq) const {
        const int col0 = u.pn * BM + wc * 32 + 8 * fq;
#pragma unroll
        for (int ai = 0; ai < 2; ++ai)
#pragma unroll
            for (int m = 0; m < 4; ++m) {
                const int row = u.pm * BM + ai * HALF + wr * 64 + m * 16 + fr; const size_t off = (size_t)row * 1024 + col0; float s = 0.f;
#pragma unroll
                for (int bj = 0; bj < 2; ++bj) {
                    const size_t idx = off + bj * HALF;
                    f32x4 x0, x1;
                    if (basef) { x0 = *(const f32x4*)(basef + idx); x1 = *(const f32x4*)(basef + idx + 4); }
                    else { const u32x4 b = *(const u32x4*)(xb + idx); x0 = (f32x4){::lo16(b.x), ::hi16(b.x), ::lo16(b.y), ::hi16(b.y)}; x1 = (f32x4){::lo16(b.z), ::hi16(b.z), ::lo16(b.w), ::hi16(b.w)}; }
                    x0 += acc[ai][bj][m][0]; x1 += acc[ai][bj][m][1];
                    s += (x0[0] * x0[0] + x0[1] * x0[1]) + (x0[2] * x0[2] + x0[3] * x0[3]) + (x1[0] * x1[0] + x1[1] * x1[1]) + (x1[2] * x1[2] + x1[3] * x1[3]);
                    if (outf && !dry) { *(f32x4*)(outf + idx) = x0; *(f32x4*)(outf + idx + 4) = x1; }
                    if (xb && !outf && !dry) { u32x4 w; w.x = ::cvtpk(x0[0], x0[1]); w.y = ::cvtpk(x0[2], x0[3]); w.z = ::cvtpk(x1[0], x1[1]); w.w = ::cvtpk(x1[2], x1[3]); *(u32x4*)(xb + idx) = w; }
                    if (dry) asm volatile("" :: "v"(x0), "v"(x1));
                }
                if (ssq_next && !dry) { s = ::sum_rows4(s); if (fq == 0) atomicAdd(ssq_next + row, s); }
            }
    }
};
}

#define XB_TMO      128
#define XB_XCNT(j)  (256  + 64 * (j))
#define XB_XSUB(j)  (1280 + 64 * (j))
#define XB_XGEN(j)  (2304 + 64 * (j))
#define XB_TOP      3328
#define XB_TOPGEN   3392
#define XCD_BAR_WORDS 3456
#define XB_SPIN_CAP (1u << 18)

__device__ __forceinline__ unsigned xb_ld(unsigned* p)              { return __hip_atomic_load(p, __ATOMIC_RELAXED, __HIP_MEMORY_SCOPE_AGENT); }
__device__ __forceinline__ unsigned xb_add(unsigned* p, unsigned v) { return __hip_atomic_fetch_add(p, v, __ATOMIC_RELAXED, __HIP_MEMORY_SCOPE_AGENT); }
__device__ __forceinline__ unsigned xb_xcc_id() { return (unsigned)__builtin_amdgcn_s_getreg((3 << 11) | 20) & 0xFu; }
#define XB_SPIN(cond, bar) do { unsigned _sp = 0; while (cond) { __builtin_amdgcn_s_sleep(1); \
    if ((++_sp & 255u) == 0u) { if (xb_ld(&(bar)[XB_TMO])) break; if (_sp > XB_SPIN_CAP) { atomicAdd(&(bar)[XB_TMO], 1u); break; } } } } while (0)

struct XcdBarrier {
    unsigned* bar; unsigned x;
    volatile LAS unsigned* st;
};

__device__ __forceinline__ XcdBarrier xcd_barrier_post(unsigned* bar, volatile LAS unsigned* st) {
    XcdBarrier b; b.bar = bar; b.x = xb_xcc_id(); b.st = st;
    if (threadIdx.x == 0) (void)xb_add(&bar[XB_XCNT(b.x)], 1u);
    return b;
}
__device__ __forceinline__ void xcd_barrier_complete(unsigned* bar, unsigned x, unsigned& nloc, unsigned& nx) {
    const unsigned G = gridDim.x * gridDim.y * gridDim.z;
    unsigned sum, cnt, mine, sp = 0u;
    for (;;) {
        sum = 0u; cnt = 0u; mine = 0u;
#pragma unroll
        for (unsigned j = 0; j < 16; ++j) { const unsigned c = xb_ld(&bar[XB_XCNT(j)]); sum += c; cnt += (c > 0u) ? 1u : 0u; mine = (j == x) ? c : mine; }
        if (sum == G) break;
        __builtin_amdgcn_s_sleep(1);
        if ((++sp & 255u) == 0u) { if (xb_ld(&bar[XB_TMO])) break; if (sp > XB_SPIN_CAP) { atomicAdd(&bar[XB_TMO], 1u); break; } }
    }
    nloc = mine > 0u ? mine : 1u; nx = cnt > 0u ? cnt : 1u;
}

__device__ __forceinline__ void xcd_barrier(const XcdBarrier& b) {
    asm volatile("s_waitcnt vmcnt(0)" ::: "memory");
    __syncthreads();
    if (threadIdx.x == 0) {
        unsigned* bar = b.bar;
        __builtin_amdgcn_s_waitcnt(0);
        unsigned nloc = b.st[0], nx = b.st[1];
        if (nloc == 0u) { xcd_barrier_complete(bar, b.x, nloc, nx); b.st[0] = nloc; b.st[1] = nx; }
        const unsigned old = xb_add(&bar[XB_XSUB(b.x)], 1u);
        const unsigned gen = old / nloc;
        if (old + 1u == (gen + 1u) * nloc) {
            __builtin_amdgcn_fence(__ATOMIC_RELEASE, "agent");
            asm volatile("s_waitcnt vmcnt(0)" ::: "memory");
            const unsigned og = xb_add(&bar[XB_TOP], 1u);
            const unsigned tg = og / nx;
            if (og + 1u == (tg + 1u) * nx) xb_add(&bar[XB_TOPGEN], 1u);
            else XB_SPIN(xb_ld(&bar[XB_TOPGEN]) == tg, bar);
            __builtin_amdgcn_fence(__ATOMIC_ACQUIRE, "agent");
            xb_add(&bar[XB_XGEN(b.x)], 1u);
            asm volatile("s_waitcnt vmcnt(0)" ::: "memory");
        } else {
            XB_SPIN(xb_ld(&bar[XB_XGEN(b.x)]) == gen, bar);
            __builtin_amdgcn_fence(__ATOMIC_ACQUIRE, "agent");
            asm volatile("s_waitcnt vmcnt(0)" ::: "memory");
        }
    }
    __syncthreads();
}
constexpr int NPHASE = 22;
constexpr int MISC_OFF = LDS_BYTES - 256;
#ifndef MK_REP_N
#define MK_REP_N 0
#define MK_REP_LO 0
#define MK_REP_HI -1
#endif
#ifndef MK_XPH
#define MK_XPH -1
#define MK_XN 0
#endif
#ifndef MK_SUB
#define MK_SUB 0
#endif
#ifndef MK_IDX2
#define MK_IDX2 0
#endif
#ifndef MK_CGSYNC
#define MK_CGSYNC 0
#endif
template <class Epi, bool ALIGN>
DEVI void run_gemm(LAS unsigned char* lds, const bf16_t* A, int lda, const bf16_t* Bt, int M, int N, int K, const Epi& E, int cu_off = 0) {
    const int Gd = (int)gridDim.x; int cu = (int)blockIdx.x - cu_off; if (cu < 0) cu += Gd;
    pg8::Gemm g{A, lda, Bt, M, N, K}; pg8::StaticOrder So; So.init(M, N, Gd, cu);
    pg8::gemm_phase<Epi, pg8::StaticOrder, ALIGN, true>(lds, g, So, E);
}
template <bool DRYK>
__global__ void __launch_bounds__(NTHR, 2) mega(Params P, int ph_lo, int ph_hi) {
    extern __shared__ __attribute__((aligned(16))) unsigned char lds_raw[];
    LAS unsigned char* lds = (LAS unsigned char*)lds_raw;
    cg::grid_group grid = cg::this_grid();
    { volatile LAS unsigned* MISC0 = (volatile LAS unsigned*)(lds + MISC_OFF);
      if (threadIdx.x < 32) MISC0[threadIdx.x] = 0u;
      __syncthreads();
      if (ph_hi - ph_lo > 1) (void)xcd_barrier_post((unsigned*)(P.ws + WS_BAR), MISC0 + 8); }
#define PH_LOCALS unsigned char* ws = P.ws; asm volatile("" : "+s"(ws)); float* ssq = (float*)(ws + WS_SSQ); bf16_t* XB = (bf16_t*)(ws + WS_XB); bf16_t* Y = (bf16_t*)(ws + WS_Y); const int G = gridDim.x, bx = blockIdx.x; (void)ssq; (void)XB; (void)Y; (void)G; (void)bx;
#define SEAM_XCD() do { XcdBarrier b_; b_.bar = (unsigned*)(P.ws + WS_BAR); b_.x = xb_xcc_id(); b_.st = (volatile LAS unsigned*)(lds + MISC_OFF) + 8; xcd_barrier(b_); } while (0)
#define PH_REPS(k) (((k) >= MK_REP_LO && (k) <= MK_REP_HI && (k) != 2 && (k) != 4) ? 1 + MK_REP_N : 1)
#define PH_BEGIN(k) if (ph_lo <= (k) && (k) < ph_hi) { PH_LOCALS for (int rep = 0; rep < PH_REPS(k); ++rep) { const int dry = (rep > 0) || DRYK; (void)dry; if (rep > 0) SEAM_XCD();
#define PH_END(k) } if ((k) + 1 < ph_hi) { if (MK_CGSYNC || (k) == 0) grid.sync(); else SEAM_XCD(); } }
#define DRYOUT (dry ? (float*)(ws + WS_Y) : P.out)
    using pg8::EpiScale; using pg8::EpiResid; using pg8::EpiHead;
    PH_BEGIN(0) phase_prologue(P, lds, dry); PH_END(0)
    PH_BEGIN(1)
#if MK_FUSE & 1
        run_gemm<EpiHead, true>(lds, (const bf16_t*)(ws + WS_XB), 1024, (const bf16_t*)(ws + W_INE), T, LDP, 1024,
            EpiHead{0, (bf16_t*)(ws + WS_PROJ), LDP, ssq, 1.f / 1024.f, (const float*)(ws + WS_CS), P.in[15], P.in[16], P.in[24], P.in[26],
                    (float*)(ws + WS_SSQCKV), (float*)(ws + WS_WI), (bf16_t*)(ws + WS_KI), (LAS float*)(lds + 132096)});
#else
        run_gemm<EpiScale, true>(lds, (const bf16_t*)(ws + WS_XB), 1024, (const bf16_t*)(ws + W_INE), T, LDP, 1024, EpiScale{(bf16_t*)(ws + WS_PROJ), LDP, ssq, 1.f / 1024.f, 0});
#endif
#if MK_FUSE & 2
        run_gemm<EpiHead, true>(lds, (const bf16_t*)(ws + WS_MB), 1024, (const bf16_t*)(ws + W_KVX), MEMT, 2048, 1024,
            EpiHead{2, (bf16_t*)(ws + WS_KVX), 2048, (const float*)(ws + WS_SSQMEM), 1.f / 1024.f, nullptr, P.in[10], nullptr, nullptr, nullptr, nullptr, nullptr, nullptr, (LAS float*)(lds + 132096)},
            ((T / 256) * (LDP / 256)) % G);
#else
        run_gemm<EpiScale, false>(lds, (const bf16_t*)(ws + WS_MB), 1024, (const bf16_t*)(ws + W_KVX), MEMT, 2048, 1024, EpiScale{(bf16_t*)(ws + WS_KVX), 2048, (const float*)(ws + WS_SSQMEM), 1.f / 1024.f, 0}, ((T / 256) * (LDP / 256)) % G);
#endif
    PH_END(1)
#if (MK_FUSE & 3) != 3
    PH_BEGIN(2) phase_post0(P, ((MK_FUSE & 1) ? 0 : 1) | ((MK_FUSE & 2) ? 0 : 2)); PH_END(2)
#endif
    PH_BEGIN(3)
#if MK_FUSE & 4
        run_gemm<EpiHead, true>(lds, (const bf16_t*)(ws + WS_PROJ) + C_CKV, LDP, (const bf16_t*)(ws + W_KVUP), T, 1024, 256,
            EpiHead{1, (bf16_t*)(ws + WS_KBVB), 1024, (const float*)(ws + WS_SSQCKV), 1.f / 256.f, (const float*)(ws + WS_CS), P.in[25], nullptr, nullptr, nullptr, nullptr, nullptr, nullptr, (LAS float*)(lds + 132096)});
#else
        run_gemm<EpiScale, false>(lds, (const bf16_t*)(ws + WS_PROJ) + C_CKV, LDP, (const bf16_t*)(ws + W_KVUP), T, 1024, 256, EpiScale{(bf16_t*)(ws + WS_KBVB), 1024, (const float*)(ws + WS_SSQCKV), 1.f / 256.f, 0});
#endif
    PH_END(3)
#if !(MK_FUSE & 4)
    PH_BEGIN(4) phase_postkb(P); PH_END(4)
#endif
    PH_BEGIN(5)
        if (!(dry && MK_SUB == 2))
        for (int u = bx; u < 256; u += G) { const int bhc = u >> 3, s = u & 7, b = bhc >> 3, h = (bhc >> 1) & 3, c = bhc & 1;
            attnA_unit(P, b, h, c, s, lds); attnA_unit(P, b, h, c, 15 - s, lds); }
        if (!(dry && MK_SUB == 1))
        for (int u = bx; u < 2048; u += G) { const int k = u / 256, c = u % 256, b = k >> 1; const int blk = (k & 1) ? (511 - c) : c;
            indexer_unit(P, b, blk * 8, lds); }
#if MK_IDX2
        for (int u = bx; u < 2048; u += G) { const int k = u / 256, c = u % 256, b = k >> 1; const int blk = (k & 1) ? (511 - c) : c;
            indexer_unit(P, b, blk * 8, lds); }
#endif
    PH_END(5)
    PH_BEGIN(6)
        if (!(dry && MK_SUB == 2))
        for (int u = bx; u < 256; u += G) { const int bh = u >> 3, s = u & 7, b = bh >> 3, hd = bh & 7;
            attnB_unit(P, b, hd, s, lds); attnB_unit(P, b, hd, 15 - s, lds); }
        if (!(dry && MK_SUB == 1)) combineA_rows(P);
    PH_END(6)
    PH_BEGIN(7) run_gemm<EpiResid, false>(lds, Y, 1024, (const bf16_t*)(ws + W_OUTE), T, 1024, 1024, EpiResid{P.in[0], nullptr, XB, ssq + 1 * T, dry}); PH_END(7)
#define XATTN_MLP(l, p0)                                                                                                                                                      \
    PH_BEGIN(p0) run_gemm<EpiScale, false>(lds, XB, 1024, (const bf16_t*)(ws + W_QX) + (size_t)(l) * 512 * 1024, T, 512, 1024, EpiScale{(bf16_t*)(ws + WS_QX), 512, ssq + ((l) ? 4 : 1) * T, 1.f / 1024.f, 0}); PH_END(p0) \
    PH_BEGIN(p0 + 1) for (int u = bx; u < 256; u += G) { const int b = u >> 6, hd = (u >> 4) & 3, qb = u & 15; xattn_unit(P, (l), b, hd, qb, lds); } PH_END(p0 + 1)                                 \
    PH_BEGIN(p0 + 2) run_gemm<EpiResid, false>(lds, (const bf16_t*)(ws + WS_YX), 512, (const bf16_t*)(ws + W_OX) + (size_t)(l) * 1024 * 512, T, 1024, 512, EpiResid{nullptr, nullptr, XB, ssq + ((l) ? 5 : 2) * T, dry}); PH_END(p0 + 2) \
    PH_BEGIN(p0 + 3) run_gemm<EpiScale, true>(lds, XB, 1024, (const bf16_t*)(ws + W_UP) + (size_t)(l) * 4096 * 1024, T, DFF, 1024, EpiScale{(bf16_t*)(ws + WS_H), DFF, ssq + ((l) ? 5 : 2) * T, 1.f / 1024.f, 1}); PH_END(p0 + 3)
    if (ph_lo <= 8 && 8 < ph_hi && !DRYK && gridDim.x == 256 && blockIdx.x >= 128) {
        const int t8 = tid_opaque();
        convert_weights(P, lds, NTR_EARLY, NTR, true, (blockIdx.x - 128) * NWAVE + (t8 >> 6), 128 * NWAVE, (blockIdx.x - 128) * NTHR + t8, 128 * NTHR); }
    XATTN_MLP(0, 8)
    PH_BEGIN(12) run_gemm<EpiResid, false>(lds, (const bf16_t*)(ws + WS_H), DFF, (const bf16_t*)(ws + W_DOWN), T, 1024, DFF, EpiResid{nullptr, nullptr, XB, ssq + 3 * T, dry}); PH_END(12)
    PH_BEGIN(13) run_gemm<EpiScale, true>(lds, XB, 1024, (const bf16_t*)(ws + W_INO), T, 2048, 1024, EpiScale{(bf16_t*)(ws + WS_PROJ1), 2048, ssq + 3 * T, 1.f / 1024.f, 0}); PH_END(13)
    PH_BEGIN(14) phase_mix1(P); PH_END(15)
    PH_BEGIN(16) run_gemm<EpiResid, false>(lds, Y, 1024, (const bf16_t*)(ws + W_OUTO), T, 1024, 1024, EpiResid{nullptr, nullptr, XB, ssq + 4 * T, dry}); PH_END(16)
    XATTN_MLP(1, 17)
    PH_BEGIN(21) run_gemm<EpiResid, false>(lds, (const bf16_t*)(ws + WS_H), DFF, (const bf16_t*)(ws + W_DOWN) + (size_t)1024 * 4096, T, 1024, DFF, EpiResid{nullptr, P.out, XB, nullptr, dry}); PH_END(21)
#if MK_TPROBE
    if (ph_hi == NPHASE) { SEAM_XCD(); unsigned char* ws = P.ws;
        const unsigned long long* TS = (const unsigned long long*)(ws + WS_BAR + 65536);
        float delta = (MK_TPROBE == 14) ? (float)TS[12] / 625000.f : (MK_TPROBE >= 10) ? (float)TS[8 + MK_TPROBE - 10] / (float)TS[12] : (MK_TPROBE == 4 || MK_TPROBE == 20) ? (float)TS[3] * 1e-6f : (float)TS[MK_TPROBE - 1] / (float)TS[3];
        delta = floorf(delta * 25.f + 0.5f) * 0.04f;
        if (MK_TPROBE == 20) delta = 0.1f * floorf(log2f((float)TS[3] / 64000.f) + 0.5f);
        for (int i = blockIdx.x * NTHR + threadIdx.x; i < T * D; i += gridDim.x * NTHR) P.out[i] *= (1.f + delta); }
#endif
}

#ifndef MK_MULTI
#define MK_MULTI 0
#endif
extern "C" void kernel_launch(void* const* d_in, const int* in_sizes, int n_in, void* d_out, int out_size, void* d_ws, size_t ws_size, hipStream_t stream) {
    static int grid = 0;
    if (grid == 0) {
        if (n_in != 33 || out_size != T * D || ws_size < WS_END) { fprintf(stderr, "kernel_launch: unexpected shapes (n_in %d out %d ws %zu)\n", n_in, out_size, ws_size); grid = -1; return; }
        int dev = 0, cus = 0, per_cu = 0;
        hipGetDevice(&dev); hipDeviceGetAttribute(&cus, hipDeviceAttributeMultiprocessorCount, dev);
        hipFuncSetAttribute((const void*)mega<false>, hipFuncAttributeMaxDynamicSharedMemorySize, LDS_BYTES);
        hipOccupancyMaxActiveBlocksPerMultiprocessor(&per_cu, (const void*)mega<false>, NTHR, LDS_BYTES);
        if (per_cu < 1) { fprintf(stderr, "kernel_launch: occupancy query says %d blocks/CU\n", per_cu); per_cu = 1; }
        (void)hipGetLastError();
        grid = cus * 1;
    }
    if (grid < 0) return;
    Params p{};
    for (int i = 0; i < 33; ++i) p.in[i] = (const float*)d_in[i];
    p.out = (float*)d_out; p.ws = (unsigned char*)d_ws;
    (void)hipMemsetAsync((char*)d_ws + WS_BAR, 0, MK_TPROBE ? 131072 : XCD_BAR_WORDS * 4, stream);
#if MK_MULTI
    for (int ph = 0; ph < NPHASE; ++ph) hipLaunchKernelGGL(mega<false>, dim3(grid), dim3(NTHR), LDS_BYTES, stream, p, ph, ph + 1);
#else
    int lo = 0, hi = NPHASE;
    void* args[] = {&p, &lo, &hi};
    hipError_t e = hipLaunchCooperativeKernel((const void*)mega<false>, dim3(grid), dim3(NTHR), args, LDS_BYTES, stream);
    if (e != hipSuccess) fprintf(stderr, "cooperative launch failed: %s (grid %d)\n", hipGetErrorString(e), grid);
#endif
#if MK_XPH >= 0
    { static bool once = false; if (!once) { (void)hipFuncSetAttribute((const void*)mega<true>, hipFuncAttributeMaxDynamicSharedMemorySize, LDS_BYTES); once = true; } }
    for (int i = 0; i < MK_XN; ++i) hipLaunchKernelGGL(mega<true>, dim3(grid), dim3(NTHR), LDS_BYTES, stream, p, MK_XPH, MK_XPH + 1);
#endif
}
```

```cpp
#include <hip/hip_runtime.h>
#include <hip/hip_cooperative_groups.h>
#include <cstdio>
#include <cstdint>
namespace cg = cooperative_groups;
#ifndef MK_SEL2
#define MK_SEL2 0
#define MK_SC2 0
#define MK_BIS2 0
#define MK_XA2 0
#define MK_FUSE 7
#define MK_AX 0
#define MK_TPROBE 0
#endif

#define DEVI __device__ __forceinline__
#define LAS __attribute__((address_space(3)))
typedef unsigned short bf16_t;
typedef short bf16x8 __attribute__((ext_vector_type(8)));
typedef short s16x4 __attribute__((ext_vector_type(4)));
typedef float f32x2 __attribute__((ext_vector_type(2)));
typedef float f32x4 __attribute__((ext_vector_type(4)));
typedef float f32x16 __attribute__((ext_vector_type(16)));
typedef unsigned u32x2 __attribute__((ext_vector_type(2)));
typedef unsigned u32x4 __attribute__((ext_vector_type(4)));
typedef unsigned long long u64;

constexpr int NB = 4, S = 4096, T = NB * S, D = 1024, DFF = 4096, MEML = 256, MEMT = NB * MEML;
constexpr int LDP = 2816;
constexpr int C_QA = 0, C_KA = 512, C_VA = 1024, C_QB = 1536, C_CKV = 2048, C_QI = 2304, C_KI = 2560, C_WI = 2624, EVEN_IN = 2628;
constexpr float EPS = 1e-6f;
constexpr float LOG2E = 1.4426950408889634f;
constexpr int NTHR = 512, NWAVE = 8;
constexpr int LDS_BYTES = 163840;

constexpr size_t MiB = 1u << 20;
constexpr size_t WS_SSQ = 0;
constexpr size_t WS_SSQCKV = WS_SSQ + 6ull * T * 4;
constexpr size_t WS_SSQMEM = WS_SSQCKV + (size_t)T * 4;
constexpr size_t WS_WI = 512 * 1024;
constexpr size_t WS_BAR = 1 * MiB;
constexpr size_t WS_W = 2 * MiB;
constexpr size_t W_INE = WS_W;
constexpr size_t W_KVUP = W_INE + (size_t)LDP * 1024 * 2;
constexpr size_t W_OUTE = W_KVUP + 1024ull * 256 * 2;
constexpr size_t W_QX = W_OUTE + 1024ull * 1024 * 2;
constexpr size_t W_KVX = W_QX + 2 * 512ull * 1024 * 2;
constexpr size_t W_OX = W_KVX + 2 * 1024ull * 1024 * 2;
constexpr size_t W_UP = W_OX + 2 * 1024ull * 512 * 2;
constexpr size_t W_DOWN = W_UP + 2 * 4096ull * 1024 * 2;
constexpr size_t W_INO = W_DOWN + 2 * 4096ull * 1024 * 2;
constexpr size_t W_POOL = W_INO + 2048ull * 1024 * 2;
constexpr size_t W_OUTO = W_POOL + 512ull * 512 * 2;
constexpr size_t W_END = W_OUTO + 1024ull * 1024 * 2;
static_assert(W_END <= 57 * MiB, "weights region");
constexpr size_t WS_XB = 57 * MiB;
constexpr size_t WS_PROJ = 89 * MiB;
constexpr size_t WS_KBVB = 177 * MiB;
constexpr size_t WS_MASK = 209 * MiB;
constexpr size_t WS_Y = 217 * MiB;
constexpr size_t WS_CS = 249 * MiB;
constexpr size_t WS_MB = 250 * MiB;
constexpr size_t WS_KVX = 252 * MiB;
constexpr size_t WS_END = 256 * MiB;
constexpr size_t WS_QX = WS_PROJ;
constexpr size_t WS_YX = WS_PROJ + 16 * MiB;
constexpr size_t WS_H = WS_PROJ;
constexpr size_t WS_PROJ1 = WS_PROJ;
constexpr size_t WS_POOLED = WS_PROJ + 64 * MiB;
constexpr size_t WS_KI = WS_Y;

struct Params { const float* in[33]; float* out; unsigned char* ws; };

DEVI float bf2f(bf16_t v) { return __uint_as_float(((unsigned)v) << 16); }
DEVI unsigned f2bf(float f) { unsigned u = __float_as_uint(f); return (u + 0x7fffu + ((u >> 16) & 1u)) >> 16; }
DEVI unsigned pk2(float lo, float hi) { return f2bf(lo) | (f2bf(hi) << 16); }
DEVI float wave_sum(float v) {
#pragma unroll
    for (int o = 1; o < 64; o <<= 1) v += __shfl_xor(v, o);
    return v;
}
DEVI float lo16(unsigned w) { return __uint_as_float(w << 16); }
DEVI float hi16(unsigned w) { return __uint_as_float(w & 0xffff0000u); }
#define LDS_WAIT() asm volatile("s_waitcnt lgkmcnt(0)" ::: "memory")
DEVI unsigned cvtpk(float lo, float hi) { typedef __bf16 bf2 __attribute__((ext_vector_type(2))); f32x2 v = {lo, hi}; bf2 b = __builtin_convertvector(v, bf2); return __builtin_bit_cast(unsigned, b); }

DEVI int tid_opaque() { int w = __builtin_amdgcn_readfirstlane(threadIdx.x >> 6); asm volatile("" : "+s"(w)); const int l = __builtin_amdgcn_mbcnt_hi(~0u, __builtin_amdgcn_mbcnt_lo(~0u, 0u)); return w * 64 + l; }
struct TrD { const float* src; bf16_t* dst; const float* sk; const float* sn; int K, N, ldd; };
constexpr int NTR = 19;
DEVI TrD get_tr(const Params& P, int i) {
    unsigned char* ws = P.ws; TrD d; d.sk = nullptr; d.sn = nullptr;
    switch (i) {
    case 0: d.src = P.in[14]; d.dst = (bf16_t*)(ws + W_INE); d.K = 1024; d.N = EVEN_IN; d.ldd = 1024; d.sk = P.in[3]; break;
    case 1: d.src = P.in[23]; d.dst = (bf16_t*)(ws + W_KVUP); d.K = 256; d.N = 1024; d.ldd = 256; d.sk = P.in[22]; break;
    case 2: d.src = P.in[27]; d.dst = (bf16_t*)(ws + W_OUTE); d.K = 1024; d.N = 1024; d.ldd = 1024; break;
    case 3: case 4: { int l = i - 3; d.src = P.in[7] + (size_t)l * 1024 * 512; d.dst = (bf16_t*)(ws + W_QX) + (size_t)l * 512 * 1024; d.K = 1024; d.N = 512; d.ldd = 1024; d.sk = P.in[4] + l * 1024; } break;
    case 5: case 6: { int l = i - 5; d.src = P.in[8] + (size_t)l * 1024 * 1024; d.dst = (bf16_t*)(ws + W_KVX) + (size_t)l * 1024 * 1024; d.K = 1024; d.N = 1024; d.ldd = 1024; d.sk = P.in[5] + l * 1024; } break;
    case 7: case 8: { int l = i - 7; d.src = P.in[11] + (size_t)l * 512 * 1024; d.dst = (bf16_t*)(ws + W_OX) + (size_t)l * 1024 * 512; d.K = 512; d.N = 1024; d.ldd = 512; } break;
    case 9: case 10: { int l = i - 9; d.src = P.in[12] + (size_t)l * 1024 * 4096; d.dst = (bf16_t*)(ws + W_UP) + (size_t)l * 4096 * 1024; d.K = 1024; d.N = 4096; d.ldd = 1024; d.sk = P.in[6] + l * 1024; } break;
    case 11: case 12: { int l = i - 11; d.src = P.in[13] + (size_t)l * 4096 * 1024; d.dst = (bf16_t*)(ws + W_DOWN) + (size_t)l * 1024 * 4096; d.K = 4096; d.N = 1024; d.ldd = 4096; } break;
    case 13: d.src = P.in[28]; d.dst = (bf16_t*)(ws + W_INO); d.K = 1024; d.N = 2048; d.ldd = 1024; d.sk = P.in[3] + 1024; break;
    case 14: case 15: case 16: case 17: d.src = P.in[30]; d.dst = (bf16_t*)(ws + W_POOL); d.K = 0; d.N = 32; d.ldd = 512; break;
    default: d.src = P.in[32]; d.dst = (bf16_t*)(ws + W_OUTO); d.K = 512; d.N = 1024; d.ldd = 1024; break;
    }
    return d;
}
DEVI int tr_items(const TrD& d) { return (d.K / 64) * ((d.N + 31) / 32); }
template <bool SK, bool SN>
DEVI void tr_item(const TrD& d, LAS float* scr, int item, int lane) {
    const int nblk = (d.N + 31) / 32, kb = item / nblk, nb = item % nblk, k0 = 64 * kb, n0 = 32 * nb;
    const int n = n0 + (lane & 31), nc = (n < d.N) ? n : (d.N - 1);
    const float* sp = d.src + (size_t)(k0 + (lane >> 5)) * d.N + nc;
    float v[32], sk[32];
#pragma unroll
    for (int i = 0; i < 32; ++i) { v[i] = sp[(size_t)(2 * i) * d.N]; if (SK) sk[i] = d.sk[k0 + 2 * i + (lane >> 5)]; }
#pragma unroll
    for (int i = 0; i < 32; ++i) { float x = v[i]; if (SK) x *= sk[i]; if (n >= d.N) x = 0.f; scr[(2 * i + (lane >> 5)) * 33 + (lane & 31)] = x; }
    LDS_WAIT(); asm volatile("" ::: "memory");
    const int c = lane & 7;
#pragma unroll
    for (int j = 0; j < 4; ++j) {
        const int nn = (lane >> 3) + 8 * j, ncl = (n0 + nn < d.N) ? (n0 + nn) : (d.N - 1);
        const LAS float* s = scr + (8 * c) * 33 + nn;
        float sc = 1.f; if (SN) sc = d.sn[ncl];
        u32x4 o; o.x = pk2(s[0 * 33] * sc, s[1 * 33] * sc); o.y = pk2(s[2 * 33] * sc, s[3 * 33] * sc); o.z = pk2(s[4 * 33] * sc, s[5 * 33] * sc); o.w = pk2(s[6 * 33] * sc, s[7 * 33] * sc);
        if (n0 + nn < d.N) *(u32x4*)(d.dst + (size_t)(n0 + nn) * d.ldd + k0 + 8 * c) = o;
    }
    LDS_WAIT(); asm volatile("" ::: "memory");
}
DEVI void row_to_bf16_ssq(const float* xrow, bf16_t* orow, float* ssq_out, int lane) {
    const f32x4* xr = (const f32x4*)xrow + lane;
    f32x4 v[4]; float s = 0.f;
#pragma unroll
    for (int j = 0; j < 4; ++j) { v[j] = xr[64 * j]; s += (v[j].x * v[j].x + v[j].y * v[j].y) + (v[j].z * v[j].z + v[j].w * v[j].w); }
    s = wave_sum(s);
    if (lane == 0) *ssq_out = s;
    u32x2* o8 = (u32x2*)orow + lane;
#pragma unroll
    for (int j = 0; j < 4; ++j) { u32x2 w; w.x = pk2(v[j].x, v[j].y); w.y = pk2(v[j].z, v[j].w); o8[64 * j] = w; }
}
#ifndef MK_SUB
#define MK_SUB 0
#endif
DEVI void convert_weights(const Params& P, LAS unsigned char* lds, int dlo, int dhi, bool fold, int gw, int NGW, int gt, int NGT) {
    const int tid = tid_opaque(), lane = tid & 63, wave = tid >> 6;
    unsigned char* ws = P.ws;
    LAS float* scr = (LAS float*)(lds + wave * 16384);
    int base = 0;
    for (int i = dlo; i < dhi; ++i) {
        const TrD d = get_tr(P, i); const int n = tr_items(d);
        int first = gw - (base % NGW); if (first < 0) first += NGW;
        if (d.sn) { for (int it = first; it < n; it += NGW) tr_item<false, true>(d, scr, it, lane); }
        else if (d.sk) { for (int it = first; it < n; it += NGW) tr_item<true, false>(d, scr, it, lane); }
        else { for (int it = first; it < n; it += NGW) tr_item<false, false>(d, scr, it, lane); }
        base += n;
    }
    if (!fold) return;
    for (int i = gt; i < 1024 * 64; i += NGT) {
        const int n = i & 1023, cp0 = (i >> 10) * 8, g = cp0 >> 7, c = cp0 & 127;
        const float* wo = P.in[32] + (size_t)(512 + g * 128) * 1024 + n; const float* wp = P.in[30] + (size_t)g * 16384 + (size_t)c * 128; const float* ps = P.in[31] + g * 128;
        float acc[8];
#pragma unroll
        for (int j = 0; j < 8; ++j) acc[j] = 0.f;
        for (int d0 = 0; d0 < 128; d0 += 8) {
            float wv[8];
#pragma unroll
            for (int dd = 0; dd < 8; ++dd) wv[dd] = wo[(size_t)(d0 + dd) * 1024] * ps[d0 + dd];
#pragma unroll
            for (int dd = 0; dd < 8; ++dd)
#pragma unroll
                for (int j = 0; j < 8; ++j) acc[j] += wp[j * 128 + d0 + dd] * wv[dd];
        }
        u32x4 w; w.x = pk2(acc[0], acc[1]); w.y = pk2(acc[2], acc[3]); w.z = pk2(acc[4], acc[5]); w.w = pk2(acc[6], acc[7]);
        *(u32x4*)((bf16_t*)(ws + W_OUTO) + (size_t)n * 1024 + 512 + cp0) = w;
    }
}
constexpr int NTR_EARLY = 7;
DEVI void phase_prologue(const Params& P, LAS unsigned char* lds, int dry = 0) {
    const int tid = tid_opaque(), lane = tid & 63, wave = tid >> 6;
#if MK_TPROBE == 20
    { float a0 = lane, a1 = lane + 1, a2 = lane + 2, a3 = lane + 3, a4 = lane + 4, a5 = lane + 5, a6 = lane + 6, a7 = lane + 7;
      unsigned long long t0_ = __builtin_amdgcn_s_memtime();
      for (int it = 0; it < 1000; ++it) {
#pragma unroll
          for (int k = 0; k < 8; ++k) { asm volatile("v_fma_f32 %0, %0, 1.0, %0\n\tv_fma_f32 %1, %1, 1.0, %1\n\tv_fma_f32 %2, %2, 1.0, %2\n\tv_fma_f32 %3, %3, 1.0, %3\n\tv_fma_f32 %4, %4, 1.0, %4\n\tv_fma_f32 %5, %5, 1.0, %5\n\tv_fma_f32 %6, %6, 1.0, %6\n\tv_fma_f32 %7, %7, 1.0, %7" : "+v"(a0), "+v"(a1), "+v"(a2), "+v"(a3), "+v"(a4), "+v"(a5), "+v"(a6), "+v"(a7)); }
      }
      unsigned long long t1_ = __builtin_amdgcn_s_memtime();
      asm volatile("" :: "v"(a0), "v"(a1), "v"(a2), "v"(a3), "v"(a4), "v"(a5), "v"(a6), "v"(a7));
      if (blockIdx.x == 0 && tid == 0) atomicAdd((unsigned long long*)(P.ws + WS_BAR + 65536) + 3, t1_ - t0_); }
#endif
    const int gw = blockIdx.x * NWAVE + wave, NGW = gridDim.x * NWAVE;
    const int gt = blockIdx.x * NTHR + tid, NGT = gridDim.x * NTHR;
    unsigned char* ws = P.ws;
    convert_weights(P, lds, 0, NTR_EARLY, false, gw, NGW, gt, NGT);
    { bf16_t* w = (bf16_t*)(ws + W_INE) + (size_t)EVEN_IN * 1024; const int n = (LDP - EVEN_IN) * 1024 / 8;
      for (int i = gt; i < n; i += NGT) ((u32x4*)w)[i] = (u32x4){0u, 0u, 0u, 0u}; }
    { float* q = (float*)(ws + WS_SSQ) + T; for (int i = gt; i < 5 * T; i += NGT) q[i] = 0.f; }
    if (!(dry && MK_SUB != 2 && MK_SUB != 0))
    for (int m = gw; m < T; m += NGW) row_to_bf16_ssq(P.in[0] + (size_t)m * D, (bf16_t*)(ws + WS_XB) + (size_t)m * D, (float*)(ws + WS_SSQ) + m, lane);
    for (int m = gw; m < MEMT; m += NGW) row_to_bf16_ssq(P.in[1] + (size_t)m * D, (bf16_t*)(ws + WS_MB) + (size_t)m * D, (float*)(ws + WS_SSQMEM) + m, lane);
    if (!(dry && MK_SUB != 3 && MK_SUB != 0))
    { const int* pos = (const int*)P.in[2]; float* cs = (float*)(ws + WS_CS);
      for (int i = gt; i < T * 8; i += NGT) { const int m = i >> 3, f = i & 7;
        const double inv = (f == 0) ? 1.0 : (f == 1) ? 0.19392274474868576 : (f == 2) ? 0.03760603093086393 : (f == 3) ? 0.007292664737217109 : (f == 4) ? 0.001414213562373095
                         : (f == 5) ? 0.0002742481756762073 : (f == 6) ? 5.318295896944988e-05 : 1.031338537721246e-05;
        const double ang = (double)pos[m] * inv, k = rint(ang * 0.15915494309189535), r = fma(-k, 6.283185307179586, ang) - k * 2.4492935982947064e-16;
        cs[m * 16 + f] = cosf((float)r); cs[m * 16 + 8 + f] = sinf((float)r); } }
}

struct EpiStore {
    bf16_t* O; int ldo; const float* ssq; float inv_n; int act;
    DEVI void operator()(const f32x4 (&acc)[4][4], int row0, int col0, int lane) const {
#pragma unroll
        for (int m = 0; m < 4; ++m)
#pragma unroll
            for (int i = 0; i < 4; ++i) {
                const int row = row0 + 16 * m + (lane >> 4) * 4 + i;
                const float rs = ssq ? rsqrtf(ssq[row] * inv_n + EPS) : 1.f;
#pragma unroll
                for (int n = 0; n < 4; ++n) {
                    float v = acc[m][n][i] * rs;
                    if (act == 1) { v = fmaxf(v, 0.f); v = v * v; }
                    O[(size_t)row * ldo + col0 + 16 * n + (lane & 15)] = (bf16_t)f2bf(v);
                }
            }
    }
};
struct EpiRes {
    const float* base; float* out; bf16_t* xb; float* ssq_next;
    DEVI void operator()(const f32x4 (&acc)[4][4], int row0, int col0, int lane) const {
#pragma unroll
        for (int m = 0; m < 4; ++m)
#pragma unroll
            for (int i = 0; i < 4; ++i) {
                const int row = row0 + 16 * m + (lane >> 4) * 4 + i; float s = 0.f;
#pragma unroll
                for (int n = 0; n < 4; ++n) {
                    const size_t idx = (size_t)row * D + col0 + 16 * n + (lane & 15);
                    const float v = base[idx] + acc[m][n][i];
                    out[idx] = v; s += v * v;
                    if (xb) xb[idx] = (bf16_t)f2bf(v);
                }
                if (ssq_next) {
                    s += __shfl_xor(s, 1); s += __shfl_xor(s, 2); s += __shfl_xor(s, 4); s += __shfl_xor(s, 8);
                    if ((lane & 15) == 0) atomicAdd(ssq_next + row, s);
                }
            }
    }
};
template <class Epi>
DEVI void gemm_simple(const bf16_t* A, int lda, const bf16_t* Bt, int ldb, int M, int N, int K, const Epi& epi) {
    const int tid = tid_opaque(), lane = tid & 63, wave = tid >> 6;
    const int gw = blockIdx.x * NWAVE + wave, NGW = gridDim.x * NWAVE;
    const int nN = N / 64, ntiles = (M / 64) * nN;
    for (int tile = gw; tile < ntiles; tile += NGW) {
        const int row0 = (tile / nN) * 64, col0 = (tile % nN) * 64;
        f32x4 acc[4][4];
#pragma unroll
        for (int m = 0; m < 4; ++m)
#pragma unroll
            for (int n = 0; n < 4; ++n) acc[m][n] = (f32x4){0.f, 0.f, 0.f, 0.f};
        const bf16_t* ap = A + (size_t)(row0 + (lane & 15)) * lda + 8 * (lane >> 4);
        const bf16_t* bp = Bt + (size_t)(col0 + (lane & 15)) * ldb + 8 * (lane >> 4);
        for (int k0 = 0; k0 < K; k0 += 32) {
            bf16x8 a[4], b[4];
#pragma unroll
            for (int m = 0; m < 4; ++m) a[m] = *(const bf16x8*)(ap + (size_t)(16 * m) * lda + k0);
#pragma unroll
            for (int n = 0; n < 4; ++n) b[n] = *(const bf16x8*)(bp + (size_t)(16 * n) * ldb + k0);
#pragma unroll
            for (int m = 0; m < 4; ++m)
#pragma unroll
                for (int n = 0; n < 4; ++n) acc[m][n] = __builtin_amdgcn_mfma_f32_16x16x32_bf16(a[m], b[n], acc[m][n], 0, 0, 0);
        }
        epi(acc, row0, col0, lane);
    }
}

DEVI u32x4 heads8(u32x4 raw, const float (&gv)[8], bool do_norm, float scale, const float (&cs)[16], int lane) {
    float v[8];
#pragma unroll
    for (int j = 0; j < 4; ++j) { v[2 * j] = lo16(raw[j]); v[2 * j + 1] = hi16(raw[j]); }
    if (do_norm) {
        float ss = 0.f;
#pragma unroll
        for (int j = 0; j < 8; ++j) ss += v[j] * v[j];
        ss += __shfl_xor(ss, 1); ss += __shfl_xor(ss, 2); ss += __shfl_xor(ss, 4);
        const float rs = rsqrtf(ss * (1.f / 64.f) + EPS);
#pragma unroll
        for (int j = 0; j < 8; ++j) v[j] = v[j] * rs * gv[j];
    }
    const int sub = lane & 7;
#pragma unroll
    for (int j = 0; j < 8; ++j) { const float o = __shfl_xor(v[j], 1); if (sub == 0) v[j] = v[j] * cs[j] - o * cs[8 + j]; else if (sub == 1) v[j] = v[j] * cs[j] + o * cs[8 + j]; }
    u32x4 w;
#pragma unroll
    for (int j = 0; j < 4; ++j) w[j] = cvtpk(v[2 * j] * scale, v[2 * j + 1] * scale);
    return w;
}
DEVI void load8(float (&g)[8], const float* p) { const f32x4 a = *(const f32x4*)p, b = *(const f32x4*)(p + 4); g[0] = a[0]; g[1] = a[1]; g[2] = a[2]; g[3] = a[3]; g[4] = b[0]; g[5] = b[1]; g[6] = b[2]; g[7] = b[3]; }
struct Post0Row { u32x4 qa, ka, qb, x, ckv; u32x2 wi; f32x4 c0, c1, c2, c3; };
DEVI void post0_load(Post0Row& R, const bf16_t* row, const float* cs, int lane) {
    R.qa = *(const u32x4*)(row + C_QA + 8 * lane); R.ka = *(const u32x4*)(row + C_KA + 8 * lane); R.qb = *(const u32x4*)(row + C_QB + 8 * lane);
    R.x = *(const u32x4*)(row + C_QI + 8 * ((lane < 40) ? lane : 0));
    R.ckv = *(const u32x4*)(row + C_CKV + 8 * (lane & 31));
    R.wi = *(const u32x2*)(row + C_WI);
    R.c0 = *(const f32x4*)cs; R.c1 = *(const f32x4*)(cs + 4); R.c2 = *(const f32x4*)(cs + 8); R.c3 = *(const f32x4*)(cs + 12);
}
DEVI void phase_post0(const Params& P, int parts = 3) {
    static_assert(C_KI == C_QI + 256, "k_idx follows q_idx");
    const int tid = tid_opaque(), lane = tid & 63, wave = tid >> 6;
    const int gw = blockIdx.x * NWAVE + wave, NGW = gridDim.x * NWAVE;
    unsigned char* ws = P.ws;
    const float qscale = 0.125f * LOG2E;
    float gqa[8], gka[8], gqb[8], gki[8];
    load8(gqa, P.in[15] + 8 * (lane & 7)); load8(gka, P.in[16] + 8 * (lane & 7)); load8(gqb, P.in[24] + 8 * (lane & 7)); load8(gki, P.in[26] + 8 * (lane & 7));
    if (parts & 1)
    for (int m0 = gw; m0 < T; m0 += 2 * NGW) {
        Post0Row R[2];
        const int m1 = (m0 + NGW < T) ? m0 + NGW : m0;
        post0_load(R[0], (const bf16_t*)(ws + WS_PROJ) + (size_t)m0 * LDP, (const float*)(ws + WS_CS) + (size_t)m0 * 16, lane);
        post0_load(R[1], (const bf16_t*)(ws + WS_PROJ) + (size_t)m1 * LDP, (const float*)(ws + WS_CS) + (size_t)m1 * 16, lane);
#pragma unroll
        for (int k = 0; k < 2; ++k) {
            const int m = k ? m1 : m0; if (k == 1 && m1 == m0) break;
            bf16_t* row = (bf16_t*)(ws + WS_PROJ) + (size_t)m * LDP;
            float cs[16];
#pragma unroll
            for (int j = 0; j < 4; ++j) { cs[j] = R[k].c0[j]; cs[4 + j] = R[k].c1[j]; cs[8 + j] = R[k].c2[j]; cs[12 + j] = R[k].c3[j]; }
            *(u32x4*)(row + C_QA + 8 * lane) = heads8(R[k].qa, gqa, true, qscale, cs, lane);
            *(u32x4*)(row + C_KA + 8 * lane) = heads8(R[k].ka, gka, true, 1.f, cs, lane);
            *(u32x4*)(row + C_QB + 8 * lane) = heads8(R[k].qb, gqb, true, qscale, cs, lane);
            {
              float v[8];
#pragma unroll
              for (int j = 0; j < 4; ++j) { v[2 * j] = lo16(R[k].x[j]); v[2 * j + 1] = hi16(R[k].x[j]); }
              float ss = 0.f;
#pragma unroll
              for (int j = 0; j < 8; ++j) ss += v[j] * v[j];
              ss += __shfl_xor(ss, 1); ss += __shfl_xor(ss, 2); ss += __shfl_xor(ss, 4);
              if (lane >= 32) { const float rs = rsqrtf(ss * (1.f / 64.f) + EPS);
#pragma unroll
                  for (int j = 0; j < 8; ++j) v[j] = v[j] * rs * gki[j]; }
              const int sub = lane & 7;
#pragma unroll
              for (int j = 0; j < 8; ++j) { const float o = __shfl_xor(v[j], 1); if (sub == 0) v[j] = v[j] * cs[j] - o * cs[8 + j]; else if (sub == 1) v[j] = v[j] * cs[j] + o * cs[8 + j]; }
              u32x4 w;
#pragma unroll
              for (int j = 0; j < 4; ++j) w[j] = cvtpk(v[2 * j], v[2 * j + 1]);
              if (lane < 32) *(u32x4*)(row + C_QI + 8 * lane) = w;
              else if (lane < 40) { const int c = lane - 32;
                  *(u32x4*)((bf16_t*)(ws + WS_KI) + (size_t)(m >> 5) * 2048 + (c >> 1) * 512 + (((c & 1) * 32 + (m & 31)) * 8)) = w; } }
            { float ss = 0.f;
#pragma unroll
              for (int j = 0; j < 4; ++j) { const float a = lo16(R[k].ckv[j]), b = hi16(R[k].ckv[j]); ss += a * a + b * b; }
              ss += __shfl_xor(ss, 1); ss += __shfl_xor(ss, 2); ss += __shfl_xor(ss, 4); ss += __shfl_xor(ss, 8); ss += __shfl_xor(ss, 16);
              if (lane == 0) { ((float*)(ws + WS_SSQCKV))[m] = ss;
                  *(f32x4*)((float*)(ws + WS_WI) + (size_t)m * 4) = (f32x4){lo16(R[k].wi.x) * (1.f / 16.f), hi16(R[k].wi.x) * (1.f / 16.f), lo16(R[k].wi.y) * (1.f / 16.f), hi16(R[k].wi.y) * (1.f / 16.f)}; } }
        }
    }
    if (parts & 2)
    for (int it = gw; it < 2 * MEMT; it += NGW) {
        const int l = it / MEMT, m = it % MEMT;
        bf16_t* row = (bf16_t*)(ws + WS_KVX) + (size_t)m * 2048 + l * 1024;
        float g[8]; load8(g, P.in[10] + l * 128 + 8 * (lane & 15));
        const u32x4 raw = *(const u32x4*)(row + 8 * lane);
        float v[8]; float ss = 0.f;
#pragma unroll
        for (int j = 0; j < 4; ++j) { v[2 * j] = lo16(raw[j]); v[2 * j + 1] = hi16(raw[j]); ss += v[2 * j] * v[2 * j] + v[2 * j + 1] * v[2 * j + 1]; }
        ss += __shfl_xor(ss, 1); ss += __shfl_xor(ss, 2); ss += __shfl_xor(ss, 4); ss += __shfl_xor(ss, 8);
        const float rs = rsqrtf(ss * (1.f / 128.f) + EPS);
        u32x4 w;
#pragma unroll
        for (int j = 0; j < 4; ++j) w[j] = cvtpk(v[2 * j] * rs * g[2 * j], v[2 * j + 1] * rs * g[2 * j + 1]);
        *(u32x4*)(row + 8 * lane) = w;
    }
}
DEVI void phase_postkb(const Params& P) {
    const int tid = tid_opaque(), lane = tid & 63, wave = tid >> 6;
    const int gw = blockIdx.x * NWAVE + wave, NGW = gridDim.x * NWAVE;
    unsigned char* ws = P.ws;
    float gkb[8]; load8(gkb, P.in[25] + 8 * (lane & 7));
    for (int m0 = gw; m0 < T; m0 += 4 * NGW) {
        u32x4 raw[4]; f32x4 c[4][4];
#pragma unroll
        for (int k = 0; k < 4; ++k) { const int m = (m0 + k * NGW < T) ? m0 + k * NGW : m0;
            raw[k] = *(const u32x4*)((const bf16_t*)(ws + WS_KBVB) + (size_t)m * 1024 + 8 * lane);
            const float* cs = (const float*)(ws + WS_CS) + (size_t)m * 16;
#pragma unroll
            for (int j = 0; j < 4; ++j) c[k][j] = *(const f32x4*)(cs + 4 * j); }
#pragma unroll
        for (int k = 0; k < 4; ++k) { const int m = m0 + k * NGW; if (m >= T) break;
            float cs[16];
#pragma unroll
            for (int j = 0; j < 16; ++j) cs[j] = c[k][j >> 2][j & 3];
            *(u32x4*)((bf16_t*)(ws + WS_KBVB) + (size_t)m * 1024 + 8 * lane) = heads8(raw[k], gkb, true, 1.f, cs, lane); }
    }
}

DEVI int crow(int r, int hi) { return (r & 3) + 8 * (r >> 2) + 4 * hi; }
typedef short v4i16_t __attribute__((ext_vector_type(4)));
DEVI s16x4 vtr(LAS const unsigned char* p) { return __builtin_bit_cast(s16x4, __builtin_amdgcn_ds_read_tr16_b64_v4i16((LAS v4i16_t*)p)); }

DEVI float max3f(float a, float b, float c) { float r; asm("v_max3_f32 %0, %1, %2, %3" : "=v"(r) : "v"(a), "v"(b), "v"(c)); return r; }
DEVI float max2f(float a, float b) { float r; asm("v_max_f32_e32 %0, %1, %2" : "=v"(r) : "v"(a), "v"(b)); return r; }
template <int DQK, int DV, int MODE, bool QP = false>
DEVI void attn_core(f32x16 (&o)[DV / 32], float& l_out, const bf16x8 (&qf)[DQK / 16],
                    const bf16_t* Kg, int ldk, const bf16_t* Vg, int ldv, int ntiles, int qpos, int qpos_wmin,
                    const u64* mrow, LAS unsigned char* lds, int tid) {
    constexpr int KROWB = DQK * 2, KCPR = DQK / 8, VP = (DV == 128) ? 320 : 192, VCPR = DV / 8;
    constexpr int KBUF = 64 * KROWB, VBUF = 64 * VP, KCH = 64 * KCPR / NTHR, VCH = 64 * VCPR / NTHR;
    constexpr float THR = 8.f;
#define KSWZ(r) ((KCPR == 8) ? (((r) >> 1) & 7) : ((r) & 15))
    LAS unsigned char* Kl = lds; LAS unsigned char* Vl = lds + 2 * KBUF;
    const int lane = tid & 63, r32 = lane & 31, hi = lane >> 5;
    u32x4 kreg[KCH], vreg[VCH];
#define A_GLOAD(t) do { _Pragma("unroll") for (int i_ = 0; i_ < KCH; ++i_) { const int c_ = tid + NTHR * i_, row_ = c_ / KCPR, ch_ = c_ % KCPR; kreg[i_] = *(const u32x4*)(Kg + (size_t)(64 * (t) + row_) * ldk + ch_ * 8); } \
        _Pragma("unroll") for (int i_ = 0; i_ < VCH; ++i_) { const int c_ = tid + NTHR * i_, row_ = c_ / VCPR, ch_ = c_ % VCPR; vreg[i_] = *(const u32x4*)(Vg + (size_t)(64 * (t) + row_) * ldv + ch_ * 8); } } while (0)
#define A_LSTORE(buf) do { _Pragma("unroll") for (int i_ = 0; i_ < KCH; ++i_) { const int c_ = tid + NTHR * i_, row_ = c_ / KCPR, ch_ = c_ % KCPR; *(LAS u32x4*)(Kl + (buf) * KBUF + row_ * KROWB + ((ch_ ^ KSWZ(row_)) << 4)) = kreg[i_]; } \
        _Pragma("unroll") for (int i_ = 0; i_ < VCH; ++i_) { const int c_ = tid + NTHR * i_, row_ = c_ / VCPR, ch_ = c_ % VCPR; *(LAS u32x4*)(Vl + (buf) * VBUF + row_ * VP + ch_ * 16) = vreg[i_]; } } while (0)
    A_GLOAD(0); A_LSTORE(0); __syncthreads();
#pragma unroll
    for (int d0 = 0; d0 < DQK / 16; ++d0) asm volatile("" :: "v"(qf[d0]));
    const int vb = (4 * hi + ((lane & 15) >> 2)) * VP + (16 * ((lane >> 4) & 1) + 4 * (lane & 3)) * 2;
    const short one = (short)0x3F80;
    const bf16x8 ones = ((r32 & ~4) == 0) ? (bf16x8){one, one, one, one, one, one, one, one} : (bf16x8){0, 0, 0, 0, 0, 0, 0, 0};
    f32x16 negm, lacc;
#pragma unroll
    for (int r = 0; r < 16; ++r) { negm[r] = 0.f; lacc[r] = 0.f; }
    float mhat = 0.f;
    const unsigned ninf = 0xFF800000u;
#if MK_AX == 1
    f32x16 dmy_;
#pragma unroll
    for (int r = 0; r < 16; ++r) dmy_[r] = 0.f;
#endif
    u64 wnext = 0ull;
    if (MODE == 2) wnext = mrow[0];
    for (int t = 0; t < ntiles; ++t) {
        const int buf = t & 1;
        const u64 wcur = wnext; (void)wcur;
        if (MODE == 2 && t + 1 < ntiles) wnext = mrow[t + 1];
        if (t + 1 < ntiles) A_GLOAD(t + 1);
        f32x16 p0, p1;
#pragma unroll
        for (int db = 0; db < DQK / 64; ++db) {
            bf16x8 kf[8];
#pragma unroll
            for (int e = 0; e < 4; ++e) { const int ch = 2 * (4 * db + e) + hi, row0 = r32, row1 = 32 + r32;
                if (!QP) {
                    kf[2 * e] = *(LAS const bf16x8*)(Kl + buf * KBUF + row0 * KROWB + ((ch ^ KSWZ(row0)) << 4));
                    kf[2 * e + 1] = *(LAS const bf16x8*)(Kl + buf * KBUF + row1 * KROWB + ((ch ^ KSWZ(row1)) << 4));
                } else {
                    const int c1 = 2 * (4 * db + e);
                    const s16x4 a0 = *(LAS const s16x4*)(Kl + buf * KBUF + row0 * KROWB + ((c1 ^ KSWZ(row0)) << 4) + 8 * hi), a1 = *(LAS const s16x4*)(Kl + buf * KBUF + row0 * KROWB + (((c1 + 1) ^ KSWZ(row0)) << 4) + 8 * hi);
                    const s16x4 b0 = *(LAS const s16x4*)(Kl + buf * KBUF + row1 * KROWB + ((c1 ^ KSWZ(row1)) << 4) + 8 * hi), b1 = *(LAS const s16x4*)(Kl + buf * KBUF + row1 * KROWB + (((c1 + 1) ^ KSWZ(row1)) << 4) + 8 * hi);
                    kf[2 * e] = (bf16x8){a0[0], a0[1], a0[2], a0[3], a1[0], a1[1], a1[2], a1[3]}; kf[2 * e + 1] = (bf16x8){b0[0], b0[1], b0[2], b0[3], b1[0], b1[1], b1[2], b1[3]};
                } }
#pragma unroll
            for (int e = 0; e < 4; ++e) { const int d0 = 4 * db + e;
                if (d0 == 0) { p0 = __builtin_amdgcn_mfma_f32_32x32x16_bf16(kf[0], qf[0], negm, 0, 0, 0); p1 = __builtin_amdgcn_mfma_f32_32x32x16_bf16(kf[1], qf[0], negm, 0, 0, 0); }
                else { p0 = __builtin_amdgcn_mfma_f32_32x32x16_bf16(kf[2 * e], qf[d0], p0, 0, 0, 0); p1 = __builtin_amdgcn_mfma_f32_32x32x16_bf16(kf[2 * e + 1], qf[d0], p1, 0, 0, 0); } }
        }
        if (MODE == 1) {
            if (64 * t + 63 > qpos_wmin) {
#pragma unroll
                for (int r = 0; r < 16; ++r) { const int kv = 64 * t + crow(r, hi); if (kv > qpos) p0[r] = -INFINITY; if (kv + 32 > qpos) p1[r] = -INFINITY; }
            }
        } else if (MODE == 2) {
            const u64 w = wcur >> (4 * hi); const unsigned wl = (unsigned)w, wh = (unsigned)(w >> 32);
#pragma unroll
            for (int r = 0; r < 16; ++r) { const int bit = (r & 3) + 8 * (r >> 2);
                const unsigned s0 = (unsigned)__builtin_amdgcn_sbfe(wl, bit, 1), s1 = (unsigned)__builtin_amdgcn_sbfe(wh, bit, 1);
                p0[r] = __uint_as_float((__float_as_uint(p0[r]) & s0) | (ninf & ~s0)); p1[r] = __uint_as_float((__float_as_uint(p1[r]) & s1) | (ninf & ~s1)); }
        }
        asm volatile("s_nop 15\n\ts_nop 7" : "+v"(p0), "+v"(p1));
        float rm;
        { float a = max3f(p0[0], p0[1], p1[0]), b = max3f(p0[2], p0[3], p1[1]); a = max3f(a, p1[2], p1[3]);
#pragma unroll
          for (int r = 4; r < 16; r += 4) { a = max3f(a, p0[r], p0[r + 1]); b = max3f(b, p0[r + 2], p0[r + 3]); a = max3f(a, p1[r], p1[r + 1]); b = max3f(b, p1[r + 2], p1[r + 3]); }
          const float m = max2f(a, b);
          const auto rr = __builtin_amdgcn_permlane32_swap(__float_as_uint(m), __float_as_uint(m), false, false);
          rm = max2f(__uint_as_float(rr[0]), __uint_as_float(rr[1])); }
        if (t == 0 || __any(rm > THR)) {
            const float dl = (t == 0) ? ((rm > -INFINITY) ? rm : 0.f) : fmaxf(rm, 0.f);
            mhat += dl;
#pragma unroll
            for (int r = 0; r < 16; ++r) { p0[r] -= dl; p1[r] -= dl; negm[r] = -mhat; }
            const float f = __builtin_amdgcn_exp2f(-dl);
#pragma unroll
            for (int d0 = 0; d0 < DV / 32; ++d0)
#pragma unroll
                for (int r = 0; r < 16; ++r) o[d0][r] *= f;
#pragma unroll
            for (int r = 0; r < 16; ++r) lacc[r] *= f;
        }
#pragma unroll
        for (int r = 0; r < 16; ++r) { p0[r] = __builtin_amdgcn_exp2f(p0[r]); p1[r] = __builtin_amdgcn_exp2f(p1[r]); }
#if MK_AX == 2
        if (MODE == 1) {
#pragma unroll
            for (int r = 0; r < 16; ++r) { float e0 = __builtin_amdgcn_exp2f(p0[r] * 0.999f), e1 = __builtin_amdgcn_exp2f(p1[r] * 0.999f); asm volatile("" :: "v"(e0), "v"(e1)); } }
#endif
        bf16x8 pb[4];
#pragma unroll
        for (int ks = 0; ks < 4; ++ks) {
            u32x4 w;
            if (ks < 2) { w.x = cvtpk(p0[8 * ks + 0], p0[8 * ks + 1]); w.y = cvtpk(p0[8 * ks + 2], p0[8 * ks + 3]); w.z = cvtpk(p0[8 * ks + 4], p0[8 * ks + 5]); w.w = cvtpk(p0[8 * ks + 6], p0[8 * ks + 7]); }
            else { const int k2 = ks - 2; w.x = cvtpk(p1[8 * k2 + 0], p1[8 * k2 + 1]); w.y = cvtpk(p1[8 * k2 + 2], p1[8 * k2 + 3]); w.z = cvtpk(p1[8 * k2 + 4], p1[8 * k2 + 5]); w.w = cvtpk(p1[8 * k2 + 6], p1[8 * k2 + 7]); }
            pb[ks] = __builtin_bit_cast(bf16x8, w);
        }
#pragma unroll
        for (int ks = 0; ks < 4; ++ks) lacc = __builtin_amdgcn_mfma_f32_32x32x16_bf16(ones, pb[ks], lacc, 0, 0, 0);
#pragma unroll
        for (int d0 = 0; d0 < DV / 32; ++d0)
#pragma unroll
            for (int ks = 0; ks < 4; ++ks) {
                const s16x4 lo = vtr(Vl + buf * VBUF + vb + (16 * ks) * VP + d0 * 64);
                const s16x4 hh = vtr(Vl + buf * VBUF + vb + (16 * ks + 8) * VP + d0 * 64);
                const bf16x8 a = (bf16x8){lo[0], lo[1], lo[2], lo[3], hh[0], hh[1], hh[2], hh[3]};
                o[d0] = __builtin_amdgcn_mfma_f32_32x32x16_bf16(a, pb[ks], o[d0], 0, 0, 0);
#if MK_AX == 1
                if (MODE == 1) dmy_ = __builtin_amdgcn_mfma_f32_32x32x16_bf16(a, pb[ks], dmy_, 0, 0, 0);
#endif
            }
        if (t + 1 < ntiles) A_LSTORE((t + 1) & 1);
        __syncthreads();
    }
#if MK_AX == 1
    asm volatile("" :: "v"(dmy_));
#endif
    l_out = lacc[0];
#undef A_GLOAD
#undef A_LSTORE
#undef KSWZ
}
template <int DV>
DEVI void store_oT(const f32x16 (&o)[DV / 32], float inv, bf16_t* dst, int hi) {
#pragma unroll
    for (int d0 = 0; d0 < DV / 32; ++d0)
#pragma unroll
        for (int g4 = 0; g4 < 4; ++g4) {
            u32x2 w; w.x = cvtpk(o[d0][4 * g4 + 0] * inv, o[d0][4 * g4 + 1] * inv); w.y = cvtpk(o[d0][4 * g4 + 2] * inv, o[d0][4 * g4 + 3] * inv);
            *(u32x2*)(dst + 32 * d0 + 8 * g4 + 4 * hi) = w;
        }
}

DEVI void attnA_unit(const Params& P, int b, int h, int c, int qb, LAS unsigned char* lds) {
    const int tid = tid_opaque(), lane = tid & 63, wave = tid >> 6, r32 = lane & 31, hi = lane >> 5;
    unsigned char* ws = P.ws;
    const bf16_t* proj = (const bf16_t*)(ws + WS_PROJ);
    const int q = qb * 256 + 32 * wave + r32; const size_t row = (size_t)b * S + q;
    bf16x8 qf[4];
#pragma unroll
    for (int d0 = 0; d0 < 4; ++d0) qf[d0] = *(const bf16x8*)(proj + row * LDP + C_QA + (2 * h + c) * 64 + 16 * d0 + 8 * hi);
    f32x16 o[4];
#pragma unroll
    for (int d0 = 0; d0 < 4; ++d0)
#pragma unroll
        for (int r = 0; r < 16; ++r) o[d0][r] = 0.f;
    float l_run = 0.f;
    attn_core<64, 128, 1>(o, l_run, qf, proj + (size_t)b * S * LDP + C_KA + (2 * h + c) * 64, LDP, proj + (size_t)b * S * LDP + C_VA + h * 128, LDP,
                          4 * (qb + 1), q, qb * 256 + 32 * wave, nullptr, lds, tid);
    const float lt = l_run;
    bf16_t* oa = (bf16_t*)(ws + WS_XB) + (size_t)c * T * 512 + row * 512 + h * 128;
    store_oT<128>(o, 1.f / lt, oa, hi);
}
DEVI void attnB_unit(const Params& P, int b, int hd, int qb, LAS unsigned char* lds) {
    const int tid = tid_opaque(), lane = tid & 63, wave = tid >> 6, r32 = lane & 31, hi = lane >> 5;
    unsigned char* ws = P.ws;
    const bf16_t* proj = (const bf16_t*)(ws + WS_PROJ); const bf16_t* kbvb = (const bf16_t*)(ws + WS_KBVB);
    const int q = qb * 256 + 32 * wave + r32; const size_t row = (size_t)b * S + q;
    bf16x8 qf[4];
#pragma unroll
    for (int d0 = 0; d0 < 4; ++d0) qf[d0] = *(const bf16x8*)(proj + row * LDP + C_QB + hd * 64 + 16 * d0 + 8 * hi);
    f32x16 o[2];
#pragma unroll
    for (int d0 = 0; d0 < 2; ++d0)
#pragma unroll
        for (int r = 0; r < 16; ++r) o[d0][r] = 0.f;
    float l_run = 0.f;
    attn_core<64, 64, 2>(o, l_run, qf, kbvb + (size_t)b * S * 1024 + hd * 64, 1024, kbvb + (size_t)b * S * 1024 + 512 + hd * 64, 1024,
                         4 * (qb + 1), q, qb * 256 + 32 * wave, (const u64*)(ws + WS_MASK) + row * 64, lds, tid);
    const float lt = l_run;
    store_oT<64>(o, 1.f / lt, (bf16_t*)(ws + WS_Y) + row * 1024 + 512 + hd * 64, hi);
}
DEVI void xattn_unit(const Params& P, int l, int b, int hd, int qb, LAS unsigned char* lds) {
    const int tid = tid_opaque(), lane = tid & 63, wave = tid >> 6, r32 = lane & 31, hi = lane >> 5;
    unsigned char* ws = P.ws;
    const bf16_t* qx = (const bf16_t*)(ws + WS_QX); const bf16_t* kvx = (const bf16_t*)(ws + WS_KVX) + l * 1024;
    const int q = qb * 256 + 32 * wave + r32; const size_t row = (size_t)b * S + q;
    const float* gq = P.in[9] + l * 128;
    u32x4 raw[8]; float ss = 0.f;
    f32x4 gqv[8][2];
#pragma unroll
    for (int d0 = 0; d0 < 8; ++d0) { raw[d0] = *(const u32x4*)(qx + row * 512 + hd * 128 + 16 * d0 + 8 * hi); gqv[d0][0] = *(const f32x4*)(gq + 16 * d0 + 8 * hi); gqv[d0][1] = *(const f32x4*)(gq + 16 * d0 + 8 * hi + 4); }
#pragma unroll
    for (int d0 = 0; d0 < 8; ++d0) {
#pragma unroll
        for (int j = 0; j < 4; ++j) { const float a = lo16(raw[d0][j]), bq = hi16(raw[d0][j]); ss += a * a + bq * bq; } }
    ss += __shfl_xor(ss, 32);
    const float rs = rsqrtf(ss * (1.f / 128.f) + EPS) * (0.08838834764831845f * LOG2E);
    bf16x8 qf[8];
#pragma unroll
    for (int d0 = 0; d0 < 8; ++d0) { u32x4 w;
#pragma unroll
        for (int j = 0; j < 4; ++j) w[j] = cvtpk(lo16(raw[d0][j]) * rs * gqv[d0][j >> 1][(2 * j) & 3], hi16(raw[d0][j]) * rs * gqv[d0][j >> 1][(2 * j + 1) & 3]);
        qf[d0] = __builtin_bit_cast(bf16x8, w); }
    f32x16 o[4];
#pragma unroll
    for (int d0 = 0; d0 < 4; ++d0)
#pragma unroll
        for (int r = 0; r < 16; ++r) o[d0][r] = 0.f;
    float l_run = 0.f;
#if MK_XA2
    attn_core<128, 128, 0>(o, l_run, qf, kvx + (size_t)b * MEML * 2048 + hd * 128, 2048, kvx + (size_t)b * MEML * 2048 + 512 + hd * 128, 2048, MEML / 64, q, 0, nullptr, lds, tid);
#pragma unroll
    for (int d0 = 0; d0 < 4; ++d0)
#pragma unroll
        for (int r = 0; r < 16; ++r) o[d0][r] = 0.f;
    l_run = 0.f;
#endif
    attn_core<128, 128, 0>(o, l_run, qf, kvx + (size_t)b * MEML * 2048 + hd * 128, 2048, kvx + (size_t)b * MEML * 2048 + 512 + hd * 128, 2048,
                           MEML / 64, q, 0, nullptr, lds, tid);
    const float lt = l_run;
    store_oT<128>(o, 1.f / lt, (bf16_t*)(ws + WS_YX) + row * 512 + hd * 128, hi);
}

DEVI void xattn_fused_unit(const Params& P, int l, int b, int hd, int qb, LAS unsigned char* lds) {
    const int tid = tid_opaque(), lane = tid & 63, wave = tid >> 6, r32 = lane & 31, hi = lane >> 5;
    unsigned char* ws = P.ws;
    const bf16_t* kvx = (const bf16_t*)(ws + WS_KVX) + l * 1024;
    const int q = qb * 256 + 32 * wave + r32; const size_t row = (size_t)b * S + q;
    const bf16_t* Wh = (const bf16_t*)(ws + W_QX) + (size_t)l * 512 * 1024 + (size_t)(hd * 128) * 1024;
    const float ssqx = ((const float*)(ws + WS_SSQ))[(size_t)(l ? 4 : 1) * T + row];
    const float* gq = P.in[9] + l * 128;
#if MK_TPROBE >= 30
    unsigned long long tsx_[5]; tsx_[0] = __builtin_amdgcn_s_memtime();
#endif
    f32x16 acc[4];
#pragma unroll
    for (int blk = 0; blk < 4; ++blk)
#pragma unroll
        for (int r = 0; r < 16; ++r) acc[blk][r] = 0.f;
    u32x4 wa[2], wb[2], xr[4];
    const bf16_t* Xb = (const bf16_t*)(ws + WS_XB) + ((size_t)b * S + qb * 256) * 1024;
    LAS unsigned char* XL = lds + 49152;
#define XF_WLOAD(W_, s) do { _Pragma("unroll") for (int i_ = 0; i_ < 2; ++i_) { const int c_ = tid + NTHR * i_; W_[i_] = *(const u32x4*)(Wh + (size_t)(c_ >> 3) * 1024 + 64 * (s) + (c_ & 7) * 8); } } while (0)
#define XF_WSTORE(W_, buf) do { _Pragma("unroll") for (int i_ = 0; i_ < 2; ++i_) { const int c_ = tid + NTHR * i_, row_ = c_ >> 3, ch_ = c_ & 7; *(LAS u32x4*)(lds + (buf) * 16384 + row_ * 128 + ((ch_ ^ ((row_ >> 1) & 7)) << 4)) = W_[i_]; } } while (0)
#define XF_XLOAD(s) do { _Pragma("unroll") for (int i_ = 0; i_ < 4; ++i_) { const int c_ = tid + NTHR * i_; xr[i_] = *(const u32x4*)(Xb + (size_t)(c_ >> 3) * 1024 + 64 * (s) + (c_ & 7) * 8); } } while (0)
#define XF_XSTORE(buf) do { _Pragma("unroll") for (int i_ = 0; i_ < 4; ++i_) { const int c_ = tid + NTHR * i_, row_ = c_ >> 3, ch_ = c_ & 7; *(LAS u32x4*)(XL + (buf) * 32768 + row_ * 128 + ((ch_ ^ ((row_ >> 1) & 7)) << 4)) = xr[i_]; } } while (0)
#define XF_MMA(wbuf, xbuf) do { bf16x8 wf_[4][4], xq_[4];        \
        _Pragma("unroll") for (int ks = 0; ks < 4; ++ks) { const int xrow = 32 * wave + r32, ch = 2 * ks + hi; \
            xq_[ks] = *(LAS const bf16x8*)(XL + (xbuf) * 32768 + xrow * 128 + ((ch ^ ((xrow >> 1) & 7)) << 4)); \
            _Pragma("unroll") for (int blk = 0; blk < 4; ++blk) { const int rw = 32 * blk + r32; \
                wf_[ks][blk] = *(LAS const bf16x8*)(lds + (wbuf) * 16384 + rw * 128 + ((ch ^ ((rw >> 1) & 7)) << 4)); } } \
        asm volatile("s_waitcnt lgkmcnt(0)" ::: "memory"); __builtin_amdgcn_sched_barrier(0); \
        _Pragma("unroll") for (int ks = 0; ks < 4; ++ks) _Pragma("unroll") for (int blk = 0; blk < 4; ++blk) acc[blk] = __builtin_amdgcn_mfma_f32_32x32x16_bf16(wf_[ks][blk], xq_[ks], acc[blk], 0, 0, 0); \
        __builtin_amdgcn_sched_barrier(0); } while (0)
    XF_WLOAD(wa, 0); XF_WLOAD(wb, 1); XF_XLOAD(0);
    XF_WSTORE(wa, 0); XF_WSTORE(wb, 1); XF_XSTORE(0); __syncthreads();
    for (int s = 0; s < 16; s += 2) {
        if (s + 2 < 16) XF_WLOAD(wa, s + 2);
        XF_XLOAD(s + 1);
        XF_MMA(s % 3, 0);
        if (s + 2 < 16) XF_WSTORE(wa, (s + 2) % 3);
        XF_XSTORE(1);
        __syncthreads();
        if (s + 3 < 16) XF_WLOAD(wb, s + 3);
        if (s + 2 < 16) XF_XLOAD(s + 2);
        XF_MMA((s + 1) % 3, 1);
        if (s + 3 < 16) XF_WSTORE(wb, (s + 3) % 3);
        if (s + 2 < 16) XF_XSTORE(0);
        __syncthreads();
    }
#undef XF_WLOAD
#undef XF_WSTORE
#undef XF_XLOAD
#undef XF_XSTORE
#undef XF_MMA
#if MK_TPROBE >= 30
    asm volatile("s_waitcnt vmcnt(0) lgkmcnt(0)" ::: "memory"); tsx_[1] = __builtin_amdgcn_s_memtime();
#endif
    f32x4 gqv[4][4];
#pragma unroll
    for (int blk = 0; blk < 4; ++blk)
#pragma unroll
        for (int g4 = 0; g4 < 4; ++g4) gqv[blk][g4] = *(const f32x4*)(gq + 32 * blk + 8 * g4 + 4 * hi);
    float ss = 0.f;
#pragma unroll
    for (int blk = 0; blk < 4; ++blk)
#pragma unroll
        for (int r = 0; r < 16; ++r) ss += acc[blk][r] * acc[blk][r];
    { const auto sw = __builtin_amdgcn_permlane32_swap(__float_as_uint(ss), __float_as_uint(ss), false, false); ss = __uint_as_float(sw[0]) + __uint_as_float(sw[1]); }
    const float c = rsqrtf(ssqx * (1.f / 1024.f) + EPS);
    const float f = c * rsqrtf(c * c * ss * (1.f / 128.f) + EPS) * (0.08838834764831845f * LOG2E);
    bf16x8 qf[8];
#pragma unroll
    for (int blk = 0; blk < 4; ++blk)
#pragma unroll
        for (int e = 0; e < 2; ++e) { u32x4 w;
#pragma unroll
            for (int jj = 0; jj < 4; ++jj) { const int r0 = 8 * e + 2 * jj;
                w[jj] = cvtpk(acc[blk][r0] * f * gqv[blk][r0 >> 2][r0 & 3], acc[blk][r0 + 1] * f * gqv[blk][r0 >> 2][(r0 & 3) + 1]); }
            qf[2 * blk + e] = __builtin_bit_cast(bf16x8, w); }
    f32x16 o[4];
#pragma unroll
    for (int d0 = 0; d0 < 4; ++d0)
#pragma unroll
        for (int r = 0; r < 16; ++r) o[d0][r] = 0.f;
    float l_run = 0.f;
#if MK_TPROBE >= 30
    asm volatile("s_waitcnt vmcnt(0) lgkmcnt(0)" ::: "memory"); tsx_[2] = __builtin_amdgcn_s_memtime();
#endif
    attn_core<128, 128, 0, true>(o, l_run, qf, kvx + (size_t)b * MEML * 2048 + hd * 128, 2048, kvx + (size_t)b * MEML * 2048 + 512 + hd * 128, 2048,
                                 MEML / 64, q, 0, nullptr, lds, tid);
#if MK_TPROBE >= 30
    asm volatile("s_waitcnt vmcnt(0) lgkmcnt(0)" ::: "memory"); tsx_[3] = __builtin_amdgcn_s_memtime();
#endif
    store_oT<128>(o, 1.f / l_run, (bf16_t*)(ws + WS_YX) + row * 512 + hd * 128, hi);
#if MK_TPROBE >= 30
    asm volatile("s_waitcnt vmcnt(0) lgkmcnt(0)" ::: "memory"); tsx_[4] = __builtin_amdgcn_s_memtime();
    if (blockIdx.x == 0 && tid == 0 && l == 0) { unsigned long long* TS = (unsigned long long*)(ws + WS_BAR + 65536); for (int k = 0; k < 4; ++k) atomicAdd(TS + 16 + k, tsx_[k + 1] - tsx_[k]); atomicAdd(TS + 20, tsx_[4] - tsx_[0]); }
#endif
}

#define DPP_STEP4(OP, v) do { v = OP(v, __builtin_amdgcn_update_dpp(v, v, 0xB1, 0xF, 0xF, false)); v = OP(v, __builtin_amdgcn_update_dpp(v, v, 0x4E, 0xF, 0xF, false)); \
        v = OP(v, __builtin_amdgcn_update_dpp(v, v, 0x141, 0xF, 0xF, false)); v = OP(v, __builtin_amdgcn_update_dpp(v, v, 0x140, 0xF, 0xF, false)); } while (0)
DEVI unsigned umax2(unsigned a, unsigned b) { return a > b ? a : b; }
DEVI unsigned umin2(unsigned a, unsigned b) { return a < b ? a : b; }
DEVI unsigned wave_max_u32(unsigned v) { DPP_STEP4(umax2, v);
    const auto a = __builtin_amdgcn_permlane16_swap(v, v, false, false); v = umax2(a[0], a[1]);
    const auto b = __builtin_amdgcn_permlane32_swap(v, v, false, false); return umax2(b[0], b[1]); }
DEVI unsigned wave_min_u32(unsigned v) { DPP_STEP4(umin2, v);
    const auto a = __builtin_amdgcn_permlane16_swap(v, v, false, false); v = umin2(a[0], a[1]);
    const auto b = __builtin_amdgcn_permlane32_swap(v, v, false, false); return umin2(b[0], b[1]); }
DEVI float row16_sum(float s) {
    s += __builtin_bit_cast(float, __builtin_amdgcn_update_dpp(0, __builtin_bit_cast(int, s), 0xB1, 0xF, 0xF, false)); s += __builtin_bit_cast(float, __builtin_amdgcn_update_dpp(0, __builtin_bit_cast(int, s), 0x4E, 0xF, 0xF, false));
    s += __builtin_bit_cast(float, __builtin_amdgcn_update_dpp(0, __builtin_bit_cast(int, s), 0x141, 0xF, 0xF, false)); s += __builtin_bit_cast(float, __builtin_amdgcn_update_dpp(0, __builtin_bit_cast(int, s), 0x140, 0xF, 0xF, false));
    return s; }
DEVI int wave_sum_dpp(int v) {
    v += __builtin_amdgcn_update_dpp(0, v, 0xB1, 0xF, 0xF, false);
    v += __builtin_amdgcn_update_dpp(0, v, 0x4E, 0xF, 0xF, false);
    v += __builtin_amdgcn_update_dpp(0, v, 0x141, 0xF, 0xF, false);
    v += __builtin_amdgcn_update_dpp(0, v, 0x140, 0xF, 0xF, false);
    return (__builtin_amdgcn_readlane(v, 0) + __builtin_amdgcn_readlane(v, 16)) + (__builtin_amdgcn_readlane(v, 32) + __builtin_amdgcn_readlane(v, 48));
}
constexpr int IDX_SROW = 4096 + 64;
DEVI void indexer_unit(const Params& P, int b, int t0, LAS unsigned char* lds) {
    const int tid = tid_opaque(), lane = tid & 63, wave = __builtin_amdgcn_readfirstlane(tid >> 6), r32 = lane & 31, hi = lane >> 5;
    unsigned char* ws = P.ws;
    const bf16_t* proj = (const bf16_t*)(ws + WS_PROJ); const float* WI = (const float*)(ws + WS_WI);
    LAS float* Ssc = (LAS float*)lds;
    for (int rs_ = 0; rs_ < 1 + MK_SC2; ++rs_)
    if (t0 + 7 >= 255) {
        bf16x8 af[4];
        { const int qq = r32 >> 2, hh = r32 & 3; const size_t row = (size_t)b * S + t0 + qq;
#pragma unroll
          for (int d0 = 0; d0 < 4; ++d0) af[d0] = *(const bf16x8*)(proj + row * LDP + C_QI + hh * 64 + 16 * d0 + 8 * hi); }
        float wv[16];
#pragma unroll
        for (int r = 0; r < 16; ++r) wv[r] = WI[((size_t)b * S + t0 + 2 * (r >> 2) + hi) * 4 + (r & 3)];
        const int nkt = (t0 + 8 + 31) / 32;
        const bf16_t* kbase = (const bf16_t*)(ws + WS_KI) + (size_t)(b * (S / 32)) * 2048 + lane * 8;
        bf16x8 kb0[4], kb1[4], kb2[4], kb3[4];
#define IDX_LOAD(B, kt_) do { const int k_ = ((kt_) < nkt) ? (kt_) : (nkt - 1); _Pragma("unroll") for (int d0 = 0; d0 < 4; ++d0) B[d0] = *(const bf16x8*)(kbase + (size_t)k_ * 2048 + d0 * 512); } while (0)
#define IDX_COMP(B, kt_) do { f32x16 c; _Pragma("unroll") for (int r = 0; r < 16; ++r) c[r] = 0.f; \
            _Pragma("unroll") for (int d0 = 0; d0 < 4; ++d0) c = __builtin_amdgcn_mfma_f32_32x32x16_bf16(af[d0], B[d0], c, 0, 0, 0); \
            const int key = (kt_) * 32 + r32; \
            _Pragma("unroll") for (int g4 = 0; g4 < 4; ++g4) { float s = 0.f; \
                _Pragma("unroll") for (int hh = 0; hh < 4; ++hh) s += fmaxf(c[4 * g4 + hh], 0.f) * wv[4 * g4 + hh]; \
                Ssc[(2 * g4 + hi) * IDX_SROW + key + (key >> 6)] = s; } } while (0)
#define IDX_FENCE() asm volatile("" ::: "memory")
        IDX_LOAD(kb0, wave); IDX_LOAD(kb1, wave + NWAVE); IDX_LOAD(kb2, wave + 2 * NWAVE); IDX_FENCE();
        for (int kt = wave; kt < nkt; kt += 4 * NWAVE) {
            IDX_LOAD(kb3, kt + 3 * NWAVE); IDX_FENCE(); IDX_COMP(kb0, kt); IDX_FENCE();
            if (kt + NWAVE >= nkt) break;
            IDX_LOAD(kb0, kt + 4 * NWAVE); IDX_FENCE(); IDX_COMP(kb1, kt + NWAVE); IDX_FENCE();
            if (kt + 2 * NWAVE >= nkt) break;
            IDX_LOAD(kb1, kt + 5 * NWAVE); IDX_FENCE(); IDX_COMP(kb2, kt + 2 * NWAVE); IDX_FENCE();
            if (kt + 3 * NWAVE >= nkt) break;
            IDX_LOAD(kb2, kt + 6 * NWAVE); IDX_FENCE(); IDX_COMP(kb3, kt + 3 * NWAVE); IDX_FENCE();
        }
#undef IDX_FENCE
#undef IDX_LOAD
#undef IDX_COMP
    }
    __syncthreads();
    for (int rr_ = 0; rr_ < 1 + MK_SEL2; ++rr_) {
        const int t = t0 + wave; u64 myw = 0ull;
#if MK_TPROBE
        unsigned long long ts0_ = __builtin_amdgcn_s_memtime(), ts1_ = ts0_, ts2_ = ts0_;
#endif
        if (t >= 255) {
            unsigned u[64];
            { const LAS float* srow = Ssc + wave * IDX_SROW + 65 * lane;
              const int jmax = t - 64 * lane;
#pragma unroll
              for (int j = 0; j < 64; ++j) { const unsigned bits = __float_as_uint(srow[j]);
                  const unsigned key = bits ^ ((unsigned)((int)bits >> 31) | 0x80000000u);
                  u[j] = (j > jmax) ? 0u : key; } }
            unsigned a32[32], a16[16], a8[8], a4[4];
#pragma unroll
            for (int i = 0; i < 32; ++i) a32[i] = max(u[2 * i], u[2 * i + 1]);
#pragma unroll
            for (int i = 0; i < 16; ++i) a16[i] = max(a32[2 * i], a32[2 * i + 1]);
#pragma unroll
            for (int i = 0; i < 8; ++i) a8[i] = max(a16[2 * i], a16[2 * i + 1]);
#pragma unroll
            for (int i = 0; i < 4; ++i) a4[i] = max(a8[2 * i], a8[2 * i + 1]);
            unsigned Mx = max(max(a4[0], a4[1]), max(a4[2], a4[3])), Lx = 0xffffffffu;
            { const int nfull = __builtin_amdgcn_readfirstlane((t + 1) >> 6); int nl;
              if (nfull >= 64) { nl = 64; Lx = min(min(a4[0], a4[1]), min(a4[2], a4[3])); }
              else if (nfull >= 32) { nl = 32;
#pragma unroll
                  for (int i = 0; i < 8; ++i) Lx = min(Lx, a8[i]); }
              else if (nfull >= 16) { nl = 16;
#pragma unroll
                  for (int i = 0; i < 16; ++i) Lx = min(Lx, a16[i]); }
              else if (nfull >= 8) { nl = 8;
#pragma unroll
                  for (int i = 0; i < 32; ++i) Lx = min(Lx, a32[i]); }
              else { nl = 4;
#pragma unroll
                  for (int j = 0; j < 64; ++j) Lx = min(Lx, u[j]); }
              if (lane >= nl) Lx = 0xffffffffu;
              Mx = wave_max_u32(Mx); Lx = wave_min_u32(Lx); }
            Mx = __builtin_amdgcn_readfirstlane(Mx); Lx = __builtin_amdgcn_readfirstlane(Lx);
#if MK_TPROBE
            asm volatile("s_waitcnt vmcnt(0) lgkmcnt(0)" ::: "memory"); ts1_ = __builtin_amdgcn_s_memtime();
#endif
#pragma unroll
            for (int j = 0; j < 64; ++j) u[j] = (u[j] >= Lx) ? (u[j] - Lx + 1u) : 0u;
            unsigned prefix = 0u; bool exact = false;
            for (int rb_ = 0; rb_ < 1 + MK_BIS2; ++rb_) { prefix = 0u; exact = false;
            for (int bit = 31 - __builtin_clz(Mx - Lx + 1u); bit >= 0; --bit) {
                const unsigned cand = prefix | (1u << bit); int c0 = 0, c1 = 0, c2 = 0, c3 = 0;
#define IDX_CNT8(j0) asm volatile( \
                    "v_cmp_le_u32 vcc, %10, %2\n\tv_addc_co_u32 %0, vcc, 0, %0, vcc\n\tv_cmp_le_u32 vcc, %10, %3\n\tv_addc_co_u32 %1, vcc, 0, %1, vcc\n\t" \
                    "v_cmp_le_u32 vcc, %10, %4\n\tv_addc_co_u32 %0, vcc, 0, %0, vcc\n\tv_cmp_le_u32 vcc, %10, %5\n\tv_addc_co_u32 %1, vcc, 0, %1, vcc\n\t" \
                    "v_cmp_le_u32 vcc, %10, %6\n\tv_addc_co_u32 %0, vcc, 0, %0, vcc\n\tv_cmp_le_u32 vcc, %10, %7\n\tv_addc_co_u32 %1, vcc, 0, %1, vcc\n\t" \
                    "v_cmp_le_u32 vcc, %10, %8\n\tv_addc_co_u32 %0, vcc, 0, %0, vcc\n\tv_cmp_le_u32 vcc, %10, %9\n\tv_addc_co_u32 %1, vcc, 0, %1, vcc" \
                    : "+v"(c0), "+v"(c1) \
                    : "v"(u[(j0)]), "v"(u[(j0) + 1]), "v"(u[(j0) + 2]), "v"(u[(j0) + 3]), "v"(u[(j0) + 4]), "v"(u[(j0) + 5]), "v"(u[(j0) + 6]), "v"(u[(j0) + 7]), "v"(candv) : "vcc")
                const unsigned candv = cand;
                IDX_CNT8(0); IDX_CNT8(8); IDX_CNT8(16); IDX_CNT8(24); IDX_CNT8(32); IDX_CNT8(40); IDX_CNT8(48); IDX_CNT8(56);
#undef IDX_CNT8
                c2 = 0; c3 = 0;
                const int cnt = wave_sum_dpp((c0 + c1) + (c2 + c3));
                if (cnt >= 256) prefix = cand;
                if (cnt == 256) { exact = true; break; }
            }
            }
#if MK_TPROBE
            asm volatile("s_waitcnt vmcnt(0) lgkmcnt(0)" ::: "memory"); ts2_ = __builtin_amdgcn_s_memtime();
#endif
            unsigned mlo = 0u, mhi = 0u;
            if (exact) {
#pragma unroll
                for (int j = 31; j >= 0; --j) asm volatile("v_cmp_le_u32 vcc, %4, %2\n\tv_addc_co_u32 %0, vcc, %0, %0, vcc\n\tv_cmp_le_u32 vcc, %4, %3\n\tv_addc_co_u32 %1, vcc, %1, %1, vcc"
                                                           : "+v"(mlo), "+v"(mhi) : "v"(u[j]), "v"(u[32 + j]), "v"(prefix) : "vcc");
            } else {
                int ngt = 0, nti = 0;
#pragma unroll
                for (int j = 0; j < 64; ++j) { ngt += (u[j] > prefix) ? 1 : 0; nti += (u[j] == prefix) ? 1 : 0; }
                const int need = 256 - (int)wave_sum((float)ngt);
                int incl = nti;
#pragma unroll
                for (int o = 1; o < 64; o <<= 1) { const int v = __shfl_up(incl, o); if (lane >= o) incl += v; }
                int running = incl - nti;
#pragma unroll
                for (int j = 0; j < 64; ++j) {
                    const bool tie = (u[j] == prefix);
                    const unsigned sel = ((u[j] > prefix) || (tie && running < need)) ? 1u : 0u;
                    running += tie ? 1 : 0;
                    if (j < 32) mlo |= sel << j; else mhi |= sel << (j - 32);
                }
            }
            myw = ((u64)mhi << 32) | mlo;
        } else {
            const int lo = 64 * lane;
            if (lo + 63 <= t) myw = ~0ull; else if (lo > t) myw = 0ull; else myw = (~0ull) >> (63 - (t - lo));
        }
        ((u64*)(ws + WS_MASK))[((size_t)b * S + t) * 64 + lane] = myw;
#if MK_TPROBE
        { asm volatile("s_waitcnt vmcnt(0) lgkmcnt(0)" ::: "memory"); const unsigned long long ts3_ = __builtin_amdgcn_s_memtime();
          if (blockIdx.x == 0 && wave == 0 && lane == 0 && t >= 255) { unsigned long long* TS = (unsigned long long*)(ws + WS_BAR + 65536);
              atomicAdd(TS + 0, ts1_ - ts0_); atomicAdd(TS + 1, ts2_ - ts1_); atomicAdd(TS + 2, ts3_ - ts2_); atomicAdd(TS + 3, ts3_ - ts0_); } }
#endif
    }
    __syncthreads();
}

DEVI void combineA_rows(const Params& P) {
    const int tid = tid_opaque(), lane = tid & 63, wave = tid >> 6;
    const int gw = blockIdx.x * NWAVE + wave, NGW = gridDim.x * NWAVE;
    unsigned char* ws = P.ws;
    const float d1 = wave_sum(P.in[17][lane] * P.in[18][lane]), d2 = wave_sum(P.in[19][lane] * P.in[20][lane]);
    const float lam_init = 0.2f, lam = expf(d1) - expf(d2) + lam_init;
    const bf16_t* o0 = (const bf16_t*)(ws + WS_XB); const bf16_t* o1 = o0 + (size_t)T * 512;
    const float* gs = P.in[21] + 8 * (lane & 15);
    for (int m0 = gw; m0 < T; m0 += 4 * NGW) {
        u32x4 a[4], bq[4];
#pragma unroll
        for (int k = 0; k < 4; ++k) { const int m = (m0 + k * NGW < T) ? m0 + k * NGW : m0; a[k] = *(const u32x4*)(o0 + (size_t)m * 512 + 8 * lane); bq[k] = *(const u32x4*)(o1 + (size_t)m * 512 + 8 * lane); }
#pragma unroll
        for (int k = 0; k < 4; ++k) { const int m = m0 + k * NGW; if (m >= T) break;
            float v[8]; float ss = 0.f;
#pragma unroll
            for (int j = 0; j < 4; ++j) { v[2 * j] = lo16(a[k][j]) - lam * lo16(bq[k][j]); v[2 * j + 1] = hi16(a[k][j]) - lam * hi16(bq[k][j]); ss += v[2 * j] * v[2 * j] + v[2 * j + 1] * v[2 * j + 1]; }
            ss = row16_sum(ss);
            const float rs = rsqrtf(ss * (1.f / 128.f) + EPS) * (1.f - lam_init);
            u32x4 w;
#pragma unroll
            for (int j = 0; j < 4; ++j) w[j] = cvtpk(v[2 * j] * rs * gs[2 * j], v[2 * j + 1] * rs * gs[2 * j + 1]);
            *(u32x4*)((bf16_t*)(ws + WS_Y) + (size_t)m * 1024 + 8 * lane) = w; }
    }
}

template <int W>
DEVI void pool_item(const bf16_t* pr, bf16_t* y, int m, int c0) {
    const int t = m & (S - 1);
    u32x4 z[W];
#pragma unroll
    for (int dt = 0; dt < W; ++dt) z[dt] = *(const u32x4*)(pr + (size_t)(m - ((dt <= t) ? dt : t)) * 2048 + 1536 + c0);
    float sum[8];
#pragma unroll
    for (int j = 0; j < 8; ++j) sum[j] = 0.f;
#pragma unroll
    for (int dt = 0; dt < W; ++dt) { const float wgt = (dt <= t) ? 1.f : 0.f;
#pragma unroll
        for (int j = 0; j < 4; ++j) { sum[2 * j] += wgt * lo16(z[dt][j]); sum[2 * j + 1] += wgt * hi16(z[dt][j]); } }
    const float inv = 1.f / (float)((t + 1 < W) ? (t + 1) : W); u32x4 w;
#pragma unroll
    for (int j = 0; j < 4; ++j) w[j] = cvtpk(sum[2 * j] * inv - lo16(z[0][j]), sum[2 * j + 1] * inv - hi16(z[0][j]));
    *(u32x4*)(y + (size_t)m * 1024 + 512 + c0) = w;
}
DEVI void phase_mix1(const Params& P) {
    const int gt = blockIdx.x * NTHR + tid_opaque(), NGT = gridDim.x * NTHR;
    unsigned char* ws = P.ws;
    const bf16_t* pr = (const bf16_t*)(ws + WS_PROJ1);
    bf16_t* y = (bf16_t*)(ws + WS_Y);
    const float* cw = P.in[29];
    for (int it0 = gt; it0 < T * 64; it0 += 2 * NGT) {
        u32x4 gc[2][3], hc[2][3], gb[2];
#pragma unroll
        for (int k = 0; k < 2; ++k) { const int it = (it0 + k * NGT < T * 64) ? it0 + k * NGT : it0; const int m = it >> 6, c0 = 8 * (it & 63), t = m & (S - 1);
#pragma unroll
            for (int dt = 0; dt < 3; ++dt) { const size_t r = (size_t)(m - ((dt <= t) ? dt : t)) * 2048; gc[k][dt] = *(const u32x4*)(pr + r + 512 + c0); hc[k][dt] = *(const u32x4*)(pr + r + 1024 + c0); }
            gb[k] = *(const u32x4*)(pr + (size_t)m * 2048 + c0); }
#pragma unroll
        for (int k = 0; k < 2; ++k) { const int it = it0 + k * NGT; if (it >= T * 64) break; const int m = it >> 6, c0 = 8 * (it & 63), t = m & (S - 1);
            float wgt[3][8];
#pragma unroll
            for (int dt = 0; dt < 3; ++dt) { float tmp[8]; load8(tmp, cw + (2 - dt) * 512 + c0); const float on = (dt <= t) ? 1.f : 0.f;
#pragma unroll
                for (int j = 0; j < 8; ++j) wgt[dt][j] = tmp[j] * on; }
            u32x4 w;
#pragma unroll
            for (int j = 0; j < 4; ++j) { float a = 0.f, b = 0.f;
#pragma unroll
                for (int dt = 0; dt < 3; ++dt) { a += wgt[dt][2 * j] * (lo16(gc[k][dt][j]) * lo16(hc[k][dt][j])); b += wgt[dt][2 * j + 1] * (hi16(gc[k][dt][j]) * hi16(hc[k][dt][j])); }
                w[j] = cvtpk(lo16(gb[k][j]) * a, hi16(gb[k][j]) * b); }
            *(u32x4*)(y + (size_t)m * 1024 + c0) = w; }
    }
    for (int it = gt; it < T * 16; it += NGT) { const int m = it >> 4, cj = 8 * (it & 15);
        pool_item<2>(pr, y, m, cj); pool_item<4>(pr, y, m, 128 + cj); asm volatile("" ::: "memory"); pool_item<8>(pr, y, m, 256 + cj); asm volatile("" ::: "memory"); pool_item<16>(pr, y, m, 384 + cj); asm volatile("" ::: "memory"); }
}

DEVI float sum_rows4(float s) {
    const auto a = __builtin_amdgcn_permlane16_swap(__float_as_uint(s), __float_as_uint(s), false, false);
    const float s2 = __uint_as_float(a[0]) + __uint_as_float(a[1]);
    const auto b = __builtin_amdgcn_permlane32_swap(__float_as_uint(s2), __float_as_uint(s2), false, false);
    return __uint_as_float(b[0]) + __uint_as_float(b[1]);
}
namespace pg8 {
#define PG8_LAS __attribute__((address_space(3)))
typedef unsigned short bf16_t;
typedef short bf16x8 __attribute__((ext_vector_type(8)));
typedef float f32x4 __attribute__((ext_vector_type(4)));
typedef unsigned u32x4 __attribute__((ext_vector_type(4)));
constexpr int BM = 256, BK = 64, HALF = 128, HTB = HALF * BK * 2  , STAGE_BYTES = 8 * HTB, NXCD = 8, WGM = 8;

__host__ __device__ __forceinline__ int lds_byte(int r, int c) { const int st = (r >> 4) * 2 + (c >> 5), rr = r & 15, cc = c & 31, ob = rr * 64 + cc * 2; return st * 1024 + (ob ^ (((ob >> 9) & 1) << 5)); }
__host__ __device__ __forceinline__ void stage_rc(int b, int& R, int& C) { const int st = b / 1024, sb = b % 1024, swz = sb ^ (((sb >> 9) & 1) << 5); R = (st >> 1) * 16 + swz / 64; C = (st & 1) * 32 + (swz % 64) / 2; }
__host__ __device__ __forceinline__ int perm32(int rho) { const int n = rho >> 4, i = rho & 15; return 8 * (i >> 2) + 4 * n + (i & 3); }

struct Unit { int pm, pn; };
struct Gemm { const bf16_t* A; int lda; const bf16_t* Bt; int M, N, K; };

struct StaticOrder {
    int nM, nN, nwg, G, c;
    __host__ __device__ void init(int M, int N, int G_, int c_) { nM = M / BM; nN = N / BM; nwg = nM * nN; G = G_; c = c_; }
    __host__ __device__ bool next(int i, Unit& u) const {
        const long L = (long)i * G + c; if (L >= nwg) return false;
        int wgid = (int)L; { const int q = nwg / NXCD, r = nwg % NXCD, xcd = wgid % NXCD, off = wgid / NXCD; wgid = (xcd < r ? xcd * (q + 1) : r * (q + 1) + (xcd - r) * q) + off; }
        const int nig = WGM * nN, gid = wgid / nig, fm = gid * WGM, gsz = (nM - fm) < WGM ? (nM - fm) : WGM;
        u.pm = fm + ((wgid % nig) % gsz); u.pn = (wgid % nig) / gsz; return true;
    }
    __device__ __forceinline__ void a_ready(const Unit&) const {}
    __device__ __forceinline__ void done(const Unit&) const {}
};
template <class Epi, class Sched, bool ALIGN_EPI = false, bool SP2 = false>
__device__ __forceinline__ void gemm_phase(PG8_LAS unsigned char* lds, const Gemm g, const Sched& S, const Epi& E) {
    const int tid = tid_opaque(), wid = __builtin_amdgcn_readfirstlane(tid >> 6), lane = tid & 63, wr = wid >> 2, wc = wid & 3, fr = lane & 15, fq = lane >> 4;
    const int K = g.K, nt = K / BK;
    unsigned voffA[2], voffB[2];
#pragma unroll
    for (int i = 0; i < 2; ++i) { int R, C; stage_rc(tid * 16 + i * 8192, R, C); const int Rb = Epi::PERM ? ((R & ~31) + perm32(R & 31)) : R;
        voffA[i] = (unsigned)(R * g.lda + C) * 2u; voffB[i] = (unsigned)(Rb * K + C) * 2u; }
    const size_t kstep = (size_t)(BK * 2);
    const size_t hstepA = (size_t)HALF * g.lda * 2, hstepB = (size_t)HALF * K * 2;
    const size_t tstepA = 2 * hstepA, tstepB = 2 * hstepB;
    const unsigned ldsw = (unsigned)wid * 1024u;
    const int aoff = lds_byte(wr * 64 + fr, fq * 8), boff = lds_byte(wc * 32 + fr, fq * 8);
#define PG8_SA(b, h) (((b) * 2 + (h)) * HTB)
#define PG8_SB(b, h) ((4 + (b) * 2 + (h)) * HTB)
#define PG8_STAGE(bufoff, gbase, voff) do { _Pragma("unroll") for (int _i = 0; _i < 2; ++_i) \
        __builtin_amdgcn_global_load_lds((const unsigned*)((const char*)(gbase) + (voff)[_i]), (PG8_LAS unsigned*)(lds + (bufoff) + ldsw + _i * 8192), 16, 0, 0); } while (0)
#define PG8_LDA(dst, b, h) do { _Pragma("unroll") for (int m = 0; m < 4; ++m) _Pragma("unroll") for (int k = 0; k < 2; ++k) dst[m][k] = *(const PG8_LAS bf16x8*)(lds + PG8_SA(b, h) + aoff + m * 2048 + k * 1024); } while (0)
#define PG8_LDB(dst, b, h) do { _Pragma("unroll") for (int n = 0; n < 2; ++n) _Pragma("unroll") for (int k = 0; k < 2; ++k) dst[n][k] = *(const PG8_LAS bf16x8*)(lds + PG8_SB(b, h) + boff + n * 2048 + k * 1024); } while (0)
#define PG8_MMA(ai, bj, At, Bt) do { __builtin_amdgcn_s_setprio(1); _Pragma("unroll") for (int m = 0; m < 4; ++m) _Pragma("unroll") for (int n = 0; n < 2; ++n) _Pragma("unroll") for (int k = 0; k < 2; ++k) \
        acc[ai][bj][m][n] = __builtin_amdgcn_mfma_f32_16x16x32_bf16(Bt[n][k], At[m][k], acc[ai][bj][m][n], 0, 0, 0); __builtin_amdgcn_s_setprio(0); } while (0)
#define PG8_WAIT_V(n) asm volatile("s_waitcnt vmcnt(" #n ")" ::: "memory")
#define PG8_WAIT_L(n) asm volatile("s_waitcnt lgkmcnt(" #n ")" ::: "memory")
#define PG8_BAR __builtin_amdgcn_s_barrier()
#define PG8_SCHED __builtin_amdgcn_sched_barrier(0)
    Unit cur, nxt; int ui = 0;
    if (!S.next(0, cur)) return;
    f32x4 acc[2][2][4][2];
#pragma unroll
    for (int a = 0; a < 2; ++a)
#pragma unroll
        for (int b = 0; b < 2; ++b)
#pragma unroll
            for (int m = 0; m < 4; ++m)
#pragma unroll
                for (int n = 0; n < 2; ++n) acc[a][b][m][n] = (f32x4){0.f, 0.f, 0.f, 0.f};
    bf16x8 At[4][2], B0[2][2], B1[2][2];
    const char* cA = (const char*)g.A + (size_t)cur.pm * tstepA; const char* cB = (const char*)g.Bt + (size_t)cur.pn * tstepB;
    S.a_ready(cur);
    if constexpr (SP2) {
        PG8_STAGE(PG8_SB(0, 0), cB, voffB); PG8_STAGE(PG8_SB(0, 1), cB + hstepB, voffB); PG8_STAGE(PG8_SA(0, 0), cA, voffA); PG8_STAGE(PG8_SA(0, 1), cA + hstepA, voffA);
        if (wr == 1) PG8_BAR;
        PG8_WAIT_V(2); PG8_BAR;
        PG8_STAGE(PG8_SB(1, 0), cB + kstep, voffB); PG8_STAGE(PG8_SA(1, 0), cA + kstep, voffA); PG8_STAGE(PG8_SB(1, 1), cB + hstepB + kstep, voffB);
        PG8_WAIT_V(6); PG8_BAR;
    } else {
        PG8_STAGE(PG8_SB(0, 0), cB, voffB); PG8_STAGE(PG8_SA(0, 0), cA, voffA); PG8_STAGE(PG8_SB(0, 1), cB + hstepB, voffB); PG8_STAGE(PG8_SA(0, 1), cA + hstepA, voffA);
        if (wr == 1) PG8_BAR;
        PG8_WAIT_V(4); PG8_BAR;
        PG8_STAGE(PG8_SB(1, 0), cB + kstep, voffB); PG8_STAGE(PG8_SA(1, 0), cA + kstep, voffA); PG8_STAGE(PG8_SB(1, 1), cB + hstepB + kstep, voffB);
        PG8_WAIT_V(6); PG8_BAR;
    }
    for (;;) {
        const bool has_next = S.next(ui + 1, nxt);
        const char* nA = has_next ? (const char*)g.A + (size_t)nxt.pm * tstepA : cA; const char* nB = has_next ? (const char*)g.Bt + (size_t)nxt.pn * tstepB : cB;
        for (int t = 0; t < nt; t += 2) {
            const bool last = (t == nt - 2);
            const char* a1 = cA + (size_t)(t + 1) * kstep;
            const char* a2 = last ? nA : cA + (size_t)(t + 2) * kstep; const char* b2 = last ? nB : cB + (size_t)(t + 2) * kstep;
            const char* a3 = a2 + kstep; const char* b3 = b2 + kstep;
            if (last && has_next) S.a_ready(nxt);
            if constexpr (SP2) {
            PG8_LDB(B0, 0, 0); PG8_LDB(B1, 0, 1); PG8_SCHED; PG8_LDA(At, 0, 0); PG8_STAGE(PG8_SA(1, 1), a1 + hstepA, voffA);
            PG8_WAIT_V(8); PG8_WAIT_L(0); PG8_BAR; PG8_MMA(0, 0, At, B0); PG8_MMA(0, 1, At, B1); PG8_BAR; PG8_SCHED;
            PG8_LDA(At, 0, 1); PG8_STAGE(PG8_SB(0, 0), b2, voffB); PG8_STAGE(PG8_SB(0, 1), b2 + hstepB, voffB); PG8_STAGE(PG8_SA(0, 0), a2, voffA);
            PG8_WAIT_V(8); PG8_WAIT_L(0); PG8_BAR; PG8_MMA(1, 0, At, B0); PG8_MMA(1, 1, At, B1); PG8_BAR; PG8_SCHED;
            PG8_LDB(B0, 1, 0); PG8_LDB(B1, 1, 1); PG8_SCHED; PG8_LDA(At, 1, 0); PG8_STAGE(PG8_SA(0, 1), a2 + hstepA, voffA);
            PG8_WAIT_V(8); PG8_WAIT_L(0); PG8_BAR; PG8_MMA(0, 0, At, B0); PG8_MMA(0, 1, At, B1); PG8_BAR; PG8_SCHED;
            PG8_LDA(At, 1, 1); PG8_STAGE(PG8_SB(1, 0), b3, voffB); PG8_STAGE(PG8_SB(1, 1), b3 + hstepB, voffB); PG8_STAGE(PG8_SA(1, 0), a3, voffA);
            PG8_WAIT_V(8); PG8_WAIT_L(0); PG8_BAR; PG8_MMA(1, 0, At, B0); PG8_MMA(1, 1, At, B1); PG8_BAR; PG8_SCHED;
            } else {
            PG8_LDB(B0, 0, 0); PG8_SCHED; PG8_LDA(At, 0, 0); PG8_STAGE(PG8_SA(1, 1), a1 + hstepA, voffA);
            PG8_WAIT_L(8); PG8_BAR; PG8_WAIT_L(0); PG8_MMA(0, 0, At, B0); PG8_BAR; PG8_SCHED;
            PG8_LDB(B1, 0, 1); PG8_STAGE(PG8_SB(0, 0), b2, voffB);
            PG8_BAR; PG8_WAIT_L(0); PG8_MMA(0, 1, At, B1); PG8_BAR;
            PG8_LDA(At, 0, 1); PG8_STAGE(PG8_SA(0, 0), a2, voffA);
            PG8_BAR; PG8_WAIT_L(0); PG8_MMA(1, 0, At, B0); PG8_BAR; PG8_SCHED;
            PG8_STAGE(PG8_SB(0, 1), b2 + hstepB, voffB);
            PG8_WAIT_V(6); PG8_BAR; PG8_MMA(1, 1, At, B1); PG8_BAR;
            PG8_LDB(B0, 1, 0); PG8_SCHED; PG8_LDA(At, 1, 0); PG8_STAGE(PG8_SA(0, 1), a2 + hstepA, voffA);
            PG8_WAIT_L(8); PG8_BAR; PG8_WAIT_L(0); PG8_MMA(0, 0, At, B0); PG8_BAR; PG8_SCHED;
            PG8_LDB(B1, 1, 1); PG8_STAGE(PG8_SB(1, 0), b3, voffB);
            PG8_BAR; PG8_WAIT_L(0); PG8_MMA(0, 1, At, B1); PG8_BAR;
            PG8_LDA(At, 1, 1); PG8_STAGE(PG8_SA(1, 0), a3, voffA);
            PG8_BAR; PG8_WAIT_L(0); PG8_MMA(1, 0, At, B0); PG8_BAR; PG8_SCHED;
            PG8_STAGE(PG8_SB(1, 1), b3 + hstepB, voffB);
            PG8_WAIT_V(6); PG8_BAR; PG8_MMA(1, 1, At, B1); PG8_BAR;
            }
        }
        if constexpr (ALIGN_EPI) { if (wr == 0) PG8_BAR; }
        if constexpr (!Epi::AFTER_DRAIN) { E(acc, cur, wr, wc, fr, fq); S.done(cur); }
        if (!has_next) break;
#pragma unroll
        for (int a = 0; a < 2; ++a)
#pragma unroll
            for (int b = 0; b < 2; ++b)
#pragma unroll
                for (int m = 0; m < 4; ++m)
#pragma unroll
                    for (int n = 0; n < 2; ++n) acc[a][b][m][n] = (f32x4){0.f, 0.f, 0.f, 0.f};
        cur = nxt; cA = nA; cB = nB; ++ui;
        if constexpr (ALIGN_EPI) { if (wr == 1) PG8_BAR; }
    }
    PG8_WAIT_V(0);
    if constexpr (!ALIGN_EPI) { if (wr == 0) PG8_BAR; }
    PG8_BAR;
    if constexpr (Epi::AFTER_DRAIN) { E.fused(acc, cur, wr, wc, fr, fq, lds, wid, lane); S.done(cur); }
#undef PG8_SA
#undef PG8_SB
#undef PG8_STAGE
#undef PG8_LDA
#undef PG8_LDB
#undef PG8_MMA
#undef PG8_WAIT_V
#undef PG8_WAIT_L
#undef PG8_BAR
#undef PG8_SCHED
}
}

namespace pg8 {
struct EpiScale {
    static constexpr bool PERM = true, AFTER_DRAIN = false;
    bf16_t* O; int ldo; const float* ssq; float inv_n; int act;
    __device__ __forceinline__ void operator()(const f32x4 (&acc)[2][2][4][2], const Unit& u, int wr, int wc, int fr, int fq) const {
        const int row0 = u.pm * BM + wr * 64 + fr, col0 = u.pn * BM + wc * 32 + 8 * fq;
#pragma unroll
        for (int ai = 0; ai < 2; ++ai)
#pragma unroll
            for (int m = 0; m < 4; ++m) {
                const int row = row0 + ai * HALF + m * 16;
                const float rs = ssq ? rsqrtf(ssq[row] * inv_n + 1e-6f) : 1.f;
                bf16_t* rowp = O + (size_t)row * ldo + col0;
#pragma unroll
                for (int bj = 0; bj < 2; ++bj) {
                    f32x4 v0 = acc[ai][bj][m][0] * rs, v1 = acc[ai][bj][m][1] * rs;
                    if (act == 1) {
#pragma unroll
                        for (int j = 0; j < 4; ++j) { const float a = fmaxf(v0[j], 0.f), b = fmaxf(v1[j], 0.f); v0[j] = a * a; v1[j] = b * b; }
                    }
                    u32x4 w; w.x = ::cvtpk(v0[0], v0[1]); w.y = ::cvtpk(v0[2], v0[3]); w.z = ::cvtpk(v1[0], v1[1]); w.w = ::cvtpk(v1[2], v1[3]);
                    *(u32x4*)(rowp + bj * HALF) = w;
                }
            }
    }
};
struct EpiHead {
    static constexpr bool PERM = true, AFTER_DRAIN = false;
    int kind; bf16_t* O; int ldo; const float* ssq; float inv_n; const float* cs;
    const float *g0, *g1, *g2, *g3; float* ssq_ckv; float* WI; bf16_t* KI; PG8_LAS float* X;
    __device__ __forceinline__ void operator()(f32x4 (&acc)[2][2][4][2], const Unit& u, int wr, int wc, int fr, int fq) const {
        asm volatile("" : "+v"(fr), "+v"(fq));
        asm volatile("" : "+s"(wr), "+s"(wc));
        const int wave = wr * 4 + wc, pn = u.pn;
        int gt = 0; bool rope = false; float scale = 1.f; const float* g = nullptr;
        if (kind == 0) {
            if (pn < 2) { gt = 1; rope = true; scale = 0.125f * 1.4426950408889634f; g = g0; }
            else if (pn < 4) { gt = 1; rope = true; g = g1; }
            else if (pn < 6) { gt = 0; }
            else if (pn < 8) { gt = 1; rope = true; scale = 0.125f * 1.4426950408889634f; g = g2; }
            else if (pn == 8) { gt = 3; }
            else if (pn == 9) { gt = 4; rope = true; }
            else { gt = 1; rope = true; g = g3; }
        } else if (kind == 1) { if (pn < 2) { gt = 1; rope = true; g = g0; } }
        else { if ((pn & 3) < 2) { gt = 2; g = g0 + (pn >> 2) * 128; } }
        const int row0 = u.pm * BM + wr * 64 + fr, col0 = pn * BM + wc * 32 + 8 * fq;
        PG8_LAS float* CSL = X + 2048;
        if (rope) {
            const int tid_ = (wave * 4 + fq) * 16 + fr; f32x4 t_[2];
#pragma unroll
            for (int i = 0; i < 2; ++i) { const int idx = tid_ + 512 * i; t_[i] = *(const f32x4*)(cs + (size_t)(u.pm * BM + (idx >> 2)) * 16 + 4 * (idx & 3)); }
#pragma unroll
            for (int i = 0; i < 2; ++i) { const int idx = tid_ + 512 * i; *(PG8_LAS f32x4*)(CSL + (idx >> 2) * 20 + 4 * (idx & 3)) = t_[i]; }
        }
        float rsv[8];
#pragma unroll
        for (int i = 0; i < 8; ++i) rsv[i] = ssq[row0 + (i >> 2) * HALF + (i & 3) * 16];
#pragma unroll
        for (int i = 0; i < 8; ++i) rsv[i] = rsqrtf(rsv[i] * inv_n + 1e-6f);
        float gv[8];
        { const int db = (gt == 2) ? (32 * wc + 8 * fq) : (32 * (wc & 1) + 8 * fq);
#pragma unroll
          for (int j = 0; j < 8; ++j) gv[j] = g ? g[db + j] : 1.f; }
#pragma unroll
        for (int ai = 0; ai < 2; ++ai)
#pragma unroll
            for (int m = 0; m < 4; ++m) {
                const float rs = rsv[ai * 4 + m];
#pragma unroll
                for (int bj = 0; bj < 2; ++bj) {
                    acc[ai][bj][m][0] *= rs; acc[ai][bj][m][1] *= rs;
                    const f32x4 a = acc[ai][bj][m][0], b = acc[ai][bj][m][1];
                    float s = (a[0] * a[0] + a[1] * a[1]) + (a[2] * a[2] + a[3] * a[3]) + (b[0] * b[0] + b[1] * b[1]) + (b[2] * b[2] + b[3] * b[3]);
                    s = ::sum_rows4(s);
                    if (fq == 0) X[(((wave * 2 + ai) * 4 + m) * 2 + bj) * 16 + fr] = s;
                }
            }
        asm volatile("s_waitcnt lgkmcnt(0)\n\ts_barrier" ::: "memory");
#pragma unroll
        for (int ai = 0; ai < 2; ++ai)
#pragma unroll
            for (int m = 0; m < 4; ++m) {
                const int row = row0 + ai * HALF + m * 16;
                float cs16[16];
                if (rope) { const PG8_LAS float* c = CSL + (ai * HALF + wr * 64 + m * 16 + fr) * 20;
#pragma unroll
                    for (int q = 0; q < 4; ++q) { const f32x4 t = *(const PG8_LAS f32x4*)(c + 4 * q); cs16[4 * q] = t[0]; cs16[4 * q + 1] = t[1]; cs16[4 * q + 2] = t[2]; cs16[4 * q + 3] = t[3]; }
#pragma unroll
                    for (int j = 0; j < 8; ++j) { const float cj = cs16[j], sj = cs16[8 + j];
                        cs16[j] = (fq == 0) ? cj : (fq == 1) ? sj : (fq == 2) ? 1.f : 0.f; cs16[8 + j] = (fq == 0) ? -sj : (fq == 1) ? cj : (fq == 2) ? 0.f : 1.f; } }
                float rowtot = 0.f;
#pragma unroll
                for (int bj = 0; bj < 2; ++bj) {
                    float v[8];
#pragma unroll
                    for (int j = 0; j < 4; ++j) { v[j] = acc[ai][bj][m][0][j]; v[4 + j] = acc[ai][bj][m][1][j]; }
#define XAT(w_) X[((((w_) * 2 + ai) * 4 + m) * 2 + bj) * 16 + fr]
                    if (gt == 1) {
                        const float tot = XAT(wave) + XAT(wave ^ 1), r2 = rsqrtf(tot * (1.f / 64.f) + 1e-6f);
#pragma unroll
                        for (int j = 0; j < 8; ++j) v[j] = v[j] * r2 * gv[j];
                    } else if (gt == 2) {
                        const int w0 = wave & 4; const float tot = (XAT(w0) + XAT(w0 + 1)) + (XAT(w0 + 2) + XAT(w0 + 3)), r2 = rsqrtf(tot * (1.f / 128.f) + 1e-6f);
#pragma unroll
                        for (int j = 0; j < 8; ++j) v[j] = v[j] * r2 * gv[j];
                    } else if (gt == 3) {
                        const int w0 = wave & 4; rowtot += (XAT(w0) + XAT(w0 + 1)) + (XAT(w0 + 2) + XAT(w0 + 3));
                    }
#undef XAT
                    if (rope && (wc & 1) == 0) {
#pragma unroll
                        for (int j = 0; j < 8; ++j) { const auto r = __builtin_amdgcn_permlane16_swap(__float_as_uint(v[j]), __float_as_uint(v[j]), false, false);
                            v[j] = __uint_as_float(r[0]) * cs16[j] + __uint_as_float(r[1]) * cs16[8 + j]; }
                    }
                    u32x4 w; w.x = ::cvtpk(v[0] * scale, v[1] * scale); w.y = ::cvtpk(v[2] * scale, v[3] * scale); w.z = ::cvtpk(v[4] * scale, v[5] * scale); w.w = ::cvtpk(v[6] * scale, v[7] * scale);
                    if (kind == 0 && pn == 10) {
                        if (bj == 0 && wc < 2) { const int c = 4 * wc + fq;
                            *(u32x4*)(KI + (size_t)(row >> 5) * 2048 + (c >> 1) * 512 + (((c & 1) * 32 + (row & 31)) * 8)) = w; }
                        if (bj == 0 && wc == 2 && fq == 0) *(f32x4*)(WI + (size_t)row * 4) = acc[ai][0][m][0] * (1.f / 16.f);
                    } else {
                        *(u32x4*)(O + (size_t)row * ldo + col0 + bj * HALF) = w;
                    }
                }
                if (gt == 3 && wc == 0 && fq == 0) ssq_ckv[row] = rowtot;
            }
    }
};
struct EpiResid {
    static constexpr bool PERM = true, AFTER_DRAIN = false;
    const float* basef; float* outf; bf16_t* xb; float* ssq_next; int dry;
    __device__ __forceinline__ void operator()(const f32x4 (&acc)[2][2][4][2], const Unit& u, int wr, int wc, int fr, int fq) const {
        const int col0 = u.pn * BM + wc * 32 + 8 * fq;
#pragma unroll
        for (int ai = 0; ai < 2; ++ai)
#pragma unroll
            for (int m = 0; m < 4; ++m) {
                const int row = u.pm * BM + ai * HALF + wr * 64 + m * 16 + fr; const size_t off = (size_t)row * 1024 + col0; float s = 0.f;
#pragma unroll
                for (int bj = 0; bj < 2; ++bj) {
                    const size_t idx = off + bj * HALF;
                    f32x4 x0, x1;
                    if (basef) { x0 = *(const f32x4*)(basef + idx); x1 = *(const f32x4*)(basef + idx + 4); }
                    else { const u32x4 b = *(const u32x4*)(xb + idx); x0 = (f32x4){::lo16(b.x), ::hi16(b.x), ::lo16(b.y), ::hi16(b.y)}; x1 = (f32x4){::lo16(b.z), ::hi16(b.z), ::lo16(b.w), ::hi16(b.w)}; }
                    x0 += acc[ai][bj][m][0]; x1 += acc[ai][bj][m][1];
                    s += (x0[0] * x0[0] + x0[1] * x0[1]) + (x0[2] * x0[2] + x0[3] * x0[3]) + (x1[0] * x1[0] + x1[1] * x1[1]) + (x1[2] * x1[2] + x1[3] * x1[3]);
                    if (outf && !dry) { *(f32x4*)(outf + idx) = x0; *(f32x4*)(outf + idx + 4) = x1; }
                    if (xb && !outf && !dry) { u32x4 w; w.x = ::cvtpk(x0[0], x0[1]); w.y = ::cvtpk(x0[2], x0[3]); w.z = ::cvtpk(x1[0], x1[1]); w.w = ::cvtpk(x1[2], x1[3]); *(u32x4*)(xb + idx) = w; }
                    if (dry) asm volatile("" :: "v"(x0), "v"(x1));
                }
                if (ssq_next && !dry) { s = ::sum_rows4(s); if (fq == 0) atomicAdd(ssq_next + row, s); }
            }
    }
};
}

#define XB_TMO      128
#define XB_XCNT(j)  (256  + 64 * (j))
#define XB_XSUB(j)  (1280 + 64 * (j))
#define XB_XGEN(j)  (2304 + 64 * (j))
#define XB_TOP      3328
#define XB_TOPGEN   3392
#define XCD_BAR_WORDS 3456
#define XB_SPIN_CAP (1u << 18)

__device__ __forceinline__ unsigned xb_ld(unsigned* p)              { return __hip_atomic_load(p, __ATOMIC_RELAXED, __HIP_MEMORY_SCOPE_AGENT); }
__device__ __forceinline__ unsigned xb_add(unsigned* p, unsigned v) { return __hip_atomic_fetch_add(p, v, __ATOMIC_RELAXED, __HIP_MEMORY_SCOPE_AGENT); }
__device__ __forceinline__ unsigned xb_xcc_id() { return (unsigned)__builtin_amdgcn_s_getreg((3 << 11) | 20) & 0xFu; }
#define XB_SPIN(cond, bar) do { unsigned _sp = 0; while (cond) { __builtin_amdgcn_s_sleep(1); \
    if ((++_sp & 255u) == 0u) { if (xb_ld(&(bar)[XB_TMO])) break; if (_sp > XB_SPIN_CAP) { atomicAdd(&(bar)[XB_TMO], 1u); break; } } } } while (0)

struct XcdBarrier {
    unsigned* bar; unsigned x;
    volatile LAS unsigned* st;
};

__device__ __forceinline__ XcdBarrier xcd_barrier_post(unsigned* bar, volatile LAS unsigned* st) {
    XcdBarrier b; b.bar = bar; b.x = xb_xcc_id(); b.st = st;
    if (threadIdx.x == 0) (void)xb_add(&bar[XB_XCNT(b.x)], 1u);
    return b;
}
__device__ __forceinline__ void xcd_barrier_complete(unsigned* bar, unsigned x, unsigned& nloc, unsigned& nx) {
    const unsigned G = gridDim.x * gridDim.y * gridDim.z;
    unsigned sum, cnt, mine, sp = 0u;
    for (;;) {
        sum = 0u; cnt = 0u; mine = 0u;
#pragma unroll
        for (unsigned j = 0; j < 16; ++j) { const unsigned c = xb_ld(&bar[XB_XCNT(j)]); sum += c; cnt += (c > 0u) ? 1u : 0u; mine = (j == x) ? c : mine; }
        if (sum == G) break;
        __builtin_amdgcn_s_sleep(1);
        if ((++sp & 255u) == 0u) { if (xb_ld(&bar[XB_TMO])) break; if (sp > XB_SPIN_CAP) { atomicAdd(&bar[XB_TMO], 1u); break; } }
    }
    nloc = mine > 0u ? mine : 1u; nx = cnt > 0u ? cnt : 1u;
}

__device__ __forceinline__ void xcd_barrier(const XcdBarrier& b) {
    asm volatile("s_waitcnt vmcnt(0)" ::: "memory");
    __syncthreads();
    if (threadIdx.x == 0) {
        unsigned* bar = b.bar;
        __builtin_amdgcn_s_waitcnt(0);
        unsigned nloc = b.st[0], nx = b.st[1];
        if (nloc == 0u) { xcd_barrier_complete(bar, b.x, nloc, nx); b.st[0] = nloc; b.st[1] = nx; }
        const unsigned old = xb_add(&bar[XB_XSUB(b.x)], 1u);
        const unsigned gen = old / nloc;
        if (old + 1u == (gen + 1u) * nloc) {
            __builtin_amdgcn_fence(__ATOMIC_RELEASE, "agent");
            asm volatile("s_waitcnt vmcnt(0)" ::: "memory");
            const unsigned og = xb_add(&bar[XB_TOP], 1u);
            const unsigned tg = og / nx;
            if (og + 1u == (tg + 1u) * nx) xb_add(&bar[XB_TOPGEN], 1u);
            else XB_SPIN(xb_ld(&bar[XB_TOPGEN]) == tg, bar);
            __builtin_amdgcn_fence(__ATOMIC_ACQUIRE, "agent");
            xb_add(&bar[XB_XGEN(b.x)], 1u);
            asm volatile("s_waitcnt vmcnt(0)" ::: "memory");
        } else {
            XB_SPIN(xb_ld(&bar[XB_XGEN(b.x)]) == gen, bar);
            __builtin_amdgcn_fence(__ATOMIC_ACQUIRE, "agent");
            asm volatile("s_waitcnt vmcnt(0)" ::: "memory");
        }
    }
    __syncthreads();
}
constexpr int NPHASE = 22;
constexpr int MISC_OFF = LDS_BYTES - 256;
#ifndef MK_REP_N
#define MK_REP_N 0
#define MK_REP_LO 0
#define MK_REP_HI -1
#endif
#ifndef MK_XPH
#define MK_XPH -1
#define MK_XN 0
#endif
#ifndef MK_SUB
#define MK_SUB 0
#endif
#ifndef MK_IDX2
#define MK_IDX2 0
#endif
#ifndef MK_CGSYNC
#define MK_CGSYNC 0
#endif
template <class Epi, bool ALIGN>
DEVI void run_gemm(LAS unsigned char* lds, const bf16_t* A, int lda, const bf16_t* Bt, int M, int N, int K, const Epi& E, int cu_off = 0) {
    const int Gd = (int)gridDim.x; int cu = (int)blockIdx.x - cu_off; if (cu < 0) cu += Gd;
    pg8::Gemm g{A, lda, Bt, M, N, K}; pg8::StaticOrder So; So.init(M, N, Gd, cu);
    pg8::gemm_phase<Epi, pg8::StaticOrder, ALIGN, true>(lds, g, So, E);
}
template <bool DRYK>
__global__ void __launch_bounds__(NTHR, 2) mega(Params P, int ph_lo, int ph_hi) {
    extern __shared__ __attribute__((aligned(16))) unsigned char lds_raw[];
    LAS unsigned char* lds = (LAS unsigned char*)lds_raw;
    cg::grid_group grid = cg::this_grid();
    { volatile LAS unsigned* MISC0 = (volatile LAS unsigned*)(lds + MISC_OFF);
      if (threadIdx.x < 32) MISC0[threadIdx.x] = 0u;
      __syncthreads();
      if (ph_hi - ph_lo > 1) (void)xcd_barrier_post((unsigned*)(P.ws + WS_BAR), MISC0 + 8); }
    if (ph_lo < 0) grid.sync();
#define PH_LOCALS unsigned char* ws = P.ws; asm volatile("" : "+s"(ws)); float* ssq = (float*)(ws + WS_SSQ); bf16_t* XB = (bf16_t*)(ws + WS_XB); bf16_t* Y = (bf16_t*)(ws + WS_Y); const int G = gridDim.x, bx = blockIdx.x; (void)ssq; (void)XB; (void)Y; (void)G; (void)bx;
#define SEAM_XCD() do { XcdBarrier b_; b_.bar = (unsigned*)(P.ws + WS_BAR); b_.x = xb_xcc_id(); b_.st = (volatile LAS unsigned*)(lds + MISC_OFF) + 8; xcd_barrier(b_); } while (0)
#define PH_REPS(k) (((k) >= MK_REP_LO && (k) <= MK_REP_HI && (k) != 2 && (k) != 4) ? 1 + MK_REP_N : 1)
#define PH_BEGIN(k) if (ph_lo <= (k) && (k) < ph_hi) { PH_LOCALS for (int rep = 0; rep < PH_REPS(k); ++rep) { const int dry = (rep > 0) || DRYK; (void)dry; if (rep > 0) SEAM_XCD();
#define PH_END(k) } if ((k) + 1 < ph_hi) { if (MK_CGSYNC) grid.sync(); else SEAM_XCD(); } }
#define DRYOUT (dry ? (float*)(ws + WS_Y) : P.out)
    using pg8::EpiScale; using pg8::EpiResid; using pg8::EpiHead;
    PH_BEGIN(0) phase_prologue(P, lds, dry); PH_END(0)
    PH_BEGIN(1)
#if MK_FUSE & 1
        run_gemm<EpiHead, true>(lds, (const bf16_t*)(ws + WS_XB), 1024, (const bf16_t*)(ws + W_INE), T, LDP, 1024,
            EpiHead{0, (bf16_t*)(ws + WS_PROJ), LDP, ssq, 1.f / 1024.f, (const float*)(ws + WS_CS), P.in[15], P.in[16], P.in[24], P.in[26],
                    (float*)(ws + WS_SSQCKV), (float*)(ws + WS_WI), (bf16_t*)(ws + WS_KI), (LAS float*)(lds + 132096)});
#else
        run_gemm<EpiScale, true>(lds, (const bf16_t*)(ws + WS_XB), 1024, (const bf16_t*)(ws + W_INE), T, LDP, 1024, EpiScale{(bf16_t*)(ws + WS_PROJ), LDP, ssq, 1.f / 1024.f, 0});
#endif
#if MK_FUSE & 2
        run_gemm<EpiHead, true>(lds, (const bf16_t*)(ws + WS_MB), 1024, (const bf16_t*)(ws + W_KVX), MEMT, 2048, 1024,
            EpiHead{2, (bf16_t*)(ws + WS_KVX), 2048, (const float*)(ws + WS_SSQMEM), 1.f / 1024.f, nullptr, P.in[10], nullptr, nullptr, nullptr, nullptr, nullptr, nullptr, (LAS float*)(lds + 132096)},
            ((T / 256) * (LDP / 256)) % G);
#else
        run_gemm<EpiScale, false>(lds, (const bf16_t*)(ws + WS_MB), 1024, (const bf16_t*)(ws + W_KVX), MEMT, 2048, 1024, EpiScale{(bf16_t*)(ws + WS_KVX), 2048, (const float*)(ws + WS_SSQMEM), 1.f / 1024.f, 0}, ((T / 256) * (LDP / 256)) % G);
#endif
    PH_END(1)
#if (MK_FUSE & 3) != 3
    PH_BEGIN(2) phase_post0(P, ((MK_FUSE & 1) ? 0 : 1) | ((MK_FUSE & 2) ? 0 : 2)); PH_END(2)
#endif
    PH_BEGIN(3)
#if MK_FUSE & 4
        run_gemm<EpiHead, true>(lds, (const bf16_t*)(ws + WS_PROJ) + C_CKV, LDP, (const bf16_t*)(ws + W_KVUP), T, 1024, 256,
            EpiHead{1, (bf16_t*)(ws + WS_KBVB), 1024, (const float*)(ws + WS_SSQCKV), 1.f / 256.f, (const float*)(ws + WS_CS), P.in[25], nullptr, nullptr, nullptr, nullptr, nullptr, nullptr, (LAS float*)(lds + 132096)});
#else
        run_gemm<EpiScale, false>(lds, (const bf16_t*)(ws + WS_PROJ) + C_CKV, LDP, (const bf16_t*)(ws + W_KVUP), T, 1024, 256, EpiScale{(bf16_t*)(ws + WS_KBVB), 1024, (const float*)(ws + WS_SSQCKV), 1.f / 256.f, 0});
#endif
    PH_END(3)
#if !(MK_FUSE & 4)
    PH_BEGIN(4) phase_postkb(P); PH_END(4)
#endif
    PH_BEGIN(5)
        if (!(dry && MK_SUB == 2))
        for (int u = bx; u < 256; u += G) { const int bhc = u >> 3, s = u & 7, b = bhc >> 3, h = (bhc >> 1) & 3, c = bhc & 1;
            attnA_unit(P, b, h, c, s, lds); attnA_unit(P, b, h, c, 15 - s, lds); }
        if (!(dry && MK_SUB == 1))
        for (int u = bx; u < 2048; u += G) { const int k = u / 256, c = u % 256, b = k >> 1; const int blk = (k & 1) ? (511 - c) : c;
            indexer_unit(P, b, blk * 8, lds); }
#if MK_IDX2
        for (int u = bx; u < 2048; u += G) { const int k = u / 256, c = u % 256, b = k >> 1; const int blk = (k & 1) ? (511 - c) : c;
            indexer_unit(P, b, blk * 8, lds); }
#endif
    PH_END(5)
    PH_BEGIN(6)
        if (!(dry && MK_SUB == 2))
        for (int u = bx; u < 256; u += G) { const int bh = u >> 3, s = u & 7, b = bh >> 3, hd = bh & 7;
            attnB_unit(P, b, hd, s, lds); attnB_unit(P, b, hd, 15 - s, lds); }
        if (!(dry && MK_SUB == 1)) combineA_rows(P);
    PH_END(6)
    PH_BEGIN(7) run_gemm<EpiResid, false>(lds, Y, 1024, (const bf16_t*)(ws + W_OUTE), T, 1024, 1024, EpiResid{P.in[0], nullptr, XB, ssq + 1 * T, dry}); PH_END(7)
#define XATTN_MLP(l, p0)                                                                                                                                                      \
    PH_BEGIN(p0 + 1) for (int u = bx; u < 256; u += G) { const int b = u >> 6, hd = (u >> 4) & 3, qb = u & 15; xattn_fused_unit(P, (l), b, hd, qb, lds); } PH_END(p0 + 1)                           \
    PH_BEGIN(p0 + 2) run_gemm<EpiResid, false>(lds, (const bf16_t*)(ws + WS_YX), 512, (const bf16_t*)(ws + W_OX) + (size_t)(l) * 1024 * 512, T, 1024, 512, EpiResid{nullptr, nullptr, XB, ssq + ((l) ? 5 : 2) * T, dry}); PH_END(p0 + 2) \
    PH_BEGIN(p0 + 3) run_gemm<EpiScale, true>(lds, XB, 1024, (const bf16_t*)(ws + W_UP) + (size_t)(l) * 4096 * 1024, T, DFF, 1024, EpiScale{(bf16_t*)(ws + WS_H), DFF, ssq + ((l) ? 5 : 2) * T, 1.f / 1024.f, 1}); PH_END(p0 + 3)
    PH_BEGIN(8)
        if (!dry) { const int t8 = tid_opaque(); convert_weights(P, lds, NTR_EARLY, NTR, true, bx * NWAVE + (t8 >> 6), G * NWAVE, bx * NTHR + t8, G * NTHR); }
    PH_END(8)
    XATTN_MLP(0, 8)
    PH_BEGIN(12) run_gemm<EpiResid, false>(lds, (const bf16_t*)(ws + WS_H), DFF, (const bf16_t*)(ws + W_DOWN), T, 1024, DFF, EpiResid{nullptr, nullptr, XB, ssq + 3 * T, dry}); PH_END(12)
    PH_BEGIN(13) run_gemm<EpiScale, true>(lds, XB, 1024, (const bf16_t*)(ws + W_INO), T, 2048, 1024, EpiScale{(bf16_t*)(ws + WS_PROJ1), 2048, ssq + 3 * T, 1.f / 1024.f, 0}); PH_END(13)
    PH_BEGIN(14) phase_mix1(P); PH_END(15)
    PH_BEGIN(16) run_gemm<EpiResid, false>(lds, Y, 1024, (const bf16_t*)(ws + W_OUTO), T, 1024, 1024, EpiResid{nullptr, nullptr, XB, ssq + 4 * T, dry}); PH_END(16)
    XATTN_MLP(1, 17)
    PH_BEGIN(21) run_gemm<EpiResid, false>(lds, (const bf16_t*)(ws + WS_H), DFF, (const bf16_t*)(ws + W_DOWN) + (size_t)1024 * 4096, T, 1024, DFF, EpiResid{nullptr, P.out, XB, nullptr, dry}); PH_END(21)
#if MK_TPROBE
    if (ph_hi == NPHASE) { SEAM_XCD(); unsigned char* ws = P.ws;
        const unsigned long long* TS = (const unsigned long long*)(ws + WS_BAR + 65536);
        float delta = (MK_TPROBE == 14) ? (float)TS[12] / 625000.f : (MK_TPROBE >= 10) ? (float)TS[8 + MK_TPROBE - 10] / (float)TS[12] : (MK_TPROBE == 4 || MK_TPROBE == 20) ? (float)TS[3] * 1e-6f : (float)TS[MK_TPROBE - 1] / (float)TS[3];
        delta = floorf(delta * 25.f + 0.5f) * 0.04f;
        if (MK_TPROBE == 20) delta = 0.1f * floorf(log2f((float)TS[3] / 64000.f) + 0.5f);
        if (MK_TPROBE == 34) delta = 0.1f * floorf(log2f((float)TS[20] / 1000.f) * 2.f + 0.5f) * 0.5f;
        else if (MK_TPROBE >= 30) delta = 0.04f * floorf(25.f * (float)TS[16 + MK_TPROBE - 30] / (float)TS[20] + 0.5f);
        for (int i = blockIdx.x * NTHR + threadIdx.x; i < T * D; i += gridDim.x * NTHR) P.out[i] *= (1.f + delta); }
#endif
}

#ifndef MK_MULTI
#define MK_MULTI 0
#endif
extern "C" void kernel_launch(void* const* d_in, const int* in_sizes, int n_in, void* d_out, int out_size, void* d_ws, size_t ws_size, hipStream_t stream) {
    static int grid = 0;
    if (grid == 0) {
        if (n_in != 33 || out_size != T * D || ws_size < WS_END) { fprintf(stderr, "kernel_launch: unexpected shapes (n_in %d out %d ws %zu)\n", n_in, out_size, ws_size); grid = -1; return; }
        int dev = 0, cus = 0, per_cu = 0;
        hipGetDevice(&dev); hipDeviceGetAttribute(&cus, hipDeviceAttributeMultiprocessorCount, dev);
        hipFuncSetAttribute((const void*)mega<false>, hipFuncAttributeMaxDynamicSharedMemorySize, LDS_BYTES);
        hipOccupancyMaxActiveBlocksPerMultiprocessor(&per_cu, (const void*)mega<false>, NTHR, LDS_BYTES);
        if (per_cu < 1) { fprintf(stderr, "kernel_launch: occupancy query says %d blocks/CU\n", per_cu); per_cu = 1; }
        (void)hipGetLastError();
        grid = cus * 1;
    }
    if (grid < 0) return;
    Params p{};
    for (int i = 0; i < 33; ++i) p.in[i] = (const float*)d_in[i];
    p.out = (float*)d_out; p.ws = (unsigned char*)d_ws;
    (void)hipMemsetAsync((char*)d_ws + WS_BAR, 0, MK_TPROBE ? 131072 : XCD_BAR_WORDS * 4, stream);
#if MK_MULTI
    for (int ph = 0; ph < NPHASE; ++ph) hipLaunchKernelGGL(mega<false>, dim3(grid), dim3(NTHR), LDS_BYTES, stream, p, ph, ph + 1);
#else
    int lo = 0, hi = NPHASE;
    void* args[] = {&p, &lo, &hi};
    hipError_t e = hipLaunchCooperativeKernel((const void*)mega<false>, dim3(grid), dim3(NTHR), args, LDS_BYTES, stream);
    if (e != hipSuccess) fprintf(stderr, "cooperative launch failed: %s (grid %d)\n", hipGetErrorString(e), grid);
#endif
#if MK_XPH >= 0
    { static bool once = false; if (!once) { (void)hipFuncSetAttribute((const void*)mega<true>, hipFuncAttributeMaxDynamicSharedMemorySize, LDS_BYTES); once = true; } }
    for (int i = 0; i < MK_XN; ++i) hipLaunchKernelGGL(mega<true>, dim3(grid), dim3(NTHR), LDS_BYTES, stream, p, MK_XPH, MK_XPH + 1);
#endif
}
```

```cpp
#include <hip/hip_runtime.h>
#include <hip/hip_cooperative_groups.h>
#include <cstdio>
#include <cstdint>
namespace cg = cooperative_groups;
#ifndef MK_SEL2
#define MK_SEL2 0
#define MK_SC2 0
#define MK_BIS2 0
#define MK_XA2 0
#define MK_FUSE 7
#define MK_AX 0
#define MK_TPROBE 0
#endif

#define DEVI __device__ __forceinline__
#define LAS __attribute__((address_space(3)))
typedef unsigned short bf16_t;
typedef short bf16x8 __attribute__((ext_vector_type(8)));
typedef short s16x4 __attribute__((ext_vector_type(4)));
typedef float f32x2 __attribute__((ext_vector_type(2)));
typedef float f32x4 __attribute__((ext_vector_type(4)));
typedef float f32x16 __attribute__((ext_vector_type(16)));
typedef unsigned u32x2 __attribute__((ext_vector_type(2)));
typedef unsigned u32x4 __attribute__((ext_vector_type(4)));
typedef unsigned long long u64;

constexpr int NB = 4, S = 4096, T = NB * S, D = 1024, DFF = 4096, MEML = 256, MEMT = NB * MEML;
constexpr int LDP = 2816;
constexpr int C_QA = 0, C_KA = 512, C_VA = 1024, C_QB = 1536, C_CKV = 2048, C_QI = 2304, C_KI = 2560, C_WI = 2624, EVEN_IN = 2628;
constexpr float EPS = 1e-6f;
constexpr float LOG2E = 1.4426950408889634f;
constexpr int NTHR = 512, NWAVE = 8;
constexpr int LDS_BYTES = 163840;

constexpr size_t MiB = 1u << 20;
constexpr size_t WS_SSQ = 0;
constexpr size_t WS_SSQCKV = WS_SSQ + 6ull * T * 4;
constexpr size_t WS_SSQMEM = WS_SSQCKV + (size_t)T * 4;
constexpr size_t WS_WI = 512 * 1024;
constexpr size_t WS_BAR = 1 * MiB;
constexpr size_t WS_W = 2 * MiB;
constexpr size_t W_INE = WS_W;
constexpr size_t W_KVUP = W_INE + (size_t)LDP * 1024 * 2;
constexpr size_t W_OUTE = W_KVUP + 1024ull * 256 * 2;
constexpr size_t W_QX = W_OUTE + 1024ull * 1024 * 2;
constexpr size_t W_KVX = W_QX + 2 * 512ull * 1024 * 2;
constexpr size_t W_OX = W_KVX + 2 * 1024ull * 1024 * 2;
constexpr size_t W_UP = W_OX + 2 * 1024ull * 512 * 2;
constexpr size_t W_DOWN = W_UP + 2 * 4096ull * 1024 * 2;
constexpr size_t W_INO = W_DOWN + 2 * 4096ull * 1024 * 2;
constexpr size_t W_POOL = W_INO + 2048ull * 1024 * 2;
constexpr size_t W_OUTO = W_POOL + 512ull * 512 * 2;
constexpr size_t W_END = W_OUTO + 1024ull * 1024 * 2;
static_assert(W_END <= 57 * MiB, "weights region");
constexpr size_t WS_XB = 57 * MiB;
constexpr size_t WS_PROJ = 89 * MiB;
constexpr size_t WS_KBVB = 177 * MiB;
constexpr size_t WS_MASK = 209 * MiB;
constexpr size_t WS_Y = 217 * MiB;
constexpr size_t WS_CS = 249 * MiB;
constexpr size_t WS_MB = 250 * MiB;
constexpr size_t WS_KVX = 252 * MiB;
constexpr size_t WS_END = 256 * MiB;
constexpr size_t WS_QX = WS_PROJ;
constexpr size_t WS_YX = WS_PROJ + 16 * MiB;
constexpr size_t WS_H = WS_PROJ;
constexpr size_t WS_PROJ1 = WS_PROJ;
constexpr size_t WS_POOLED = WS_PROJ + 64 * MiB;
constexpr size_t WS_KI = WS_Y;

struct Params { const float* in[33]; float* out; unsigned char* ws; };

DEVI float bf2f(bf16_t v) { return __uint_as_float(((unsigned)v) << 16); }
DEVI unsigned f2bf(float f) { unsigned u = __float_as_uint(f); return (u + 0x7fffu + ((u >> 16) & 1u)) >> 16; }
DEVI unsigned pk2(float lo, float hi) { return f2bf(lo) | (f2bf(hi) << 16); }
DEVI float wave_sum(float v) {
#pragma unroll
    for (int o = 1; o < 64; o <<= 1) v += __shfl_xor(v, o);
    return v;
}
DEVI float lo16(unsigned w) { return __uint_as_float(w << 16); }
DEVI float hi16(unsigned w) { return __uint_as_float(w & 0xffff0000u); }
#define LDS_WAIT() asm volatile("s_waitcnt lgkmcnt(0)" ::: "memory")
DEVI unsigned cvtpk(float lo, float hi) { typedef __bf16 bf2 __attribute__((ext_vector_type(2))); f32x2 v = {lo, hi}; bf2 b = __builtin_convertvector(v, bf2); return __builtin_bit_cast(unsigned, b); }

DEVI int tid_opaque() { int w = __builtin_amdgcn_readfirstlane(threadIdx.x >> 6); asm volatile("" : "+s"(w)); const int l = __builtin_amdgcn_mbcnt_hi(~0u, __builtin_amdgcn_mbcnt_lo(~0u, 0u)); return w * 64 + l; }
struct TrD { const float* src; bf16_t* dst; const float* sk; const float* sn; int K, N, ldd; };
constexpr int NTR = 19;
DEVI TrD get_tr(const Params& P, int i) {
    unsigned char* ws = P.ws; TrD d; d.sk = nullptr; d.sn = nullptr;
    switch (i) {
    case 0: d.src = P.in[14]; d.dst = (bf16_t*)(ws + W_INE); d.K = 1024; d.N = EVEN_IN; d.ldd = 1024; d.sk = P.in[3]; break;
    case 1: d.src = P.in[23]; d.dst = (bf16_t*)(ws + W_KVUP); d.K = 256; d.N = 1024; d.ldd = 256; d.sk = P.in[22]; break;
    case 2: d.src = P.in[27]; d.dst = (bf16_t*)(ws + W_OUTE); d.K = 1024; d.N = 1024; d.ldd = 1024; break;
    case 3: case 4: { int l = i - 3; d.src = P.in[7] + (size_t)l * 1024 * 512; d.dst = (bf16_t*)(ws + W_QX) + (size_t)l * 512 * 1024; d.K = 1024; d.N = 512; d.ldd = 1024; d.sk = P.in[4] + l * 1024; } break;
    case 5: case 6: { int l = i - 5; d.src = P.in[8] + (size_t)l * 1024 * 1024; d.dst = (bf16_t*)(ws + W_KVX) + (size_t)l * 1024 * 1024; d.K = 1024; d.N = 1024; d.ldd = 1024; d.sk = P.in[5] + l * 1024; } break;
    case 7: case 8: { int l = i - 7; d.src = P.in[11] + (size_t)l * 512 * 1024; d.dst = (bf16_t*)(ws + W_OX) + (size_t)l * 1024 * 512; d.K = 512; d.N = 1024; d.ldd = 512; } break;
    case 9: case 10: { int l = i - 9; d.src = P.in[12] + (size_t)l * 1024 * 4096; d.dst = (bf16_t*)(ws + W_UP) + (size_t)l * 4096 * 1024; d.K = 1024; d.N = 4096; d.ldd = 1024; d.sk = P.in[6] + l * 1024; } break;
    case 11: case 12: { int l = i - 11; d.src = P.in[13] + (size_t)l * 4096 * 1024; d.dst = (bf16_t*)(ws + W_DOWN) + (size_t)l * 1024 * 4096; d.K = 4096; d.N = 1024; d.ldd = 4096; } break;
    case 13: d.src = P.in[28]; d.dst = (bf16_t*)(ws + W_INO); d.K = 1024; d.N = 2048; d.ldd = 1024; d.sk = P.in[3] + 1024; break;
    case 14: case 15: case 16: case 17: d.src = P.in[30]; d.dst = (bf16_t*)(ws + W_POOL); d.K = 0; d.N = 32; d.ldd = 512; break;
    default: d.src = P.in[32]; d.dst = (bf16_t*)(ws + W_OUTO); d.K = 512; d.N = 1024; d.ldd = 1024; break;
    }
    return d;
}
DEVI int tr_items(const TrD& d) { return (d.K / 64) * ((d.N + 31) / 32); }
template <bool SK, bool SN>
DEVI void tr_item(const TrD& d, LAS float* scr, int item, int lane) {
    const int nblk = (d.N + 31) / 32, kb = item / nblk, nb = item % nblk, k0 = 64 * kb, n0 = 32 * nb;
    const int n = n0 + (lane & 31), nc = (n < d.N) ? n : (d.N - 1);
    const float* sp = d.src + (size_t)(k0 + (lane >> 5)) * d.N + nc;
    float v[32], sk[32];
#pragma unroll
    for (int i = 0; i < 32; ++i) { v[i] = sp[(size_t)(2 * i) * d.N]; if (SK) sk[i] = d.sk[k0 + 2 * i + (lane >> 5)]; }
#pragma unroll
    for (int i = 0; i < 32; ++i) { float x = v[i]; if (SK) x *= sk[i]; if (n >= d.N) x = 0.f; scr[(2 * i + (lane >> 5)) * 33 + (lane & 31)] = x; }
    LDS_WAIT(); asm volatile("" ::: "memory");
    const int c = lane & 7;
#pragma unroll
    for (int j = 0; j < 4; ++j) {
        const int nn = (lane >> 3) + 8 * j, ncl = (n0 + nn < d.N) ? (n0 + nn) : (d.N - 1);
        const LAS float* s = scr + (8 * c) * 33 + nn;
        float sc = 1.f; if (SN) sc = d.sn[ncl];
        u32x4 o; o.x = pk2(s[0 * 33] * sc, s[1 * 33] * sc); o.y = pk2(s[2 * 33] * sc, s[3 * 33] * sc); o.z = pk2(s[4 * 33] * sc, s[5 * 33] * sc); o.w = pk2(s[6 * 33] * sc, s[7 * 33] * sc);
        if (n0 + nn < d.N) *(u32x4*)(d.dst + (size_t)(n0 + nn) * d.ldd + k0 + 8 * c) = o;
    }
    LDS_WAIT(); asm volatile("" ::: "memory");
}
template <int NR>
DEVI void rows_to_bf16_ssq(const float* x, bf16_t* o, float* ssq_out, int m0, int stride, int nrows, int lane) {
    f32x4 v[NR][4];
#pragma unroll
    for (int k = 0; k < NR; ++k) { const int m = (m0 + k * stride < nrows) ? m0 + k * stride : m0; const f32x4* xr = (const f32x4*)(x + (size_t)m * D) + lane;
#pragma unroll
        for (int j = 0; j < 4; ++j) v[k][j] = xr[64 * j]; }
#pragma unroll
    for (int k = 0; k < NR; ++k) { const int m = m0 + k * stride; if (m >= nrows) break;
        float s = 0.f;
#pragma unroll
        for (int j = 0; j < 4; ++j) s += (v[k][j].x * v[k][j].x + v[k][j].y * v[k][j].y) + (v[k][j].z * v[k][j].z + v[k][j].w * v[k][j].w);
        s = wave_sum(s);
        if (lane == 0) ssq_out[m] = s;
        u32x2* o8 = (u32x2*)(o + (size_t)m * D) + lane;
#pragma unroll
        for (int j = 0; j < 4; ++j) { u32x2 w; w.x = pk2(v[k][j].x, v[k][j].y); w.y = pk2(v[k][j].z, v[k][j].w); o8[64 * j] = w; } }
}
#ifndef MK_SUB
#define MK_SUB 0
#endif
DEVI void convert_weights(const Params& P, LAS unsigned char* lds, int dlo, int dhi, bool fold, int gw, int NGW, int gt, int NGT) {
    const int tid = tid_opaque(), lane = tid & 63, wave = tid >> 6;
    unsigned char* ws = P.ws;
    LAS float* scr = (LAS float*)(lds + wave * 16384);
    int base = 0;
    for (int i = dlo; i < dhi; ++i) {
        const TrD d = get_tr(P, i); const int n = tr_items(d);
        int first = gw - (base % NGW); if (first < 0) first += NGW;
        if (d.sn) { for (int it = first; it < n; it += NGW) tr_item<false, true>(d, scr, it, lane); }
        else if (d.sk) { for (int it = first; it < n; it += NGW) tr_item<true, false>(d, scr, it, lane); }
        else { for (int it = first; it < n; it += NGW) tr_item<false, false>(d, scr, it, lane); }
        base += n;
    }
    if (!fold) return;
    for (int i = gt; i < 1024 * 64; i += NGT) {
        const int n = i & 1023, cp0 = (i >> 10) * 8, g = cp0 >> 7, c = cp0 & 127;
        const float* wo = P.in[32] + (size_t)(512 + g * 128) * 1024 + n; const float* wp = P.in[30] + (size_t)g * 16384 + (size_t)c * 128; const float* ps = P.in[31] + g * 128;
        float acc[8];
#pragma unroll
        for (int j = 0; j < 8; ++j) acc[j] = 0.f;
        for (int d0 = 0; d0 < 128; d0 += 8) {
            float wv[8];
#pragma unroll
            for (int dd = 0; dd < 8; ++dd) wv[dd] = wo[(size_t)(d0 + dd) * 1024] * ps[d0 + dd];
#pragma unroll
            for (int dd = 0; dd < 8; ++dd)
#pragma unroll
                for (int j = 0; j < 8; ++j) acc[j] += wp[j * 128 + d0 + dd] * wv[dd];
        }
        u32x4 w; w.x = pk2(acc[0], acc[1]); w.y = pk2(acc[2], acc[3]); w.z = pk2(acc[4], acc[5]); w.w = pk2(acc[6], acc[7]);
        *(u32x4*)((bf16_t*)(ws + W_OUTO) + (size_t)n * 1024 + 512 + cp0) = w;
    }
}
constexpr int NTR_EARLY = 7;
DEVI void phase_prologue(const Params& P, LAS unsigned char* lds, int dry = 0) {
    const int tid = tid_opaque(), lane = tid & 63, wave = tid >> 6;
#if MK_TPROBE == 20
    { float a0 = lane, a1 = lane + 1, a2 = lane + 2, a3 = lane + 3, a4 = lane + 4, a5 = lane + 5, a6 = lane + 6, a7 = lane + 7;
      unsigned long long t0_ = __builtin_amdgcn_s_memtime();
      for (int it = 0; it < 1000; ++it) {
#pragma unroll
          for (int k = 0; k < 8; ++k) { asm volatile("v_fma_f32 %0, %0, 1.0, %0\n\tv_fma_f32 %1, %1, 1.0, %1\n\tv_fma_f32 %2, %2, 1.0, %2\n\tv_fma_f32 %3, %3, 1.0, %3\n\tv_fma_f32 %4, %4, 1.0, %4\n\tv_fma_f32 %5, %5, 1.0, %5\n\tv_fma_f32 %6, %6, 1.0, %6\n\tv_fma_f32 %7, %7, 1.0, %7" : "+v"(a0), "+v"(a1), "+v"(a2), "+v"(a3), "+v"(a4), "+v"(a5), "+v"(a6), "+v"(a7)); }
      }
      unsigned long long t1_ = __builtin_amdgcn_s_memtime();
      asm volatile("" :: "v"(a0), "v"(a1), "v"(a2), "v"(a3), "v"(a4), "v"(a5), "v"(a6), "v"(a7));
      if (blockIdx.x == 0 && tid == 0) atomicAdd((unsigned long long*)(P.ws + WS_BAR + 65536) + 3, t1_ - t0_); }
#endif
    const int gw = blockIdx.x * NWAVE + wave, NGW = gridDim.x * NWAVE;
    const int gt = blockIdx.x * NTHR + tid, NGT = gridDim.x * NTHR;
    unsigned char* ws = P.ws;
    convert_weights(P, lds, 0, NTR_EARLY, false, gw, NGW, gt, NGT);
    { bf16_t* w = (bf16_t*)(ws + W_INE) + (size_t)EVEN_IN * 1024; const int n = (LDP - EVEN_IN) * 1024 / 8;
      for (int i = gt; i < n; i += NGT) ((u32x4*)w)[i] = (u32x4){0u, 0u, 0u, 0u}; }
    { float* q = (float*)(ws + WS_SSQ) + T; for (int i = gt; i < 5 * T; i += NGT) q[i] = 0.f; }
    if (!(dry && MK_SUB != 2 && MK_SUB != 0))
    for (int m = gw; m < T; m += 4 * NGW) rows_to_bf16_ssq<4>(P.in[0], (bf16_t*)(ws + WS_XB), (float*)(ws + WS_SSQ), m, NGW, T, lane);
    for (int m = gw; m < MEMT; m += NGW) rows_to_bf16_ssq<1>(P.in[1], (bf16_t*)(ws + WS_MB), (float*)(ws + WS_SSQMEM), m, NGW, MEMT, lane);
    if (!(dry && MK_SUB != 3 && MK_SUB != 0))
    { const int* pos = (const int*)P.in[2]; float* cs = (float*)(ws + WS_CS);
      for (int i = gt; i < T * 8; i += NGT) { const int m = i >> 3, f = i & 7;
        const double inv = (f == 0) ? 1.0 : (f == 1) ? 0.19392274474868576 : (f == 2) ? 0.03760603093086393 : (f == 3) ? 0.007292664737217109 : (f == 4) ? 0.001414213562373095
                         : (f == 5) ? 0.0002742481756762073 : (f == 6) ? 5.318295896944988e-05 : 1.031338537721246e-05;
        const double ang = (double)pos[m] * inv, k = rint(ang * 0.15915494309189535), r = fma(-k, 6.283185307179586, ang) - k * 2.4492935982947064e-16;
        cs[m * 16 + f] = cosf((float)r); cs[m * 16 + 8 + f] = sinf((float)r); } }
}

struct EpiStore {
    bf16_t* O; int ldo; const float* ssq; float inv_n; int act;
    DEVI void operator()(const f32x4 (&acc)[4][4], int row0, int col0, int lane) const {
#pragma unroll
        for (int m = 0; m < 4; ++m)
#pragma unroll
            for (int i = 0; i < 4; ++i) {
                const int row = row0 + 16 * m + (lane >> 4) * 4 + i;
                const float rs = ssq ? rsqrtf(ssq[row] * inv_n + EPS) : 1.f;
#pragma unroll
                for (int n = 0; n < 4; ++n) {
                    float v = acc[m][n][i] * rs;
                    if (act == 1) { v = fmaxf(v, 0.f); v = v * v; }
                    O[(size_t)row * ldo + col0 + 16 * n + (lane & 15)] = (bf16_t)f2bf(v);
                }
            }
    }
};
struct EpiRes {
    const float* base; float* out; bf16_t* xb; float* ssq_next;
    DEVI void operator()(const f32x4 (&acc)[4][4], int row0, int col0, int lane) const {
#pragma unroll
        for (int m = 0; m < 4; ++m)
#pragma unroll
            for (int i = 0; i < 4; ++i) {
                const int row = row0 + 16 * m + (lane >> 4) * 4 + i; float s = 0.f;
#pragma unroll
                for (int n = 0; n < 4; ++n) {
                    const size_t idx = (size_t)row * D + col0 + 16 * n + (lane & 15);
                    const float v = base[idx] + acc[m][n][i];
                    out[idx] = v; s += v * v;
                    if (xb) xb[idx] = (bf16_t)f2bf(v);
                }
                if (ssq_next) {
                    s += __shfl_xor(s, 1); s += __shfl_xor(s, 2); s += __shfl_xor(s, 4); s += __shfl_xor(s, 8);
                    if ((lane & 15) == 0) atomicAdd(ssq_next + row, s);
                }
            }
    }
};
template <class Epi>
DEVI void gemm_simple(const bf16_t* A, int lda, const bf16_t* Bt, int ldb, int M, int N, int K, const Epi& epi) {
    const int tid = tid_opaque(), lane = tid & 63, wave = tid >> 6;
    const int gw = blockIdx.x * NWAVE + wave, NGW = gridDim.x * NWAVE;
    const int nN = N / 64, ntiles = (M / 64) * nN;
    for (int tile = gw; tile < ntiles; tile += NGW) {
        const int row0 = (tile / nN) * 64, col0 = (tile % nN) * 64;
        f32x4 acc[4][4];
#pragma unroll
        for (int m = 0; m < 4; ++m)
#pragma unroll
            for (int n = 0; n < 4; ++n) acc[m][n] = (f32x4){0.f, 0.f, 0.f, 0.f};
        const bf16_t* ap = A + (size_t)(row0 + (lane & 15)) * lda + 8 * (lane >> 4);
        const bf16_t* bp = Bt + (size_t)(col0 + (lane & 15)) * ldb + 8 * (lane >> 4);
        for (int k0 = 0; k0 < K; k0 += 32) {
            bf16x8 a[4], b[4];
#pragma unroll
            for (int m = 0; m < 4; ++m) a[m] = *(const bf16x8*)(ap + (size_t)(16 * m) * lda + k0);
#pragma unroll
            for (int n = 0; n < 4; ++n) b[n] = *(const bf16x8*)(bp + (size_t)(16 * n) * ldb + k0);
#pragma unroll
            for (int m = 0; m < 4; ++m)
#pragma unroll
                for (int n = 0; n < 4; ++n) acc[m][n] = __builtin_amdgcn_mfma_f32_16x16x32_bf16(a[m], b[n], acc[m][n], 0, 0, 0);
        }
        epi(acc, row0, col0, lane);
    }
}

DEVI u32x4 heads8(u32x4 raw, const float (&gv)[8], bool do_norm, float scale, const float (&cs)[16], int lane) {
    float v[8];
#pragma unroll
    for (int j = 0; j < 4; ++j) { v[2 * j] = lo16(raw[j]); v[2 * j + 1] = hi16(raw[j]); }
    if (do_norm) {
        float ss = 0.f;
#pragma unroll
        for (int j = 0; j < 8; ++j) ss += v[j] * v[j];
        ss += __shfl_xor(ss, 1); ss += __shfl_xor(ss, 2); ss += __shfl_xor(ss, 4);
        const float rs = rsqrtf(ss * (1.f / 64.f) + EPS);
#pragma unroll
        for (int j = 0; j < 8; ++j) v[j] = v[j] * rs * gv[j];
    }
    const int sub = lane & 7;
#pragma unroll
    for (int j = 0; j < 8; ++j) { const float o = __shfl_xor(v[j], 1); if (sub == 0) v[j] = v[j] * cs[j] - o * cs[8 + j]; else if (sub == 1) v[j] = v[j] * cs[j] + o * cs[8 + j]; }
    u32x4 w;
#pragma unroll
    for (int j = 0; j < 4; ++j) w[j] = cvtpk(v[2 * j] * scale, v[2 * j + 1] * scale);
    return w;
}
DEVI void load8(float (&g)[8], const float* p) { const f32x4 a = *(const f32x4*)p, b = *(const f32x4*)(p + 4); g[0] = a[0]; g[1] = a[1]; g[2] = a[2]; g[3] = a[3]; g[4] = b[0]; g[5] = b[1]; g[6] = b[2]; g[7] = b[3]; }
struct Post0Row { u32x4 qa, ka, qb, x, ckv; u32x2 wi; f32x4 c0, c1, c2, c3; };
DEVI void post0_load(Post0Row& R, const bf16_t* row, const float* cs, int lane) {
    R.qa = *(const u32x4*)(row + C_QA + 8 * lane); R.ka = *(const u32x4*)(row + C_KA + 8 * lane); R.qb = *(const u32x4*)(row + C_QB + 8 * lane);
    R.x = *(const u32x4*)(row + C_QI + 8 * ((lane < 40) ? lane : 0));
    R.ckv = *(const u32x4*)(row + C_CKV + 8 * (lane & 31));
    R.wi = *(const u32x2*)(row + C_WI);
    R.c0 = *(const f32x4*)cs; R.c1 = *(const f32x4*)(cs + 4); R.c2 = *(const f32x4*)(cs + 8); R.c3 = *(const f32x4*)(cs + 12);
}
DEVI void phase_post0(const Params& P, int parts = 3) {
    static_assert(C_KI == C_QI + 256, "k_idx follows q_idx");
    const int tid = tid_opaque(), lane = tid & 63, wave = tid >> 6;
    const int gw = blockIdx.x * NWAVE + wave, NGW = gridDim.x * NWAVE;
    unsigned char* ws = P.ws;
    const float qscale = 0.125f * LOG2E;
    float gqa[8], gka[8], gqb[8], gki[8];
    load8(gqa, P.in[15] + 8 * (lane & 7)); load8(gka, P.in[16] + 8 * (lane & 7)); load8(gqb, P.in[24] + 8 * (lane & 7)); load8(gki, P.in[26] + 8 * (lane & 7));
    if (parts & 1)
    for (int m0 = gw; m0 < T; m0 += 2 * NGW) {
        Post0Row R[2];
        const int m1 = (m0 + NGW < T) ? m0 + NGW : m0;
        post0_load(R[0], (const bf16_t*)(ws + WS_PROJ) + (size_t)m0 * LDP, (const float*)(ws + WS_CS) + (size_t)m0 * 16, lane);
        post0_load(R[1], (const bf16_t*)(ws + WS_PROJ) + (size_t)m1 * LDP, (const float*)(ws + WS_CS) + (size_t)m1 * 16, lane);
#pragma unroll
        for (int k = 0; k < 2; ++k) {
            const int m = k ? m1 : m0; if (k == 1 && m1 == m0) break;
            bf16_t* row = (bf16_t*)(ws + WS_PROJ) + (size_t)m * LDP;
            float cs[16];
#pragma unroll
            for (int j = 0; j < 4; ++j) { cs[j] = R[k].c0[j]; cs[4 + j] = R[k].c1[j]; cs[8 + j] = R[k].c2[j]; cs[12 + j] = R[k].c3[j]; }
            *(u32x4*)(row + C_QA + 8 * lane) = heads8(R[k].qa, gqa, true, qscale, cs, lane);
            *(u32x4*)(row + C_KA + 8 * lane) = heads8(R[k].ka, gka, true, 1.f, cs, lane);
            *(u32x4*)(row + C_QB + 8 * lane) = heads8(R[k].qb, gqb, true, qscale, cs, lane);
            {
              float v[8];
#pragma unroll
              for (int j = 0; j < 4; ++j) { v[2 * j] = lo16(R[k].x[j]); v[2 * j + 1] = hi16(R[k].x[j]); }
              float ss = 0.f;
#pragma unroll
              for (int j = 0; j < 8; ++j) ss += v[j] * v[j];
              ss += __shfl_xor(ss, 1); ss += __shfl_xor(ss, 2); ss += __shfl_xor(ss, 4);
              if (lane >= 32) { const float rs = rsqrtf(ss * (1.f / 64.f) + EPS);
#pragma unroll
                  for (int j = 0; j < 8; ++j) v[j] = v[j] * rs * gki[j]; }
              const int sub = lane & 7;
#pragma unroll
              for (int j = 0; j < 8; ++j) { const float o = __shfl_xor(v[j], 1); if (sub == 0) v[j] = v[j] * cs[j] - o * cs[8 + j]; else if (sub == 1) v[j] = v[j] * cs[j] + o * cs[8 + j]; }
              u32x4 w;
#pragma unroll
              for (int j = 0; j < 4; ++j) w[j] = cvtpk(v[2 * j], v[2 * j + 1]);
              if (lane < 32) *(u32x4*)(row + C_QI + 8 * lane) = w;
              else if (lane < 40) { const int c = lane - 32;
                  *(u32x4*)((bf16_t*)(ws + WS_KI) + (size_t)(m >> 5) * 2048 + (c >> 1) * 512 + (((c & 1) * 32 + (m & 31)) * 8)) = w; } }
            { float ss = 0.f;
#pragma unroll
              for (int j = 0; j < 4; ++j) { const float a = lo16(R[k].ckv[j]), b = hi16(R[k].ckv[j]); ss += a * a + b * b; }
              ss += __shfl_xor(ss, 1); ss += __shfl_xor(ss, 2); ss += __shfl_xor(ss, 4); ss += __shfl_xor(ss, 8); ss += __shfl_xor(ss, 16);
              if (lane == 0) { ((float*)(ws + WS_SSQCKV))[m] = ss;
                  *(f32x4*)((float*)(ws + WS_WI) + (size_t)m * 4) = (f32x4){lo16(R[k].wi.x) * (1.f / 16.f), hi16(R[k].wi.x) * (1.f / 16.f), lo16(R[k].wi.y) * (1.f / 16.f), hi16(R[k].wi.y) * (1.f / 16.f)}; } }
        }
    }
    if (parts & 2)
    for (int it = gw; it < 2 * MEMT; it += NGW) {
        const int l = it / MEMT, m = it % MEMT;
        bf16_t* row = (bf16_t*)(ws + WS_KVX) + (size_t)m * 2048 + l * 1024;
        float g[8]; load8(g, P.in[10] + l * 128 + 8 * (lane & 15));
        const u32x4 raw = *(const u32x4*)(row + 8 * lane);
        float v[8]; float ss = 0.f;
#pragma unroll
        for (int j = 0; j < 4; ++j) { v[2 * j] = lo16(raw[j]); v[2 * j + 1] = hi16(raw[j]); ss += v[2 * j] * v[2 * j] + v[2 * j + 1] * v[2 * j + 1]; }
        ss += __shfl_xor(ss, 1); ss += __shfl_xor(ss, 2); ss += __shfl_xor(ss, 4); ss += __shfl_xor(ss, 8);
        const float rs = rsqrtf(ss * (1.f / 128.f) + EPS);
        u32x4 w;
#pragma unroll
        for (int j = 0; j < 4; ++j) w[j] = cvtpk(v[2 * j] * rs * g[2 * j], v[2 * j + 1] * rs * g[2 * j + 1]);
        *(u32x4*)(row + 8 * lane) = w;
    }
}
DEVI void phase_postkb(const Params& P) {
    const int tid = tid_opaque(), lane = tid & 63, wave = tid >> 6;
    const int gw = blockIdx.x * NWAVE + wave, NGW = gridDim.x * NWAVE;
    unsigned char* ws = P.ws;
    float gkb[8]; load8(gkb, P.in[25] + 8 * (lane & 7));
    for (int m0 = gw; m0 < T; m0 += 4 * NGW) {
        u32x4 raw[4]; f32x4 c[4][4];
#pragma unroll
        for (int k = 0; k < 4; ++k) { const int m = (m0 + k * NGW < T) ? m0 + k * NGW : m0;
            raw[k] = *(const u32x4*)((const bf16_t*)(ws + WS_KBVB) + (size_t)m * 1024 + 8 * lane);
            const float* cs = (const float*)(ws + WS_CS) + (size_t)m * 16;
#pragma unroll
            for (int j = 0; j < 4; ++j) c[k][j] = *(const f32x4*)(cs + 4 * j); }
#pragma unroll
        for (int k = 0; k < 4; ++k) { const int m = m0 + k * NGW; if (m >= T) break;
            float cs[16];
#pragma unroll
            for (int j = 0; j < 16; ++j) cs[j] = c[k][j >> 2][j & 3];
            *(u32x4*)((bf16_t*)(ws + WS_KBVB) + (size_t)m * 1024 + 8 * lane) = heads8(raw[k], gkb, true, 1.f, cs, lane); }
    }
}

DEVI int crow(int r, int hi) { return (r & 3) + 8 * (r >> 2) + 4 * hi; }
typedef short v4i16_t __attribute__((ext_vector_type(4)));
DEVI s16x4 vtr(LAS const unsigned char* p) { return __builtin_bit_cast(s16x4, __builtin_amdgcn_ds_read_tr16_b64_v4i16((LAS v4i16_t*)p)); }

DEVI float max3f(float a, float b, float c) { float r; asm("v_max3_f32 %0, %1, %2, %3" : "=v"(r) : "v"(a), "v"(b), "v"(c)); return r; }
DEVI float max2f(float a, float b) { float r; asm("v_max_f32_e32 %0, %1, %2" : "=v"(r) : "v"(a), "v"(b)); return r; }
template <int DQK, int DV, int MODE, bool QP = false>
DEVI void attn_core(f32x16 (&o)[DV / 32], float& l_out, const bf16x8 (&qf)[DQK / 16],
                    const bf16_t* Kg, int ldk, const bf16_t* Vg, int ldv, int ntiles, int qpos, int qpos_wmin,
                    const u64* mrow, LAS unsigned char* lds, int tid) {
    constexpr int KROWB = DQK * 2, KCPR = DQK / 8, VP = (DV == 128) ? 320 : 192, VCPR = DV / 8;
    constexpr int KBUF = 64 * KROWB, VBUF = 64 * VP, KCH = 64 * KCPR / NTHR, VCH = 64 * VCPR / NTHR;
    constexpr float THR = 8.f;
#define KSWZ(r) ((KCPR == 8) ? (((r) >> 1) & 7) : ((r) & 15))
    LAS unsigned char* Kl = lds; LAS unsigned char* Vl = lds + 2 * KBUF;
    const int lane = tid & 63, r32 = lane & 31, hi = lane >> 5;
    u32x4 kreg[KCH], vreg[VCH];
#define A_GLOAD(t) do { _Pragma("unroll") for (int i_ = 0; i_ < KCH; ++i_) { const int c_ = tid + NTHR * i_, row_ = c_ / KCPR, ch_ = c_ % KCPR; kreg[i_] = *(const u32x4*)(Kg + (size_t)(64 * (t) + row_) * ldk + ch_ * 8); } \
        _Pragma("unroll") for (int i_ = 0; i_ < VCH; ++i_) { const int c_ = tid + NTHR * i_, row_ = c_ / VCPR, ch_ = c_ % VCPR; vreg[i_] = *(const u32x4*)(Vg + (size_t)(64 * (t) + row_) * ldv + ch_ * 8); } } while (0)
#define A_LSTORE(buf) do { _Pragma("unroll") for (int i_ = 0; i_ < KCH; ++i_) { const int c_ = tid + NTHR * i_, row_ = c_ / KCPR, ch_ = c_ % KCPR; *(LAS u32x4*)(Kl + (buf) * KBUF + row_ * KROWB + ((ch_ ^ KSWZ(row_)) << 4)) = kreg[i_]; } \
        _Pragma("unroll") for (int i_ = 0; i_ < VCH; ++i_) { const int c_ = tid + NTHR * i_, row_ = c_ / VCPR, ch_ = c_ % VCPR; *(LAS u32x4*)(Vl + (buf) * VBUF + row_ * VP + ch_ * 16) = vreg[i_]; } } while (0)
    A_GLOAD(0); A_LSTORE(0); __syncthreads();
#pragma unroll
    for (int d0 = 0; d0 < DQK / 16; ++d0) asm volatile("" :: "v"(qf[d0]));
    const int vb = (4 * hi + ((lane & 15) >> 2)) * VP + (16 * ((lane >> 4) & 1) + 4 * (lane & 3)) * 2;
    const short one = (short)0x3F80;
    const bf16x8 ones = ((r32 & ~4) == 0) ? (bf16x8){one, one, one, one, one, one, one, one} : (bf16x8){0, 0, 0, 0, 0, 0, 0, 0};
    f32x16 negm, lacc;
#pragma unroll
    for (int r = 0; r < 16; ++r) { negm[r] = 0.f; lacc[r] = 0.f; }
    float mhat = 0.f;
    const unsigned ninf = 0xFF800000u;
#if MK_AX == 1
    f32x16 dmy_;
#pragma unroll
    for (int r = 0; r < 16; ++r) dmy_[r] = 0.f;
#endif
    u64 wnext = 0ull;
    if (MODE == 2) wnext = mrow[0];
    for (int t = 0; t < ntiles; ++t) {
        const int buf = t & 1;
        const u64 wcur = wnext; (void)wcur;
        if (MODE == 2 && t + 1 < ntiles) wnext = mrow[t + 1];
        if (t + 1 < ntiles) A_GLOAD(t + 1);
        f32x16 p0, p1;
#pragma unroll
        for (int db = 0; db < DQK / 64; ++db) {
            bf16x8 kf[8];
#pragma unroll
            for (int e = 0; e < 4; ++e) { const int ch = 2 * (4 * db + e) + hi, row0 = r32, row1 = 32 + r32;
                if (!QP) {
                    kf[2 * e] = *(LAS const bf16x8*)(Kl + buf * KBUF + row0 * KROWB + ((ch ^ KSWZ(row0)) << 4));
                    kf[2 * e + 1] = *(LAS const bf16x8*)(Kl + buf * KBUF + row1 * KROWB + ((ch ^ KSWZ(row1)) << 4));
                } else {
                    const int c1 = 2 * (4 * db + e);
                    const s16x4 a0 = *(LAS const s16x4*)(Kl + buf * KBUF + row0 * KROWB + ((c1 ^ KSWZ(row0)) << 4) + 8 * hi), a1 = *(LAS const s16x4*)(Kl + buf * KBUF + row0 * KROWB + (((c1 + 1) ^ KSWZ(row0)) << 4) + 8 * hi);
                    const s16x4 b0 = *(LAS const s16x4*)(Kl + buf * KBUF + row1 * KROWB + ((c1 ^ KSWZ(row1)) << 4) + 8 * hi), b1 = *(LAS const s16x4*)(Kl + buf * KBUF + row1 * KROWB + (((c1 + 1) ^ KSWZ(row1)) << 4) + 8 * hi);
                    kf[2 * e] = (bf16x8){a0[0], a0[1], a0[2], a0[3], a1[0], a1[1], a1[2], a1[3]}; kf[2 * e + 1] = (bf16x8){b0[0], b0[1], b0[2], b0[3], b1[0], b1[1], b1[2], b1[3]};
                } }
#pragma unroll
            for (int e = 0; e < 4; ++e) { const int d0 = 4 * db + e;
                if (d0 == 0 && MODE == 2) {
                    const u64 w = wcur >> (4 * hi); const unsigned wl = (unsigned)w, wh = (unsigned)(w >> 32), nm = __float_as_uint(negm[0]);
#pragma unroll
                    for (int r = 0; r < 16; ++r) { const int bit = (r & 3) + 8 * (r >> 2);
                        const unsigned s0 = (unsigned)__builtin_amdgcn_sbfe(wl, bit, 1), s1 = (unsigned)__builtin_amdgcn_sbfe(wh, bit, 1);
                        p0[r] = __uint_as_float((nm & s0) | (ninf & ~s0)); p1[r] = __uint_as_float((nm & s1) | (ninf & ~s1)); }
                    p0 = __builtin_amdgcn_mfma_f32_32x32x16_bf16(kf[0], qf[0], p0, 0, 0, 0); p1 = __builtin_amdgcn_mfma_f32_32x32x16_bf16(kf[1], qf[0], p1, 0, 0, 0); }
                else if (d0 == 0) { p0 = __builtin_amdgcn_mfma_f32_32x32x16_bf16(kf[0], qf[0], negm, 0, 0, 0); p1 = __builtin_amdgcn_mfma_f32_32x32x16_bf16(kf[1], qf[0], negm, 0, 0, 0); }
                else { p0 = __builtin_amdgcn_mfma_f32_32x32x16_bf16(kf[2 * e], qf[d0], p0, 0, 0, 0); p1 = __builtin_amdgcn_mfma_f32_32x32x16_bf16(kf[2 * e + 1], qf[d0], p1, 0, 0, 0); } }
        }
        if (MODE == 1) {
            if (64 * t + 63 > qpos_wmin) {
#pragma unroll
                for (int r = 0; r < 16; ++r) { const int kv = 64 * t + crow(r, hi); if (kv > qpos) p0[r] = -INFINITY; if (kv + 32 > qpos) p1[r] = -INFINITY; }
            }
        }
        asm volatile("s_nop 15\n\ts_nop 7" : "+v"(p0), "+v"(p1));
        float rm;
        { float a, b;
#define MAX16(R, X) asm("v_max3_f32 %0, %1, %2, %3\n\tv_max3_f32 %0, %0, %4, %5\n\tv_max3_f32 %0, %0, %6, %7\n\tv_max3_f32 %0, %0, %8, %9\n\tv_max3_f32 %0, %0, %10, %11\n\tv_max3_f32 %0, %0, %12, %13\n\tv_max3_f32 %0, %0, %14, %15\n\tv_max_f32 %0, %0, %16" \
            : "=&v"(R) : "v"(X[0]), "v"(X[1]), "v"(X[2]), "v"(X[3]), "v"(X[4]), "v"(X[5]), "v"(X[6]), "v"(X[7]), "v"(X[8]), "v"(X[9]), "v"(X[10]), "v"(X[11]), "v"(X[12]), "v"(X[13]), "v"(X[14]), "v"(X[15]))
          MAX16(a, p0); MAX16(b, p1);
#undef MAX16
          const float m = max2f(a, b);
          const auto rr = __builtin_amdgcn_permlane32_swap(__float_as_uint(m), __float_as_uint(m), false, false);
          rm = max2f(__uint_as_float(rr[0]), __uint_as_float(rr[1])); }
        if (t == 0 || __any(rm > THR)) {
            const float dl = (t == 0) ? ((rm > -INFINITY) ? rm : 0.f) : fmaxf(rm, 0.f);
            mhat += dl;
#pragma unroll
            for (int r = 0; r < 16; ++r) { p0[r] -= dl; p1[r] -= dl; negm[r] = -mhat; }
            const float f = __builtin_amdgcn_exp2f(-dl);
#pragma unroll
            for (int d0 = 0; d0 < DV / 32; ++d0)
#pragma unroll
                for (int r = 0; r < 16; ++r) o[d0][r] *= f;
#pragma unroll
            for (int r = 0; r < 16; ++r) lacc[r] *= f;
        }
#pragma unroll
        for (int r = 0; r < 16; ++r) { p0[r] = __builtin_amdgcn_exp2f(p0[r]); p1[r] = __builtin_amdgcn_exp2f(p1[r]); }
#if MK_AX == 2
        if (MODE == 1) {
#pragma unroll
            for (int r = 0; r < 16; ++r) { float e0 = __builtin_amdgcn_exp2f(p0[r] * 0.999f), e1 = __builtin_amdgcn_exp2f(p1[r] * 0.999f); asm volatile("" :: "v"(e0), "v"(e1)); } }
#endif
        bf16x8 pb[4];
#pragma unroll
        for (int ks = 0; ks < 4; ++ks) {
            u32x4 w;
            if (ks < 2) { w.x = cvtpk(p0[8 * ks + 0], p0[8 * ks + 1]); w.y = cvtpk(p0[8 * ks + 2], p0[8 * ks + 3]); w.z = cvtpk(p0[8 * ks + 4], p0[8 * ks + 5]); w.w = cvtpk(p0[8 * ks + 6], p0[8 * ks + 7]); }
            else { const int k2 = ks - 2; w.x = cvtpk(p1[8 * k2 + 0], p1[8 * k2 + 1]); w.y = cvtpk(p1[8 * k2 + 2], p1[8 * k2 + 3]); w.z = cvtpk(p1[8 * k2 + 4], p1[8 * k2 + 5]); w.w = cvtpk(p1[8 * k2 + 6], p1[8 * k2 + 7]); }
            pb[ks] = __builtin_bit_cast(bf16x8, w);
        }
#pragma unroll
        for (int ks = 0; ks < 4; ++ks) lacc = __builtin_amdgcn_mfma_f32_32x32x16_bf16(ones, pb[ks], lacc, 0, 0, 0);
#pragma unroll
        for (int d0 = 0; d0 < DV / 32; ++d0)
#pragma unroll
            for (int ks = 0; ks < 4; ++ks) {
                const s16x4 lo = vtr(Vl + buf * VBUF + vb + (16 * ks) * VP + d0 * 64);
                const s16x4 hh = vtr(Vl + buf * VBUF + vb + (16 * ks + 8) * VP + d0 * 64);
                const bf16x8 a = (bf16x8){lo[0], lo[1], lo[2], lo[3], hh[0], hh[1], hh[2], hh[3]};
                o[d0] = __builtin_amdgcn_mfma_f32_32x32x16_bf16(a, pb[ks], o[d0], 0, 0, 0);
#if MK_AX == 1
                if (MODE == 1) dmy_ = __builtin_amdgcn_mfma_f32_32x32x16_bf16(a, pb[ks], dmy_, 0, 0, 0);
#endif
            }
        if (t + 1 < ntiles) A_LSTORE((t + 1) & 1);
        __syncthreads();
    }
#if MK_AX == 1
    asm volatile("" :: "v"(dmy_));
#endif
    l_out = lacc[0];
#undef A_GLOAD
#undef A_LSTORE
#undef KSWZ
}
template <int DV>
DEVI void store_oT(const f32x16 (&o)[DV / 32], float inv, bf16_t* dst, int hi) {
#pragma unroll
    for (int d0 = 0; d0 < DV / 32; ++d0)
#pragma unroll
        for (int g4 = 0; g4 < 4; ++g4) {
            u32x2 w; w.x = cvtpk(o[d0][4 * g4 + 0] * inv, o[d0][4 * g4 + 1] * inv); w.y = cvtpk(o[d0][4 * g4 + 2] * inv, o[d0][4 * g4 + 3] * inv);
            *(u32x2*)(dst + 32 * d0 + 8 * g4 + 4 * hi) = w;
        }
}

DEVI void attnA_unit(const Params& P, int b, int h, int c, int qb, LAS unsigned char* lds) {
    const int tid = tid_opaque(), lane = tid & 63, wave = tid >> 6, r32 = lane & 31, hi = lane >> 5;
    unsigned char* ws = P.ws;
    const bf16_t* proj = (const bf16_t*)(ws + WS_PROJ);
    const int q = qb * 256 + 32 * wave + r32; const size_t row = (size_t)b * S + q;
    bf16x8 qf[4];
#pragma unroll
    for (int d0 = 0; d0 < 4; ++d0) qf[d0] = *(const bf16x8*)(proj + row * LDP + C_QA + (2 * h + c) * 64 + 16 * d0 + 8 * hi);
    f32x16 o[4];
#pragma unroll
    for (int d0 = 0; d0 < 4; ++d0)
#pragma unroll
        for (int r = 0; r < 16; ++r) o[d0][r] = 0.f;
    float l_run = 0.f;
    attn_core<64, 128, 1>(o, l_run, qf, proj + (size_t)b * S * LDP + C_KA + (2 * h + c) * 64, LDP, proj + (size_t)b * S * LDP + C_VA + h * 128, LDP,
                          4 * (qb + 1), q, qb * 256 + 32 * wave, nullptr, lds, tid);
    const float lt = l_run;
    bf16_t* oa = (bf16_t*)(ws + WS_XB) + (size_t)c * T * 512 + row * 512 + h * 128;
    store_oT<128>(o, 1.f / lt, oa, hi);
}
DEVI void attnB_unit(const Params& P, int b, int hd, int qb, LAS unsigned char* lds) {
    const int tid = tid_opaque(), lane = tid & 63, wave = tid >> 6, r32 = lane & 31, hi = lane >> 5;
    unsigned char* ws = P.ws;
    const bf16_t* proj = (const bf16_t*)(ws + WS_PROJ); const bf16_t* kbvb = (const bf16_t*)(ws + WS_KBVB);
    const int q = qb * 256 + 32 * wave + r32; const size_t row = (size_t)b * S + q;
    bf16x8 qf[4];
#pragma unroll
    for (int d0 = 0; d0 < 4; ++d0) qf[d0] = *(const bf16x8*)(proj + row * LDP + C_QB + hd * 64 + 16 * d0 + 8 * hi);
    f32x16 o[2];
#pragma unroll
    for (int d0 = 0; d0 < 2; ++d0)
#pragma unroll
        for (int r = 0; r < 16; ++r) o[d0][r] = 0.f;
    float l_run = 0.f;
    attn_core<64, 64, 2>(o, l_run, qf, kbvb + (size_t)b * S * 1024 + hd * 64, 1024, kbvb + (size_t)b * S * 1024 + 512 + hd * 64, 1024,
                         4 * (qb + 1), q, qb * 256 + 32 * wave, (const u64*)(ws + WS_MASK) + row * 64, lds, tid);
    const float lt = l_run;
    store_oT<64>(o, 1.f / lt, (bf16_t*)(ws + WS_Y) + row * 1024 + 512 + hd * 64, hi);
}
DEVI void xattn_unit(const Params& P, int l, int b, int hd, int qb, LAS unsigned char* lds) {
    const int tid = tid_opaque(), lane = tid & 63, wave = tid >> 6, r32 = lane & 31, hi = lane >> 5;
    unsigned char* ws = P.ws;
    const bf16_t* qx = (const bf16_t*)(ws + WS_QX); const bf16_t* kvx = (const bf16_t*)(ws + WS_KVX) + l * 1024;
    const int q = qb * 256 + 32 * wave + r32; const size_t row = (size_t)b * S + q;
    const float* gq = P.in[9] + l * 128;
    u32x4 raw[8]; float ss = 0.f;
    f32x4 gqv[8][2];
#pragma unroll
    for (int d0 = 0; d0 < 8; ++d0) { raw[d0] = *(const u32x4*)(qx + row * 512 + hd * 128 + 16 * d0 + 8 * hi); gqv[d0][0] = *(const f32x4*)(gq + 16 * d0 + 8 * hi); gqv[d0][1] = *(const f32x4*)(gq + 16 * d0 + 8 * hi + 4); }
#pragma unroll
    for (int d0 = 0; d0 < 8; ++d0) {
#pragma unroll
        for (int j = 0; j < 4; ++j) { const float a = lo16(raw[d0][j]), bq = hi16(raw[d0][j]); ss += a * a + bq * bq; } }
    ss += __shfl_xor(ss, 32);
    const float rs = rsqrtf(ss * (1.f / 128.f) + EPS) * (0.08838834764831845f * LOG2E);
    bf16x8 qf[8];
#pragma unroll
    for (int d0 = 0; d0 < 8; ++d0) { u32x4 w;
#pragma unroll
        for (int j = 0; j < 4; ++j) w[j] = cvtpk(lo16(raw[d0][j]) * rs * gqv[d0][j >> 1][(2 * j) & 3], hi16(raw[d0][j]) * rs * gqv[d0][j >> 1][(2 * j + 1) & 3]);
        qf[d0] = __builtin_bit_cast(bf16x8, w); }
    f32x16 o[4];
#pragma unroll
    for (int d0 = 0; d0 < 4; ++d0)
#pragma unroll
        for (int r = 0; r < 16; ++r) o[d0][r] = 0.f;
    float l_run = 0.f;
#if MK_XA2
    attn_core<128, 128, 0>(o, l_run, qf, kvx + (size_t)b * MEML * 2048 + hd * 128, 2048, kvx + (size_t)b * MEML * 2048 + 512 + hd * 128, 2048, MEML / 64, q, 0, nullptr, lds, tid);
#pragma unroll
    for (int d0 = 0; d0 < 4; ++d0)
#pragma unroll
        for (int r = 0; r < 16; ++r) o[d0][r] = 0.f;
    l_run = 0.f;
#endif
    attn_core<128, 128, 0>(o, l_run, qf, kvx + (size_t)b * MEML * 2048 + hd * 128, 2048, kvx + (size_t)b * MEML * 2048 + 512 + hd * 128, 2048,
                           MEML / 64, q, 0, nullptr, lds, tid);
    const float lt = l_run;
    store_oT<128>(o, 1.f / lt, (bf16_t*)(ws + WS_YX) + row * 512 + hd * 128, hi);
}

DEVI void xattn_fused_unit(const Params& P, int l, int b, int hd, int qb, LAS unsigned char* lds) {
    const int tid = tid_opaque(), lane = tid & 63, wave = tid >> 6, r32 = lane & 31, hi = lane >> 5;
    unsigned char* ws = P.ws;
    const bf16_t* kvx = (const bf16_t*)(ws + WS_KVX) + l * 1024;
    const int q = qb * 256 + 32 * wave + r32; const size_t row = (size_t)b * S + q;
    const bf16_t* Wh = (const bf16_t*)(ws + W_QX) + (size_t)l * 512 * 1024 + (size_t)(hd * 128) * 1024;
    const float ssqx = ((const float*)(ws + WS_SSQ))[(size_t)(l ? 4 : 1) * T + row];
    const float* gq = P.in[9] + l * 128;
#if MK_TPROBE >= 30
    unsigned long long tsx_[5]; tsx_[0] = __builtin_amdgcn_s_memtime();
#endif
    f32x16 acc[4];
#pragma unroll
    for (int blk = 0; blk < 4; ++blk)
#pragma unroll
        for (int r = 0; r < 16; ++r) acc[blk][r] = 0.f;
    u32x4 wa[2], wb[2], xr[4];
    const bf16_t* Xb = (const bf16_t*)(ws + WS_XB) + ((size_t)b * S + qb * 256) * 1024;
    LAS unsigned char* XL = lds + 49152;
#define XF_WLOAD(W_, s) do { _Pragma("unroll") for (int i_ = 0; i_ < 2; ++i_) { const int c_ = tid + NTHR * i_; W_[i_] = *(const u32x4*)(Wh + (size_t)(c_ >> 3) * 1024 + 64 * (s) + (c_ & 7) * 8); } } while (0)
#define XF_WSTORE(W_, buf) do { _Pragma("unroll") for (int i_ = 0; i_ < 2; ++i_) { const int c_ = tid + NTHR * i_, row_ = c_ >> 3, ch_ = c_ & 7; *(LAS u32x4*)(lds + (buf) * 16384 + row_ * 128 + ((ch_ ^ ((row_ >> 1) & 7)) << 4)) = W_[i_]; } } while (0)
#define XF_XLOAD(s) do { _Pragma("unroll") for (int i_ = 0; i_ < 4; ++i_) { const int c_ = tid + NTHR * i_; xr[i_] = *(const u32x4*)(Xb + (size_t)(c_ >> 3) * 1024 + 64 * (s) + (c_ & 7) * 8); } } while (0)
#define XF_XSTORE(buf) do { _Pragma("unroll") for (int i_ = 0; i_ < 4; ++i_) { const int c_ = tid + NTHR * i_, row_ = c_ >> 3, ch_ = c_ & 7; *(LAS u32x4*)(XL + (buf) * 32768 + row_ * 128 + ((ch_ ^ ((row_ >> 1) & 7)) << 4)) = xr[i_]; } } while (0)
#define XF_MMA(wbuf, xbuf) do { bf16x8 wf_[4][4], xq_[4];        \
        _Pragma("unroll") for (int ks = 0; ks < 4; ++ks) { const int xrow = 32 * wave + r32, ch = 2 * ks + hi; \
            xq_[ks] = *(LAS const bf16x8*)(XL + (xbuf) * 32768 + xrow * 128 + ((ch ^ ((xrow >> 1) & 7)) << 4)); \
            _Pragma("unroll") for (int blk = 0; blk < 4; ++blk) { const int rw = 32 * blk + r32; \
                wf_[ks][blk] = *(LAS const bf16x8*)(lds + (wbuf) * 16384 + rw * 128 + ((ch ^ ((rw >> 1) & 7)) << 4)); } } \
        asm volatile("s_waitcnt lgkmcnt(0)" ::: "memory"); __builtin_amdgcn_sched_barrier(0); \
        _Pragma("unroll") for (int ks = 0; ks < 4; ++ks) _Pragma("unroll") for (int blk = 0; blk < 4; ++blk) acc[blk] = __builtin_amdgcn_mfma_f32_32x32x16_bf16(wf_[ks][blk], xq_[ks], acc[blk], 0, 0, 0); \
        __builtin_amdgcn_sched_barrier(0); } while (0)
    XF_WLOAD(wa, 0); XF_WLOAD(wb, 1); XF_XLOAD(0);
    XF_WSTORE(wa, 0); XF_WSTORE(wb, 1); XF_XSTORE(0); __syncthreads();
    for (int s = 0; s < 16; s += 2) {
        if (s + 2 < 16) XF_WLOAD(wa, s + 2);
        XF_XLOAD(s + 1);
        XF_MMA(s % 3, 0);
        if (s + 2 < 16) XF_WSTORE(wa, (s + 2) % 3);
        XF_XSTORE(1);
        __syncthreads();
        if (s + 3 < 16) XF_WLOAD(wb, s + 3);
        if (s + 2 < 16) XF_XLOAD(s + 2);
        XF_MMA((s + 1) % 3, 1);
        if (s + 3 < 16) XF_WSTORE(wb, (s + 3) % 3);
        if (s + 2 < 16) XF_XSTORE(0);
        __syncthreads();
    }
#undef XF_WLOAD
#undef XF_WSTORE
#undef XF_XLOAD
#undef XF_XSTORE
#undef XF_MMA
#if MK_TPROBE >= 30
    asm volatile("s_waitcnt vmcnt(0) lgkmcnt(0)" ::: "memory"); tsx_[1] = __builtin_amdgcn_s_memtime();
#endif
    f32x4 gqv[4][4];
#pragma unroll
    for (int blk = 0; blk < 4; ++blk)
#pragma unroll
        for (int g4 = 0; g4 < 4; ++g4) gqv[blk][g4] = *(const f32x4*)(gq + 32 * blk + 8 * g4 + 4 * hi);
    float ss = 0.f;
#pragma unroll
    for (int blk = 0; blk < 4; ++blk)
#pragma unroll
        for (int r = 0; r < 16; ++r) ss += acc[blk][r] * acc[blk][r];
    { const auto sw = __builtin_amdgcn_permlane32_swap(__float_as_uint(ss), __float_as_uint(ss), false, false); ss = __uint_as_float(sw[0]) + __uint_as_float(sw[1]); }
    const float c = rsqrtf(ssqx * (1.f / 1024.f) + EPS);
    const float f = c * rsqrtf(c * c * ss * (1.f / 128.f) + EPS) * (0.08838834764831845f * LOG2E);
    bf16x8 qf[8];
#pragma unroll
    for (int blk = 0; blk < 4; ++blk)
#pragma unroll
        for (int e = 0; e < 2; ++e) { u32x4 w;
#pragma unroll
            for (int jj = 0; jj < 4; ++jj) { const int r0 = 8 * e + 2 * jj;
                w[jj] = cvtpk(acc[blk][r0] * f * gqv[blk][r0 >> 2][r0 & 3], acc[blk][r0 + 1] * f * gqv[blk][r0 >> 2][(r0 & 3) + 1]); }
            qf[2 * blk + e] = __builtin_bit_cast(bf16x8, w); }
    f32x16 o[4];
#pragma unroll
    for (int d0 = 0; d0 < 4; ++d0)
#pragma unroll
        for (int r = 0; r < 16; ++r) o[d0][r] = 0.f;
    float l_run = 0.f;
#if MK_TPROBE >= 30
    asm volatile("s_waitcnt vmcnt(0) lgkmcnt(0)" ::: "memory"); tsx_[2] = __builtin_amdgcn_s_memtime();
#endif
    attn_core<128, 128, 0, true>(o, l_run, qf, kvx + (size_t)b * MEML * 2048 + hd * 128, 2048, kvx + (size_t)b * MEML * 2048 + 512 + hd * 128, 2048,
                                 MEML / 64, q, 0, nullptr, lds, tid);
#if MK_TPROBE >= 30
    asm volatile("s_waitcnt vmcnt(0) lgkmcnt(0)" ::: "memory"); tsx_[3] = __builtin_amdgcn_s_memtime();
#endif
    store_oT<128>(o, 1.f / l_run, (bf16_t*)(ws + WS_YX) + row * 512 + hd * 128, hi);
#if MK_TPROBE >= 30
    asm volatile("s_waitcnt vmcnt(0) lgkmcnt(0)" ::: "memory"); tsx_[4] = __builtin_amdgcn_s_memtime();
    if (blockIdx.x == 0 && tid == 0 && l == 0) { unsigned long long* TS = (unsigned long long*)(ws + WS_BAR + 65536); for (int k = 0; k < 4; ++k) atomicAdd(TS + 16 + k, tsx_[k + 1] - tsx_[k]); atomicAdd(TS + 20, tsx_[4] - tsx_[0]); }
#endif
}

#define DPP_STEP4(OP, v) do { v = OP(v, __builtin_amdgcn_update_dpp(v, v, 0xB1, 0xF, 0xF, false)); v = OP(v, __builtin_amdgcn_update_dpp(v, v, 0x4E, 0xF, 0xF, false)); \
        v = OP(v, __builtin_amdgcn_update_dpp(v, v, 0x141, 0xF, 0xF, false)); v = OP(v, __builtin_amdgcn_update_dpp(v, v, 0x140, 0xF, 0xF, false)); } while (0)
DEVI unsigned umax2(unsigned a, unsigned b) { return a > b ? a : b; }
DEVI unsigned umin2(unsigned a, unsigned b) { return a < b ? a : b; }
DEVI unsigned wave_max_u32(unsigned v) { DPP_STEP4(umax2, v);
    const auto a = __builtin_amdgcn_permlane16_swap(v, v, false, false); v = umax2(a[0], a[1]);
    const auto b = __builtin_amdgcn_permlane32_swap(v, v, false, false); return umax2(b[0], b[1]); }
DEVI unsigned wave_min_u32(unsigned v) { DPP_STEP4(umin2, v);
    const auto a = __builtin_amdgcn_permlane16_swap(v, v, false, false); v = umin2(a[0], a[1]);
    const auto b = __builtin_amdgcn_permlane32_swap(v, v, false, false); return umin2(b[0], b[1]); }
DEVI float row16_sum(float s) {
    s += __builtin_bit_cast(float, __builtin_amdgcn_update_dpp(0, __builtin_bit_cast(int, s), 0xB1, 0xF, 0xF, false)); s += __builtin_bit_cast(float, __builtin_amdgcn_update_dpp(0, __builtin_bit_cast(int, s), 0x4E, 0xF, 0xF, false));
    s += __builtin_bit_cast(float, __builtin_amdgcn_update_dpp(0, __builtin_bit_cast(int, s), 0x141, 0xF, 0xF, false)); s += __builtin_bit_cast(float, __builtin_amdgcn_update_dpp(0, __builtin_bit_cast(int, s), 0x140, 0xF, 0xF, false));
    return s; }
DEVI int wave_sum_dpp(int v) {
    v += __builtin_amdgcn_update_dpp(0, v, 0xB1, 0xF, 0xF, false);
    v += __builtin_amdgcn_update_dpp(0, v, 0x4E, 0xF, 0xF, false);
    v += __builtin_amdgcn_update_dpp(0, v, 0x141, 0xF, 0xF, false);
    v += __builtin_amdgcn_update_dpp(0, v, 0x140, 0xF, 0xF, false);
    return (__builtin_amdgcn_readlane(v, 0) + __builtin_amdgcn_readlane(v, 16)) + (__builtin_amdgcn_readlane(v, 32) + __builtin_amdgcn_readlane(v, 48));
}
constexpr int IDX_SROW = 4096 + 64;
DEVI void indexer_unit(const Params& P, int b, int t0, LAS unsigned char* lds) {
    const int tid = tid_opaque(), lane = tid & 63, wave = __builtin_amdgcn_readfirstlane(tid >> 6), r32 = lane & 31, hi = lane >> 5;
    unsigned char* ws = P.ws;
    const bf16_t* proj = (const bf16_t*)(ws + WS_PROJ); const float* WI = (const float*)(ws + WS_WI);
    LAS float* Ssc = (LAS float*)lds;
    for (int rs_ = 0; rs_ < 1 + MK_SC2; ++rs_)
    if (t0 + 7 >= 255) {
        bf16x8 af[4];
        { const int qq = r32 >> 2, hh = r32 & 3; const size_t row = (size_t)b * S + t0 + qq;
#pragma unroll
          for (int d0 = 0; d0 < 4; ++d0) af[d0] = *(const bf16x8*)(proj + row * LDP + C_QI + hh * 64 + 16 * d0 + 8 * hi); }
        float wv[16];
#pragma unroll
        for (int r = 0; r < 16; ++r) wv[r] = WI[((size_t)b * S + t0 + 2 * (r >> 2) + hi) * 4 + (r & 3)];
        const int nkt = (t0 + 8 + 31) / 32;
        const bf16_t* kbase = (const bf16_t*)(ws + WS_KI) + (size_t)(b * (S / 32)) * 2048 + lane * 8;
        bf16x8 kb0[4], kb1[4], kb2[4], kb3[4];
#define IDX_LOAD(B, kt_) do { const int k_ = ((kt_) < nkt) ? (kt_) : (nkt - 1); _Pragma("unroll") for (int d0 = 0; d0 < 4; ++d0) B[d0] = *(const bf16x8*)(kbase + (size_t)k_ * 2048 + d0 * 512); } while (0)
#define IDX_COMP(B, kt_) do { f32x16 c; _Pragma("unroll") for (int r = 0; r < 16; ++r) c[r] = 0.f; \
            _Pragma("unroll") for (int d0 = 0; d0 < 4; ++d0) c = __builtin_amdgcn_mfma_f32_32x32x16_bf16(af[d0], B[d0], c, 0, 0, 0); \
            const int key = (kt_) * 32 + r32; \
            _Pragma("unroll") for (int g4 = 0; g4 < 4; ++g4) { float s = 0.f; \
                _Pragma("unroll") for (int hh = 0; hh < 4; ++hh) s += fmaxf(c[4 * g4 + hh], 0.f) * wv[4 * g4 + hh]; \
                if ((kt_) == nkt - 1 && key > t0 + 2 * g4 + hi) s = -INFINITY;        \
                Ssc[(2 * g4 + hi) * IDX_SROW + key + (key >> 6)] = s; } } while (0)
#define IDX_FENCE() asm volatile("" ::: "memory")
        IDX_LOAD(kb0, wave); IDX_LOAD(kb1, wave + NWAVE); IDX_LOAD(kb2, wave + 2 * NWAVE); IDX_FENCE();
        for (int kt = wave; kt < nkt; kt += 4 * NWAVE) {
            IDX_LOAD(kb3, kt + 3 * NWAVE); IDX_FENCE(); IDX_COMP(kb0, kt); IDX_FENCE();
            if (kt + NWAVE >= nkt) break;
            IDX_LOAD(kb0, kt + 4 * NWAVE); IDX_FENCE(); IDX_COMP(kb1, kt + NWAVE); IDX_FENCE();
            if (kt + 2 * NWAVE >= nkt) break;
            IDX_LOAD(kb1, kt + 5 * NWAVE); IDX_FENCE(); IDX_COMP(kb2, kt + 2 * NWAVE); IDX_FENCE();
            if (kt + 3 * NWAVE >= nkt) break;
            IDX_LOAD(kb2, kt + 6 * NWAVE); IDX_FENCE(); IDX_COMP(kb3, kt + 3 * NWAVE); IDX_FENCE();
        }
#undef IDX_FENCE
#undef IDX_LOAD
#undef IDX_COMP
        if ((nkt & 1) && lane < 32) { const int key = nkt * 32 + lane; Ssc[wave * IDX_SROW + key + (key >> 6)] = -INFINITY; }
        if (wave == 0) Ssc[8 * IDX_SROW + lane] = -INFINITY;
    }
    __syncthreads();
    for (int rr_ = 0; rr_ < 1 + MK_SEL2; ++rr_) {
        const int t = t0 + wave; u64 myw = 0ull;
#if MK_TPROBE
        unsigned long long ts0_ = __builtin_amdgcn_s_memtime(), ts1_ = ts0_, ts2_ = ts0_;
#endif
        if (t >= 255) {
            unsigned u[64];
            { const LAS float* srow = (64 * lane <= t) ? (Ssc + wave * IDX_SROW + 65 * lane) : (Ssc + 8 * IDX_SROW);
#pragma unroll
              for (int j = 0; j < 64; ++j) { const unsigned bits = __float_as_uint(srow[j]);
                  u[j] = bits ^ ((unsigned)((int)bits >> 31) | 0x80000000u); } }
            unsigned a32[32], a16[16], a8[8], a4[4];
#pragma unroll
            for (int i = 0; i < 32; ++i) a32[i] = max(u[2 * i], u[2 * i + 1]);
#pragma unroll
            for (int i = 0; i < 16; ++i) a16[i] = max(a32[2 * i], a32[2 * i + 1]);
#pragma unroll
            for (int i = 0; i < 8; ++i) a8[i] = max(a16[2 * i], a16[2 * i + 1]);
#pragma unroll
            for (int i = 0; i < 4; ++i) a4[i] = max(a8[2 * i], a8[2 * i + 1]);
            unsigned Mx = max(max(a4[0], a4[1]), max(a4[2], a4[3])), Lx = 0xffffffffu;
            { const int nfull = __builtin_amdgcn_readfirstlane((t + 1) >> 6); int nl;
              if (nfull >= 64) { nl = 64; Lx = min(min(a4[0], a4[1]), min(a4[2], a4[3])); }
              else if (nfull >= 32) { nl = 32;
#pragma unroll
                  for (int i = 0; i < 8; ++i) Lx = min(Lx, a8[i]); }
              else if (nfull >= 16) { nl = 16;
#pragma unroll
                  for (int i = 0; i < 16; ++i) Lx = min(Lx, a16[i]); }
              else if (nfull >= 8) { nl = 8;
#pragma unroll
                  for (int i = 0; i < 32; ++i) Lx = min(Lx, a32[i]); }
              else { nl = 4;
#pragma unroll
                  for (int j = 0; j < 64; ++j) Lx = min(Lx, u[j]); }
              if (lane >= nl) Lx = 0xffffffffu;
              Mx = wave_max_u32(Mx); Lx = wave_min_u32(Lx); }
            Mx = __builtin_amdgcn_readfirstlane(Mx); Lx = __builtin_amdgcn_readfirstlane(Lx);
#if MK_TPROBE
            asm volatile("s_waitcnt vmcnt(0) lgkmcnt(0)" ::: "memory"); ts1_ = __builtin_amdgcn_s_memtime();
#endif
            { const unsigned lxm1 = Lx - 1u;
#pragma unroll
              for (int j = 0; j < 64; ++j) u[j] = __builtin_elementwise_sub_sat(u[j], lxm1); }
            unsigned prefix = 0u; bool exact = false;
            for (int rb_ = 0; rb_ < 1 + MK_BIS2; ++rb_) { prefix = 0u; exact = false;
            for (int bit = 31 - __builtin_clz(Mx - Lx + 1u); bit >= 0; --bit) {
                const unsigned cand = prefix | (1u << bit); int c0 = 0, c1 = 0, c2 = 0, c3 = 0;
#define IDX_CNT8(j0) asm volatile( \
                    "v_cmp_le_u32 vcc, %10, %2\n\tv_addc_co_u32 %0, vcc, 0, %0, vcc\n\tv_cmp_le_u32 vcc, %10, %3\n\tv_addc_co_u32 %1, vcc, 0, %1, vcc\n\t" \
                    "v_cmp_le_u32 vcc, %10, %4\n\tv_addc_co_u32 %0, vcc, 0, %0, vcc\n\tv_cmp_le_u32 vcc, %10, %5\n\tv_addc_co_u32 %1, vcc, 0, %1, vcc\n\t" \
                    "v_cmp_le_u32 vcc, %10, %6\n\tv_addc_co_u32 %0, vcc, 0, %0, vcc\n\tv_cmp_le_u32 vcc, %10, %7\n\tv_addc_co_u32 %1, vcc, 0, %1, vcc\n\t" \
                    "v_cmp_le_u32 vcc, %10, %8\n\tv_addc_co_u32 %0, vcc, 0, %0, vcc\n\tv_cmp_le_u32 vcc, %10, %9\n\tv_addc_co_u32 %1, vcc, 0, %1, vcc" \
                    : "+v"(c0), "+v"(c1) \
                    : "v"(u[(j0)]), "v"(u[(j0) + 1]), "v"(u[(j0) + 2]), "v"(u[(j0) + 3]), "v"(u[(j0) + 4]), "v"(u[(j0) + 5]), "v"(u[(j0) + 6]), "v"(u[(j0) + 7]), "v"(candv) : "vcc")
                const unsigned candv = cand;
                IDX_CNT8(0); IDX_CNT8(8); IDX_CNT8(16); IDX_CNT8(24); IDX_CNT8(32); IDX_CNT8(40); IDX_CNT8(48); IDX_CNT8(56);
#undef IDX_CNT8
                c2 = 0; c3 = 0;
                const int cnt = wave_sum_dpp((c0 + c1) + (c2 + c3));
                if (cnt >= 256) prefix = cand;
                if (cnt == 256) { exact = true; break; }
            }
            }
#if MK_TPROBE
            asm volatile("s_waitcnt vmcnt(0) lgkmcnt(0)" ::: "memory"); ts2_ = __builtin_amdgcn_s_memtime();
#endif
            unsigned mlo = 0u, mhi = 0u;
            if (exact) {
#pragma unroll
                for (int j = 31; j >= 0; --j) asm volatile("v_cmp_le_u32 vcc, %4, %2\n\tv_addc_co_u32 %0, vcc, %0, %0, vcc\n\tv_cmp_le_u32 vcc, %4, %3\n\tv_addc_co_u32 %1, vcc, %1, %1, vcc"
                                                           : "+v"(mlo), "+v"(mhi) : "v"(u[j]), "v"(u[32 + j]), "v"(prefix) : "vcc");
            } else {
                int ngt = 0, nti = 0;
#pragma unroll
                for (int j = 0; j < 64; ++j) { ngt += (u[j] > prefix) ? 1 : 0; nti += (u[j] == prefix) ? 1 : 0; }
                const int need = 256 - (int)wave_sum((float)ngt);
                int incl = nti;
#pragma unroll
                for (int o = 1; o < 64; o <<= 1) { const int v = __shfl_up(incl, o); if (lane >= o) incl += v; }
                int running = incl - nti;
#pragma unroll
                for (int j = 0; j < 64; ++j) {
                    const bool tie = (u[j] == prefix);
                    const unsigned sel = ((u[j] > prefix) || (tie && running < need)) ? 1u : 0u;
                    running += tie ? 1 : 0;
                    if (j < 32) mlo |= sel << j; else mhi |= sel << (j - 32);
                }
            }
            myw = ((u64)mhi << 32) | mlo;
        } else {
            const int lo = 64 * lane;
            if (lo + 63 <= t) myw = ~0ull; else if (lo > t) myw = 0ull; else myw = (~0ull) >> (63 - (t - lo));
        }
        ((u64*)(ws + WS_MASK))[((size_t)b * S + t) * 64 + lane] = myw;
#if MK_TPROBE
        { asm volatile("s_waitcnt vmcnt(0) lgkmcnt(0)" ::: "memory"); const unsigned long long ts3_ = __builtin_amdgcn_s_memtime();
          if (blockIdx.x == 0 && wave == 0 && lane == 0 && t >= 255) { unsigned long long* TS = (unsigned long long*)(ws + WS_BAR + 65536);
              atomicAdd(TS + 0, ts1_ - ts0_); atomicAdd(TS + 1, ts2_ - ts1_); atomicAdd(TS + 2, ts3_ - ts2_); atomicAdd(TS + 3, ts3_ - ts0_); } }
#endif
    }
    __syncthreads();
}

DEVI void combineA_rows(const Params& P) {
    const int tid = tid_opaque(), lane = tid & 63, wave = tid >> 6;
    const int gw = blockIdx.x * NWAVE + wave, NGW = gridDim.x * NWAVE;
    unsigned char* ws = P.ws;
    const float d1 = wave_sum(P.in[17][lane] * P.in[18][lane]), d2 = wave_sum(P.in[19][lane] * P.in[20][lane]);
    const float lam_init = 0.2f, lam = expf(d1) - expf(d2) + lam_init;
    const bf16_t* o0 = (const bf16_t*)(ws + WS_XB); const bf16_t* o1 = o0 + (size_t)T * 512;
    const float* gs = P.in[21] + 8 * (lane & 15);
    for (int m0 = gw; m0 < T; m0 += 4 * NGW) {
        u32x4 a[4], bq[4];
#pragma unroll
        for (int k = 0; k < 4; ++k) { const int m = (m0 + k * NGW < T) ? m0 + k * NGW : m0; a[k] = *(const u32x4*)(o0 + (size_t)m * 512 + 8 * lane); bq[k] = *(const u32x4*)(o1 + (size_t)m * 512 + 8 * lane); }
#pragma unroll
        for (int k = 0; k < 4; ++k) { const int m = m0 + k * NGW; if (m >= T) break;
            float v[8]; float ss = 0.f;
#pragma unroll
            for (int j = 0; j < 4; ++j) { v[2 * j] = lo16(a[k][j]) - lam * lo16(bq[k][j]); v[2 * j + 1] = hi16(a[k][j]) - lam * hi16(bq[k][j]); ss += v[2 * j] * v[2 * j] + v[2 * j + 1] * v[2 * j + 1]; }
            ss = row16_sum(ss);
            const float rs = rsqrtf(ss * (1.f / 128.f) + EPS) * (1.f - lam_init);
            u32x4 w;
#pragma unroll
            for (int j = 0; j < 4; ++j) w[j] = cvtpk(v[2 * j] * rs * gs[2 * j], v[2 * j + 1] * rs * gs[2 * j + 1]);
            *(u32x4*)((bf16_t*)(ws + WS_Y) + (size_t)m * 1024 + 8 * lane) = w; }
    }
}

template <int W>
DEVI void pool_item(const bf16_t* pr, bf16_t* y, int m, int c0) {
    const int t = m & (S - 1);
    u32x4 z[W];
#pragma unroll
    for (int dt = 0; dt < W; ++dt) z[dt] = *(const u32x4*)(pr + (size_t)(m - ((dt <= t) ? dt : t)) * 2048 + 1536 + c0);
    float sum[8];
#pragma unroll
    for (int j = 0; j < 8; ++j) sum[j] = 0.f;
#pragma unroll
    for (int dt = 0; dt < W; ++dt) { const float wgt = (dt <= t) ? 1.f : 0.f;
#pragma unroll
        for (int j = 0; j < 4; ++j) { sum[2 * j] += wgt * lo16(z[dt][j]); sum[2 * j + 1] += wgt * hi16(z[dt][j]); } }
    const float inv = 1.f / (float)((t + 1 < W) ? (t + 1) : W); u32x4 w;
#pragma unroll
    for (int j = 0; j < 4; ++j) w[j] = cvtpk(sum[2 * j] * inv - lo16(z[0][j]), sum[2 * j + 1] * inv - hi16(z[0][j]));
    *(u32x4*)(y + (size_t)m * 1024 + 512 + c0) = w;
}
DEVI void phase_mix1(const Params& P) {
    const int gt = blockIdx.x * NTHR + tid_opaque(), NGT = gridDim.x * NTHR;
    unsigned char* ws = P.ws;
    const bf16_t* pr = (const bf16_t*)(ws + WS_PROJ1);
    bf16_t* y = (bf16_t*)(ws + WS_Y);
    const float* cw = P.in[29];
    for (int it0 = gt; it0 < T * 64; it0 += 2 * NGT) {
        u32x4 gc[2][3], hc[2][3], gb[2];
#pragma unroll
        for (int k = 0; k < 2; ++k) { const int it = (it0 + k * NGT < T * 64) ? it0 + k * NGT : it0; const int m = it >> 6, c0 = 8 * (it & 63), t = m & (S - 1);
#pragma unroll
            for (int dt = 0; dt < 3; ++dt) { const size_t r = (size_t)(m - ((dt <= t) ? dt : t)) * 2048; gc[k][dt] = *(const u32x4*)(pr + r + 512 + c0); hc[k][dt] = *(const u32x4*)(pr + r + 1024 + c0); }
            gb[k] = *(const u32x4*)(pr + (size_t)m * 2048 + c0); }
#pragma unroll
        for (int k = 0; k < 2; ++k) { const int it = it0 + k * NGT; if (it >= T * 64) break; const int m = it >> 6, c0 = 8 * (it & 63), t = m & (S - 1);
            float wgt[3][8];
#pragma unroll
            for (int dt = 0; dt < 3; ++dt) { float tmp[8]; load8(tmp, cw + (2 - dt) * 512 + c0); const float on = (dt <= t) ? 1.f : 0.f;
#pragma unroll
                for (int j = 0; j < 8; ++j) wgt[dt][j] = tmp[j] * on; }
            u32x4 w;
#pragma unroll
            for (int j = 0; j < 4; ++j) { float a = 0.f, b = 0.f;
#pragma unroll
                for (int dt = 0; dt < 3; ++dt) { a += wgt[dt][2 * j] * (lo16(gc[k][dt][j]) * lo16(hc[k][dt][j])); b += wgt[dt][2 * j + 1] * (hi16(gc[k][dt][j]) * hi16(hc[k][dt][j])); }
                w[j] = cvtpk(lo16(gb[k][j]) * a, hi16(gb[k][j]) * b); }
            *(u32x4*)(y + (size_t)m * 1024 + c0) = w; }
    }
    for (int it = gt; it < T * 16; it += NGT) { const int m = it >> 4, cj = 8 * (it & 15);
        pool_item<2>(pr, y, m, cj); pool_item<4>(pr, y, m, 128 + cj); asm volatile("" ::: "memory"); pool_item<8>(pr, y, m, 256 + cj); asm volatile("" ::: "memory"); pool_item<16>(pr, y, m, 384 + cj); asm volatile("" ::: "memory"); }
}

DEVI float sum_rows4(float s) {
    const auto a = __builtin_amdgcn_permlane16_swap(__float_as_uint(s), __float_as_uint(s), false, false);
    const float s2 = __uint_as_float(a[0]) + __uint_as_float(a[1]);
    const auto b = __builtin_amdgcn_permlane32_swap(__float_as_uint(s2), __float_as_uint(s2), false, false);
    return __uint_as_float(b[0]) + __uint_as_float(b[1]);
}
namespace pg8 {
#define PG8_LAS __attribute__((address_space(3)))
typedef unsigned short bf16_t;
typedef short bf16x8 __attribute__((ext_vector_type(8)));
typedef float f32x4 __attribute__((ext_vector_type(4)));
typedef unsigned u32x4 __attribute__((ext_vector_type(4)));
constexpr int BM = 256, BK = 64, HALF = 128, HTB = HALF * BK * 2  , STAGE_BYTES = 8 * HTB, NXCD = 8, WGM = 8;

__host__ __device__ __forceinline__ int lds_byte(int r, int c) { const int st = (r >> 4) * 2 + (c >> 5), rr = r & 15, cc = c & 31, ob = rr * 64 + cc * 2; return st * 1024 + (ob ^ (((ob >> 9) & 1) << 5)); }
__host__ __device__ __forceinline__ void stage_rc(int b, int& R, int& C) { const int st = b / 1024, sb = b % 1024, swz = sb ^ (((sb >> 9) & 1) << 5); R = (st >> 1) * 16 + swz / 64; C = (st & 1) * 32 + (swz % 64) / 2; }
__host__ __device__ __forceinline__ int perm32(int rho) { const int n = rho >> 4, i = rho & 15; return 8 * (i >> 2) + 4 * n + (i & 3); }

struct Unit { int pm, pn; };
struct Gemm { const bf16_t* A; int lda; const bf16_t* Bt; int M, N, K; };

struct StaticOrder {
    int nM, nN, nwg, G, c;
    __host__ __device__ void init(int M, int N, int G_, int c_) { nM = M / BM; nN = N / BM; nwg = nM * nN; G = G_; c = c_; }
    __host__ __device__ bool next(int i, Unit& u) const {
        const long L = (long)i * G + c; if (L >= nwg) return false;
        int wgid = (int)L; { const int q = nwg / NXCD, r = nwg % NXCD, xcd = wgid % NXCD, off = wgid / NXCD; wgid = (xcd < r ? xcd * (q + 1) : r * (q + 1) + (xcd - r) * q) + off; }
        const int nig = WGM * nN, gid = wgid / nig, fm = gid * WGM, gsz = (nM - fm) < WGM ? (nM - fm) : WGM;
        u.pm = fm + ((wgid % nig) % gsz); u.pn = (wgid % nig) / gsz; return true;
    }
    __device__ __forceinline__ void a_ready(const Unit&) const {}
    __device__ __forceinline__ void done(const Unit&) const {}
};
template <class Epi, class Sched, bool ALIGN_EPI = false, bool SP2 = false>
__device__ __forceinline__ void gemm_phase(PG8_LAS unsigned char* lds, const Gemm g, const Sched& S, const Epi& E) {
    const int tid = tid_opaque(), wid = __builtin_amdgcn_readfirstlane(tid >> 6), lane = tid & 63, wr = wid >> 2, wc = wid & 3, fr = lane & 15, fq = lane >> 4;
    const int K = g.K, nt = K / BK;
    unsigned voffA[2], voffB[2];
#pragma unroll
    for (int i = 0; i < 2; ++i) { int R, C; stage_rc(tid * 16 + i * 8192, R, C); const int Rb = Epi::PERM ? ((R & ~31) + perm32(R & 31)) : R;
        voffA[i] = (unsigned)(R * g.lda + C) * 2u; voffB[i] = (unsigned)(Rb * K + C) * 2u; }
    const size_t kstep = (size_t)(BK * 2);
    const size_t hstepA = (size_t)HALF * g.lda * 2, hstepB = (size_t)HALF * K * 2;
    const size_t tstepA = 2 * hstepA, tstepB = 2 * hstepB;
    const unsigned ldsw = (unsigned)wid * 1024u;
    const int aoff = lds_byte(wr * 64 + fr, fq * 8), boff = lds_byte(wc * 32 + fr, fq * 8);
#define PG8_SA(b, h) (((b) * 2 + (h)) * HTB)
#define PG8_SB(b, h) ((4 + (b) * 2 + (h)) * HTB)
#define PG8_STAGE(bufoff, gbase, voff) do { _Pragma("unroll") for (int _i = 0; _i < 2; ++_i) \
        __builtin_amdgcn_global_load_lds((const unsigned*)((const char*)(gbase) + (voff)[_i]), (PG8_LAS unsigned*)(lds + (bufoff) + ldsw + _i * 8192), 16, 0, 0); } while (0)
#define PG8_LDA(dst, b, h) do { _Pragma("unroll") for (int m = 0; m < 4; ++m) _Pragma("unroll") for (int k = 0; k < 2; ++k) dst[m][k] = *(const PG8_LAS bf16x8*)(lds + PG8_SA(b, h) + aoff + m * 2048 + k * 1024); } while (0)
#define PG8_LDB(dst, b, h) do { _Pragma("unroll") for (int n = 0; n < 2; ++n) _Pragma("unroll") for (int k = 0; k < 2; ++k) dst[n][k] = *(const PG8_LAS bf16x8*)(lds + PG8_SB(b, h) + boff + n * 2048 + k * 1024); } while (0)
#define PG8_MMA(ai, bj, At, Bt) do { __builtin_amdgcn_s_setprio(1); _Pragma("unroll") for (int m = 0; m < 4; ++m) _Pragma("unroll") for (int n = 0; n < 2; ++n) _Pragma("unroll") for (int k = 0; k < 2; ++k) \
        acc[ai][bj][m][n] = __builtin_amdgcn_mfma_f32_16x16x32_bf16(Bt[n][k], At[m][k], acc[ai][bj][m][n], 0, 0, 0); __builtin_amdgcn_s_setprio(0); } while (0)
#define PG8_WAIT_V(n) asm volatile("s_waitcnt vmcnt(" #n ")" ::: "memory")
#define PG8_WAIT_L(n) asm volatile("s_waitcnt lgkmcnt(" #n ")" ::: "memory")
#define PG8_BAR __builtin_amdgcn_s_barrier()
#define PG8_SCHED __builtin_amdgcn_sched_barrier(0)
    Unit cur, nxt; int ui = 0;
    if (!S.next(0, cur)) return;
    f32x4 acc[2][2][4][2];
#pragma unroll
    for (int a = 0; a < 2; ++a)
#pragma unroll
        for (int b = 0; b < 2; ++b)
#pragma unroll
            for (int m = 0; m < 4; ++m)
#pragma unroll
                for (int n = 0; n < 2; ++n) acc[a][b][m][n] = (f32x4){0.f, 0.f, 0.f, 0.f};
    bf16x8 At[4][2], B0[2][2], B1[2][2];
    const char* cA = (const char*)g.A + (size_t)cur.pm * tstepA; const char* cB = (const char*)g.Bt + (size_t)cur.pn * tstepB;
    S.a_ready(cur);
    if constexpr (SP2) {
        PG8_STAGE(PG8_SB(0, 0), cB, voffB); PG8_STAGE(PG8_SB(0, 1), cB + hstepB, voffB); PG8_STAGE(PG8_SA(0, 0), cA, voffA); PG8_STAGE(PG8_SA(0, 1), cA + hstepA, voffA);
        if (wr == 1) PG8_BAR;
        PG8_WAIT_V(2); PG8_BAR;
        PG8_STAGE(PG8_SB(1, 0), cB + kstep, voffB); PG8_STAGE(PG8_SA(1, 0), cA + kstep, voffA); PG8_STAGE(PG8_SB(1, 1), cB + hstepB + kstep, voffB);
        PG8_WAIT_V(6); PG8_BAR;
    } else {
        PG8_STAGE(PG8_SB(0, 0), cB, voffB); PG8_STAGE(PG8_SA(0, 0), cA, voffA); PG8_STAGE(PG8_SB(0, 1), cB + hstepB, voffB); PG8_STAGE(PG8_SA(0, 1), cA + hstepA, voffA);
        if (wr == 1) PG8_BAR;
        PG8_WAIT_V(4); PG8_BAR;
        PG8_STAGE(PG8_SB(1, 0), cB + kstep, voffB); PG8_STAGE(PG8_SA(1, 0), cA + kstep, voffA); PG8_STAGE(PG8_SB(1, 1), cB + hstepB + kstep, voffB);
        PG8_WAIT_V(6); PG8_BAR;
    }
    for (;;) {
        const bool has_next = S.next(ui + 1, nxt);
        const char* nA = has_next ? (const char*)g.A + (size_t)nxt.pm * tstepA : cA; const char* nB = has_next ? (const char*)g.Bt + (size_t)nxt.pn * tstepB : cB;
        for (int t = 0; t < nt; t += 2) {
            const bool last = (t == nt - 2);
            const char* a1 = cA + (size_t)(t + 1) * kstep;
            const char* a2 = last ? nA : cA + (size_t)(t + 2) * kstep; const char* b2 = last ? nB : cB + (size_t)(t + 2) * kstep;
            const char* a3 = a2 + kstep; const char* b3 = b2 + kstep;
            if (last && has_next) S.a_ready(nxt);
            if constexpr (SP2) {
            PG8_LDB(B0, 0, 0); PG8_LDB(B1, 0, 1); PG8_SCHED; PG8_LDA(At, 0, 0); PG8_STAGE(PG8_SA(1, 1), a1 + hstepA, voffA);
            PG8_WAIT_V(8); PG8_WAIT_L(0); PG8_BAR; PG8_MMA(0, 0, At, B0); PG8_MMA(0, 1, At, B1); PG8_BAR; PG8_SCHED;
            PG8_LDA(At, 0, 1); PG8_STAGE(PG8_SB(0, 0), b2, voffB); PG8_STAGE(PG8_SB(0, 1), b2 + hstepB, voffB); PG8_STAGE(PG8_SA(0, 0), a2, voffA);
            PG8_WAIT_V(8); PG8_WAIT_L(0); PG8_BAR; PG8_MMA(1, 0, At, B0); PG8_MMA(1, 1, At, B1); PG8_BAR; PG8_SCHED;
            PG8_LDB(B0, 1, 0); PG8_LDB(B1, 1, 1); PG8_SCHED; PG8_LDA(At, 1, 0); PG8_STAGE(PG8_SA(0, 1), a2 + hstepA, voffA);
            PG8_WAIT_V(8); PG8_WAIT_L(0); PG8_BAR; PG8_MMA(0, 0, At, B0); PG8_MMA(0, 1, At, B1); PG8_BAR; PG8_SCHED;
            PG8_LDA(At, 1, 1); PG8_STAGE(PG8_SB(1, 0), b3, voffB); PG8_STAGE(PG8_SB(1, 1), b3 + hstepB, voffB); PG8_STAGE(PG8_SA(1, 0), a3, voffA);
            PG8_WAIT_V(8); PG8_WAIT_L(0); PG8_BAR; PG8_MMA(1, 0, At, B0); PG8_MMA(1, 1, At, B1); PG8_BAR; PG8_SCHED;
            } else {
            PG8_LDB(B0, 0, 0); PG8_SCHED; PG8_LDA(At, 0, 0); PG8_STAGE(PG8_SA(1, 1), a1 + hstepA, voffA);
            PG8_WAIT_L(8); PG8_BAR; PG8_WAIT_L(0); PG8_MMA(0, 0, At, B0); PG8_BAR; PG8_SCHED;
            PG8_LDB(B1, 0, 1); PG8_STAGE(PG8_SB(0, 0), b2, voffB);
            PG8_BAR; PG8_WAIT_L(0); PG8_MMA(0, 1, At, B1); PG8_BAR;
            PG8_LDA(At, 0, 1); PG8_STAGE(PG8_SA(0, 0), a2, voffA);
            PG8_BAR; PG8_WAIT_L(0); PG8_MMA(1, 0, At, B0); PG8_BAR; PG8_SCHED;
            PG8_STAGE(PG8_SB(0, 1), b2 + hstepB, voffB);
            PG8_WAIT_V(6); PG8_BAR; PG8_MMA(1, 1, At, B1); PG8_BAR;
            PG8_LDB(B0, 1, 0); PG8_SCHED; PG8_LDA(At, 1, 0); PG8_STAGE(PG8_SA(0, 1), a2 + hstepA, voffA);
            PG8_WAIT_L(8); PG8_BAR; PG8_WAIT_L(0); PG8_MMA(0, 0, At, B0); PG8_BAR; PG8_SCHED;
            PG8_LDB(B1, 1, 1); PG8_STAGE(PG8_SB(1, 0), b3, voffB);
            PG8_BAR; PG8_WAIT_L(0); PG8_MMA(0, 1, At, B1); PG8_BAR;
            PG8_LDA(At, 1, 1); PG8_STAGE(PG8_SA(1, 0), a3, voffA);
            PG8_BAR; PG8_WAIT_L(0); PG8_MMA(1, 0, At, B0); PG8_BAR; PG8_SCHED;
            PG8_STAGE(PG8_SB(1, 1), b3 + hstepB, voffB);
            PG8_WAIT_V(6); PG8_BAR; PG8_MMA(1, 1, At, B1); PG8_BAR;
            }
        }
        if constexpr (ALIGN_EPI) { if (wr == 0) PG8_BAR; }
        if constexpr (!Epi::AFTER_DRAIN) { E(acc, cur, wr, wc, fr, fq); S.done(cur); }
        if (!has_next) break;
#pragma unroll
        for (int a = 0; a < 2; ++a)
#pragma unroll
            for (int b = 0; b < 2; ++b)
#pragma unroll
                for (int m = 0; m < 4; ++m)
#pragma unroll
                    for (int n = 0; n < 2; ++n) acc[a][b][m][n] = (f32x4){0.f, 0.f, 0.f, 0.f};
        cur = nxt; cA = nA; cB = nB; ++ui;
        if constexpr (ALIGN_EPI) { if (wr == 1) PG8_BAR; }
    }
    PG8_WAIT_V(0);
    if constexpr (!ALIGN_EPI) { if (wr == 0) PG8_BAR; }
    PG8_BAR;
    if constexpr (Epi::AFTER_DRAIN) { E.fused(acc, cur, wr, wc, fr, fq, lds, wid, lane); S.done(cur); }
#undef PG8_SA
#undef PG8_SB
#undef PG8_STAGE
#undef PG8_LDA
#undef PG8_LDB
#undef PG8_MMA
#undef PG8_WAIT_V
#undef PG8_WAIT_L
#undef PG8_BAR
#undef PG8_SCHED
}
}

namespace pg8 {
struct EpiScale {
    static constexpr bool PERM = true, AFTER_DRAIN = false;
    bf16_t* O; int ldo; const float* ssq; float inv_n; int act;
    __device__ __forceinline__ void operator()(const f32x4 (&acc)[2][2][4][2], const Unit& u, int wr, int wc, int fr, int fq) const {
        asm volatile("" : "+v"(fr), "+v"(fq));
        const int row0 = u.pm * BM + wr * 64 + fr, col0 = u.pn * BM + wc * 32 + 8 * fq;
        float rsv[8];
#pragma unroll
        for (int i = 0; i < 8; ++i) rsv[i] = ssq ? ssq[row0 + (i >> 2) * HALF + (i & 3) * 16] : 0.f;
#pragma unroll
        for (int i = 0; i < 8; ++i) rsv[i] = ssq ? rsqrtf(rsv[i] * inv_n + 1e-6f) : 1.f;
#pragma unroll
        for (int ai = 0; ai < 2; ++ai)
#pragma unroll
            for (int m = 0; m < 4; ++m) {
                const int row = row0 + ai * HALF + m * 16;
                const float rs = rsv[ai * 4 + m];
                bf16_t* rowp = O + (size_t)row * ldo + col0;
#pragma unroll
                for (int bj = 0; bj < 2; ++bj) {
                    f32x4 v0 = acc[ai][bj][m][0] * rs, v1 = acc[ai][bj][m][1] * rs;
                    if (act == 1) {
#pragma unroll
                        for (int j = 0; j < 4; ++j) { const float a = fmaxf(v0[j], 0.f), b = fmaxf(v1[j], 0.f); v0[j] = a * a; v1[j] = b * b; }
                    }
                    u32x4 w; w.x = ::cvtpk(v0[0], v0[1]); w.y = ::cvtpk(v0[2], v0[3]); w.z = ::cvtpk(v1[0], v1[1]); w.w = ::cvtpk(v1[2], v1[3]);
                    *(u32x4*)(rowp + bj * HALF) = w;
                }
            }
    }
};
struct EpiHead {
    static constexpr bool PERM = true, AFTER_DRAIN = false;
    int kind; bf16_t* O; int ldo; const float* ssq; float inv_n; const float* cs;
    const float *g0, *g1, *g2, *g3; float* ssq_ckv; float* WI; bf16_t* KI; PG8_LAS float* X;
    __device__ __forceinline__ void operator()(f32x4 (&acc)[2][2][4][2], const Unit& u, int wr, int wc, int fr, int fq) const {
        asm volatile("" : "+v"(fr), "+v"(fq));
        asm volatile("" : "+s"(wr), "+s"(wc));
        const int wave = wr * 4 + wc, pn = u.pn;
        int gt = 0; bool rope = false; float scale = 1.f; const float* g = nullptr;
        if (kind == 0) {
            if (pn < 2) { gt = 1; rope = true; scale = 0.125f * 1.4426950408889634f; g = g0; }
            else if (pn < 4) { gt = 1; rope = true; g = g1; }
            else if (pn < 6) { gt = 0; }
            else if (pn < 8) { gt = 1; rope = true; scale = 0.125f * 1.4426950408889634f; g = g2; }
            else if (pn == 8) { gt = 3; }
            else if (pn == 9) { gt = 4; rope = true; }
            else { gt = 1; rope = true; g = g3; }
        } else if (kind == 1) { if (pn < 2) { gt = 1; rope = true; g = g0; } }
        else { if ((pn & 3) < 2) { gt = 2; g = g0 + (pn >> 2) * 128; } }
        const int row0 = u.pm * BM + wr * 64 + fr, col0 = pn * BM + wc * 32 + 8 * fq;
        PG8_LAS float* CSL = X + 2048;
        if (rope) {
            const int tid_ = (wave * 4 + fq) * 16 + fr; f32x4 t_[2];
#pragma unroll
            for (int i = 0; i < 2; ++i) { const int idx = tid_ + 512 * i; t_[i] = *(const f32x4*)(cs + (size_t)(u.pm * BM + (idx >> 2)) * 16 + 4 * (idx & 3)); }
#pragma unroll
            for (int i = 0; i < 2; ++i) { const int idx = tid_ + 512 * i; *(PG8_LAS f32x4*)(CSL + (idx >> 2) * 20 + 4 * (idx & 3)) = t_[i]; }
        }
        float rsv[8];
#pragma unroll
        for (int i = 0; i < 8; ++i) rsv[i] = ssq[row0 + (i >> 2) * HALF + (i & 3) * 16];
#pragma unroll
        for (int i = 0; i < 8; ++i) rsv[i] = rsqrtf(rsv[i] * inv_n + 1e-6f);
        float gv[8];
        { const int db = (gt == 2) ? (32 * wc + 8 * fq) : (32 * (wc & 1) + 8 * fq);
#pragma unroll
          for (int j = 0; j < 8; ++j) gv[j] = g ? g[db + j] : 1.f; }
#pragma unroll
        for (int ai = 0; ai < 2; ++ai)
#pragma unroll
            for (int m = 0; m < 4; ++m) {
                const float rs = rsv[ai * 4 + m];
#pragma unroll
                for (int bj = 0; bj < 2; ++bj) {
                    acc[ai][bj][m][0] *= rs; acc[ai][bj][m][1] *= rs;
                    const f32x4 a = acc[ai][bj][m][0], b = acc[ai][bj][m][1];
                    float s = (a[0] * a[0] + a[1] * a[1]) + (a[2] * a[2] + a[3] * a[3]) + (b[0] * b[0] + b[1] * b[1]) + (b[2] * b[2] + b[3] * b[3]);
                    s = ::sum_rows4(s);
                    if (fq == 0) X[(((wave * 2 + ai) * 4 + m) * 2 + bj) * 16 + fr] = s;
                }
            }
        asm volatile("s_waitcnt lgkmcnt(0)\n\ts_barrier" ::: "memory");
#pragma unroll
        for (int ai = 0; ai < 2; ++ai)
#pragma unroll
            for (int m = 0; m < 4; ++m) {
                const int row = row0 + ai * HALF + m * 16;
                float cs16[16];
                if (rope) { const PG8_LAS float* c = CSL + (ai * HALF + wr * 64 + m * 16 + fr) * 20;
#pragma unroll
                    for (int q = 0; q < 4; ++q) { const f32x4 t = *(const PG8_LAS f32x4*)(c + 4 * q); cs16[4 * q] = t[0]; cs16[4 * q + 1] = t[1]; cs16[4 * q + 2] = t[2]; cs16[4 * q + 3] = t[3]; }
#pragma unroll
                    for (int j = 0; j < 8; ++j) { const float cj = cs16[j], sj = cs16[8 + j];
                        cs16[j] = (fq == 0) ? cj : (fq == 1) ? sj : (fq == 2) ? 1.f : 0.f; cs16[8 + j] = (fq == 0) ? -sj : (fq == 1) ? cj : (fq == 2) ? 0.f : 1.f; } }
                float rowtot = 0.f;
#pragma unroll
                for (int bj = 0; bj < 2; ++bj) {
                    float v[8];
#pragma unroll
                    for (int j = 0; j < 4; ++j) { v[j] = acc[ai][bj][m][0][j]; v[4 + j] = acc[ai][bj][m][1][j]; }
#define XAT(w_) X[((((w_) * 2 + ai) * 4 + m) * 2 + bj) * 16 + fr]
                    if (gt == 1) {
                        const float tot = XAT(wave) + XAT(wave ^ 1), r2 = rsqrtf(tot * (1.f / 64.f) + 1e-6f);
#pragma unroll
                        for (int j = 0; j < 8; ++j) v[j] = v[j] * r2 * gv[j];
                    } else if (gt == 2) {
                        const int w0 = wave & 4; const float tot = (XAT(w0) + XAT(w0 + 1)) + (XAT(w0 + 2) + XAT(w0 + 3)), r2 = rsqrtf(tot * (1.f / 128.f) + 1e-6f);
#pragma unroll
                        for (int j = 0; j < 8; ++j) v[j] = v[j] * r2 * gv[j];
                    } else if (gt == 3) {
                        const int w0 = wave & 4; rowtot += (XAT(w0) + XAT(w0 + 1)) + (XAT(w0 + 2) + XAT(w0 + 3));
                    }
#undef XAT
                    if (rope && (wc & 1) == 0) {
#pragma unroll
                        for (int j = 0; j < 8; ++j) { const auto r = __builtin_amdgcn_permlane16_swap(__float_as_uint(v[j]), __float_as_uint(v[j]), false, false);
                            v[j] = __uint_as_float(r[0]) * cs16[j] + __uint_as_float(r[1]) * cs16[8 + j]; }
                    }
                    u32x4 w; w.x = ::cvtpk(v[0] * scale, v[1] * scale); w.y = ::cvtpk(v[2] * scale, v[3] * scale); w.z = ::cvtpk(v[4] * scale, v[5] * scale); w.w = ::cvtpk(v[6] * scale, v[7] * scale);
                    if (kind == 0 && pn == 10) {
                        if (bj == 0 && wc < 2) { const int c = 4 * wc + fq;
                            *(u32x4*)(KI + (size_t)(row >> 5) * 2048 + (c >> 1) * 512 + (((c & 1) * 32 + (row & 31)) * 8)) = w; }
                        if (bj == 0 && wc == 2 && fq == 0) *(f32x4*)(WI + (size_t)row * 4) = acc[ai][0][m][0] * (1.f / 16.f);
                    } else {
                        *(u32x4*)(O + (size_t)row * ldo + col0 + bj * HALF) = w;
                    }
                }
                if (gt == 3 && wc == 0 && fq == 0) ssq_ckv[row] = rowtot;
            }
    }
};
template <bool F32BASE> struct EpiResidT {
    static constexpr bool PERM = true, AFTER_DRAIN = false;
    const float* basef; float* outf; bf16_t* xb; float* ssq_next; int dry;
    __device__ __forceinline__ void operator()(const f32x4 (&acc)[2][2][4][2], const Unit& u, int wr, int wc, int fr, int fq) const {
        asm volatile("" : "+v"(fr), "+v"(fq));
        const int col0 = u.pn * BM + wc * 32 + 8 * fq;
        constexpr int MB = F32BASE ? 2 : 4;
#pragma unroll
        for (int ai = 0; ai < 2; ++ai)
#pragma unroll
        for (int m0 = 0; m0 < 4; m0 += MB) {
            u32x4 bb[MB][2]; f32x4 bf[MB][2][2];
#pragma unroll
            for (int mm = 0; mm < MB; ++mm)
#pragma unroll
                for (int bj = 0; bj < 2; ++bj) { const size_t idx = (size_t)(u.pm * BM + ai * HALF + wr * 64 + (m0 + mm) * 16 + fr) * 1024 + col0 + bj * HALF;
                    if (F32BASE) { bf[mm][bj][0] = *(const f32x4*)(basef + idx); bf[mm][bj][1] = *(const f32x4*)(basef + idx + 4); } else bb[mm][bj] = *(const u32x4*)(xb + idx); }
#pragma unroll
            for (int mm = 0; mm < MB; ++mm) { const int m = m0 + mm;
                const int row = u.pm * BM + ai * HALF + wr * 64 + m * 16 + fr; const size_t off = (size_t)row * 1024 + col0; float s = 0.f;
#pragma unroll
                for (int bj = 0; bj < 2; ++bj) {
                    const size_t idx = off + bj * HALF;
                    f32x4 x0, x1;
                    if (F32BASE) { x0 = bf[mm][bj][0]; x1 = bf[mm][bj][1]; }
                    else { const u32x4 b = bb[mm][bj]; x0 = (f32x4){::lo16(b.x), ::hi16(b.x), ::lo16(b.y), ::hi16(b.y)}; x1 = (f32x4){::lo16(b.z), ::hi16(b.z), ::lo16(b.w), ::hi16(b.w)}; }
                    x0 += acc[ai][bj][m][0]; x1 += acc[ai][bj][m][1];
                    s += (x0[0] * x0[0] + x0[1] * x0[1]) + (x0[2] * x0[2] + x0[3] * x0[3]) + (x1[0] * x1[0] + x1[1] * x1[1]) + (x1[2] * x1[2] + x1[3] * x1[3]);
                    if (outf && !dry) { *(f32x4*)(outf + idx) = x0; *(f32x4*)(outf + idx + 4) = x1; }
                    if (xb && !outf && !dry) { u32x4 w; w.x = ::cvtpk(x0[0], x0[1]); w.y = ::cvtpk(x0[2], x0[3]); w.z = ::cvtpk(x1[0], x1[1]); w.w = ::cvtpk(x1[2], x1[3]); *(u32x4*)(xb + idx) = w; }
                    if (dry) asm volatile("" :: "v"(x0), "v"(x1));
                }
                if (ssq_next && !dry) { s = ::sum_rows4(s); if (fq == 0) atomicAdd(ssq_next + row, s); }
            }
            asm volatile("" ::: "memory");
        }
    }
};
typedef EpiResidT<false> EpiResid; typedef EpiResidT<true> EpiResidF;
}

#define XB_TMO      128
#define XB_XCNT(j)  (256  + 64 * (j))
#define XB_XSUB(j)  (1280 + 64 * (j))
#define XB_XGEN(j)  (2304 + 64 * (j))
#define XB_TOP      3328
#define XB_TOPGEN   3392
#define XCD_BAR_WORDS 3456
#define XB_SPIN_CAP (1u << 18)

__device__ __forceinline__ unsigned xb_ld(unsigned* p)              { return __hip_atomic_load(p, __ATOMIC_RELAXED, __HIP_MEMORY_SCOPE_AGENT); }
__device__ __forceinline__ unsigned xb_add(unsigned* p, unsigned v) { return __hip_atomic_fetch_add(p, v, __ATOMIC_RELAXED, __HIP_MEMORY_SCOPE_AGENT); }
__device__ __forceinline__ unsigned xb_xcc_id() { return (unsigned)__builtin_amdgcn_s_getreg((3 << 11) | 20) & 0xFu; }
#define XB_SPIN(cond, bar) do { unsigned _sp = 0; while (cond) { __builtin_amdgcn_s_sleep(1); \
    if ((++_sp & 255u) == 0u) { if (xb_ld(&(bar)[XB_TMO])) break; if (_sp > XB_SPIN_CAP) { atomicAdd(&(bar)[XB_TMO], 1u); break; } } } } while (0)

struct XcdBarrier {
    unsigned* bar; unsigned x;
    volatile LAS unsigned* st;
};

__device__ __forceinline__ XcdBarrier xcd_barrier_post(unsigned* bar, volatile LAS unsigned* st) {
    XcdBarrier b; b.bar = bar; b.x = xb_xcc_id(); b.st = st;
    if (threadIdx.x == 0) (void)xb_add(&bar[XB_XCNT(b.x)], 1u);
    return b;
}
__device__ __forceinline__ void xcd_barrier_complete(unsigned* bar, unsigned x, unsigned& nloc, unsigned& nx) {
    const unsigned G = gridDim.x * gridDim.y * gridDim.z;
    unsigned sum, cnt, mine, sp = 0u;
    for (;;) {
        sum = 0u; cnt = 0u; mine = 0u;
#pragma unroll
        for (unsigned j = 0; j < 16; ++j) { const unsigned c = xb_ld(&bar[XB_XCNT(j)]); sum += c; cnt += (c > 0u) ? 1u : 0u; mine = (j == x) ? c : mine; }
        if (sum == G) break;
        __builtin_amdgcn_s_sleep(1);
        if ((++sp & 255u) == 0u) { if (xb_ld(&bar[XB_TMO])) break; if (sp > XB_SPIN_CAP) { atomicAdd(&bar[XB_TMO], 1u); break; } }
    }
    nloc = mine > 0u ? mine : 1u; nx = cnt > 0u ? cnt : 1u;
}

__device__ __forceinline__ void xcd_barrier(const XcdBarrier& b) {
    asm volatile("s_waitcnt vmcnt(0)" ::: "memory");
    __syncthreads();
    if (threadIdx.x == 0) {
        unsigned* bar = b.bar;
        __builtin_amdgcn_s_waitcnt(0);
        unsigned nloc = b.st[0], nx = b.st[1];
        if (nloc == 0u) { xcd_barrier_complete(bar, b.x, nloc, nx); b.st[0] = nloc; b.st[1] = nx; }
        const unsigned old = xb_add(&bar[XB_XSUB(b.x)], 1u);
        const unsigned gen = old / nloc;
        if (old + 1u == (gen + 1u) * nloc) {
            __builtin_amdgcn_fence(__ATOMIC_RELEASE, "agent");
            asm volatile("s_waitcnt vmcnt(0)" ::: "memory");
            const unsigned og = xb_add(&bar[XB_TOP], 1u);
            const unsigned tg = og / nx;
            if (og + 1u == (tg + 1u) * nx) xb_add(&bar[XB_TOPGEN], 1u);
            else XB_SPIN(xb_ld(&bar[XB_TOPGEN]) == tg, bar);
            __builtin_amdgcn_fence(__ATOMIC_ACQUIRE, "agent");
            xb_add(&bar[XB_XGEN(b.x)], 1u);
            asm volatile("s_waitcnt vmcnt(0)" ::: "memory");
        } else {
            XB_SPIN(xb_ld(&bar[XB_XGEN(b.x)]) == gen, bar);
            __builtin_amdgcn_fence(__ATOMIC_ACQUIRE, "agent");
            asm volatile("s_waitcnt vmcnt(0)" ::: "memory");
        }
    }
    __syncthreads();
}
constexpr int NPHASE = 22;
constexpr int MISC_OFF = LDS_BYTES - 256;
#ifndef MK_REP_N
#define MK_REP_N 0
#define MK_REP_LO 0
#define MK_REP_HI -1
#endif
#ifndef MK_XPH
#define MK_XPH -1
#define MK_XN 0
#endif
#ifndef MK_SUB
#define MK_SUB 0
#endif
#ifndef MK_IDX2
#define MK_IDX2 0
#endif
#ifndef MK_CGSYNC
#define MK_CGSYNC 0
#endif
template <class Epi, bool ALIGN>
DEVI void run_gemm(LAS unsigned char* lds, const bf16_t* A, int lda, const bf16_t* Bt, int M, int N, int K, const Epi& E, int cu_off = 0) {
    const int Gd = (int)gridDim.x; int cu = (int)blockIdx.x - cu_off; if (cu < 0) cu += Gd;
    pg8::Gemm g{A, lda, Bt, M, N, K}; pg8::StaticOrder So; So.init(M, N, Gd, cu);
    pg8::gemm_phase<Epi, pg8::StaticOrder, ALIGN, true>(lds, g, So, E);
}
template <bool DRYK>
__global__ void __launch_bounds__(NTHR, 2) mega(Params P, int ph_lo, int ph_hi) {
    extern __shared__ __attribute__((aligned(16))) unsigned char lds_raw[];
    LAS unsigned char* lds = (LAS unsigned char*)lds_raw;
    cg::grid_group grid = cg::this_grid();
    { volatile LAS unsigned* MISC0 = (volatile LAS unsigned*)(lds + MISC_OFF);
      if (threadIdx.x < 32) MISC0[threadIdx.x] = 0u;
      __syncthreads();
      if (ph_hi - ph_lo > 1) (void)xcd_barrier_post((unsigned*)(P.ws + WS_BAR), MISC0 + 8); }
    if (ph_lo < 0) grid.sync();
#define PH_LOCALS unsigned char* ws = P.ws; asm volatile("" : "+s"(ws)); float* ssq = (float*)(ws + WS_SSQ); bf16_t* XB = (bf16_t*)(ws + WS_XB); bf16_t* Y = (bf16_t*)(ws + WS_Y); const int G = gridDim.x, bx = blockIdx.x; (void)ssq; (void)XB; (void)Y; (void)G; (void)bx;
#define SEAM_XCD() do { XcdBarrier b_; b_.bar = (unsigned*)(P.ws + WS_BAR); b_.x = xb_xcc_id(); b_.st = (volatile LAS unsigned*)(lds + MISC_OFF) + 8; xcd_barrier(b_); } while (0)
#define PH_REPS(k) (((k) >= MK_REP_LO && (k) <= MK_REP_HI && (k) != 2 && (k) != 4) ? 1 + MK_REP_N : 1)
#define PH_BEGIN(k) if (ph_lo <= (k) && (k) < ph_hi) { PH_LOCALS for (int rep = 0; rep < PH_REPS(k); ++rep) { const int dry = (rep > 0) || DRYK; (void)dry; if (rep > 0) SEAM_XCD();
#define PH_END(k) } if ((k) + 1 < ph_hi) { if (MK_CGSYNC) grid.sync(); else SEAM_XCD(); } }
#define DRYOUT (dry ? (float*)(ws + WS_Y) : P.out)
    using pg8::EpiScale; using pg8::EpiResid; using pg8::EpiResidF; using pg8::EpiHead;
    PH_BEGIN(0) phase_prologue(P, lds, dry); PH_END(0)
    PH_BEGIN(1)
#if MK_FUSE & 1
        run_gemm<EpiHead, true>(lds, (const bf16_t*)(ws + WS_XB), 1024, (const bf16_t*)(ws + W_INE), T, LDP, 1024,
            EpiHead{0, (bf16_t*)(ws + WS_PROJ), LDP, ssq, 1.f / 1024.f, (const float*)(ws + WS_CS), P.in[15], P.in[16], P.in[24], P.in[26],
                    (float*)(ws + WS_SSQCKV), (float*)(ws + WS_WI), (bf16_t*)(ws + WS_KI), (LAS float*)(lds + 132096)});
#else
        run_gemm<EpiScale, true>(lds, (const bf16_t*)(ws + WS_XB), 1024, (const bf16_t*)(ws + W_INE), T, LDP, 1024, EpiScale{(bf16_t*)(ws + WS_PROJ), LDP, ssq, 1.f / 1024.f, 0});
#endif
#if MK_FUSE & 2
        run_gemm<EpiHead, true>(lds, (const bf16_t*)(ws + WS_MB), 1024, (const bf16_t*)(ws + W_KVX), MEMT, 2048, 1024,
            EpiHead{2, (bf16_t*)(ws + WS_KVX), 2048, (const float*)(ws + WS_SSQMEM), 1.f / 1024.f, nullptr, P.in[10], nullptr, nullptr, nullptr, nullptr, nullptr, nullptr, (LAS float*)(lds + 132096)},
            ((T / 256) * (LDP / 256)) % G);
#else
        run_gemm<EpiScale, false>(lds, (const bf16_t*)(ws + WS_MB), 1024, (const bf16_t*)(ws + W_KVX), MEMT, 2048, 1024, EpiScale{(bf16_t*)(ws + WS_KVX), 2048, (const float*)(ws + WS_SSQMEM), 1.f / 1024.f, 0}, ((T / 256) * (LDP / 256)) % G);
#endif
    PH_END(1)
#if (MK_FUSE & 3) != 3
    PH_BEGIN(2) phase_post0(P, ((MK_FUSE & 1) ? 0 : 1) | ((MK_FUSE & 2) ? 0 : 2)); PH_END(2)
#endif
    PH_BEGIN(3)
#if MK_FUSE & 4
        run_gemm<EpiHead, true>(lds, (const bf16_t*)(ws + WS_PROJ) + C_CKV, LDP, (const bf16_t*)(ws + W_KVUP), T, 1024, 256,
            EpiHead{1, (bf16_t*)(ws + WS_KBVB), 1024, (const float*)(ws + WS_SSQCKV), 1.f / 256.f, (const float*)(ws + WS_CS), P.in[25], nullptr, nullptr, nullptr, nullptr, nullptr, nullptr, (LAS float*)(lds + 132096)});
#else
        run_gemm<EpiScale, false>(lds, (const bf16_t*)(ws + WS_PROJ) + C_CKV, LDP, (const bf16_t*)(ws + W_KVUP), T, 1024, 256, EpiScale{(bf16_t*)(ws + WS_KBVB), 1024, (const float*)(ws + WS_SSQCKV), 1.f / 256.f, 0});
#endif
    PH_END(3)
#if !(MK_FUSE & 4)
    PH_BEGIN(4) phase_postkb(P); PH_END(4)
#endif
    PH_BEGIN(5)
        if (!(dry && MK_SUB == 2))
        for (int u = bx; u < 256; u += G) { const int bhc = u >> 3, s = u & 7, b = bhc >> 3, h = (bhc >> 1) & 3, c = bhc & 1;
            attnA_unit(P, b, h, c, s, lds); attnA_unit(P, b, h, c, 15 - s, lds); }
        if (!(dry && MK_SUB == 1))
        for (int u = bx; u < 2048; u += G) { const int k = u / 256, c = u % 256, b = k >> 1; const int blk = (k & 1) ? (511 - c) : c;
            indexer_unit(P, b, blk * 8, lds); }
#if MK_IDX2
        for (int u = bx; u < 2048; u += G) { const int k = u / 256, c = u % 256, b = k >> 1; const int blk = (k & 1) ? (511 - c) : c;
            indexer_unit(P, b, blk * 8, lds); }
#endif
    PH_END(5)
    PH_BEGIN(6)
        if (!(dry && MK_SUB == 2))
        for (int u = bx; u < 256; u += G) { const int bh = u >> 3, s = u & 7, b = bh >> 3, hd = bh & 7;
            attnB_unit(P, b, hd, s, lds); attnB_unit(P, b, hd, 15 - s, lds); }
        if (!(dry && MK_SUB == 1)) combineA_rows(P);
    PH_END(6)
    PH_BEGIN(7) run_gemm<EpiResidF, false>(lds, Y, 1024, (const bf16_t*)(ws + W_OUTE), T, 1024, 1024, EpiResidF{P.in[0], nullptr, XB, ssq + 1 * T, dry}); PH_END(7)
#define XATTN_MLP(l, p0)                                                                                                                                                      \
    PH_BEGIN(p0 + 1) for (int u = bx; u < 256; u += G) { const int b = u >> 6, hd = (u >> 4) & 3, qb = u & 15; xattn_fused_unit(P, (l), b, hd, qb, lds); } PH_END(p0 + 1)                           \
    PH_BEGIN(p0 + 2) run_gemm<EpiResid, false>(lds, (const bf16_t*)(ws + WS_YX), 512, (const bf16_t*)(ws + W_OX) + (size_t)(l) * 1024 * 512, T, 1024, 512, EpiResid{nullptr, nullptr, XB, ssq + ((l) ? 5 : 2) * T, dry}); PH_END(p0 + 2) \
    PH_BEGIN(p0 + 3) run_gemm<EpiScale, true>(lds, XB, 1024, (const bf16_t*)(ws + W_UP) + (size_t)(l) * 4096 * 1024, T, DFF, 1024, EpiScale{(bf16_t*)(ws + WS_H), DFF, ssq + ((l) ? 5 : 2) * T, 1.f / 1024.f, 1}); PH_END(p0 + 3)
    PH_BEGIN(8)
        if (!dry) { const int t8 = tid_opaque(); convert_weights(P, lds, NTR_EARLY, NTR, true, bx * NWAVE + (t8 >> 6), G * NWAVE, bx * NTHR + t8, G * NTHR); }
    PH_END(8)
    XATTN_MLP(0, 8)
    PH_BEGIN(12) run_gemm<EpiResid, false>(lds, (const bf16_t*)(ws + WS_H), DFF, (const bf16_t*)(ws + W_DOWN), T, 1024, DFF, EpiResid{nullptr, nullptr, XB, ssq + 3 * T, dry}); PH_END(12)
    PH_BEGIN(13) run_gemm<EpiScale, true>(lds, XB, 1024, (const bf16_t*)(ws + W_INO), T, 2048, 1024, EpiScale{(bf16_t*)(ws + WS_PROJ1), 2048, ssq + 3 * T, 1.f / 1024.f, 0}); PH_END(13)
    PH_BEGIN(14) phase_mix1(P); PH_END(15)
    PH_BEGIN(16) run_gemm<EpiResid, false>(lds, Y, 1024, (const bf16_t*)(ws + W_OUTO), T, 1024, 1024, EpiResid{nullptr, nullptr, XB, ssq + 4 * T, dry}); PH_END(16)
    XATTN_MLP(1, 17)
    PH_BEGIN(21) run_gemm<EpiResid, false>(lds, (const bf16_t*)(ws + WS_H), DFF, (const bf16_t*)(ws + W_DOWN) + (size_t)1024 * 4096, T, 1024, DFF, EpiResid{nullptr, P.out, XB, nullptr, dry}); PH_END(21)
#if MK_TPROBE
    if (ph_hi == NPHASE) { SEAM_XCD(); unsigned char* ws = P.ws;
        const unsigned long long* TS = (const unsigned long long*)(ws + WS_BAR + 65536);
        float delta = (MK_TPROBE == 14) ? (float)TS[12] / 625000.f : (MK_TPROBE >= 10) ? (float)TS[8 + MK_TPROBE - 10] / (float)TS[12] : (MK_TPROBE == 4 || MK_TPROBE == 20) ? (float)TS[3] * 1e-6f : (float)TS[MK_TPROBE - 1] / (float)TS[3];
        delta = floorf(delta * 25.f + 0.5f) * 0.04f;
        if (MK_TPROBE == 20) delta = 0.1f * floorf(log2f((float)TS[3] / 64000.f) + 0.5f);
        if (MK_TPROBE == 34) delta = 0.1f * floorf(log2f((float)TS[20] / 1000.f) * 2.f + 0.5f) * 0.5f;
        else if (MK_TPROBE >= 30) delta = 0.04f * floorf(25.f * (float)TS[16 + MK_TPROBE - 30] / (float)TS[20] + 0.5f);
        for (int i = blockIdx.x * NTHR + threadIdx.x; i < T * D; i += gridDim.x * NTHR) P.out[i] *= (1.f + delta); }
#endif
}

#ifndef MK_MULTI
#define MK_MULTI 0
#endif
extern "C" void kernel_launch(void* const* d_in, const int* in_sizes, int n_in, void* d_out, int out_size, void* d_ws, size_t ws_size, hipStream_t stream) {
    static int grid = 0;
    if (grid == 0) {
        if (n_in != 33 || out_size != T * D || ws_size < WS_END) { fprintf(stderr, "kernel_launch: unexpected shapes (n_in %d out %d ws %zu)\n", n_in, out_size, ws_size); grid = -1; return; }
        int dev = 0, cus = 0, per_cu = 0;
        hipGetDevice(&dev); hipDeviceGetAttribute(&cus, hipDeviceAttributeMultiprocessorCount, dev);
        hipFuncSetAttribute((const void*)mega<false>, hipFuncAttributeMaxDynamicSharedMemorySize, LDS_BYTES);
        hipOccupancyMaxActiveBlocksPerMultiprocessor(&per_cu, (const void*)mega<false>, NTHR, LDS_BYTES);
        if (per_cu < 1) { fprintf(stderr, "kernel_launch: occupancy query says %d blocks/CU\n", per_cu); per_cu = 1; }
        (void)hipGetLastError();
        grid = cus * 1;
    }
    if (grid < 0) return;
    Params p{};
    for (int i = 0; i < 33; ++i) p.in[i] = (const float*)d_in[i];
    p.out = (float*)d_out; p.ws = (unsigned char*)d_ws;
    (void)hipMemsetAsync((char*)d_ws + WS_BAR, 0, MK_TPROBE ? 131072 : XCD_BAR_WORDS * 4, stream);
#if MK_MULTI
    for (int ph = 0; ph < NPHASE; ++ph) hipLaunchKernelGGL(mega<false>, dim3(grid), dim3(NTHR), LDS_BYTES, stream, p, ph, ph + 1);
#else
    int lo = 0, hi = NPHASE;
    void* args[] = {&p, &lo, &hi};
    hipError_t e = hipLaunchCooperativeKernel((const void*)mega<false>, dim3(grid), dim3(NTHR), args, LDS_BYTES, stream);
    if (e != hipSuccess) fprintf(stderr, "cooperative launch failed: %s (grid %d)\n", hipGetErrorString(e), grid);
#endif
#if MK_XPH >= 0
    { static bool once = false; if (!once) { (void)hipFuncSetAttribute((const void*)mega<true>, hipFuncAttributeMaxDynamicSharedMemorySize, LDS_BYTES); once = true; } }
    for (int i = 0; i < MK_XN; ++i) hipLaunchKernelGGL(mega<true>, dim3(grid), dim3(NTHR), LDS_BYTES, stream, p, MK_XPH, MK_XPH + 1);
#endif
}
```

```cpp
#include <hip/hip_runtime.h>
#include <hip/hip_cooperative_groups.h>
#include <cstdio>
#include <cstdint>
namespace cg = cooperative_groups;
#ifndef MK_SEL2
#define MK_SEL2 0
#define MK_SC2 0
#define MK_BIS2 0
#define MK_XA2 0
#define MK_FUSE 7
#define MK_AX 0
#define MK_TPROBE 0
#endif

#define DEVI __device__ __forceinline__
#define LAS __attribute__((address_space(3)))
typedef unsigned short bf16_t;
typedef short bf16x8 __attribute__((ext_vector_type(8)));
typedef short s16x4 __attribute__((ext_vector_type(4)));
typedef float f32x2 __attribute__((ext_vector_type(2)));
typedef float f32x4 __attribute__((ext_vector_type(4)));
typedef float f32x16 __attribute__((ext_vector_type(16)));
typedef unsigned u32x2 __attribute__((ext_vector_type(2)));
typedef unsigned u32x4 __attribute__((ext_vector_type(4)));
typedef unsigned long long u64;

constexpr int NB = 4, S = 4096, T = NB * S, D = 1024, DFF = 4096, MEML = 256, MEMT = NB * MEML;
constexpr int LDP = 2816;
constexpr int C_QA = 0, C_KA = 512, C_VA = 1024, C_QB = 1536, C_CKV = 2048, C_QI = 2304, C_KI = 2560, C_WI = 2624, EVEN_IN = 2628;
constexpr float EPS = 1e-6f;
constexpr float LOG2E = 1.4426950408889634f;
constexpr int NTHR = 512, NWAVE = 8;
constexpr int LDS_BYTES = 163840;

constexpr size_t MiB = 1u << 20;
constexpr size_t WS_SSQ = 0;
constexpr size_t WS_SSQCKV = WS_SSQ + 6ull * T * 4;
constexpr size_t WS_SSQMEM = WS_SSQCKV + (size_t)T * 4;
constexpr size_t WS_WI = 512 * 1024;
constexpr size_t WS_BAR = 1 * MiB;
constexpr size_t WS_W = 2 * MiB;
constexpr size_t W_INE = WS_W;
constexpr size_t W_KVUP = W_INE + (size_t)LDP * 1024 * 2;
constexpr size_t W_OUTE = W_KVUP + 1024ull * 256 * 2;
constexpr size_t W_QX = W_OUTE + 1024ull * 1024 * 2;
constexpr size_t W_KVX = W_QX + 2 * 512ull * 1024 * 2;
constexpr size_t W_OX = W_KVX + 2 * 1024ull * 1024 * 2;
constexpr size_t W_UP = W_OX + 2 * 1024ull * 512 * 2;
constexpr size_t W_DOWN = W_UP + 2 * 4096ull * 1024 * 2;
constexpr size_t W_INO = W_DOWN + 2 * 4096ull * 1024 * 2;
constexpr size_t W_POOL = W_INO + 2048ull * 1024 * 2;
constexpr size_t W_OUTO = W_POOL + 512ull * 512 * 2;
constexpr size_t W_END = W_OUTO + 1024ull * 1024 * 2;
static_assert(W_END <= 57 * MiB, "weights region");
constexpr size_t WS_XB = 57 * MiB;
constexpr size_t WS_PROJ = 89 * MiB;
constexpr size_t WS_KBVB = 177 * MiB;
constexpr size_t WS_MASK = 209 * MiB;
constexpr size_t WS_Y = 217 * MiB;
constexpr size_t WS_CS = 249 * MiB;
constexpr size_t WS_MB = 250 * MiB;
constexpr size_t WS_KVX = 252 * MiB;
constexpr size_t WS_END = 256 * MiB;
constexpr size_t WS_QX = WS_PROJ;
constexpr size_t WS_YX = WS_PROJ + 16 * MiB;
constexpr size_t WS_H = WS_PROJ;
constexpr size_t WS_PROJ1 = WS_PROJ;
constexpr size_t WS_POOLED = WS_PROJ + 64 * MiB;
constexpr size_t WS_KI = WS_Y;

struct Params { const float* in[33]; float* out; unsigned char* ws; };

DEVI float bf2f(bf16_t v) { return __uint_as_float(((unsigned)v) << 16); }
DEVI unsigned f2bf(float f) { unsigned u = __float_as_uint(f); return (u + 0x7fffu + ((u >> 16) & 1u)) >> 16; }
DEVI unsigned pk2(float lo, float hi) { return f2bf(lo) | (f2bf(hi) << 16); }
DEVI float wave_sum(float v) {
#pragma unroll
    for (int o = 1; o < 64; o <<= 1) v += __shfl_xor(v, o);
    return v;
}
DEVI float lo16(unsigned w) { return __uint_as_float(w << 16); }
DEVI float hi16(unsigned w) { return __uint_as_float(w & 0xffff0000u); }
#define LDS_WAIT() asm volatile("s_waitcnt lgkmcnt(0)" ::: "memory")
DEVI unsigned cvtpk(float lo, float hi) { typedef __bf16 bf2 __attribute__((ext_vector_type(2))); f32x2 v = {lo, hi}; bf2 b = __builtin_convertvector(v, bf2); return __builtin_bit_cast(unsigned, b); }

DEVI int tid_opaque() { int w = __builtin_amdgcn_readfirstlane(threadIdx.x >> 6); asm volatile("" : "+s"(w)); const int l = __builtin_amdgcn_mbcnt_hi(~0u, __builtin_amdgcn_mbcnt_lo(~0u, 0u)); return w * 64 + l; }
struct TrD { const float* src; bf16_t* dst; const float* sk; const float* sn; int K, N, ldd; };
constexpr int NTR = 19;
DEVI TrD get_tr(const Params& P, int i) {
    unsigned char* ws = P.ws; TrD d; d.sk = nullptr; d.sn = nullptr;
    switch (i) {
    case 0: d.src = P.in[14]; d.dst = (bf16_t*)(ws + W_INE); d.K = 1024; d.N = EVEN_IN; d.ldd = 1024; d.sk = P.in[3]; break;
    case 1: d.src = P.in[23]; d.dst = (bf16_t*)(ws + W_KVUP); d.K = 256; d.N = 1024; d.ldd = 256; d.sk = P.in[22]; break;
    case 2: d.src = P.in[27]; d.dst = (bf16_t*)(ws + W_OUTE); d.K = 1024; d.N = 1024; d.ldd = 1024; break;
    case 3: case 4: { int l = i - 3; d.src = P.in[7] + (size_t)l * 1024 * 512; d.dst = (bf16_t*)(ws + W_QX) + (size_t)l * 512 * 1024; d.K = 1024; d.N = 512; d.ldd = 1024; d.sk = P.in[4] + l * 1024; } break;
    case 5: case 6: { int l = i - 5; d.src = P.in[8] + (size_t)l * 1024 * 1024; d.dst = (bf16_t*)(ws + W_KVX) + (size_t)l * 1024 * 1024; d.K = 1024; d.N = 1024; d.ldd = 1024; d.sk = P.in[5] + l * 1024; } break;
    case 7: case 8: { int l = i - 7; d.src = P.in[11] + (size_t)l * 512 * 1024; d.dst = (bf16_t*)(ws + W_OX) + (size_t)l * 1024 * 512; d.K = 512; d.N = 1024; d.ldd = 512; } break;
    case 9: case 10: { int l = i - 9; d.src = P.in[12] + (size_t)l * 1024 * 4096; d.dst = (bf16_t*)(ws + W_UP) + (size_t)l * 4096 * 1024; d.K = 1024; d.N = 4096; d.ldd = 1024; d.sk = P.in[6] + l * 1024; } break;
    case 11: case 12: { int l = i - 11; d.src = P.in[13] + (size_t)l * 4096 * 1024; d.dst = (bf16_t*)(ws + W_DOWN) + (size_t)l * 1024 * 4096; d.K = 4096; d.N = 1024; d.ldd = 4096; } break;
    case 13: d.src = P.in[28]; d.dst = (bf16_t*)(ws + W_INO); d.K = 1024; d.N = 2048; d.ldd = 1024; d.sk = P.in[3] + 1024; break;
    case 14: case 15: case 16: case 17: d.src = P.in[30]; d.dst = (bf16_t*)(ws + W_POOL); d.K = 0; d.N = 32; d.ldd = 512; break;
    default: d.src = P.in[32]; d.dst = (bf16_t*)(ws + W_OUTO); d.K = 512; d.N = 1024; d.ldd = 1024; break;
    }
    return d;
}
DEVI int tr_items(const TrD& d) { return (d.K / 64) * ((d.N + 31) / 32); }
template <bool SK, bool SN>
DEVI void tr_item(const TrD& d, LAS float* scr, int item, int lane) {
    const int nblk = (d.N + 31) / 32, kb = item / nblk, nb = item % nblk, k0 = 64 * kb, n0 = 32 * nb;
    const int n = n0 + (lane & 31), nc = (n < d.N) ? n : (d.N - 1);
    const float* sp = d.src + (size_t)(k0 + (lane >> 5)) * d.N + nc;
    float v[32], sk[32];
#pragma unroll
    for (int i = 0; i < 32; ++i) { v[i] = sp[(size_t)(2 * i) * d.N]; if (SK) sk[i] = d.sk[k0 + 2 * i + (lane >> 5)]; }
#pragma unroll
    for (int i = 0; i < 32; ++i) { float x = v[i]; if (SK) x *= sk[i]; if (n >= d.N) x = 0.f; scr[(2 * i + (lane >> 5)) * 33 + (lane & 31)] = x; }
    LDS_WAIT(); asm volatile("" ::: "memory");
    const int c = lane & 7;
#pragma unroll
    for (int j = 0; j < 4; ++j) {
        const int nn = (lane >> 3) + 8 * j, ncl = (n0 + nn < d.N) ? (n0 + nn) : (d.N - 1);
        const LAS float* s = scr + (8 * c) * 33 + nn;
        float sc = 1.f; if (SN) sc = d.sn[ncl];
        u32x4 o; o.x = pk2(s[0 * 33] * sc, s[1 * 33] * sc); o.y = pk2(s[2 * 33] * sc, s[3 * 33] * sc); o.z = pk2(s[4 * 33] * sc, s[5 * 33] * sc); o.w = pk2(s[6 * 33] * sc, s[7 * 33] * sc);
        if (n0 + nn < d.N) *(u32x4*)(d.dst + (size_t)(n0 + nn) * d.ldd + k0 + 8 * c) = o;
    }
    LDS_WAIT(); asm volatile("" ::: "memory");
}
template <int NR>
DEVI void rows_to_bf16_ssq(const float* x, bf16_t* o, float* ssq_out, int m0, int stride, int nrows, int lane) {
    f32x4 v[NR][4];
#pragma unroll
    for (int k = 0; k < NR; ++k) { const int m = (m0 + k * stride < nrows) ? m0 + k * stride : m0; const f32x4* xr = (const f32x4*)(x + (size_t)m * D) + lane;
#pragma unroll
        for (int j = 0; j < 4; ++j) v[k][j] = xr[64 * j]; }
#pragma unroll
    for (int k = 0; k < NR; ++k) { const int m = m0 + k * stride; if (m >= nrows) break;
        float s = 0.f;
#pragma unroll
        for (int j = 0; j < 4; ++j) s += (v[k][j].x * v[k][j].x + v[k][j].y * v[k][j].y) + (v[k][j].z * v[k][j].z + v[k][j].w * v[k][j].w);
        s = wave_sum(s);
        if (lane == 0) ssq_out[m] = s;
        u32x2* o8 = (u32x2*)(o + (size_t)m * D) + lane;
#pragma unroll
        for (int j = 0; j < 4; ++j) { u32x2 w; w.x = pk2(v[k][j].x, v[k][j].y); w.y = pk2(v[k][j].z, v[k][j].w); o8[64 * j] = w; } }
}
#ifndef MK_SUB
#define MK_SUB 0
#endif
DEVI void convert_weights(const Params& P, LAS unsigned char* lds, int dlo, int dhi, bool fold, int gw, int NGW, int gt, int NGT) {
    const int tid = tid_opaque(), lane = tid & 63, wave = tid >> 6;
    unsigned char* ws = P.ws;
    LAS float* scr = (LAS float*)(lds + wave * 16384);
    int base = 0;
    for (int i = dlo; i < dhi; ++i) {
        const TrD d = get_tr(P, i); const int n = tr_items(d);
        int first = gw - (base % NGW); if (first < 0) first += NGW;
        if (d.sn) { for (int it = first; it < n; it += NGW) tr_item<false, true>(d, scr, it, lane); }
        else if (d.sk) { for (int it = first; it < n; it += NGW) tr_item<true, false>(d, scr, it, lane); }
        else { for (int it = first; it < n; it += NGW) tr_item<false, false>(d, scr, it, lane); }
        base += n;
    }
    if (!fold) return;
    for (int i = gt; i < 1024 * 64; i += NGT) {
        const int n = i & 1023, cp0 = (i >> 10) * 8, g = cp0 >> 7, c = cp0 & 127;
        const float* wo = P.in[32] + (size_t)(512 + g * 128) * 1024 + n; const float* wp = P.in[30] + (size_t)g * 16384 + (size_t)c * 128; const float* ps = P.in[31] + g * 128;
        float acc[8];
#pragma unroll
        for (int j = 0; j < 8; ++j) acc[j] = 0.f;
        for (int d0 = 0; d0 < 128; d0 += 8) {
            float wv[8];
#pragma unroll
            for (int dd = 0; dd < 8; ++dd) wv[dd] = wo[(size_t)(d0 + dd) * 1024] * ps[d0 + dd];
#pragma unroll
            for (int dd = 0; dd < 8; ++dd)
#pragma unroll
                for (int j = 0; j < 8; ++j) acc[j] += wp[j * 128 + d0 + dd] * wv[dd];
        }
        u32x4 w; w.x = pk2(acc[0], acc[1]); w.y = pk2(acc[2], acc[3]); w.z = pk2(acc[4], acc[5]); w.w = pk2(acc[6], acc[7]);
        *(u32x4*)((bf16_t*)(ws + W_OUTO) + (size_t)n * 1024 + 512 + cp0) = w;
    }
}
constexpr int NTR_EARLY = 7;
DEVI void phase_prologue(const Params& P, LAS unsigned char* lds, int dry = 0) {
    const int tid = tid_opaque(), lane = tid & 63, wave = tid >> 6;
#if MK_TPROBE == 20
    { float a0 = lane, a1 = lane + 1, a2 = lane + 2, a3 = lane + 3, a4 = lane + 4, a5 = lane + 5, a6 = lane + 6, a7 = lane + 7;
      unsigned long long t0_ = __builtin_amdgcn_s_memtime();
      for (int it = 0; it < 1000; ++it) {
#pragma unroll
          for (int k = 0; k < 8; ++k) { asm volatile("v_fma_f32 %0, %0, 1.0, %0\n\tv_fma_f32 %1, %1, 1.0, %1\n\tv_fma_f32 %2, %2, 1.0, %2\n\tv_fma_f32 %3, %3, 1.0, %3\n\tv_fma_f32 %4, %4, 1.0, %4\n\tv_fma_f32 %5, %5, 1.0, %5\n\tv_fma_f32 %6, %6, 1.0, %6\n\tv_fma_f32 %7, %7, 1.0, %7" : "+v"(a0), "+v"(a1), "+v"(a2), "+v"(a3), "+v"(a4), "+v"(a5), "+v"(a6), "+v"(a7)); }
      }
      unsigned long long t1_ = __builtin_amdgcn_s_memtime();
      asm volatile("" :: "v"(a0), "v"(a1), "v"(a2), "v"(a3), "v"(a4), "v"(a5), "v"(a6), "v"(a7));
      if (blockIdx.x == 0 && tid == 0) atomicAdd((unsigned long long*)(P.ws + WS_BAR + 65536) + 3, t1_ - t0_); }
#endif
    const int gw = blockIdx.x * NWAVE + wave, NGW = gridDim.x * NWAVE;
    const int gt = blockIdx.x * NTHR + tid, NGT = gridDim.x * NTHR;
    unsigned char* ws = P.ws;
    convert_weights(P, lds, 0, NTR_EARLY, false, gw, NGW, gt, NGT);
    { bf16_t* w = (bf16_t*)(ws + W_INE) + (size_t)EVEN_IN * 1024; const int n = (LDP - EVEN_IN) * 1024 / 8;
      for (int i = gt; i < n; i += NGT) ((u32x4*)w)[i] = (u32x4){0u, 0u, 0u, 0u}; }
    { float* q = (float*)(ws + WS_SSQ) + T; for (int i = gt; i < 5 * T; i += NGT) q[i] = 0.f; }
    if (!(dry && MK_SUB != 2 && MK_SUB != 0))
    for (int m = gw; m < T; m += 4 * NGW) rows_to_bf16_ssq<4>(P.in[0], (bf16_t*)(ws + WS_XB), (float*)(ws + WS_SSQ), m, NGW, T, lane);
    for (int m = gw; m < MEMT; m += NGW) rows_to_bf16_ssq<1>(P.in[1], (bf16_t*)(ws + WS_MB), (float*)(ws + WS_SSQMEM), m, NGW, MEMT, lane);
    if (!(dry && MK_SUB != 3 && MK_SUB != 0))
    { const int* pos = (const int*)P.in[2]; float* cs = (float*)(ws + WS_CS);
      for (int i = gt; i < T * 8; i += NGT) { const int m = i >> 3, f = i & 7;
        const double inv = (f == 0) ? 1.0 : (f == 1) ? 0.19392274474868576 : (f == 2) ? 0.03760603093086393 : (f == 3) ? 0.007292664737217109 : (f == 4) ? 0.001414213562373095
                         : (f == 5) ? 0.0002742481756762073 : (f == 6) ? 5.318295896944988e-05 : 1.031338537721246e-05;
        const double ang = (double)pos[m] * inv, k = rint(ang * 0.15915494309189535), r = fma(-k, 6.283185307179586, ang) - k * 2.4492935982947064e-16;
        cs[m * 16 + f] = cosf((float)r); cs[m * 16 + 8 + f] = sinf((float)r); } }
}

struct EpiStore {
    bf16_t* O; int ldo; const float* ssq; float inv_n; int act;
    DEVI void operator()(const f32x4 (&acc)[4][4], int row0, int col0, int lane) const {
#pragma unroll
        for (int m = 0; m < 4; ++m)
#pragma unroll
            for (int i = 0; i < 4; ++i) {
                const int row = row0 + 16 * m + (lane >> 4) * 4 + i;
                const float rs = ssq ? rsqrtf(ssq[row] * inv_n + EPS) : 1.f;
#pragma unroll
                for (int n = 0; n < 4; ++n) {
                    float v = acc[m][n][i] * rs;
                    if (act == 1) { v = fmaxf(v, 0.f); v = v * v; }
                    O[(size_t)row * ldo + col0 + 16 * n + (lane & 15)] = (bf16_t)f2bf(v);
                }
            }
    }
};
struct EpiRes {
    const float* base; float* out; bf16_t* xb; float* ssq_next;
    DEVI void operator()(const f32x4 (&acc)[4][4], int row0, int col0, int lane) const {
#pragma unroll
        for (int m = 0; m < 4; ++m)
#pragma unroll
            for (int i = 0; i < 4; ++i) {
                const int row = row0 + 16 * m + (lane >> 4) * 4 + i; float s = 0.f;
#pragma unroll
                for (int n = 0; n < 4; ++n) {
                    const size_t idx = (size_t)row * D + col0 + 16 * n + (lane & 15);
                    const float v = base[idx] + acc[m][n][i];
                    out[idx] = v; s += v * v;
                    if (xb) xb[idx] = (bf16_t)f2bf(v);
                }
                if (ssq_next) {
                    s += __shfl_xor(s, 1); s += __shfl_xor(s, 2); s += __shfl_xor(s, 4); s += __shfl_xor(s, 8);
                    if ((lane & 15) == 0) atomicAdd(ssq_next + row, s);
                }
            }
    }
};
template <class Epi>
DEVI void gemm_simple(const bf16_t* A, int lda, const bf16_t* Bt, int ldb, int M, int N, int K, const Epi& epi) {
    const int tid = tid_opaque(), lane = tid & 63, wave = tid >> 6;
    const int gw = blockIdx.x * NWAVE + wave, NGW = gridDim.x * NWAVE;
    const int nN = N / 64, ntiles = (M / 64) * nN;
    for (int tile = gw; tile < ntiles; tile += NGW) {
        const int row0 = (tile / nN) * 64, col0 = (tile % nN) * 64;
        f32x4 acc[4][4];
#pragma unroll
        for (int m = 0; m < 4; ++m)
#pragma unroll
            for (int n = 0; n < 4; ++n) acc[m][n] = (f32x4){0.f, 0.f, 0.f, 0.f};
        const bf16_t* ap = A + (size_t)(row0 + (lane & 15)) * lda + 8 * (lane >> 4);
        const bf16_t* bp = Bt + (size_t)(col0 + (lane & 15)) * ldb + 8 * (lane >> 4);
        for (int k0 = 0; k0 < K; k0 += 32) {
            bf16x8 a[4], b[4];
#pragma unroll
            for (int m = 0; m < 4; ++m) a[m] = *(const bf16x8*)(ap + (size_t)(16 * m) * lda + k0);
#pragma unroll
            for (int n = 0; n < 4; ++n) b[n] = *(const bf16x8*)(bp + (size_t)(16 * n) * ldb + k0);
#pragma unroll
            for (int m = 0; m < 4; ++m)
#pragma unroll
                for (int n = 0; n < 4; ++n) acc[m][n] = __builtin_amdgcn_mfma_f32_16x16x32_bf16(a[m], b[n], acc[m][n], 0, 0, 0);
        }
        epi(acc, row0, col0, lane);
    }
}

DEVI u32x4 heads8(u32x4 raw, const float (&gv)[8], bool do_norm, float scale, const float (&cs)[16], int lane) {
    float v[8];
#pragma unroll
    for (int j = 0; j < 4; ++j) { v[2 * j] = lo16(raw[j]); v[2 * j + 1] = hi16(raw[j]); }
    if (do_norm) {
        float ss = 0.f;
#pragma unroll
        for (int j = 0; j < 8; ++j) ss += v[j] * v[j];
        ss += __shfl_xor(ss, 1); ss += __shfl_xor(ss, 2); ss += __shfl_xor(ss, 4);
        const float rs = rsqrtf(ss * (1.f / 64.f) + EPS);
#pragma unroll
        for (int j = 0; j < 8; ++j) v[j] = v[j] * rs * gv[j];
    }
    const int sub = lane & 7;
#pragma unroll
    for (int j = 0; j < 8; ++j) { const float o = __shfl_xor(v[j], 1); if (sub == 0) v[j] = v[j] * cs[j] - o * cs[8 + j]; else if (sub == 1) v[j] = v[j] * cs[j] + o * cs[8 + j]; }
    u32x4 w;
#pragma unroll
    for (int j = 0; j < 4; ++j) w[j] = cvtpk(v[2 * j] * scale, v[2 * j + 1] * scale);
    return w;
}
DEVI void load8(float (&g)[8], const float* p) { const f32x4 a = *(const f32x4*)p, b = *(const f32x4*)(p + 4); g[0] = a[0]; g[1] = a[1]; g[2] = a[2]; g[3] = a[3]; g[4] = b[0]; g[5] = b[1]; g[6] = b[2]; g[7] = b[3]; }
struct Post0Row { u32x4 qa, ka, qb, x, ckv; u32x2 wi; f32x4 c0, c1, c2, c3; };
DEVI void post0_load(Post0Row& R, const bf16_t* row, const float* cs, int lane) {
    R.qa = *(const u32x4*)(row + C_QA + 8 * lane); R.ka = *(const u32x4*)(row + C_KA + 8 * lane); R.qb = *(const u32x4*)(row + C_QB + 8 * lane);
    R.x = *(const u32x4*)(row + C_QI + 8 * ((lane < 40) ? lane : 0));
    R.ckv = *(const u32x4*)(row + C_CKV + 8 * (lane & 31));
    R.wi = *(const u32x2*)(row + C_WI);
    R.c0 = *(const f32x4*)cs; R.c1 = *(const f32x4*)(cs + 4); R.c2 = *(const f32x4*)(cs + 8); R.c3 = *(const f32x4*)(cs + 12);
}
DEVI void phase_post0(const Params& P, int parts = 3) {
    static_assert(C_KI == C_QI + 256, "k_idx follows q_idx");
    const int tid = tid_opaque(), lane = tid & 63, wave = tid >> 6;
    const int gw = blockIdx.x * NWAVE + wave, NGW = gridDim.x * NWAVE;
    unsigned char* ws = P.ws;
    const float qscale = 0.125f * LOG2E;
    float gqa[8], gka[8], gqb[8], gki[8];
    load8(gqa, P.in[15] + 8 * (lane & 7)); load8(gka, P.in[16] + 8 * (lane & 7)); load8(gqb, P.in[24] + 8 * (lane & 7)); load8(gki, P.in[26] + 8 * (lane & 7));
    if (parts & 1)
    for (int m0 = gw; m0 < T; m0 += 2 * NGW) {
        Post0Row R[2];
        const int m1 = (m0 + NGW < T) ? m0 + NGW : m0;
        post0_load(R[0], (const bf16_t*)(ws + WS_PROJ) + (size_t)m0 * LDP, (const float*)(ws + WS_CS) + (size_t)m0 * 16, lane);
        post0_load(R[1], (const bf16_t*)(ws + WS_PROJ) + (size_t)m1 * LDP, (const float*)(ws + WS_CS) + (size_t)m1 * 16, lane);
#pragma unroll
        for (int k = 0; k < 2; ++k) {
            const int m = k ? m1 : m0; if (k == 1 && m1 == m0) break;
            bf16_t* row = (bf16_t*)(ws + WS_PROJ) + (size_t)m * LDP;
            float cs[16];
#pragma unroll
            for (int j = 0; j < 4; ++j) { cs[j] = R[k].c0[j]; cs[4 + j] = R[k].c1[j]; cs[8 + j] = R[k].c2[j]; cs[12 + j] = R[k].c3[j]; }
            *(u32x4*)(row + C_QA + 8 * lane) = heads8(R[k].qa, gqa, true, qscale, cs, lane);
            *(u32x4*)(row + C_KA + 8 * lane) = heads8(R[k].ka, gka, true, 1.f, cs, lane);
            *(u32x4*)(row + C_QB + 8 * lane) = heads8(R[k].qb, gqb, true, qscale, cs, lane);
            {
              float v[8];
#pragma unroll
              for (int j = 0; j < 4; ++j) { v[2 * j] = lo16(R[k].x[j]); v[2 * j + 1] = hi16(R[k].x[j]); }
              float ss = 0.f;
#pragma unroll
              for (int j = 0; j < 8; ++j) ss += v[j] * v[j];
              ss += __shfl_xor(ss, 1); ss += __shfl_xor(ss, 2); ss += __shfl_xor(ss, 4);
              if (lane >= 32) { const float rs = rsqrtf(ss * (1.f / 64.f) + EPS);
#pragma unroll
                  for (int j = 0; j < 8; ++j) v[j] = v[j] * rs * gki[j]; }
              const int sub = lane & 7;
#pragma unroll
              for (int j = 0; j < 8; ++j) { const float o = __shfl_xor(v[j], 1); if (sub == 0) v[j] = v[j] * cs[j] - o * cs[8 + j]; else if (sub == 1) v[j] = v[j] * cs[j] + o * cs[8 + j]; }
              u32x4 w;
#pragma unroll
              for (int j = 0; j < 4; ++j) w[j] = cvtpk(v[2 * j], v[2 * j + 1]);
              if (lane < 32) *(u32x4*)(row + C_QI + 8 * lane) = w;
              else if (lane < 40) { const int c = lane - 32;
                  *(u32x4*)((bf16_t*)(ws + WS_KI) + (size_t)(m >> 5) * 2048 + (c >> 1) * 512 + (((c & 1) * 32 + (m & 31)) * 8)) = w; } }
            { float ss = 0.f;
#pragma unroll
              for (int j = 0; j < 4; ++j) { const float a = lo16(R[k].ckv[j]), b = hi16(R[k].ckv[j]); ss += a * a + b * b; }
              ss += __shfl_xor(ss, 1); ss += __shfl_xor(ss, 2); ss += __shfl_xor(ss, 4); ss += __shfl_xor(ss, 8); ss += __shfl_xor(ss, 16);
              if (lane == 0) { ((float*)(ws + WS_SSQCKV))[m] = ss;
                  *(f32x4*)((float*)(ws + WS_WI) + (size_t)m * 4) = (f32x4){lo16(R[k].wi.x) * (1.f / 16.f), hi16(R[k].wi.x) * (1.f / 16.f), lo16(R[k].wi.y) * (1.f / 16.f), hi16(R[k].wi.y) * (1.f / 16.f)}; } }
        }
    }
    if (parts & 2)
    for (int it = gw; it < 2 * MEMT; it += NGW) {
        const int l = it / MEMT, m = it % MEMT;
        bf16_t* row = (bf16_t*)(ws + WS_KVX) + (size_t)m * 2048 + l * 1024;
        float g[8]; load8(g, P.in[10] + l * 128 + 8 * (lane & 15));
        const u32x4 raw = *(const u32x4*)(row + 8 * lane);
        float v[8]; float ss = 0.f;
#pragma unroll
        for (int j = 0; j < 4; ++j) { v[2 * j] = lo16(raw[j]); v[2 * j + 1] = hi16(raw[j]); ss += v[2 * j] * v[2 * j] + v[2 * j + 1] * v[2 * j + 1]; }
        ss += __shfl_xor(ss, 1); ss += __shfl_xor(ss, 2); ss += __shfl_xor(ss, 4); ss += __shfl_xor(ss, 8);
        const float rs = rsqrtf(ss * (1.f / 128.f) + EPS);
        u32x4 w;
#pragma unroll
        for (int j = 0; j < 4; ++j) w[j] = cvtpk(v[2 * j] * rs * g[2 * j], v[2 * j + 1] * rs * g[2 * j + 1]);
        *(u32x4*)(row + 8 * lane) = w;
    }
}
DEVI void phase_postkb(const Params& P) {
    const int tid = tid_opaque(), lane = tid & 63, wave = tid >> 6;
    const int gw = blockIdx.x * NWAVE + wave, NGW = gridDim.x * NWAVE;
    unsigned char* ws = P.ws;
    float gkb[8]; load8(gkb, P.in[25] + 8 * (lane & 7));
    for (int m0 = gw; m0 < T; m0 += 4 * NGW) {
        u32x4 raw[4]; f32x4 c[4][4];
#pragma unroll
        for (int k = 0; k < 4; ++k) { const int m = (m0 + k * NGW < T) ? m0 + k * NGW : m0;
            raw[k] = *(const u32x4*)((const bf16_t*)(ws + WS_KBVB) + (size_t)m * 1024 + 8 * lane);
            const float* cs = (const float*)(ws + WS_CS) + (size_t)m * 16;
#pragma unroll
            for (int j = 0; j < 4; ++j) c[k][j] = *(const f32x4*)(cs + 4 * j); }
#pragma unroll
        for (int k = 0; k < 4; ++k) { const int m = m0 + k * NGW; if (m >= T) break;
            float cs[16];
#pragma unroll
            for (int j = 0; j < 16; ++j) cs[j] = c[k][j >> 2][j & 3];
            *(u32x4*)((bf16_t*)(ws + WS_KBVB) + (size_t)m * 1024 + 8 * lane) = heads8(raw[k], gkb, true, 1.f, cs, lane); }
    }
}

DEVI int crow(int r, int hi) { return (r & 3) + 8 * (r >> 2) + 4 * hi; }
typedef short v4i16_t __attribute__((ext_vector_type(4)));
DEVI s16x4 vtr(LAS const unsigned char* p) { return __builtin_bit_cast(s16x4, __builtin_amdgcn_ds_read_tr16_b64_v4i16((LAS v4i16_t*)p)); }

DEVI float max3f(float a, float b, float c) { float r; asm("v_max3_f32 %0, %1, %2, %3" : "=v"(r) : "v"(a), "v"(b), "v"(c)); return r; }
DEVI float max2f(float a, float b) { float r; asm("v_max_f32_e32 %0, %1, %2" : "=v"(r) : "v"(a), "v"(b)); return r; }
template <int DQK, int DV, int MODE, bool QP = false>
DEVI void attn_core(f32x16 (&o)[DV / 32], float& l_out, const bf16x8 (&qf)[DQK / 16],
                    const bf16_t* Kg, int ldk, const bf16_t* Vg, int ldv, int ntiles, int qpos, int qpos_wmin,
                    const u64* mrow, LAS unsigned char* lds, int tid) {
    constexpr int KROWB = DQK * 2, KCPR = DQK / 8, VP = (DV == 128) ? 320 : 192, VCPR = DV / 8;
    constexpr int KBUF = 64 * KROWB, VBUF = 64 * VP, KCH = 64 * KCPR / NTHR, VCH = 64 * VCPR / NTHR;
    constexpr float THR = 8.f;
#define KSWZ(r) ((KCPR == 8) ? (((r) >> 1) & 7) : ((r) & 15))
    LAS unsigned char* Kl = lds; LAS unsigned char* Vl = lds + 2 * KBUF;
    const int lane = tid & 63, r32 = lane & 31, hi = lane >> 5;
    u32x4 kreg[KCH], vreg[VCH];
#define A_GLOAD(t) do { _Pragma("unroll") for (int i_ = 0; i_ < KCH; ++i_) { const int c_ = tid + NTHR * i_, row_ = c_ / KCPR, ch_ = c_ % KCPR; kreg[i_] = *(const u32x4*)(Kg + (size_t)(64 * (t) + row_) * ldk + ch_ * 8); } \
        _Pragma("unroll") for (int i_ = 0; i_ < VCH; ++i_) { const int c_ = tid + NTHR * i_, row_ = c_ / VCPR, ch_ = c_ % VCPR; vreg[i_] = *(const u32x4*)(Vg + (size_t)(64 * (t) + row_) * ldv + ch_ * 8); } } while (0)
#define A_LSTORE(buf) do { _Pragma("unroll") for (int i_ = 0; i_ < KCH; ++i_) { const int c_ = tid + NTHR * i_, row_ = c_ / KCPR, ch_ = c_ % KCPR; *(LAS u32x4*)(Kl + (buf) * KBUF + row_ * KROWB + ((ch_ ^ KSWZ(row_)) << 4)) = kreg[i_]; } \
        _Pragma("unroll") for (int i_ = 0; i_ < VCH; ++i_) { const int c_ = tid + NTHR * i_, row_ = c_ / VCPR, ch_ = c_ % VCPR; *(LAS u32x4*)(Vl + (buf) * VBUF + row_ * VP + ch_ * 16) = vreg[i_]; } } while (0)
    A_GLOAD(0); A_LSTORE(0); __syncthreads();
#pragma unroll
    for (int d0 = 0; d0 < DQK / 16; ++d0) asm volatile("" :: "v"(qf[d0]));
    const int vb = (4 * hi + ((lane & 15) >> 2)) * VP + (16 * ((lane >> 4) & 1) + 4 * (lane & 3)) * 2;
    const short one = (short)0x3F80;
    const bf16x8 ones = ((r32 & ~4) == 0) ? (bf16x8){one, one, one, one, one, one, one, one} : (bf16x8){0, 0, 0, 0, 0, 0, 0, 0};
    f32x16 negm, lacc;
#pragma unroll
    for (int r = 0; r < 16; ++r) { negm[r] = 0.f; lacc[r] = 0.f; }
    float mhat = 0.f;
    const unsigned ninf = 0xFF800000u;
#if MK_AX == 1
    f32x16 dmy_;
#pragma unroll
    for (int r = 0; r < 16; ++r) dmy_[r] = 0.f;
#endif
    u64 wnext = 0ull;
    if (MODE == 2) wnext = mrow[0];
    for (int t = 0; t < ntiles; ++t) {
        const int buf = t & 1;
        const u64 wcur = wnext; (void)wcur;
        if (MODE == 2 && t + 1 < ntiles) wnext = mrow[t + 1];
        if (t + 1 < ntiles) A_GLOAD(t + 1);
        f32x16 p0, p1;
#pragma unroll
        for (int db = 0; db < DQK / 64; ++db) {
            bf16x8 kf[8];
#pragma unroll
            for (int e = 0; e < 4; ++e) { const int ch = 2 * (4 * db + e) + hi, row0 = r32, row1 = 32 + r32;
                if (!QP) {
                    kf[2 * e] = *(LAS const bf16x8*)(Kl + buf * KBUF + row0 * KROWB + ((ch ^ KSWZ(row0)) << 4));
                    kf[2 * e + 1] = *(LAS const bf16x8*)(Kl + buf * KBUF + row1 * KROWB + ((ch ^ KSWZ(row1)) << 4));
                } else {
                    const int c1 = 2 * (4 * db + e);
                    const s16x4 a0 = *(LAS const s16x4*)(Kl + buf * KBUF + row0 * KROWB + ((c1 ^ KSWZ(row0)) << 4) + 8 * hi), a1 = *(LAS const s16x4*)(Kl + buf * KBUF + row0 * KROWB + (((c1 + 1) ^ KSWZ(row0)) << 4) + 8 * hi);
                    const s16x4 b0 = *(LAS const s16x4*)(Kl + buf * KBUF + row1 * KROWB + ((c1 ^ KSWZ(row1)) << 4) + 8 * hi), b1 = *(LAS const s16x4*)(Kl + buf * KBUF + row1 * KROWB + (((c1 + 1) ^ KSWZ(row1)) << 4) + 8 * hi);
                    kf[2 * e] = (bf16x8){a0[0], a0[1], a0[2], a0[3], a1[0], a1[1], a1[2], a1[3]}; kf[2 * e + 1] = (bf16x8){b0[0], b0[1], b0[2], b0[3], b1[0], b1[1], b1[2], b1[3]};
                } }
#pragma unroll
            for (int e = 0; e < 4; ++e) { const int d0 = 4 * db + e;
                if (d0 == 0 && MODE == 2) {
                    const u64 w = wcur >> (4 * hi); const unsigned wl = (unsigned)w, wh = (unsigned)(w >> 32), nm = __float_as_uint(negm[0]);
#pragma unroll
                    for (int r = 0; r < 16; ++r) { const int bit = (r & 3) + 8 * (r >> 2);
                        const unsigned s0 = (unsigned)__builtin_amdgcn_sbfe(wl, bit, 1), s1 = (unsigned)__builtin_amdgcn_sbfe(wh, bit, 1);
                        p0[r] = __uint_as_float((nm & s0) | (ninf & ~s0)); p1[r] = __uint_as_float((nm & s1) | (ninf & ~s1)); }
                    p0 = __builtin_amdgcn_mfma_f32_32x32x16_bf16(kf[0], qf[0], p0, 0, 0, 0); p1 = __builtin_amdgcn_mfma_f32_32x32x16_bf16(kf[1], qf[0], p1, 0, 0, 0); }
                else if (d0 == 0) { p0 = __builtin_amdgcn_mfma_f32_32x32x16_bf16(kf[0], qf[0], negm, 0, 0, 0); p1 = __builtin_amdgcn_mfma_f32_32x32x16_bf16(kf[1], qf[0], negm, 0, 0, 0); }
                else { p0 = __builtin_amdgcn_mfma_f32_32x32x16_bf16(kf[2 * e], qf[d0], p0, 0, 0, 0); p1 = __builtin_amdgcn_mfma_f32_32x32x16_bf16(kf[2 * e + 1], qf[d0], p1, 0, 0, 0); } }
        }
        if (MODE == 1) {
            if (64 * t + 63 > qpos_wmin) {
#pragma unroll
                for (int r = 0; r < 16; ++r) { const int kv = 64 * t + crow(r, hi); if (kv > qpos) p0[r] = -INFINITY; if (kv + 32 > qpos) p1[r] = -INFINITY; }
            }
        }
        asm volatile("s_nop 15\n\ts_nop 7" : "+v"(p0), "+v"(p1));
        float rm;
        { float a, b;
#define MAX16(R, X) asm("v_max3_f32 %0, %1, %2, %3\n\tv_max3_f32 %0, %0, %4, %5\n\tv_max3_f32 %0, %0, %6, %7\n\tv_max3_f32 %0, %0, %8, %9\n\tv_max3_f32 %0, %0, %10, %11\n\tv_max3_f32 %0, %0, %12, %13\n\tv_max3_f32 %0, %0, %14, %15\n\tv_max_f32 %0, %0, %16" \
            : "=&v"(R) : "v"(X[0]), "v"(X[1]), "v"(X[2]), "v"(X[3]), "v"(X[4]), "v"(X[5]), "v"(X[6]), "v"(X[7]), "v"(X[8]), "v"(X[9]), "v"(X[10]), "v"(X[11]), "v"(X[12]), "v"(X[13]), "v"(X[14]), "v"(X[15]))
          MAX16(a, p0); MAX16(b, p1);
#undef MAX16
          const float m = max2f(a, b);
          const auto rr = __builtin_amdgcn_permlane32_swap(__float_as_uint(m), __float_as_uint(m), false, false);
          rm = max2f(__uint_as_float(rr[0]), __uint_as_float(rr[1])); }
        if (t == 0 || __any(rm > THR)) {
            const float dl = (t == 0) ? ((rm > -INFINITY) ? rm : 0.f) : fmaxf(rm, 0.f);
            mhat += dl;
#pragma unroll
            for (int r = 0; r < 16; ++r) { p0[r] -= dl; p1[r] -= dl; negm[r] = -mhat; }
            const float f = __builtin_amdgcn_exp2f(-dl);
#pragma unroll
            for (int d0 = 0; d0 < DV / 32; ++d0)
#pragma unroll
                for (int r = 0; r < 16; ++r) o[d0][r] *= f;
#pragma unroll
            for (int r = 0; r < 16; ++r) lacc[r] *= f;
        }
#pragma unroll
        for (int r = 0; r < 16; ++r) { p0[r] = __builtin_amdgcn_exp2f(p0[r]); p1[r] = __builtin_amdgcn_exp2f(p1[r]); }
#if MK_AX == 2
        if (MODE == 1) {
#pragma unroll
            for (int r = 0; r < 16; ++r) { float e0 = __builtin_amdgcn_exp2f(p0[r] * 0.999f), e1 = __builtin_amdgcn_exp2f(p1[r] * 0.999f); asm volatile("" :: "v"(e0), "v"(e1)); } }
#endif
        bf16x8 pb[4];
#pragma unroll
        for (int ks = 0; ks < 4; ++ks) {
            u32x4 w;
            if (ks < 2) { w.x = cvtpk(p0[8 * ks + 0], p0[8 * ks + 1]); w.y = cvtpk(p0[8 * ks + 2], p0[8 * ks + 3]); w.z = cvtpk(p0[8 * ks + 4], p0[8 * ks + 5]); w.w = cvtpk(p0[8 * ks + 6], p0[8 * ks + 7]); }
            else { const int k2 = ks - 2; w.x = cvtpk(p1[8 * k2 + 0], p1[8 * k2 + 1]); w.y = cvtpk(p1[8 * k2 + 2], p1[8 * k2 + 3]); w.z = cvtpk(p1[8 * k2 + 4], p1[8 * k2 + 5]); w.w = cvtpk(p1[8 * k2 + 6], p1[8 * k2 + 7]); }
            pb[ks] = __builtin_bit_cast(bf16x8, w);
        }
#pragma unroll
        for (int ks = 0; ks < 4; ++ks) lacc = __builtin_amdgcn_mfma_f32_32x32x16_bf16(ones, pb[ks], lacc, 0, 0, 0);
#pragma unroll
        for (int d0 = 0; d0 < DV / 32; ++d0)
#pragma unroll
            for (int ks = 0; ks < 4; ++ks) {
                const s16x4 lo = vtr(Vl + buf * VBUF + vb + (16 * ks) * VP + d0 * 64);
                const s16x4 hh = vtr(Vl + buf * VBUF + vb + (16 * ks + 8) * VP + d0 * 64);
                const bf16x8 a = (bf16x8){lo[0], lo[1], lo[2], lo[3], hh[0], hh[1], hh[2], hh[3]};
                o[d0] = __builtin_amdgcn_mfma_f32_32x32x16_bf16(a, pb[ks], o[d0], 0, 0, 0);
#if MK_AX == 1
                if (MODE == 1) dmy_ = __builtin_amdgcn_mfma_f32_32x32x16_bf16(a, pb[ks], dmy_, 0, 0, 0);
#endif
            }
        if (t + 1 < ntiles) A_LSTORE((t + 1) & 1);
        __syncthreads();
    }
#if MK_AX == 1
    asm volatile("" :: "v"(dmy_));
#endif
    l_out = lacc[0];
#undef A_GLOAD
#undef A_LSTORE
#undef KSWZ
}
template <int DV>
DEVI void store_oT(const f32x16 (&o)[DV / 32], float inv, bf16_t* dst, int hi) {
#pragma unroll
    for (int d0 = 0; d0 < DV / 32; ++d0)
#pragma unroll
        for (int g4 = 0; g4 < 4; ++g4) {
            u32x2 w; w.x = cvtpk(o[d0][4 * g4 + 0] * inv, o[d0][4 * g4 + 1] * inv); w.y = cvtpk(o[d0][4 * g4 + 2] * inv, o[d0][4 * g4 + 3] * inv);
            *(u32x2*)(dst + 32 * d0 + 8 * g4 + 4 * hi) = w;
        }
}

DEVI void attnA_unit(const Params& P, int b, int h, int c, int qb, LAS unsigned char* lds) {
    const int tid = tid_opaque(), lane = tid & 63, wave = tid >> 6, r32 = lane & 31, hi = lane >> 5;
    unsigned char* ws = P.ws;
    const bf16_t* proj = (const bf16_t*)(ws + WS_PROJ);
    const int q = qb * 256 + 32 * wave + r32; const size_t row = (size_t)b * S + q;
    bf16x8 qf[4];
#pragma unroll
    for (int d0 = 0; d0 < 4; ++d0) qf[d0] = *(const bf16x8*)(proj + row * LDP + C_QA + (2 * h + c) * 64 + 16 * d0 + 8 * hi);
    f32x16 o[4];
#pragma unroll
    for (int d0 = 0; d0 < 4; ++d0)
#pragma unroll
        for (int r = 0; r < 16; ++r) o[d0][r] = 0.f;
    float l_run = 0.f;
    attn_core<64, 128, 1>(o, l_run, qf, proj + (size_t)b * S * LDP + C_KA + (2 * h + c) * 64, LDP, proj + (size_t)b * S * LDP + C_VA + h * 128, LDP,
                          4 * (qb + 1), q, qb * 256 + 32 * wave, nullptr, lds, tid);
    const float lt = l_run;
    bf16_t* oa = (bf16_t*)(ws + WS_XB) + (size_t)c * T * 512 + row * 512 + h * 128;
    store_oT<128>(o, 1.f / lt, oa, hi);
}
DEVI void attnB_unit(const Params& P, int b, int hd, int qb, LAS unsigned char* lds) {
    const int tid = tid_opaque(), lane = tid & 63, wave = tid >> 6, r32 = lane & 31, hi = lane >> 5;
    unsigned char* ws = P.ws;
    const bf16_t* proj = (const bf16_t*)(ws + WS_PROJ); const bf16_t* kbvb = (const bf16_t*)(ws + WS_KBVB);
    const int q = qb * 256 + 32 * wave + r32; const size_t row = (size_t)b * S + q;
    bf16x8 qf[4];
#pragma unroll
    for (int d0 = 0; d0 < 4; ++d0) qf[d0] = *(const bf16x8*)(proj + row * LDP + C_QB + hd * 64 + 16 * d0 + 8 * hi);
    f32x16 o[2];
#pragma unroll
    for (int d0 = 0; d0 < 2; ++d0)
#pragma unroll
        for (int r = 0; r < 16; ++r) o[d0][r] = 0.f;
    float l_run = 0.f;
    attn_core<64, 64, 2>(o, l_run, qf, kbvb + (size_t)b * S * 1024 + hd * 64, 1024, kbvb + (size_t)b * S * 1024 + 512 + hd * 64, 1024,
                         4 * (qb + 1), q, qb * 256 + 32 * wave, (const u64*)(ws + WS_MASK) + row * 64, lds, tid);
    const float lt = l_run;
    store_oT<64>(o, 1.f / lt, (bf16_t*)(ws + WS_Y) + row * 1024 + 512 + hd * 64, hi);
}
DEVI void xattn_unit(const Params& P, int l, int b, int hd, int qb, LAS unsigned char* lds) {
    const int tid = tid_opaque(), lane = tid & 63, wave = tid >> 6, r32 = lane & 31, hi = lane >> 5;
    unsigned char* ws = P.ws;
    const bf16_t* qx = (const bf16_t*)(ws + WS_QX); const bf16_t* kvx = (const bf16_t*)(ws + WS_KVX) + l * 1024;
    const int q = qb * 256 + 32 * wave + r32; const size_t row = (size_t)b * S + q;
    const float* gq = P.in[9] + l * 128;
    u32x4 raw[8]; float ss = 0.f;
    f32x4 gqv[8][2];
#pragma unroll
    for (int d0 = 0; d0 < 8; ++d0) { raw[d0] = *(const u32x4*)(qx + row * 512 + hd * 128 + 16 * d0 + 8 * hi); gqv[d0][0] = *(const f32x4*)(gq + 16 * d0 + 8 * hi); gqv[d0][1] = *(const f32x4*)(gq + 16 * d0 + 8 * hi + 4); }
#pragma unroll
    for (int d0 = 0; d0 < 8; ++d0) {
#pragma unroll
        for (int j = 0; j < 4; ++j) { const float a = lo16(raw[d0][j]), bq = hi16(raw[d0][j]); ss += a * a + bq * bq; } }
    ss += __shfl_xor(ss, 32);
    const float rs = rsqrtf(ss * (1.f / 128.f) + EPS) * (0.08838834764831845f * LOG2E);
    bf16x8 qf[8];
#pragma unroll
    for (int d0 = 0; d0 < 8; ++d0) { u32x4 w;
#pragma unroll
        for (int j = 0; j < 4; ++j) w[j] = cvtpk(lo16(raw[d0][j]) * rs * gqv[d0][j >> 1][(2 * j) & 3], hi16(raw[d0][j]) * rs * gqv[d0][j >> 1][(2 * j + 1) & 3]);
        qf[d0] = __builtin_bit_cast(bf16x8, w); }
    f32x16 o[4];
#pragma unroll
    for (int d0 = 0; d0 < 4; ++d0)
#pragma unroll
        for (int r = 0; r < 16; ++r) o[d0][r] = 0.f;
    float l_run = 0.f;
#if MK_XA2
    attn_core<128, 128, 0>(o, l_run, qf, kvx + (size_t)b * MEML * 2048 + hd * 128, 2048, kvx + (size_t)b * MEML * 2048 + 512 + hd * 128, 2048, MEML / 64, q, 0, nullptr, lds, tid);
#pragma unroll
    for (int d0 = 0; d0 < 4; ++d0)
#pragma unroll
        for (int r = 0; r < 16; ++r) o[d0][r] = 0.f;
    l_run = 0.f;
#endif
    attn_core<128, 128, 0>(o, l_run, qf, kvx + (size_t)b * MEML * 2048 + hd * 128, 2048, kvx + (size_t)b * MEML * 2048 + 512 + hd * 128, 2048,
                           MEML / 64, q, 0, nullptr, lds, tid);
    const float lt = l_run;
    store_oT<128>(o, 1.f / lt, (bf16_t*)(ws + WS_YX) + row * 512 + hd * 128, hi);
}

DEVI void xattn_fused_unit(const Params& P, int l, int b, int hd, int qb, LAS unsigned char* lds) {
    const int tid = tid_opaque(), lane = tid & 63, wave = tid >> 6, r32 = lane & 31, hi = lane >> 5;
    unsigned char* ws = P.ws;
    const bf16_t* kvx = (const bf16_t*)(ws + WS_KVX) + l * 1024;
    const int q = qb * 256 + 32 * wave + r32; const size_t row = (size_t)b * S + q;
    const bf16_t* Wh = (const bf16_t*)(ws + W_QX) + (size_t)l * 512 * 1024 + (size_t)(hd * 128) * 1024;
    const float ssqx = ((const float*)(ws + WS_SSQ))[(size_t)(l ? 4 : 1) * T + row];
    const float* gq = P.in[9] + l * 128;
#if MK_TPROBE >= 30
    unsigned long long tsx_[5]; tsx_[0] = __builtin_amdgcn_s_memtime();
#endif
    f32x16 acc[4];
#pragma unroll
    for (int blk = 0; blk < 4; ++blk)
#pragma unroll
        for (int r = 0; r < 16; ++r) acc[blk][r] = 0.f;
    u32x4 wa[2], wb[2], xr[4];
    const bf16_t* Xb = (const bf16_t*)(ws + WS_XB) + ((size_t)b * S + qb * 256) * 1024;
    LAS unsigned char* XL = lds + 49152;
#define XF_WLOAD(W_, s) do { _Pragma("unroll") for (int i_ = 0; i_ < 2; ++i_) { const int c_ = tid + NTHR * i_; W_[i_] = *(const u32x4*)(Wh + (size_t)(c_ >> 3) * 1024 + 64 * (s) + (c_ & 7) * 8); } } while (0)
#define XF_WSTORE(W_, buf) do { _Pragma("unroll") for (int i_ = 0; i_ < 2; ++i_) { const int c_ = tid + NTHR * i_, row_ = c_ >> 3, ch_ = c_ & 7; *(LAS u32x4*)(lds + (buf) * 16384 + row_ * 128 + ((ch_ ^ ((row_ >> 1) & 7)) << 4)) = W_[i_]; } } while (0)
#define XF_XLOAD(s) do { _Pragma("unroll") for (int i_ = 0; i_ < 4; ++i_) { const int c_ = tid + NTHR * i_; xr[i_] = *(const u32x4*)(Xb + (size_t)(c_ >> 3) * 1024 + 64 * (s) + (c_ & 7) * 8); } } while (0)
#define XF_XSTORE(buf) do { _Pragma("unroll") for (int i_ = 0; i_ < 4; ++i_) { const int c_ = tid + NTHR * i_, row_ = c_ >> 3, ch_ = c_ & 7; *(LAS u32x4*)(XL + (buf) * 32768 + row_ * 128 + ((ch_ ^ ((row_ >> 1) & 7)) << 4)) = xr[i_]; } } while (0)
#define XF_MMA(wbuf, xbuf) do { bf16x8 wf_[4][4], xq_[4];        \
        _Pragma("unroll") for (int ks = 0; ks < 4; ++ks) { const int xrow = 32 * wave + r32, ch = 2 * ks + hi; \
            xq_[ks] = *(LAS const bf16x8*)(XL + (xbuf) * 32768 + xrow * 128 + ((ch ^ ((xrow >> 1) & 7)) << 4)); \
            _Pragma("unroll") for (int blk = 0; blk < 4; ++blk) { const int rw = 32 * blk + r32; \
                wf_[ks][blk] = *(LAS const bf16x8*)(lds + (wbuf) * 16384 + rw * 128 + ((ch ^ ((rw >> 1) & 7)) << 4)); } } \
        asm volatile("s_waitcnt lgkmcnt(0)" ::: "memory"); __builtin_amdgcn_sched_barrier(0); \
        _Pragma("unroll") for (int ks = 0; ks < 4; ++ks) _Pragma("unroll") for (int blk = 0; blk < 4; ++blk) acc[blk] = __builtin_amdgcn_mfma_f32_32x32x16_bf16(wf_[ks][blk], xq_[ks], acc[blk], 0, 0, 0); \
        __builtin_amdgcn_sched_barrier(0); } while (0)
    XF_WLOAD(wa, 0); XF_WLOAD(wb, 1); XF_XLOAD(0);
    XF_WSTORE(wa, 0); XF_WSTORE(wb, 1); XF_XSTORE(0); __syncthreads();
    for (int s = 0; s < 16; s += 2) {
        if (s + 2 < 16) XF_WLOAD(wa, s + 2);
        XF_XLOAD(s + 1);
        XF_MMA(s % 3, 0);
        if (s + 2 < 16) XF_WSTORE(wa, (s + 2) % 3);
        XF_XSTORE(1);
        __syncthreads();
        if (s + 3 < 16) XF_WLOAD(wb, s + 3);
        if (s + 2 < 16) XF_XLOAD(s + 2);
        XF_MMA((s + 1) % 3, 1);
        if (s + 3 < 16) XF_WSTORE(wb, (s + 3) % 3);
        if (s + 2 < 16) XF_XSTORE(0);
        __syncthreads();
    }
#undef XF_WLOAD
#undef XF_WSTORE
#undef XF_XLOAD
#undef XF_XSTORE
#undef XF_MMA
#if MK_TPROBE >= 30
    asm volatile("s_waitcnt vmcnt(0) lgkmcnt(0)" ::: "memory"); tsx_[1] = __builtin_amdgcn_s_memtime();
#endif
    f32x4 gqv[4][4];
#pragma unroll
    for (int blk = 0; blk < 4; ++blk)
#pragma unroll
        for (int g4 = 0; g4 < 4; ++g4) gqv[blk][g4] = *(const f32x4*)(gq + 32 * blk + 8 * g4 + 4 * hi);
    float ss = 0.f;
#pragma unroll
    for (int blk = 0; blk < 4; ++blk)
#pragma unroll
        for (int r = 0; r < 16; ++r) ss += acc[blk][r] * acc[blk][r];
    { const auto sw = __builtin_amdgcn_permlane32_swap(__float_as_uint(ss), __float_as_uint(ss), false, false); ss = __uint_as_float(sw[0]) + __uint_as_float(sw[1]); }
    const float c = rsqrtf(ssqx * (1.f / 1024.f) + EPS);
    const float f = c * rsqrtf(c * c * ss * (1.f / 128.f) + EPS) * (0.08838834764831845f * LOG2E);
    bf16x8 qf[8];
#pragma unroll
    for (int blk = 0; blk < 4; ++blk)
#pragma unroll
        for (int e = 0; e < 2; ++e) { u32x4 w;
#pragma unroll
            for (int jj = 0; jj < 4; ++jj) { const int r0 = 8 * e + 2 * jj;
                w[jj] = cvtpk(acc[blk][r0] * f * gqv[blk][r0 >> 2][r0 & 3], acc[blk][r0 + 1] * f * gqv[blk][r0 >> 2][(r0 & 3) + 1]); }
            qf[2 * blk + e] = __builtin_bit_cast(bf16x8, w); }
    f32x16 o[4];
#pragma unroll
    for (int d0 = 0; d0 < 4; ++d0)
#pragma unroll
        for (int r = 0; r < 16; ++r) o[d0][r] = 0.f;
    float l_run = 0.f;
#if MK_TPROBE >= 30
    asm volatile("s_waitcnt vmcnt(0) lgkmcnt(0)" ::: "memory"); tsx_[2] = __builtin_amdgcn_s_memtime();
#endif
    attn_core<128, 128, 0, true>(o, l_run, qf, kvx + (size_t)b * MEML * 2048 + hd * 128, 2048, kvx + (size_t)b * MEML * 2048 + 512 + hd * 128, 2048,
                                 MEML / 64, q, 0, nullptr, lds, tid);
#if MK_TPROBE >= 30
    asm volatile("s_waitcnt vmcnt(0) lgkmcnt(0)" ::: "memory"); tsx_[3] = __builtin_amdgcn_s_memtime();
#endif
    store_oT<128>(o, 1.f / l_run, (bf16_t*)(ws + WS_YX) + row * 512 + hd * 128, hi);
#if MK_TPROBE >= 30
    asm volatile("s_waitcnt vmcnt(0) lgkmcnt(0)" ::: "memory"); tsx_[4] = __builtin_amdgcn_s_memtime();
    if (blockIdx.x == 0 && tid == 0 && l == 0) { unsigned long long* TS = (unsigned long long*)(ws + WS_BAR + 65536); for (int k = 0; k < 4; ++k) atomicAdd(TS + 16 + k, tsx_[k + 1] - tsx_[k]); atomicAdd(TS + 20, tsx_[4] - tsx_[0]); }
#endif
}

#define DPP_STEP4(OP, v) do { v = OP(v, __builtin_amdgcn_update_dpp(v, v, 0xB1, 0xF, 0xF, false)); v = OP(v, __builtin_amdgcn_update_dpp(v, v, 0x4E, 0xF, 0xF, false)); \
        v = OP(v, __builtin_amdgcn_update_dpp(v, v, 0x141, 0xF, 0xF, false)); v = OP(v, __builtin_amdgcn_update_dpp(v, v, 0x140, 0xF, 0xF, false)); } while (0)
DEVI unsigned umax2(unsigned a, unsigned b) { return a > b ? a : b; }
DEVI unsigned umin2(unsigned a, unsigned b) { return a < b ? a : b; }
DEVI unsigned wave_max_u32(unsigned v) { DPP_STEP4(umax2, v);
    const auto a = __builtin_amdgcn_permlane16_swap(v, v, false, false); v = umax2(a[0], a[1]);
    const auto b = __builtin_amdgcn_permlane32_swap(v, v, false, false); return umax2(b[0], b[1]); }
DEVI unsigned wave_min_u32(unsigned v) { DPP_STEP4(umin2, v);
    const auto a = __builtin_amdgcn_permlane16_swap(v, v, false, false); v = umin2(a[0], a[1]);
    const auto b = __builtin_amdgcn_permlane32_swap(v, v, false, false); return umin2(b[0], b[1]); }
DEVI float row16_sum(float s) {
    s += __builtin_bit_cast(float, __builtin_amdgcn_update_dpp(0, __builtin_bit_cast(int, s), 0xB1, 0xF, 0xF, false)); s += __builtin_bit_cast(float, __builtin_amdgcn_update_dpp(0, __builtin_bit_cast(int, s), 0x4E, 0xF, 0xF, false));
    s += __builtin_bit_cast(float, __builtin_amdgcn_update_dpp(0, __builtin_bit_cast(int, s), 0x141, 0xF, 0xF, false)); s += __builtin_bit_cast(float, __builtin_amdgcn_update_dpp(0, __builtin_bit_cast(int, s), 0x140, 0xF, 0xF, false));
    return s; }
DEVI int wave_sum_dpp(int v) {
    v += __builtin_amdgcn_update_dpp(0, v, 0xB1, 0xF, 0xF, false);
    v += __builtin_amdgcn_update_dpp(0, v, 0x4E, 0xF, 0xF, false);
    v += __builtin_amdgcn_update_dpp(0, v, 0x141, 0xF, 0xF, false);
    v += __builtin_amdgcn_update_dpp(0, v, 0x140, 0xF, 0xF, false);
    return (__builtin_amdgcn_readlane(v, 0) + __builtin_amdgcn_readlane(v, 16)) + (__builtin_amdgcn_readlane(v, 32) + __builtin_amdgcn_readlane(v, 48));
}
constexpr int IDX_SROW = 4096 + 64;
DEVI void indexer_unit(const Params& P, int b, int t0, LAS unsigned char* lds) {
    const int tid = tid_opaque(), lane = tid & 63, wave = __builtin_amdgcn_readfirstlane(tid >> 6), r32 = lane & 31, hi = lane >> 5;
    unsigned char* ws = P.ws;
    const bf16_t* proj = (const bf16_t*)(ws + WS_PROJ); const float* WI = (const float*)(ws + WS_WI);
    LAS float* Ssc = (LAS float*)lds;
    for (int rs_ = 0; rs_ < 1 + MK_SC2; ++rs_)
    if (t0 + 7 >= 255) {
        bf16x8 af[4];
        { const int qq = r32 >> 2, hh = r32 & 3; const size_t row = (size_t)b * S + t0 + qq;
#pragma unroll
          for (int d0 = 0; d0 < 4; ++d0) af[d0] = *(const bf16x8*)(proj + row * LDP + C_QI + hh * 64 + 16 * d0 + 8 * hi); }
        float wv[16];
#pragma unroll
        for (int r = 0; r < 16; ++r) wv[r] = WI[((size_t)b * S + t0 + 2 * (r >> 2) + hi) * 4 + (r & 3)];
        const int nkt = (t0 + 8 + 31) / 32;
        const bf16_t* kbase = (const bf16_t*)(ws + WS_KI) + (size_t)(b * (S / 32)) * 2048 + lane * 8;
        bf16x8 kb0[4], kb1[4], kb2[4], kb3[4];
#define IDX_LOAD(B, kt_) do { const int k_ = ((kt_) < nkt) ? (kt_) : (nkt - 1); _Pragma("unroll") for (int d0 = 0; d0 < 4; ++d0) B[d0] = *(const bf16x8*)(kbase + (size_t)k_ * 2048 + d0 * 512); } while (0)
#define IDX_COMP(B, kt_) do { f32x16 c; _Pragma("unroll") for (int r = 0; r < 16; ++r) c[r] = 0.f; \
            _Pragma("unroll") for (int d0 = 0; d0 < 4; ++d0) c = __builtin_amdgcn_mfma_f32_32x32x16_bf16(af[d0], B[d0], c, 0, 0, 0); \
            const int key = (kt_) * 32 + r32; \
            _Pragma("unroll") for (int g4 = 0; g4 < 4; ++g4) { float s = 0.f; \
                _Pragma("unroll") for (int hh = 0; hh < 4; ++hh) s += fmaxf(c[4 * g4 + hh], 0.f) * wv[4 * g4 + hh]; \
                if ((kt_) == nkt - 1 && key > t0 + 2 * g4 + hi) s = -INFINITY;        \
                Ssc[(2 * g4 + hi) * IDX_SROW + key + (key >> 6)] = s; } } while (0)
#define IDX_FENCE() asm volatile("" ::: "memory")
        IDX_LOAD(kb0, wave); IDX_LOAD(kb1, wave + NWAVE); IDX_LOAD(kb2, wave + 2 * NWAVE); IDX_FENCE();
        for (int kt = wave; kt < nkt; kt += 4 * NWAVE) {
            IDX_LOAD(kb3, kt + 3 * NWAVE); IDX_FENCE(); IDX_COMP(kb0, kt); IDX_FENCE();
            if (kt + NWAVE >= nkt) break;
            IDX_LOAD(kb0, kt + 4 * NWAVE); IDX_FENCE(); IDX_COMP(kb1, kt + NWAVE); IDX_FENCE();
            if (kt + 2 * NWAVE >= nkt) break;
            IDX_LOAD(kb1, kt + 5 * NWAVE); IDX_FENCE(); IDX_COMP(kb2, kt + 2 * NWAVE); IDX_FENCE();
            if (kt + 3 * NWAVE >= nkt) break;
            IDX_LOAD(kb2, kt + 6 * NWAVE); IDX_FENCE(); IDX_COMP(kb3, kt + 3 * NWAVE); IDX_FENCE();
        }
#undef IDX_FENCE
#undef IDX_LOAD
#undef IDX_COMP
        if ((nkt & 1) && lane < 32) { const int key = nkt * 32 + lane; Ssc[wave * IDX_SROW + key + (key >> 6)] = -INFINITY; }
        if (wave == 0) Ssc[8 * IDX_SROW + lane] = -INFINITY;
    }
    __syncthreads();
    for (int rr_ = 0; rr_ < 1 + MK_SEL2; ++rr_) {
        const int t = t0 + wave; u64 myw = 0ull;
#if MK_TPROBE
        unsigned long long ts0_ = __builtin_amdgcn_s_memtime(), ts1_ = ts0_, ts2_ = ts0_;
#endif
        if (t >= 255) {
            unsigned u[64];
            { const LAS float* srow = (64 * lane <= t) ? (Ssc + wave * IDX_SROW + 65 * lane) : (Ssc + 8 * IDX_SROW);
#pragma unroll
              for (int j = 0; j < 64; ++j) { const unsigned bits = __float_as_uint(srow[j]);
                  u[j] = bits ^ ((unsigned)((int)bits >> 31) | 0x80000000u); } }
            unsigned a32[32], a16[16], a8[8], a4[4];
#pragma unroll
            for (int i = 0; i < 32; ++i) a32[i] = max(u[2 * i], u[2 * i + 1]);
#pragma unroll
            for (int i = 0; i < 16; ++i) a16[i] = max(a32[2 * i], a32[2 * i + 1]);
#pragma unroll
            for (int i = 0; i < 8; ++i) a8[i] = max(a16[2 * i], a16[2 * i + 1]);
#pragma unroll
            for (int i = 0; i < 4; ++i) a4[i] = max(a8[2 * i], a8[2 * i + 1]);
            unsigned Mx = max(max(a4[0], a4[1]), max(a4[2], a4[3])), Lx = 0xffffffffu;
            { const int nfull = __builtin_amdgcn_readfirstlane((t + 1) >> 6); int nl;
              if (nfull >= 64) { nl = 64; Lx = min(min(a4[0], a4[1]), min(a4[2], a4[3])); }
              else if (nfull >= 32) { nl = 32;
#pragma unroll
                  for (int i = 0; i < 8; ++i) Lx = min(Lx, a8[i]); }
              else if (nfull >= 16) { nl = 16;
#pragma unroll
                  for (int i = 0; i < 16; ++i) Lx = min(Lx, a16[i]); }
              else if (nfull >= 8) { nl = 8;
#pragma unroll
                  for (int i = 0; i < 32; ++i) Lx = min(Lx, a32[i]); }
              else { nl = 4;
#pragma unroll
                  for (int j = 0; j < 64; ++j) Lx = min(Lx, u[j]); }
              if (lane >= nl) Lx = 0xffffffffu;
              Mx = wave_max_u32(Mx); Lx = wave_min_u32(Lx); }
            Mx = __builtin_amdgcn_readfirstlane(Mx); Lx = __builtin_amdgcn_readfirstlane(Lx);
#if MK_TPROBE
            asm volatile("s_waitcnt vmcnt(0) lgkmcnt(0)" ::: "memory"); ts1_ = __builtin_amdgcn_s_memtime();
#endif
            { const unsigned lxm1 = Lx - 1u;
#pragma unroll
              for (int j = 0; j < 64; ++j) u[j] = __builtin_elementwise_sub_sat(u[j], lxm1); }
            unsigned prefix = 0u; bool exact = false;
            for (int rb_ = 0; rb_ < 1 + MK_BIS2; ++rb_) { prefix = 0u; exact = false;
            for (int bit = 31 - __builtin_clz(Mx - Lx + 1u); bit >= 0; --bit) {
                const unsigned cand = prefix | (1u << bit); int c0 = 0, c1 = 0, c2 = 0, c3 = 0;
#define IDX_CNT8(j0) asm volatile( \
                    "v_cmp_le_u32 vcc, %10, %2\n\tv_addc_co_u32 %0, vcc, 0, %0, vcc\n\tv_cmp_le_u32 vcc, %10, %3\n\tv_addc_co_u32 %1, vcc, 0, %1, vcc\n\t" \
                    "v_cmp_le_u32 vcc, %10, %4\n\tv_addc_co_u32 %0, vcc, 0, %0, vcc\n\tv_cmp_le_u32 vcc, %10, %5\n\tv_addc_co_u32 %1, vcc, 0, %1, vcc\n\t" \
                    "v_cmp_le_u32 vcc, %10, %6\n\tv_addc_co_u32 %0, vcc, 0, %0, vcc\n\tv_cmp_le_u32 vcc, %10, %7\n\tv_addc_co_u32 %1, vcc, 0, %1, vcc\n\t" \
                    "v_cmp_le_u32 vcc, %10, %8\n\tv_addc_co_u32 %0, vcc, 0, %0, vcc\n\tv_cmp_le_u32 vcc, %10, %9\n\tv_addc_co_u32 %1, vcc, 0, %1, vcc" \
                    : "+v"(c0), "+v"(c1) \
                    : "v"(u[(j0)]), "v"(u[(j0) + 1]), "v"(u[(j0) + 2]), "v"(u[(j0) + 3]), "v"(u[(j0) + 4]), "v"(u[(j0) + 5]), "v"(u[(j0) + 6]), "v"(u[(j0) + 7]), "v"(candv) : "vcc")
                const unsigned candv = cand;
                IDX_CNT8(0); IDX_CNT8(8); IDX_CNT8(16); IDX_CNT8(24); IDX_CNT8(32); IDX_CNT8(40); IDX_CNT8(48); IDX_CNT8(56);
#undef IDX_CNT8
                c2 = 0; c3 = 0;
                const int cnt = wave_sum_dpp((c0 + c1) + (c2 + c3));
                if (cnt >= 256) prefix = cand;
                if (cnt == 256) { exact = true; break; }
            }
            }
#if MK_TPROBE
            asm volatile("s_waitcnt vmcnt(0) lgkmcnt(0)" ::: "memory"); ts2_ = __builtin_amdgcn_s_memtime();
#endif
            unsigned mlo = 0u, mhi = 0u;
            if (exact) {
#pragma unroll
                for (int j = 31; j >= 0; --j) asm volatile("v_cmp_le_u32 vcc, %4, %2\n\tv_addc_co_u32 %0, vcc, %0, %0, vcc\n\tv_cmp_le_u32 vcc, %4, %3\n\tv_addc_co_u32 %1, vcc, %1, %1, vcc"
                                                           : "+v"(mlo), "+v"(mhi) : "v"(u[j]), "v"(u[32 + j]), "v"(prefix) : "vcc");
            } else {
                int ngt = 0, nti = 0;
#pragma unroll
                for (int j = 0; j < 64; ++j) { ngt += (u[j] > prefix) ? 1 : 0; nti += (u[j] == prefix) ? 1 : 0; }
                const int need = 256 - (int)wave_sum((float)ngt);
                int incl = nti;
#pragma unroll
                for (int o = 1; o < 64; o <<= 1) { const int v = __shfl_up(incl, o); if (lane >= o) incl += v; }
                int running = incl - nti;
#pragma unroll
                for (int j = 0; j < 64; ++j) {
                    const bool tie = (u[j] == prefix);
                    const unsigned sel = ((u[j] > prefix) || (tie && running < need)) ? 1u : 0u;
                    running += tie ? 1 : 0;
                    if (j < 32) mlo |= sel << j; else mhi |= sel << (j - 32);
                }
            }
            myw = ((u64)mhi << 32) | mlo;
        } else {
            const int lo = 64 * lane;
            if (lo + 63 <= t) myw = ~0ull; else if (lo > t) myw = 0ull; else myw = (~0ull) >> (63 - (t - lo));
        }
        ((u64*)(ws + WS_MASK))[((size_t)b * S + t) * 64 + lane] = myw;
#if MK_TPROBE
        { asm volatile("s_waitcnt vmcnt(0) lgkmcnt(0)" ::: "memory"); const unsigned long long ts3_ = __builtin_amdgcn_s_memtime();
          if (blockIdx.x == 0 && wave == 0 && lane == 0 && t >= 255) { unsigned long long* TS = (unsigned long long*)(ws + WS_BAR + 65536);
              atomicAdd(TS + 0, ts1_ - ts0_); atomicAdd(TS + 1, ts2_ - ts1_); atomicAdd(TS + 2, ts3_ - ts2_); atomicAdd(TS + 3, ts3_ - ts0_); } }
#endif
    }
    __syncthreads();
}

DEVI void combineA_rows(const Params& P) {
    const int tid = tid_opaque(), lane = tid & 63, wave = tid >> 6;
    const int gw = blockIdx.x * NWAVE + wave, NGW = gridDim.x * NWAVE;
    unsigned char* ws = P.ws;
    const float d1 = wave_sum(P.in[17][lane] * P.in[18][lane]), d2 = wave_sum(P.in[19][lane] * P.in[20][lane]);
    const float lam_init = 0.2f, lam = expf(d1) - expf(d2) + lam_init;
    const bf16_t* o0 = (const bf16_t*)(ws + WS_XB); const bf16_t* o1 = o0 + (size_t)T * 512;
    const float* gs = P.in[21] + 8 * (lane & 15);
    for (int m0 = gw; m0 < T; m0 += 4 * NGW) {
        u32x4 a[4], bq[4];
#pragma unroll
        for (int k = 0; k < 4; ++k) { const int m = (m0 + k * NGW < T) ? m0 + k * NGW : m0; a[k] = *(const u32x4*)(o0 + (size_t)m * 512 + 8 * lane); bq[k] = *(const u32x4*)(o1 + (size_t)m * 512 + 8 * lane); }
#pragma unroll
        for (int k = 0; k < 4; ++k) { const int m = m0 + k * NGW; if (m >= T) break;
            float v[8]; float ss = 0.f;
#pragma unroll
            for (int j = 0; j < 4; ++j) { v[2 * j] = lo16(a[k][j]) - lam * lo16(bq[k][j]); v[2 * j + 1] = hi16(a[k][j]) - lam * hi16(bq[k][j]); ss += v[2 * j] * v[2 * j] + v[2 * j + 1] * v[2 * j + 1]; }
            ss = row16_sum(ss);
            const float rs = rsqrtf(ss * (1.f / 128.f) + EPS) * (1.f - lam_init);
            u32x4 w;
#pragma unroll
            for (int j = 0; j < 4; ++j) w[j] = cvtpk(v[2 * j] * rs * gs[2 * j], v[2 * j + 1] * rs * gs[2 * j + 1]);
            *(u32x4*)((bf16_t*)(ws + WS_Y) + (size_t)m * 1024 + 8 * lane) = w; }
    }
}

template <int W>
DEVI void pool_item(const bf16_t* pr, bf16_t* y, int m, int c0) {
    const int t = m & (S - 1);
    u32x4 z[W];
#pragma unroll
    for (int dt = 0; dt < W; ++dt) z[dt] = *(const u32x4*)(pr + (size_t)(m - ((dt <= t) ? dt : t)) * 2048 + 1536 + c0);
    float sum[8];
#pragma unroll
    for (int j = 0; j < 8; ++j) sum[j] = 0.f;
#pragma unroll
    for (int dt = 0; dt < W; ++dt) { const float wgt = (dt <= t) ? 1.f : 0.f;
#pragma unroll
        for (int j = 0; j < 4; ++j) { sum[2 * j] += wgt * lo16(z[dt][j]); sum[2 * j + 1] += wgt * hi16(z[dt][j]); } }
    const float inv = 1.f / (float)((t + 1 < W) ? (t + 1) : W); u32x4 w;
#pragma unroll
    for (int j = 0; j < 4; ++j) w[j] = cvtpk(sum[2 * j] * inv - lo16(z[0][j]), sum[2 * j + 1] * inv - hi16(z[0][j]));
    *(u32x4*)(y + (size_t)m * 1024 + 512 + c0) = w;
}
DEVI void phase_mix1(const Params& P) {
    const int gt = blockIdx.x * NTHR + tid_opaque(), NGT = gridDim.x * NTHR;
    unsigned char* ws = P.ws;
    const bf16_t* pr = (const bf16_t*)(ws + WS_PROJ1);
    bf16_t* y = (bf16_t*)(ws + WS_Y);
    const float* cw = P.in[29];
    for (int it0 = gt; it0 < T * 64; it0 += 2 * NGT) {
        u32x4 gc[2][3], hc[2][3], gb[2];
#pragma unroll
        for (int k = 0; k < 2; ++k) { const int it = (it0 + k * NGT < T * 64) ? it0 + k * NGT : it0; const int m = it >> 6, c0 = 8 * (it & 63), t = m & (S - 1);
#pragma unroll
            for (int dt = 0; dt < 3; ++dt) { const size_t r = (size_t)(m - ((dt <= t) ? dt : t)) * 2048; gc[k][dt] = *(const u32x4*)(pr + r + 512 + c0); hc[k][dt] = *(const u32x4*)(pr + r + 1024 + c0); }
            gb[k] = *(const u32x4*)(pr + (size_t)m * 2048 + c0); }
#pragma unroll
        for (int k = 0; k < 2; ++k) { const int it = it0 + k * NGT; if (it >= T * 64) break; const int m = it >> 6, c0 = 8 * (it & 63), t = m & (S - 1);
            float wgt[3][8];
#pragma unroll
            for (int dt = 0; dt < 3; ++dt) { float tmp[8]; load8(tmp, cw + (2 - dt) * 512 + c0); const float on = (dt <= t) ? 1.f : 0.f;
#pragma unroll
                for (int j = 0; j < 8; ++j) wgt[dt][j] = tmp[j] * on; }
            u32x4 w;
#pragma unroll
            for (int j = 0; j < 4; ++j) { float a = 0.f, b = 0.f;
#pragma unroll
                for (int dt = 0; dt < 3; ++dt) { a += wgt[dt][2 * j] * (lo16(gc[k][dt][j]) * lo16(hc[k][dt][j])); b += wgt[dt][2 * j + 1] * (hi16(gc[k][dt][j]) * hi16(hc[k][dt][j])); }
                w[j] = cvtpk(lo16(gb[k][j]) * a, hi16(gb[k][j]) * b); }
            *(u32x4*)(y + (size_t)m * 1024 + c0) = w; }
    }
    for (int it = gt; it < T * 16; it += NGT) { const int m = it >> 4, cj = 8 * (it & 15);
        pool_item<2>(pr, y, m, cj); pool_item<4>(pr, y, m, 128 + cj); asm volatile("" ::: "memory"); pool_item<8>(pr, y, m, 256 + cj); asm volatile("" ::: "memory"); pool_item<16>(pr, y, m, 384 + cj); asm volatile("" ::: "memory"); }
}

DEVI float sum_rows4(float s) {
    const auto a = __builtin_amdgcn_permlane16_swap(__float_as_uint(s), __float_as_uint(s), false, false);
    const float s2 = __uint_as_float(a[0]) + __uint_as_float(a[1]);
    const auto b = __builtin_amdgcn_permlane32_swap(__float_as_uint(s2), __float_as_uint(s2), false, false);
    return __uint_as_float(b[0]) + __uint_as_float(b[1]);
}
namespace pg8 {
#define PG8_LAS __attribute__((address_space(3)))
typedef unsigned short bf16_t;
typedef short bf16x8 __attribute__((ext_vector_type(8)));
typedef float f32x4 __attribute__((ext_vector_type(4)));
typedef unsigned u32x4 __attribute__((ext_vector_type(4)));
constexpr int BM = 256, BK = 64, HALF = 128, HTB = HALF * BK * 2  , STAGE_BYTES = 8 * HTB, NXCD = 8, WGM = 8;

__host__ __device__ __forceinline__ int lds_byte(int r, int c) { const int st = (r >> 4) * 2 + (c >> 5), rr = r & 15, cc = c & 31, ob = rr * 64 + cc * 2; return st * 1024 + (ob ^ (((ob >> 9) & 1) << 5)); }
__host__ __device__ __forceinline__ void stage_rc(int b, int& R, int& C) { const int st = b / 1024, sb = b % 1024, swz = sb ^ (((sb >> 9) & 1) << 5); R = (st >> 1) * 16 + swz / 64; C = (st & 1) * 32 + (swz % 64) / 2; }
__host__ __device__ __forceinline__ int perm32(int rho) { const int n = rho >> 4, i = rho & 15; return 8 * (i >> 2) + 4 * n + (i & 3); }

struct Unit { int pm, pn; };
struct Gemm { const bf16_t* A; int lda; const bf16_t* Bt; int M, N, K; };

struct StaticOrder {
    int nM, nN, nwg, G, c;
    __host__ __device__ void init(int M, int N, int G_, int c_) { nM = M / BM; nN = N / BM; nwg = nM * nN; G = G_; c = c_; }
    __host__ __device__ bool next(int i, Unit& u) const {
        const long L = (long)i * G + c; if (L >= nwg) return false;
        int wgid = (int)L; { const int q = nwg / NXCD, r = nwg % NXCD, xcd = wgid % NXCD, off = wgid / NXCD; wgid = (xcd < r ? xcd * (q + 1) : r * (q + 1) + (xcd - r) * q) + off; }
        const int nig = WGM * nN, gid = wgid / nig, fm = gid * WGM, gsz = (nM - fm) < WGM ? (nM - fm) : WGM;
        u.pm = fm + ((wgid % nig) % gsz); u.pn = (wgid % nig) / gsz; return true;
    }
    __device__ __forceinline__ void a_ready(const Unit&) const {}
    __device__ __forceinline__ void done(const Unit&) const {}
};
template <class Epi, class Sched, bool ALIGN_EPI = false, bool SP2 = false>
__device__ __forceinline__ void gemm_phase(PG8_LAS unsigned char* lds, const Gemm g, const Sched& S, const Epi& E) {
    const int tid = tid_opaque(), wid = __builtin_amdgcn_readfirstlane(tid >> 6), lane = tid & 63, wr = wid >> 2, wc = wid & 3, fr = lane & 15, fq = lane >> 4;
    const int K = g.K, nt = K / BK;
    unsigned voffA[2], voffB[2];
#pragma unroll
    for (int i = 0; i < 2; ++i) { int R, C; stage_rc(tid * 16 + i * 8192, R, C); const int Rb = Epi::PERM ? ((R & ~31) + perm32(R & 31)) : R;
        voffA[i] = (unsigned)(R * g.lda + C) * 2u; voffB[i] = (unsigned)(Rb * K + C) * 2u; }
    const size_t kstep = (size_t)(BK * 2);
    const size_t hstepA = (size_t)HALF * g.lda * 2, hstepB = (size_t)HALF * K * 2;
    const size_t tstepA = 2 * hstepA, tstepB = 2 * hstepB;
    const unsigned ldsw = (unsigned)wid * 1024u;
    const int aoff = lds_byte(wr * 64 + fr, fq * 8), boff = lds_byte(wc * 32 + fr, fq * 8);
#define PG8_SA(b, h) (((b) * 2 + (h)) * HTB)
#define PG8_SB(b, h) ((4 + (b) * 2 + (h)) * HTB)
#define PG8_STAGE(bufoff, gbase, voff) do { _Pragma("unroll") for (int _i = 0; _i < 2; ++_i) \
        __builtin_amdgcn_global_load_lds((const unsigned*)((const char*)(gbase) + (voff)[_i]), (PG8_LAS unsigned*)(lds + (bufoff) + ldsw + _i * 8192), 16, 0, 0); } while (0)
#define PG8_LDA(dst, b, h) do { _Pragma("unroll") for (int m = 0; m < 4; ++m) _Pragma("unroll") for (int k = 0; k < 2; ++k) dst[m][k] = *(const PG8_LAS bf16x8*)(lds + PG8_SA(b, h) + aoff + m * 2048 + k * 1024); } while (0)
#define PG8_LDB(dst, b, h) do { _Pragma("unroll") for (int n = 0; n < 2; ++n) _Pragma("unroll") for (int k = 0; k < 2; ++k) dst[n][k] = *(const PG8_LAS bf16x8*)(lds + PG8_SB(b, h) + boff + n * 2048 + k * 1024); } while (0)
#define PG8_MMA(ai, bj, At, Bt) do { __builtin_amdgcn_s_setprio(1); _Pragma("unroll") for (int m = 0; m < 4; ++m) _Pragma("unroll") for (int n = 0; n < 2; ++n) _Pragma("unroll") for (int k = 0; k < 2; ++k) \
        acc[ai][bj][m][n] = __builtin_amdgcn_mfma_f32_16x16x32_bf16(Bt[n][k], At[m][k], acc[ai][bj][m][n], 0, 0, 0); __builtin_amdgcn_s_setprio(0); } while (0)
#define PG8_WAIT_V(n) asm volatile("s_waitcnt vmcnt(" #n ")" ::: "memory")
#define PG8_WAIT_L(n) asm volatile("s_waitcnt lgkmcnt(" #n ")" ::: "memory")
#define PG8_BAR __builtin_amdgcn_s_barrier()
#define PG8_SCHED __builtin_amdgcn_sched_barrier(0)
    Unit cur, nxt; int ui = 0;
    if (!S.next(0, cur)) return;
    f32x4 acc[2][2][4][2];
#pragma unroll
    for (int a = 0; a < 2; ++a)
#pragma unroll
        for (int b = 0; b < 2; ++b)
#pragma unroll
            for (int m = 0; m < 4; ++m)
#pragma unroll
                for (int n = 0; n < 2; ++n) acc[a][b][m][n] = (f32x4){0.f, 0.f, 0.f, 0.f};
    bf16x8 At[4][2], B0[2][2], B1[2][2];
    const char* cA = (const char*)g.A + (size_t)cur.pm * tstepA; const char* cB = (const char*)g.Bt + (size_t)cur.pn * tstepB;
    S.a_ready(cur);
    if constexpr (SP2) {
        PG8_STAGE(PG8_SB(0, 0), cB, voffB); PG8_STAGE(PG8_SB(0, 1), cB + hstepB, voffB); PG8_STAGE(PG8_SA(0, 0), cA, voffA); PG8_STAGE(PG8_SA(0, 1), cA + hstepA, voffA);
        if (wr == 1) PG8_BAR;
        PG8_WAIT_V(2); PG8_BAR;
        PG8_STAGE(PG8_SB(1, 0), cB + kstep, voffB); PG8_STAGE(PG8_SA(1, 0), cA + kstep, voffA); PG8_STAGE(PG8_SB(1, 1), cB + hstepB + kstep, voffB);
        PG8_WAIT_V(6); PG8_BAR;
    } else {
        PG8_STAGE(PG8_SB(0, 0), cB, voffB); PG8_STAGE(PG8_SA(0, 0), cA, voffA); PG8_STAGE(PG8_SB(0, 1), cB + hstepB, voffB); PG8_STAGE(PG8_SA(0, 1), cA + hstepA, voffA);
        if (wr == 1) PG8_BAR;
        PG8_WAIT_V(4); PG8_BAR;
        PG8_STAGE(PG8_SB(1, 0), cB + kstep, voffB); PG8_STAGE(PG8_SA(1, 0), cA + kstep, voffA); PG8_STAGE(PG8_SB(1, 1), cB + hstepB + kstep, voffB);
        PG8_WAIT_V(6); PG8_BAR;
    }
    for (;;) {
        const bool has_next = S.next(ui + 1, nxt);
        const char* nA = has_next ? (const char*)g.A + (size_t)nxt.pm * tstepA : cA; const char* nB = has_next ? (const char*)g.Bt + (size_t)nxt.pn * tstepB : cB;
        for (int t = 0; t < nt; t += 2) {
            const bool last = (t == nt - 2);
            const char* a1 = cA + (size_t)(t + 1) * kstep;
            const char* a2 = last ? nA : cA + (size_t)(t + 2) * kstep; const char* b2 = last ? nB : cB + (size_t)(t + 2) * kstep;
            const char* a3 = a2 + kstep; const char* b3 = b2 + kstep;
            if (last && has_next) S.a_ready(nxt);
            if constexpr (SP2) {
            PG8_LDB(B0, 0, 0); PG8_LDB(B1, 0, 1); PG8_SCHED; PG8_LDA(At, 0, 0); PG8_STAGE(PG8_SA(1, 1), a1 + hstepA, voffA);
            PG8_WAIT_V(8); PG8_WAIT_L(0); PG8_BAR; PG8_MMA(0, 0, At, B0); PG8_MMA(0, 1, At, B1); PG8_BAR; PG8_SCHED;
            PG8_LDA(At, 0, 1); PG8_STAGE(PG8_SB(0, 0), b2, voffB); PG8_STAGE(PG8_SB(0, 1), b2 + hstepB, voffB); PG8_STAGE(PG8_SA(0, 0), a2, voffA);
            PG8_WAIT_V(8); PG8_WAIT_L(0); PG8_BAR; PG8_MMA(1, 0, At, B0); PG8_MMA(1, 1, At, B1); PG8_BAR; PG8_SCHED;
            PG8_LDB(B0, 1, 0); PG8_LDB(B1, 1, 1); PG8_SCHED; PG8_LDA(At, 1, 0); PG8_STAGE(PG8_SA(0, 1), a2 + hstepA, voffA);
            PG8_WAIT_V(8); PG8_WAIT_L(0); PG8_BAR; PG8_MMA(0, 0, At, B0); PG8_MMA(0, 1, At, B1); PG8_BAR; PG8_SCHED;
            PG8_LDA(At, 1, 1); PG8_STAGE(PG8_SB(1, 0), b3, voffB); PG8_STAGE(PG8_SB(1, 1), b3 + hstepB, voffB); PG8_STAGE(PG8_SA(1, 0), a3, voffA);
            PG8_WAIT_V(8); PG8_WAIT_L(0); PG8_BAR; PG8_MMA(1, 0, At, B0); PG8_MMA(1, 1, At, B1); PG8_BAR; PG8_SCHED;
            } else {
            PG8_LDB(B0, 0, 0); PG8_SCHED; PG8_LDA(At, 0, 0); PG8_STAGE(PG8_SA(1, 1), a1 + hstepA, voffA);
            PG8_WAIT_L(8); PG8_BAR; PG8_WAIT_L(0); PG8_MMA(0, 0, At, B0); PG8_BAR; PG8_SCHED;
            PG8_LDB(B1, 0, 1); PG8_STAGE(PG8_SB(0, 0), b2, voffB);
            PG8_BAR; PG8_WAIT_L(0); PG8_MMA(0, 1, At, B1); PG8_BAR;
            PG8_LDA(At, 0, 1); PG8_STAGE(PG8_SA(0, 0), a2, voffA);
            PG8_BAR; PG8_WAIT_L(0); PG8_MMA(1, 0, At, B0); PG8_BAR; PG8_SCHED;
            PG8_STAGE(PG8_SB(0, 1), b2 + hstepB, voffB);
            PG8_WAIT_V(6); PG8_BAR; PG8_MMA(1, 1, At, B1); PG8_BAR;
            PG8_LDB(B0, 1, 0); PG8_SCHED; PG8_LDA(At, 1, 0); PG8_STAGE(PG8_SA(0, 1), a2 + hstepA, voffA);
            PG8_WAIT_L(8); PG8_BAR; PG8_WAIT_L(0); PG8_MMA(0, 0, At, B0); PG8_BAR; PG8_SCHED;
            PG8_LDB(B1, 1, 1); PG8_STAGE(PG8_SB(1, 0), b3, voffB);
            PG8_BAR; PG8_WAIT_L(0); PG8_MMA(0, 1, At, B1); PG8_BAR;
            PG8_LDA(At, 1, 1); PG8_STAGE(PG8_SA(1, 0), a3, voffA);
            PG8_BAR; PG8_WAIT_L(0); PG8_MMA(1, 0, At, B0); PG8_BAR; PG8_SCHED;
            PG8_STAGE(PG8_SB(1, 1), b3 + hstepB, voffB);
            PG8_WAIT_V(6); PG8_BAR; PG8_MMA(1, 1, At, B1); PG8_BAR;
            }
        }
        if constexpr (ALIGN_EPI) { if (wr == 0) PG8_BAR; }
        if constexpr (!Epi::AFTER_DRAIN) { E(acc, cur, wr, wc, fr, fq); S.done(cur); }
        if (!has_next) break;
#pragma unroll
        for (int a = 0; a < 2; ++a)
#pragma unroll
            for (int b = 0; b < 2; ++b)
#pragma unroll
                for (int m = 0; m < 4; ++m)
#pragma unroll
                    for (int n = 0; n < 2; ++n) acc[a][b][m][n] = (f32x4){0.f, 0.f, 0.f, 0.f};
        cur = nxt; cA = nA; cB = nB; ++ui;
        if constexpr (ALIGN_EPI) { if (wr == 1) PG8_BAR; }
    }
    PG8_WAIT_V(0);
    if constexpr (!ALIGN_EPI) { if (wr == 0) PG8_BAR; }
    PG8_BAR;
    if constexpr (Epi::AFTER_DRAIN) { E.fused(acc, cur, wr, wc, fr, fq, lds, wid, lane); S.done(cur); }
#undef PG8_SA
#undef PG8_SB
#undef PG8_STAGE
#undef PG8_LDA
#undef PG8_LDB
#undef PG8_MMA
#undef PG8_WAIT_V
#undef PG8_WAIT_L
#undef PG8_BAR
#undef PG8_SCHED
}
}

namespace pg8 {
struct EpiScale {
    static constexpr bool PERM = true, AFTER_DRAIN = false;
    bf16_t* O; int ldo; const float* ssq; float inv_n; int act;
    __device__ __forceinline__ void operator()(const f32x4 (&acc)[2][2][4][2], const Unit& u, int wr, int wc, int fr, int fq) const {
        asm volatile("" : "+v"(fr), "+v"(fq));
        const int row0 = u.pm * BM + wr * 64 + fr, col0 = u.pn * BM + wc * 32 + 8 * fq;
        float rsv[8];
#pragma unroll
        for (int i = 0; i < 8; ++i) rsv[i] = ssq ? ssq[row0 + (i >> 2) * HALF + (i & 3) * 16] : 0.f;
#pragma unroll
        for (int i = 0; i < 8; ++i) rsv[i] = ssq ? rsqrtf(rsv[i] * inv_n + 1e-6f) : 1.f;
#pragma unroll
        for (int ai = 0; ai < 2; ++ai)
#pragma unroll
            for (int m = 0; m < 4; ++m) {
                const int row = row0 + ai * HALF + m * 16;
                const float rs = rsv[ai * 4 + m];
                bf16_t* rowp = O + (size_t)row * ldo + col0;
#pragma unroll
                for (int bj = 0; bj < 2; ++bj) {
                    f32x4 v0 = acc[ai][bj][m][0] * rs, v1 = acc[ai][bj][m][1] * rs;
                    if (act == 1) {
#pragma unroll
                        for (int j = 0; j < 4; ++j) { const float a = fmaxf(v0[j], 0.f), b = fmaxf(v1[j], 0.f); v0[j] = a * a; v1[j] = b * b; }
                    }
                    u32x4 w; w.x = ::cvtpk(v0[0], v0[1]); w.y = ::cvtpk(v0[2], v0[3]); w.z = ::cvtpk(v1[0], v1[1]); w.w = ::cvtpk(v1[2], v1[3]);
                    *(u32x4*)(rowp + bj * HALF) = w;
                }
            }
    }
};
struct EpiHead {
    static constexpr bool PERM = true, AFTER_DRAIN = false;
    int kind; bf16_t* O; int ldo; const float* ssq; float inv_n; const float* cs;
    const float *g0, *g1, *g2, *g3; float* ssq_ckv; float* WI; bf16_t* KI; PG8_LAS float* X;
    __device__ __forceinline__ void operator()(f32x4 (&acc)[2][2][4][2], const Unit& u, int wr, int wc, int fr, int fq) const {
        asm volatile("" : "+v"(fr), "+v"(fq));
        asm volatile("" : "+s"(wr), "+s"(wc));
        const int wave = wr * 4 + wc, pn = u.pn;
        int gt = 0; bool rope = false; float scale = 1.f; const float* g = nullptr;
        if (kind == 0) {
            if (pn < 2) { gt = 1; rope = true; scale = 0.125f * 1.4426950408889634f; g = g0; }
            else if (pn < 4) { gt = 1; rope = true; g = g1; }
            else if (pn < 6) { gt = 0; }
            else if (pn < 8) { gt = 1; rope = true; scale = 0.125f * 1.4426950408889634f; g = g2; }
            else if (pn == 8) { gt = 3; }
            else if (pn == 9) { gt = 4; rope = true; }
            else { gt = 1; rope = true; g = g3; }
        } else if (kind == 1) { if (pn < 2) { gt = 1; rope = true; g = g0; } }
        else { if ((pn & 3) < 2) { gt = 2; g = g0 + (pn >> 2) * 128; } }
        const int row0 = u.pm * BM + wr * 64 + fr, col0 = pn * BM + wc * 32 + 8 * fq;
        PG8_LAS float* CSL = X + 2048;
        if (rope) {
            const int tid_ = (wave * 4 + fq) * 16 + fr; f32x4 t_[2];
#pragma unroll
            for (int i = 0; i < 2; ++i) { const int idx = tid_ + 512 * i; t_[i] = *(const f32x4*)(cs + (size_t)(u.pm * BM + (idx >> 2)) * 16 + 4 * (idx & 3)); }
#pragma unroll
            for (int i = 0; i < 2; ++i) { const int idx = tid_ + 512 * i; *(PG8_LAS f32x4*)(CSL + (idx >> 2) * 20 + 4 * (idx & 3)) = t_[i]; }
        }
        float rsv[8];
#pragma unroll
        for (int i = 0; i < 8; ++i) rsv[i] = ssq[row0 + (i >> 2) * HALF + (i & 3) * 16];
#pragma unroll
        for (int i = 0; i < 8; ++i) rsv[i] = rsqrtf(rsv[i] * inv_n + 1e-6f);
        float gv[8];
        { const int db = (gt == 2) ? (32 * wc + 8 * fq) : (32 * (wc & 1) + 8 * fq);
#pragma unroll
          for (int j = 0; j < 8; ++j) gv[j] = g ? g[db + j] : 1.f; }
#pragma unroll
        for (int ai = 0; ai < 2; ++ai)
#pragma unroll
            for (int m = 0; m < 4; ++m) {
                const float rs = rsv[ai * 4 + m];
#pragma unroll
                for (int bj = 0; bj < 2; ++bj) {
                    acc[ai][bj][m][0] *= rs; acc[ai][bj][m][1] *= rs;
                    const f32x4 a = acc[ai][bj][m][0], b = acc[ai][bj][m][1];
                    float s = (a[0] * a[0] + a[1] * a[1]) + (a[2] * a[2] + a[3] * a[3]) + (b[0] * b[0] + b[1] * b[1]) + (b[2] * b[2] + b[3] * b[3]);
                    s = ::sum_rows4(s);
                    if (fq == 0) X[(((wave * 2 + ai) * 4 + m) * 2 + bj) * 16 + fr] = s;
                }
            }
        asm volatile("s_waitcnt lgkmcnt(0)\n\ts_barrier" ::: "memory");
#pragma unroll
        for (int ai = 0; ai < 2; ++ai)
#pragma unroll
            for (int m = 0; m < 4; ++m) {
                const int row = row0 + ai * HALF + m * 16;
                float cs16[16];
                if (rope) { const PG8_LAS float* c = CSL + (ai * HALF + wr * 64 + m * 16 + fr) * 20;
#pragma unroll
                    for (int q = 0; q < 4; ++q) { const f32x4 t = *(const PG8_LAS f32x4*)(c + 4 * q); cs16[4 * q] = t[0]; cs16[4 * q + 1] = t[1]; cs16[4 * q + 2] = t[2]; cs16[4 * q + 3] = t[3]; }
#pragma unroll
                    for (int j = 0; j < 8; ++j) { const float cj = cs16[j], sj = cs16[8 + j];
                        cs16[j] = (fq == 0) ? cj : (fq == 1) ? sj : (fq == 2) ? 1.f : 0.f; cs16[8 + j] = (fq == 0) ? -sj : (fq == 1) ? cj : (fq == 2) ? 0.f : 1.f; } }
                float rowtot = 0.f;
#pragma unroll
                for (int bj = 0; bj < 2; ++bj) {
                    float v[8];
#pragma unroll
                    for (int j = 0; j < 4; ++j) { v[j] = acc[ai][bj][m][0][j]; v[4 + j] = acc[ai][bj][m][1][j]; }
#define XAT(w_) X[((((w_) * 2 + ai) * 4 + m) * 2 + bj) * 16 + fr]
                    if (gt == 1) {
                        const float tot = XAT(wave) + XAT(wave ^ 1), r2 = rsqrtf(tot * (1.f / 64.f) + 1e-6f);
#pragma unroll
                        for (int j = 0; j < 8; ++j) v[j] = v[j] * r2 * gv[j];
                    } else if (gt == 2) {
                        const int w0 = wave & 4; const float tot = (XAT(w0) + XAT(w0 + 1)) + (XAT(w0 + 2) + XAT(w0 + 3)), r2 = rsqrtf(tot * (1.f / 128.f) + 1e-6f);
#pragma unroll
                        for (int j = 0; j < 8; ++j) v[j] = v[j] * r2 * gv[j];
                    } else if (gt == 3) {
                        const int w0 = wave & 4; rowtot += (XAT(w0) + XAT(w0 + 1)) + (XAT(w0 + 2) + XAT(w0 + 3));
                    }
#undef XAT
                    if (rope && (wc & 1) == 0) {
#pragma unroll
                        for (int j = 0; j < 8; ++j) { const auto r = __builtin_amdgcn_permlane16_swap(__float_as_uint(v[j]), __float_as_uint(v[j]), false, false);
                            v[j] = __uint_as_float(r[0]) * cs16[j] + __uint_as_float(r[1]) * cs16[8 + j]; }
                    }
                    u32x4 w; w.x = ::cvtpk(v[0] * scale, v[1] * scale); w.y = ::cvtpk(v[2] * scale, v[3] * scale); w.z = ::cvtpk(v[4] * scale, v[5] * scale); w.w = ::cvtpk(v[6] * scale, v[7] * scale);
                    if (kind == 0 && pn == 10) {
                        if (bj == 0 && wc < 2) { const int c = 4 * wc + fq;
                            *(u32x4*)(KI + (size_t)(row >> 5) * 2048 + (c >> 1) * 512 + (((c & 1) * 32 + (row & 31)) * 8)) = w; }
                        if (bj == 0 && wc == 2 && fq == 0) *(f32x4*)(WI + (size_t)row * 4) = acc[ai][0][m][0] * (1.f / 16.f);
                    } else {
                        *(u32x4*)(O + (size_t)row * ldo + col0 + bj * HALF) = w;
                    }
                }
                if (gt == 3 && wc == 0 && fq == 0) ssq_ckv[row] = rowtot;
            }
    }
};
template <bool F32BASE> struct EpiResidT {
    static constexpr bool PERM = true, AFTER_DRAIN = false;
    const float* basef; float* outf; bf16_t* xb; float* ssq_next; int dry;
    __device__ __forceinline__ void operator()(const f32x4 (&acc)[2][2][4][2], const Unit& u, int wr, int wc, int fr, int fq) const {
        asm volatile("" : "+v"(fr), "+v"(fq));
        const int col0 = u.pn * BM + wc * 32 + 8 * fq;
        constexpr int MB = F32BASE ? 2 : 4;
#pragma unroll
        for (int ai = 0; ai < 2; ++ai)
#pragma unroll
        for (int m0 = 0; m0 < 4; m0 += MB) {
            u32x4 bb[MB][2]; f32x4 bf[MB][2][2];
#pragma unroll
            for (int mm = 0; mm < MB; ++mm)
#pragma unroll
                for (int bj = 0; bj < 2; ++bj) { const size_t idx = (size_t)(u.pm * BM + ai * HALF + wr * 64 + (m0 + mm) * 16 + fr) * 1024 + col0 + bj * HALF;
                    if (F32BASE) { bf[mm][bj][0] = *(const f32x4*)(basef + idx); bf[mm][bj][1] = *(const f32x4*)(basef + idx + 4); } else bb[mm][bj] = *(const u32x4*)(xb + idx); }
#pragma unroll
            for (int mm = 0; mm < MB; ++mm) { const int m = m0 + mm;
                const int row = u.pm * BM + ai * HALF + wr * 64 + m * 16 + fr; const size_t off = (size_t)row * 1024 + col0; float s = 0.f;
#pragma unroll
                for (int bj = 0; bj < 2; ++bj) {
                    const size_t idx = off + bj * HALF;
                    f32x4 x0, x1;
                    if (F32BASE) { x0 = bf[mm][bj][0]; x1 = bf[mm][bj][1]; }
                    else { const u32x4 b = bb[mm][bj]; x0 = (f32x4){::lo16(b.x), ::hi16(b.x), ::lo16(b.y), ::hi16(b.y)}; x1 = (f32x4){::lo16(b.z), ::hi16(b.z), ::lo16(b.w), ::hi16(b.w)}; }
                    x0 += acc[ai][bj][m][0]; x1 += acc[ai][bj][m][1];
                    s += (x0[0] * x0[0] + x0[1] * x0[1]) + (x0[2] * x0[2] + x0[3] * x0[3]) + (x1[0] * x1[0] + x1[1] * x1[1]) + (x1[2] * x1[2] + x1[3] * x1[3]);
                    if (outf && !dry) { *(f32x4*)(outf + idx) = x0; *(f32x4*)(outf + idx + 4) = x1; }
                    if (xb && !outf && !dry) { u32x4 w; w.x = ::cvtpk(x0[0], x0[1]); w.y = ::cvtpk(x0[2], x0[3]); w.z = ::cvtpk(x1[0], x1[1]); w.w = ::cvtpk(x1[2], x1[3]); *(u32x4*)(xb + idx) = w; }
                    if (dry) asm volatile("" :: "v"(x0), "v"(x1));
                }
                if (ssq_next && !dry) { s = ::sum_rows4(s); if (fq == 0) atomicAdd(ssq_next + row, s); }
            }
            asm volatile("" ::: "memory");
        }
    }
};
typedef EpiResidT<false> EpiResid; typedef EpiResidT<true> EpiResidF;
}

#define XB_TMO      128
#define XB_XCNT(j)  (256  + 64 * (j))
#define XB_XSUB(j)  (1280 + 64 * (j))
#define XB_XGEN(j)  (2304 + 64 * (j))
#define XB_TOP      3328
#define XB_TOPGEN   3392
#define XCD_BAR_WORDS 3456
#define XB_SPIN_CAP (1u << 18)

__device__ __forceinline__ unsigned xb_ld(unsigned* p)              { return __hip_atomic_load(p, __ATOMIC_RELAXED, __HIP_MEMORY_SCOPE_AGENT); }
__device__ __forceinline__ unsigned xb_add(unsigned* p, unsigned v) { return __hip_atomic_fetch_add(p, v, __ATOMIC_RELAXED, __HIP_MEMORY_SCOPE_AGENT); }
__device__ __forceinline__ unsigned xb_xcc_id() { return (unsigned)__builtin_amdgcn_s_getreg((3 << 11) | 20) & 0xFu; }
#define XB_SPIN(cond, bar) do { unsigned _sp = 0; while (cond) { __builtin_amdgcn_s_sleep(1); \
    if ((++_sp & 255u) == 0u) { if (xb_ld(&(bar)[XB_TMO])) break; if (_sp > XB_SPIN_CAP) { atomicAdd(&(bar)[XB_TMO], 1u); break; } } } } while (0)

struct XcdBarrier {
    unsigned* bar; unsigned x;
    volatile LAS unsigned* st;
};

__device__ __forceinline__ XcdBarrier xcd_barrier_post(unsigned* bar, volatile LAS unsigned* st) {
    XcdBarrier b; b.bar = bar; b.x = xb_xcc_id(); b.st = st;
    if (threadIdx.x == 0) (void)xb_add(&bar[XB_XCNT(b.x)], 1u);
    return b;
}
__device__ __forceinline__ void xcd_barrier_complete(unsigned* bar, unsigned x, unsigned& nloc, unsigned& nx) {
    const unsigned G = gridDim.x * gridDim.y * gridDim.z;
    unsigned sum, cnt, mine, sp = 0u;
    for (;;) {
        sum = 0u; cnt = 0u; mine = 0u;
#pragma unroll
        for (unsigned j = 0; j < 16; ++j) { const unsigned c = xb_ld(&bar[XB_XCNT(j)]); sum += c; cnt += (c > 0u) ? 1u : 0u; mine = (j == x) ? c : mine; }
        if (sum == G) break;
        __builtin_amdgcn_s_sleep(1);
        if ((++sp & 255u) == 0u) { if (xb_ld(&bar[XB_TMO])) break; if (sp > XB_SPIN_CAP) { atomicAdd(&bar[XB_TMO], 1u); break; } }
    }
    nloc = mine > 0u ? mine : 1u; nx = cnt > 0u ? cnt : 1u;
}

__device__ __forceinline__ void xcd_barrier(const XcdBarrier& b) {
    asm volatile("s_waitcnt vmcnt(0)" ::: "memory");
    __syncthreads();
    if (threadIdx.x == 0) {
        unsigned* bar = b.bar;
        __builtin_amdgcn_s_waitcnt(0);
        unsigned nloc = b.st[0], nx = b.st[1];
        if (nloc == 0u) { xcd_barrier_complete(bar, b.x, nloc, nx); b.st[0] = nloc; b.st[1] = nx; }
        const unsigned old = xb_add(&bar[XB_XSUB(b.x)], 1u);
        const unsigned gen = old / nloc;
        if (old + 1u == (gen + 1u) * nloc) {
            __builtin_amdgcn_fence(__ATOMIC_RELEASE, "agent");
            asm volatile("s_waitcnt vmcnt(0)" ::: "memory");
            const unsigned og = xb_add(&bar[XB_TOP], 1u);
            const unsigned tg = og / nx;
            if (og + 1u == (tg + 1u) * nx) xb_add(&bar[XB_TOPGEN], 1u);
            else XB_SPIN(xb_ld(&bar[XB_TOPGEN]) == tg, bar);
            __builtin_amdgcn_fence(__ATOMIC_ACQUIRE, "agent");
            xb_add(&bar[XB_XGEN(b.x)], 1u);
            asm volatile("s_waitcnt vmcnt(0)" ::: "memory");
        } else {
            XB_SPIN(xb_ld(&bar[XB_XGEN(b.x)]) == gen, bar);
            __builtin_amdgcn_fence(__ATOMIC_ACQUIRE, "agent");
            asm volatile("s_waitcnt vmcnt(0)" ::: "memory");
        }
    }
    __syncthreads();
}
constexpr int NPHASE = 22;
constexpr int MISC_OFF = LDS_BYTES - 256;
#ifndef MK_REP_N
#define MK_REP_N 0
#define MK_REP_LO 0
#define MK_REP_HI -1
#endif
#ifndef MK_XPH
#define MK_XPH -1
#define MK_XN 0
#endif
#ifndef MK_SUB
#define MK_SUB 0
#endif
#ifndef MK_IDX2
#define MK_IDX2 0
#endif
#ifndef MK_CGSYNC
#define MK_CGSYNC 0
#endif
template <class Epi, bool ALIGN>
DEVI void run_gemm(LAS unsigned char* lds, const bf16_t* A, int lda, const bf16_t* Bt, int M, int N, int K, const Epi& E, int cu_off = 0) {
    const int Gd = (int)gridDim.x; int cu = (int)blockIdx.x - cu_off; if (cu < 0) cu += Gd;
    pg8::Gemm g{A, lda, Bt, M, N, K}; pg8::StaticOrder So; So.init(M, N, Gd, cu);
    pg8::gemm_phase<Epi, pg8::StaticOrder, ALIGN, true>(lds, g, So, E);
}
template <bool DRYK>
__global__ void __launch_bounds__(NTHR, 2) mega(Params P, int ph_lo, int ph_hi) {
    extern __shared__ __attribute__((aligned(16))) unsigned char lds_raw[];
    LAS unsigned char* lds = (LAS unsigned char*)lds_raw;
    cg::grid_group grid = cg::this_grid();
    { volatile LAS unsigned* MISC0 = (volatile LAS unsigned*)(lds + MISC_OFF);
      if (threadIdx.x < 32) MISC0[threadIdx.x] = 0u;
      __syncthreads();
      if (ph_hi - ph_lo > 1) (void)xcd_barrier_post((unsigned*)(P.ws + WS_BAR), MISC0 + 8); }
    if (ph_lo < 0) grid.sync();
#define PH_LOCALS unsigned char* ws = P.ws; asm volatile("" : "+s"(ws)); float* ssq = (float*)(ws + WS_SSQ); bf16_t* XB = (bf16_t*)(ws + WS_XB); bf16_t* Y = (bf16_t*)(ws + WS_Y); const int G = gridDim.x, bx = blockIdx.x; (void)ssq; (void)XB; (void)Y; (void)G; (void)bx;
#define SEAM_XCD() do { XcdBarrier b_; b_.bar = (unsigned*)(P.ws + WS_BAR); b_.x = xb_xcc_id(); b_.st = (volatile LAS unsigned*)(lds + MISC_OFF) + 8; xcd_barrier(b_); } while (0)
#define PH_REPS(k) (((k) >= MK_REP_LO && (k) <= MK_REP_HI && (k) != 2 && (k) != 4) ? 1 + MK_REP_N : 1)
#define PH_BEGIN(k) if (ph_lo <= (k) && (k) < ph_hi) { PH_LOCALS for (int rep = 0; rep < PH_REPS(k); ++rep) { const int dry = (rep > 0) || DRYK; (void)dry; if (rep > 0) SEAM_XCD();
#define PH_END(k) } if ((k) + 1 < ph_hi) { if (MK_CGSYNC) grid.sync(); else SEAM_XCD(); } }
#define DRYOUT (dry ? (float*)(ws + WS_Y) : P.out)
    using pg8::EpiScale; using pg8::EpiResid; using pg8::EpiResidF; using pg8::EpiHead;
    PH_BEGIN(0) phase_prologue(P, lds, dry); PH_END(0)
    PH_BEGIN(1)
#if MK_FUSE & 1
        run_gemm<EpiHead, true>(lds, (const bf16_t*)(ws + WS_XB), 1024, (const bf16_t*)(ws + W_INE), T, LDP, 1024,
            EpiHead{0, (bf16_t*)(ws + WS_PROJ), LDP, ssq, 1.f / 1024.f, (const float*)(ws + WS_CS), P.in[15], P.in[16], P.in[24], P.in[26],
                    (float*)(ws + WS_SSQCKV), (float*)(ws + WS_WI), (bf16_t*)(ws + WS_KI), (LAS float*)(lds + 132096)});
#else
        run_gemm<EpiScale, true>(lds, (const bf16_t*)(ws + WS_XB), 1024, (const bf16_t*)(ws + W_INE), T, LDP, 1024, EpiScale{(bf16_t*)(ws + WS_PROJ), LDP, ssq, 1.f / 1024.f, 0});
#endif
#if MK_FUSE & 2
        run_gemm<EpiHead, true>(lds, (const bf16_t*)(ws + WS_MB), 1024, (const bf16_t*)(ws + W_KVX), MEMT, 2048, 1024,
            EpiHead{2, (bf16_t*)(ws + WS_KVX), 2048, (const float*)(ws + WS_SSQMEM), 1.f / 1024.f, nullptr, P.in[10], nullptr, nullptr, nullptr, nullptr, nullptr, nullptr, (LAS float*)(lds + 132096)},
            ((T / 256) * (LDP / 256)) % G);
#else
        run_gemm<EpiScale, false>(lds, (const bf16_t*)(ws + WS_MB), 1024, (const bf16_t*)(ws + W_KVX), MEMT, 2048, 1024, EpiScale{(bf16_t*)(ws + WS_KVX), 2048, (const float*)(ws + WS_SSQMEM), 1.f / 1024.f, 0}, ((T / 256) * (LDP / 256)) % G);
#endif
    PH_END(1)
#if (MK_FUSE & 3) != 3
    PH_BEGIN(2) phase_post0(P, ((MK_FUSE & 1) ? 0 : 1) | ((MK_FUSE & 2) ? 0 : 2)); PH_END(2)
#endif
    PH_BEGIN(3)
#if MK_FUSE & 4
        run_gemm<EpiHead, true>(lds, (const bf16_t*)(ws + WS_PROJ) + C_CKV, LDP, (const bf16_t*)(ws + W_KVUP), T, 1024, 256,
            EpiHead{1, (bf16_t*)(ws + WS_KBVB), 1024, (const float*)(ws + WS_SSQCKV), 1.f / 256.f, (const float*)(ws + WS_CS), P.in[25], nullptr, nullptr, nullptr, nullptr, nullptr, nullptr, (LAS float*)(lds + 132096)});
#else
        run_gemm<EpiScale, false>(lds, (const bf16_t*)(ws + WS_PROJ) + C_CKV, LDP, (const bf16_t*)(ws + W_KVUP), T, 1024, 256, EpiScale{(bf16_t*)(ws + WS_KBVB), 1024, (const float*)(ws + WS_SSQCKV), 1.f / 256.f, 0});
#endif
    PH_END(3)
#if !(MK_FUSE & 4)
    PH_BEGIN(4) phase_postkb(P); PH_END(4)
#endif
    PH_BEGIN(5)
        if (!(dry && MK_SUB == 2))
        for (int u = bx; u < 256; u += G) { const int bhc = u >> 3, s = u & 7, b = bhc >> 3, h = (bhc >> 1) & 3, c = bhc & 1;
            attnA_unit(P, b, h, c, s, lds); attnA_unit(P, b, h, c, 15 - s, lds); }
        if (!(dry && MK_SUB == 1))
        for (int u = bx; u < 2048; u += G) { const int k = u / 256, c = u % 256, b = k >> 1; const int blk = (k & 1) ? (511 - c) : c;
            indexer_unit(P, b, blk * 8, lds); }
#if MK_IDX2
        for (int u = bx; u < 2048; u += G) { const int k = u / 256, c = u % 256, b = k >> 1; const int blk = (k & 1) ? (511 - c) : c;
            indexer_unit(P, b, blk * 8, lds); }
#endif
    PH_END(5)
    PH_BEGIN(6)
        if (!(dry && MK_SUB == 2))
        for (int u = bx; u < 256; u += G) { const int bh = u >> 3, s = u & 7, b = bh >> 3, hd = bh & 7;
            attnB_unit(P, b, hd, s, lds); attnB_unit(P, b, hd, 15 - s, lds); }
        if (!(dry && MK_SUB == 1)) combineA_rows(P);
    PH_END(6)
    PH_BEGIN(7) run_gemm<EpiResidF, false>(lds, Y, 1024, (const bf16_t*)(ws + W_OUTE), T, 1024, 1024, EpiResidF{P.in[0], nullptr, XB, ssq + 1 * T, dry});
        if (!dry) { const int t8 = tid_opaque(); convert_weights(P, lds, NTR_EARLY, NTR, true, bx * NWAVE + (t8 >> 6), G * NWAVE, bx * NTHR + t8, G * NTHR); }
    PH_END(8)
#define XATTN_MLP(l, p0)                                                                                                                                                      \
    PH_BEGIN(p0 + 1) for (int u = bx; u < 256; u += G) { const int b = u >> 6, hd = (u >> 4) & 3, qb = u & 15; xattn_fused_unit(P, (l), b, hd, qb, lds); } PH_END(p0 + 1)                           \
    PH_BEGIN(p0 + 2) run_gemm<EpiResid, false>(lds, (const bf16_t*)(ws + WS_YX), 512, (const bf16_t*)(ws + W_OX) + (size_t)(l) * 1024 * 512, T, 1024, 512, EpiResid{nullptr, nullptr, XB, ssq + ((l) ? 5 : 2) * T, dry}); PH_END(p0 + 2) \
    PH_BEGIN(p0 + 3) run_gemm<EpiScale, true>(lds, XB, 1024, (const bf16_t*)(ws + W_UP) + (size_t)(l) * 4096 * 1024, T, DFF, 1024, EpiScale{(bf16_t*)(ws + WS_H), DFF, ssq + ((l) ? 5 : 2) * T, 1.f / 1024.f, 1}); PH_END(p0 + 3)
    XATTN_MLP(0, 8)
    PH_BEGIN(12) run_gemm<EpiResid, false>(lds, (const bf16_t*)(ws + WS_H), DFF, (const bf16_t*)(ws + W_DOWN), T, 1024, DFF, EpiResid{nullptr, nullptr, XB, ssq + 3 * T, dry}); PH_END(12)
    PH_BEGIN(13) run_gemm<EpiScale, true>(lds, XB, 1024, (const bf16_t*)(ws + W_INO), T, 2048, 1024, EpiScale{(bf16_t*)(ws + WS_PROJ1), 2048, ssq + 3 * T, 1.f / 1024.f, 0}); PH_END(13)
    PH_BEGIN(14) phase_mix1(P); PH_END(15)
    PH_BEGIN(16) run_gemm<EpiResid, false>(lds, Y, 1024, (const bf16_t*)(ws + W_OUTO), T, 1024, 1024, EpiResid{nullptr, nullptr, XB, ssq + 4 * T, dry}); PH_END(16)
    XATTN_MLP(1, 17)
    PH_BEGIN(21) run_gemm<EpiResid, false>(lds, (const bf16_t*)(ws + WS_H), DFF, (const bf16_t*)(ws + W_DOWN) + (size_t)1024 * 4096, T, 1024, DFF, EpiResid{nullptr, P.out, XB, nullptr, dry}); PH_END(21)
#if MK_TPROBE
    if (ph_hi == NPHASE) { SEAM_XCD(); unsigned char* ws = P.ws;
        const unsigned long long* TS = (const unsigned long long*)(ws + WS_BAR + 65536);
        float delta = (MK_TPROBE == 14) ? (float)TS[12] / 625000.f : (MK_TPROBE >= 10) ? (float)TS[8 + MK_TPROBE - 10] / (float)TS[12] : (MK_TPROBE == 4 || MK_TPROBE == 20) ? (float)TS[3] * 1e-6f : (float)TS[MK_TPROBE - 1] / (float)TS[3];
        delta = floorf(delta * 25.f + 0.5f) * 0.04f;
        if (MK_TPROBE == 20) delta = 0.1f * floorf(log2f((float)TS[3] / 64000.f) + 0.5f);
        if (MK_TPROBE == 34) delta = 0.1f * floorf(log2f((float)TS[20] / 1000.f) * 2.f + 0.5f) * 0.5f;
        else if (MK_TPROBE >= 30) delta = 0.04f * floorf(25.f * (float)TS[16 + MK_TPROBE - 30] / (float)TS[20] + 0.5f);
        for (int i = blockIdx.x * NTHR + threadIdx.x; i < T * D; i += gridDim.x * NTHR) P.out[i] *= (1.f + delta); }
#endif
}

#ifndef MK_MULTI
#define MK_MULTI 0
#endif
extern "C" void kernel_launch(void* const* d_in, const int* in_sizes, int n_in, void* d_out, int out_size, void* d_ws, size_t ws_size, hipStream_t stream) {
    static int grid = 0;
    if (grid == 0) {
        if (n_in != 33 || out_size != T * D || ws_size < WS_END) { fprintf(stderr, "kernel_launch: unexpected shapes (n_in %d out %d ws %zu)\n", n_in, out_size, ws_size); grid = -1; return; }
        int dev = 0, cus = 0, per_cu = 0;
        hipGetDevice(&dev); hipDeviceGetAttribute(&cus, hipDeviceAttributeMultiprocessorCount, dev);
        hipFuncSetAttribute((const void*)mega<false>, hipFuncAttributeMaxDynamicSharedMemorySize, LDS_BYTES);
        hipOccupancyMaxActiveBlocksPerMultiprocessor(&per_cu, (const void*)mega<false>, NTHR, LDS_BYTES);
        if (per_cu < 1) { fprintf(stderr, "kernel_launch: occupancy query says %d blocks/CU\n", per_cu); per_cu = 1; }
        (void)hipGetLastError();
        grid = cus * 1;
    }
    if (grid < 0) return;
    Params p{};
    for (int i = 0; i < 33; ++i) p.in[i] = (const float*)d_in[i];
    p.out = (float*)d_out; p.ws = (unsigned char*)d_ws;
    (void)hipMemsetAsync((char*)d_ws + WS_BAR, 0, MK_TPROBE ? 131072 : XCD_BAR_WORDS * 4, stream);
#if MK_MULTI
    for (int ph = 0; ph < NPHASE; ++ph) hipLaunchKernelGGL(mega<false>, dim3(grid), dim3(NTHR), LDS_BYTES, stream, p, ph, ph + 1);
#else
    int lo = 0, hi = NPHASE;
    void* args[] = {&p, &lo, &hi};
    hipError_t e = hipLaunchCooperativeKernel((const void*)mega<false>, dim3(grid), dim3(NTHR), args, LDS_BYTES, stream);
    if (e != hipSuccess) fprintf(stderr, "cooperative launch failed: %s (grid %d)\n", hipGetErrorString(e), grid);
#endif
#if MK_XPH >= 0
    { static bool once = false; if (!once) { (void)hipFuncSetAttribute((const void*)mega<true>, hipFuncAttributeMaxDynamicSharedMemorySize, LDS_BYTES); once = true; } }
    for (int i = 0; i < MK_XN; ++i) hipLaunchKernelGGL(mega<true>, dim3(grid), dim3(NTHR), LDS_BYTES, stream, p, MK_XPH, MK_XPH + 1);
#endif
}
```

```cpp
#include <hip/hip_runtime.h>
#include <hip/hip_cooperative_groups.h>
#include <cstdio>
#include <cstdint>
namespace cg = cooperative_groups;
#ifndef MK_SEL2
#define MK_SEL2 0
#define MK_SC2 0
#define MK_BIS2 0
#define MK_A64 1
#define MK_B64 1
#define MK_SP2 true
#define MK_XA2 0
#define MK_FUSE 7
#define MK_AX 0
#define MK_TPROBE 0
#endif

#define DEVI __device__ __forceinline__
#define LAS __attribute__((address_space(3)))
typedef unsigned short bf16_t;
typedef short bf16x8 __attribute__((ext_vector_type(8)));
typedef short s16x4 __attribute__((ext_vector_type(4)));
typedef float f32x2 __attribute__((ext_vector_type(2)));
typedef float f32x4 __attribute__((ext_vector_type(4)));
typedef float f32x16 __attribute__((ext_vector_type(16)));
typedef unsigned u32x2 __attribute__((ext_vector_type(2)));
typedef unsigned u32x4 __attribute__((ext_vector_type(4)));
typedef unsigned long long u64;

constexpr int NB = 4, S = 4096, T = NB * S, D = 1024, DFF = 4096, MEML = 256, MEMT = NB * MEML;
constexpr int LDP = 2816;
constexpr int C_QA = 0, C_KA = 512, C_VA = 1024, C_QB = 1536, C_CKV = 2048, C_QI = 2304, C_KI = 2560, C_WI = 2624, EVEN_IN = 2628;
constexpr float EPS = 1e-6f;
constexpr float LOG2E = 1.4426950408889634f;
constexpr int NTHR = 512, NWAVE = 8;
constexpr int LDS_BYTES = 163840;

constexpr size_t MiB = 1u << 20;
constexpr size_t WS_SSQ = 0;
constexpr size_t WS_SSQCKV = WS_SSQ + 6ull * T * 4;
constexpr size_t WS_SSQMEM = WS_SSQCKV + (size_t)T * 4;
constexpr size_t WS_WI = 512 * 1024;
constexpr size_t WS_BAR = 1 * MiB;
constexpr size_t WS_W = 2 * MiB;
constexpr size_t W_INE = WS_W;
constexpr size_t W_KVUP = W_INE + (size_t)LDP * 1024 * 2;
constexpr size_t W_OUTE = W_KVUP + 1024ull * 256 * 2;
constexpr size_t W_QX = W_OUTE + 1024ull * 1024 * 2;
constexpr size_t W_KVX = W_QX + 2 * 512ull * 1024 * 2;
constexpr size_t W_OX = W_KVX + 2 * 1024ull * 1024 * 2;
constexpr size_t W_UP = W_OX + 2 * 1024ull * 512 * 2;
constexpr size_t W_DOWN = W_UP + 2 * 4096ull * 1024 * 2;
constexpr size_t W_INO = W_DOWN + 2 * 4096ull * 1024 * 2;
constexpr size_t W_POOL = W_INO + 2048ull * 1024 * 2;
constexpr size_t W_OUTO = W_POOL + 512ull * 512 * 2;
constexpr size_t W_END = W_OUTO + 1024ull * 1024 * 2;
static_assert(W_END <= 57 * MiB, "weights region");
constexpr size_t WS_XB = 57 * MiB;
constexpr size_t WS_PROJ = 89 * MiB;
constexpr size_t WS_KBVB = 177 * MiB;
constexpr size_t WS_MASK = 209 * MiB;
constexpr size_t WS_Y = 217 * MiB;
constexpr size_t WS_CS = 249 * MiB;
constexpr size_t WS_MB = 250 * MiB;
constexpr size_t WS_KVX = 252 * MiB;
constexpr size_t WS_END = 256 * MiB;
constexpr size_t WS_QX = WS_PROJ;
constexpr size_t WS_YX = WS_PROJ + 16 * MiB;
constexpr size_t WS_H = WS_PROJ;
constexpr size_t WS_PROJ1 = WS_PROJ;
constexpr size_t WS_POOLED = WS_PROJ + 64 * MiB;
constexpr size_t WS_KI = WS_Y;

struct Params { const float* in[33]; float* out; unsigned char* ws; };

DEVI float bf2f(bf16_t v) { return __uint_as_float(((unsigned)v) << 16); }
DEVI unsigned f2bf(float f) { unsigned u = __float_as_uint(f); return (u + 0x7fffu + ((u >> 16) & 1u)) >> 16; }
DEVI unsigned pk2(float lo, float hi) { return f2bf(lo) | (f2bf(hi) << 16); }
DEVI float wave_sum(float v) {
#pragma unroll
    for (int o = 1; o < 64; o <<= 1) v += __shfl_xor(v, o);
    return v;
}
DEVI float lo16(unsigned w) { return __uint_as_float(w << 16); }
DEVI float hi16(unsigned w) { return __uint_as_float(w & 0xffff0000u); }
#define LDS_WAIT() asm volatile("s_waitcnt lgkmcnt(0)" ::: "memory")
DEVI unsigned cvtpk(float lo, float hi) { typedef __bf16 bf2 __attribute__((ext_vector_type(2))); f32x2 v = {lo, hi}; bf2 b = __builtin_convertvector(v, bf2); return __builtin_bit_cast(unsigned, b); }

extern __shared__ __attribute__((aligned(16))) unsigned char lds_raw[];
constexpr int WTAB_OFF = 163840 - 128;
DEVI unsigned hw_slot() { return (unsigned)__builtin_amdgcn_s_getreg((5 << 11) | 4) & 63u; }
DEVI int tid_opaque() { int w = ((volatile LAS unsigned char*)lds_raw)[WTAB_OFF + hw_slot()]; w = __builtin_amdgcn_readfirstlane(w); asm volatile("" : "+s"(w));
    const int l = __builtin_amdgcn_mbcnt_hi(~0u, __builtin_amdgcn_mbcnt_lo(~0u, 0u)); return w * 64 + l; }
struct TrD { const float* src; bf16_t* dst; const float* sk; const float* sn; int K, N, ldd; };
constexpr int NTR = 19;
DEVI TrD get_tr(const Params& P, int i) {
    unsigned char* ws = P.ws; TrD d; d.sk = nullptr; d.sn = nullptr;
    switch (i) {
    case 0: d.src = P.in[14]; d.dst = (bf16_t*)(ws + W_INE); d.K = 1024; d.N = EVEN_IN; d.ldd = 1024; d.sk = P.in[3]; break;
    case 1: d.src = P.in[23]; d.dst = (bf16_t*)(ws + W_KVUP); d.K = 256; d.N = 1024; d.ldd = 256; d.sk = P.in[22]; break;
    case 2: d.src = P.in[27]; d.dst = (bf16_t*)(ws + W_OUTE); d.K = 1024; d.N = 1024; d.ldd = 1024; break;
    case 3: case 4: { int l = i - 3; d.src = P.in[7] + (size_t)l * 1024 * 512; d.dst = (bf16_t*)(ws + W_QX) + (size_t)l * 512 * 1024; d.K = 1024; d.N = 512; d.ldd = 1024; d.sk = P.in[4] + l * 1024; } break;
    case 5: case 6: { int l = i - 5; d.src = P.in[8] + (size_t)l * 1024 * 1024; d.dst = (bf16_t*)(ws + W_KVX) + (size_t)l * 1024 * 1024; d.K = 1024; d.N = 1024; d.ldd = 1024; d.sk = P.in[5] + l * 1024; } break;
    case 7: case 8: { int l = i - 7; d.src = P.in[11] + (size_t)l * 512 * 1024; d.dst = (bf16_t*)(ws + W_OX) + (size_t)l * 1024 * 512; d.K = 512; d.N = 1024; d.ldd = 512; } break;
    case 9: case 10: { int l = i - 9; d.src = P.in[12] + (size_t)l * 1024 * 4096; d.dst = (bf16_t*)(ws + W_UP) + (size_t)l * 4096 * 1024; d.K = 1024; d.N = 4096; d.ldd = 1024; d.sk = P.in[6] + l * 1024; } break;
    case 11: case 12: { int l = i - 11; d.src = P.in[13] + (size_t)l * 4096 * 1024; d.dst = (bf16_t*)(ws + W_DOWN) + (size_t)l * 1024 * 4096; d.K = 4096; d.N = 1024; d.ldd = 4096; } break;
    case 13: d.src = P.in[28]; d.dst = (bf16_t*)(ws + W_INO); d.K = 1024; d.N = 2048; d.ldd = 1024; d.sk = P.in[3] + 1024; break;
    case 14: case 15: case 16: case 17: d.src = P.in[30]; d.dst = (bf16_t*)(ws + W_POOL); d.K = 0; d.N = 32; d.ldd = 512; break;
    default: d.src = P.in[32]; d.dst = (bf16_t*)(ws + W_OUTO); d.K = 512; d.N = 1024; d.ldd = 1024; break;
    }
    return d;
}
DEVI int tr_items(const TrD& d) { return (d.K / 64) * ((d.N + 31) / 32); }
template <bool SK, bool SN>
DEVI void tr_item(const TrD& d, LAS float* scr, int item, int lane) {
    const int nblk = (d.N + 31) / 32, kb = item / nblk, nb = item % nblk, k0 = 64 * kb, n0 = 32 * nb;
    const int n = n0 + (lane & 31), nc = (n < d.N) ? n : (d.N - 1);
    const float* sp = d.src + (size_t)(k0 + (lane >> 5)) * d.N + nc;
    float v[32], sk[32];
#pragma unroll
    for (int i = 0; i < 32; ++i) { v[i] = sp[(size_t)(2 * i) * d.N]; if (SK) sk[i] = d.sk[k0 + 2 * i + (lane >> 5)]; }
#pragma unroll
    for (int i = 0; i < 32; ++i) { float x = v[i]; if (SK) x *= sk[i]; if (n >= d.N) x = 0.f; scr[(2 * i + (lane >> 5)) * 33 + (lane & 31)] = x; }
    LDS_WAIT(); asm volatile("" ::: "memory");
    const int c = lane & 7;
#pragma unroll
    for (int j = 0; j < 4; ++j) {
        const int nn = (lane >> 3) + 8 * j, ncl = (n0 + nn < d.N) ? (n0 + nn) : (d.N - 1);
        const LAS float* s = scr + (8 * c) * 33 + nn;
        float sc = 1.f; if (SN) sc = d.sn[ncl];
        u32x4 o; o.x = pk2(s[0 * 33] * sc, s[1 * 33] * sc); o.y = pk2(s[2 * 33] * sc, s[3 * 33] * sc); o.z = pk2(s[4 * 33] * sc, s[5 * 33] * sc); o.w = pk2(s[6 * 33] * sc, s[7 * 33] * sc);
        if (n0 + nn < d.N) *(u32x4*)(d.dst + (size_t)(n0 + nn) * d.ldd + k0 + 8 * c) = o;
    }
    LDS_WAIT(); asm volatile("" ::: "memory");
}
template <int NR>
DEVI void rows_to_bf16_ssq(const float* x, bf16_t* o, float* ssq_out, int m0, int stride, int nrows, int lane) {
    f32x4 v[NR][4];
#pragma unroll
    for (int k = 0; k < NR; ++k) { const int m = (m0 + k * stride < nrows) ? m0 + k * stride : m0; const f32x4* xr = (const f32x4*)(x + (size_t)m * D) + lane;
#pragma unroll
        for (int j = 0; j < 4; ++j) v[k][j] = xr[64 * j]; }
#pragma unroll
    for (int k = 0; k < NR; ++k) { const int m = m0 + k * stride; if (m >= nrows) break;
        float s = 0.f;
#pragma unroll
        for (int j = 0; j < 4; ++j) s += (v[k][j].x * v[k][j].x + v[k][j].y * v[k][j].y) + (v[k][j].z * v[k][j].z + v[k][j].w * v[k][j].w);
        s = wave_sum(s);
        if (lane == 0) ssq_out[m] = s;
        u32x2* o8 = (u32x2*)(o + (size_t)m * D) + lane;
#pragma unroll
        for (int j = 0; j < 4; ++j) { u32x2 w; w.x = pk2(v[k][j].x, v[k][j].y); w.y = pk2(v[k][j].z, v[k][j].w); o8[64 * j] = w; } }
}
#ifndef MK_SUB
#define MK_SUB 0
#endif
DEVI void convert_weights(const Params& P, LAS unsigned char* lds, int dlo, int dhi, bool fold, int gw, int NGW, int gt, int NGT) {
    const int tid = tid_opaque(), lane = tid & 63, wave = tid >> 6;
    unsigned char* ws = P.ws;
    LAS float* scr = (LAS float*)(lds + wave * 16384);
    int base = 0;
    for (int i = dlo; i < dhi; ++i) {
        const TrD d = get_tr(P, i); const int n = tr_items(d);
        int first = gw - (base % NGW); if (first < 0) first += NGW;
        if (d.sn) { for (int it = first; it < n; it += NGW) tr_item<false, true>(d, scr, it, lane); }
        else if (d.sk) { for (int it = first; it < n; it += NGW) tr_item<true, false>(d, scr, it, lane); }
        else { for (int it = first; it < n; it += NGW) tr_item<false, false>(d, scr, it, lane); }
        base += n;
    }
    if (!fold) return;
    for (int i = gt; i < 1024 * 64; i += NGT) {
        const int n = i & 1023, cp0 = (i >> 10) * 8, g = cp0 >> 7, c = cp0 & 127;
        const float* wo = P.in[32] + (size_t)(512 + g * 128) * 1024 + n; const float* wp = P.in[30] + (size_t)g * 16384 + (size_t)c * 128; const float* ps = P.in[31] + g * 128;
        float acc[8];
#pragma unroll
        for (int j = 0; j < 8; ++j) acc[j] = 0.f;
        for (int d0 = 0; d0 < 128; d0 += 8) {
            float wv[8];
#pragma unroll
            for (int dd = 0; dd < 8; ++dd) wv[dd] = wo[(size_t)(d0 + dd) * 1024] * ps[d0 + dd];
#pragma unroll
            for (int dd = 0; dd < 8; ++dd)
#pragma unroll
                for (int j = 0; j < 8; ++j) acc[j] += wp[j * 128 + d0 + dd] * wv[dd];
        }
        u32x4 w; w.x = pk2(acc[0], acc[1]); w.y = pk2(acc[2], acc[3]); w.z = pk2(acc[4], acc[5]); w.w = pk2(acc[6], acc[7]);
        *(u32x4*)((bf16_t*)(ws + W_OUTO) + (size_t)n * 1024 + 512 + cp0) = w;
    }
}
constexpr int NTR_EARLY = 7;
DEVI void phase_prologue(const Params& P, LAS unsigned char* lds, int dry = 0) {
    const int tid = tid_opaque(), lane = tid & 63, wave = tid >> 6;
#if MK_TPROBE == 20
    { float a0 = lane, a1 = lane + 1, a2 = lane + 2, a3 = lane + 3, a4 = lane + 4, a5 = lane + 5, a6 = lane + 6, a7 = lane + 7;
      unsigned long long t0_ = __builtin_amdgcn_s_memtime();
      for (int it = 0; it < 1000; ++it) {
#pragma unroll
          for (int k = 0; k < 8; ++k) { asm volatile("v_fma_f32 %0, %0, 1.0, %0\n\tv_fma_f32 %1, %1, 1.0, %1\n\tv_fma_f32 %2, %2, 1.0, %2\n\tv_fma_f32 %3, %3, 1.0, %3\n\tv_fma_f32 %4, %4, 1.0, %4\n\tv_fma_f32 %5, %5, 1.0, %5\n\tv_fma_f32 %6, %6, 1.0, %6\n\tv_fma_f32 %7, %7, 1.0, %7" : "+v"(a0), "+v"(a1), "+v"(a2), "+v"(a3), "+v"(a4), "+v"(a5), "+v"(a6), "+v"(a7)); }
      }
      unsigned long long t1_ = __builtin_amdgcn_s_memtime();
      asm volatile("" :: "v"(a0), "v"(a1), "v"(a2), "v"(a3), "v"(a4), "v"(a5), "v"(a6), "v"(a7));
      if (blockIdx.x == 0 && tid == 0) atomicAdd((unsigned long long*)(P.ws + WS_BAR + 65536) + 3, t1_ - t0_); }
#endif
    const int gw = blockIdx.x * NWAVE + wave, NGW = gridDim.x * NWAVE;
    const int gt = blockIdx.x * NTHR + tid, NGT = gridDim.x * NTHR;
    unsigned char* ws = P.ws;
    convert_weights(P, lds, 0, NTR_EARLY, false, gw, NGW, gt, NGT);
    { bf16_t* w = (bf16_t*)(ws + W_INE) + (size_t)EVEN_IN * 1024; const int n = (LDP - EVEN_IN) * 1024 / 8;
      for (int i = gt; i < n; i += NGT) ((u32x4*)w)[i] = (u32x4){0u, 0u, 0u, 0u}; }
    { float* q = (float*)(ws + WS_SSQ) + T; for (int i = gt; i < 5 * T; i += NGT) q[i] = 0.f; }
    if (!(dry && MK_SUB != 2 && MK_SUB != 0))
    for (int m = gw; m < T; m += 4 * NGW) rows_to_bf16_ssq<4>(P.in[0], (bf16_t*)(ws + WS_XB), (float*)(ws + WS_SSQ), m, NGW, T, lane);
    for (int m = gw; m < MEMT; m += NGW) rows_to_bf16_ssq<1>(P.in[1], (bf16_t*)(ws + WS_MB), (float*)(ws + WS_SSQMEM), m, NGW, MEMT, lane);
    if (!(dry && MK_SUB != 3 && MK_SUB != 0))
    { const int* pos = (const int*)P.in[2]; float* cs = (float*)(ws + WS_CS);
      for (int i = gt; i < T * 8; i += NGT) { const int m = i >> 3, f = i & 7;
        const double inv = (f == 0) ? 1.0 : (f == 1) ? 0.19392274474868576 : (f == 2) ? 0.03760603093086393 : (f == 3) ? 0.007292664737217109 : (f == 4) ? 0.001414213562373095
                         : (f == 5) ? 0.0002742481756762073 : (f == 6) ? 5.318295896944988e-05 : 1.031338537721246e-05;
        const double ang = (double)pos[m] * inv, k = rint(ang * 0.15915494309189535), r = fma(-k, 6.283185307179586, ang) - k * 2.4492935982947064e-16;
        cs[m * 16 + f] = cosf((float)r); cs[m * 16 + 8 + f] = sinf((float)r); } }
}

struct EpiStore {
    bf16_t* O; int ldo; const float* ssq; float inv_n; int act;
    DEVI void operator()(const f32x4 (&acc)[4][4], int row0, int col0, int lane) const {
#pragma unroll
        for (int m = 0; m < 4; ++m)
#pragma unroll
            for (int i = 0; i < 4; ++i) {
                const int row = row0 + 16 * m + (lane >> 4) * 4 + i;
                const float rs = ssq ? rsqrtf(ssq[row] * inv_n + EPS) : 1.f;
#pragma unroll
                for (int n = 0; n < 4; ++n) {
                    float v = acc[m][n][i] * rs;
                    if (act == 1) { v = fmaxf(v, 0.f); v = v * v; }
                    O[(size_t)row * ldo + col0 + 16 * n + (lane & 15)] = (bf16_t)f2bf(v);
                }
            }
    }
};
struct EpiRes {
    const float* base; float* out; bf16_t* xb; float* ssq_next;
    DEVI void operator()(const f32x4 (&acc)[4][4], int row0, int col0, int lane) const {
#pragma unroll
        for (int m = 0; m < 4; ++m)
#pragma unroll
            for (int i = 0; i < 4; ++i) {
                const int row = row0 + 16 * m + (lane >> 4) * 4 + i; float s = 0.f;
#pragma unroll
                for (int n = 0; n < 4; ++n) {
                    const size_t idx = (size_t)row * D + col0 + 16 * n + (lane & 15);
                    const float v = base[idx] + acc[m][n][i];
                    out[idx] = v; s += v * v;
                    if (xb) xb[idx] = (bf16_t)f2bf(v);
                }
                if (ssq_next) {
                    s += __shfl_xor(s, 1); s += __shfl_xor(s, 2); s += __shfl_xor(s, 4); s += __shfl_xor(s, 8);
                    if ((lane & 15) == 0) atomicAdd(ssq_next + row, s);
                }
            }
    }
};
template <class Epi>
DEVI void gemm_simple(const bf16_t* A, int lda, const bf16_t* Bt, int ldb, int M, int N, int K, const Epi& epi) {
    const int tid = tid_opaque(), lane = tid & 63, wave = tid >> 6;
    const int gw = blockIdx.x * NWAVE + wave, NGW = gridDim.x * NWAVE;
    const int nN = N / 64, ntiles = (M / 64) * nN;
    for (int tile = gw; tile < ntiles; tile += NGW) {
        const int row0 = (tile / nN) * 64, col0 = (tile % nN) * 64;
        f32x4 acc[4][4];
#pragma unroll
        for (int m = 0; m < 4; ++m)
#pragma unroll
            for (int n = 0; n < 4; ++n) acc[m][n] = (f32x4){0.f, 0.f, 0.f, 0.f};
        const bf16_t* ap = A + (size_t)(row0 + (lane & 15)) * lda + 8 * (lane >> 4);
        const bf16_t* bp = Bt + (size_t)(col0 + (lane & 15)) * ldb + 8 * (lane >> 4);
        for (int k0 = 0; k0 < K; k0 += 32) {
            bf16x8 a[4], b[4];
#pragma unroll
            for (int m = 0; m < 4; ++m) a[m] = *(const bf16x8*)(ap + (size_t)(16 * m) * lda + k0);
#pragma unroll
            for (int n = 0; n < 4; ++n) b[n] = *(const bf16x8*)(bp + (size_t)(16 * n) * ldb + k0);
#pragma unroll
            for (int m = 0; m < 4; ++m)
#pragma unroll
                for (int n = 0; n < 4; ++n) acc[m][n] = __builtin_amdgcn_mfma_f32_16x16x32_bf16(a[m], b[n], acc[m][n], 0, 0, 0);
        }
        epi(acc, row0, col0, lane);
    }
}

DEVI u32x4 heads8(u32x4 raw, const float (&gv)[8], bool do_norm, float scale, const float (&cs)[16], int lane) {
    float v[8];
#pragma unroll
    for (int j = 0; j < 4; ++j) { v[2 * j] = lo16(raw[j]); v[2 * j + 1] = hi16(raw[j]); }
    if (do_norm) {
        float ss = 0.f;
#pragma unroll
        for (int j = 0; j < 8; ++j) ss += v[j] * v[j];
        ss += __shfl_xor(ss, 1); ss += __shfl_xor(ss, 2); ss += __shfl_xor(ss, 4);
        const float rs = rsqrtf(ss * (1.f / 64.f) + EPS);
#pragma unroll
        for (int j = 0; j < 8; ++j) v[j] = v[j] * rs * gv[j];
    }
    const int sub = lane & 7;
#pragma unroll
    for (int j = 0; j < 8; ++j) { const float o = __shfl_xor(v[j], 1); if (sub == 0) v[j] = v[j] * cs[j] - o * cs[8 + j]; else if (sub == 1) v[j] = v[j] * cs[j] + o * cs[8 + j]; }
    u32x4 w;
#pragma unroll
    for (int j = 0; j < 4; ++j) w[j] = cvtpk(v[2 * j] * scale, v[2 * j + 1] * scale);
    return w;
}
DEVI void load8(float (&g)[8], const float* p) { const f32x4 a = *(const f32x4*)p, b = *(const f32x4*)(p + 4); g[0] = a[0]; g[1] = a[1]; g[2] = a[2]; g[3] = a[3]; g[4] = b[0]; g[5] = b[1]; g[6] = b[2]; g[7] = b[3]; }
struct Post0Row { u32x4 qa, ka, qb, x, ckv; u32x2 wi; f32x4 c0, c1, c2, c3; };
DEVI void post0_load(Post0Row& R, const bf16_t* row, const float* cs, int lane) {
    R.qa = *(const u32x4*)(row + C_QA + 8 * lane); R.ka = *(const u32x4*)(row + C_KA + 8 * lane); R.qb = *(const u32x4*)(row + C_QB + 8 * lane);
    R.x = *(const u32x4*)(row + C_QI + 8 * ((lane < 40) ? lane : 0));
    R.ckv = *(const u32x4*)(row + C_CKV + 8 * (lane & 31));
    R.wi = *(const u32x2*)(row + C_WI);
    R.c0 = *(const f32x4*)cs; R.c1 = *(const f32x4*)(cs + 4); R.c2 = *(const f32x4*)(cs + 8); R.c3 = *(const f32x4*)(cs + 12);
}
DEVI void phase_post0(const Params& P, int parts = 3) {
    static_assert(C_KI == C_QI + 256, "k_idx follows q_idx");
    const int tid = tid_opaque(), lane = tid & 63, wave = tid >> 6;
    const int gw = blockIdx.x * NWAVE + wave, NGW = gridDim.x * NWAVE;
    unsigned char* ws = P.ws;
    const float qscale = 0.125f * LOG2E;
    float gqa[8], gka[8], gqb[8], gki[8];
    load8(gqa, P.in[15] + 8 * (lane & 7)); load8(gka, P.in[16] + 8 * (lane & 7)); load8(gqb, P.in[24] + 8 * (lane & 7)); load8(gki, P.in[26] + 8 * (lane & 7));
    if (parts & 1)
    for (int m0 = gw; m0 < T; m0 += 2 * NGW) {
        Post0Row R[2];
        const int m1 = (m0 + NGW < T) ? m0 + NGW : m0;
        post0_load(R[0], (const bf16_t*)(ws + WS_PROJ) + (size_t)m0 * LDP, (const float*)(ws + WS_CS) + (size_t)m0 * 16, lane);
        post0_load(R[1], (const bf16_t*)(ws + WS_PROJ) + (size_t)m1 * LDP, (const float*)(ws + WS_CS) + (size_t)m1 * 16, lane);
#pragma unroll
        for (int k = 0; k < 2; ++k) {
            const int m = k ? m1 : m0; if (k == 1 && m1 == m0) break;
            bf16_t* row = (bf16_t*)(ws + WS_PROJ) + (size_t)m * LDP;
            float cs[16];
#pragma unroll
            for (int j = 0; j < 4; ++j) { cs[j] = R[k].c0[j]; cs[4 + j] = R[k].c1[j]; cs[8 + j] = R[k].c2[j]; cs[12 + j] = R[k].c3[j]; }
            *(u32x4*)(row + C_QA + 8 * lane) = heads8(R[k].qa, gqa, true, qscale, cs, lane);
            *(u32x4*)(row + C_KA + 8 * lane) = heads8(R[k].ka, gka, true, 1.f, cs, lane);
            *(u32x4*)(row + C_QB + 8 * lane) = heads8(R[k].qb, gqb, true, qscale, cs, lane);
            {
              float v[8];
#pragma unroll
              for (int j = 0; j < 4; ++j) { v[2 * j] = lo16(R[k].x[j]); v[2 * j + 1] = hi16(R[k].x[j]); }
              float ss = 0.f;
#pragma unroll
              for (int j = 0; j < 8; ++j) ss += v[j] * v[j];
              ss += __shfl_xor(ss, 1); ss += __shfl_xor(ss, 2); ss += __shfl_xor(ss, 4);
              if (lane >= 32) { const float rs = rsqrtf(ss * (1.f / 64.f) + EPS);
#pragma unroll
                  for (int j = 0; j < 8; ++j) v[j] = v[j] * rs * gki[j]; }
              const int sub = lane & 7;
#pragma unroll
              for (int j = 0; j < 8; ++j) { const float o = __shfl_xor(v[j], 1); if (sub == 0) v[j] = v[j] * cs[j] - o * cs[8 + j]; else if (sub == 1) v[j] = v[j] * cs[j] + o * cs[8 + j]; }
              u32x4 w;
#pragma unroll
              for (int j = 0; j < 4; ++j) w[j] = cvtpk(v[2 * j], v[2 * j + 1]);
              if (lane < 32) *(u32x4*)(row + C_QI + 8 * lane) = w;
              else if (lane < 40) { const int c = lane - 32;
                  *(u32x4*)((bf16_t*)(ws + WS_KI) + (size_t)(m >> 5) * 2048 + (c >> 1) * 512 + (((c & 1) * 32 + (m & 31)) * 8)) = w; } }
            { float ss = 0.f;
#pragma unroll
              for (int j = 0; j < 4; ++j) { const float a = lo16(R[k].ckv[j]), b = hi16(R[k].ckv[j]); ss += a * a + b * b; }
              ss += __shfl_xor(ss, 1); ss += __shfl_xor(ss, 2); ss += __shfl_xor(ss, 4); ss += __shfl_xor(ss, 8); ss += __shfl_xor(ss, 16);
              if (lane == 0) { ((float*)(ws + WS_SSQCKV))[m] = ss;
                  *(f32x4*)((float*)(ws + WS_WI) + (size_t)m * 4) = (f32x4){lo16(R[k].wi.x) * (1.f / 16.f), hi16(R[k].wi.x) * (1.f / 16.f), lo16(R[k].wi.y) * (1.f / 16.f), hi16(R[k].wi.y) * (1.f / 16.f)}; } }
        }
    }
    if (parts & 2)
    for (int it = gw; it < 2 * MEMT; it += NGW) {
        const int l = it / MEMT, m = it % MEMT;
        bf16_t* row = (bf16_t*)(ws + WS_KVX) + (size_t)m * 2048 + l * 1024;
        float g[8]; load8(g, P.in[10] + l * 128 + 8 * (lane & 15));
        const u32x4 raw = *(const u32x4*)(row + 8 * lane);
        float v[8]; float ss = 0.f;
#pragma unroll
        for (int j = 0; j < 4; ++j) { v[2 * j] = lo16(raw[j]); v[2 * j + 1] = hi16(raw[j]); ss += v[2 * j] * v[2 * j] + v[2 * j + 1] * v[2 * j + 1]; }
        ss += __shfl_xor(ss, 1); ss += __shfl_xor(ss, 2); ss += __shfl_xor(ss, 4); ss += __shfl_xor(ss, 8);
        const float rs = rsqrtf(ss * (1.f / 128.f) + EPS);
        u32x4 w;
#pragma unroll
        for (int j = 0; j < 4; ++j) w[j] = cvtpk(v[2 * j] * rs * g[2 * j], v[2 * j + 1] * rs * g[2 * j + 1]);
        *(u32x4*)(row + 8 * lane) = w;
    }
}
DEVI void phase_postkb(const Params& P) {
    const int tid = tid_opaque(), lane = tid & 63, wave = tid >> 6;
    const int gw = blockIdx.x * NWAVE + wave, NGW = gridDim.x * NWAVE;
    unsigned char* ws = P.ws;
    float gkb[8]; load8(gkb, P.in[25] + 8 * (lane & 7));
    for (int m0 = gw; m0 < T; m0 += 4 * NGW) {
        u32x4 raw[4]; f32x4 c[4][4];
#pragma unroll
        for (int k = 0; k < 4; ++k) { const int m = (m0 + k * NGW < T) ? m0 + k * NGW : m0;
            raw[k] = *(const u32x4*)((const bf16_t*)(ws + WS_KBVB) + (size_t)m * 1024 + 8 * lane);
            const float* cs = (const float*)(ws + WS_CS) + (size_t)m * 16;
#pragma unroll
            for (int j = 0; j < 4; ++j) c[k][j] = *(const f32x4*)(cs + 4 * j); }
#pragma unroll
        for (int k = 0; k < 4; ++k) { const int m = m0 + k * NGW; if (m >= T) break;
            float cs[16];
#pragma unroll
            for (int j = 0; j < 16; ++j) cs[j] = c[k][j >> 2][j & 3];
            *(u32x4*)((bf16_t*)(ws + WS_KBVB) + (size_t)m * 1024 + 8 * lane) = heads8(raw[k], gkb, true, 1.f, cs, lane); }
    }
}

DEVI int crow(int r, int hi) { return (r & 3) + 8 * (r >> 2) + 4 * hi; }
typedef short v4i16_t __attribute__((ext_vector_type(4)));
DEVI s16x4 vtr(LAS const unsigned char* p) { return __builtin_bit_cast(s16x4, __builtin_amdgcn_ds_read_tr16_b64_v4i16((LAS v4i16_t*)p)); }

DEVI float max3f(float a, float b, float c) { float r; asm("v_max3_f32 %0, %1, %2, %3" : "=v"(r) : "v"(a), "v"(b), "v"(c)); return r; }
DEVI float max2f(float a, float b) { float r; asm("v_max_f32_e32 %0, %1, %2" : "=v"(r) : "v"(a), "v"(b)); return r; }
template <int DQK, int DV, int MODE, bool QP = false>
DEVI void attn_core(f32x16 (&o)[DV / 32], float& l_out, const bf16x8 (&qf)[DQK / 16],
                    const bf16_t* Kg, int ldk, const bf16_t* Vg, int ldv, int ntiles, int qpos, int qpos_wmin,
                    const u64* mrow, LAS unsigned char* lds, int tid) {
    constexpr int KROWB = DQK * 2, KCPR = DQK / 8, VP = (DV == 128) ? 320 : 192, VCPR = DV / 8;
    constexpr int KBUF = 64 * KROWB, VBUF = 64 * VP, KCH = 64 * KCPR / NTHR, VCH = 64 * VCPR / NTHR;
    constexpr float THR = 8.f;
#define KSWZ(r) ((KCPR == 8) ? (((r) >> 1) & 7) : ((r) & 15))
    LAS unsigned char* Kl = lds; LAS unsigned char* Vl = lds + 2 * KBUF;
    const int lane = tid & 63, r32 = lane & 31, hi = lane >> 5;
    u32x4 kreg[KCH], vreg[VCH];
#define A_GLOAD(t) do { _Pragma("unroll") for (int i_ = 0; i_ < KCH; ++i_) { const int c_ = tid + NTHR * i_, row_ = c_ / KCPR, ch_ = c_ % KCPR; kreg[i_] = *(const u32x4*)(Kg + (size_t)(64 * (t) + row_) * ldk + ch_ * 8); } \
        _Pragma("unroll") for (int i_ = 0; i_ < VCH; ++i_) { const int c_ = tid + NTHR * i_, row_ = c_ / VCPR, ch_ = c_ % VCPR; vreg[i_] = *(const u32x4*)(Vg + (size_t)(64 * (t) + row_) * ldv + ch_ * 8); } } while (0)
#define A_LSTORE(buf) do { _Pragma("unroll") for (int i_ = 0; i_ < KCH; ++i_) { const int c_ = tid + NTHR * i_, row_ = c_ / KCPR, ch_ = c_ % KCPR; *(LAS u32x4*)(Kl + (buf) * KBUF + row_ * KROWB + ((ch_ ^ KSWZ(row_)) << 4)) = kreg[i_]; } \
        _Pragma("unroll") for (int i_ = 0; i_ < VCH; ++i_) { const int c_ = tid + NTHR * i_, row_ = c_ / VCPR, ch_ = c_ % VCPR; *(LAS u32x4*)(Vl + (buf) * VBUF + row_ * VP + ch_ * 16) = vreg[i_]; } } while (0)
    A_GLOAD(0); A_LSTORE(0); __syncthreads();
#pragma unroll
    for (int d0 = 0; d0 < DQK / 16; ++d0) asm volatile("" :: "v"(qf[d0]));
    const int vb = (4 * hi + ((lane & 15) >> 2)) * VP + (16 * ((lane >> 4) & 1) + 4 * (lane & 3)) * 2;
    const short one = (short)0x3F80;
    const bf16x8 ones = ((r32 & ~4) == 0) ? (bf16x8){one, one, one, one, one, one, one, one} : (bf16x8){0, 0, 0, 0, 0, 0, 0, 0};
    f32x16 negm, lacc;
#pragma unroll
    for (int r = 0; r < 16; ++r) { negm[r] = 0.f; lacc[r] = 0.f; }
    float mhat = 0.f;
    const unsigned ninf = 0xFF800000u;
#if MK_AX == 1
    f32x16 dmy_;
#pragma unroll
    for (int r = 0; r < 16; ++r) dmy_[r] = 0.f;
#endif
    u64 wnext = 0ull;
    if (MODE == 2) wnext = mrow[0];
    for (int t = 0; t < ntiles; ++t) {
        const int buf = t & 1;
        const u64 wcur = wnext; (void)wcur;
        if (MODE == 2 && t + 1 < ntiles) wnext = mrow[t + 1];
        if (t + 1 < ntiles) A_GLOAD(t + 1);
        f32x16 p0, p1;
#pragma unroll
        for (int db = 0; db < DQK / 64; ++db) {
            bf16x8 kf[8];
#pragma unroll
            for (int e = 0; e < 4; ++e) { const int ch = 2 * (4 * db + e) + hi, row0 = r32, row1 = 32 + r32;
                if (!QP) {
                    kf[2 * e] = *(LAS const bf16x8*)(Kl + buf * KBUF + row0 * KROWB + ((ch ^ KSWZ(row0)) << 4));
                    kf[2 * e + 1] = *(LAS const bf16x8*)(Kl + buf * KBUF + row1 * KROWB + ((ch ^ KSWZ(row1)) << 4));
                } else {
                    const int c1 = 2 * (4 * db + e);
                    const s16x4 a0 = *(LAS const s16x4*)(Kl + buf * KBUF + row0 * KROWB + ((c1 ^ KSWZ(row0)) << 4) + 8 * hi), a1 = *(LAS const s16x4*)(Kl + buf * KBUF + row0 * KROWB + (((c1 + 1) ^ KSWZ(row0)) << 4) + 8 * hi);
                    const s16x4 b0 = *(LAS const s16x4*)(Kl + buf * KBUF + row1 * KROWB + ((c1 ^ KSWZ(row1)) << 4) + 8 * hi), b1 = *(LAS const s16x4*)(Kl + buf * KBUF + row1 * KROWB + (((c1 + 1) ^ KSWZ(row1)) << 4) + 8 * hi);
                    kf[2 * e] = (bf16x8){a0[0], a0[1], a0[2], a0[3], a1[0], a1[1], a1[2], a1[3]}; kf[2 * e + 1] = (bf16x8){b0[0], b0[1], b0[2], b0[3], b1[0], b1[1], b1[2], b1[3]};
                } }
#pragma unroll
            for (int e = 0; e < 4; ++e) { const int d0 = 4 * db + e;
                if (d0 == 0 && MODE == 2) {
                    const u64 w = wcur >> (4 * hi); const unsigned wl = (unsigned)w, wh = (unsigned)(w >> 32), nm = __float_as_uint(negm[0]);
#pragma unroll
                    for (int r = 0; r < 16; ++r) { const int bit = (r & 3) + 8 * (r >> 2);
                        const unsigned s0 = (unsigned)__builtin_amdgcn_sbfe(wl, bit, 1), s1 = (unsigned)__builtin_amdgcn_sbfe(wh, bit, 1);
                        p0[r] = __uint_as_float((nm & s0) | (ninf & ~s0)); p1[r] = __uint_as_float((nm & s1) | (ninf & ~s1)); }
                    p0 = __builtin_amdgcn_mfma_f32_32x32x16_bf16(kf[0], qf[0], p0, 0, 0, 0); p1 = __builtin_amdgcn_mfma_f32_32x32x16_bf16(kf[1], qf[0], p1, 0, 0, 0); }
                else if (d0 == 0) { p0 = __builtin_amdgcn_mfma_f32_32x32x16_bf16(kf[0], qf[0], negm, 0, 0, 0); p1 = __builtin_amdgcn_mfma_f32_32x32x16_bf16(kf[1], qf[0], negm, 0, 0, 0); }
                else { p0 = __builtin_amdgcn_mfma_f32_32x32x16_bf16(kf[2 * e], qf[d0], p0, 0, 0, 0); p1 = __builtin_amdgcn_mfma_f32_32x32x16_bf16(kf[2 * e + 1], qf[d0], p1, 0, 0, 0); } }
        }
        if (MODE == 1) {
            if (64 * t + 63 > qpos_wmin) {
#pragma unroll
                for (int r = 0; r < 16; ++r) { const int kv = 64 * t + crow(r, hi); if (kv > qpos) p0[r] = -INFINITY; if (kv + 32 > qpos) p1[r] = -INFINITY; }
            }
        }
        asm volatile("s_nop 15\n\ts_nop 7" : "+v"(p0), "+v"(p1));
        float rm;
        { float a, b;
#define MAX16(R, X) asm("v_max3_f32 %0, %1, %2, %3\n\tv_max3_f32 %0, %0, %4, %5\n\tv_max3_f32 %0, %0, %6, %7\n\tv_max3_f32 %0, %0, %8, %9\n\tv_max3_f32 %0, %0, %10, %11\n\tv_max3_f32 %0, %0, %12, %13\n\tv_max3_f32 %0, %0, %14, %15\n\tv_max_f32 %0, %0, %16" \
            : "=&v"(R) : "v"(X[0]), "v"(X[1]), "v"(X[2]), "v"(X[3]), "v"(X[4]), "v"(X[5]), "v"(X[6]), "v"(X[7]), "v"(X[8]), "v"(X[9]), "v"(X[10]), "v"(X[11]), "v"(X[12]), "v"(X[13]), "v"(X[14]), "v"(X[15]))
          MAX16(a, p0); MAX16(b, p1);
#undef MAX16
          const float m = max2f(a, b);
          const auto rr = __builtin_amdgcn_permlane32_swap(__float_as_uint(m), __float_as_uint(m), false, false);
          rm = max2f(__uint_as_float(rr[0]), __uint_as_float(rr[1])); }
        if (t == 0 || __any(rm > THR)) {
            const float dl = (t == 0) ? ((rm > -INFINITY) ? rm : 0.f) : fmaxf(rm, 0.f);
            mhat += dl;
#pragma unroll
            for (int r = 0; r < 16; ++r) { p0[r] -= dl; p1[r] -= dl; negm[r] = -mhat; }
            const float f = __builtin_amdgcn_exp2f(-dl);
#pragma unroll
            for (int d0 = 0; d0 < DV / 32; ++d0)
#pragma unroll
                for (int r = 0; r < 16; ++r) o[d0][r] *= f;
#pragma unroll
            for (int r = 0; r < 16; ++r) lacc[r] *= f;
        }
#pragma unroll
        for (int r = 0; r < 16; ++r) { p0[r] = __builtin_amdgcn_exp2f(p0[r]); p1[r] = __builtin_amdgcn_exp2f(p1[r]); }
#if MK_AX == 2
        if (MODE == 1) {
#pragma unroll
            for (int r = 0; r < 16; ++r) { float e0 = __builtin_amdgcn_exp2f(p0[r] * 0.999f), e1 = __builtin_amdgcn_exp2f(p1[r] * 0.999f); asm volatile("" :: "v"(e0), "v"(e1)); } }
#endif
        bf16x8 pb[4];
#pragma unroll
        for (int ks = 0; ks < 4; ++ks) {
            u32x4 w;
            if (ks < 2) { w.x = cvtpk(p0[8 * ks + 0], p0[8 * ks + 1]); w.y = cvtpk(p0[8 * ks + 2], p0[8 * ks + 3]); w.z = cvtpk(p0[8 * ks + 4], p0[8 * ks + 5]); w.w = cvtpk(p0[8 * ks + 6], p0[8 * ks + 7]); }
            else { const int k2 = ks - 2; w.x = cvtpk(p1[8 * k2 + 0], p1[8 * k2 + 1]); w.y = cvtpk(p1[8 * k2 + 2], p1[8 * k2 + 3]); w.z = cvtpk(p1[8 * k2 + 4], p1[8 * k2 + 5]); w.w = cvtpk(p1[8 * k2 + 6], p1[8 * k2 + 7]); }
            pb[ks] = __builtin_bit_cast(bf16x8, w);
        }
#pragma unroll
        for (int ks = 0; ks < 4; ++ks) lacc = __builtin_amdgcn_mfma_f32_32x32x16_bf16(ones, pb[ks], lacc, 0, 0, 0);
#pragma unroll
        for (int d0 = 0; d0 < DV / 32; ++d0)
#pragma unroll
            for (int ks = 0; ks < 4; ++ks) {
                const s16x4 lo = vtr(Vl + buf * VBUF + vb + (16 * ks) * VP + d0 * 64);
                const s16x4 hh = vtr(Vl + buf * VBUF + vb + (16 * ks + 8) * VP + d0 * 64);
                const bf16x8 a = (bf16x8){lo[0], lo[1], lo[2], lo[3], hh[0], hh[1], hh[2], hh[3]};
                o[d0] = __builtin_amdgcn_mfma_f32_32x32x16_bf16(a, pb[ks], o[d0], 0, 0, 0);
#if MK_AX == 1
                if (MODE == 1) dmy_ = __builtin_amdgcn_mfma_f32_32x32x16_bf16(a, pb[ks], dmy_, 0, 0, 0);
#endif
            }
        if (t + 1 < ntiles) A_LSTORE((t + 1) & 1);
        __syncthreads();
    }
#if MK_AX == 1
    asm volatile("" :: "v"(dmy_));
#endif
    l_out = lacc[0];
#undef A_GLOAD
#undef A_LSTORE
#undef KSWZ
}
template <int DV>
DEVI void store_oT(const f32x16 (&o)[DV / 32], float inv, bf16_t* dst, int hi) {
#pragma unroll
    for (int d0 = 0; d0 < DV / 32; ++d0)
#pragma unroll
        for (int g4 = 0; g4 < 4; ++g4) {
            u32x2 w; w.x = cvtpk(o[d0][4 * g4 + 0] * inv, o[d0][4 * g4 + 1] * inv); w.y = cvtpk(o[d0][4 * g4 + 2] * inv, o[d0][4 * g4 + 3] * inv);
            *(u32x2*)(dst + 32 * d0 + 8 * g4 + 4 * hi) = w;
        }
}

DEVI void attnA_unit(const Params& P, int b, int h, int c, int qb, LAS unsigned char* lds) {
    const int tid = tid_opaque(), lane = tid & 63, wave = tid >> 6, r32 = lane & 31, hi = lane >> 5;
    unsigned char* ws = P.ws;
    const bf16_t* proj = (const bf16_t*)(ws + WS_PROJ);
    const int q = qb * 256 + 32 * wave + r32; const size_t row = (size_t)b * S + q;
    bf16x8 qf[4];
#pragma unroll
    for (int d0 = 0; d0 < 4; ++d0) qf[d0] = *(const bf16x8*)(proj + row * LDP + C_QA + (2 * h + c) * 64 + 16 * d0 + 8 * hi);
    f32x16 o[4];
#pragma unroll
    for (int d0 = 0; d0 < 4; ++d0)
#pragma unroll
        for (int r = 0; r < 16; ++r) o[d0][r] = 0.f;
    float l_run = 0.f;
    attn_core<64, 128, 1>(o, l_run, qf, proj + (size_t)b * S * LDP + C_KA + (2 * h + c) * 64, LDP, proj + (size_t)b * S * LDP + C_VA + h * 128, LDP,
                          4 * (qb + 1), q, qb * 256 + 32 * wave, nullptr, lds, tid);
    const float lt = l_run;
    bf16_t* oa = (bf16_t*)(ws + WS_XB) + (size_t)c * T * 512 + row * 512 + h * 128;
    store_oT<128>(o, 1.f / lt, oa, hi);
}
namespace b64 {
constexpr int SLOTB = 8192, LDS_K = 0, LDS_V = 3 * SLOTB, LDS_M = 6 * SLOTB, LDS_WS = LDS_M + NWAVE * 768, LDS_OST = LDS_WS + NWAVE * 256;
typedef const LAS unsigned char* lptr;
#define B64_SBAR() __builtin_amdgcn_sched_barrier(0)
#define B64_PIN(x) asm volatile("" : "+v"(x))
#define B64_MFMA(a, b, c) __builtin_amdgcn_mfma_f32_32x32x16_bf16(a, b, c, 0, 0, 0)
#define B64_WAIT_BAR(N) asm volatile("s_waitcnt vmcnt(" #N ") lgkmcnt(0)\n\ts_barrier" ::: "memory")
DEVI int crow(int r, int hi) { return (r & 3) + 8 * (r >> 2) + 4 * hi; }
DEVI unsigned cvtpk_a(float lo, float hi) { unsigned r; asm("v_cvt_pk_bf16_f32 %0, %1, %2" : "=v"(r) : "v"(lo), "v"(hi)); return r; }
DEVI void glds16(const void* g, unsigned lds_base) {
    unsigned sv; asm volatile("s_mov_b32 %0, m0\n\ts_mov_b32 m0, %2\n\ts_nop 0\n\tglobal_load_lds_dwordx4 %1, off\n\ts_mov_b32 m0, %0" : "=&s"(sv) : "v"(g), "s"(lds_base) : "memory"); }
DEVI void glds4(const void* g, unsigned lds_base) {
    unsigned sv; asm volatile("s_mov_b32 %0, m0\n\ts_mov_b32 m0, %2\n\ts_nop 0\n\tglobal_load_lds_dword %1, off\n\ts_mov_b32 m0, %0" : "=&s"(sv) : "v"(g), "s"(lds_base) : "memory"); }
DEVI void kload2(bf16x8* kf, lptr kp, int d0) { kf[2 * d0] = *(const LAS bf16x8*)(kp + d0 * 2048); kf[2 * d0 + 1] = *(const LAS bf16x8*)(kp + d0 * 2048 + 512); }
#define B64_MX3(a, b, c) __builtin_fmaxf(__builtin_fmaxf((a), (b)), (c))
DEVI float rowmax(const f32x16& p0, const f32x16& p1) {
    float a = B64_MX3(p0[0], p0[1], p1[0]), b = B64_MX3(p0[2], p0[3], p1[1]); a = B64_MX3(a, p1[2], p1[3]);
#pragma unroll
    for (int r = 4; r < 16; r += 4) { a = B64_MX3(a, p0[r], p0[r + 1]); b = B64_MX3(b, p0[r + 2], p0[r + 3]); a = B64_MX3(a, p1[r], p1[r + 1]); b = B64_MX3(b, p1[r + 2], p1[r + 3]); }
    float m = __builtin_fmaxf(a, b); auto rr = __builtin_amdgcn_permlane32_swap(__float_as_uint(m), __float_as_uint(m), false, false);
    return __builtin_fmaxf(__uint_as_float(rr[0]), __uint_as_float(rr[1])); }
DEVI float cinit(unsigned w, int r, unsigned nm) { const unsigned s = (unsigned)__builtin_amdgcn_sbfe(w, (r & 3) + 8 * (r >> 2), 1); float d;
    asm("v_bfi_b32 %0, %1, %2, %3" : "=v"(d) : "v"(s), "v"(nm), "s"(0xFF800000u)); return d; }
DEVI void unit(int qb, const bf16_t* Q, int ldq, const bf16_t* __restrict__ K, const bf16_t* __restrict__ V, bf16_t* O, const u64* msk, LAS unsigned char* lds) {
    constexpr int DM = 1024; constexpr float THR = 8.f;
    const int tid = tid_opaque(), lane = tid & 63, r32 = lane & 31, hi = lane >> 5; const int wid = __builtin_amdgcn_readfirstlane(tid >> 6);
    const int q0 = qb * 256, NT = 4 * qb + 4;
    const bf16_t* Qw = Q + (size_t)(q0 + wid * 32) * ldq;
    const unsigned lds0 = (unsigned)(size_t)lds; LAS float* wsf = (LAS float*)(lds + LDS_WS) + wid * 64;
    const bf16_t* ksrc = K + (size_t)lane * DM + wid * 8;
    const bf16_t* vsrc = V + (size_t)(16 * (wid & 3) + (lane >> 2)) * DM + (wid >> 2) * 32 + (lane & 3) * 8;
    const unsigned* msrc = (const unsigned*)(msk + (size_t)(q0 + wid * 32 + (lane >> 1)) * 64) + (lane & 1);
    const unsigned kdst = lds0 + LDS_K + wid * 1024, vdst = lds0 + LDS_V + wid * 1024, mdst = lds0 + LDS_M + wid * 768;
#define DMA_K(t, slot) glds16(ksrc + (size_t)(t) * 64 * DM, (unsigned)__builtin_amdgcn_readfirstlane(kdst + (slot)))
#define DMA_V(t, slot) glds16(vsrc + (size_t)(t) * 64 * DM, (unsigned)__builtin_amdgcn_readfirstlane(vdst + (slot)))
#define DMA_M(t, slot) glds4(msrc + 2 * (t), (unsigned)__builtin_amdgcn_readfirstlane(mdst + ((slot) >> 5)))
    const lptr vp0 = (lptr)lds + LDS_V + ((lane >> 4) & 1) * 32 + (lane & 3) * 8 + (4 * hi + ((lane & 15) >> 2)) * 64;
    const lptr kp0 = (lptr)lds + LDS_K + hi * 1024 + r32 * 16;
    const lptr mp0 = (lptr)lds + LDS_M + wid * 768 + r32 * 8;
    DMA_M(0, 0); DMA_K(0, 0); DMA_V(0, 0); DMA_K(1, SLOTB); DMA_M(1, SLOTB);
    bf16x8 qr[4];
#pragma unroll
    for (int d0 = 0; d0 < 4; ++d0) qr[d0] = *(const bf16x8*)(Qw + (size_t)r32 * ldq + d0 * 16 + hi * 8);
    float mhat = 0.f, l_reg = 0.f; f32x16 o[2];
#pragma unroll
    for (int r = 0; r < 16; ++r) { o[0][r] = 0.f; o[1][r] = 0.f; }
    bool resc = false;
    f32x16 pA0, pA1, pB0, pB1; bf16x8 kf[8]; s16x4 vlo[8], vhi[8]; u32x4 pw0, pw1, pw2, pw3;
    int sl_prev = 0, sl_cur = 0, sl_next = SLOTB;
#define ROT() do { sl_prev = sl_cur; sl_cur = sl_next; sl_next = (sl_next == 2 * SLOTB) ? 0 : sl_next + SLOTB; } while (0)
#define EX(v) __builtin_amdgcn_exp2f(v)
#define RESC() do { if (resc) { _Pragma("unroll") for (int d_ = 0; d_ < 2; ++d_) _Pragma("unroll") for (int r = 0; r < 16; ++r) o[d_][r] *= wsf[crow(r, hi)]; } } while (0)
    DMA_K(2, 2 * SLOTB); DMA_M(2, 2 * SLOTB);
    B64_WAIT_BAR(4);
    _Pragma("unroll") for (int d0 = 0; d0 < 4; ++d0) kload2(kf, kp0, d0);
    { const u64 w = *(const LAS u64*)(mp0) >> (4 * hi); const unsigned wl = (unsigned)w, wh = (unsigned)(w >> 32);
#pragma unroll
      for (int r = 0; r < 16; ++r) { pA0[r] = cinit(wl, r, 0u); pA1[r] = cinit(wh, r, 0u); } }
    pA0 = B64_MFMA(kf[0], qr[0], pA0); pA1 = B64_MFMA(kf[1], qr[0], pA1); pA0 = B64_MFMA(kf[2], qr[1], pA0); pA1 = B64_MFMA(kf[3], qr[1], pA1);
    pA0 = B64_MFMA(kf[4], qr[2], pA0); pA1 = B64_MFMA(kf[5], qr[2], pA1); pA0 = B64_MFMA(kf[6], qr[3], pA0); pA1 = B64_MFMA(kf[7], qr[3], pA1);
    { const float rm = rowmax(pA0, pA1); mhat = (rm > -INFINITY) ? rm : 0.f;
#pragma unroll
      for (int r = 0; r < 16; ++r) { pA0[r] = EX(pA0[r] - mhat); pA1[r] = EX(pA1[r] - mhat); } }
    B64_WAIT_BAR(0);
    DMA_K(3, 0); DMA_M(3, 0); DMA_V(1, SLOTB); ROT();
    _Pragma("unroll") for (int d0 = 0; d0 < 4; ++d0) kload2(kf, kp0 + sl_cur, d0);
    { const u64 w = *(const LAS u64*)(mp0 + (sl_cur >> 5)) >> (4 * hi); const unsigned wl = (unsigned)w, wh = (unsigned)(w >> 32), nm = __float_as_uint(-mhat);
#pragma unroll
      for (int r = 0; r < 16; ++r) { pB0[r] = cinit(wl, r, nm); pB1[r] = cinit(wh, r, nm); } }
    B64_WAIT_BAR(3);
#define PKW(P, i) cvtpk_a(P[i], P[i + 1])
#define PAF(k) __builtin_bit_cast(bf16x8, pw##k)
#define VFR(i) (bf16x8){vlo[i][0], vlo[i][1], vlo[i][2], vlo[i][3], vhi[i][0], vhi[i][1], vhi[i][2], vhi[i][3]}
#define VRD(i) do { vlo[i] = vtr(vp_ + (((i) >> 2) * 4096 + ((i) & 3) * 1024)); vhi[i] = vtr(vp_ + (((i) >> 2) * 4096 + ((i) & 3) * 1024 + 512)); } while (0)
#define KRD(G, d0) do { if (G) { kload2(kf, kp0 + sl_next, d0); B64_SBAR(); } } while (0)
#define GAPA(MF, a0, a1, a2, a3, W0, W1, PW) do { MF; sacc += a0; sacc += a1; sacc += a2; sacc += a3; W0; W1; B64_PIN(PW); B64_PIN(sacc); B64_SBAR(); } while (0)
#define GAPB(MF, X, i, G, N, WN) do { MF; X[i] = EX(X[i]); X[i + 1] = EX(X[i + 1]); X[i + 2] = EX(X[i + 2]); X[i + 3] = EX(X[i + 3]); \
        if (G) { N[i] = cinit(WN, i, nm); N[i + 1] = cinit(WN, i + 1, nm); N[i + 2] = cinit(WN, i + 2, nm); N[i + 3] = cinit(WN, i + 3, nm); B64_PIN(N); } B64_PIN(X); B64_SBAR(); } while (0)
#define STEP(C0, C1, P0, P1, t, GK, GV, GL) do { B64_SBAR(); \
    const lptr vp_ = vp0 + sl_prev; \
    VRD(0); B64_SBAR(); float sacc = P0[0] + P0[1]; \
                        GAPA(C0 = B64_MFMA(kf[0], qr[0], C0), P0[2], P0[3], P0[4], P0[5],     pw0[0] = PKW(P0, 0),  pw0[1] = PKW(P0, 2),  pw0); \
    VRD(4); B64_SBAR(); GAPA(C1 = B64_MFMA(kf[1], qr[0], C1), P0[6], P0[7], P0[8], P0[9],     pw0[2] = PKW(P0, 4),  pw0[3] = PKW(P0, 6),  pw0); \
    VRD(1); B64_SBAR(); GAPA(C0 = B64_MFMA(kf[2], qr[1], C0), P0[10], P0[11], P0[12], P0[13], pw1[0] = PKW(P0, 8),  pw1[1] = PKW(P0, 10), pw1); \
    VRD(5); B64_SBAR(); GAPA(C1 = B64_MFMA(kf[3], qr[1], C1), P0[14], P0[15], P1[0], P1[1],   pw1[2] = PKW(P0, 12), pw1[3] = PKW(P0, 14), pw1); \
    VRD(2); B64_SBAR(); GAPA(C0 = B64_MFMA(kf[4], qr[2], C0), P1[2], P1[3], P1[4], P1[5],     pw2[0] = PKW(P1, 0),  pw2[1] = PKW(P1, 2),  pw2); \
    VRD(6); B64_SBAR(); GAPA(C1 = B64_MFMA(kf[5], qr[2], C1), P1[6], P1[7], P1[8], P1[9],     pw2[2] = PKW(P1, 4),  pw2[3] = PKW(P1, 6),  pw2); \
    VRD(3); B64_SBAR(); GAPA(C0 = B64_MFMA(kf[6], qr[3], C0), P1[10], P1[11], P1[12], P1[13], pw3[0] = PKW(P1, 8),  pw3[1] = PKW(P1, 10), pw3); \
    VRD(7); B64_SBAR(); GAPA(C1 = B64_MFMA(kf[7], qr[3], C1), P1[14], P1[15], 0.f, 0.f,       pw3[2] = PKW(P1, 12), pw3[3] = PKW(P1, 14), pw3); \
    l_reg += sacc; \
    if (GK) { DMA_K((t) + 3, sl_cur); DMA_M((t) + 3, sl_cur); } if (GV) DMA_V((t) + 1, sl_next); \
    { const float rm = rowmax(C0, C1); resc = false; \
      if (__builtin_expect(__any(rm > THR), 0)) { const float dl = __builtin_fmaxf(rm, 0.f); mhat += dl; \
          _Pragma("unroll") for (int r = 0; r < 16; ++r) { C0[r] -= dl; C1[r] -= dl; } \
          const float f = __builtin_amdgcn_exp2f(-dl); l_reg *= f; if (hi == 0) wsf[r32] = f; resc = true; } } \
    const unsigned nm = __float_as_uint(-mhat); unsigned wl_ = 0, wh_ = 0; \
    if (GL) { const u64 w = *(const LAS u64*)(mp0 + (sl_next >> 5)) >> (4 * hi); wl_ = (unsigned)w; wh_ = (unsigned)(w >> 32); } B64_SBAR(); \
    GAPB(o[0] = B64_MFMA(PAF(0), VFR(0), o[0]), C0, 0, GL, P0, wl_);              GAPB(o[1] = B64_MFMA(PAF(0), VFR(4), o[1]), C0, 4, GL, P0, wl_); \
    KRD(GL, 0); GAPB(o[0] = B64_MFMA(PAF(1), VFR(1), o[0]), C0, 8, GL, P0, wl_);  KRD(GL, 1); GAPB(o[1] = B64_MFMA(PAF(1), VFR(5), o[1]), C0, 12, GL, P0, wl_); \
    KRD(GL, 2); GAPB(o[0] = B64_MFMA(PAF(2), VFR(2), o[0]), C1, 0, GL, P1, wh_);  KRD(GL, 3); GAPB(o[1] = B64_MFMA(PAF(2), VFR(6), o[1]), C1, 4, GL, P1, wh_); \
    GAPB(o[0] = B64_MFMA(PAF(3), VFR(3), o[0]), C1, 8, GL, P1, wh_);              GAPB(o[1] = B64_MFMA(PAF(3), VFR(7), o[1]), C1, 12, GL, P1, wh_); \
    } while (0)
    int t = 1;
    for (; t + 5 < NT; t += 2) {
        STEP(pB0, pB1, pA0, pA1, t, true, true, true);     B64_WAIT_BAR(3); RESC(); ROT();
        STEP(pA0, pA1, pB0, pB1, t + 1, true, true, true); B64_WAIT_BAR(3); RESC(); ROT();
    }
#define ENDW(tt) do { if ((tt) + 3 < NT) { B64_WAIT_BAR(3); } else if ((tt) + 2 < NT) { B64_WAIT_BAR(1); } else { B64_WAIT_BAR(0); } } while (0)
    for (; t + 1 < NT; t += 2) {
        STEP(pB0, pB1, pA0, pA1, t, (t + 3 < NT), (t + 1 < NT), (t + 1 < NT));         ENDW(t);     RESC(); ROT();
        STEP(pA0, pA1, pB0, pB1, t + 1, (t + 4 < NT), (t + 2 < NT), (t + 2 < NT));     ENDW(t + 1); RESC(); ROT();
    }
    STEP(pB0, pB1, pA0, pA1, NT - 1, false, false, false); RESC();
    { float sacc = pB0[0] + pB0[1];
#pragma unroll
      for (int r = 2; r < 16; ++r) sacc += pB0[r];
#pragma unroll
      for (int r = 0; r < 16; ++r) sacc += pB1[r];
      l_reg += sacc;
      pw0 = (u32x4){PKW(pB0, 0), PKW(pB0, 2), PKW(pB0, 4), PKW(pB0, 6)}; pw1 = (u32x4){PKW(pB0, 8), PKW(pB0, 10), PKW(pB0, 12), PKW(pB0, 14)};
      pw2 = (u32x4){PKW(pB1, 0), PKW(pB1, 2), PKW(pB1, 4), PKW(pB1, 6)}; pw3 = (u32x4){PKW(pB1, 8), PKW(pB1, 10), PKW(pB1, 12), PKW(pB1, 14)};
      const lptr vp_ = vp0 + sl_cur; _Pragma("unroll") for (int i = 0; i < 8; ++i) VRD(i);
      o[0] = B64_MFMA(PAF(0), VFR(0), o[0]); o[1] = B64_MFMA(PAF(0), VFR(4), o[1]); o[0] = B64_MFMA(PAF(1), VFR(1), o[0]); o[1] = B64_MFMA(PAF(1), VFR(5), o[1]);
      o[0] = B64_MFMA(PAF(2), VFR(2), o[0]); o[1] = B64_MFMA(PAF(2), VFR(6), o[1]); o[0] = B64_MFMA(PAF(3), VFR(3), o[0]); o[1] = B64_MFMA(PAF(3), VFR(7), o[1]); }
    { auto rr = __builtin_amdgcn_permlane32_swap(__float_as_uint(l_reg), __float_as_uint(l_reg), false, false); l_reg = __uint_as_float(rr[0]) + __uint_as_float(rr[1]); }
    if (hi == 0) wsf[32 + r32] = l_reg; asm volatile("s_waitcnt lgkmcnt(0)" ::: "memory");
    float rli[16];
#pragma unroll
    for (int r = 0; r < 16; ++r) rli[r] = __builtin_amdgcn_rcpf(wsf[32 + crow(r, hi)]);
    bf16_t* Ow = O + (size_t)(q0 + wid * 32) * DM; LAS bf16_t* stg = (LAS bf16_t*)(lds + LDS_OST) + wid * 2048;
#pragma unroll
    for (int r = 0; r < 16; r += 2) { const int orow = crow(r, hi);
#pragma unroll
        for (int d0 = 0; d0 < 2; ++d0) { const unsigned pk = cvtpk(o[d0][r] * rli[r], o[d0][r + 1] * rli[r + 1]);
            stg[orow * 64 + d0 * 32 + r32] = (bf16_t)(pk & 0xFFFFu); stg[(orow + 1) * 64 + d0 * 32 + r32] = (bf16_t)(pk >> 16); } }
    asm volatile("s_waitcnt lgkmcnt(0)" ::: "memory");
#pragma unroll
    for (int i = 0; i < 4; ++i) { const int row = i * 8 + (lane >> 3), ch = lane & 7; *(u32x4*)(Ow + (size_t)row * DM + ch * 8) = *(const LAS u32x4*)(stg + row * 64 + ch * 8); }
    asm volatile("s_waitcnt lgkmcnt(0)\n\ts_barrier" ::: "memory");
#undef DMA_K
#undef DMA_V
#undef DMA_M
#undef ROT
#undef EX
#undef RESC
#undef PKW
#undef PAF
#undef VFR
#undef VRD
#undef KRD
#undef ENDW
#undef GAPA
#undef GAPB
#undef STEP
}
}
namespace a64 {
using b64::lptr; using b64::crow; using b64::cvtpk_a; using b64::glds16; using b64::kload2; using b64::rowmax;
constexpr int SLOTK = 8192, SLOTV = 16384, LDS_K = 0, LDS_V = 3 * SLOTK, LDS_WS = LDS_V + 3 * SLOTV, LDS_OST = LDS_WS + NWAVE * 256;
DEVI void glds16s(const void* base, unsigned off, unsigned lds_base) {
    unsigned sv; asm volatile("s_mov_b32 %0, m0\n\ts_mov_b32 m0, %3\n\ts_nop 0\n\tglobal_load_lds_dwordx4 %1, %2\n\ts_mov_b32 m0, %0" : "=&s"(sv) : "v"(off), "s"(base), "s"(lds_base) : "memory"); }
DEVI void cmask(f32x16& p0, f32x16& p1, int jb, int qrel, int hi) {
    const int kb = 64 * jb + 4 * hi;
#pragma unroll
    for (int r = 0; r < 16; ++r) { const int kv = kb + (r & 3) + 8 * (r >> 2); if (kv > qrel) p0[r] = -INFINITY; if (kv + 32 > qrel) p1[r] = -INFINITY; } }
DEVI void unit(int qb, const bf16_t* Q, const bf16_t* __restrict__ K, const bf16_t* __restrict__ V, int ld, bf16_t* O, int ldo, LAS unsigned char* lds) {
    constexpr float THR = 8.f;
    const int tid = tid_opaque(); int lane = tid & 63; asm volatile("" : "+v"(lane));
    const int r32 = lane & 31, hi = lane >> 5; const int wid = __builtin_amdgcn_readfirstlane(tid >> 6);
    const int q0 = qb * 256, NT = 4 * qb + 4;
    const bf16_t* Qw = Q + (size_t)(q0 + wid * 32) * ld;
    const unsigned lds0 = (unsigned)(size_t)lds; LAS float* wsf = (LAS float*)(lds + LDS_WS) + wid * 64;
    const unsigned koff = (unsigned)(lane * ld + wid * 8) * 2u;
    const unsigned voff = (unsigned)((16 * (wid & 3) + (lane >> 2)) * ld + (wid >> 2) * 32 + (lane & 3) * 8) * 2u;
    const unsigned tstep = (unsigned)(64 * ld) * 2u;
    const unsigned kdst = lds0 + LDS_K + wid * 1024, vdst = lds0 + LDS_V + wid * 1024;
#define DMA_K(t, slot) glds16s(K, koff + (unsigned)(t) * tstep, (unsigned)__builtin_amdgcn_readfirstlane(kdst + (slot)))
#define DMA_V(t, slot) do { const unsigned vo_ = voff + (unsigned)(t) * tstep; glds16s(V, vo_, (unsigned)__builtin_amdgcn_readfirstlane(vdst + 2 * (slot))); glds16s(V, vo_ + 128u, (unsigned)__builtin_amdgcn_readfirstlane(vdst + 2 * (slot) + 8192)); } while (0)
    const lptr vp0 = (lptr)lds + LDS_V + ((lane >> 4) & 1) * 32 + (lane & 3) * 8 + (4 * hi + ((lane & 15) >> 2)) * 64;
    const lptr kp0 = (lptr)lds + LDS_K + hi * 1024 + r32 * 16;
    DMA_K(0, 0); DMA_V(0, 0); DMA_K(1, SLOTK);
    const lptr qp0 = (lptr)lds + LDS_OST + wid * 8192 + lane * 16;
    bf16x8 qq[2];
    { bf16x8 qr[4];
#pragma unroll
      for (int d0 = 0; d0 < 4; ++d0) qr[d0] = *(const bf16x8*)(Qw + (size_t)r32 * ld + d0 * 16 + hi * 8);
#pragma unroll
      for (int d0 = 0; d0 < 4; ++d0) *(LAS bf16x8*)(lds + LDS_OST + wid * 8192 + lane * 16 + d0 * 1024) = qr[d0]; }
#define QRD(d0) qq[(d0) & 1] = *(const LAS bf16x8*)(qp0 + (d0) * 1024)
    float mhat = 0.f, l_reg = 0.f; f32x16 o[4];
#pragma unroll
    for (int r = 0; r < 16; ++r) { o[0][r] = 0.f; o[1][r] = 0.f; o[2][r] = 0.f; o[3][r] = 0.f; }
    const f32x16 zero16 = {0.f, 0.f, 0.f, 0.f, 0.f, 0.f, 0.f, 0.f, 0.f, 0.f, 0.f, 0.f, 0.f, 0.f, 0.f, 0.f};
    bool resc = false;
    f32x16 pA0, pA1, pB0, pB1; bf16x8 kf[8]; s16x4 vlo[4], vhi[4]; u32x4 pw0, pw1, pw2, pw3;
    int sl_prev = 0, sl_cur = 0, sl_next = SLOTK;
#define ROT() do { sl_prev = sl_cur; sl_cur = sl_next; sl_next = (sl_next == 2 * SLOTK) ? 0 : sl_next + SLOTK; } while (0)
#define EX(v) __builtin_amdgcn_exp2f((v) + nmh)
#define RESC() do { if (resc) { int ln_ = lane; asm volatile("" : "+v"(ln_)); const int hi_ = ln_ >> 5; _Pragma("unroll") for (int d_ = 0; d_ < 4; ++d_) _Pragma("unroll") for (int r = 0; r < 16; ++r) o[d_][r] *= wsf[crow(r, hi_)]; } } while (0)
    DMA_K(2, 2 * SLOTK);
    B64_WAIT_BAR(4);
    _Pragma("unroll") for (int d0 = 0; d0 < 4; ++d0) kload2(kf, kp0, d0);
    QRD(0); QRD(1);
    pA0 = B64_MFMA(kf[0], qq[0], zero16); pA1 = B64_MFMA(kf[1], qq[0], zero16); pA0 = B64_MFMA(kf[2], qq[1], pA0); pA1 = B64_MFMA(kf[3], qq[1], pA1); B64_SBAR();
    QRD(2); QRD(3);
    pA0 = B64_MFMA(kf[4], qq[0], pA0); pA1 = B64_MFMA(kf[5], qq[0], pA1); pA0 = B64_MFMA(kf[6], qq[1], pA0); pA1 = B64_MFMA(kf[7], qq[1], pA1); B64_SBAR();
    QRD(0); QRD(1);
    if (NT == 4) cmask(pA0, pA1, 0, wid * 32 + r32, hi);
    { mhat = rowmax(pA0, pA1); const float nmh = -mhat;
#pragma unroll
      for (int r = 0; r < 16; ++r) { pA0[r] = EX(pA0[r]); pA1[r] = EX(pA1[r]); } }
    B64_WAIT_BAR(0);
    DMA_K(3, 0); DMA_V(1, SLOTK); ROT();
    _Pragma("unroll") for (int d0 = 0; d0 < 4; ++d0) kload2(kf, kp0 + sl_cur, d0);
    B64_WAIT_BAR(3);
#define PKW(P, i) cvtpk_a(P[i], P[i + 1])
#define PAF(k) __builtin_bit_cast(bf16x8, pw##k)
#define VFR(i) (bf16x8){vlo[(i) & 3][0], vlo[(i) & 3][1], vlo[(i) & 3][2], vlo[(i) & 3][3], vhi[(i) & 3][0], vhi[(i) & 3][1], vhi[(i) & 3][2], vhi[(i) & 3][3]}
#define VRD(f) do { vlo[(f) & 3] = vtr(vp_ + (((f) & 3) * 4096 + ((f) >> 2) * 1024)); vhi[(f) & 3] = vtr(vp_ + (((f) & 3) * 4096 + ((f) >> 2) * 1024 + 512)); } while (0)
#define KRD(G, d0) do { if (G) { kload2(kf, kp0 + sl_next, d0); B64_SBAR(); } } while (0)
#define GAPA(MF, a0, a1, a2, a3, W0, W1, PW) do { MF; sacc += a0; sacc += a1; sacc += a2; sacc += a3; W0; W1; B64_PIN(PW); B64_PIN(sacc); B64_SBAR(); } while (0)
#define GAPB(g, kq, X, i) do { o[(g) & 3] = B64_MFMA(PAF(kq), VFR(g), o[(g) & 3]); X[i] = EX(X[i]); X[(i) + 1] = EX(X[(i) + 1]); B64_PIN(X); if ((g) < 12) VRD((g) + 4); B64_SBAR(); } while (0)
#define STEP(C0, C1, P0, P1, t, MASK, GK, GV, GL) do { B64_SBAR(); \
    const lptr vp_ = vp0 + 2 * sl_prev; \
    float sacc = P0[0] + P0[1]; \
                        GAPA(C0 = B64_MFMA(kf[0], qq[0], zero16), P0[2], P0[3], P0[4], P0[5],     pw0[0] = PKW(P0, 0),  pw0[1] = PKW(P0, 2),  pw0); \
                        GAPA(C1 = B64_MFMA(kf[1], qq[0], zero16), P0[6], P0[7], P0[8], P0[9],     pw0[2] = PKW(P0, 4),  pw0[3] = PKW(P0, 6),  pw0); \
    QRD(2); B64_SBAR(); GAPA(C0 = B64_MFMA(kf[2], qq[1], C0),     P0[10], P0[11], P0[12], P0[13], pw1[0] = PKW(P0, 8),  pw1[1] = PKW(P0, 10), pw1); \
                        GAPA(C1 = B64_MFMA(kf[3], qq[1], C1),     P0[14], P0[15], P1[0], P1[1],   pw1[2] = PKW(P0, 12), pw1[3] = PKW(P0, 14), pw1); \
    QRD(3); VRD(0); B64_SBAR(); GAPA(C0 = B64_MFMA(kf[4], qq[0], C0),     P1[2], P1[3], P1[4], P1[5],     pw2[0] = PKW(P1, 0),  pw2[1] = PKW(P1, 2),  pw2); \
    VRD(1); B64_SBAR(); GAPA(C1 = B64_MFMA(kf[5], qq[0], C1),     P1[6], P1[7], P1[8], P1[9],     pw2[2] = PKW(P1, 4),  pw2[3] = PKW(P1, 6),  pw2); \
    VRD(2); B64_SBAR(); GAPA(C0 = B64_MFMA(kf[6], qq[1], C0),     P1[10], P1[11], P1[12], P1[13], pw3[0] = PKW(P1, 8),  pw3[1] = PKW(P1, 10), pw3); \
    VRD(3); B64_SBAR(); GAPA(C1 = B64_MFMA(kf[7], qq[1], C1),     P1[14], P1[15], 0.f, 0.f,       pw3[2] = PKW(P1, 12), pw3[3] = PKW(P1, 14), pw3); \
    l_reg += sacc; \
    if (GK) DMA_K((t) + 3, sl_cur); if (GV) DMA_V((t) + 1, sl_next); \
    if (MASK) { int ln_ = lane; asm volatile("" : "+v"(ln_)); cmask(C0, C1, (t) - (NT - 4), wid * 32 + (ln_ & 31), ln_ >> 5); } \
    { const float rm = rowmax(C0, C1) - mhat; resc = false; \
      if (__builtin_expect(__any(rm > THR), 0)) { const float dl = __builtin_fmaxf(rm, 0.f); mhat += dl; \
          const float f = __builtin_amdgcn_exp2f(-dl); l_reg *= f; int ln_ = lane; asm volatile("" : "+v"(ln_)); if (ln_ < 32) wsf[ln_] = f; resc = true; } } \
    const float nmh = -mhat; B64_SBAR(); \
    GAPB(0, 0, C0, 0);  GAPB(1, 0, C0, 2);  GAPB(2, 0, C0, 4);   GAPB(3, 0, C0, 6); \
    GAPB(4, 1, C0, 8);  GAPB(5, 1, C0, 10); GAPB(6, 1, C0, 12);  GAPB(7, 1, C0, 14); \
    KRD(GL, 0); GAPB(8, 2, C1, 0);   KRD(GL, 1); GAPB(9, 2, C1, 2);   KRD(GL, 2); GAPB(10, 2, C1, 4);  KRD(GL, 3); GAPB(11, 2, C1, 6); \
    if (GL) { QRD(0); QRD(1); B64_SBAR(); } GAPB(12, 3, C1, 8); GAPB(13, 3, C1, 10); GAPB(14, 3, C1, 12); GAPB(15, 3, C1, 14); \
    } while (0)
    int t = 1;
    for (; t + 5 < NT; t += 2) {
        STEP(pB0, pB1, pA0, pA1, t, false, true, true, true);     B64_WAIT_BAR(3); RESC(); ROT();
        STEP(pA0, pA1, pB0, pB1, t + 1, false, true, true, true); B64_WAIT_BAR(3); RESC(); ROT();
    }
#define ENDW(tt) do { if ((tt) + 3 < NT) { B64_WAIT_BAR(3); } else if ((tt) + 2 < NT) { B64_WAIT_BAR(2); } else { B64_WAIT_BAR(0); } } while (0)
    for (; t + 1 < NT; t += 2) {
        STEP(pB0, pB1, pA0, pA1, t, true, (t + 3 < NT), (t + 1 < NT), (t + 1 < NT));         ENDW(t);     RESC(); ROT();
        STEP(pA0, pA1, pB0, pB1, t + 1, true, (t + 4 < NT), (t + 2 < NT), (t + 2 < NT));     ENDW(t + 1); RESC(); ROT();
    }
    STEP(pB0, pB1, pA0, pA1, NT - 1, true, false, false, false); RESC();
    { float sacc = pB0[0] + pB0[1];
#pragma unroll
      for (int r = 2; r < 16; ++r) sacc += pB0[r];
#pragma unroll
      for (int r = 0; r < 16; ++r) sacc += pB1[r];
      l_reg += sacc;
      pw0 = (u32x4){PKW(pB0, 0), PKW(pB0, 2), PKW(pB0, 4), PKW(pB0, 6)}; pw1 = (u32x4){PKW(pB0, 8), PKW(pB0, 10), PKW(pB0, 12), PKW(pB0, 14)};
      pw2 = (u32x4){PKW(pB1, 0), PKW(pB1, 2), PKW(pB1, 4), PKW(pB1, 6)}; pw3 = (u32x4){PKW(pB1, 8), PKW(pB1, 10), PKW(pB1, 12), PKW(pB1, 14)};
      const lptr vp_ = vp0 + 2 * sl_cur;
      _Pragma("unroll") for (int f = 0; f < 4; ++f) VRD(f);
      o[0] = B64_MFMA(PAF(0), VFR(0), o[0]); o[1] = B64_MFMA(PAF(0), VFR(1), o[1]); o[2] = B64_MFMA(PAF(0), VFR(2), o[2]); o[3] = B64_MFMA(PAF(0), VFR(3), o[3]); B64_SBAR();
      _Pragma("unroll") for (int f = 4; f < 8; ++f) VRD(f);
      o[0] = B64_MFMA(PAF(1), VFR(4), o[0]); o[1] = B64_MFMA(PAF(1), VFR(5), o[1]); o[2] = B64_MFMA(PAF(1), VFR(6), o[2]); o[3] = B64_MFMA(PAF(1), VFR(7), o[3]); B64_SBAR();
      _Pragma("unroll") for (int f = 8; f < 12; ++f) VRD(f);
      o[0] = B64_MFMA(PAF(2), VFR(8), o[0]); o[1] = B64_MFMA(PAF(2), VFR(9), o[1]); o[2] = B64_MFMA(PAF(2), VFR(10), o[2]); o[3] = B64_MFMA(PAF(2), VFR(11), o[3]); B64_SBAR();
      _Pragma("unroll") for (int f = 12; f < 16; ++f) VRD(f);
      o[0] = B64_MFMA(PAF(3), VFR(12), o[0]); o[1] = B64_MFMA(PAF(3), VFR(13), o[1]); o[2] = B64_MFMA(PAF(3), VFR(14), o[2]); o[3] = B64_MFMA(PAF(3), VFR(15), o[3]); }
    { auto rr = __builtin_amdgcn_permlane32_swap(__float_as_uint(l_reg), __float_as_uint(l_reg), false, false); l_reg = __uint_as_float(rr[0]) + __uint_as_float(rr[1]); }
    int lnE = lane; asm volatile("" : "+v"(lnE)); const int r32e = lnE & 31, hie = lnE >> 5;
    if (hie == 0) wsf[32 + r32e] = l_reg; asm volatile("s_waitcnt lgkmcnt(0)" ::: "memory");
    bf16_t* Ow = O + (size_t)(q0 + wid * 32) * ldo; LAS bf16_t* stg = (LAS bf16_t*)(lds + LDS_OST) + wid * 4096;
#pragma unroll
    for (int r = 0; r < 16; r += 2) { const int orow = crow(r, hie); const float i0 = __builtin_amdgcn_rcpf(wsf[32 + orow]), i1 = __builtin_amdgcn_rcpf(wsf[32 + orow + 1]);
#pragma unroll
        for (int d0 = 0; d0 < 4; ++d0) { const unsigned pk = cvtpk(o[d0][r] * i0, o[d0][r + 1] * i1);
            stg[orow * 128 + d0 * 32 + r32e] = (bf16_t)(pk & 0xFFFFu); stg[(orow + 1) * 128 + d0 * 32 + r32e] = (bf16_t)(pk >> 16); } }
    asm volatile("s_waitcnt lgkmcnt(0)" ::: "memory");
#pragma unroll
    for (int i = 0; i < 8; ++i) { const int row = i * 4 + (lnE >> 4), ch = lnE & 15; *(u32x4*)(Ow + (size_t)row * ldo + ch * 8) = *(const LAS u32x4*)(stg + row * 128 + ch * 8); }
    asm volatile("s_waitcnt lgkmcnt(0)\n\ts_barrier" ::: "memory");
#undef QRD
#undef DMA_K
#undef DMA_V
#undef ROT
#undef EX
#undef RESC
#undef PKW
#undef PAF
#undef VFR
#undef VRD
#undef KRD
#undef ENDW
#undef GAPA
#undef GAPB
#undef STEP
}
}
DEVI void attnB_unit(const Params& P, int b, int hd, int qb, LAS unsigned char* lds) {
    const int tid = tid_opaque(), lane = tid & 63, wave = tid >> 6, r32 = lane & 31, hi = lane >> 5;
    unsigned char* ws = P.ws;
    const bf16_t* proj = (const bf16_t*)(ws + WS_PROJ); const bf16_t* kbvb = (const bf16_t*)(ws + WS_KBVB);
    const int q = qb * 256 + 32 * wave + r32; const size_t row = (size_t)b * S + q;
    bf16x8 qf[4];
#pragma unroll
    for (int d0 = 0; d0 < 4; ++d0) qf[d0] = *(const bf16x8*)(proj + row * LDP + C_QB + hd * 64 + 16 * d0 + 8 * hi);
    f32x16 o[2];
#pragma unroll
    for (int d0 = 0; d0 < 2; ++d0)
#pragma unroll
        for (int r = 0; r < 16; ++r) o[d0][r] = 0.f;
    float l_run = 0.f;
    attn_core<64, 64, 2>(o, l_run, qf, kbvb + (size_t)b * S * 1024 + hd * 64, 1024, kbvb + (size_t)b * S * 1024 + 512 + hd * 64, 1024,
                         4 * (qb + 1), q, qb * 256 + 32 * wave, (const u64*)(ws + WS_MASK) + row * 64, lds, tid);
    const float lt = l_run;
    store_oT<64>(o, 1.f / lt, (bf16_t*)(ws + WS_Y) + row * 1024 + 512 + hd * 64, hi);
}
DEVI void xattn_unit(const Params& P, int l, int b, int hd, int qb, LAS unsigned char* lds) {
    const int tid = tid_opaque(), lane = tid & 63, wave = tid >> 6, r32 = lane & 31, hi = lane >> 5;
    unsigned char* ws = P.ws;
    const bf16_t* qx = (const bf16_t*)(ws + WS_QX); const bf16_t* kvx = (const bf16_t*)(ws + WS_KVX) + l * 1024;
    const int q = qb * 256 + 32 * wave + r32; const size_t row = (size_t)b * S + q;
    const float* gq = P.in[9] + l * 128;
    u32x4 raw[8]; float ss = 0.f;
    f32x4 gqv[8][2];
#pragma unroll
    for (int d0 = 0; d0 < 8; ++d0) { raw[d0] = *(const u32x4*)(qx + row * 512 + hd * 128 + 16 * d0 + 8 * hi); gqv[d0][0] = *(const f32x4*)(gq + 16 * d0 + 8 * hi); gqv[d0][1] = *(const f32x4*)(gq + 16 * d0 + 8 * hi + 4); }
#pragma unroll
    for (int d0 = 0; d0 < 8; ++d0) {
#pragma unroll
        for (int j = 0; j < 4; ++j) { const float a = lo16(raw[d0][j]), bq = hi16(raw[d0][j]); ss += a * a + bq * bq; } }
    ss += __shfl_xor(ss, 32);
    const float rs = rsqrtf(ss * (1.f / 128.f) + EPS) * (0.08838834764831845f * LOG2E);
    bf16x8 qf[8];
#pragma unroll
    for (int d0 = 0; d0 < 8; ++d0) { u32x4 w;
#pragma unroll
        for (int j = 0; j < 4; ++j) w[j] = cvtpk(lo16(raw[d0][j]) * rs * gqv[d0][j >> 1][(2 * j) & 3], hi16(raw[d0][j]) * rs * gqv[d0][j >> 1][(2 * j + 1) & 3]);
        qf[d0] = __builtin_bit_cast(bf16x8, w); }
    f32x16 o[4];
#pragma unroll
    for (int d0 = 0; d0 < 4; ++d0)
#pragma unroll
        for (int r = 0; r < 16; ++r) o[d0][r] = 0.f;
    float l_run = 0.f;
#if MK_XA2
    attn_core<128, 128, 0>(o, l_run, qf, kvx + (size_t)b * MEML * 2048 + hd * 128, 2048, kvx + (size_t)b * MEML * 2048 + 512 + hd * 128, 2048, MEML / 64, q, 0, nullptr, lds, tid);
#pragma unroll
    for (int d0 = 0; d0 < 4; ++d0)
#pragma unroll
        for (int r = 0; r < 16; ++r) o[d0][r] = 0.f;
    l_run = 0.f;
#endif
    attn_core<128, 128, 0>(o, l_run, qf, kvx + (size_t)b * MEML * 2048 + hd * 128, 2048, kvx + (size_t)b * MEML * 2048 + 512 + hd * 128, 2048,
                           MEML / 64, q, 0, nullptr, lds, tid);
    const float lt = l_run;
    store_oT<128>(o, 1.f / lt, (bf16_t*)(ws + WS_YX) + row * 512 + hd * 128, hi);
}

DEVI void xattn_fused_unit(const Params& P, int l, int b, int hd, int qb, LAS unsigned char* lds) {
    const int tid = tid_opaque(), lane = tid & 63, wave = tid >> 6, r32 = lane & 31, hi = lane >> 5;
    unsigned char* ws = P.ws;
    const bf16_t* kvx = (const bf16_t*)(ws + WS_KVX) + l * 1024;
    const int q = qb * 256 + 32 * wave + r32; const size_t row = (size_t)b * S + q;
    const bf16_t* Wh = (const bf16_t*)(ws + W_QX) + (size_t)l * 512 * 1024 + (size_t)(hd * 128) * 1024;
    const float ssqx = ((const float*)(ws + WS_SSQ))[(size_t)(l ? 4 : 1) * T + row];
    const float* gq = P.in[9] + l * 128;
#if MK_TPROBE >= 30
    unsigned long long tsx_[5]; tsx_[0] = __builtin_amdgcn_s_memtime();
#endif
    f32x16 acc[4];
#pragma unroll
    for (int blk = 0; blk < 4; ++blk)
#pragma unroll
        for (int r = 0; r < 16; ++r) acc[blk][r] = 0.f;
    u32x4 wa[2], wb[2], xr[4];
    const bf16_t* Xb = (const bf16_t*)(ws + WS_XB) + ((size_t)b * S + qb * 256) * 1024;
    LAS unsigned char* XL = lds + 49152;
#define XF_WLOAD(W_, s) do { _Pragma("unroll") for (int i_ = 0; i_ < 2; ++i_) { const int c_ = tid + NTHR * i_; W_[i_] = *(const u32x4*)(Wh + (size_t)(c_ >> 3) * 1024 + 64 * (s) + (c_ & 7) * 8); } } while (0)
#define XF_WSTORE(W_, buf) do { _Pragma("unroll") for (int i_ = 0; i_ < 2; ++i_) { const int c_ = tid + NTHR * i_, row_ = c_ >> 3, ch_ = c_ & 7; *(LAS u32x4*)(lds + (buf) * 16384 + row_ * 128 + ((ch_ ^ ((row_ >> 1) & 7)) << 4)) = W_[i_]; } } while (0)
#define XF_XLOAD(s) do { _Pragma("unroll") for (int i_ = 0; i_ < 4; ++i_) { const int c_ = tid + NTHR * i_; xr[i_] = *(const u32x4*)(Xb + (size_t)(c_ >> 3) * 1024 + 64 * (s) + (c_ & 7) * 8); } } while (0)
#define XF_XSTORE(buf) do { _Pragma("unroll") for (int i_ = 0; i_ < 4; ++i_) { const int c_ = tid + NTHR * i_, row_ = c_ >> 3, ch_ = c_ & 7; *(LAS u32x4*)(XL + (buf) * 32768 + row_ * 128 + ((ch_ ^ ((row_ >> 1) & 7)) << 4)) = xr[i_]; } } while (0)
#define XF_MMA(wbuf, xbuf) do { bf16x8 wf_[4][4], xq_[4];        \
        _Pragma("unroll") for (int ks = 0; ks < 4; ++ks) { const int xrow = 32 * wave + r32, ch = 2 * ks + hi; \
            xq_[ks] = *(LAS const bf16x8*)(XL + (xbuf) * 32768 + xrow * 128 + ((ch ^ ((xrow >> 1) & 7)) << 4)); \
            _Pragma("unroll") for (int blk = 0; blk < 4; ++blk) { const int rw = 32 * blk + r32; \
                wf_[ks][blk] = *(LAS const bf16x8*)(lds + (wbuf) * 16384 + rw * 128 + ((ch ^ ((rw >> 1) & 7)) << 4)); } } \
        asm volatile("s_waitcnt lgkmcnt(0)" ::: "memory"); __builtin_amdgcn_sched_barrier(0); \
        _Pragma("unroll") for (int ks = 0; ks < 4; ++ks) _Pragma("unroll") for (int blk = 0; blk < 4; ++blk) acc[blk] = __builtin_amdgcn_mfma_f32_32x32x16_bf16(wf_[ks][blk], xq_[ks], acc[blk], 0, 0, 0); \
        __builtin_amdgcn_sched_barrier(0); } while (0)
    XF_WLOAD(wa, 0); XF_WLOAD(wb, 1); XF_XLOAD(0);
    XF_WSTORE(wa, 0); XF_WSTORE(wb, 1); XF_XSTORE(0); __syncthreads();
    for (int s = 0; s < 16; s += 2) {
        if (s + 2 < 16) XF_WLOAD(wa, s + 2);
        XF_XLOAD(s + 1);
        XF_MMA(s % 3, 0);
        if (s + 2 < 16) XF_WSTORE(wa, (s + 2) % 3);
        XF_XSTORE(1);
        __syncthreads();
        if (s + 3 < 16) XF_WLOAD(wb, s + 3);
        if (s + 2 < 16) XF_XLOAD(s + 2);
        XF_MMA((s + 1) % 3, 1);
        if (s + 3 < 16) XF_WSTORE(wb, (s + 3) % 3);
        if (s + 2 < 16) XF_XSTORE(0);
        __syncthreads();
    }
#undef XF_WLOAD
#undef XF_WSTORE
#undef XF_XLOAD
#undef XF_XSTORE
#undef XF_MMA
#if MK_TPROBE >= 30
    asm volatile("s_waitcnt vmcnt(0) lgkmcnt(0)" ::: "memory"); tsx_[1] = __builtin_amdgcn_s_memtime();
#endif
    f32x4 gqv[4][4];
#pragma unroll
    for (int blk = 0; blk < 4; ++blk)
#pragma unroll
        for (int g4 = 0; g4 < 4; ++g4) gqv[blk][g4] = *(const f32x4*)(gq + 32 * blk + 8 * g4 + 4 * hi);
    float ss = 0.f;
#pragma unroll
    for (int blk = 0; blk < 4; ++blk)
#pragma unroll
        for (int r = 0; r < 16; ++r) ss += acc[blk][r] * acc[blk][r];
    { const auto sw = __builtin_amdgcn_permlane32_swap(__float_as_uint(ss), __float_as_uint(ss), false, false); ss = __uint_as_float(sw[0]) + __uint_as_float(sw[1]); }
    const float c = rsqrtf(ssqx * (1.f / 1024.f) + EPS);
    const float f = c * rsqrtf(c * c * ss * (1.f / 128.f) + EPS) * (0.08838834764831845f * LOG2E);
    bf16x8 qf[8];
#pragma unroll
    for (int blk = 0; blk < 4; ++blk)
#pragma unroll
        for (int e = 0; e < 2; ++e) { u32x4 w;
#pragma unroll
            for (int jj = 0; jj < 4; ++jj) { const int r0 = 8 * e + 2 * jj;
                w[jj] = cvtpk(acc[blk][r0] * f * gqv[blk][r0 >> 2][r0 & 3], acc[blk][r0 + 1] * f * gqv[blk][r0 >> 2][(r0 & 3) + 1]); }
            qf[2 * blk + e] = __builtin_bit_cast(bf16x8, w); }
    f32x16 o[4];
#pragma unroll
    for (int d0 = 0; d0 < 4; ++d0)
#pragma unroll
        for (int r = 0; r < 16; ++r) o[d0][r] = 0.f;
    float l_run = 0.f;
#if MK_TPROBE >= 30
    asm volatile("s_waitcnt vmcnt(0) lgkmcnt(0)" ::: "memory"); tsx_[2] = __builtin_amdgcn_s_memtime();
#endif
    attn_core<128, 128, 0, true>(o, l_run, qf, kvx + (size_t)b * MEML * 2048 + hd * 128, 2048, kvx + (size_t)b * MEML * 2048 + 512 + hd * 128, 2048,
                                 MEML / 64, q, 0, nullptr, lds, tid);
#if MK_TPROBE >= 30
    asm volatile("s_waitcnt vmcnt(0) lgkmcnt(0)" ::: "memory"); tsx_[3] = __builtin_amdgcn_s_memtime();
#endif
    store_oT<128>(o, 1.f / l_run, (bf16_t*)(ws + WS_YX) + row * 512 + hd * 128, hi);
#if MK_TPROBE >= 30
    asm volatile("s_waitcnt vmcnt(0) lgkmcnt(0)" ::: "memory"); tsx_[4] = __builtin_amdgcn_s_memtime();
    if (blockIdx.x == 0 && tid == 0 && l == 0) { unsigned long long* TS = (unsigned long long*)(ws + WS_BAR + 65536); for (int k = 0; k < 4; ++k) atomicAdd(TS + 16 + k, tsx_[k + 1] - tsx_[k]); atomicAdd(TS + 20, tsx_[4] - tsx_[0]); }
#endif
}

#define DPP_STEP4(OP, v) do { v = OP(v, __builtin_amdgcn_update_dpp(v, v, 0xB1, 0xF, 0xF, false)); v = OP(v, __builtin_amdgcn_update_dpp(v, v, 0x4E, 0xF, 0xF, false)); \
        v = OP(v, __builtin_amdgcn_update_dpp(v, v, 0x141, 0xF, 0xF, false)); v = OP(v, __builtin_amdgcn_update_dpp(v, v, 0x140, 0xF, 0xF, false)); } while (0)
DEVI unsigned umax2(unsigned a, unsigned b) { return a > b ? a : b; }
DEVI unsigned umin2(unsigned a, unsigned b) { return a < b ? a : b; }
DEVI unsigned wave_max_u32(unsigned v) { DPP_STEP4(umax2, v);
    const auto a = __builtin_amdgcn_permlane16_swap(v, v, false, false); v = umax2(a[0], a[1]);
    const auto b = __builtin_amdgcn_permlane32_swap(v, v, false, false); return umax2(b[0], b[1]); }
DEVI unsigned wave_min_u32(unsigned v) { DPP_STEP4(umin2, v);
    const auto a = __builtin_amdgcn_permlane16_swap(v, v, false, false); v = umin2(a[0], a[1]);
    const auto b = __builtin_amdgcn_permlane32_swap(v, v, false, false); return umin2(b[0], b[1]); }
DEVI float row16_sum(float s) {
    s += __builtin_bit_cast(float, __builtin_amdgcn_update_dpp(0, __builtin_bit_cast(int, s), 0xB1, 0xF, 0xF, false)); s += __builtin_bit_cast(float, __builtin_amdgcn_update_dpp(0, __builtin_bit_cast(int, s), 0x4E, 0xF, 0xF, false));
    s += __builtin_bit_cast(float, __builtin_amdgcn_update_dpp(0, __builtin_bit_cast(int, s), 0x141, 0xF, 0xF, false)); s += __builtin_bit_cast(float, __builtin_amdgcn_update_dpp(0, __builtin_bit_cast(int, s), 0x140, 0xF, 0xF, false));
    return s; }
DEVI int wave_sum_dpp(int v) {
    v += __builtin_amdgcn_update_dpp(0, v, 0xB1, 0xF, 0xF, false);
    v += __builtin_amdgcn_update_dpp(0, v, 0x4E, 0xF, 0xF, false);
    v += __builtin_amdgcn_update_dpp(0, v, 0x141, 0xF, 0xF, false);
    v += __builtin_amdgcn_update_dpp(0, v, 0x140, 0xF, 0xF, false);
    return (__builtin_amdgcn_readlane(v, 0) + __builtin_amdgcn_readlane(v, 16)) + (__builtin_amdgcn_readlane(v, 32) + __builtin_amdgcn_readlane(v, 48));
}
constexpr int IDX_SROW = 4096 + 64;
DEVI void indexer_unit(const Params& P, int b, int t0, LAS unsigned char* lds) {
    const int tid = tid_opaque(), lane = tid & 63, wave = __builtin_amdgcn_readfirstlane(tid >> 6), r32 = lane & 31, hi = lane >> 5;
    unsigned char* ws = P.ws;
    const bf16_t* proj = (const bf16_t*)(ws + WS_PROJ); const float* WI = (const float*)(ws + WS_WI);
    LAS float* Ssc = (LAS float*)lds;
    for (int rs_ = 0; rs_ < 1 + MK_SC2; ++rs_)
    if (t0 + 7 >= 255) {
        bf16x8 af[4];
        { const int qq = r32 >> 2, hh = r32 & 3; const size_t row = (size_t)b * S + t0 + qq;
#pragma unroll
          for (int d0 = 0; d0 < 4; ++d0) af[d0] = *(const bf16x8*)(proj + row * LDP + C_QI + hh * 64 + 16 * d0 + 8 * hi); }
        float wv[16];
#pragma unroll
        for (int r = 0; r < 16; ++r) wv[r] = WI[((size_t)b * S + t0 + 2 * (r >> 2) + hi) * 4 + (r & 3)];
        const int nkt = (t0 + 8 + 31) / 32;
        const bf16_t* kbase = (const bf16_t*)(ws + WS_KI) + (size_t)(b * (S / 32)) * 2048 + lane * 8;
        bf16x8 kb0[4], kb1[4], kb2[4], kb3[4];
#define IDX_LOAD(B, kt_) do { const int k_ = ((kt_) < nkt) ? (kt_) : (nkt - 1); _Pragma("unroll") for (int d0 = 0; d0 < 4; ++d0) B[d0] = *(const bf16x8*)(kbase + (size_t)k_ * 2048 + d0 * 512); } while (0)
#define IDX_COMP(B, kt_) do { f32x16 c; _Pragma("unroll") for (int r = 0; r < 16; ++r) c[r] = 0.f; \
            _Pragma("unroll") for (int d0 = 0; d0 < 4; ++d0) c = __builtin_amdgcn_mfma_f32_32x32x16_bf16(af[d0], B[d0], c, 0, 0, 0); \
            const int key = (kt_) * 32 + r32; \
            _Pragma("unroll") for (int g4 = 0; g4 < 4; ++g4) { float s = 0.f; \
                _Pragma("unroll") for (int hh = 0; hh < 4; ++hh) s += fmaxf(c[4 * g4 + hh], 0.f) * wv[4 * g4 + hh]; \
                if ((kt_) == nkt - 1 && key > t0 + 2 * g4 + hi) s = -INFINITY;        \
                Ssc[(2 * g4 + hi) * IDX_SROW + key + (key >> 6)] = s; } } while (0)
#define IDX_FENCE() asm volatile("" ::: "memory")
        IDX_LOAD(kb0, wave); IDX_LOAD(kb1, wave + NWAVE); IDX_LOAD(kb2, wave + 2 * NWAVE); IDX_FENCE();
        for (int kt = wave; kt < nkt; kt += 4 * NWAVE) {
            IDX_LOAD(kb3, kt + 3 * NWAVE); IDX_FENCE(); IDX_COMP(kb0, kt); IDX_FENCE();
            if (kt + NWAVE >= nkt) break;
            IDX_LOAD(kb0, kt + 4 * NWAVE); IDX_FENCE(); IDX_COMP(kb1, kt + NWAVE); IDX_FENCE();
            if (kt + 2 * NWAVE >= nkt) break;
            IDX_LOAD(kb1, kt + 5 * NWAVE); IDX_FENCE(); IDX_COMP(kb2, kt + 2 * NWAVE); IDX_FENCE();
            if (kt + 3 * NWAVE >= nkt) break;
            IDX_LOAD(kb2, kt + 6 * NWAVE); IDX_FENCE(); IDX_COMP(kb3, kt + 3 * NWAVE); IDX_FENCE();
        }
#undef IDX_FENCE
#undef IDX_LOAD
#undef IDX_COMP
        if ((nkt & 1) && lane < 32) { const int key = nkt * 32 + lane; Ssc[wave * IDX_SROW + key + (key >> 6)] = -INFINITY; }
        if (wave == 0) Ssc[8 * IDX_SROW + lane] = -INFINITY;
    }
    __syncthreads();
    for (int rr_ = 0; rr_ < 1 + MK_SEL2; ++rr_) {
        const int t = t0 + wave; u64 myw = 0ull;
#if MK_TPROBE
        unsigned long long ts0_ = __builtin_amdgcn_s_memtime(), ts1_ = ts0_, ts2_ = ts0_;
#endif
        if (t >= 255) {
            unsigned u[64];
            { const LAS float* srow = (64 * lane <= t) ? (Ssc + wave * IDX_SROW + 65 * lane) : (Ssc + 8 * IDX_SROW);
#pragma unroll
              for (int j = 0; j < 64; ++j) { const unsigned bits = __float_as_uint(srow[j]);
                  u[j] = bits ^ ((unsigned)((int)bits >> 31) | 0x80000000u); } }
            unsigned a32[32], a16[16], a8[8], a4[4];
#pragma unroll
            for (int i = 0; i < 32; ++i) a32[i] = max(u[2 * i], u[2 * i + 1]);
#pragma unroll
            for (int i = 0; i < 16; ++i) a16[i] = max(a32[2 * i], a32[2 * i + 1]);
#pragma unroll
            for (int i = 0; i < 8; ++i) a8[i] = max(a16[2 * i], a16[2 * i + 1]);
#pragma unroll
            for (int i = 0; i < 4; ++i) a4[i] = max(a8[2 * i], a8[2 * i + 1]);
            unsigned Mx = max(max(a4[0], a4[1]), max(a4[2], a4[3])), Lx = 0xffffffffu;
            { const int nfull = __builtin_amdgcn_readfirstlane((t + 1) >> 6); int nl;
              if (nfull >= 64) { nl = 64; Lx = min(min(a4[0], a4[1]), min(a4[2], a4[3])); }
              else if (nfull >= 32) { nl = 32;
#pragma unroll
                  for (int i = 0; i < 8; ++i) Lx = min(Lx, a8[i]); }
              else if (nfull >= 16) { nl = 16;
#pragma unroll
                  for (int i = 0; i < 16; ++i) Lx = min(Lx, a16[i]); }
              else if (nfull >= 8) { nl = 8;
#pragma unroll
                  for (int i = 0; i < 32; ++i) Lx = min(Lx, a32[i]); }
              else { nl = 4;
#pragma unroll
                  for (int j = 0; j < 64; ++j) Lx = min(Lx, u[j]); }
              if (lane >= nl) Lx = 0xffffffffu;
              Mx = wave_max_u32(Mx); Lx = wave_min_u32(Lx); }
            Mx = __builtin_amdgcn_readfirstlane(Mx); Lx = __builtin_amdgcn_readfirstlane(Lx);
#if MK_TPROBE
            asm volatile("s_waitcnt vmcnt(0) lgkmcnt(0)" ::: "memory"); ts1_ = __builtin_amdgcn_s_memtime();
#endif
            { const unsigned lxm1 = Lx - 1u;
#pragma unroll
              for (int j = 0; j < 64; ++j) u[j] = __builtin_elementwise_sub_sat(u[j], lxm1); }
            unsigned prefix = 0u; bool exact = false;
            for (int rb_ = 0; rb_ < 1 + MK_BIS2; ++rb_) { prefix = 0u; exact = false;
            for (int bit = 31 - __builtin_clz(Mx - Lx + 1u); bit >= 0; --bit) {
                const unsigned cand = prefix | (1u << bit); int c0 = 0, c1 = 0, c2 = 0, c3 = 0;
#define IDX_CNT8(j0) asm volatile( \
                    "v_cmp_le_u32 vcc, %10, %2\n\tv_addc_co_u32 %0, vcc, 0, %0, vcc\n\tv_cmp_le_u32 vcc, %10, %3\n\tv_addc_co_u32 %1, vcc, 0, %1, vcc\n\t" \
                    "v_cmp_le_u32 vcc, %10, %4\n\tv_addc_co_u32 %0, vcc, 0, %0, vcc\n\tv_cmp_le_u32 vcc, %10, %5\n\tv_addc_co_u32 %1, vcc, 0, %1, vcc\n\t" \
                    "v_cmp_le_u32 vcc, %10, %6\n\tv_addc_co_u32 %0, vcc, 0, %0, vcc\n\tv_cmp_le_u32 vcc, %10, %7\n\tv_addc_co_u32 %1, vcc, 0, %1, vcc\n\t" \
                    "v_cmp_le_u32 vcc, %10, %8\n\tv_addc_co_u32 %0, vcc, 0, %0, vcc\n\tv_cmp_le_u32 vcc, %10, %9\n\tv_addc_co_u32 %1, vcc, 0, %1, vcc" \
                    : "+v"(c0), "+v"(c1) \
                    : "v"(u[(j0)]), "v"(u[(j0) + 1]), "v"(u[(j0) + 2]), "v"(u[(j0) + 3]), "v"(u[(j0) + 4]), "v"(u[(j0) + 5]), "v"(u[(j0) + 6]), "v"(u[(j0) + 7]), "v"(candv) : "vcc")
                const unsigned candv = cand;
                IDX_CNT8(0); IDX_CNT8(8); IDX_CNT8(16); IDX_CNT8(24); IDX_CNT8(32); IDX_CNT8(40); IDX_CNT8(48); IDX_CNT8(56);
#undef IDX_CNT8
                c2 = 0; c3 = 0;
                const int cnt = wave_sum_dpp((c0 + c1) + (c2 + c3));
                if (cnt >= 256) prefix = cand;
                if (cnt == 256) { exact = true; break; }
            }
            }
#if MK_TPROBE
            asm volatile("s_waitcnt vmcnt(0) lgkmcnt(0)" ::: "memory"); ts2_ = __builtin_amdgcn_s_memtime();
#endif
            unsigned mlo = 0u, mhi = 0u;
            if (exact) {
#pragma unroll
                for (int j = 31; j >= 0; --j) asm volatile("v_cmp_le_u32 vcc, %4, %2\n\tv_addc_co_u32 %0, vcc, %0, %0, vcc\n\tv_cmp_le_u32 vcc, %4, %3\n\tv_addc_co_u32 %1, vcc, %1, %1, vcc"
                                                           : "+v"(mlo), "+v"(mhi) : "v"(u[j]), "v"(u[32 + j]), "v"(prefix) : "vcc");
            } else {
                int ngt = 0, nti = 0;
#pragma unroll
                for (int j = 0; j < 64; ++j) { ngt += (u[j] > prefix) ? 1 : 0; nti += (u[j] == prefix) ? 1 : 0; }
                const int need = 256 - (int)wave_sum((float)ngt);
                int incl = nti;
#pragma unroll
                for (int o = 1; o < 64; o <<= 1) { const int v = __shfl_up(incl, o); if (lane >= o) incl += v; }
                int running = incl - nti;
#pragma unroll
                for (int j = 0; j < 64; ++j) {
                    const bool tie = (u[j] == prefix);
                    const unsigned sel = ((u[j] > prefix) || (tie && running < need)) ? 1u : 0u;
                    running += tie ? 1 : 0;
                    if (j < 32) mlo |= sel << j; else mhi |= sel << (j - 32);
                }
            }
            myw = ((u64)mhi << 32) | mlo;
        } else {
            const int lo = 64 * lane;
            if (lo + 63 <= t) myw = ~0ull; else if (lo > t) myw = 0ull; else myw = (~0ull) >> (63 - (t - lo));
        }
        ((u64*)(ws + WS_MASK))[((size_t)b * S + t) * 64 + lane] = myw;
#if MK_TPROBE
        { asm volatile("s_waitcnt vmcnt(0) lgkmcnt(0)" ::: "memory"); const unsigned long long ts3_ = __builtin_amdgcn_s_memtime();
          if (blockIdx.x == 0 && wave == 0 && lane == 0 && t >= 255) { unsigned long long* TS = (unsigned long long*)(ws + WS_BAR + 65536);
              atomicAdd(TS + 0, ts1_ - ts0_); atomicAdd(TS + 1, ts2_ - ts1_); atomicAdd(TS + 2, ts3_ - ts2_); atomicAdd(TS + 3, ts3_ - ts0_); } }
#endif
    }
    __syncthreads();
}

DEVI void combineA_rows(const Params& P) {
    const int tid = tid_opaque(), lane = tid & 63, wave = tid >> 6;
    const int gw = blockIdx.x * NWAVE + wave, NGW = gridDim.x * NWAVE;
    unsigned char* ws = P.ws;
    const float d1 = wave_sum(P.in[17][lane] * P.in[18][lane]), d2 = wave_sum(P.in[19][lane] * P.in[20][lane]);
    const float lam_init = 0.2f, lam = expf(d1) - expf(d2) + lam_init;
    const bf16_t* o0 = (const bf16_t*)(ws + WS_XB); const bf16_t* o1 = o0 + (size_t)T * 512;
    const float* gs = P.in[21] + 8 * (lane & 15);
    for (int m0 = gw; m0 < T; m0 += 4 * NGW) {
        u32x4 a[4], bq[4];
#pragma unroll
        for (int k = 0; k < 4; ++k) { const int m = (m0 + k * NGW < T) ? m0 + k * NGW : m0; a[k] = *(const u32x4*)(o0 + (size_t)m * 512 + 8 * lane); bq[k] = *(const u32x4*)(o1 + (size_t)m * 512 + 8 * lane); }
#pragma unroll
        for (int k = 0; k < 4; ++k) { const int m = m0 + k * NGW; if (m >= T) break;
            float v[8]; float ss = 0.f;
#pragma unroll
            for (int j = 0; j < 4; ++j) { v[2 * j] = lo16(a[k][j]) - lam * lo16(bq[k][j]); v[2 * j + 1] = hi16(a[k][j]) - lam * hi16(bq[k][j]); ss += v[2 * j] * v[2 * j] + v[2 * j + 1] * v[2 * j + 1]; }
            ss = row16_sum(ss);
            const float rs = rsqrtf(ss * (1.f / 128.f) + EPS) * (1.f - lam_init);
            u32x4 w;
#pragma unroll
            for (int j = 0; j < 4; ++j) w[j] = cvtpk(v[2 * j] * rs * gs[2 * j], v[2 * j + 1] * rs * gs[2 * j + 1]);
            *(u32x4*)((bf16_t*)(ws + WS_Y) + (size_t)m * 1024 + 8 * lane) = w; }
    }
}

template <int W>
DEVI void pool_item(const bf16_t* pr, bf16_t* y, int m, int c0) {
    const int t = m & (S - 1);
    u32x4 z[W];
#pragma unroll
    for (int dt = 0; dt < W; ++dt) z[dt] = *(const u32x4*)(pr + (size_t)(m - ((dt <= t) ? dt : t)) * 2048 + 1536 + c0);
    float sum[8];
#pragma unroll
    for (int j = 0; j < 8; ++j) sum[j] = 0.f;
#pragma unroll
    for (int dt = 0; dt < W; ++dt) { const float wgt = (dt <= t) ? 1.f : 0.f;
#pragma unroll
        for (int j = 0; j < 4; ++j) { sum[2 * j] += wgt * lo16(z[dt][j]); sum[2 * j + 1] += wgt * hi16(z[dt][j]); } }
    const float inv = 1.f / (float)((t + 1 < W) ? (t + 1) : W); u32x4 w;
#pragma unroll
    for (int j = 0; j < 4; ++j) w[j] = cvtpk(sum[2 * j] * inv - lo16(z[0][j]), sum[2 * j + 1] * inv - hi16(z[0][j]));
    *(u32x4*)(y + (size_t)m * 1024 + 512 + c0) = w;
}
DEVI void phase_mix1(const Params& P) {
    const int gt = blockIdx.x * NTHR + tid_opaque(), NGT = gridDim.x * NTHR;
    unsigned char* ws = P.ws;
    const bf16_t* pr = (const bf16_t*)(ws + WS_PROJ1);
    bf16_t* y = (bf16_t*)(ws + WS_Y);
    const float* cw = P.in[29];
    for (int it0 = gt; it0 < T * 64; it0 += 2 * NGT) {
        u32x4 gc[2][3], hc[2][3], gb[2];
#pragma unroll
        for (int k = 0; k < 2; ++k) { const int it = (it0 + k * NGT < T * 64) ? it0 + k * NGT : it0; const int m = it >> 6, c0 = 8 * (it & 63), t = m & (S - 1);
#pragma unroll
            for (int dt = 0; dt < 3; ++dt) { const size_t r = (size_t)(m - ((dt <= t) ? dt : t)) * 2048; gc[k][dt] = *(const u32x4*)(pr + r + 512 + c0); hc[k][dt] = *(const u32x4*)(pr + r + 1024 + c0); }
            gb[k] = *(const u32x4*)(pr + (size_t)m * 2048 + c0); }
#pragma unroll
        for (int k = 0; k < 2; ++k) { const int it = it0 + k * NGT; if (it >= T * 64) break; const int m = it >> 6, c0 = 8 * (it & 63), t = m & (S - 1);
            float wgt[3][8];
#pragma unroll
            for (int dt = 0; dt < 3; ++dt) { float tmp[8]; load8(tmp, cw + (2 - dt) * 512 + c0); const float on = (dt <= t) ? 1.f : 0.f;
#pragma unroll
                for (int j = 0; j < 8; ++j) wgt[dt][j] = tmp[j] * on; }
            u32x4 w;
#pragma unroll
            for (int j = 0; j < 4; ++j) { float a = 0.f, b = 0.f;
#pragma unroll
                for (int dt = 0; dt < 3; ++dt) { a += wgt[dt][2 * j] * (lo16(gc[k][dt][j]) * lo16(hc[k][dt][j])); b += wgt[dt][2 * j + 1] * (hi16(gc[k][dt][j]) * hi16(hc[k][dt][j])); }
                w[j] = cvtpk(lo16(gb[k][j]) * a, hi16(gb[k][j]) * b); }
            *(u32x4*)(y + (size_t)m * 1024 + c0) = w; }
    }
    for (int it = gt; it < T * 16; it += NGT) { const int m = it >> 4, cj = 8 * (it & 15);
        pool_item<2>(pr, y, m, cj); pool_item<4>(pr, y, m, 128 + cj); asm volatile("" ::: "memory"); pool_item<8>(pr, y, m, 256 + cj); asm volatile("" ::: "memory"); pool_item<16>(pr, y, m, 384 + cj); asm volatile("" ::: "memory"); }
}

DEVI float sum_rows4(float s) {
    const auto a = __builtin_amdgcn_permlane16_swap(__float_as_uint(s), __float_as_uint(s), false, false);
    const float s2 = __uint_as_float(a[0]) + __uint_as_float(a[1]);
    const auto b = __builtin_amdgcn_permlane32_swap(__float_as_uint(s2), __float_as_uint(s2), false, false);
    return __uint_as_float(b[0]) + __uint_as_float(b[1]);
}
namespace pg8 {
#define PG8_LAS __attribute__((address_space(3)))
typedef unsigned short bf16_t;
typedef short bf16x8 __attribute__((ext_vector_type(8)));
typedef float f32x4 __attribute__((ext_vector_type(4)));
typedef unsigned u32x4 __attribute__((ext_vector_type(4)));
constexpr int BM = 256, BK = 64, HALF = 128, HTB = HALF * BK * 2  , STAGE_BYTES = 8 * HTB, NXCD = 8, WGM = 8;

__host__ __device__ __forceinline__ int lds_byte(int r, int c) { const int st = (r >> 4) * 2 + (c >> 5), rr = r & 15, cc = c & 31, ob = rr * 64 + cc * 2; return st * 1024 + (ob ^ (((ob >> 9) & 1) << 5)); }
__host__ __device__ __forceinline__ void stage_rc(int b, int& R, int& C) { const int st = b / 1024, sb = b % 1024, swz = sb ^ (((sb >> 9) & 1) << 5); R = (st >> 1) * 16 + swz / 64; C = (st & 1) * 32 + (swz % 64) / 2; }
__host__ __device__ __forceinline__ int perm32(int rho) { const int n = rho >> 4, i = rho & 15; return 8 * (i >> 2) + 4 * n + (i & 3); }

struct Unit { int pm, pn; };
struct Gemm { const bf16_t* A; int lda; const bf16_t* Bt; int M, N, K; };

struct StaticOrder {
    int nM, nN, nwg, G, c;
    __host__ __device__ void init(int M, int N, int G_, int c_) { nM = M / BM; nN = N / BM; nwg = nM * nN; G = G_; c = c_; }
    __host__ __device__ bool next(int i, Unit& u) const {
        const long L = (long)i * G + c; if (L >= nwg) return false;
        int wgid = (int)L; { const int q = nwg / NXCD, r = nwg % NXCD, xcd = wgid % NXCD, off = wgid / NXCD; wgid = (xcd < r ? xcd * (q + 1) : r * (q + 1) + (xcd - r) * q) + off; }
        const int nig = WGM * nN, gid = wgid / nig, fm = gid * WGM, gsz = (nM - fm) < WGM ? (nM - fm) : WGM;
        u.pm = fm + ((wgid % nig) % gsz); u.pn = (wgid % nig) / gsz; return true;
    }
    __device__ __forceinline__ void a_ready(const Unit&) const {}
    __device__ __forceinline__ void done(const Unit&) const {}
};
template <class Epi, class Sched, bool ALIGN_EPI = false, bool SP2 = false>
__device__ __forceinline__ void gemm_phase(PG8_LAS unsigned char* lds, const Gemm g, const Sched& S, const Epi& E) {
    const int tid = tid_opaque(), wid = __builtin_amdgcn_readfirstlane(tid >> 6), lane = tid & 63, wr = wid >> 2, wc = wid & 3, fr = lane & 15, fq = lane >> 4;
    const int K = g.K, nt = K / BK;
    unsigned voffA[2], voffB[2];
#pragma unroll
    for (int i = 0; i < 2; ++i) { int R, C; stage_rc(tid * 16 + i * 8192, R, C); const int Rb = Epi::PERM ? ((R & ~31) + perm32(R & 31)) : R;
        voffA[i] = (unsigned)(R * g.lda + C) * 2u; voffB[i] = (unsigned)(Rb * K + C) * 2u; }
    const size_t kstep = (size_t)(BK * 2);
    const size_t hstepA = (size_t)HALF * g.lda * 2, hstepB = (size_t)HALF * K * 2;
    const size_t tstepA = 2 * hstepA, tstepB = 2 * hstepB;
    const unsigned ldsw = (unsigned)wid * 1024u;
    const int aoff = lds_byte(wr * 64 + fr, fq * 8), boff = lds_byte(wc * 32 + fr, fq * 8);
#define PG8_SA(b, h) (((b) * 2 + (h)) * HTB)
#define PG8_SB(b, h) ((4 + (b) * 2 + (h)) * HTB)
#define PG8_STAGE(bufoff, gbase, voff) do { _Pragma("unroll") for (int _i = 0; _i < 2; ++_i) \
        __builtin_amdgcn_global_load_lds((const unsigned*)((const char*)(gbase) + (voff)[_i]), (PG8_LAS unsigned*)(lds + (bufoff) + ldsw + _i * 8192), 16, 0, 0); } while (0)
#define PG8_LDA(dst, b, h) do { _Pragma("unroll") for (int m = 0; m < 4; ++m) _Pragma("unroll") for (int k = 0; k < 2; ++k) dst[m][k] = *(const PG8_LAS bf16x8*)(lds + PG8_SA(b, h) + aoff + m * 2048 + k * 1024); } while (0)
#define PG8_LDB(dst, b, h) do { _Pragma("unroll") for (int n = 0; n < 2; ++n) _Pragma("unroll") for (int k = 0; k < 2; ++k) dst[n][k] = *(const PG8_LAS bf16x8*)(lds + PG8_SB(b, h) + boff + n * 2048 + k * 1024); } while (0)
#define PG8_MMA(ai, bj, At, Bt) do { __builtin_amdgcn_s_setprio(1); _Pragma("unroll") for (int m = 0; m < 4; ++m) _Pragma("unroll") for (int n = 0; n < 2; ++n) _Pragma("unroll") for (int k = 0; k < 2; ++k) \
        acc[ai][bj][m][n] = __builtin_amdgcn_mfma_f32_16x16x32_bf16(Bt[n][k], At[m][k], acc[ai][bj][m][n], 0, 0, 0); __builtin_amdgcn_s_setprio(0); } while (0)
#define PG8_WAIT_V(n) asm volatile("s_waitcnt vmcnt(" #n ")" ::: "memory")
#define PG8_WAIT_L(n) asm volatile("s_waitcnt lgkmcnt(" #n ")" ::: "memory")
#define PG8_BAR __builtin_amdgcn_s_barrier()
#define PG8_SCHED __builtin_amdgcn_sched_barrier(0)
    Unit cur, nxt; int ui = 0;
    if (!S.next(0, cur)) return;
    f32x4 acc[2][2][4][2];
#pragma unroll
    for (int a = 0; a < 2; ++a)
#pragma unroll
        for (int b = 0; b < 2; ++b)
#pragma unroll
            for (int m = 0; m < 4; ++m)
#pragma unroll
                for (int n = 0; n < 2; ++n) acc[a][b][m][n] = (f32x4){0.f, 0.f, 0.f, 0.f};
    bf16x8 At[4][2], B0[2][2], B1[2][2];
    const char* cA = (const char*)g.A + (size_t)cur.pm * tstepA; const char* cB = (const char*)g.Bt + (size_t)cur.pn * tstepB;
    S.a_ready(cur);
    if constexpr (SP2) {
        PG8_STAGE(PG8_SB(0, 0), cB, voffB); PG8_STAGE(PG8_SB(0, 1), cB + hstepB, voffB); PG8_STAGE(PG8_SA(0, 0), cA, voffA); PG8_STAGE(PG8_SA(0, 1), cA + hstepA, voffA);
        if (wr == 1) PG8_BAR;
        PG8_WAIT_V(2); PG8_BAR;
        PG8_STAGE(PG8_SB(1, 0), cB + kstep, voffB); PG8_STAGE(PG8_SA(1, 0), cA + kstep, voffA); PG8_STAGE(PG8_SB(1, 1), cB + hstepB + kstep, voffB);
        PG8_WAIT_V(6); PG8_BAR;
    } else {
        PG8_STAGE(PG8_SB(0, 0), cB, voffB); PG8_STAGE(PG8_SA(0, 0), cA, voffA); PG8_STAGE(PG8_SB(0, 1), cB + hstepB, voffB); PG8_STAGE(PG8_SA(0, 1), cA + hstepA, voffA);
        if (wr == 1) PG8_BAR;
        PG8_WAIT_V(4); PG8_BAR;
        PG8_STAGE(PG8_SB(1, 0), cB + kstep, voffB); PG8_STAGE(PG8_SA(1, 0), cA + kstep, voffA); PG8_STAGE(PG8_SB(1, 1), cB + hstepB + kstep, voffB);
        PG8_WAIT_V(6); PG8_BAR;
    }
    for (;;) {
        const bool has_next = S.next(ui + 1, nxt);
        const char* nA = has_next ? (const char*)g.A + (size_t)nxt.pm * tstepA : cA; const char* nB = has_next ? (const char*)g.Bt + (size_t)nxt.pn * tstepB : cB;
        for (int t = 0; t < nt; t += 2) {
            const bool last = (t == nt - 2);
            const char* a1 = cA + (size_t)(t + 1) * kstep;
            const char* a2 = last ? nA : cA + (size_t)(t + 2) * kstep; const char* b2 = last ? nB : cB + (size_t)(t + 2) * kstep;
            const char* a3 = a2 + kstep; const char* b3 = b2 + kstep;
            if (last && has_next) S.a_ready(nxt);
            if constexpr (SP2) {
            PG8_LDB(B0, 0, 0); PG8_LDB(B1, 0, 1); PG8_SCHED; PG8_LDA(At, 0, 0); PG8_STAGE(PG8_SA(1, 1), a1 + hstepA, voffA);
            PG8_WAIT_V(8); PG8_WAIT_L(0); PG8_BAR; PG8_MMA(0, 0, At, B0); PG8_MMA(0, 1, At, B1); PG8_BAR; PG8_SCHED;
            PG8_LDA(At, 0, 1); PG8_STAGE(PG8_SB(0, 0), b2, voffB); PG8_STAGE(PG8_SB(0, 1), b2 + hstepB, voffB); PG8_STAGE(PG8_SA(0, 0), a2, voffA);
            PG8_WAIT_V(8); PG8_WAIT_L(0); PG8_BAR; PG8_MMA(1, 0, At, B0); PG8_MMA(1, 1, At, B1); PG8_BAR; PG8_SCHED;
            PG8_LDB(B0, 1, 0); PG8_LDB(B1, 1, 1); PG8_SCHED; PG8_LDA(At, 1, 0); PG8_STAGE(PG8_SA(0, 1), a2 + hstepA, voffA);
            PG8_WAIT_V(8); PG8_WAIT_L(0); PG8_BAR; PG8_MMA(0, 0, At, B0); PG8_MMA(0, 1, At, B1); PG8_BAR; PG8_SCHED;
            PG8_LDA(At, 1, 1); PG8_STAGE(PG8_SB(1, 0), b3, voffB); PG8_STAGE(PG8_SB(1, 1), b3 + hstepB, voffB); PG8_STAGE(PG8_SA(1, 0), a3, voffA);
            PG8_WAIT_V(8); PG8_WAIT_L(0); PG8_BAR; PG8_MMA(1, 0, At, B0); PG8_MMA(1, 1, At, B1); PG8_BAR; PG8_SCHED;
            } else {
            PG8_LDB(B0, 0, 0); PG8_SCHED; PG8_LDA(At, 0, 0); PG8_STAGE(PG8_SA(1, 1), a1 + hstepA, voffA);
            PG8_WAIT_L(8); PG8_BAR; PG8_WAIT_L(0); PG8_MMA(0, 0, At, B0); PG8_BAR; PG8_SCHED;
            PG8_LDB(B1, 0, 1); PG8_STAGE(PG8_SB(0, 0), b2, voffB);
            PG8_BAR; PG8_WAIT_L(0); PG8_MMA(0, 1, At, B1); PG8_BAR;
            PG8_LDA(At, 0, 1); PG8_STAGE(PG8_SA(0, 0), a2, voffA);
            PG8_BAR; PG8_WAIT_L(0); PG8_MMA(1, 0, At, B0); PG8_BAR; PG8_SCHED;
            PG8_STAGE(PG8_SB(0, 1), b2 + hstepB, voffB);
            PG8_WAIT_V(6); PG8_BAR; PG8_MMA(1, 1, At, B1); PG8_BAR;
            PG8_LDB(B0, 1, 0); PG8_SCHED; PG8_LDA(At, 1, 0); PG8_STAGE(PG8_SA(0, 1), a2 + hstepA, voffA);
            PG8_WAIT_L(8); PG8_BAR; PG8_WAIT_L(0); PG8_MMA(0, 0, At, B0); PG8_BAR; PG8_SCHED;
            PG8_LDB(B1, 1, 1); PG8_STAGE(PG8_SB(1, 0), b3, voffB);
            PG8_BAR; PG8_WAIT_L(0); PG8_MMA(0, 1, At, B1); PG8_BAR;
            PG8_LDA(At, 1, 1); PG8_STAGE(PG8_SA(1, 0), a3, voffA);
            PG8_BAR; PG8_WAIT_L(0); PG8_MMA(1, 0, At, B0); PG8_BAR; PG8_SCHED;
            PG8_STAGE(PG8_SB(1, 1), b3 + hstepB, voffB);
            PG8_WAIT_V(6); PG8_BAR; PG8_MMA(1, 1, At, B1); PG8_BAR;
            }
        }
        if constexpr (ALIGN_EPI) { if (wr == 0) PG8_BAR; }
        if constexpr (!Epi::AFTER_DRAIN) { E(acc, cur, wr, wc, fr, fq); S.done(cur); }
        if (!has_next) break;
#pragma unroll
        for (int a = 0; a < 2; ++a)
#pragma unroll
            for (int b = 0; b < 2; ++b)
#pragma unroll
                for (int m = 0; m < 4; ++m)
#pragma unroll
                    for (int n = 0; n < 2; ++n) acc[a][b][m][n] = (f32x4){0.f, 0.f, 0.f, 0.f};
        cur = nxt; cA = nA; cB = nB; ++ui;
        if constexpr (ALIGN_EPI) { if (wr == 1) PG8_BAR; }
    }
    PG8_WAIT_V(0);
    if constexpr (!ALIGN_EPI) { if (wr == 0) PG8_BAR; }
    PG8_BAR;
    if constexpr (Epi::AFTER_DRAIN) { E.fused(acc, cur, wr, wc, fr, fq, lds, wid, lane); S.done(cur); }
#undef PG8_SA
#undef PG8_SB
#undef PG8_STAGE
#undef PG8_LDA
#undef PG8_LDB
#undef PG8_MMA
#undef PG8_WAIT_V
#undef PG8_WAIT_L
#undef PG8_BAR
#undef PG8_SCHED
}
}

namespace pg8 {
struct EpiScale {
    static constexpr bool PERM = true, AFTER_DRAIN = false;
    bf16_t* O; int ldo; const float* ssq; float inv_n; int act;
    __device__ __forceinline__ void operator()(const f32x4 (&acc)[2][2][4][2], const Unit& u, int wr, int wc, int fr, int fq) const {
        asm volatile("" : "+v"(fr), "+v"(fq));
        const int row0 = u.pm * BM + wr * 64 + fr, col0 = u.pn * BM + wc * 32 + 8 * fq;
        float rsv[8];
#pragma unroll
        for (int i = 0; i < 8; ++i) rsv[i] = ssq ? ssq[row0 + (i >> 2) * HALF + (i & 3) * 16] : 0.f;
#pragma unroll
        for (int i = 0; i < 8; ++i) rsv[i] = ssq ? rsqrtf(rsv[i] * inv_n + 1e-6f) : 1.f;
#pragma unroll
        for (int ai = 0; ai < 2; ++ai)
#pragma unroll
            for (int m = 0; m < 4; ++m) {
                const int row = row0 + ai * HALF + m * 16;
                const float rs = rsv[ai * 4 + m];
                bf16_t* rowp = O + (size_t)row * ldo + col0;
#pragma unroll
                for (int bj = 0; bj < 2; ++bj) {
                    f32x4 v0 = acc[ai][bj][m][0] * rs, v1 = acc[ai][bj][m][1] * rs;
                    if (act == 1) {
#pragma unroll
                        for (int j = 0; j < 4; ++j) { const float a = fmaxf(v0[j], 0.f), b = fmaxf(v1[j], 0.f); v0[j] = a * a; v1[j] = b * b; }
                    }
                    u32x4 w; w.x = ::cvtpk(v0[0], v0[1]); w.y = ::cvtpk(v0[2], v0[3]); w.z = ::cvtpk(v1[0], v1[1]); w.w = ::cvtpk(v1[2], v1[3]);
                    *(u32x4*)(rowp + bj * HALF) = w;
                }
            }
    }
};
struct EpiHead {
    static constexpr bool PERM = true, AFTER_DRAIN = false;
    int kind; bf16_t* O; int ldo; const float* ssq; float inv_n; const float* cs;
    const float *g0, *g1, *g2, *g3; float* ssq_ckv; float* WI; bf16_t* KI; PG8_LAS float* X;
    __device__ __forceinline__ void operator()(f32x4 (&acc)[2][2][4][2], const Unit& u, int wr, int wc, int fr, int fq) const {
        asm volatile("" : "+v"(fr), "+v"(fq));
        asm volatile("" : "+s"(wr), "+s"(wc));
        const int wave = wr * 4 + wc, pn = u.pn;
        int gt = 0; bool rope = false; float scale = 1.f; const float* g = nullptr;
        if (kind == 0) {
            if (pn < 2) { gt = 1; rope = true; scale = 0.125f * 1.4426950408889634f; g = g0; }
            else if (pn < 4) { gt = 1; rope = true; g = g1; }
            else if (pn < 6) { gt = 0; }
            else if (pn < 8) { gt = 1; rope = true; scale = 0.125f * 1.4426950408889634f; g = g2; }
            else if (pn == 8) { gt = 3; }
            else if (pn == 9) { gt = 4; rope = true; }
            else { gt = 1; rope = true; g = g3; }
        } else if (kind == 1) { if (pn < 2) { gt = 1; rope = true; g = g0; } }
        else { if ((pn & 3) < 2) { gt = 2; g = g0 + (pn >> 2) * 128; } }
        const int row0 = u.pm * BM + wr * 64 + fr, col0 = pn * BM + wc * 32 + 8 * fq;
        PG8_LAS float* CSL = X + 2048;
        if (rope) {
            const int tid_ = (wave * 4 + fq) * 16 + fr; f32x4 t_[2];
#pragma unroll
            for (int i = 0; i < 2; ++i) { const int idx = tid_ + 512 * i; t_[i] = *(const f32x4*)(cs + (size_t)(u.pm * BM + (idx >> 2)) * 16 + 4 * (idx & 3)); }
#pragma unroll
            for (int i = 0; i < 2; ++i) { const int idx = tid_ + 512 * i; *(PG8_LAS f32x4*)(CSL + (idx >> 2) * 20 + 4 * (idx & 3)) = t_[i]; }
        }
        float rsv[8];
#pragma unroll
        for (int i = 0; i < 8; ++i) rsv[i] = ssq[row0 + (i >> 2) * HALF + (i & 3) * 16];
#pragma unroll
        for (int i = 0; i < 8; ++i) rsv[i] = rsqrtf(rsv[i] * inv_n + 1e-6f);
        float gv[8];
        { const int db = (gt == 2) ? (32 * wc + 8 * fq) : (32 * (wc & 1) + 8 * fq);
#pragma unroll
          for (int j = 0; j < 8; ++j) gv[j] = g ? g[db + j] : 1.f; }
#pragma unroll
        for (int ai = 0; ai < 2; ++ai)
#pragma unroll
            for (int m = 0; m < 4; ++m) {
                const float rs = rsv[ai * 4 + m];
#pragma unroll
                for (int bj = 0; bj < 2; ++bj) {
                    acc[ai][bj][m][0] *= rs; acc[ai][bj][m][1] *= rs;
                    const f32x4 a = acc[ai][bj][m][0], b = acc[ai][bj][m][1];
                    float s = (a[0] * a[0] + a[1] * a[1]) + (a[2] * a[2] + a[3] * a[3]) + (b[0] * b[0] + b[1] * b[1]) + (b[2] * b[2] + b[3] * b[3]);
                    s = ::sum_rows4(s);
                    if (fq == 0) X[(((wave * 2 + ai) * 4 + m) * 2 + bj) * 16 + fr] = s;
                }
            }
        asm volatile("s_waitcnt lgkmcnt(0)\n\ts_barrier" ::: "memory");
#pragma unroll
        for (int ai = 0; ai < 2; ++ai)
#pragma unroll
            for (int m = 0; m < 4; ++m) {
                const int row = row0 + ai * HALF + m * 16;
                float cs16[16];
                if (rope) { const PG8_LAS float* c = CSL + (ai * HALF + wr * 64 + m * 16 + fr) * 20;
#pragma unroll
                    for (int q = 0; q < 4; ++q) { const f32x4 t = *(const PG8_LAS f32x4*)(c + 4 * q); cs16[4 * q] = t[0]; cs16[4 * q + 1] = t[1]; cs16[4 * q + 2] = t[2]; cs16[4 * q + 3] = t[3]; }
#pragma unroll
                    for (int j = 0; j < 8; ++j) { const float cj = cs16[j], sj = cs16[8 + j];
                        cs16[j] = (fq == 0) ? cj : (fq == 1) ? sj : (fq == 2) ? 1.f : 0.f; cs16[8 + j] = (fq == 0) ? -sj : (fq == 1) ? cj : (fq == 2) ? 0.f : 1.f; } }
                float rowtot = 0.f;
#pragma unroll
                for (int bj = 0; bj < 2; ++bj) {
                    float v[8];
#pragma unroll
                    for (int j = 0; j < 4; ++j) { v[j] = acc[ai][bj][m][0][j]; v[4 + j] = acc[ai][bj][m][1][j]; }
#define XAT(w_) X[((((w_) * 2 + ai) * 4 + m) * 2 + bj) * 16 + fr]
                    if (gt == 1) {
                        const float tot = XAT(wave) + XAT(wave ^ 1), r2 = rsqrtf(tot * (1.f / 64.f) + 1e-6f);
#pragma unroll
                        for (int j = 0; j < 8; ++j) v[j] = v[j] * r2 * gv[j];
                    } else if (gt == 2) {
                        const int w0 = wave & 4; const float tot = (XAT(w0) + XAT(w0 + 1)) + (XAT(w0 + 2) + XAT(w0 + 3)), r2 = rsqrtf(tot * (1.f / 128.f) + 1e-6f);
#pragma unroll
                        for (int j = 0; j < 8; ++j) v[j] = v[j] * r2 * gv[j];
                    } else if (gt == 3) {
                        const int w0 = wave & 4; rowtot += (XAT(w0) + XAT(w0 + 1)) + (XAT(w0 + 2) + XAT(w0 + 3));
                    }
#undef XAT
                    if (rope && (wc & 1) == 0) {
#pragma unroll
                        for (int j = 0; j < 8; ++j) { const auto r = __builtin_amdgcn_permlane16_swap(__float_as_uint(v[j]), __float_as_uint(v[j]), false, false);
                            v[j] = __uint_as_float(r[0]) * cs16[j] + __uint_as_float(r[1]) * cs16[8 + j]; }
                    }
                    u32x4 w; w.x = ::cvtpk(v[0] * scale, v[1] * scale); w.y = ::cvtpk(v[2] * scale, v[3] * scale); w.z = ::cvtpk(v[4] * scale, v[5] * scale); w.w = ::cvtpk(v[6] * scale, v[7] * scale);
                    if (kind == 0 && pn == 10) {
                        if (bj == 0 && wc < 2) { const int c = 4 * wc + fq;
                            *(u32x4*)(KI + (size_t)(row >> 5) * 2048 + (c >> 1) * 512 + (((c & 1) * 32 + (row & 31)) * 8)) = w; }
                        if (bj == 0 && wc == 2 && fq == 0) *(f32x4*)(WI + (size_t)row * 4) = acc[ai][0][m][0] * (1.f / 16.f);
                    } else {
                        *(u32x4*)(O + (size_t)row * ldo + col0 + bj * HALF) = w;
                    }
                }
                if (gt == 3 && wc == 0 && fq == 0) ssq_ckv[row] = rowtot;
            }
    }
};
template <bool F32BASE> struct EpiResidT {
    static constexpr bool PERM = true, AFTER_DRAIN = false;
    const float* basef; float* outf; bf16_t* xb; float* ssq_next; int dry;
    __device__ __forceinline__ void operator()(const f32x4 (&acc)[2][2][4][2], const Unit& u, int wr, int wc, int fr, int fq) const {
        asm volatile("" : "+v"(fr), "+v"(fq));
        const int col0 = u.pn * BM + wc * 32 + 8 * fq;
        constexpr int MB = F32BASE ? 2 : 4;
#pragma unroll
        for (int ai = 0; ai < 2; ++ai)
#pragma unroll
        for (int m0 = 0; m0 < 4; m0 += MB) {
            u32x4 bb[MB][2]; f32x4 bf[MB][2][2];
#pragma unroll
            for (int mm = 0; mm < MB; ++mm)
#pragma unroll
                for (int bj = 0; bj < 2; ++bj) { const size_t idx = (size_t)(u.pm * BM + ai * HALF + wr * 64 + (m0 + mm) * 16 + fr) * 1024 + col0 + bj * HALF;
                    if (F32BASE) { bf[mm][bj][0] = *(const f32x4*)(basef + idx); bf[mm][bj][1] = *(const f32x4*)(basef + idx + 4); } else bb[mm][bj] = *(const u32x4*)(xb + idx); }
#pragma unroll
            for (int mm = 0; mm < MB; ++mm) { const int m = m0 + mm;
                const int row = u.pm * BM + ai * HALF + wr * 64 + m * 16 + fr; const size_t off = (size_t)row * 1024 + col0; float s = 0.f;
#pragma unroll
                for (int bj = 0; bj < 2; ++bj) {
                    const size_t idx = off + bj * HALF;
                    f32x4 x0, x1;
                    if (F32BASE) { x0 = bf[mm][bj][0]; x1 = bf[mm][bj][1]; }
                    else { const u32x4 b = bb[mm][bj]; x0 = (f32x4){::lo16(b.x), ::hi16(b.x), ::lo16(b.y), ::hi16(b.y)}; x1 = (f32x4){::lo16(b.z), ::hi16(b.z), ::lo16(b.w), ::hi16(b.w)}; }
                    x0 += acc[ai][bj][m][0]; x1 += acc[ai][bj][m][1];
                    s += (x0[0] * x0[0] + x0[1] * x0[1]) + (x0[2] * x0[2] + x0[3] * x0[3]) + (x1[0] * x1[0] + x1[1] * x1[1]) + (x1[2] * x1[2] + x1[3] * x1[3]);
                    if (outf && !dry) { *(f32x4*)(outf + idx) = x0; *(f32x4*)(outf + idx + 4) = x1; }
                    if (xb && !outf && !dry) { u32x4 w; w.x = ::cvtpk(x0[0], x0[1]); w.y = ::cvtpk(x0[2], x0[3]); w.z = ::cvtpk(x1[0], x1[1]); w.w = ::cvtpk(x1[2], x1[3]); *(u32x4*)(xb + idx) = w; }
                    if (dry) asm volatile("" :: "v"(x0), "v"(x1));
                }
                if (ssq_next && !dry) { s = ::sum_rows4(s); if (fq == 0) atomicAdd(ssq_next + row, s); }
            }
            asm volatile("" ::: "memory");
        }
    }
};
typedef EpiResidT<false> EpiResid; typedef EpiResidT<true> EpiResidF;
}

#define XB_TMO      128
#define XB_XCNT(j)  (256  + 64 * (j))
#define XB_XSUB(j)  (1280 + 64 * (j))
#define XB_XGEN(j)  (2304 + 64 * (j))
#define XB_TOP      3328
#define XB_TOPGEN   3392
#define XCD_BAR_WORDS 3456
#define XB_SPIN_CAP (1u << 18)

__device__ __forceinline__ unsigned xb_ld(unsigned* p)              { return __hip_atomic_load(p, __ATOMIC_RELAXED, __HIP_MEMORY_SCOPE_AGENT); }
__device__ __forceinline__ unsigned xb_add(unsigned* p, unsigned v) { return __hip_atomic_fetch_add(p, v, __ATOMIC_RELAXED, __HIP_MEMORY_SCOPE_AGENT); }
__device__ __forceinline__ unsigned xb_xcc_id() { return (unsigned)__builtin_amdgcn_s_getreg((3 << 11) | 20) & 0xFu; }
#define XB_SPIN(cond, bar) do { unsigned _sp = 0; while (cond) { __builtin_amdgcn_s_sleep(1); \
    if ((++_sp & 255u) == 0u) { if (xb_ld(&(bar)[XB_TMO])) break; if (_sp > XB_SPIN_CAP) { atomicAdd(&(bar)[XB_TMO], 1u); break; } } } } while (0)

struct XcdBarrier {
    unsigned* bar; unsigned x;
    volatile LAS unsigned* st;
};

__device__ __forceinline__ XcdBarrier xcd_barrier_post(unsigned* bar, volatile LAS unsigned* st) {
    XcdBarrier b; b.bar = bar; b.x = xb_xcc_id(); b.st = st;
    if (threadIdx.x == 0) (void)xb_add(&bar[XB_XCNT(b.x)], 1u);
    return b;
}
__device__ __forceinline__ void xcd_barrier_complete(unsigned* bar, unsigned x, unsigned& nloc, unsigned& nx) {
    const unsigned G = gridDim.x * gridDim.y * gridDim.z;
    unsigned sum, cnt, mine, sp = 0u;
    for (;;) {
        sum = 0u; cnt = 0u; mine = 0u;
#pragma unroll
        for (unsigned j = 0; j < 16; ++j) { const unsigned c = xb_ld(&bar[XB_XCNT(j)]); sum += c; cnt += (c > 0u) ? 1u : 0u; mine = (j == x) ? c : mine; }
        if (sum == G) break;
        __builtin_amdgcn_s_sleep(1);
        if ((++sp & 255u) == 0u) { if (xb_ld(&bar[XB_TMO])) break; if (sp > XB_SPIN_CAP) { atomicAdd(&bar[XB_TMO], 1u); break; } }
    }
    nloc = mine > 0u ? mine : 1u; nx = cnt > 0u ? cnt : 1u;
}

__device__ __forceinline__ void xcd_barrier(const XcdBarrier& b) {
    asm volatile("s_waitcnt vmcnt(0)" ::: "memory");
    __syncthreads();
    if (tid_opaque() == 0) {
        unsigned* bar = b.bar;
        __builtin_amdgcn_s_waitcnt(0);
        unsigned nloc = b.st[0], nx = b.st[1];
        if (nloc == 0u) { xcd_barrier_complete(bar, b.x, nloc, nx); b.st[0] = nloc; b.st[1] = nx; }
        const unsigned old = xb_add(&bar[XB_XSUB(b.x)], 1u);
        const unsigned gen = old / nloc;
        if (old + 1u == (gen + 1u) * nloc) {
            __builtin_amdgcn_fence(__ATOMIC_RELEASE, "agent");
            asm volatile("s_waitcnt vmcnt(0)" ::: "memory");
            const unsigned og = xb_add(&bar[XB_TOP], 1u);
            const unsigned tg = og / nx;
            if (og + 1u == (tg + 1u) * nx) xb_add(&bar[XB_TOPGEN], 1u);
            else XB_SPIN(xb_ld(&bar[XB_TOPGEN]) == tg, bar);
            __builtin_amdgcn_fence(__ATOMIC_ACQUIRE, "agent");
            xb_add(&bar[XB_XGEN(b.x)], 1u);
            asm volatile("s_waitcnt vmcnt(0)" ::: "memory");
        } else {
            XB_SPIN(xb_ld(&bar[XB_XGEN(b.x)]) == gen, bar);
            __builtin_amdgcn_fence(__ATOMIC_ACQUIRE, "agent");
            asm volatile("s_waitcnt vmcnt(0)" ::: "memory");
        }
    }
    __syncthreads();
}
constexpr int NPHASE = 22;
constexpr int MISC_OFF = LDS_BYTES - 256;
#ifndef MK_REP_N
#define MK_REP_N 0
#define MK_REP_LO 0
#define MK_REP_HI -1
#endif
#ifndef MK_XPH
#define MK_XPH -1
#define MK_XN 0
#endif
#ifndef MK_SUB
#define MK_SUB 0
#endif
#ifndef MK_IDX2
#define MK_IDX2 0
#endif
#ifndef MK_CGSYNC
#define MK_CGSYNC 0
#endif
template <class Epi, bool ALIGN>
DEVI void run_gemm(LAS unsigned char* lds, const bf16_t* A, int lda, const bf16_t* Bt, int M, int N, int K, const Epi& E, int cu_off = 0) {
    const int Gd = (int)gridDim.x; int cu = (int)blockIdx.x - cu_off; if (cu < 0) cu += Gd;
    pg8::Gemm g{A, lda, Bt, M, N, K}; pg8::StaticOrder So; So.init(M, N, Gd, cu);
    pg8::gemm_phase<Epi, pg8::StaticOrder, ALIGN, MK_SP2>(lds, g, So, E);
}
template <bool DRYK>
__global__ void __launch_bounds__(NTHR, 2) mega(Params P, int ph_lo, int ph_hi) {
    LAS unsigned char* lds = (LAS unsigned char*)lds_raw;
    cg::grid_group grid = cg::this_grid();
    { volatile LAS unsigned* MISC0 = (volatile LAS unsigned*)(lds + MISC_OFF);
      if (threadIdx.x < 32) MISC0[threadIdx.x] = 0u;
      if ((threadIdx.x & 63) == 0) ((volatile LAS unsigned char*)lds)[WTAB_OFF + hw_slot()] = (unsigned char)(threadIdx.x >> 6);
      __syncthreads();
      if (ph_hi - ph_lo > 1) (void)xcd_barrier_post((unsigned*)(P.ws + WS_BAR), MISC0 + 8); }
    if (ph_lo < 0) grid.sync();
#define PH_LOCALS unsigned char* ws = P.ws; asm volatile("" : "+s"(ws)); float* ssq = (float*)(ws + WS_SSQ); bf16_t* XB = (bf16_t*)(ws + WS_XB); bf16_t* Y = (bf16_t*)(ws + WS_Y); const int G = gridDim.x, bx = blockIdx.x; (void)ssq; (void)XB; (void)Y; (void)G; (void)bx;
#define SEAM_XCD() do { XcdBarrier b_; b_.bar = (unsigned*)(P.ws + WS_BAR); b_.x = xb_xcc_id(); b_.st = (volatile LAS unsigned*)(lds + MISC_OFF) + 8; xcd_barrier(b_); } while (0)
#define PH_REPS(k) (((k) >= MK_REP_LO && (k) <= MK_REP_HI && (k) != 2 && (k) != 4) ? 1 + MK_REP_N : 1)
#define PH_BEGIN(k) if (ph_lo <= (k) && (k) < ph_hi) { PH_LOCALS for (int rep = 0; rep < PH_REPS(k); ++rep) { const int dry = (rep > 0) || DRYK; (void)dry; if (rep > 0) SEAM_XCD();
#define PH_END(k) } if ((k) + 1 < ph_hi) { if (MK_CGSYNC) grid.sync(); else SEAM_XCD(); } }
#define DRYOUT (dry ? (float*)(ws + WS_Y) : P.out)
    using pg8::EpiScale; using pg8::EpiResid; using pg8::EpiResidF; using pg8::EpiHead;
    PH_BEGIN(0) phase_prologue(P, lds, dry); PH_END(0)
    PH_BEGIN(1)
#if MK_FUSE & 1
        run_gemm<EpiHead, true>(lds, (const bf16_t*)(ws + WS_XB), 1024, (const bf16_t*)(ws + W_INE), T, LDP, 1024,
            EpiHead{0, (bf16_t*)(ws + WS_PROJ), LDP, ssq, 1.f / 1024.f, (const float*)(ws + WS_CS), P.in[15], P.in[16], P.in[24], P.in[26],
                    (float*)(ws + WS_SSQCKV), (float*)(ws + WS_WI), (bf16_t*)(ws + WS_KI), (LAS float*)(lds + 132096)});
#else
        run_gemm<EpiScale, true>(lds, (const bf16_t*)(ws + WS_XB), 1024, (const bf16_t*)(ws + W_INE), T, LDP, 1024, EpiScale{(bf16_t*)(ws + WS_PROJ), LDP, ssq, 1.f / 1024.f, 0});
#endif
#if MK_FUSE & 2
        run_gemm<EpiHead, true>(lds, (const bf16_t*)(ws + WS_MB), 1024, (const bf16_t*)(ws + W_KVX), MEMT, 2048, 1024,
            EpiHead{2, (bf16_t*)(ws + WS_KVX), 2048, (const float*)(ws + WS_SSQMEM), 1.f / 1024.f, nullptr, P.in[10], nullptr, nullptr, nullptr, nullptr, nullptr, nullptr, (LAS float*)(lds + 132096)},
            ((T / 256) * (LDP / 256)) % G);
#else
        run_gemm<EpiScale, false>(lds, (const bf16_t*)(ws + WS_MB), 1024, (const bf16_t*)(ws + W_KVX), MEMT, 2048, 1024, EpiScale{(bf16_t*)(ws + WS_KVX), 2048, (const float*)(ws + WS_SSQMEM), 1.f / 1024.f, 0}, ((T / 256) * (LDP / 256)) % G);
#endif
    PH_END(1)
#if (MK_FUSE & 3) != 3
    PH_BEGIN(2) phase_post0(P, ((MK_FUSE & 1) ? 0 : 1) | ((MK_FUSE & 2) ? 0 : 2)); PH_END(2)
#endif
    PH_BEGIN(3)
#if MK_FUSE & 4
        run_gemm<EpiHead, true>(lds, (const bf16_t*)(ws + WS_PROJ) + C_CKV, LDP, (const bf16_t*)(ws + W_KVUP), T, 1024, 256,
            EpiHead{1, (bf16_t*)(ws + WS_KBVB), 1024, (const float*)(ws + WS_SSQCKV), 1.f / 256.f, (const float*)(ws + WS_CS), P.in[25], nullptr, nullptr, nullptr, nullptr, nullptr, nullptr, (LAS float*)(lds + 132096)});
#else
        run_gemm<EpiScale, false>(lds, (const bf16_t*)(ws + WS_PROJ) + C_CKV, LDP, (const bf16_t*)(ws + W_KVUP), T, 1024, 256, EpiScale{(bf16_t*)(ws + WS_KBVB), 1024, (const float*)(ws + WS_SSQCKV), 1.f / 256.f, 0});
#endif
    PH_END(3)
#if !(MK_FUSE & 4)
    PH_BEGIN(4) phase_postkb(P); PH_END(4)
#endif
    PH_BEGIN(5)
        if (!(dry && MK_SUB == 2))
        for (int u = bx; u < 256; u += G) { const int bhc = 4 * (u & 7) + (u >> 6), s = (u >> 3) & 7, b = bhc >> 3, h = (bhc >> 1) & 3, c = bhc & 1;
#if MK_A64
            const bf16_t* pj_ = (const bf16_t*)(ws + WS_PROJ) + (size_t)b * S * LDP; bf16_t* oa_ = (bf16_t*)(ws + WS_XB) + (size_t)c * T * 512 + (size_t)b * S * 512 + h * 128;
            a64::unit(s, pj_ + C_QA + (2 * h + c) * 64, pj_ + C_KA + (2 * h + c) * 64, pj_ + C_VA + h * 128, LDP, oa_, 512, lds);
            a64::unit(15 - s, pj_ + C_QA + (2 * h + c) * 64, pj_ + C_KA + (2 * h + c) * 64, pj_ + C_VA + h * 128, LDP, oa_, 512, lds);
#else
            attnA_unit(P, b, h, c, s, lds); attnA_unit(P, b, h, c, 15 - s, lds);
#endif
        }
        if (!(dry && MK_SUB == 1))
        for (int u = bx; u < 2048; u += G) { const int k = u / 256, c = u % 256, b = k >> 1; const int blk = (k & 1) ? (511 - c) : c;
            indexer_unit(P, b, blk * 8, lds); }
#if MK_IDX2
        for (int u = bx; u < 2048; u += G) { const int k = u / 256, c = u % 256, b = k >> 1; const int blk = (k & 1) ? (511 - c) : c;
            indexer_unit(P, b, blk * 8, lds); }
#endif
    PH_END(5)
    PH_BEGIN(6)
        if (!(dry && MK_SUB == 2))
        for (int u = bx; u < 256; u += G) { const int bh = 4 * (u & 7) + (u >> 6), s = (u >> 3) & 7, b = bh >> 3, hd = bh & 7;
#if MK_B64
            const bf16_t* kb_ = (const bf16_t*)(ws + WS_KBVB) + (size_t)b * S * 1024 + hd * 64; const bf16_t* qb_ = (const bf16_t*)(ws + WS_PROJ) + (size_t)b * S * LDP + C_QB + hd * 64;
            bf16_t* ob_ = (bf16_t*)(ws + WS_Y) + (size_t)b * S * 1024 + 512 + hd * 64; const u64* mb_ = (const u64*)(ws + WS_MASK) + (size_t)b * S * 64;
            b64::unit(s, qb_, LDP, kb_, kb_ + 512, ob_, mb_, lds); b64::unit(15 - s, qb_, LDP, kb_, kb_ + 512, ob_, mb_, lds);
#else
            attnB_unit(P, b, hd, s, lds); attnB_unit(P, b, hd, 15 - s, lds);
#endif
        }
        if (!(dry && MK_SUB == 1)) combineA_rows(P);
    PH_END(6)
    PH_BEGIN(7) run_gemm<EpiResidF, false>(lds, Y, 1024, (const bf16_t*)(ws + W_OUTE), T, 1024, 1024, EpiResidF{P.in[0], nullptr, XB, ssq + 1 * T, dry});
        if (!dry) { const int t8 = tid_opaque(); convert_weights(P, lds, NTR_EARLY, NTR, true, bx * NWAVE + (t8 >> 6), G * NWAVE, bx * NTHR + t8, G * NTHR); }
    PH_END(8)
#define XATTN_MLP(l, p0)                                                                                                                                                      \
    PH_BEGIN(p0 + 1) for (int u = bx; u < 256; u += G) { const int b = u >> 6, hd = (u >> 4) & 3, qb = u & 15; xattn_fused_unit(P, (l), b, hd, qb, lds); } PH_END(p0 + 1)                           \
    PH_BEGIN(p0 + 2) run_gemm<EpiResid, false>(lds, (const bf16_t*)(ws + WS_YX), 512, (const bf16_t*)(ws + W_OX) + (size_t)(l) * 1024 * 512, T, 1024, 512, EpiResid{nullptr, nullptr, XB, ssq + ((l) ? 5 : 2) * T, dry}); PH_END(p0 + 2) \
    PH_BEGIN(p0 + 3) run_gemm<EpiScale, true>(lds, XB, 1024, (const bf16_t*)(ws + W_UP) + (size_t)(l) * 4096 * 1024, T, DFF, 1024, EpiScale{(bf16_t*)(ws + WS_H), DFF, ssq + ((l) ? 5 : 2) * T, 1.f / 1024.f, 1}); PH_END(p0 + 3)
    XATTN_MLP(0, 8)
    PH_BEGIN(12) run_gemm<EpiResid, false>(lds, (const bf16_t*)(ws + WS_H), DFF, (const bf16_t*)(ws + W_DOWN), T, 1024, DFF, EpiResid{nullptr, nullptr, XB, ssq + 3 * T, dry}); PH_END(12)
    PH_BEGIN(13) run_gemm<EpiScale, true>(lds, XB, 1024, (const bf16_t*)(ws + W_INO), T, 2048, 1024, EpiScale{(bf16_t*)(ws + WS_PROJ1), 2048, ssq + 3 * T, 1.f / 1024.f, 0}); PH_END(13)
    PH_BEGIN(14) phase_mix1(P); PH_END(15)
    PH_BEGIN(16) run_gemm<EpiResid, false>(lds, Y, 1024, (const bf16_t*)(ws + W_OUTO), T, 1024, 1024, EpiResid{nullptr, nullptr, XB, ssq + 4 * T, dry}); PH_END(16)
    XATTN_MLP(1, 17)
    PH_BEGIN(21) run_gemm<EpiResid, false>(lds, (const bf16_t*)(ws + WS_H), DFF, (const bf16_t*)(ws + W_DOWN) + (size_t)1024 * 4096, T, 1024, DFF, EpiResid{nullptr, P.out, XB, nullptr, dry}); PH_END(21)
#if MK_TPROBE
    if (ph_hi == NPHASE) { SEAM_XCD(); unsigned char* ws = P.ws;
        const unsigned long long* TS = (const unsigned long long*)(ws + WS_BAR + 65536);
        float delta = (MK_TPROBE == 14) ? (float)TS[12] / 625000.f : (MK_TPROBE >= 10) ? (float)TS[8 + MK_TPROBE - 10] / (float)TS[12] : (MK_TPROBE == 4 || MK_TPROBE == 20) ? (float)TS[3] * 1e-6f : (float)TS[MK_TPROBE - 1] / (float)TS[3];
        delta = floorf(delta * 25.f + 0.5f) * 0.04f;
        if (MK_TPROBE == 20) delta = 0.1f * floorf(log2f((float)TS[3] / 64000.f) + 0.5f);
        if (MK_TPROBE == 34) delta = 0.1f * floorf(log2f((float)TS[20] / 1000.f) * 2.f + 0.5f) * 0.5f;
        else if (MK_TPROBE >= 30) delta = 0.04f * floorf(25.f * (float)TS[16 + MK_TPROBE - 30] / (float)TS[20] + 0.5f);
        for (int i = blockIdx.x * NTHR + threadIdx.x; i < T * D; i += gridDim.x * NTHR) P.out[i] *= (1.f + delta); }
#endif
}

#ifndef MK_MULTI
#define MK_MULTI 0
#endif
extern "C" void kernel_launch(void* const* d_in, const int* in_sizes, int n_in, void* d_out, int out_size, void* d_ws, size_t ws_size, hipStream_t stream) {
    static int grid = 0;
    if (grid == 0) {
        if (n_in != 33 || out_size != T * D || ws_size < WS_END) { fprintf(stderr, "kernel_launch: unexpected shapes (n_in %d out %d ws %zu)\n", n_in, out_size, ws_size); grid = -1; return; }
        int dev = 0, cus = 0, per_cu = 0;
        hipGetDevice(&dev); hipDeviceGetAttribute(&cus, hipDeviceAttributeMultiprocessorCount, dev);
        hipFuncSetAttribute((const void*)mega<false>, hipFuncAttributeMaxDynamicSharedMemorySize, LDS_BYTES);
        hipOccupancyMaxActiveBlocksPerMultiprocessor(&per_cu, (const void*)mega<false>, NTHR, LDS_BYTES);
        if (per_cu < 1) { fprintf(stderr, "kernel_launch: occupancy query says %d blocks/CU\n", per_cu); per_cu = 1; }
        (void)hipGetLastError();
        grid = cus * 1;
    }
    if (grid < 0) return;
    Params p{};
    for (int i = 0; i < 33; ++i) p.in[i] = (const float*)d_in[i];
    p.out = (float*)d_out; p.ws = (unsigned char*)d_ws;
    (void)hipMemsetAsync((char*)d_ws + WS_BAR, 0, MK_TPROBE ? 131072 : XCD_BAR_WORDS * 4, stream);
#if MK_MULTI
    for (int ph = 0; ph < NPHASE; ++ph) hipLaunchKernelGGL(mega<false>, dim3(grid), dim3(NTHR), LDS_BYTES, stream, p, ph, ph + 1);
#else
    int lo = 0, hi = NPHASE;
    void* args[] = {&p, &lo, &hi};
    hipError_t e = hipLaunchCooperativeKernel((const void*)mega<false>, dim3(grid), dim3(NTHR), args, LDS_BYTES, stream);
    if (e != hipSuccess) fprintf(stderr, "cooperative launch failed: %s (grid %d)\n", hipGetErrorString(e), grid);
#endif
#if MK_XPH >= 0
    { static bool once = false; if (!once) { (void)hipFuncSetAttribute((const void*)mega<true>, hipFuncAttributeMaxDynamicSharedMemorySize, LDS_BYTES); once = true; } }
    for (int i = 0; i < MK_XN; ++i) hipLaunchKernelGGL(mega<true>, dim3(grid), dim3(NTHR), LDS_BYTES, stream, p, MK_XPH, MK_XPH + 1);
#endif
}
```

```cpp
#include <hip/hip_runtime.h>
#include <hip/hip_cooperative_groups.h>
#include <cstdio>
#include <cstdint>
namespace cg = cooperative_groups;
#ifndef MK_SEL2
#define MK_SEL2 0
#define MK_SC2 0
#define MK_BIS2 0
#define MK_IQUEUE 1
#define MK_WT 1
#define IDX_NV 64
#define MK_ICOMP 1
#define IDX_CLIM 640
#define MK_ISRCH 0
#define MK_A64 1
#define MK_B64 1
#define MK_SP2 true
#define MK_XA2 0
#define MK_FUSE 7
#define MK_AX 0
#define MK_TPROBE 0
#endif

#define DEVI __device__ __forceinline__
#define LAS __attribute__((address_space(3)))
typedef unsigned short bf16_t;
typedef short bf16x8 __attribute__((ext_vector_type(8)));
typedef short s16x4 __attribute__((ext_vector_type(4)));
typedef float f32x2 __attribute__((ext_vector_type(2)));
typedef float f32x4 __attribute__((ext_vector_type(4)));
typedef float f32x16 __attribute__((ext_vector_type(16)));
typedef unsigned u32x2 __attribute__((ext_vector_type(2)));
typedef unsigned u32x4 __attribute__((ext_vector_type(4)));
typedef unsigned long long u64;

constexpr int NB = 4, S = 4096, T = NB * S, D = 1024, DFF = 4096, MEML = 256, MEMT = NB * MEML;
constexpr int LDP = 2816;
constexpr int C_QA = 0, C_KA = 512, C_VA = 1024, C_QB = 1536, C_CKV = 2048, C_QI = 2304, C_KI = 2560, C_WI = 2624, EVEN_IN = 2628;
constexpr float EPS = 1e-6f;
constexpr float LOG2E = 1.4426950408889634f;
constexpr int NTHR = 512, NWAVE = 8;
constexpr int LDS_BYTES = 163840;

constexpr size_t MiB = 1u << 20;
constexpr size_t WS_SSQ = 0;
constexpr size_t WS_SSQCKV = WS_SSQ + 6ull * T * 4;
constexpr size_t WS_SSQMEM = WS_SSQCKV + (size_t)T * 4;
constexpr size_t WS_WI = 512 * 1024;
constexpr size_t WS_BAR = 1 * MiB;
constexpr size_t WS_W = 2 * MiB;
constexpr size_t W_INE = WS_W;
constexpr size_t W_KVUP = W_INE + (size_t)LDP * 1024 * 2;
constexpr size_t W_OUTE = W_KVUP + 1024ull * 256 * 2;
constexpr size_t W_QX = W_OUTE + 1024ull * 1024 * 2;
constexpr size_t W_KVX = W_QX + 2 * 512ull * 1024 * 2;
constexpr size_t W_OX = W_KVX + 2 * 1024ull * 1024 * 2;
constexpr size_t W_UP = W_OX + 2 * 1024ull * 512 * 2;
constexpr size_t W_DOWN = W_UP + 2 * 4096ull * 1024 * 2;
constexpr size_t W_INO = W_DOWN + 2 * 4096ull * 1024 * 2;
constexpr size_t W_POOL = W_INO + 2048ull * 1024 * 2;
constexpr size_t W_OUTO = W_POOL + 512ull * 512 * 2;
constexpr size_t W_END = W_OUTO + 1024ull * 1024 * 2;
static_assert(W_END <= 57 * MiB, "weights region");
constexpr size_t WS_XB = 57 * MiB;
constexpr size_t WS_PROJ = 89 * MiB;
constexpr size_t WS_KBVB = 177 * MiB;
constexpr size_t WS_MASK = 209 * MiB;
constexpr size_t WS_Y = 217 * MiB;
constexpr size_t WS_CS = 249 * MiB;
constexpr size_t WS_MB = 250 * MiB;
constexpr size_t WS_KVX = 252 * MiB;
constexpr size_t WS_END = 256 * MiB;
constexpr size_t WS_QX = WS_PROJ;
constexpr size_t WS_YX = WS_PROJ + 16 * MiB;
constexpr size_t WS_H = WS_PROJ;
constexpr size_t WS_PROJ1 = WS_PROJ;
constexpr size_t WS_POOLED = WS_PROJ + 64 * MiB;
constexpr size_t WS_KI = WS_Y;

struct Params { const float* in[33]; float* out; unsigned char* ws; };

DEVI float bf2f(bf16_t v) { return __uint_as_float(((unsigned)v) << 16); }
DEVI unsigned f2bf(float f) { unsigned u = __float_as_uint(f); return (u + 0x7fffu + ((u >> 16) & 1u)) >> 16; }
DEVI unsigned pk2(float lo, float hi) { return f2bf(lo) | (f2bf(hi) << 16); }
DEVI float wave_sum(float v) {
#pragma unroll
    for (int o = 1; o < 64; o <<= 1) v += __shfl_xor(v, o);
    return v;
}
DEVI float lo16(unsigned w) { return __uint_as_float(w << 16); }
DEVI float hi16(unsigned w) { return __uint_as_float(w & 0xffff0000u); }
#define LDS_WAIT() asm volatile("s_waitcnt lgkmcnt(0)" ::: "memory")
DEVI void st16_wt(void* p, u32x4 w) { asm volatile("global_store_dwordx4 %0, %1, off sc0 sc1\n\ts_nop 1" :: "v"(p), "v"(w) : "memory"); }
DEVI unsigned cvtpk(float lo, float hi) { typedef __bf16 bf2 __attribute__((ext_vector_type(2))); f32x2 v = {lo, hi}; bf2 b = __builtin_convertvector(v, bf2); return __builtin_bit_cast(unsigned, b); }

extern __shared__ __attribute__((aligned(16))) unsigned char lds_raw[];
constexpr int WTAB_OFF = 163840 - 128;
DEVI unsigned hw_slot() { return (unsigned)__builtin_amdgcn_s_getreg((5 << 11) | 4) & 63u; }
DEVI int tid_opaque() { int w = ((volatile LAS unsigned char*)lds_raw)[WTAB_OFF + hw_slot()]; w = __builtin_amdgcn_readfirstlane(w); asm volatile("" : "+s"(w));
    const int l = __builtin_amdgcn_mbcnt_hi(~0u, __builtin_amdgcn_mbcnt_lo(~0u, 0u)); return w * 64 + l; }
struct TrD { const float* src; bf16_t* dst; const float* sk; const float* sn; int K, N, ldd; };
constexpr int NTR = 19;
DEVI TrD get_tr(const Params& P, int i) {
    unsigned char* ws = P.ws; TrD d; d.sk = nullptr; d.sn = nullptr;
    switch (i) {
    case 0: d.src = P.in[14]; d.dst = (bf16_t*)(ws + W_INE); d.K = 1024; d.N = EVEN_IN; d.ldd = 1024; d.sk = P.in[3]; break;
    case 1: d.src = P.in[23]; d.dst = (bf16_t*)(ws + W_KVUP); d.K = 256; d.N = 1024; d.ldd = 256; d.sk = P.in[22]; break;
    case 2: d.src = P.in[27]; d.dst = (bf16_t*)(ws + W_OUTE); d.K = 1024; d.N = 1024; d.ldd = 1024; break;
    case 3: case 4: { int l = i - 3; d.src = P.in[7] + (size_t)l * 1024 * 512; d.dst = (bf16_t*)(ws + W_QX) + (size_t)l * 512 * 1024; d.K = 1024; d.N = 512; d.ldd = 1024; d.sk = P.in[4] + l * 1024; } break;
    case 5: case 6: { int l = i - 5; d.src = P.in[8] + (size_t)l * 1024 * 1024; d.dst = (bf16_t*)(ws + W_KVX) + (size_t)l * 1024 * 1024; d.K = 1024; d.N = 1024; d.ldd = 1024; d.sk = P.in[5] + l * 1024; } break;
    case 7: case 8: { int l = i - 7; d.src = P.in[11] + (size_t)l * 512 * 1024; d.dst = (bf16_t*)(ws + W_OX) + (size_t)l * 1024 * 512; d.K = 512; d.N = 1024; d.ldd = 512; } break;
    case 9: case 10: { int l = i - 9; d.src = P.in[12] + (size_t)l * 1024 * 4096; d.dst = (bf16_t*)(ws + W_UP) + (size_t)l * 4096 * 1024; d.K = 1024; d.N = 4096; d.ldd = 1024; d.sk = P.in[6] + l * 1024; } break;
    case 11: case 12: { int l = i - 11; d.src = P.in[13] + (size_t)l * 4096 * 1024; d.dst = (bf16_t*)(ws + W_DOWN) + (size_t)l * 1024 * 4096; d.K = 4096; d.N = 1024; d.ldd = 4096; } break;
    case 13: d.src = P.in[28]; d.dst = (bf16_t*)(ws + W_INO); d.K = 1024; d.N = 2048; d.ldd = 1024; d.sk = P.in[3] + 1024; break;
    case 14: case 15: case 16: case 17: d.src = P.in[30]; d.dst = (bf16_t*)(ws + W_POOL); d.K = 0; d.N = 32; d.ldd = 512; break;
    default: d.src = P.in[32]; d.dst = (bf16_t*)(ws + W_OUTO); d.K = 512; d.N = 1024; d.ldd = 1024; break;
    }
    return d;
}
DEVI int tr_items(const TrD& d) { return (d.K / 64) * ((d.N + 31) / 32); }
template <bool SK, bool SN>
DEVI void tr_item(const TrD& d, LAS float* scr, int item, int lane) {
    const int nblk = (d.N + 31) / 32, kb = item / nblk, nb = item % nblk, k0 = 64 * kb, n0 = 32 * nb;
    const int n = n0 + (lane & 31), nc = (n < d.N) ? n : (d.N - 1);
    const float* sp = d.src + (size_t)(k0 + (lane >> 5)) * d.N + nc;
    float v[32], sk[32];
#pragma unroll
    for (int i = 0; i < 32; ++i) { v[i] = sp[(size_t)(2 * i) * d.N]; if (SK) sk[i] = d.sk[k0 + 2 * i + (lane >> 5)]; }
#pragma unroll
    for (int i = 0; i < 32; ++i) { float x = v[i]; if (SK) x *= sk[i]; if (n >= d.N) x = 0.f; scr[(2 * i + (lane >> 5)) * 33 + (lane & 31)] = x; }
    LDS_WAIT(); asm volatile("" ::: "memory");
    const int c = lane & 7;
#pragma unroll
    for (int j = 0; j < 4; ++j) {
        const int nn = (lane >> 3) + 8 * j, ncl = (n0 + nn < d.N) ? (n0 + nn) : (d.N - 1);
        const LAS float* s = scr + (8 * c) * 33 + nn;
        float sc = 1.f; if (SN) sc = d.sn[ncl];
        u32x4 o; o.x = pk2(s[0 * 33] * sc, s[1 * 33] * sc); o.y = pk2(s[2 * 33] * sc, s[3 * 33] * sc); o.z = pk2(s[4 * 33] * sc, s[5 * 33] * sc); o.w = pk2(s[6 * 33] * sc, s[7 * 33] * sc);
        if (n0 + nn < d.N) *(u32x4*)(d.dst + (size_t)(n0 + nn) * d.ldd + k0 + 8 * c) = o;
    }
    LDS_WAIT(); asm volatile("" ::: "memory");
}
template <int NR>
DEVI void rows_to_bf16_ssq(const float* x, bf16_t* o, float* ssq_out, int m0, int stride, int nrows, int lane) {
    f32x4 v[NR][4];
#pragma unroll
    for (int k = 0; k < NR; ++k) { const int m = (m0 + k * stride < nrows) ? m0 + k * stride : m0; const f32x4* xr = (const f32x4*)(x + (size_t)m * D) + lane;
#pragma unroll
        for (int j = 0; j < 4; ++j) v[k][j] = xr[64 * j]; }
#pragma unroll
    for (int k = 0; k < NR; ++k) { const int m = m0 + k * stride; if (m >= nrows) break;
        float s = 0.f;
#pragma unroll
        for (int j = 0; j < 4; ++j) s += (v[k][j].x * v[k][j].x + v[k][j].y * v[k][j].y) + (v[k][j].z * v[k][j].z + v[k][j].w * v[k][j].w);
        s = wave_sum(s);
        if (lane == 0) ssq_out[m] = s;
        u32x2* o8 = (u32x2*)(o + (size_t)m * D) + lane;
#pragma unroll
        for (int j = 0; j < 4; ++j) { u32x2 w; w.x = pk2(v[k][j].x, v[k][j].y); w.y = pk2(v[k][j].z, v[k][j].w); o8[64 * j] = w; } }
}
#ifndef MK_SUB
#define MK_SUB 0
#endif
DEVI void convert_weights(const Params& P, LAS unsigned char* lds, int dlo, int dhi, bool fold, int gw, int NGW, int gt, int NGT) {
    const int tid = tid_opaque(), lane = tid & 63, wave = tid >> 6;
    unsigned char* ws = P.ws;
    LAS float* scr = (LAS float*)(lds + wave * 16384);
    int base = 0;
    for (int i = dlo; i < dhi; ++i) {
        const TrD d = get_tr(P, i); const int n = tr_items(d);
        int first = gw - (base % NGW); if (first < 0) first += NGW;
        if (d.sn) { for (int it = first; it < n; it += NGW) tr_item<false, true>(d, scr, it, lane); }
        else if (d.sk) { for (int it = first; it < n; it += NGW) tr_item<true, false>(d, scr, it, lane); }
        else { for (int it = first; it < n; it += NGW) tr_item<false, false>(d, scr, it, lane); }
        base += n;
    }
    if (!fold) return;
    (void)gt; (void)NGT;
    for (int unit = gw; unit < 2048; unit += NGW) {
        const int nb = unit & 15, cb = (unit >> 4) & 31, g = unit >> 9, c = cb * 4, n = nb * 64 + lane;
        const float* wo = P.in[32] + (size_t)(512 + g * 128) * 1024 + n; const float* wp = P.in[30] + (size_t)g * 16384 + (size_t)c * 128; const float* ps = P.in[31] + g * 128;
        { const f32x2 p = *(const f32x2*)(ps + 2 * lane);
#pragma unroll
          for (int j = 0; j < 4; ++j) { const f32x2 w = *(const f32x2*)(wp + j * 128 + 2 * lane); scr[j * 128 + 2 * lane] = w.x * p.x; scr[j * 128 + 2 * lane + 1] = w.y * p.y; } }
        LDS_WAIT(); asm volatile("" ::: "memory");
        float acc[4] = {0.f, 0.f, 0.f, 0.f};
        for (int d0 = 0; d0 < 128; d0 += 16) {
            float wv[16];
#pragma unroll
            for (int dd = 0; dd < 16; ++dd) wv[dd] = wo[(size_t)(d0 + dd) * 1024];
#pragma unroll
            for (int dd = 0; dd < 16; dd += 4)
#pragma unroll
                for (int j = 0; j < 4; ++j) { const f32x4 w4 = *(const LAS f32x4*)(scr + j * 128 + d0 + dd); acc[j] += (w4.x * wv[dd] + w4.y * wv[dd + 1]) + (w4.z * wv[dd + 2] + w4.w * wv[dd + 3]); }
        }
        u32x2 w; w.x = pk2(acc[0], acc[1]); w.y = pk2(acc[2], acc[3]);
        *(u32x2*)((bf16_t*)(ws + W_OUTO) + (size_t)n * 1024 + 512 + g * 128 + c) = w;
        LDS_WAIT(); asm volatile("" ::: "memory");
    }
}
constexpr int NTR_EARLY = 7;
DEVI void phase_prologue(const Params& P, LAS unsigned char* lds, int dry = 0) {
    const int tid = tid_opaque(), lane = tid & 63, wave = tid >> 6;
#if MK_TPROBE == 20
    { float a0 = lane, a1 = lane + 1, a2 = lane + 2, a3 = lane + 3, a4 = lane + 4, a5 = lane + 5, a6 = lane + 6, a7 = lane + 7;
      unsigned long long t0_ = __builtin_amdgcn_s_memtime();
      for (int it = 0; it < 1000; ++it) {
#pragma unroll
          for (int k = 0; k < 8; ++k) { asm volatile("v_fma_f32 %0, %0, 1.0, %0\n\tv_fma_f32 %1, %1, 1.0, %1\n\tv_fma_f32 %2, %2, 1.0, %2\n\tv_fma_f32 %3, %3, 1.0, %3\n\tv_fma_f32 %4, %4, 1.0, %4\n\tv_fma_f32 %5, %5, 1.0, %5\n\tv_fma_f32 %6, %6, 1.0, %6\n\tv_fma_f32 %7, %7, 1.0, %7" : "+v"(a0), "+v"(a1), "+v"(a2), "+v"(a3), "+v"(a4), "+v"(a5), "+v"(a6), "+v"(a7)); }
      }
      unsigned long long t1_ = __builtin_amdgcn_s_memtime();
      asm volatile("" :: "v"(a0), "v"(a1), "v"(a2), "v"(a3), "v"(a4), "v"(a5), "v"(a6), "v"(a7));
      if (blockIdx.x == 0 && tid == 0) atomicAdd((unsigned long long*)(P.ws + WS_BAR + 65536) + 3, t1_ - t0_); }
#endif
    const int gw = blockIdx.x * NWAVE + wave, NGW = gridDim.x * NWAVE;
    const int gt = blockIdx.x * NTHR + tid, NGT = gridDim.x * NTHR;
    unsigned char* ws = P.ws;
    convert_weights(P, lds, 0, NTR_EARLY, false, gw, NGW, gt, NGT);
    { bf16_t* w = (bf16_t*)(ws + W_INE) + (size_t)EVEN_IN * 1024; const int n = (LDP - EVEN_IN) * 1024 / 8;
      for (int i = gt; i < n; i += NGT) ((u32x4*)w)[i] = (u32x4){0u, 0u, 0u, 0u}; }
    { float* q = (float*)(ws + WS_SSQ) + T; for (int i = gt; i < 5 * T; i += NGT) q[i] = 0.f; }
    if (!(dry && MK_SUB != 2 && MK_SUB != 0))
    for (int m = gw; m < T; m += 4 * NGW) rows_to_bf16_ssq<4>(P.in[0], (bf16_t*)(ws + WS_XB), (float*)(ws + WS_SSQ), m, NGW, T, lane);
    for (int m = gw; m < MEMT; m += NGW) rows_to_bf16_ssq<1>(P.in[1], (bf16_t*)(ws + WS_MB), (float*)(ws + WS_SSQMEM), m, NGW, MEMT, lane);
    if (!(dry && MK_SUB != 3 && MK_SUB != 0))
    { const int* pos = (const int*)P.in[2]; float* cs = (float*)(ws + WS_CS);
      for (int i = gt; i < T * 8; i += NGT) { const int m = i >> 3, f = i & 7;
        const double inv = (f == 0) ? 1.0 : (f == 1) ? 0.19392274474868576 : (f == 2) ? 0.03760603093086393 : (f == 3) ? 0.007292664737217109 : (f == 4) ? 0.001414213562373095
                         : (f == 5) ? 0.0002742481756762073 : (f == 6) ? 5.318295896944988e-05 : 1.031338537721246e-05;
        const double ang = (double)pos[m] * inv, k = rint(ang * 0.15915494309189535), r = fma(-k, 6.283185307179586, ang) - k * 2.4492935982947064e-16;
        cs[m * 16 + f] = cosf((float)r); cs[m * 16 + 8 + f] = sinf((float)r); } }
}

struct EpiStore {
    bf16_t* O; int ldo; const float* ssq; float inv_n; int act;
    DEVI void operator()(const f32x4 (&acc)[4][4], int row0, int col0, int lane) const {
#pragma unroll
        for (int m = 0; m < 4; ++m)
#pragma unroll
            for (int i = 0; i < 4; ++i) {
                const int row = row0 + 16 * m + (lane >> 4) * 4 + i;
                const float rs = ssq ? rsqrtf(ssq[row] * inv_n + EPS) : 1.f;
#pragma unroll
                for (int n = 0; n < 4; ++n) {
                    float v = acc[m][n][i] * rs;
                    if (act == 1) { v = fmaxf(v, 0.f); v = v * v; }
                    O[(size_t)row * ldo + col0 + 16 * n + (lane & 15)] = (bf16_t)f2bf(v);
                }
            }
    }
};
struct EpiRes {
    const float* base; float* out; bf16_t* xb; float* ssq_next;
    DEVI void operator()(const f32x4 (&acc)[4][4], int row0, int col0, int lane) const {
#pragma unroll
        for (int m = 0; m < 4; ++m)
#pragma unroll
            for (int i = 0; i < 4; ++i) {
                const int row = row0 + 16 * m + (lane >> 4) * 4 + i; float s = 0.f;
#pragma unroll
                for (int n = 0; n < 4; ++n) {
                    const size_t idx = (size_t)row * D + col0 + 16 * n + (lane & 15);
                    const float v = base[idx] + acc[m][n][i];
                    out[idx] = v; s += v * v;
                    if (xb) xb[idx] = (bf16_t)f2bf(v);
                }
                if (ssq_next) {
                    s += __shfl_xor(s, 1); s += __shfl_xor(s, 2); s += __shfl_xor(s, 4); s += __shfl_xor(s, 8);
                    if ((lane & 15) == 0) atomicAdd(ssq_next + row, s);
                }
            }
    }
};
template <class Epi>
DEVI void gemm_simple(const bf16_t* A, int lda, const bf16_t* Bt, int ldb, int M, int N, int K, const Epi& epi) {
    const int tid = tid_opaque(), lane = tid & 63, wave = tid >> 6;
    const int gw = blockIdx.x * NWAVE + wave, NGW = gridDim.x * NWAVE;
    const int nN = N / 64, ntiles = (M / 64) * nN;
    for (int tile = gw; tile < ntiles; tile += NGW) {
        const int row0 = (tile / nN) * 64, col0 = (tile % nN) * 64;
        f32x4 acc[4][4];
#pragma unroll
        for (int m = 0; m < 4; ++m)
#pragma unroll
            for (int n = 0; n < 4; ++n) acc[m][n] = (f32x4){0.f, 0.f, 0.f, 0.f};
        const bf16_t* ap = A + (size_t)(row0 + (lane & 15)) * lda + 8 * (lane >> 4);
        const bf16_t* bp = Bt + (size_t)(col0 + (lane & 15)) * ldb + 8 * (lane >> 4);
        for (int k0 = 0; k0 < K; k0 += 32) {
            bf16x8 a[4], b[4];
#pragma unroll
            for (int m = 0; m < 4; ++m) a[m] = *(const bf16x8*)(ap + (size_t)(16 * m) * lda + k0);
#pragma unroll
            for (int n = 0; n < 4; ++n) b[n] = *(const bf16x8*)(bp + (size_t)(16 * n) * ldb + k0);
#pragma unroll
            for (int m = 0; m < 4; ++m)
#pragma unroll
                for (int n = 0; n < 4; ++n) acc[m][n] = __builtin_amdgcn_mfma_f32_16x16x32_bf16(a[m], b[n], acc[m][n], 0, 0, 0);
        }
        epi(acc, row0, col0, lane);
    }
}

DEVI u32x4 heads8(u32x4 raw, const float (&gv)[8], bool do_norm, float scale, const float (&cs)[16], int lane) {
    float v[8];
#pragma unroll
    for (int j = 0; j < 4; ++j) { v[2 * j] = lo16(raw[j]); v[2 * j + 1] = hi16(raw[j]); }
    if (do_norm) {
        float ss = 0.f;
#pragma unroll
        for (int j = 0; j < 8; ++j) ss += v[j] * v[j];
        ss += __shfl_xor(ss, 1); ss += __shfl_xor(ss, 2); ss += __shfl_xor(ss, 4);
        const float rs = rsqrtf(ss * (1.f / 64.f) + EPS);
#pragma unroll
        for (int j = 0; j < 8; ++j) v[j] = v[j] * rs * gv[j];
    }
    const int sub = lane & 7;
#pragma unroll
    for (int j = 0; j < 8; ++j) { const float o = __shfl_xor(v[j], 1); if (sub == 0) v[j] = v[j] * cs[j] - o * cs[8 + j]; else if (sub == 1) v[j] = v[j] * cs[j] + o * cs[8 + j]; }
    u32x4 w;
#pragma unroll
    for (int j = 0; j < 4; ++j) w[j] = cvtpk(v[2 * j] * scale, v[2 * j + 1] * scale);
    return w;
}
DEVI void load8(float (&g)[8], const float* p) { const f32x4 a = *(const f32x4*)p, b = *(const f32x4*)(p + 4); g[0] = a[0]; g[1] = a[1]; g[2] = a[2]; g[3] = a[3]; g[4] = b[0]; g[5] = b[1]; g[6] = b[2]; g[7] = b[3]; }
struct Post0Row { u32x4 qa, ka, qb, x, ckv; u32x2 wi; f32x4 c0, c1, c2, c3; };
DEVI void post0_load(Post0Row& R, const bf16_t* row, const float* cs, int lane) {
    R.qa = *(const u32x4*)(row + C_QA + 8 * lane); R.ka = *(const u32x4*)(row + C_KA + 8 * lane); R.qb = *(const u32x4*)(row + C_QB + 8 * lane);
    R.x = *(const u32x4*)(row + C_QI + 8 * ((lane < 40) ? lane : 0));
    R.ckv = *(const u32x4*)(row + C_CKV + 8 * (lane & 31));
    R.wi = *(const u32x2*)(row + C_WI);
    R.c0 = *(const f32x4*)cs; R.c1 = *(const f32x4*)(cs + 4); R.c2 = *(const f32x4*)(cs + 8); R.c3 = *(const f32x4*)(cs + 12);
}
DEVI void phase_post0(const Params& P, int parts = 3) {
    static_assert(C_KI == C_QI + 256, "k_idx follows q_idx");
    const int tid = tid_opaque(), lane = tid & 63, wave = tid >> 6;
    const int gw = blockIdx.x * NWAVE + wave, NGW = gridDim.x * NWAVE;
    unsigned char* ws = P.ws;
    const float qscale = 0.125f * LOG2E;
    float gqa[8], gka[8], gqb[8], gki[8];
    load8(gqa, P.in[15] + 8 * (lane & 7)); load8(gka, P.in[16] + 8 * (lane & 7)); load8(gqb, P.in[24] + 8 * (lane & 7)); load8(gki, P.in[26] + 8 * (lane & 7));
    if (parts & 1)
    for (int m0 = gw; m0 < T; m0 += 2 * NGW) {
        Post0Row R[2];
        const int m1 = (m0 + NGW < T) ? m0 + NGW : m0;
        post0_load(R[0], (const bf16_t*)(ws + WS_PROJ) + (size_t)m0 * LDP, (const float*)(ws + WS_CS) + (size_t)m0 * 16, lane);
        post0_load(R[1], (const bf16_t*)(ws + WS_PROJ) + (size_t)m1 * LDP, (const float*)(ws + WS_CS) + (size_t)m1 * 16, lane);
#pragma unroll
        for (int k = 0; k < 2; ++k) {
            const int m = k ? m1 : m0; if (k == 1 && m1 == m0) break;
            bf16_t* row = (bf16_t*)(ws + WS_PROJ) + (size_t)m * LDP;
            float cs[16];
#pragma unroll
            for (int j = 0; j < 4; ++j) { cs[j] = R[k].c0[j]; cs[4 + j] = R[k].c1[j]; cs[8 + j] = R[k].c2[j]; cs[12 + j] = R[k].c3[j]; }
            *(u32x4*)(row + C_QA + 8 * lane) = heads8(R[k].qa, gqa, true, qscale, cs, lane);
            *(u32x4*)(row + C_KA + 8 * lane) = heads8(R[k].ka, gka, true, 1.f, cs, lane);
            *(u32x4*)(row + C_QB + 8 * lane) = heads8(R[k].qb, gqb, true, qscale, cs, lane);
            {
              float v[8];
#pragma unroll
              for (int j = 0; j < 4; ++j) { v[2 * j] = lo16(R[k].x[j]); v[2 * j + 1] = hi16(R[k].x[j]); }
              float ss = 0.f;
#pragma unroll
              for (int j = 0; j < 8; ++j) ss += v[j] * v[j];
              ss += __shfl_xor(ss, 1); ss += __shfl_xor(ss, 2); ss += __shfl_xor(ss, 4);
              if (lane >= 32) { const float rs = rsqrtf(ss * (1.f / 64.f) + EPS);
#pragma unroll
                  for (int j = 0; j < 8; ++j) v[j] = v[j] * rs * gki[j]; }
              const int sub = lane & 7;
#pragma unroll
              for (int j = 0; j < 8; ++j) { const float o = __shfl_xor(v[j], 1); if (sub == 0) v[j] = v[j] * cs[j] - o * cs[8 + j]; else if (sub == 1) v[j] = v[j] * cs[j] + o * cs[8 + j]; }
              u32x4 w;
#pragma unroll
              for (int j = 0; j < 4; ++j) w[j] = cvtpk(v[2 * j], v[2 * j + 1]);
              if (lane < 32) *(u32x4*)(row + C_QI + 8 * lane) = w;
              else if (lane < 40) { const int c = lane - 32;
                  *(u32x4*)((bf16_t*)(ws + WS_KI) + (size_t)(m >> 5) * 2048 + (c >> 1) * 512 + (((c & 1) * 32 + (m & 31)) * 8)) = w; } }
            { float ss = 0.f;
#pragma unroll
              for (int j = 0; j < 4; ++j) { const float a = lo16(R[k].ckv[j]), b = hi16(R[k].ckv[j]); ss += a * a + b * b; }
              ss += __shfl_xor(ss, 1); ss += __shfl_xor(ss, 2); ss += __shfl_xor(ss, 4); ss += __shfl_xor(ss, 8); ss += __shfl_xor(ss, 16);
              if (lane == 0) { ((float*)(ws + WS_SSQCKV))[m] = ss;
                  *(f32x4*)((float*)(ws + WS_WI) + (size_t)m * 4) = (f32x4){lo16(R[k].wi.x) * (1.f / 16.f), hi16(R[k].wi.x) * (1.f / 16.f), lo16(R[k].wi.y) * (1.f / 16.f), hi16(R[k].wi.y) * (1.f / 16.f)}; } }
        }
    }
    if (parts & 2)
    for (int it = gw; it < 2 * MEMT; it += NGW) {
        const int l = it / MEMT, m = it % MEMT;
        bf16_t* row = (bf16_t*)(ws + WS_KVX) + (size_t)m * 2048 + l * 1024;
        float g[8]; load8(g, P.in[10] + l * 128 + 8 * (lane & 15));
        const u32x4 raw = *(const u32x4*)(row + 8 * lane);
        float v[8]; float ss = 0.f;
#pragma unroll
        for (int j = 0; j < 4; ++j) { v[2 * j] = lo16(raw[j]); v[2 * j + 1] = hi16(raw[j]); ss += v[2 * j] * v[2 * j] + v[2 * j + 1] * v[2 * j + 1]; }
        ss += __shfl_xor(ss, 1); ss += __shfl_xor(ss, 2); ss += __shfl_xor(ss, 4); ss += __shfl_xor(ss, 8);
        const float rs = rsqrtf(ss * (1.f / 128.f) + EPS);
        u32x4 w;
#pragma unroll
        for (int j = 0; j < 4; ++j) w[j] = cvtpk(v[2 * j] * rs * g[2 * j], v[2 * j + 1] * rs * g[2 * j + 1]);
        *(u32x4*)(row + 8 * lane) = w;
    }
}
DEVI void phase_postkb(const Params& P) {
    const int tid = tid_opaque(), lane = tid & 63, wave = tid >> 6;
    const int gw = blockIdx.x * NWAVE + wave, NGW = gridDim.x * NWAVE;
    unsigned char* ws = P.ws;
    float gkb[8]; load8(gkb, P.in[25] + 8 * (lane & 7));
    for (int m0 = gw; m0 < T; m0 += 4 * NGW) {
        u32x4 raw[4]; f32x4 c[4][4];
#pragma unroll
        for (int k = 0; k < 4; ++k) { const int m = (m0 + k * NGW < T) ? m0 + k * NGW : m0;
            raw[k] = *(const u32x4*)((const bf16_t*)(ws + WS_KBVB) + (size_t)m * 1024 + 8 * lane);
            const float* cs = (const float*)(ws + WS_CS) + (size_t)m * 16;
#pragma unroll
            for (int j = 0; j < 4; ++j) c[k][j] = *(const f32x4*)(cs + 4 * j); }
#pragma unroll
        for (int k = 0; k < 4; ++k) { const int m = m0 + k * NGW; if (m >= T) break;
            float cs[16];
#pragma unroll
            for (int j = 0; j < 16; ++j) cs[j] = c[k][j >> 2][j & 3];
            *(u32x4*)((bf16_t*)(ws + WS_KBVB) + (size_t)m * 1024 + 8 * lane) = heads8(raw[k], gkb, true, 1.f, cs, lane); }
    }
}

DEVI int crow(int r, int hi) { return (r & 3) + 8 * (r >> 2) + 4 * hi; }
typedef short v4i16_t __attribute__((ext_vector_type(4)));
DEVI s16x4 vtr(LAS const unsigned char* p) { return __builtin_bit_cast(s16x4, __builtin_amdgcn_ds_read_tr16_b64_v4i16((LAS v4i16_t*)p)); }

DEVI float max3f(float a, float b, float c) { float r; asm("v_max3_f32 %0, %1, %2, %3" : "=v"(r) : "v"(a), "v"(b), "v"(c)); return r; }
DEVI float max2f(float a, float b) { float r; asm("v_max_f32_e32 %0, %1, %2" : "=v"(r) : "v"(a), "v"(b)); return r; }
template <int DQK, int DV, int MODE, bool QP = false>
DEVI void attn_core(f32x16 (&o)[DV / 32], float& l_out, const bf16x8 (&qf)[DQK / 16],
                    const bf16_t* Kg, int ldk, const bf16_t* Vg, int ldv, int ntiles, int qpos, int qpos_wmin,
                    const u64* mrow, LAS unsigned char* lds, int tid) {
    constexpr int KROWB = DQK * 2, KCPR = DQK / 8, VP = (DV == 128) ? 320 : 192, VCPR = DV / 8;
    constexpr int KBUF = 64 * KROWB, VBUF = 64 * VP, KCH = 64 * KCPR / NTHR, VCH = 64 * VCPR / NTHR;
    constexpr float THR = 8.f;
#define KSWZ(r) ((KCPR == 8) ? (((r) >> 1) & 7) : ((r) & 15))
    LAS unsigned char* Kl = lds; LAS unsigned char* Vl = lds + 2 * KBUF;
    const int lane = tid & 63, r32 = lane & 31, hi = lane >> 5;
    u32x4 kreg[KCH], vreg[VCH];
#define A_GLOAD(t) do { _Pragma("unroll") for (int i_ = 0; i_ < KCH; ++i_) { const int c_ = tid + NTHR * i_, row_ = c_ / KCPR, ch_ = c_ % KCPR; kreg[i_] = *(const u32x4*)(Kg + (size_t)(64 * (t) + row_) * ldk + ch_ * 8); } \
        _Pragma("unroll") for (int i_ = 0; i_ < VCH; ++i_) { const int c_ = tid + NTHR * i_, row_ = c_ / VCPR, ch_ = c_ % VCPR; vreg[i_] = *(const u32x4*)(Vg + (size_t)(64 * (t) + row_) * ldv + ch_ * 8); } } while (0)
#define A_LSTORE(buf) do { _Pragma("unroll") for (int i_ = 0; i_ < KCH; ++i_) { const int c_ = tid + NTHR * i_, row_ = c_ / KCPR, ch_ = c_ % KCPR; *(LAS u32x4*)(Kl + (buf) * KBUF + row_ * KROWB + ((ch_ ^ KSWZ(row_)) << 4)) = kreg[i_]; } \
        _Pragma("unroll") for (int i_ = 0; i_ < VCH; ++i_) { const int c_ = tid + NTHR * i_, row_ = c_ / VCPR, ch_ = c_ % VCPR; *(LAS u32x4*)(Vl + (buf) * VBUF + row_ * VP + ch_ * 16) = vreg[i_]; } } while (0)
    A_GLOAD(0); A_LSTORE(0); __syncthreads();
#pragma unroll
    for (int d0 = 0; d0 < DQK / 16; ++d0) asm volatile("" :: "v"(qf[d0]));
    const int vb = (4 * hi + ((lane & 15) >> 2)) * VP + (16 * ((lane >> 4) & 1) + 4 * (lane & 3)) * 2;
    const short one = (short)0x3F80;
    const bf16x8 ones = ((r32 & ~4) == 0) ? (bf16x8){one, one, one, one, one, one, one, one} : (bf16x8){0, 0, 0, 0, 0, 0, 0, 0};
    f32x16 negm, lacc;
#pragma unroll
    for (int r = 0; r < 16; ++r) { negm[r] = 0.f; lacc[r] = 0.f; }
    float mhat = 0.f;
    const unsigned ninf = 0xFF800000u;
#if MK_AX == 1
    f32x16 dmy_;
#pragma unroll
    for (int r = 0; r < 16; ++r) dmy_[r] = 0.f;
#endif
    u64 wnext = 0ull;
    if (MODE == 2) wnext = mrow[0];
    for (int t = 0; t < ntiles; ++t) {
        const int buf = t & 1;
        const u64 wcur = wnext; (void)wcur;
        if (MODE == 2 && t + 1 < ntiles) wnext = mrow[t + 1];
        if (t + 1 < ntiles) A_GLOAD(t + 1);
        f32x16 p0, p1;
#pragma unroll
        for (int db = 0; db < DQK / 64; ++db) {
            bf16x8 kf[8];
#pragma unroll
            for (int e = 0; e < 4; ++e) { const int ch = 2 * (4 * db + e) + hi, row0 = r32, row1 = 32 + r32;
                if (!QP) {
                    kf[2 * e] = *(LAS const bf16x8*)(Kl + buf * KBUF + row0 * KROWB + ((ch ^ KSWZ(row0)) << 4));
                    kf[2 * e + 1] = *(LAS const bf16x8*)(Kl + buf * KBUF + row1 * KROWB + ((ch ^ KSWZ(row1)) << 4));
                } else {
                    const int c1 = 2 * (4 * db + e);
                    const s16x4 a0 = *(LAS const s16x4*)(Kl + buf * KBUF + row0 * KROWB + ((c1 ^ KSWZ(row0)) << 4) + 8 * hi), a1 = *(LAS const s16x4*)(Kl + buf * KBUF + row0 * KROWB + (((c1 + 1) ^ KSWZ(row0)) << 4) + 8 * hi);
                    const s16x4 b0 = *(LAS const s16x4*)(Kl + buf * KBUF + row1 * KROWB + ((c1 ^ KSWZ(row1)) << 4) + 8 * hi), b1 = *(LAS const s16x4*)(Kl + buf * KBUF + row1 * KROWB + (((c1 + 1) ^ KSWZ(row1)) << 4) + 8 * hi);
                    kf[2 * e] = (bf16x8){a0[0], a0[1], a0[2], a0[3], a1[0], a1[1], a1[2], a1[3]}; kf[2 * e + 1] = (bf16x8){b0[0], b0[1], b0[2], b0[3], b1[0], b1[1], b1[2], b1[3]};
                } }
#pragma unroll
            for (int e = 0; e < 4; ++e) { const int d0 = 4 * db + e;
                if (d0 == 0 && MODE == 2) {
                    const u64 w = wcur >> (4 * hi); const unsigned wl = (unsigned)w, wh = (unsigned)(w >> 32), nm = __float_as_uint(negm[0]);
#pragma unroll
                    for (int r = 0; r < 16; ++r) { const int bit = (r & 3) + 8 * (r >> 2);
                        const unsigned s0 = (unsigned)__builtin_amdgcn_sbfe(wl, bit, 1), s1 = (unsigned)__builtin_amdgcn_sbfe(wh, bit, 1);
                        p0[r] = __uint_as_float((nm & s0) | (ninf & ~s0)); p1[r] = __uint_as_float((nm & s1) | (ninf & ~s1)); }
                    p0 = __builtin_amdgcn_mfma_f32_32x32x16_bf16(kf[0], qf[0], p0, 0, 0, 0); p1 = __builtin_amdgcn_mfma_f32_32x32x16_bf16(kf[1], qf[0], p1, 0, 0, 0); }
                else if (d0 == 0) { p0 = __builtin_amdgcn_mfma_f32_32x32x16_bf16(kf[0], qf[0], negm, 0, 0, 0); p1 = __builtin_amdgcn_mfma_f32_32x32x16_bf16(kf[1], qf[0], negm, 0, 0, 0); }
                else { p0 = __builtin_amdgcn_mfma_f32_32x32x16_bf16(kf[2 * e], qf[d0], p0, 0, 0, 0); p1 = __builtin_amdgcn_mfma_f32_32x32x16_bf16(kf[2 * e + 1], qf[d0], p1, 0, 0, 0); } }
        }
        if (MODE == 1) {
            if (64 * t + 63 > qpos_wmin) {
#pragma unroll
                for (int r = 0; r < 16; ++r) { const int kv = 64 * t + crow(r, hi); if (kv > qpos) p0[r] = -INFINITY; if (kv + 32 > qpos) p1[r] = -INFINITY; }
            }
        }
        asm volatile("s_nop 15\n\ts_nop 7" : "+v"(p0), "+v"(p1));
        float rm;
        { float a, b;
#define MAX16(R, X) asm("v_max3_f32 %0, %1, %2, %3\n\tv_max3_f32 %0, %0, %4, %5\n\tv_max3_f32 %0, %0, %6, %7\n\tv_max3_f32 %0, %0, %8, %9\n\tv_max3_f32 %0, %0, %10, %11\n\tv_max3_f32 %0, %0, %12, %13\n\tv_max3_f32 %0, %0, %14, %15\n\tv_max_f32 %0, %0, %16" \
            : "=&v"(R) : "v"(X[0]), "v"(X[1]), "v"(X[2]), "v"(X[3]), "v"(X[4]), "v"(X[5]), "v"(X[6]), "v"(X[7]), "v"(X[8]), "v"(X[9]), "v"(X[10]), "v"(X[11]), "v"(X[12]), "v"(X[13]), "v"(X[14]), "v"(X[15]))
          MAX16(a, p0); MAX16(b, p1);
#undef MAX16
          const float m = max2f(a, b);
          const auto rr = __builtin_amdgcn_permlane32_swap(__float_as_uint(m), __float_as_uint(m), false, false);
          rm = max2f(__uint_as_float(rr[0]), __uint_as_float(rr[1])); }
        if (t == 0 || __any(rm > THR)) {
            const float dl = (t == 0) ? ((rm > -INFINITY) ? rm : 0.f) : fmaxf(rm, 0.f);
            mhat += dl;
#pragma unroll
            for (int r = 0; r < 16; ++r) { p0[r] -= dl; p1[r] -= dl; negm[r] = -mhat; }
            const float f = __builtin_amdgcn_exp2f(-dl);
#pragma unroll
            for (int d0 = 0; d0 < DV / 32; ++d0)
#pragma unroll
                for (int r = 0; r < 16; ++r) o[d0][r] *= f;
#pragma unroll
            for (int r = 0; r < 16; ++r) lacc[r] *= f;
        }
#pragma unroll
        for (int r = 0; r < 16; ++r) { p0[r] = __builtin_amdgcn_exp2f(p0[r]); p1[r] = __builtin_amdgcn_exp2f(p1[r]); }
#if MK_AX == 2
        if (MODE == 1) {
#pragma unroll
            for (int r = 0; r < 16; ++r) { float e0 = __builtin_amdgcn_exp2f(p0[r] * 0.999f), e1 = __builtin_amdgcn_exp2f(p1[r] * 0.999f); asm volatile("" :: "v"(e0), "v"(e1)); } }
#endif
        bf16x8 pb[4];
#pragma unroll
        for (int ks = 0; ks < 4; ++ks) {
            u32x4 w;
            if (ks < 2) { w.x = cvtpk(p0[8 * ks + 0], p0[8 * ks + 1]); w.y = cvtpk(p0[8 * ks + 2], p0[8 * ks + 3]); w.z = cvtpk(p0[8 * ks + 4], p0[8 * ks + 5]); w.w = cvtpk(p0[8 * ks + 6], p0[8 * ks + 7]); }
            else { const int k2 = ks - 2; w.x = cvtpk(p1[8 * k2 + 0], p1[8 * k2 + 1]); w.y = cvtpk(p1[8 * k2 + 2], p1[8 * k2 + 3]); w.z = cvtpk(p1[8 * k2 + 4], p1[8 * k2 + 5]); w.w = cvtpk(p1[8 * k2 + 6], p1[8 * k2 + 7]); }
            pb[ks] = __builtin_bit_cast(bf16x8, w);
        }
#pragma unroll
        for (int ks = 0; ks < 4; ++ks) lacc = __builtin_amdgcn_mfma_f32_32x32x16_bf16(ones, pb[ks], lacc, 0, 0, 0);
#pragma unroll
        for (int d0 = 0; d0 < DV / 32; ++d0)
#pragma unroll
            for (int ks = 0; ks < 4; ++ks) {
                const s16x4 lo = vtr(Vl + buf * VBUF + vb + (16 * ks) * VP + d0 * 64);
                const s16x4 hh = vtr(Vl + buf * VBUF + vb + (16 * ks + 8) * VP + d0 * 64);
                const bf16x8 a = (bf16x8){lo[0], lo[1], lo[2], lo[3], hh[0], hh[1], hh[2], hh[3]};
                o[d0] = __builtin_amdgcn_mfma_f32_32x32x16_bf16(a, pb[ks], o[d0], 0, 0, 0);
#if MK_AX == 1
                if (MODE == 1) dmy_ = __builtin_amdgcn_mfma_f32_32x32x16_bf16(a, pb[ks], dmy_, 0, 0, 0);
#endif
            }
        if (t + 1 < ntiles) A_LSTORE((t + 1) & 1);
        __syncthreads();
    }
#if MK_AX == 1
    asm volatile("" :: "v"(dmy_));
#endif
    l_out = lacc[0];
#undef A_GLOAD
#undef A_LSTORE
#undef KSWZ
}
template <int DV>
DEVI void store_oT(const f32x16 (&o)[DV / 32], float inv, bf16_t* dst, int hi) {
#pragma unroll
    for (int d0 = 0; d0 < DV / 32; ++d0)
#pragma unroll
        for (int g4 = 0; g4 < 4; ++g4) {
            u32x2 w; w.x = cvtpk(o[d0][4 * g4 + 0] * inv, o[d0][4 * g4 + 1] * inv); w.y = cvtpk(o[d0][4 * g4 + 2] * inv, o[d0][4 * g4 + 3] * inv);
            *(u32x2*)(dst + 32 * d0 + 8 * g4 + 4 * hi) = w;
        }
}

DEVI void attnA_unit(const Params& P, int b, int h, int c, int qb, LAS unsigned char* lds) {
    const int tid = tid_opaque(), lane = tid & 63, wave = tid >> 6, r32 = lane & 31, hi = lane >> 5;
    unsigned char* ws = P.ws;
    const bf16_t* proj = (const bf16_t*)(ws + WS_PROJ);
    const int q = qb * 256 + 32 * wave + r32; const size_t row = (size_t)b * S + q;
    bf16x8 qf[4];
#pragma unroll
    for (int d0 = 0; d0 < 4; ++d0) qf[d0] = *(const bf16x8*)(proj + row * LDP + C_QA + (2 * h + c) * 64 + 16 * d0 + 8 * hi);
    f32x16 o[4];
#pragma unroll
    for (int d0 = 0; d0 < 4; ++d0)
#pragma unroll
        for (int r = 0; r < 16; ++r) o[d0][r] = 0.f;
    float l_run = 0.f;
    attn_core<64, 128, 1>(o, l_run, qf, proj + (size_t)b * S * LDP + C_KA + (2 * h + c) * 64, LDP, proj + (size_t)b * S * LDP + C_VA + h * 128, LDP,
                          4 * (qb + 1), q, qb * 256 + 32 * wave, nullptr, lds, tid);
    const float lt = l_run;
    bf16_t* oa = (bf16_t*)(ws + WS_XB) + (size_t)c * T * 512 + row * 512 + h * 128;
    store_oT<128>(o, 1.f / lt, oa, hi);
}
namespace b64 {
constexpr int SLOTB = 8192, LDS_K = 0, LDS_V = 3 * SLOTB, LDS_M = 6 * SLOTB, LDS_WS = LDS_M + NWAVE * 768, LDS_OST = LDS_WS + NWAVE * 256;
typedef const LAS unsigned char* lptr;
#define B64_SBAR() __builtin_amdgcn_sched_barrier(0)
#define B64_PIN(x) asm volatile("" : "+v"(x))
#define B64_MFMA(a, b, c) __builtin_amdgcn_mfma_f32_32x32x16_bf16(a, b, c, 0, 0, 0)
#define B64_WAIT_BAR(N) asm volatile("s_waitcnt vmcnt(" #N ") lgkmcnt(0)\n\ts_barrier" ::: "memory")
DEVI int crow(int r, int hi) { return (r & 3) + 8 * (r >> 2) + 4 * hi; }
DEVI unsigned cvtpk_a(float lo, float hi) { unsigned r; asm("v_cvt_pk_bf16_f32 %0, %1, %2" : "=v"(r) : "v"(lo), "v"(hi)); return r; }
DEVI void glds16(const void* g, unsigned lds_base) {
    asm volatile("s_mov_b32 m0, %1\n\ts_nop 0\n\tglobal_load_lds_dwordx4 %0, off" :: "v"(g), "s"(lds_base) : "memory", "m0"); }
DEVI void glds4(const void* g, unsigned lds_base) {
    asm volatile("s_mov_b32 m0, %1\n\ts_nop 0\n\tglobal_load_lds_dword %0, off" :: "v"(g), "s"(lds_base) : "memory", "m0"); }
DEVI void kload2(bf16x8* kf, lptr kp, int d0) { kf[2 * d0] = *(const LAS bf16x8*)(kp + d0 * 2048); kf[2 * d0 + 1] = *(const LAS bf16x8*)(kp + d0 * 2048 + 512); }
#define B64_MX3(a, b, c) __builtin_fmaxf(__builtin_fmaxf((a), (b)), (c))
DEVI float rowmax(const f32x16& p0, const f32x16& p1) {
    float a = B64_MX3(p0[0], p0[1], p1[0]), b = B64_MX3(p0[2], p0[3], p1[1]); a = B64_MX3(a, p1[2], p1[3]);
#pragma unroll
    for (int r = 4; r < 16; r += 4) { a = B64_MX3(a, p0[r], p0[r + 1]); b = B64_MX3(b, p0[r + 2], p0[r + 3]); a = B64_MX3(a, p1[r], p1[r + 1]); b = B64_MX3(b, p1[r + 2], p1[r + 3]); }
    float m = __builtin_fmaxf(a, b); auto rr = __builtin_amdgcn_permlane32_swap(__float_as_uint(m), __float_as_uint(m), false, false);
    return __builtin_fmaxf(__uint_as_float(rr[0]), __uint_as_float(rr[1])); }
DEVI float cinit(unsigned w, int r, unsigned nm) { const unsigned s = (unsigned)__builtin_amdgcn_sbfe(w, (r & 3) + 8 * (r >> 2), 1); float d;
    asm("v_bfi_b32 %0, %1, %2, %3" : "=v"(d) : "v"(s), "v"(nm), "s"(0xFF800000u)); return d; }
DEVI bool unit(int qb, const bf16_t* Q, int ldq, const bf16_t* __restrict__ K, const bf16_t* __restrict__ V, bf16_t* O, const u64* msk, LAS unsigned char* lds) {
    constexpr int DM = 1024;
    const int tid = tid_opaque(), lane = tid & 63, r32 = lane & 31, hi = lane >> 5; const int wid = __builtin_amdgcn_readfirstlane(tid >> 6);
    const int q0 = qb * 256, NT = 4 * qb + 4;
    const bf16_t* Qw = Q + (size_t)(q0 + wid * 32) * ldq;
    const unsigned lds0 = (unsigned)(size_t)lds; LAS float* wsf = (LAS float*)(lds + LDS_WS) + wid * 64;
    const bf16_t* ksrc = K + (size_t)lane * DM + wid * 8;
    const bf16_t* vsrc = V + (size_t)(16 * (wid & 3) + (lane >> 2)) * DM + (wid >> 2) * 32 + (lane & 3) * 8;
    const unsigned* msrc = (const unsigned*)(msk + (size_t)(q0 + wid * 32 + (lane >> 1)) * 64) + (lane & 1);
    const unsigned kdst = lds0 + LDS_K + wid * 1024, vdst = lds0 + LDS_V + wid * 1024, mdst = lds0 + LDS_M + wid * 768;
#define DMA_K(t, slot) glds16(ksrc + (size_t)(t) * 64 * DM, (unsigned)__builtin_amdgcn_readfirstlane(kdst + (slot)))
#define DMA_V(t, slot) glds16(vsrc + (size_t)(t) * 64 * DM, (unsigned)__builtin_amdgcn_readfirstlane(vdst + (slot)))
#define DMA_M(t, slot) glds4(msrc + 2 * (t), (unsigned)__builtin_amdgcn_readfirstlane(mdst + ((slot) >> 5)))
    const lptr vp0 = (lptr)lds + LDS_V + ((lane >> 4) & 1) * 32 + (lane & 3) * 8 + (4 * hi + ((lane & 15) >> 2)) * 64;
    const lptr kp0 = (lptr)lds + LDS_K + hi * 1024 + r32 * 16;
    const lptr mp0 = (lptr)lds + LDS_M + wid * 768 + r32 * 8;
    DMA_M(0, 0); DMA_K(0, 0); DMA_V(0, 0); DMA_K(1, SLOTB); DMA_M(1, SLOTB);
    bf16x8 qr[4];
#pragma unroll
    for (int d0 = 0; d0 < 4; ++d0) qr[d0] = *(const bf16x8*)(Qw + (size_t)r32 * ldq + d0 * 16 + hi * 8);
    float l_reg = 0.f; f32x16 o[2];
    volatile LAS unsigned* flagp = (volatile LAS unsigned*)(lds + LDS_WS); if (tid == 0) *flagp = 0u;
#pragma unroll
    for (int r = 0; r < 16; ++r) { o[0][r] = 0.f; o[1][r] = 0.f; }
    f32x16 pA0, pA1, pB0, pB1; bf16x8 kf[8]; s16x4 vlo[8], vhi[8]; u32x4 pw0, pw1, pw2, pw3;
    int sl_prev = 0, sl_cur = 0, sl_next = SLOTB;
#define ROT() do { sl_prev = sl_cur; sl_cur = sl_next; sl_next = (sl_next == 2 * SLOTB) ? 0 : sl_next + SLOTB; } while (0)
#define EX(v) __builtin_amdgcn_exp2f(v)
#define RESC() do { } while (0)
    DMA_K(2, 2 * SLOTB); DMA_M(2, 2 * SLOTB);
    B64_WAIT_BAR(4);
    _Pragma("unroll") for (int d0 = 0; d0 < 4; ++d0) kload2(kf, kp0, d0);
    { const u64 w = *(const LAS u64*)(mp0) >> (4 * hi); const unsigned wl = (unsigned)w, wh = (unsigned)(w >> 32);
#pragma unroll
      for (int r = 0; r < 16; ++r) { pA0[r] = cinit(wl, r, 0u); pA1[r] = cinit(wh, r, 0u); } }
    pA0 = B64_MFMA(kf[0], qr[0], pA0); pA1 = B64_MFMA(kf[1], qr[0], pA1); pA0 = B64_MFMA(kf[2], qr[1], pA0); pA1 = B64_MFMA(kf[3], qr[1], pA1);
    pA0 = B64_MFMA(kf[4], qr[2], pA0); pA1 = B64_MFMA(kf[5], qr[2], pA1); pA0 = B64_MFMA(kf[6], qr[3], pA0); pA1 = B64_MFMA(kf[7], qr[3], pA1);
#pragma unroll
    for (int r = 0; r < 16; ++r) { pA0[r] = EX(pA0[r]); pA1[r] = EX(pA1[r]); }
    B64_WAIT_BAR(0);
    DMA_K(3, 0); DMA_M(3, 0); DMA_V(1, SLOTB); ROT();
    _Pragma("unroll") for (int d0 = 0; d0 < 4; ++d0) kload2(kf, kp0 + sl_cur, d0);
    { const u64 w = *(const LAS u64*)(mp0 + (sl_cur >> 5)) >> (4 * hi); const unsigned wl = (unsigned)w, wh = (unsigned)(w >> 32);
#pragma unroll
      for (int r = 0; r < 16; ++r) { pB0[r] = cinit(wl, r, 0u); pB1[r] = cinit(wh, r, 0u); } }
    B64_WAIT_BAR(3);
#define PKW(P, i) cvtpk(P[i], P[i + 1])
#define PAF(k) __builtin_bit_cast(bf16x8, pw##k)
#define VFR(i) (bf16x8){vlo[i][0], vlo[i][1], vlo[i][2], vlo[i][3], vhi[i][0], vhi[i][1], vhi[i][2], vhi[i][3]}
#define VRD(i) do { vlo[i] = vtr(vp_ + (((i) >> 2) * 4096 + ((i) & 3) * 1024)); vhi[i] = vtr(vp_ + (((i) >> 2) * 4096 + ((i) & 3) * 1024 + 512)); } while (0)
#define KRD(G, d0) do { if (G) { kload2(kf, kp0 + sl_next, d0); B64_SBAR(); } } while (0)
#define GAPA(MF, a0, a1, a2, a3, W0, W1, PW) do { MF; sacc += a0; sacc += a1; sacc += a2; sacc += a3; W0; W1; B64_PIN(PW); B64_PIN(sacc); B64_SBAR(); } while (0)
#define GAPB(MF, X, i, G, N, WN) do { MF; X[i] = EX(X[i]); X[i + 1] = EX(X[i + 1]); X[i + 2] = EX(X[i + 2]); X[i + 3] = EX(X[i + 3]); \
        if (G) { N[i] = cinit(WN, i, nm); N[i + 1] = cinit(WN, i + 1, nm); N[i + 2] = cinit(WN, i + 2, nm); N[i + 3] = cinit(WN, i + 3, nm); B64_PIN(N); } B64_PIN(X); B64_SBAR(); } while (0)
#define STEP(C0, C1, P0, P1, t, GK, GV, GL) do { B64_SBAR(); \
    const lptr vp_ = vp0 + sl_prev; \
    VRD(0); B64_SBAR(); float sacc = P0[0] + P0[1]; \
                        GAPA(C0 = B64_MFMA(kf[0], qr[0], C0), P0[2], P0[3], P0[4], P0[5],     pw0[0] = PKW(P0, 0),  pw0[1] = PKW(P0, 2),  pw0); \
    VRD(4); B64_SBAR(); GAPA(C1 = B64_MFMA(kf[1], qr[0], C1), P0[6], P0[7], P0[8], P0[9],     pw0[2] = PKW(P0, 4),  pw0[3] = PKW(P0, 6),  pw0); \
    VRD(1); B64_SBAR(); GAPA(C0 = B64_MFMA(kf[2], qr[1], C0), P0[10], P0[11], P0[12], P0[13], pw1[0] = PKW(P0, 8),  pw1[1] = PKW(P0, 10), pw1); \
    VRD(5); B64_SBAR(); GAPA(C1 = B64_MFMA(kf[3], qr[1], C1), P0[14], P0[15], P1[0], P1[1],   pw1[2] = PKW(P0, 12), pw1[3] = PKW(P0, 14), pw1); \
    VRD(2); B64_SBAR(); GAPA(C0 = B64_MFMA(kf[4], qr[2], C0), P1[2], P1[3], P1[4], P1[5],     pw2[0] = PKW(P1, 0),  pw2[1] = PKW(P1, 2),  pw2); \
    VRD(6); B64_SBAR(); GAPA(C1 = B64_MFMA(kf[5], qr[2], C1), P1[6], P1[7], P1[8], P1[9],     pw2[2] = PKW(P1, 4),  pw2[3] = PKW(P1, 6),  pw2); \
    VRD(3); B64_SBAR(); GAPA(C0 = B64_MFMA(kf[6], qr[3], C0), P1[10], P1[11], P1[12], P1[13], pw3[0] = PKW(P1, 8),  pw3[1] = PKW(P1, 10), pw3); \
    VRD(7); B64_SBAR(); GAPA(C1 = B64_MFMA(kf[7], qr[3], C1), P1[14], P1[15], 0.f, 0.f,       pw3[2] = PKW(P1, 12), pw3[3] = PKW(P1, 14), pw3); \
    l_reg += sacc; \
    if (GK) { DMA_K((t) + 3, sl_cur); DMA_M((t) + 3, sl_cur); } if (GV) DMA_V((t) + 1, sl_next); \
    const unsigned nm = 0u; unsigned wl_ = 0, wh_ = 0; \
    if (GL) { const u64 w = *(const LAS u64*)(mp0 + (sl_next >> 5)) >> (4 * hi); wl_ = (unsigned)w; wh_ = (unsigned)(w >> 32); } B64_SBAR(); \
    GAPB(o[0] = B64_MFMA(PAF(0), VFR(0), o[0]), C0, 0, GL, P0, wl_);              GAPB(o[1] = B64_MFMA(PAF(0), VFR(4), o[1]), C0, 4, GL, P0, wl_); \
    KRD(GL, 0); GAPB(o[0] = B64_MFMA(PAF(1), VFR(1), o[0]), C0, 8, GL, P0, wl_);  KRD(GL, 1); GAPB(o[1] = B64_MFMA(PAF(1), VFR(5), o[1]), C0, 12, GL, P0, wl_); \
    KRD(GL, 2); GAPB(o[0] = B64_MFMA(PAF(2), VFR(2), o[0]), C1, 0, GL, P1, wh_);  KRD(GL, 3); GAPB(o[1] = B64_MFMA(PAF(2), VFR(6), o[1]), C1, 4, GL, P1, wh_); \
    GAPB(o[0] = B64_MFMA(PAF(3), VFR(3), o[0]), C1, 8, GL, P1, wh_);              GAPB(o[1] = B64_MFMA(PAF(3), VFR(7), o[1]), C1, 12, GL, P1, wh_); \
    } while (0)
    int t = 1;
    for (; t + 5 < NT; t += 2) {
        STEP(pB0, pB1, pA0, pA1, t, true, true, true);     B64_WAIT_BAR(3); RESC(); ROT();
        STEP(pA0, pA1, pB0, pB1, t + 1, true, true, true); B64_WAIT_BAR(3); RESC(); ROT();
    }
#define ENDW(tt) do { if ((tt) + 3 < NT) { B64_WAIT_BAR(3); } else if ((tt) + 2 < NT) { B64_WAIT_BAR(1); } else { B64_WAIT_BAR(0); } } while (0)
    for (; t + 1 < NT; t += 2) {
        STEP(pB0, pB1, pA0, pA1, t, (t + 3 < NT), (t + 1 < NT), (t + 1 < NT));         ENDW(t);     RESC(); ROT();
        STEP(pA0, pA1, pB0, pB1, t + 1, (t + 4 < NT), (t + 2 < NT), (t + 2 < NT));     ENDW(t + 1); RESC(); ROT();
    }
    STEP(pB0, pB1, pA0, pA1, NT - 1, false, false, false); RESC();
    { float sacc = pB0[0] + pB0[1];
#pragma unroll
      for (int r = 2; r < 16; ++r) sacc += pB0[r];
#pragma unroll
      for (int r = 0; r < 16; ++r) sacc += pB1[r];
      l_reg += sacc;
      pw0 = (u32x4){PKW(pB0, 0), PKW(pB0, 2), PKW(pB0, 4), PKW(pB0, 6)}; pw1 = (u32x4){PKW(pB0, 8), PKW(pB0, 10), PKW(pB0, 12), PKW(pB0, 14)};
      pw2 = (u32x4){PKW(pB1, 0), PKW(pB1, 2), PKW(pB1, 4), PKW(pB1, 6)}; pw3 = (u32x4){PKW(pB1, 8), PKW(pB1, 10), PKW(pB1, 12), PKW(pB1, 14)};
      const lptr vp_ = vp0 + sl_cur; _Pragma("unroll") for (int i = 0; i < 8; ++i) VRD(i);
      o[0] = B64_MFMA(PAF(0), VFR(0), o[0]); o[1] = B64_MFMA(PAF(0), VFR(4), o[1]); o[0] = B64_MFMA(PAF(1), VFR(1), o[0]); o[1] = B64_MFMA(PAF(1), VFR(5), o[1]);
      o[0] = B64_MFMA(PAF(2), VFR(2), o[0]); o[1] = B64_MFMA(PAF(2), VFR(6), o[1]); o[0] = B64_MFMA(PAF(3), VFR(3), o[0]); o[1] = B64_MFMA(PAF(3), VFR(7), o[1]); }
    { auto rr = __builtin_amdgcn_permlane32_swap(__float_as_uint(l_reg), __float_as_uint(l_reg), false, false); l_reg = __uint_as_float(rr[0]) + __uint_as_float(rr[1]); }
    if (hi == 0) wsf[32 + r32] = l_reg;
    if (__any(!(l_reg > 1e-30f && l_reg < 1e30f)) && lane == 0) *flagp = 1u;
    asm volatile("s_waitcnt lgkmcnt(0)" ::: "memory");
    float rli[16];
#pragma unroll
    for (int r = 0; r < 16; ++r) rli[r] = __builtin_amdgcn_rcpf(wsf[32 + crow(r, hi)]);
    bf16_t* Ow = O + (size_t)(q0 + wid * 32) * DM; LAS bf16_t* stg = (LAS bf16_t*)(lds + LDS_OST) + wid * 2048;
#pragma unroll
    for (int r = 0; r < 16; r += 2) { const int orow = crow(r, hi);
#pragma unroll
        for (int d0 = 0; d0 < 2; ++d0) { const unsigned pk = cvtpk(o[d0][r] * rli[r], o[d0][r + 1] * rli[r + 1]);
            stg[orow * 64 + d0 * 32 + r32] = (bf16_t)(pk & 0xFFFFu); stg[(orow + 1) * 64 + d0 * 32 + r32] = (bf16_t)(pk >> 16); } }
    asm volatile("s_waitcnt lgkmcnt(0)" ::: "memory");
#pragma unroll
    for (int i = 0; i < 4; ++i) { const int row = i * 8 + (lane >> 3), ch = lane & 7; *(u32x4*)(Ow + (size_t)row * DM + ch * 8) = *(const LAS u32x4*)(stg + row * 64 + ch * 8); }
    asm volatile("s_waitcnt lgkmcnt(0)\n\ts_barrier" ::: "memory");
    const unsigned bad = *flagp;
    asm volatile("s_waitcnt lgkmcnt(0)\n\ts_barrier" ::: "memory");
    return __builtin_amdgcn_readfirstlane(bad) != 0u;
#undef DMA_K
#undef DMA_V
#undef DMA_M
#undef ROT
#undef EX
#undef RESC
#undef PKW
#undef PAF
#undef VFR
#undef VRD
#undef KRD
#undef ENDW
#undef GAPA
#undef GAPB
#undef STEP
}
}
namespace a64 {
using b64::lptr; using b64::crow; using b64::cvtpk_a; using b64::glds16; using b64::kload2; using b64::rowmax;
constexpr int SLOTK = 8192, SLOTV = 16384, LDS_K = 0, LDS_V = 3 * SLOTK, LDS_WS = LDS_V + 3 * SLOTV, LDS_OST = LDS_WS + NWAVE * 256;
DEVI void glds16s(const void* base, unsigned off, unsigned lds_base) {
    asm volatile("s_mov_b32 m0, %2\n\ts_nop 0\n\tglobal_load_lds_dwordx4 %0, %1" :: "v"(off), "s"(base), "s"(lds_base) : "memory", "m0"); }
DEVI void cmask(f32x16& p0, f32x16& p1, int jb, int qrel, int hi) {
    const int kb = 64 * jb + 4 * hi;
#pragma unroll
    for (int r = 0; r < 16; ++r) { const int kv = kb + (r & 3) + 8 * (r >> 2); if (kv > qrel) p0[r] = -INFINITY; if (kv + 32 > qrel) p1[r] = -INFINITY; } }
DEVI bool unit(int qb, const bf16_t* Q, const bf16_t* __restrict__ K, const bf16_t* __restrict__ V, int ld, bf16_t* O, int ldo, LAS unsigned char* lds) {
    const int tid = tid_opaque(); int lane = tid & 63; asm volatile("" : "+v"(lane));
    const int r32 = lane & 31, hi = lane >> 5; const int wid = __builtin_amdgcn_readfirstlane(tid >> 6);
    const int q0 = qb * 256, NT = 4 * qb + 4;
    const bf16_t* Qw = Q + (size_t)(q0 + wid * 32) * ld;
    const unsigned lds0 = (unsigned)(size_t)lds; LAS float* wsf = (LAS float*)(lds + LDS_WS) + wid * 64;
    const unsigned koff = (unsigned)(lane * ld + wid * 8) * 2u;
    const unsigned voff = (unsigned)((16 * (wid & 3) + (lane >> 2)) * ld + (wid >> 2) * 32 + (lane & 3) * 8) * 2u;
    const unsigned tstep = (unsigned)(64 * ld) * 2u;
    const unsigned kdst = lds0 + LDS_K + wid * 1024, vdst = lds0 + LDS_V + wid * 1024;
#define DMA_K(t, slot) glds16s(K, koff + (unsigned)(t) * tstep, (unsigned)__builtin_amdgcn_readfirstlane(kdst + (slot)))
#define DMA_V(t, slot) do { const unsigned vo_ = voff + (unsigned)(t) * tstep; glds16s(V, vo_, (unsigned)__builtin_amdgcn_readfirstlane(vdst + 2 * (slot))); glds16s(V, vo_ + 128u, (unsigned)__builtin_amdgcn_readfirstlane(vdst + 2 * (slot) + 8192)); } while (0)
    const lptr vp0 = (lptr)lds + LDS_V + ((lane >> 4) & 1) * 32 + (lane & 3) * 8 + (4 * hi + ((lane & 15) >> 2)) * 64;
    const lptr kp0 = (lptr)lds + LDS_K + hi * 1024 + r32 * 16;
    DMA_K(0, 0); DMA_V(0, 0); DMA_K(1, SLOTK);
    const lptr qp0 = (lptr)lds + LDS_OST + wid * 8192 + lane * 16;
    bf16x8 qq[2];
    { bf16x8 qr[4];
#pragma unroll
      for (int d0 = 0; d0 < 4; ++d0) qr[d0] = *(const bf16x8*)(Qw + (size_t)r32 * ld + d0 * 16 + hi * 8);
#pragma unroll
      for (int d0 = 0; d0 < 4; ++d0) *(LAS bf16x8*)(lds + LDS_OST + wid * 8192 + lane * 16 + d0 * 1024) = qr[d0]; }
#define QRD(d0) qq[(d0) & 1] = *(const LAS bf16x8*)(qp0 + (d0) * 1024)
    float l_reg = 0.f; f32x16 o[4];
    volatile LAS unsigned* flagp = (volatile LAS unsigned*)(lds + LDS_WS); if (tid == 0) *flagp = 0u;
#pragma unroll
    for (int r = 0; r < 16; ++r) { o[0][r] = 0.f; o[1][r] = 0.f; o[2][r] = 0.f; o[3][r] = 0.f; }
    const f32x16 zero16 = {0.f, 0.f, 0.f, 0.f, 0.f, 0.f, 0.f, 0.f, 0.f, 0.f, 0.f, 0.f, 0.f, 0.f, 0.f, 0.f};
    f32x16 pA0, pA1, pB0, pB1; bf16x8 kf[8]; s16x4 vlo[8], vhi[8]; u32x4 pw0, pw1, pw2, pw3;
    int sl_prev = 0, sl_cur = 0, sl_next = SLOTK;
#define ROT() do { sl_prev = sl_cur; sl_cur = sl_next; sl_next = (sl_next == 2 * SLOTK) ? 0 : sl_next + SLOTK; } while (0)
#define EX(v) __builtin_amdgcn_exp2f(v)
#define RESC() do { } while (0)
    DMA_K(2, 2 * SLOTK);
    B64_WAIT_BAR(4);
    _Pragma("unroll") for (int d0 = 0; d0 < 4; ++d0) kload2(kf, kp0, d0);
    QRD(0); QRD(1);
    pA0 = B64_MFMA(kf[0], qq[0], zero16); pA1 = B64_MFMA(kf[1], qq[0], zero16); pA0 = B64_MFMA(kf[2], qq[1], pA0); pA1 = B64_MFMA(kf[3], qq[1], pA1); B64_SBAR();
    QRD(2); QRD(3);
    pA0 = B64_MFMA(kf[4], qq[0], pA0); pA1 = B64_MFMA(kf[5], qq[0], pA1); pA0 = B64_MFMA(kf[6], qq[1], pA0); pA1 = B64_MFMA(kf[7], qq[1], pA1); B64_SBAR();
    QRD(0); QRD(1);
    if (NT == 4) cmask(pA0, pA1, 0, wid * 32 + r32, hi);
#pragma unroll
    for (int r = 0; r < 16; ++r) { pA0[r] = EX(pA0[r]); pA1[r] = EX(pA1[r]); }
    B64_WAIT_BAR(0);
    DMA_K(3, 0); DMA_V(1, SLOTK); ROT();
    _Pragma("unroll") for (int d0 = 0; d0 < 4; ++d0) kload2(kf, kp0 + sl_cur, d0);
    B64_WAIT_BAR(3);
#define PKW(P, i) cvtpk(P[i], P[i + 1])
#define PAF(k) __builtin_bit_cast(bf16x8, pw##k)
#define VFR(i) (bf16x8){vlo[(i) & 7][0], vlo[(i) & 7][1], vlo[(i) & 7][2], vlo[(i) & 7][3], vhi[(i) & 7][0], vhi[(i) & 7][1], vhi[(i) & 7][2], vhi[(i) & 7][3]}
#define VRD(f) do { vlo[(f) & 7] = vtr(vp_ + (((f) & 3) * 4096 + ((f) >> 2) * 1024)); vhi[(f) & 7] = vtr(vp_ + (((f) & 3) * 4096 + ((f) >> 2) * 1024 + 512)); } while (0)
#define KRD(G, d0) do { if (G) { kload2(kf, kp0 + sl_next, d0); B64_SBAR(); } } while (0)
#define GAPA(MF, a0, a1, a2, a3, W0, W1, PW) do { MF; sacc += a0; sacc += a1; sacc += a2; sacc += a3; W0; W1; B64_PIN(PW); B64_PIN(sacc); B64_SBAR(); } while (0)
#define GAPB(g, kq, X, i) do { o[(g) & 3] = B64_MFMA(PAF(kq), VFR(g), o[(g) & 3]); X[i] = EX(X[i]); X[(i) + 1] = EX(X[(i) + 1]); B64_PIN(X); if ((g) < 8) VRD((g) + 8); B64_SBAR(); } while (0)
#define STEP(C0, C1, P0, P1, t, MASK, GK, GV, GL) do { B64_SBAR(); \
    const lptr vp_ = vp0 + 2 * sl_prev; \
    float sacc = P0[0] + P0[1]; \
                        GAPA(C0 = B64_MFMA(kf[0], qq[0], zero16), P0[2], P0[3], P0[4], P0[5],     pw0[0] = PKW(P0, 0),  pw0[1] = PKW(P0, 2),  pw0); \
                        GAPA(C1 = B64_MFMA(kf[1], qq[0], zero16), P0[6], P0[7], P0[8], P0[9],     pw0[2] = PKW(P0, 4),  pw0[3] = PKW(P0, 6),  pw0); \
    QRD(2); B64_SBAR(); GAPA(C0 = B64_MFMA(kf[2], qq[1], C0),     P0[10], P0[11], P0[12], P0[13], pw1[0] = PKW(P0, 8),  pw1[1] = PKW(P0, 10), pw1); \
                        GAPA(C1 = B64_MFMA(kf[3], qq[1], C1),     P0[14], P0[15], P1[0], P1[1],   pw1[2] = PKW(P0, 12), pw1[3] = PKW(P0, 14), pw1); \
    QRD(3); VRD(0); B64_SBAR(); GAPA(C0 = B64_MFMA(kf[4], qq[0], C0),     P1[2], P1[3], P1[4], P1[5],     pw2[0] = PKW(P1, 0),  pw2[1] = PKW(P1, 2),  pw2); \
    VRD(1); B64_SBAR(); GAPA(C1 = B64_MFMA(kf[5], qq[0], C1),     P1[6], P1[7], P1[8], P1[9],     pw2[2] = PKW(P1, 4),  pw2[3] = PKW(P1, 6),  pw2); \
    VRD(2); B64_SBAR(); GAPA(C0 = B64_MFMA(kf[6], qq[1], C0),     P1[10], P1[11], P1[12], P1[13], pw3[0] = PKW(P1, 8),  pw3[1] = PKW(P1, 10), pw3); \
    VRD(3); B64_SBAR(); GAPA(C1 = B64_MFMA(kf[7], qq[1], C1),     P1[14], P1[15], 0.f, 0.f,       pw3[2] = PKW(P1, 12), pw3[3] = PKW(P1, 14), pw3); \
    l_reg += sacc; \
    VRD(4); VRD(5); VRD(6); VRD(7); B64_SBAR();        \
    if (GK) DMA_K((t) + 3, sl_cur); if (GV) DMA_V((t) + 1, sl_next); \
    if (MASK) { int ln_ = lane; asm volatile("" : "+v"(ln_)); cmask(C0, C1, (t) - (NT - 4), wid * 32 + (ln_ & 31), ln_ >> 5); } \
    B64_SBAR(); \
    GAPB(0, 0, C0, 0);  GAPB(1, 0, C0, 2);  GAPB(2, 0, C0, 4);   GAPB(3, 0, C0, 6); \
    GAPB(4, 1, C0, 8);  GAPB(5, 1, C0, 10); GAPB(6, 1, C0, 12);  GAPB(7, 1, C0, 14); \
    KRD(GL, 0); GAPB(8, 2, C1, 0);   KRD(GL, 1); GAPB(9, 2, C1, 2);   KRD(GL, 2); GAPB(10, 2, C1, 4);  KRD(GL, 3); GAPB(11, 2, C1, 6); \
    if (GL) { QRD(0); QRD(1); B64_SBAR(); } GAPB(12, 3, C1, 8); GAPB(13, 3, C1, 10); GAPB(14, 3, C1, 12); GAPB(15, 3, C1, 14); \
    } while (0)
    int t = 1;
    for (; t + 5 < NT; t += 2) {
        STEP(pB0, pB1, pA0, pA1, t, false, true, true, true);     B64_WAIT_BAR(3); RESC(); ROT();
        STEP(pA0, pA1, pB0, pB1, t + 1, false, true, true, true); B64_WAIT_BAR(3); RESC(); ROT();
    }
#define ENDW(tt) do { if ((tt) + 3 < NT) { B64_WAIT_BAR(3); } else if ((tt) + 2 < NT) { B64_WAIT_BAR(2); } else { B64_WAIT_BAR(0); } } while (0)
    for (; t + 1 < NT; t += 2) {
        STEP(pB0, pB1, pA0, pA1, t, true, (t + 3 < NT), (t + 1 < NT), (t + 1 < NT));         ENDW(t);     RESC(); ROT();
        STEP(pA0, pA1, pB0, pB1, t + 1, true, (t + 4 < NT), (t + 2 < NT), (t + 2 < NT));     ENDW(t + 1); RESC(); ROT();
    }
    STEP(pB0, pB1, pA0, pA1, NT - 1, true, false, false, false); RESC();
    { float sacc = pB0[0] + pB0[1];
#pragma unroll
      for (int r = 2; r < 16; ++r) sacc += pB0[r];
#pragma unroll
      for (int r = 0; r < 16; ++r) sacc += pB1[r];
      l_reg += sacc;
      pw0 = (u32x4){PKW(pB0, 0), PKW(pB0, 2), PKW(pB0, 4), PKW(pB0, 6)}; pw1 = (u32x4){PKW(pB0, 8), PKW(pB0, 10), PKW(pB0, 12), PKW(pB0, 14)};
      pw2 = (u32x4){PKW(pB1, 0), PKW(pB1, 2), PKW(pB1, 4), PKW(pB1, 6)}; pw3 = (u32x4){PKW(pB1, 8), PKW(pB1, 10), PKW(pB1, 12), PKW(pB1, 14)};
      const lptr vp_ = vp0 + 2 * sl_cur;
      _Pragma("unroll") for (int f = 0; f < 4; ++f) VRD(f);
      o[0] = B64_MFMA(PAF(0), VFR(0), o[0]); o[1] = B64_MFMA(PAF(0), VFR(1), o[1]); o[2] = B64_MFMA(PAF(0), VFR(2), o[2]); o[3] = B64_MFMA(PAF(0), VFR(3), o[3]); B64_SBAR();
      _Pragma("unroll") for (int f = 4; f < 8; ++f) VRD(f);
      o[0] = B64_MFMA(PAF(1), VFR(4), o[0]); o[1] = B64_MFMA(PAF(1), VFR(5), o[1]); o[2] = B64_MFMA(PAF(1), VFR(6), o[2]); o[3] = B64_MFMA(PAF(1), VFR(7), o[3]); B64_SBAR();
      _Pragma("unroll") for (int f = 8; f < 12; ++f) VRD(f);
      o[0] = B64_MFMA(PAF(2), VFR(8), o[0]); o[1] = B64_MFMA(PAF(2), VFR(9), o[1]); o[2] = B64_MFMA(PAF(2), VFR(10), o[2]); o[3] = B64_MFMA(PAF(2), VFR(11), o[3]); B64_SBAR();
      _Pragma("unroll") for (int f = 12; f < 16; ++f) VRD(f);
      o[0] = B64_MFMA(PAF(3), VFR(12), o[0]); o[1] = B64_MFMA(PAF(3), VFR(13), o[1]); o[2] = B64_MFMA(PAF(3), VFR(14), o[2]); o[3] = B64_MFMA(PAF(3), VFR(15), o[3]); }
    { auto rr = __builtin_amdgcn_permlane32_swap(__float_as_uint(l_reg), __float_as_uint(l_reg), false, false); l_reg = __uint_as_float(rr[0]) + __uint_as_float(rr[1]); }
    int lnE = lane; asm volatile("" : "+v"(lnE)); const int r32e = lnE & 31, hie = lnE >> 5;
    if (hie == 0) wsf[32 + r32e] = l_reg;
    if (__any(!(l_reg > 1e-30f && l_reg < 1e30f)) && lnE == 0) *flagp = 1u;
    asm volatile("s_waitcnt lgkmcnt(0)" ::: "memory");
    bf16_t* Ow = O + (size_t)(q0 + wid * 32) * ldo; LAS bf16_t* stg = (LAS bf16_t*)(lds + LDS_OST) + wid * 4096;
#pragma unroll
    for (int r = 0; r < 16; r += 2) { const int orow = crow(r, hie); const float i0 = __builtin_amdgcn_rcpf(wsf[32 + orow]), i1 = __builtin_amdgcn_rcpf(wsf[32 + orow + 1]);
#pragma unroll
        for (int d0 = 0; d0 < 4; ++d0) { const unsigned pk = cvtpk(o[d0][r] * i0, o[d0][r + 1] * i1);
            stg[orow * 128 + d0 * 32 + r32e] = (bf16_t)(pk & 0xFFFFu); stg[(orow + 1) * 128 + d0 * 32 + r32e] = (bf16_t)(pk >> 16); } }
    asm volatile("s_waitcnt lgkmcnt(0)" ::: "memory");
#pragma unroll
    for (int i = 0; i < 8; ++i) { const int row = i * 4 + (lnE >> 4), ch = lnE & 15; *(u32x4*)(Ow + (size_t)row * ldo + ch * 8) = *(const LAS u32x4*)(stg + row * 128 + ch * 8); }
    asm volatile("s_waitcnt lgkmcnt(0)\n\ts_barrier" ::: "memory");
    const unsigned bad = *flagp;
    asm volatile("s_waitcnt lgkmcnt(0)\n\ts_barrier" ::: "memory");
    return __builtin_amdgcn_readfirstlane(bad) != 0u;
#undef QRD
#undef DMA_K
#undef DMA_V
#undef ROT
#undef EX
#undef RESC
#undef PKW
#undef PAF
#undef VFR
#undef VRD
#undef KRD
#undef ENDW
#undef GAPA
#undef GAPB
#undef STEP
}
}
DEVI void attnB_unit(const Params& P, int b, int hd, int qb, LAS unsigned char* lds) {
    const int tid = tid_opaque(), lane = tid & 63, wave = tid >> 6, r32 = lane & 31, hi = lane >> 5;
    unsigned char* ws = P.ws;
    const bf16_t* proj = (const bf16_t*)(ws + WS_PROJ); const bf16_t* kbvb = (const bf16_t*)(ws + WS_KBVB);
    const int q = qb * 256 + 32 * wave + r32; const size_t row = (size_t)b * S + q;
    bf16x8 qf[4];
#pragma unroll
    for (int d0 = 0; d0 < 4; ++d0) qf[d0] = *(const bf16x8*)(proj + row * LDP + C_QB + hd * 64 + 16 * d0 + 8 * hi);
    f32x16 o[2];
#pragma unroll
    for (int d0 = 0; d0 < 2; ++d0)
#pragma unroll
        for (int r = 0; r < 16; ++r) o[d0][r] = 0.f;
    float l_run = 0.f;
    attn_core<64, 64, 2>(o, l_run, qf, kbvb + (size_t)b * S * 1024 + hd * 64, 1024, kbvb + (size_t)b * S * 1024 + 512 + hd * 64, 1024,
                         4 * (qb + 1), q, qb * 256 + 32 * wave, (const u64*)(ws + WS_MASK) + row * 64, lds, tid);
    const float lt = l_run;
    store_oT<64>(o, 1.f / lt, (bf16_t*)(ws + WS_Y) + row * 1024 + 512 + hd * 64, hi);
}
DEVI void xattn_unit(const Params& P, int l, int b, int hd, int qb, LAS unsigned char* lds) {
    const int tid = tid_opaque(), lane = tid & 63, wave = tid >> 6, r32 = lane & 31, hi = lane >> 5;
    unsigned char* ws = P.ws;
    const bf16_t* qx = (const bf16_t*)(ws + WS_QX); const bf16_t* kvx = (const bf16_t*)(ws + WS_KVX) + l * 1024;
    const int q = qb * 256 + 32 * wave + r32; const size_t row = (size_t)b * S + q;
    const float* gq = P.in[9] + l * 128;
    u32x4 raw[8]; float ss = 0.f;
    f32x4 gqv[8][2];
#pragma unroll
    for (int d0 = 0; d0 < 8; ++d0) { raw[d0] = *(const u32x4*)(qx + row * 512 + hd * 128 + 16 * d0 + 8 * hi); gqv[d0][0] = *(const f32x4*)(gq + 16 * d0 + 8 * hi); gqv[d0][1] = *(const f32x4*)(gq + 16 * d0 + 8 * hi + 4); }
#pragma unroll
    for (int d0 = 0; d0 < 8; ++d0) {
#pragma unroll
        for (int j = 0; j < 4; ++j) { const float a = lo16(raw[d0][j]), bq = hi16(raw[d0][j]); ss += a * a + bq * bq; } }
    ss += __shfl_xor(ss, 32);
    const float rs = rsqrtf(ss * (1.f / 128.f) + EPS) * (0.08838834764831845f * LOG2E);
    bf16x8 qf[8];
#pragma unroll
    for (int d0 = 0; d0 < 8; ++d0) { u32x4 w;
#pragma unroll
        for (int j = 0; j < 4; ++j) w[j] = cvtpk(lo16(raw[d0][j]) * rs * gqv[d0][j >> 1][(2 * j) & 3], hi16(raw[d0][j]) * rs * gqv[d0][j >> 1][(2 * j + 1) & 3]);
        qf[d0] = __builtin_bit_cast(bf16x8, w); }
    f32x16 o[4];
#pragma unroll
    for (int d0 = 0; d0 < 4; ++d0)
#pragma unroll
        for (int r = 0; r < 16; ++r) o[d0][r] = 0.f;
    float l_run = 0.f;
#if MK_XA2
    attn_core<128, 128, 0>(o, l_run, qf, kvx + (size_t)b * MEML * 2048 + hd * 128, 2048, kvx + (size_t)b * MEML * 2048 + 512 + hd * 128, 2048, MEML / 64, q, 0, nullptr, lds, tid);
#pragma unroll
    for (int d0 = 0; d0 < 4; ++d0)
#pragma unroll
        for (int r = 0; r < 16; ++r) o[d0][r] = 0.f;
    l_run = 0.f;
#endif
    attn_core<128, 128, 0>(o, l_run, qf, kvx + (size_t)b * MEML * 2048 + hd * 128, 2048, kvx + (size_t)b * MEML * 2048 + 512 + hd * 128, 2048,
                           MEML / 64, q, 0, nullptr, lds, tid);
    const float lt = l_run;
    store_oT<128>(o, 1.f / lt, (bf16_t*)(ws + WS_YX) + row * 512 + hd * 128, hi);
}

DEVI void xattn_fused_unit(const Params& P, int l, int b, int hd, int qb, LAS unsigned char* lds) {
    const int tid = tid_opaque(), lane = tid & 63, wave = tid >> 6, r32 = lane & 31, hi = lane >> 5;
    unsigned char* ws = P.ws;
    const bf16_t* kvx = (const bf16_t*)(ws + WS_KVX) + l * 1024;
    const int q = qb * 256 + 32 * wave + r32; const size_t row = (size_t)b * S + q;
    const bf16_t* Wh = (const bf16_t*)(ws + W_QX) + (size_t)l * 512 * 1024 + (size_t)(hd * 128) * 1024;
    const float ssqx = ((const float*)(ws + WS_SSQ))[(size_t)(l ? 4 : 1) * T + row];
    const float* gq = P.in[9] + l * 128;
#if MK_TPROBE >= 30
    unsigned long long tsx_[5]; tsx_[0] = __builtin_amdgcn_s_memtime();
#endif
    f32x16 acc[4];
#pragma unroll
    for (int blk = 0; blk < 4; ++blk)
#pragma unroll
        for (int r = 0; r < 16; ++r) acc[blk][r] = 0.f;
    u32x4 wa[2], wb[2], xr[4];
    const bf16_t* Xb = (const bf16_t*)(ws + WS_XB) + ((size_t)b * S + qb * 256) * 1024;
    LAS unsigned char* XL = lds + 49152;
#define XF_WLOAD(W_, s) do { _Pragma("unroll") for (int i_ = 0; i_ < 2; ++i_) { const int c_ = tid + NTHR * i_; W_[i_] = *(const u32x4*)(Wh + (size_t)(c_ >> 3) * 1024 + 64 * (s) + (c_ & 7) * 8); } } while (0)
#define XF_WSTORE(W_, buf) do { _Pragma("unroll") for (int i_ = 0; i_ < 2; ++i_) { const int c_ = tid + NTHR * i_, row_ = c_ >> 3, ch_ = c_ & 7; *(LAS u32x4*)(lds + (buf) * 16384 + row_ * 128 + ((ch_ ^ ((row_ >> 1) & 7)) << 4)) = W_[i_]; } } while (0)
#define XF_XLOAD(s) do { _Pragma("unroll") for (int i_ = 0; i_ < 4; ++i_) { const int c_ = tid + NTHR * i_; xr[i_] = *(const u32x4*)(Xb + (size_t)(c_ >> 3) * 1024 + 64 * (s) + (c_ & 7) * 8); } } while (0)
#define XF_XSTORE(buf) do { _Pragma("unroll") for (int i_ = 0; i_ < 4; ++i_) { const int c_ = tid + NTHR * i_, row_ = c_ >> 3, ch_ = c_ & 7; *(LAS u32x4*)(XL + (buf) * 32768 + row_ * 128 + ((ch_ ^ ((row_ >> 1) & 7)) << 4)) = xr[i_]; } } while (0)
#define XF_MMA(wbuf, xbuf) do { bf16x8 wf_[4][4], xq_[4];        \
        _Pragma("unroll") for (int ks = 0; ks < 4; ++ks) { const int xrow = 32 * wave + r32, ch = 2 * ks + hi; \
            xq_[ks] = *(LAS const bf16x8*)(XL + (xbuf) * 32768 + xrow * 128 + ((ch ^ ((xrow >> 1) & 7)) << 4)); \
            _Pragma("unroll") for (int blk = 0; blk < 4; ++blk) { const int rw = 32 * blk + r32; \
                wf_[ks][blk] = *(LAS const bf16x8*)(lds + (wbuf) * 16384 + rw * 128 + ((ch ^ ((rw >> 1) & 7)) << 4)); } } \
        asm volatile("s_waitcnt lgkmcnt(0)" ::: "memory"); __builtin_amdgcn_sched_barrier(0); \
        _Pragma("unroll") for (int ks = 0; ks < 4; ++ks) _Pragma("unroll") for (int blk = 0; blk < 4; ++blk) acc[blk] = __builtin_amdgcn_mfma_f32_32x32x16_bf16(wf_[ks][blk], xq_[ks], acc[blk], 0, 0, 0); \
        __builtin_amdgcn_sched_barrier(0); } while (0)
    XF_WLOAD(wa, 0); XF_WLOAD(wb, 1); XF_XLOAD(0);
    XF_WSTORE(wa, 0); XF_WSTORE(wb, 1); XF_XSTORE(0); __syncthreads();
    for (int s = 0; s < 16; s += 2) {
        if (s + 2 < 16) XF_WLOAD(wa, s + 2);
        XF_XLOAD(s + 1);
        XF_MMA(s % 3, 0);
        if (s + 2 < 16) XF_WSTORE(wa, (s + 2) % 3);
        XF_XSTORE(1);
        __syncthreads();
        if (s + 3 < 16) XF_WLOAD(wb, s + 3);
        if (s + 2 < 16) XF_XLOAD(s + 2);
        XF_MMA((s + 1) % 3, 1);
        if (s + 3 < 16) XF_WSTORE(wb, (s + 3) % 3);
        if (s + 2 < 16) XF_XSTORE(0);
        __syncthreads();
    }
#undef XF_WLOAD
#undef XF_WSTORE
#undef XF_XLOAD
#undef XF_XSTORE
#undef XF_MMA
#if MK_TPROBE >= 30
    asm volatile("s_waitcnt vmcnt(0) lgkmcnt(0)" ::: "memory"); tsx_[1] = __builtin_amdgcn_s_memtime();
#endif
    f32x4 gqv[4][4];
#pragma unroll
    for (int blk = 0; blk < 4; ++blk)
#pragma unroll
        for (int g4 = 0; g4 < 4; ++g4) gqv[blk][g4] = *(const f32x4*)(gq + 32 * blk + 8 * g4 + 4 * hi);
    float ss = 0.f;
#pragma unroll
    for (int blk = 0; blk < 4; ++blk)
#pragma unroll
        for (int r = 0; r < 16; ++r) ss += acc[blk][r] * acc[blk][r];
    { const auto sw = __builtin_amdgcn_permlane32_swap(__float_as_uint(ss), __float_as_uint(ss), false, false); ss = __uint_as_float(sw[0]) + __uint_as_float(sw[1]); }
    const float c = rsqrtf(ssqx * (1.f / 1024.f) + EPS);
    const float f = c * rsqrtf(c * c * ss * (1.f / 128.f) + EPS) * (0.08838834764831845f * LOG2E);
    bf16x8 qf[8];
#pragma unroll
    for (int blk = 0; blk < 4; ++blk)
#pragma unroll
        for (int e = 0; e < 2; ++e) { u32x4 w;
#pragma unroll
            for (int jj = 0; jj < 4; ++jj) { const int r0 = 8 * e + 2 * jj;
                w[jj] = cvtpk(acc[blk][r0] * f * gqv[blk][r0 >> 2][r0 & 3], acc[blk][r0 + 1] * f * gqv[blk][r0 >> 2][(r0 & 3) + 1]); }
            qf[2 * blk + e] = __builtin_bit_cast(bf16x8, w); }
    f32x16 o[4];
#pragma unroll
    for (int d0 = 0; d0 < 4; ++d0)
#pragma unroll
        for (int r = 0; r < 16; ++r) o[d0][r] = 0.f;
    float l_run = 0.f;
#if MK_TPROBE >= 30
    asm volatile("s_waitcnt vmcnt(0) lgkmcnt(0)" ::: "memory"); tsx_[2] = __builtin_amdgcn_s_memtime();
#endif
    attn_core<128, 128, 0, true>(o, l_run, qf, kvx + (size_t)b * MEML * 2048 + hd * 128, 2048, kvx + (size_t)b * MEML * 2048 + 512 + hd * 128, 2048,
                                 MEML / 64, q, 0, nullptr, lds, tid);
#if MK_TPROBE >= 30
    asm volatile("s_waitcnt vmcnt(0) lgkmcnt(0)" ::: "memory"); tsx_[3] = __builtin_amdgcn_s_memtime();
#endif
    store_oT<128>(o, 1.f / l_run, (bf16_t*)(ws + WS_YX) + row * 512 + hd * 128, hi);
#if MK_TPROBE >= 30
    asm volatile("s_waitcnt vmcnt(0) lgkmcnt(0)" ::: "memory"); tsx_[4] = __builtin_amdgcn_s_memtime();
    if (blockIdx.x == 0 && tid == 0 && l == 0) { unsigned long long* TS = (unsigned long long*)(ws + WS_BAR + 65536); for (int k = 0; k < 4; ++k) atomicAdd(TS + 16 + k, tsx_[k + 1] - tsx_[k]); atomicAdd(TS + 20, tsx_[4] - tsx_[0]); }
#endif
}

#define DPP_STEP4(OP, v) do { v = OP(v, __builtin_amdgcn_update_dpp(v, v, 0xB1, 0xF, 0xF, false)); v = OP(v, __builtin_amdgcn_update_dpp(v, v, 0x4E, 0xF, 0xF, false)); \
        v = OP(v, __builtin_amdgcn_update_dpp(v, v, 0x141, 0xF, 0xF, false)); v = OP(v, __builtin_amdgcn_update_dpp(v, v, 0x140, 0xF, 0xF, false)); } while (0)
DEVI unsigned umax2(unsigned a, unsigned b) { return a > b ? a : b; }
DEVI unsigned umin2(unsigned a, unsigned b) { return a < b ? a : b; }
DEVI unsigned wave_max_u32(unsigned v) { DPP_STEP4(umax2, v);
    const auto a = __builtin_amdgcn_permlane16_swap(v, v, false, false); v = umax2(a[0], a[1]);
    const auto b = __builtin_amdgcn_permlane32_swap(v, v, false, false); return umax2(b[0], b[1]); }
DEVI unsigned wave_min_u32(unsigned v) { DPP_STEP4(umin2, v);
    const auto a = __builtin_amdgcn_permlane16_swap(v, v, false, false); v = umin2(a[0], a[1]);
    const auto b = __builtin_amdgcn_permlane32_swap(v, v, false, false); return umin2(b[0], b[1]); }
DEVI float row16_sum(float s) {
    s += __builtin_bit_cast(float, __builtin_amdgcn_update_dpp(0, __builtin_bit_cast(int, s), 0xB1, 0xF, 0xF, false)); s += __builtin_bit_cast(float, __builtin_amdgcn_update_dpp(0, __builtin_bit_cast(int, s), 0x4E, 0xF, 0xF, false));
    s += __builtin_bit_cast(float, __builtin_amdgcn_update_dpp(0, __builtin_bit_cast(int, s), 0x141, 0xF, 0xF, false)); s += __builtin_bit_cast(float, __builtin_amdgcn_update_dpp(0, __builtin_bit_cast(int, s), 0x140, 0xF, 0xF, false));
    return s; }
DEVI int wave_sum_dpp(int v) {
    v += __builtin_amdgcn_update_dpp(0, v, 0xB1, 0xF, 0xF, false);
    v += __builtin_amdgcn_update_dpp(0, v, 0x4E, 0xF, 0xF, false);
    v += __builtin_amdgcn_update_dpp(0, v, 0x141, 0xF, 0xF, false);
    v += __builtin_amdgcn_update_dpp(0, v, 0x140, 0xF, 0xF, false);
    return (__builtin_amdgcn_readlane(v, 0) + __builtin_amdgcn_readlane(v, 16)) + (__builtin_amdgcn_readlane(v, 32) + __builtin_amdgcn_readlane(v, 48));
}
constexpr int IDX_SROW = 4096 + 64;
DEVI void indexer_unit(const Params& P, int b, int t0, LAS unsigned char* lds) {
    const int tid = tid_opaque(), lane = tid & 63, wave = __builtin_amdgcn_readfirstlane(tid >> 6), r32 = lane & 31, hi = lane >> 5;
    unsigned char* ws = P.ws;
    const bf16_t* proj = (const bf16_t*)(ws + WS_PROJ); const float* WI = (const float*)(ws + WS_WI);
    LAS float* Ssc = (LAS float*)lds;
    for (int rs_ = 0; rs_ < 1 + MK_SC2; ++rs_)
    if (t0 + 7 >= 255) {
        bf16x8 af[4];
        { const int qq = r32 >> 2, hh = r32 & 3; const size_t row = (size_t)b * S + t0 + qq;
#pragma unroll
          for (int d0 = 0; d0 < 4; ++d0) af[d0] = *(const bf16x8*)(proj + row * LDP + C_QI + hh * 64 + 16 * d0 + 8 * hi); }
        float wv[16];
#pragma unroll
        for (int r = 0; r < 16; ++r) wv[r] = WI[((size_t)b * S + t0 + 2 * (r >> 2) + hi) * 4 + (r & 3)];
        const int nkt = (t0 + 8 + 31) / 32;
        const bf16_t* kbase = (const bf16_t*)(ws + WS_KI) + (size_t)(b * (S / 32)) * 2048 + lane * 8;
        bf16x8 kb0[4], kb1[4], kb2[4], kb3[4];
#define IDX_LOAD(B, kt_) do { const int k_ = ((kt_) < nkt) ? (kt_) : (nkt - 1); _Pragma("unroll") for (int d0 = 0; d0 < 4; ++d0) B[d0] = *(const bf16x8*)(kbase + (size_t)k_ * 2048 + d0 * 512); } while (0)
#define IDX_COMP(B, kt_) do { f32x16 c; _Pragma("unroll") for (int r = 0; r < 16; ++r) c[r] = 0.f; \
            _Pragma("unroll") for (int d0 = 0; d0 < 4; ++d0) c = __builtin_amdgcn_mfma_f32_32x32x16_bf16(af[d0], B[d0], c, 0, 0, 0); \
            const int key = (kt_) * 32 + r32; \
            _Pragma("unroll") for (int g4 = 0; g4 < 4; ++g4) { float s = 0.f; \
                _Pragma("unroll") for (int hh = 0; hh < 4; ++hh) s += fmaxf(c[4 * g4 + hh], 0.f) * wv[4 * g4 + hh]; \
                if ((kt_) == nkt - 1 && key > t0 + 2 * g4 + hi) s = -INFINITY;        \
                Ssc[(2 * g4 + hi) * IDX_SROW + key + (key >> 6)] = s; } } while (0)
#define IDX_FENCE() asm volatile("" ::: "memory")
        IDX_LOAD(kb0, wave); IDX_LOAD(kb1, wave + NWAVE); IDX_LOAD(kb2, wave + 2 * NWAVE); IDX_FENCE();
        for (int kt = wave; kt < nkt; kt += 4 * NWAVE) {
            IDX_LOAD(kb3, kt + 3 * NWAVE); IDX_FENCE(); IDX_COMP(kb0, kt); IDX_FENCE();
            if (kt + NWAVE >= nkt) break;
            IDX_LOAD(kb0, kt + 4 * NWAVE); IDX_FENCE(); IDX_COMP(kb1, kt + NWAVE); IDX_FENCE();
            if (kt + 2 * NWAVE >= nkt) break;
            IDX_LOAD(kb1, kt + 5 * NWAVE); IDX_FENCE(); IDX_COMP(kb2, kt + 2 * NWAVE); IDX_FENCE();
            if (kt + 3 * NWAVE >= nkt) break;
            IDX_LOAD(kb2, kt + 6 * NWAVE); IDX_FENCE(); IDX_COMP(kb3, kt + 3 * NWAVE); IDX_FENCE();
        }
#undef IDX_FENCE
#undef IDX_LOAD
#undef IDX_COMP
        if ((nkt & 1) && lane < 32) { const int key = nkt * 32 + lane; Ssc[wave * IDX_SROW + key + (key >> 6)] = -INFINITY; }
        if (wave == 0) Ssc[8 * IDX_SROW + lane] = -INFINITY;
    }
    __syncthreads();
    for (int rr_ = 0; rr_ < 1 + MK_SEL2; ++rr_) {
        const int t = t0 + wave; u64 myw = 0ull;
#if MK_TPROBE
        unsigned long long ts0_ = __builtin_amdgcn_s_memtime(), ts1_ = ts0_, ts2_ = ts0_;
#endif
        if (t >= 255) {
            unsigned u[64];
            { const LAS float* srow = (64 * lane <= t) ? (Ssc + wave * IDX_SROW + 65 * lane) : (Ssc + 8 * IDX_SROW);
#pragma unroll
              for (int j = 0; j < 64; ++j) { const unsigned bits = __float_as_uint(srow[j]);
                  u[j] = bits ^ ((unsigned)((int)bits >> 31) | 0x80000000u); } }
            unsigned a32[32], a16[16], a8[8], a4[4];
#pragma unroll
            for (int i = 0; i < 32; ++i) a32[i] = max(u[2 * i], u[2 * i + 1]);
#pragma unroll
            for (int i = 0; i < 16; ++i) a16[i] = max(a32[2 * i], a32[2 * i + 1]);
#pragma unroll
            for (int i = 0; i < 8; ++i) a8[i] = max(a16[2 * i], a16[2 * i + 1]);
#pragma unroll
            for (int i = 0; i < 4; ++i) a4[i] = max(a8[2 * i], a8[2 * i + 1]);
            unsigned Mx = max(max(a4[0], a4[1]), max(a4[2], a4[3])), Lx = 0xffffffffu;
            { const int nfull = __builtin_amdgcn_readfirstlane((t + 1) >> 6); int nl;
              if (nfull >= 64) { nl = 64; Lx = min(min(a4[0], a4[1]), min(a4[2], a4[3])); }
              else if (nfull >= 32) { nl = 32;
#pragma unroll
                  for (int i = 0; i < 8; ++i) Lx = min(Lx, a8[i]); }
              else if (nfull >= 16) { nl = 16;
#pragma unroll
                  for (int i = 0; i < 16; ++i) Lx = min(Lx, a16[i]); }
              else if (nfull >= 8) { nl = 8;
#pragma unroll
                  for (int i = 0; i < 32; ++i) Lx = min(Lx, a32[i]); }
              else { nl = 4;
#pragma unroll
                  for (int j = 0; j < 64; ++j) Lx = min(Lx, u[j]); }
              if (lane >= nl) Lx = 0xffffffffu;
              Mx = wave_max_u32(Mx); Lx = wave_min_u32(Lx); }
            Mx = __builtin_amdgcn_readfirstlane(Mx); Lx = __builtin_amdgcn_readfirstlane(Lx);
#if MK_TPROBE
            asm volatile("s_waitcnt vmcnt(0) lgkmcnt(0)" ::: "memory"); ts1_ = __builtin_amdgcn_s_memtime();
#endif
            { const unsigned lxm1 = Lx - 1u;
#pragma unroll
              for (int j = 0; j < 64; ++j) u[j] = __builtin_elementwise_sub_sat(u[j], lxm1); }
            unsigned prefix = 0u; bool exact = false;
#define IDX_CNT8(j0) asm volatile( \
                    "v_cmp_le_u32 vcc, %10, %2\n\tv_addc_co_u32 %0, vcc, 0, %0, vcc\n\tv_cmp_le_u32 vcc, %10, %3\n\tv_addc_co_u32 %1, vcc, 0, %1, vcc\n\t" \
                    "v_cmp_le_u32 vcc, %10, %4\n\tv_addc_co_u32 %0, vcc, 0, %0, vcc\n\tv_cmp_le_u32 vcc, %10, %5\n\tv_addc_co_u32 %1, vcc, 0, %1, vcc\n\t" \
                    "v_cmp_le_u32 vcc, %10, %6\n\tv_addc_co_u32 %0, vcc, 0, %0, vcc\n\tv_cmp_le_u32 vcc, %10, %7\n\tv_addc_co_u32 %1, vcc, 0, %1, vcc\n\t" \
                    "v_cmp_le_u32 vcc, %10, %8\n\tv_addc_co_u32 %0, vcc, 0, %0, vcc\n\tv_cmp_le_u32 vcc, %10, %9\n\tv_addc_co_u32 %1, vcc, 0, %1, vcc" \
                    : "+v"(c0), "+v"(c1) \
                    : "v"(IDX_ARR[(j0)]), "v"(IDX_ARR[(j0) + 1]), "v"(IDX_ARR[(j0) + 2]), "v"(IDX_ARR[(j0) + 3]), "v"(IDX_ARR[(j0) + 4]), "v"(IDX_ARR[(j0) + 5]), "v"(IDX_ARR[(j0) + 6]), "v"(IDX_ARR[(j0) + 7]), "v"(candv) : "vcc")
#define IDX_ARR u
#define IDX_COUNT(CNT, C) do { int c0 = 0, c1 = 0, sc_ = 0; const unsigned candv = (C); \
                _Pragma("unroll") for (int j_ = IDX_NV; j_ < 64; j_ += 8) { u64 m0_, m1_, m2_, m3_, m4_, m5_, m6_, m7_;        \
                    asm volatile("v_cmp_le_u32 %0, %8, %9\n\tv_cmp_le_u32 %1, %8, %10\n\tv_cmp_le_u32 %2, %8, %11\n\tv_cmp_le_u32 %3, %8, %12\n\tv_cmp_le_u32 %4, %8, %13\n\tv_cmp_le_u32 %5, %8, %14\n\tv_cmp_le_u32 %6, %8, %15\n\tv_cmp_le_u32 %7, %8, %16" \
                        : "=&s"(m0_), "=&s"(m1_), "=&s"(m2_), "=&s"(m3_), "=&s"(m4_), "=&s"(m5_), "=&s"(m6_), "=&s"(m7_) \
                        : "v"(candv), "v"(u[j_]), "v"(u[j_ + 1]), "v"(u[j_ + 2]), "v"(u[j_ + 3]), "v"(u[j_ + 4]), "v"(u[j_ + 5]), "v"(u[j_ + 6]), "v"(u[j_ + 7])); \
                    sc_ += (__builtin_popcountll(m0_) + __builtin_popcountll(m1_)) + (__builtin_popcountll(m2_) + __builtin_popcountll(m3_)) + (__builtin_popcountll(m4_) + __builtin_popcountll(m5_)) + (__builtin_popcountll(m6_) + __builtin_popcountll(m7_)); } \
                _Pragma("unroll") for (int j8_ = 0; j8_ < IDX_NV / 8; ++j8_) { \
                    if (j8_ == 0) IDX_CNT8(0); else if (j8_ == 1) IDX_CNT8(8); else if (j8_ == 2) IDX_CNT8(16); else if (j8_ == 3) IDX_CNT8(24); \
                    else if (j8_ == 4) IDX_CNT8(32); else if (j8_ == 5) IDX_CNT8(40); else if (j8_ == 6) IDX_CNT8(48); else IDX_CNT8(56); } \
                CNT = wave_sum_dpp(c0 + c1) + sc_; } while (0)
#if MK_ISRCH
            for (int rb_ = 0; rb_ < 1 + MK_BIS2; ++rb_) {
                const unsigned Rr = Mx - Lx + 1u;
                unsigned lo = 1u, hi = Rr + 1u; int clo; IDX_COUNT(clo, 1u);
                float flo = (float)clo - 255.5f, fhi = -255.5f; int side = 0; unsigned w2 = 0xffffffffu, w1 = 0xffffffffu;
                exact = false;
                for (int it = 0; it < 200; ++it) {
                    if (clo == 256) { exact = true; break; }
                    const unsigned w = hi - lo;
                    if (w == 1u) break;
                    unsigned off = (unsigned)((float)w * (flo / (flo - fhi)));
                    if (w > (w2 >> 1)) off = w >> 1;
                    off = off < 1u ? 1u : (off > w - 1u ? w - 1u : off);
                    w2 = w1; w1 = w;
                    const unsigned cand = lo + off; int cnt; IDX_COUNT(cnt, cand);
                    if (cnt >= 256) { lo = cand; clo = cnt; flo = (float)cnt - 255.5f; if (side > 0) fhi *= 0.5f; side = 1; }
                    else { hi = cand; fhi = (float)cnt - 255.5f; if (side < 0) flo *= 0.5f; side = -1; }
                }
                prefix = lo;
            }
#else
            for (int rb_ = 0; rb_ < 1 + MK_BIS2; ++rb_) { prefix = 0u; exact = false;
            int comp = 0; bool tried = false; int c_lo = 0, c_hi = 0, c_base = 0; unsigned kc[32];
#pragma unroll
            for (int i = 0; i < 32; ++i) kc[i] = 0u;
            for (int bit = 31 - __builtin_clz(Mx - Lx + 1u); bit >= 0; --bit) {
                const unsigned cand = prefix | (1u << bit); int cnt;
                if (comp) { int c0 = 0, c1 = 0; const unsigned candv = cand;
#undef IDX_ARR
#define IDX_ARR kc
                    IDX_CNT8(0); IDX_CNT8(8); if (comp > 1) { IDX_CNT8(16); IDX_CNT8(24); }
#undef IDX_ARR
#define IDX_ARR u
                    cnt = wave_sum_dpp(c0 + c1) + c_base; }
                else IDX_COUNT(cnt, cand);
                if (cnt >= 256) { prefix = cand; c_lo = cnt; } else c_hi = cnt;
                if (cnt == 256) { exact = true; break; }
                if (MK_ICOMP && !tried && prefix != 0u && bit >= 4 && c_lo - c_hi <= IDX_CLIM) { tried = true;
                    LAS unsigned* mylist = (LAS unsigned*)(Ssc + wave * IDX_SROW + 65 * lane);
#pragma unroll
                    for (int i = 0; i < 32; ++i) mylist[i] = 0u;
                    const unsigned wdt = 1u << bit; unsigned idx = 0u;
#pragma unroll
                    for (int j = 0; j < 64; ++j) { mylist[idx] = u[j]; idx += ((u[j] - prefix) < wdt) ? 1u : 0u; }
                    if (idx < 64u) mylist[idx] = 0u;
                    const unsigned nmax = wave_max_u32(idx);
                    if (__builtin_amdgcn_readfirstlane(nmax) <= 32u) { comp = (__builtin_amdgcn_readfirstlane(nmax) <= 16u) ? 1 : 2; c_base = c_hi;
#pragma unroll
                        for (int i = 0; i < 32; ++i) kc[i] = mylist[i]; }
                }
            }
            }
#endif
#undef IDX_COUNT
#undef IDX_CNT8
#undef IDX_ARR
#if MK_TPROBE
            asm volatile("s_waitcnt vmcnt(0) lgkmcnt(0)" ::: "memory"); ts2_ = __builtin_amdgcn_s_memtime();
#endif
            unsigned mlo = 0u, mhi = 0u;
            if (exact) {
#pragma unroll
                for (int j = 31; j >= 0; --j) asm volatile("v_cmp_le_u32 vcc, %4, %2\n\tv_addc_co_u32 %0, vcc, %0, %0, vcc\n\tv_cmp_le_u32 vcc, %4, %3\n\tv_addc_co_u32 %1, vcc, %1, %1, vcc"
                                                           : "+v"(mlo), "+v"(mhi) : "v"(u[j]), "v"(u[32 + j]), "v"(prefix) : "vcc");
            } else {
                int ngt = 0, nti = 0;
#pragma unroll
                for (int j = 0; j < 64; ++j) { ngt += (u[j] > prefix) ? 1 : 0; nti += (u[j] == prefix) ? 1 : 0; }
                const int need = 256 - (int)wave_sum((float)ngt);
                int incl = nti;
#pragma unroll
                for (int o = 1; o < 64; o <<= 1) { const int v = __shfl_up(incl, o); if (lane >= o) incl += v; }
                int running = incl - nti;
#pragma unroll
                for (int j = 0; j < 64; ++j) {
                    const bool tie = (u[j] == prefix);
                    const unsigned sel = ((u[j] > prefix) || (tie && running < need)) ? 1u : 0u;
                    running += tie ? 1 : 0;
                    if (j < 32) mlo |= sel << j; else mhi |= sel << (j - 32);
                }
            }
            myw = ((u64)mhi << 32) | mlo;
        } else {
            const int lo = 64 * lane;
            if (lo + 63 <= t) myw = ~0ull; else if (lo > t) myw = 0ull; else myw = (~0ull) >> (63 - (t - lo));
        }
        ((u64*)(ws + WS_MASK))[((size_t)b * S + t) * 64 + lane] = myw;
#if MK_TPROBE
        { asm volatile("s_waitcnt vmcnt(0) lgkmcnt(0)" ::: "memory"); const unsigned long long ts3_ = __builtin_amdgcn_s_memtime();
          if (blockIdx.x == 0 && wave == 0 && lane == 0 && t >= 255) { unsigned long long* TS = (unsigned long long*)(ws + WS_BAR + 65536);
              atomicAdd(TS + 0, ts1_ - ts0_); atomicAdd(TS + 1, ts2_ - ts1_); atomicAdd(TS + 2, ts3_ - ts2_); atomicAdd(TS + 3, ts3_ - ts0_); } }
#endif
    }
    __syncthreads();
}

DEVI void combineA_rows(const Params& P) {
    const int tid = tid_opaque(), lane = tid & 63, wave = tid >> 6;
    const int gw = blockIdx.x * NWAVE + wave, NGW = gridDim.x * NWAVE;
    unsigned char* ws = P.ws;
    const float d1 = wave_sum(P.in[17][lane] * P.in[18][lane]), d2 = wave_sum(P.in[19][lane] * P.in[20][lane]);
    const float lam_init = 0.2f, lam = expf(d1) - expf(d2) + lam_init;
    const bf16_t* o0 = (const bf16_t*)(ws + WS_XB); const bf16_t* o1 = o0 + (size_t)T * 512;
    const float* gs = P.in[21] + 8 * (lane & 15);
    for (int m0 = gw; m0 < T; m0 += 4 * NGW) {
        u32x4 a[4], bq[4];
#pragma unroll
        for (int k = 0; k < 4; ++k) { const int m = (m0 + k * NGW < T) ? m0 + k * NGW : m0; a[k] = *(const u32x4*)(o0 + (size_t)m * 512 + 8 * lane); bq[k] = *(const u32x4*)(o1 + (size_t)m * 512 + 8 * lane); }
#pragma unroll
        for (int k = 0; k < 4; ++k) { const int m = m0 + k * NGW; if (m >= T) break;
            float v[8]; float ss = 0.f;
#pragma unroll
            for (int j = 0; j < 4; ++j) { v[2 * j] = lo16(a[k][j]) - lam * lo16(bq[k][j]); v[2 * j + 1] = hi16(a[k][j]) - lam * hi16(bq[k][j]); ss += v[2 * j] * v[2 * j] + v[2 * j + 1] * v[2 * j + 1]; }
            ss = row16_sum(ss);
            const float rs = rsqrtf(ss * (1.f / 128.f) + EPS) * (1.f - lam_init);
            u32x4 w;
#pragma unroll
            for (int j = 0; j < 4; ++j) w[j] = cvtpk(v[2 * j] * rs * gs[2 * j], v[2 * j + 1] * rs * gs[2 * j + 1]);
            *(u32x4*)((bf16_t*)(ws + WS_Y) + (size_t)m * 1024 + 8 * lane) = w; }
    }
}

template <int W>
DEVI void pool_item(const bf16_t* pr, bf16_t* y, int m, int c0) {
    const int t = m & (S - 1);
    u32x4 z[W];
#pragma unroll
    for (int dt = 0; dt < W; ++dt) z[dt] = *(const u32x4*)(pr + (size_t)(m - ((dt <= t) ? dt : t)) * 2048 + 1536 + c0);
    float sum[8];
#pragma unroll
    for (int j = 0; j < 8; ++j) sum[j] = 0.f;
#pragma unroll
    for (int dt = 0; dt < W; ++dt) { const float wgt = (dt <= t) ? 1.f : 0.f;
#pragma unroll
        for (int j = 0; j < 4; ++j) { sum[2 * j] += wgt * lo16(z[dt][j]); sum[2 * j + 1] += wgt * hi16(z[dt][j]); } }
    const float inv = 1.f / (float)((t + 1 < W) ? (t + 1) : W); u32x4 w;
#pragma unroll
    for (int j = 0; j < 4; ++j) w[j] = cvtpk(sum[2 * j] * inv - lo16(z[0][j]), sum[2 * j + 1] * inv - hi16(z[0][j]));
    *(u32x4*)(y + (size_t)m * 1024 + 512 + c0) = w;
}
DEVI void phase_mix1(const Params& P) {
    const int gt = blockIdx.x * NTHR + tid_opaque(), NGT = gridDim.x * NTHR;
    unsigned char* ws = P.ws;
    const bf16_t* pr = (const bf16_t*)(ws + WS_PROJ1);
    bf16_t* y = (bf16_t*)(ws + WS_Y);
    const float* cw = P.in[29];
    for (int it0 = gt; it0 < T * 64; it0 += 2 * NGT) {
        u32x4 gc[2][3], hc[2][3], gb[2];
#pragma unroll
        for (int k = 0; k < 2; ++k) { const int it = (it0 + k * NGT < T * 64) ? it0 + k * NGT : it0; const int m = it >> 6, c0 = 8 * (it & 63), t = m & (S - 1);
#pragma unroll
            for (int dt = 0; dt < 3; ++dt) { const size_t r = (size_t)(m - ((dt <= t) ? dt : t)) * 2048; gc[k][dt] = *(const u32x4*)(pr + r + 512 + c0); hc[k][dt] = *(const u32x4*)(pr + r + 1024 + c0); }
            gb[k] = *(const u32x4*)(pr + (size_t)m * 2048 + c0); }
#pragma unroll
        for (int k = 0; k < 2; ++k) { const int it = it0 + k * NGT; if (it >= T * 64) break; const int m = it >> 6, c0 = 8 * (it & 63), t = m & (S - 1);
            float wgt[3][8];
#pragma unroll
            for (int dt = 0; dt < 3; ++dt) { float tmp[8]; load8(tmp, cw + (2 - dt) * 512 + c0); const float on = (dt <= t) ? 1.f : 0.f;
#pragma unroll
                for (int j = 0; j < 8; ++j) wgt[dt][j] = tmp[j] * on; }
            u32x4 w;
#pragma unroll
            for (int j = 0; j < 4; ++j) { float a = 0.f, b = 0.f;
#pragma unroll
                for (int dt = 0; dt < 3; ++dt) { a += wgt[dt][2 * j] * (lo16(gc[k][dt][j]) * lo16(hc[k][dt][j])); b += wgt[dt][2 * j + 1] * (hi16(gc[k][dt][j]) * hi16(hc[k][dt][j])); }
                w[j] = cvtpk(lo16(gb[k][j]) * a, hi16(gb[k][j]) * b); }
            *(u32x4*)(y + (size_t)m * 1024 + c0) = w; }
    }
    for (int it = gt; it < T * 16; it += NGT) { const int m = it >> 4, cj = 8 * (it & 15);
        pool_item<2>(pr, y, m, cj); pool_item<4>(pr, y, m, 128 + cj); asm volatile("" ::: "memory"); pool_item<8>(pr, y, m, 256 + cj); asm volatile("" ::: "memory"); pool_item<16>(pr, y, m, 384 + cj); asm volatile("" ::: "memory"); }
}

DEVI float sum_rows4(float s) {
    const auto a = __builtin_amdgcn_permlane16_swap(__float_as_uint(s), __float_as_uint(s), false, false);
    const float s2 = __uint_as_float(a[0]) + __uint_as_float(a[1]);
    const auto b = __builtin_amdgcn_permlane32_swap(__float_as_uint(s2), __float_as_uint(s2), false, false);
    return __uint_as_float(b[0]) + __uint_as_float(b[1]);
}
namespace pg8 {
#define PG8_LAS __attribute__((address_space(3)))
typedef unsigned short bf16_t;
typedef short bf16x8 __attribute__((ext_vector_type(8)));
typedef float f32x4 __attribute__((ext_vector_type(4)));
typedef unsigned u32x4 __attribute__((ext_vector_type(4)));
constexpr int BM = 256, BK = 64, HALF = 128, HTB = HALF * BK * 2  , STAGE_BYTES = 8 * HTB, NXCD = 8, WGM = 4;

__host__ __device__ __forceinline__ int lds_byte(int r, int c) { const int st = (r >> 4) * 2 + (c >> 5), rr = r & 15, cc = c & 31, ob = rr * 64 + cc * 2; return st * 1024 + (ob ^ (((ob >> 9) & 1) << 5)); }
__host__ __device__ __forceinline__ void stage_rc(int b, int& R, int& C) { const int st = b / 1024, sb = b % 1024, swz = sb ^ (((sb >> 9) & 1) << 5); R = (st >> 1) * 16 + swz / 64; C = (st & 1) * 32 + (swz % 64) / 2; }
__host__ __device__ __forceinline__ int perm32(int rho) { const int n = rho >> 4, i = rho & 15; return 8 * (i >> 2) + 4 * n + (i & 3); }

struct Unit { int pm, pn; };
struct Gemm { const bf16_t* A; int lda; const bf16_t* Bt; int M, N, K; };

struct StaticOrder {
    int nM, nN, nwg, G, c;
    __host__ __device__ void init(int M, int N, int G_, int c_) { nM = M / BM; nN = N / BM; nwg = nM * nN; G = G_; c = c_; }
    __host__ __device__ bool next(int i, Unit& u) const {
        const long L = (long)i * G + c; if (L >= nwg) return false;
        int wgid = (int)L; { const int q = nwg / NXCD, r = nwg % NXCD, xcd = wgid % NXCD, off = wgid / NXCD; wgid = (xcd < r ? xcd * (q + 1) : r * (q + 1) + (xcd - r) * q) + off; }
        const int nig = WGM * nN, gid = wgid / nig, fm = gid * WGM, gsz = (nM - fm) < WGM ? (nM - fm) : WGM;
        u.pm = fm + ((wgid % nig) % gsz); u.pn = (wgid % nig) / gsz; return true;
    }
    __device__ __forceinline__ void a_ready(const Unit&) const {}
    __device__ __forceinline__ void done(const Unit&) const {}
};
template <class Epi, class Sched, bool ALIGN_EPI = false, bool SP2 = false>
__device__ __forceinline__ void gemm_phase(PG8_LAS unsigned char* lds, const Gemm g, const Sched& S, const Epi& E) {
    const int tid = tid_opaque(), wid = __builtin_amdgcn_readfirstlane(tid >> 6), lane = tid & 63, wr = wid >> 2, wc = wid & 3, fr = lane & 15, fq = lane >> 4;
    const int K = g.K, nt = K / BK;
    unsigned voffA[2], voffB[2];
#pragma unroll
    for (int i = 0; i < 2; ++i) { int R, C; stage_rc(tid * 16 + i * 8192, R, C); const int Rb = Epi::PERM ? ((R & ~31) + perm32(R & 31)) : R;
        voffA[i] = (unsigned)(R * g.lda + C) * 2u; voffB[i] = (unsigned)(Rb * K + C) * 2u; }
    const size_t kstep = (size_t)(BK * 2);
    const size_t hstepA = (size_t)HALF * g.lda * 2, hstepB = (size_t)HALF * K * 2;
    const size_t tstepA = 2 * hstepA, tstepB = 2 * hstepB;
    const unsigned ldsw = (unsigned)wid * 1024u;
    const int aoff = lds_byte(wr * 64 + fr, fq * 8), boff = lds_byte(wc * 32 + fr, fq * 8);
#define PG8_SA(b, h) (((b) * 2 + (h)) * HTB)
#define PG8_SB(b, h) ((4 + (b) * 2 + (h)) * HTB)
#define PG8_STAGE(bufoff, gbase, voff) do { _Pragma("unroll") for (int _i = 0; _i < 2; ++_i) \
        __builtin_amdgcn_global_load_lds((const unsigned*)((const char*)(gbase) + (voff)[_i]), (PG8_LAS unsigned*)(lds + (bufoff) + ldsw + _i * 8192), 16, 0, 0); } while (0)
#define PG8_LDA(dst, b, h) do { _Pragma("unroll") for (int m = 0; m < 4; ++m) _Pragma("unroll") for (int k = 0; k < 2; ++k) dst[m][k] = *(const PG8_LAS bf16x8*)(lds + PG8_SA(b, h) + aoff + m * 2048 + k * 1024); } while (0)
#define PG8_LDB(dst, b, h) do { _Pragma("unroll") for (int n = 0; n < 2; ++n) _Pragma("unroll") for (int k = 0; k < 2; ++k) dst[n][k] = *(const PG8_LAS bf16x8*)(lds + PG8_SB(b, h) + boff + n * 2048 + k * 1024); } while (0)
#define PG8_MMA(ai, bj, At, Bt) do { __builtin_amdgcn_s_setprio(1); _Pragma("unroll") for (int m = 0; m < 4; ++m) _Pragma("unroll") for (int n = 0; n < 2; ++n) _Pragma("unroll") for (int k = 0; k < 2; ++k) \
        acc[ai][bj][m][n] = __builtin_amdgcn_mfma_f32_16x16x32_bf16(Bt[n][k], At[m][k], acc[ai][bj][m][n], 0, 0, 0); __builtin_amdgcn_s_setprio(0); } while (0)
#define PG8_WAIT_V(n) asm volatile("s_waitcnt vmcnt(" #n ")" ::: "memory")
#define PG8_WAIT_L(n) asm volatile("s_waitcnt lgkmcnt(" #n ")" ::: "memory")
#define PG8_BAR __builtin_amdgcn_s_barrier()
#define PG8_SCHED __builtin_amdgcn_sched_barrier(0)
    Unit cur, nxt; int ui = 0;
    if (!S.next(0, cur)) return;
    f32x4 acc[2][2][4][2];
#pragma unroll
    for (int a = 0; a < 2; ++a)
#pragma unroll
        for (int b = 0; b < 2; ++b)
#pragma unroll
            for (int m = 0; m < 4; ++m)
#pragma unroll
                for (int n = 0; n < 2; ++n) acc[a][b][m][n] = (f32x4){0.f, 0.f, 0.f, 0.f};
    bf16x8 At[4][2], B0[2][2], B1[2][2];
    const char* cA = (const char*)g.A + (size_t)cur.pm * tstepA; const char* cB = (const char*)g.Bt + (size_t)cur.pn * tstepB;
    S.a_ready(cur);
    if constexpr (SP2) {
        PG8_STAGE(PG8_SB(0, 0), cB, voffB); PG8_STAGE(PG8_SB(0, 1), cB + hstepB, voffB); PG8_STAGE(PG8_SA(0, 0), cA, voffA); PG8_STAGE(PG8_SA(0, 1), cA + hstepA, voffA);
        if (wr == 1) PG8_BAR;
        PG8_WAIT_V(2); PG8_BAR;
        PG8_STAGE(PG8_SB(1, 0), cB + kstep, voffB); PG8_STAGE(PG8_SA(1, 0), cA + kstep, voffA); PG8_STAGE(PG8_SB(1, 1), cB + hstepB + kstep, voffB);
        PG8_WAIT_V(6); PG8_BAR;
    } else {
        PG8_STAGE(PG8_SB(0, 0), cB, voffB); PG8_STAGE(PG8_SA(0, 0), cA, voffA); PG8_STAGE(PG8_SB(0, 1), cB + hstepB, voffB); PG8_STAGE(PG8_SA(0, 1), cA + hstepA, voffA);
        if (wr == 1) PG8_BAR;
        PG8_WAIT_V(4); PG8_BAR;
        PG8_STAGE(PG8_SB(1, 0), cB + kstep, voffB); PG8_STAGE(PG8_SA(1, 0), cA + kstep, voffA); PG8_STAGE(PG8_SB(1, 1), cB + hstepB + kstep, voffB);
        PG8_WAIT_V(6); PG8_BAR;
    }
    for (;;) {
        const bool has_next = S.next(ui + 1, nxt);
        const char* nA = has_next ? (const char*)g.A + (size_t)nxt.pm * tstepA : cA; const char* nB = has_next ? (const char*)g.Bt + (size_t)nxt.pn * tstepB : cB;
        for (int t = 0; t < nt; t += 2) {
            const bool last = (t == nt - 2);
            const char* a1 = cA + (size_t)(t + 1) * kstep;
            const char* a2 = last ? nA : cA + (size_t)(t + 2) * kstep; const char* b2 = last ? nB : cB + (size_t)(t + 2) * kstep;
            const char* a3 = a2 + kstep; const char* b3 = b2 + kstep;
            if (last && has_next) S.a_ready(nxt);
            if constexpr (SP2) {
            PG8_LDB(B0, 0, 0); PG8_LDB(B1, 0, 1); PG8_SCHED; PG8_LDA(At, 0, 0); PG8_STAGE(PG8_SA(1, 1), a1 + hstepA, voffA);
            PG8_WAIT_V(8); PG8_WAIT_L(0); PG8_BAR; PG8_MMA(0, 0, At, B0); PG8_MMA(0, 1, At, B1); PG8_BAR; PG8_SCHED;
            PG8_LDA(At, 0, 1); PG8_STAGE(PG8_SB(0, 0), b2, voffB); PG8_STAGE(PG8_SB(0, 1), b2 + hstepB, voffB); PG8_STAGE(PG8_SA(0, 0), a2, voffA);
            PG8_WAIT_V(8); PG8_WAIT_L(0); PG8_BAR; PG8_MMA(1, 0, At, B0); PG8_MMA(1, 1, At, B1); PG8_BAR; PG8_SCHED;
            PG8_LDB(B0, 1, 0); PG8_LDB(B1, 1, 1); PG8_SCHED; PG8_LDA(At, 1, 0); PG8_STAGE(PG8_SA(0, 1), a2 + hstepA, voffA);
            PG8_WAIT_V(8); PG8_WAIT_L(0); PG8_BAR; PG8_MMA(0, 0, At, B0); PG8_MMA(0, 1, At, B1); PG8_BAR; PG8_SCHED;
            PG8_LDA(At, 1, 1); PG8_STAGE(PG8_SB(1, 0), b3, voffB); PG8_STAGE(PG8_SB(1, 1), b3 + hstepB, voffB); PG8_STAGE(PG8_SA(1, 0), a3, voffA);
            PG8_WAIT_V(8); PG8_WAIT_L(0); PG8_BAR; PG8_MMA(1, 0, At, B0); PG8_MMA(1, 1, At, B1); PG8_BAR; PG8_SCHED;
            } else {
            PG8_LDB(B0, 0, 0); PG8_SCHED; PG8_LDA(At, 0, 0); PG8_STAGE(PG8_SA(1, 1), a1 + hstepA, voffA);
            PG8_WAIT_L(8); PG8_BAR; PG8_WAIT_L(0); PG8_MMA(0, 0, At, B0); PG8_BAR; PG8_SCHED;
            PG8_LDB(B1, 0, 1); PG8_STAGE(PG8_SB(0, 0), b2, voffB);
            PG8_BAR; PG8_WAIT_L(0); PG8_MMA(0, 1, At, B1); PG8_BAR;
            PG8_LDA(At, 0, 1); PG8_STAGE(PG8_SA(0, 0), a2, voffA);
            PG8_BAR; PG8_WAIT_L(0); PG8_MMA(1, 0, At, B0); PG8_BAR; PG8_SCHED;
            PG8_STAGE(PG8_SB(0, 1), b2 + hstepB, voffB);
            PG8_WAIT_V(6); PG8_BAR; PG8_MMA(1, 1, At, B1); PG8_BAR;
            PG8_LDB(B0, 1, 0); PG8_SCHED; PG8_LDA(At, 1, 0); PG8_STAGE(PG8_SA(0, 1), a2 + hstepA, voffA);
            PG8_WAIT_L(8); PG8_BAR; PG8_WAIT_L(0); PG8_MMA(0, 0, At, B0); PG8_BAR; PG8_SCHED;
            PG8_LDB(B1, 1, 1); PG8_STAGE(PG8_SB(1, 0), b3, voffB);
            PG8_BAR; PG8_WAIT_L(0); PG8_MMA(0, 1, At, B1); PG8_BAR;
            PG8_LDA(At, 1, 1); PG8_STAGE(PG8_SA(1, 0), a3, voffA);
            PG8_BAR; PG8_WAIT_L(0); PG8_MMA(1, 0, At, B0); PG8_BAR; PG8_SCHED;
            PG8_STAGE(PG8_SB(1, 1), b3 + hstepB, voffB);
            PG8_WAIT_V(6); PG8_BAR; PG8_MMA(1, 1, At, B1); PG8_BAR;
            }
        }
        if constexpr (ALIGN_EPI) { if (wr == 0) PG8_BAR; }
        if constexpr (!Epi::AFTER_DRAIN) { E(acc, cur, wr, wc, fr, fq); S.done(cur); }
        if (!has_next) break;
#pragma unroll
        for (int a = 0; a < 2; ++a)
#pragma unroll
            for (int b = 0; b < 2; ++b)
#pragma unroll
                for (int m = 0; m < 4; ++m)
#pragma unroll
                    for (int n = 0; n < 2; ++n) acc[a][b][m][n] = (f32x4){0.f, 0.f, 0.f, 0.f};
        cur = nxt; cA = nA; cB = nB; ++ui;
        if constexpr (ALIGN_EPI) { if (wr == 1) PG8_BAR; }
    }
    PG8_WAIT_V(0);
    if constexpr (!ALIGN_EPI) { if (wr == 0) PG8_BAR; }
    PG8_BAR;
    if constexpr (Epi::AFTER_DRAIN) { E.fused(acc, cur, wr, wc, fr, fq, lds, wid, lane); S.done(cur); }
#undef PG8_SA
#undef PG8_SB
#undef PG8_STAGE
#undef PG8_LDA
#undef PG8_LDB
#undef PG8_MMA
#undef PG8_WAIT_V
#undef PG8_WAIT_L
#undef PG8_BAR
#undef PG8_SCHED
}
}

namespace pg8 {
struct EpiScale {
    static constexpr bool PERM = true, AFTER_DRAIN = false;
    bf16_t* O; int ldo; const float* ssq; float inv_n; int act;
    __device__ __forceinline__ void operator()(const f32x4 (&acc)[2][2][4][2], const Unit& u, int wr, int wc, int fr, int fq) const {
        asm volatile("" : "+v"(fr), "+v"(fq));
        const int row0 = u.pm * BM + wr * 64 + fr, col0 = u.pn * BM + wc * 32 + 8 * fq;
        float rsv[8];
#pragma unroll
        for (int i = 0; i < 8; ++i) rsv[i] = ssq ? ssq[row0 + (i >> 2) * HALF + (i & 3) * 16] : 0.f;
#pragma unroll
        for (int i = 0; i < 8; ++i) rsv[i] = ssq ? rsqrtf(rsv[i] * inv_n + 1e-6f) : 1.f;
#pragma unroll
        for (int ai = 0; ai < 2; ++ai)
#pragma unroll
            for (int m = 0; m < 4; ++m) {
                const int row = row0 + ai * HALF + m * 16;
                const float rs = rsv[ai * 4 + m];
                bf16_t* rowp = O + (size_t)row * ldo + col0;
#pragma unroll
                for (int bj = 0; bj < 2; ++bj) {
                    f32x4 v0 = acc[ai][bj][m][0] * rs, v1 = acc[ai][bj][m][1] * rs;
                    if (act == 1) {
#pragma unroll
                        for (int j = 0; j < 4; ++j) { const float a = fmaxf(v0[j], 0.f), b = fmaxf(v1[j], 0.f); v0[j] = a * a; v1[j] = b * b; }
                    }
                    u32x4 w; w.x = ::cvtpk(v0[0], v0[1]); w.y = ::cvtpk(v0[2], v0[3]); w.z = ::cvtpk(v1[0], v1[1]); w.w = ::cvtpk(v1[2], v1[3]);
                    if (MK_WT) ::st16_wt(rowp + bj * HALF, w); else *(u32x4*)(rowp + bj * HALF) = w;
                }
            }
    }
};
struct EpiHead {
    static constexpr bool PERM = true, AFTER_DRAIN = false;
    int kind; bf16_t* O; int ldo; const float* ssq; float inv_n; const float* cs;
    const float *g0, *g1, *g2, *g3; float* ssq_ckv; float* WI; bf16_t* KI; PG8_LAS float* X;
    __device__ __forceinline__ void operator()(f32x4 (&acc)[2][2][4][2], const Unit& u, int wr, int wc, int fr, int fq) const {
        asm volatile("" : "+v"(fr), "+v"(fq));
        asm volatile("" : "+s"(wr), "+s"(wc));
        const int wave = wr * 4 + wc, pn = u.pn;
        int gt = 0; bool rope = false; float scale = 1.f; const float* g = nullptr;
        if (kind == 0) {
            if (pn < 2) { gt = 1; rope = true; scale = 0.125f * 1.4426950408889634f; g = g0; }
            else if (pn < 4) { gt = 1; rope = true; g = g1; }
            else if (pn < 6) { gt = 0; }
            else if (pn < 8) { gt = 1; rope = true; scale = 0.125f * 1.4426950408889634f; g = g2; }
            else if (pn == 8) { gt = 3; }
            else if (pn == 9) { gt = 4; rope = true; }
            else { gt = 1; rope = true; g = g3; }
        } else if (kind == 1) { if (pn < 2) { gt = 1; rope = true; g = g0; } }
        else { if ((pn & 3) < 2) { gt = 2; g = g0 + (pn >> 2) * 128; } }
        const int row0 = u.pm * BM + wr * 64 + fr, col0 = pn * BM + wc * 32 + 8 * fq;
        PG8_LAS float* CSL = X + 2048;
        if (rope) {
            const int tid_ = (wave * 4 + fq) * 16 + fr; f32x4 t_[2];
#pragma unroll
            for (int i = 0; i < 2; ++i) { const int idx = tid_ + 512 * i; t_[i] = *(const f32x4*)(cs + (size_t)(u.pm * BM + (idx >> 2)) * 16 + 4 * (idx & 3)); }
#pragma unroll
            for (int i = 0; i < 2; ++i) { const int idx = tid_ + 512 * i; *(PG8_LAS f32x4*)(CSL + (idx >> 2) * 20 + 4 * (idx & 3)) = t_[i]; }
        }
        float rsv[8];
#pragma unroll
        for (int i = 0; i < 8; ++i) rsv[i] = ssq[row0 + (i >> 2) * HALF + (i & 3) * 16];
#pragma unroll
        for (int i = 0; i < 8; ++i) rsv[i] = rsqrtf(rsv[i] * inv_n + 1e-6f);
        float gv[8];
        { const int db = (gt == 2) ? (32 * wc + 8 * fq) : (32 * (wc & 1) + 8 * fq);
#pragma unroll
          for (int j = 0; j < 8; ++j) gv[j] = g ? g[db + j] : 1.f; }
#pragma unroll
        for (int ai = 0; ai < 2; ++ai)
#pragma unroll
            for (int m = 0; m < 4; ++m) {
                const float rs = rsv[ai * 4 + m];
#pragma unroll
                for (int bj = 0; bj < 2; ++bj) {
                    acc[ai][bj][m][0] *= rs; acc[ai][bj][m][1] *= rs;
                    const f32x4 a = acc[ai][bj][m][0], b = acc[ai][bj][m][1];
                    float s = (a[0] * a[0] + a[1] * a[1]) + (a[2] * a[2] + a[3] * a[3]) + (b[0] * b[0] + b[1] * b[1]) + (b[2] * b[2] + b[3] * b[3]);
                    s = ::sum_rows4(s);
                    if (fq == 0) X[(((wave * 2 + ai) * 4 + m) * 2 + bj) * 16 + fr] = s;
                }
            }
        asm volatile("s_waitcnt lgkmcnt(0)\n\ts_barrier" ::: "memory");
#pragma unroll
        for (int ai = 0; ai < 2; ++ai)
#pragma unroll
            for (int m = 0; m < 4; ++m) {
                const int row = row0 + ai * HALF + m * 16;
                float cs16[16];
                if (rope) { const PG8_LAS float* c = CSL + (ai * HALF + wr * 64 + m * 16 + fr) * 20;
#pragma unroll
                    for (int q = 0; q < 4; ++q) { const f32x4 t = *(const PG8_LAS f32x4*)(c + 4 * q); cs16[4 * q] = t[0]; cs16[4 * q + 1] = t[1]; cs16[4 * q + 2] = t[2]; cs16[4 * q + 3] = t[3]; }
#pragma unroll
                    for (int j = 0; j < 8; ++j) { const float cj = cs16[j], sj = cs16[8 + j];
                        cs16[j] = (fq == 0) ? cj : (fq == 1) ? sj : (fq == 2) ? 1.f : 0.f; cs16[8 + j] = (fq == 0) ? -sj : (fq == 1) ? cj : (fq == 2) ? 0.f : 1.f; } }
                float rowtot = 0.f;
#pragma unroll
                for (int bj = 0; bj < 2; ++bj) {
                    float v[8];
#pragma unroll
                    for (int j = 0; j < 4; ++j) { v[j] = acc[ai][bj][m][0][j]; v[4 + j] = acc[ai][bj][m][1][j]; }
#define XAT(w_) X[((((w_) * 2 + ai) * 4 + m) * 2 + bj) * 16 + fr]
                    if (gt == 1) {
                        const float tot = XAT(wave) + XAT(wave ^ 1), r2 = rsqrtf(tot * (1.f / 64.f) + 1e-6f);
#pragma unroll
                        for (int j = 0; j < 8; ++j) v[j] = v[j] * r2 * gv[j];
                    } else if (gt == 2) {
                        const int w0 = wave & 4; const float tot = (XAT(w0) + XAT(w0 + 1)) + (XAT(w0 + 2) + XAT(w0 + 3)), r2 = rsqrtf(tot * (1.f / 128.f) + 1e-6f);
#pragma unroll
                        for (int j = 0; j < 8; ++j) v[j] = v[j] * r2 * gv[j];
                    } else if (gt == 3) {
                        const int w0 = wave & 4; rowtot += (XAT(w0) + XAT(w0 + 1)) + (XAT(w0 + 2) + XAT(w0 + 3));
                    }
#undef XAT
                    if (rope && (wc & 1) == 0) {
#pragma unroll
                        for (int j = 0; j < 8; ++j) { const auto r = __builtin_amdgcn_permlane16_swap(__float_as_uint(v[j]), __float_as_uint(v[j]), false, false);
                            v[j] = __uint_as_float(r[0]) * cs16[j] + __uint_as_float(r[1]) * cs16[8 + j]; }
                    }
                    u32x4 w; w.x = ::cvtpk(v[0] * scale, v[1] * scale); w.y = ::cvtpk(v[2] * scale, v[3] * scale); w.z = ::cvtpk(v[4] * scale, v[5] * scale); w.w = ::cvtpk(v[6] * scale, v[7] * scale);
                    if (kind == 0 && pn == 10) {
                        if (bj == 0 && wc < 2) { const int c = 4 * wc + fq;
                            *(u32x4*)(KI + (size_t)(row >> 5) * 2048 + (c >> 1) * 512 + (((c & 1) * 32 + (row & 31)) * 8)) = w; }
                        if (bj == 0 && wc == 2 && fq == 0) *(f32x4*)(WI + (size_t)row * 4) = acc[ai][0][m][0] * (1.f / 16.f);
                    } else {
                        *(u32x4*)(O + (size_t)row * ldo + col0 + bj * HALF) = w;
                    }
                }
                if (gt == 3 && wc == 0 && fq == 0) ssq_ckv[row] = rowtot;
            }
    }
};
template <bool F32BASE> struct EpiResidT {
    static constexpr bool PERM = true, AFTER_DRAIN = false;
    const float* basef; float* outf; bf16_t* xb; float* ssq_next; int dry;
    __device__ __forceinline__ void operator()(const f32x4 (&acc)[2][2][4][2], const Unit& u, int wr, int wc, int fr, int fq) const {
        asm volatile("" : "+v"(fr), "+v"(fq));
        const int col0 = u.pn * BM + wc * 32 + 8 * fq;
        constexpr int MB = F32BASE ? 2 : 4;
#pragma unroll
        for (int ai = 0; ai < 2; ++ai)
#pragma unroll
        for (int m0 = 0; m0 < 4; m0 += MB) {
            u32x4 bb[MB][2]; f32x4 bf[MB][2][2];
#pragma unroll
            for (int mm = 0; mm < MB; ++mm)
#pragma unroll
                for (int bj = 0; bj < 2; ++bj) { const size_t idx = (size_t)(u.pm * BM + ai * HALF + wr * 64 + (m0 + mm) * 16 + fr) * 1024 + col0 + bj * HALF;
                    if (F32BASE) { bf[mm][bj][0] = *(const f32x4*)(basef + idx); bf[mm][bj][1] = *(const f32x4*)(basef + idx + 4); } else bb[mm][bj] = *(const u32x4*)(xb + idx); }
#pragma unroll
            for (int mm = 0; mm < MB; ++mm) { const int m = m0 + mm;
                const int row = u.pm * BM + ai * HALF + wr * 64 + m * 16 + fr; const size_t off = (size_t)row * 1024 + col0; float s = 0.f;
#pragma unroll
                for (int bj = 0; bj < 2; ++bj) {
                    const size_t idx = off + bj * HALF;
                    f32x4 x0, x1;
                    if (F32BASE) { x0 = bf[mm][bj][0]; x1 = bf[mm][bj][1]; }
                    else { const u32x4 b = bb[mm][bj]; x0 = (f32x4){::lo16(b.x), ::hi16(b.x), ::lo16(b.y), ::hi16(b.y)}; x1 = (f32x4){::lo16(b.z), ::hi16(b.z), ::lo16(b.w), ::hi16(b.w)}; }
                    x0 += acc[ai][bj][m][0]; x1 += acc[ai][bj][m][1];
                    s += (x0[0] * x0[0] + x0[1] * x0[1]) + (x0[2] * x0[2] + x0[3] * x0[3]) + (x1[0] * x1[0] + x1[1] * x1[1]) + (x1[2] * x1[2] + x1[3] * x1[3]);
                    if (outf && !dry) { *(f32x4*)(outf + idx) = x0; *(f32x4*)(outf + idx + 4) = x1; }
                    if (xb && !outf && !dry) { u32x4 w; w.x = ::cvtpk(x0[0], x0[1]); w.y = ::cvtpk(x0[2], x0[3]); w.z = ::cvtpk(x1[0], x1[1]); w.w = ::cvtpk(x1[2], x1[3]); *(u32x4*)(xb + idx) = w; }
                    if (dry) asm volatile("" :: "v"(x0), "v"(x1));
                }
                if (ssq_next && !dry) { s = ::sum_rows4(s); if (fq == 0) atomicAdd(ssq_next + row, s); }
            }
            asm volatile("" ::: "memory");
        }
    }
};
typedef EpiResidT<false> EpiResid; typedef EpiResidT<true> EpiResidF;
}

#define XB_TMO      128
#define XB_XCNT(j)  (256  + 64 * (j))
#define XB_XSUB(j)  (1280 + 64 * (j))
#define XB_XGEN(j)  (2304 + 64 * (j))
#define XB_TOP      3328
#define XB_TOPGEN   3392
#define XCD_BAR_WORDS 3456
#define XB_SPIN_CAP (1u << 18)

__device__ __forceinline__ unsigned xb_ld(unsigned* p)              { return __hip_atomic_load(p, __ATOMIC_RELAXED, __HIP_MEMORY_SCOPE_AGENT); }
__device__ __forceinline__ unsigned xb_add(unsigned* p, unsigned v) { return __hip_atomic_fetch_add(p, v, __ATOMIC_RELAXED, __HIP_MEMORY_SCOPE_AGENT); }
__device__ __forceinline__ unsigned xb_xcc_id() { return (unsigned)__builtin_amdgcn_s_getreg((3 << 11) | 20) & 0xFu; }
#define XB_SPIN(cond, bar) do { unsigned _sp = 0; while (cond) { __builtin_amdgcn_s_sleep(1); \
    if ((++_sp & 255u) == 0u) { if (xb_ld(&(bar)[XB_TMO])) break; if (_sp > XB_SPIN_CAP) { atomicAdd(&(bar)[XB_TMO], 1u); break; } } } } while (0)

struct XcdBarrier {
    unsigned* bar; unsigned x;
    volatile LAS unsigned* st;
};

__device__ __forceinline__ XcdBarrier xcd_barrier_post(unsigned* bar, volatile LAS unsigned* st) {
    XcdBarrier b; b.bar = bar; b.x = xb_xcc_id(); b.st = st;
    if (threadIdx.x == 0) (void)xb_add(&bar[XB_XCNT(b.x)], 1u);
    return b;
}
__device__ __forceinline__ void xcd_barrier_complete(unsigned* bar, unsigned x, unsigned& nloc, unsigned& nx) {
    const unsigned G = gridDim.x * gridDim.y * gridDim.z;
    unsigned sum, cnt, mine, sp = 0u;
    for (;;) {
        sum = 0u; cnt = 0u; mine = 0u;
#pragma unroll
        for (unsigned j = 0; j < 16; ++j) { const unsigned c = xb_ld(&bar[XB_XCNT(j)]); sum += c; cnt += (c > 0u) ? 1u : 0u; mine = (j == x) ? c : mine; }
        if (sum == G) break;
        __builtin_amdgcn_s_sleep(1);
        if ((++sp & 255u) == 0u) { if (xb_ld(&bar[XB_TMO])) break; if (sp > XB_SPIN_CAP) { atomicAdd(&bar[XB_TMO], 1u); break; } }
    }
    nloc = mine > 0u ? mine : 1u; nx = cnt > 0u ? cnt : 1u;
}

__device__ __forceinline__ void xcd_barrier(const XcdBarrier& b) {
    asm volatile("s_waitcnt vmcnt(0)" ::: "memory");
    __syncthreads();
    if (tid_opaque() == 0) {
        unsigned* bar = b.bar;
        __builtin_amdgcn_s_waitcnt(0);
        unsigned nloc = b.st[0], nx = b.st[1];
        if (nloc == 0u) { xcd_barrier_complete(bar, b.x, nloc, nx); b.st[0] = nloc; b.st[1] = nx; }
        const unsigned old = xb_add(&bar[XB_XSUB(b.x)], 1u);
        const unsigned gen = old / nloc;
        if (old + 1u == (gen + 1u) * nloc) {
            __builtin_amdgcn_fence(__ATOMIC_RELEASE, "agent");
            asm volatile("s_waitcnt vmcnt(0)" ::: "memory");
            const unsigned og = xb_add(&bar[XB_TOP], 1u);
            const unsigned tg = og / nx;
            if (og + 1u == (tg + 1u) * nx) xb_add(&bar[XB_TOPGEN], 1u);
            else XB_SPIN(xb_ld(&bar[XB_TOPGEN]) == tg, bar);
            __builtin_amdgcn_fence(__ATOMIC_ACQUIRE, "agent");
            xb_add(&bar[XB_XGEN(b.x)], 1u);
            asm volatile("s_waitcnt vmcnt(0)" ::: "memory");
        } else {
            XB_SPIN(xb_ld(&bar[XB_XGEN(b.x)]) == gen, bar);
            __builtin_amdgcn_fence(__ATOMIC_ACQUIRE, "agent");
            asm volatile("s_waitcnt vmcnt(0)" ::: "memory");
        }
    }
    __syncthreads();
}
constexpr int NPHASE = 22;
constexpr int MISC_OFF = LDS_BYTES - 256;
#ifndef MK_REP_N
#define MK_REP_N 0
#define MK_REP_LO 0
#define MK_REP_HI -1
#endif
#ifndef MK_XPH
#define MK_XPH -1
#define MK_XN 0
#endif
#ifndef MK_SUB
#define MK_SUB 0
#endif
#ifndef MK_IDX2
#define MK_IDX2 0
#endif
#ifndef MK_CGSYNC
#define MK_CGSYNC 0
#endif
template <class Epi, bool ALIGN>
DEVI void run_gemm(LAS unsigned char* lds, const bf16_t* A, int lda, const bf16_t* Bt, int M, int N, int K, const Epi& E, int cu_off = 0) {
    const int Gd = (int)gridDim.x; int cu = (int)blockIdx.x - cu_off; if (cu < 0) cu += Gd;
    pg8::Gemm g{A, lda, Bt, M, N, K}; pg8::StaticOrder So; So.init(M, N, Gd, cu);
    pg8::gemm_phase<Epi, pg8::StaticOrder, ALIGN, MK_SP2>(lds, g, So, E);
}
template <bool DRYK>
__global__ void __launch_bounds__(NTHR, 2) mega(Params P, int ph_lo, int ph_hi) {
    LAS unsigned char* lds = (LAS unsigned char*)lds_raw;
    cg::grid_group grid = cg::this_grid();
    { volatile LAS unsigned* MISC0 = (volatile LAS unsigned*)(lds + MISC_OFF);
      if (threadIdx.x < 32) MISC0[threadIdx.x] = 0u;
      if ((threadIdx.x & 63) == 0) ((volatile LAS unsigned char*)lds)[WTAB_OFF + hw_slot()] = (unsigned char)(threadIdx.x >> 6);
      __syncthreads();
      if (ph_hi - ph_lo > 1) (void)xcd_barrier_post((unsigned*)(P.ws + WS_BAR), MISC0 + 8); }
    if (ph_lo < 0) grid.sync();
#define PH_LOCALS unsigned char* ws = P.ws; asm volatile("" : "+s"(ws)); float* ssq = (float*)(ws + WS_SSQ); bf16_t* XB = (bf16_t*)(ws + WS_XB); bf16_t* Y = (bf16_t*)(ws + WS_Y); const int G = gridDim.x, bx = blockIdx.x; (void)ssq; (void)XB; (void)Y; (void)G; (void)bx;
#define SEAM_XCD() do { XcdBarrier b_; b_.bar = (unsigned*)(P.ws + WS_BAR); b_.x = xb_xcc_id(); b_.st = (volatile LAS unsigned*)(lds + MISC_OFF) + 8; xcd_barrier(b_); } while (0)
#define PH_REPS(k) (((k) >= MK_REP_LO && (k) <= MK_REP_HI && (k) != 2 && (k) != 4) ? 1 + MK_REP_N : 1)
#define PH_BEGIN(k) if (ph_lo <= (k) && (k) < ph_hi) { PH_LOCALS for (int rep = 0; rep < PH_REPS(k); ++rep) { const int dry = (rep > 0) || DRYK; (void)dry; if (rep > 0) SEAM_XCD();
#define PH_END(k) } if ((k) + 1 < ph_hi) { if (MK_CGSYNC) grid.sync(); else SEAM_XCD(); } }
#define DRYOUT (dry ? (float*)(ws + WS_Y) : P.out)
    using pg8::EpiScale; using pg8::EpiResid; using pg8::EpiResidF; using pg8::EpiHead;
    PH_BEGIN(0) phase_prologue(P, lds, dry); PH_END(0)
    PH_BEGIN(1)
#if MK_FUSE & 1
        run_gemm<EpiHead, true>(lds, (const bf16_t*)(ws + WS_XB), 1024, (const bf16_t*)(ws + W_INE), T, LDP, 1024,
            EpiHead{0, (bf16_t*)(ws + WS_PROJ), LDP, ssq, 1.f / 1024.f, (const float*)(ws + WS_CS), P.in[15], P.in[16], P.in[24], P.in[26],
                    (float*)(ws + WS_SSQCKV), (float*)(ws + WS_WI), (bf16_t*)(ws + WS_KI), (LAS float*)(lds + 132096)});
#else
        run_gemm<EpiScale, true>(lds, (const bf16_t*)(ws + WS_XB), 1024, (const bf16_t*)(ws + W_INE), T, LDP, 1024, EpiScale{(bf16_t*)(ws + WS_PROJ), LDP, ssq, 1.f / 1024.f, 0});
#endif
#if MK_FUSE & 2
        run_gemm<EpiHead, true>(lds, (const bf16_t*)(ws + WS_MB), 1024, (const bf16_t*)(ws + W_KVX), MEMT, 2048, 1024,
            EpiHead{2, (bf16_t*)(ws + WS_KVX), 2048, (const float*)(ws + WS_SSQMEM), 1.f / 1024.f, nullptr, P.in[10], nullptr, nullptr, nullptr, nullptr, nullptr, nullptr, (LAS float*)(lds + 132096)},
            ((T / 256) * (LDP / 256)) % G);
#else
        run_gemm<EpiScale, false>(lds, (const bf16_t*)(ws + WS_MB), 1024, (const bf16_t*)(ws + W_KVX), MEMT, 2048, 1024, EpiScale{(bf16_t*)(ws + WS_KVX), 2048, (const float*)(ws + WS_SSQMEM), 1.f / 1024.f, 0}, ((T / 256) * (LDP / 256)) % G);
#endif
    PH_END(1)
#if (MK_FUSE & 3) != 3
    PH_BEGIN(2) phase_post0(P, ((MK_FUSE & 1) ? 0 : 1) | ((MK_FUSE & 2) ? 0 : 2)); PH_END(2)
#endif
    PH_BEGIN(5)
        run_gemm<EpiHead, true>(lds, (const bf16_t*)(ws + WS_PROJ) + C_CKV, LDP, (const bf16_t*)(ws + W_KVUP), T, 1024, 256,
            EpiHead{1, (bf16_t*)(ws + WS_KBVB), 1024, (const float*)(ws + WS_SSQCKV), 1.f / 256.f, (const float*)(ws + WS_CS), P.in[25], nullptr, nullptr, nullptr, nullptr, nullptr, nullptr, (LAS float*)(lds + 132096)});
        __syncthreads();
        if (!(dry && MK_SUB == 2))
        for (int u = bx; u < 256; u += G) { const int bhc = 4 * (u & 7) + (u >> 6), s = (u >> 3) & 7, b = bhc >> 3, h = (bhc >> 1) & 3, c = bhc & 1;
#if MK_A64
            const bf16_t* pj_ = (const bf16_t*)(ws + WS_PROJ) + (size_t)b * S * LDP; bf16_t* oa_ = (bf16_t*)(ws + WS_XB) + (size_t)c * T * 512 + (size_t)b * S * 512 + h * 128;
            if (a64::unit(s, pj_ + C_QA + (2 * h + c) * 64, pj_ + C_KA + (2 * h + c) * 64, pj_ + C_VA + h * 128, LDP, oa_, 512, lds)) attnA_unit(P, b, h, c, s, lds);
            if (a64::unit(15 - s, pj_ + C_QA + (2 * h + c) * 64, pj_ + C_KA + (2 * h + c) * 64, pj_ + C_VA + h * 128, LDP, oa_, 512, lds)) attnA_unit(P, b, h, c, 15 - s, lds);
#else
            attnA_unit(P, b, h, c, s, lds); attnA_unit(P, b, h, c, 15 - s, lds);
#endif
        }
        if (!(dry && MK_SUB == 1))
#if MK_IQUEUE
        {
            unsigned* queue = (unsigned*)(ws + WS_BAR + 15360); volatile LAS unsigned* nx = (volatile LAS unsigned*)(lds + MISC_OFF) + 24;
            int n = bx; const int t9 = tid_opaque();
            while (n < 2048) {
                unsigned req = 0u; if (t9 == 0) req = (unsigned)G + __hip_atomic_fetch_add(queue, 1u, __ATOMIC_RELAXED, __HIP_MEMORY_SCOPE_AGENT);
                indexer_unit(P, n & 3, (511 - (n >> 2)) * 8, lds);
                if (t9 == 0) *nx = req;
                __syncthreads();
                n = (int)*nx;
                __syncthreads();
            }
        }
#else
        for (int u = bx; u < 2048; u += G) { const int k = u / 256, c = u % 256, b = k >> 1; const int blk = (k & 1) ? (511 - c) : c;
            indexer_unit(P, b, blk * 8, lds); }
#endif
#if MK_IDX2
        for (int u = bx; u < 2048; u += G) { const int k = u / 256, c = u % 256, b = k >> 1; const int blk = (k & 1) ? (511 - c) : c;
            indexer_unit(P, b, blk * 8, lds); }
#endif
    PH_END(5)
    PH_BEGIN(6)
        if (!(dry && MK_SUB == 2))
        for (int u = bx; u < 256; u += G) { const int bh = 4 * (u & 7) + (u >> 6), s = (u >> 3) & 7, b = bh >> 3, hd = bh & 7;
#if MK_B64
            const bf16_t* kb_ = (const bf16_t*)(ws + WS_KBVB) + (size_t)b * S * 1024 + hd * 64; const bf16_t* qb_ = (const bf16_t*)(ws + WS_PROJ) + (size_t)b * S * LDP + C_QB + hd * 64;
            bf16_t* ob_ = (bf16_t*)(ws + WS_Y) + (size_t)b * S * 1024 + 512 + hd * 64; const u64* mb_ = (const u64*)(ws + WS_MASK) + (size_t)b * S * 64;
            if (b64::unit(s, qb_, LDP, kb_, kb_ + 512, ob_, mb_, lds)) attnB_unit(P, b, hd, s, lds);
            if (b64::unit(15 - s, qb_, LDP, kb_, kb_ + 512, ob_, mb_, lds)) attnB_unit(P, b, hd, 15 - s, lds);
#else
            attnB_unit(P, b, hd, s, lds); attnB_unit(P, b, hd, 15 - s, lds);
#endif
        }
        if (!(dry && MK_SUB == 1)) combineA_rows(P);
    PH_END(6)
    PH_BEGIN(7) run_gemm<EpiResidF, true>(lds, Y, 1024, (const bf16_t*)(ws + W_OUTE), T, 1024, 1024, EpiResidF{P.in[0], nullptr, XB, ssq + 1 * T, dry});
        if (!dry) { const int t8 = tid_opaque(); convert_weights(P, lds, NTR_EARLY, NTR, true, bx * NWAVE + (t8 >> 6), G * NWAVE, bx * NTHR + t8, G * NTHR); }
    PH_END(8)
#define XATTN_MLP(l, p0)                                                                                                                                                      \
    PH_BEGIN(p0 + 1) for (int u = bx; u < 256; u += G) { const int b = u >> 6, hd = (u >> 4) & 3, qb = u & 15; xattn_fused_unit(P, (l), b, hd, qb, lds); } PH_END(p0 + 1)                           \
    PH_BEGIN(p0 + 2) run_gemm<EpiResid, true>(lds, (const bf16_t*)(ws + WS_YX), 512, (const bf16_t*)(ws + W_OX) + (size_t)(l) * 1024 * 512, T, 1024, 512, EpiResid{nullptr, nullptr, XB, ssq + ((l) ? 5 : 2) * T, dry}); PH_END(p0 + 2) \
    PH_BEGIN(p0 + 3) run_gemm<EpiScale, true>(lds, XB, 1024, (const bf16_t*)(ws + W_UP) + (size_t)(l) * 4096 * 1024, T, DFF, 1024, EpiScale{(bf16_t*)(ws + WS_H), DFF, ssq + ((l) ? 5 : 2) * T, 1.f / 1024.f, 1}); PH_END(p0 + 3)
    XATTN_MLP(0, 8)
    PH_BEGIN(12) run_gemm<EpiResid, true>(lds, (const bf16_t*)(ws + WS_H), DFF, (const bf16_t*)(ws + W_DOWN), T, 1024, DFF, EpiResid{nullptr, nullptr, XB, ssq + 3 * T, dry}); PH_END(12)
    PH_BEGIN(13) run_gemm<EpiScale, true>(lds, XB, 1024, (const bf16_t*)(ws + W_INO), T, 2048, 1024, EpiScale{(bf16_t*)(ws + WS_PROJ1), 2048, ssq + 3 * T, 1.f / 1024.f, 0}); PH_END(13)
    PH_BEGIN(14) phase_mix1(P); PH_END(15)
    PH_BEGIN(16) run_gemm<EpiResid, true>(lds, Y, 1024, (const bf16_t*)(ws + W_OUTO), T, 1024, 1024, EpiResid{nullptr, nullptr, XB, ssq + 4 * T, dry}); PH_END(16)
    XATTN_MLP(1, 17)
    PH_BEGIN(21) run_gemm<EpiResid, true>(lds, (const bf16_t*)(ws + WS_H), DFF, (const bf16_t*)(ws + W_DOWN) + (size_t)1024 * 4096, T, 1024, DFF, EpiResid{nullptr, P.out, XB, nullptr, dry}); PH_END(21)
#if MK_TPROBE
    if (ph_hi == NPHASE) { SEAM_XCD(); unsigned char* ws = P.ws;
        const unsigned long long* TS = (const unsigned long long*)(ws + WS_BAR + 65536);
        float delta = (MK_TPROBE == 14) ? (float)TS[12] / 625000.f : (MK_TPROBE >= 10) ? (float)TS[8 + MK_TPROBE - 10] / (float)TS[12] : (MK_TPROBE == 4 || MK_TPROBE == 20) ? (float)TS[3] * 1e-6f : (float)TS[MK_TPROBE - 1] / (float)TS[3];
        delta = floorf(delta * 25.f + 0.5f) * 0.04f;
        if (MK_TPROBE == 20) delta = 0.1f * floorf(log2f((float)TS[3] / 64000.f) + 0.5f);
        if (MK_TPROBE == 34) delta = 0.1f * floorf(log2f((float)TS[20] / 1000.f) * 2.f + 0.5f) * 0.5f;
        else if (MK_TPROBE >= 30) delta = 0.04f * floorf(25.f * (float)TS[16 + MK_TPROBE - 30] / (float)TS[20] + 0.5f);
        for (int i = blockIdx.x * NTHR + threadIdx.x; i < T * D; i += gridDim.x * NTHR) P.out[i] *= (1.f + delta); }
#endif
}

#ifndef MK_MULTI
#define MK_MULTI 0
#endif
extern "C" void kernel_launch(void* const* d_in, const int* in_sizes, int n_in, void* d_out, int out_size, void* d_ws, size_t ws_size, hipStream_t stream) {
    static int grid = 0;
    if (grid == 0) {
        if (n_in != 33 || out_size != T * D || ws_size < WS_END) { fprintf(stderr, "kernel_launch: unexpected shapes (n_in %d out %d ws %zu)\n", n_in, out_size, ws_size); grid = -1; return; }
        int dev = 0, cus = 0, per_cu = 0;
        hipGetDevice(&dev); hipDeviceGetAttribute(&cus, hipDeviceAttributeMultiprocessorCount, dev);
        hipFuncSetAttribute((const void*)mega<false>, hipFuncAttributeMaxDynamicSharedMemorySize, LDS_BYTES);
        hipOccupancyMaxActiveBlocksPerMultiprocessor(&per_cu, (const void*)mega<false>, NTHR, LDS_BYTES);
        if (per_cu < 1) { fprintf(stderr, "kernel_launch: occupancy query says %d blocks/CU\n", per_cu); per_cu = 1; }
        (void)hipGetLastError();
        grid = cus * 1;
    }
    if (grid < 0) return;
    Params p{};
    for (int i = 0; i < 33; ++i) p.in[i] = (const float*)d_in[i];
    p.out = (float*)d_out; p.ws = (unsigned char*)d_ws;
    (void)hipMemsetAsync((char*)d_ws + WS_BAR, 0, MK_TPROBE ? 131072 : 16384, stream);
#if MK_MULTI
    for (int ph = 0; ph < NPHASE; ++ph) hipLaunchKernelGGL(mega<false>, dim3(grid), dim3(NTHR), LDS_BYTES, stream, p, ph, ph + 1);
#else
    int lo = 0, hi = NPHASE;
    void* args[] = {&p, &lo, &hi};
    hipError_t e = hipLaunchCooperativeKernel((const void*)mega<false>, dim3(grid), dim3(NTHR), args, LDS_BYTES, stream);
    if (e != hipSuccess) fprintf(stderr, "cooperative launch failed: %s (grid %d)\n", hipGetErrorString(e), grid);
#endif
#if MK_XPH >= 0
    { static bool once = false; if (!once) { (void)hipFuncSetAttribute((const void*)mega<true>, hipFuncAttributeMaxDynamicSharedMemorySize, LDS_BYTES); once = true; } }
    for (int i = 0; i < MK_XN; ++i) hipLaunchKernelGGL(mega<true>, dim3(grid), dim3(NTHR), LDS_BYTES, stream, p, MK_XPH, MK_XPH + 1);
#endif
}
```
